# Optimizing an MI355X kernel written in HIP

```python
import math
import jax, jax.numpy as jnp
from jax import lax
import numpy as np

D_MODEL = 1024
BATCH = 2
SEQ = 16384
DEPTH = 2

CHUNK = 64
Q_BLOCK = 128
A_HEADS = 8
A_HEAD_DIM = 64
A_WIDTH = A_HEADS * A_HEAD_DIM
B_EXPAND = 128
B_WIDTH = D_MODEL // 2
B_HEADS = B_WIDTH // B_EXPAND
B_DK = B_EXPAND
B_DV = B_WIDTH // B_HEADS
FFN_HIDDEN = int(math.ceil((8 * D_MODEL / 3) / 256) * 256)
ALPHA = (2 * DEPTH) ** 0.25
BETA = (8 * DEPTH) ** -0.25
LN_EPS = 1e-5
RMS_EPS = 1e-6

IN_WIDTHS = [A_WIDTH, A_WIDTH, A_WIDTH, A_HEADS,
             B_WIDTH, B_WIDTH, B_WIDTH, B_WIDTH,
             D_MODEL, D_MODEL]
IN_TOTAL = int(sum(IN_WIDTHS))
IN_SPLITS = [int(s) for s in np.cumsum(IN_WIDTHS)[:-1]]

kernel_name = "fox_hgrn2_gated_hybrid_deepnorm"


def layer_norm(x, g, b):
    xf = x.astype(jnp.float32)
    mu = jnp.mean(xf, axis=-1, keepdims=True)
    var = jnp.mean(jnp.square(xf - mu), axis=-1, keepdims=True)
    y = (xf - mu) * lax.rsqrt(var + LN_EPS) * g.astype(jnp.float32) + b.astype(jnp.float32)
    return y.astype(x.dtype)


def fox_attention(q, k, v, log_f):
    B, S, H, dh = q.shape
    nb = S // Q_BLOCK
    F = jnp.cumsum(log_f, axis=1).transpose(0, 2, 1)
    kh = k.transpose(0, 2, 1, 3)
    vh = v.transpose(0, 2, 1, 3)
    qb = q.reshape(B, nb, Q_BLOCK, H, dh).transpose(1, 0, 3, 2, 4)
    fq = F.reshape(B, H, nb, Q_BLOCK).transpose(2, 0, 1, 3)
    starts = jnp.arange(nb, dtype=jnp.int32) * Q_BLOCK
    key_pos = jnp.arange(S, dtype=jnp.int32)
    scale = dh ** -0.5

    def one_block(args):
        q_i, fq_i, start = args
        s = jnp.einsum('bhqd,bhkd->bhqk', q_i, kh).astype(jnp.float32) * scale
        s = s + fq_i[..., None] - F[:, :, None, :]
        q_pos = start + jnp.arange(Q_BLOCK, dtype=jnp.int32)
        causal = key_pos[None, :] <= q_pos[:, None]
        p = jax.nn.softmax(jnp.where(causal, s, -jnp.inf), axis=-1)
        return jnp.einsum('bhqk,bhkd->bhqd', p.astype(vh.dtype), vh)

    o = lax.map(one_block, (qb, fq, starts))
    return o.transpose(1, 0, 3, 2, 4).reshape(B, S, H * dh)


def hgrn2_chunkwise(q, k, v, log_f):
    B, S, H, dk = q.shape
    dv = v.shape[-1]
    nc = S // CHUNK

    def to_chunks(t):
        return t.reshape(B, nc, CHUNK, H, t.shape[-1]).transpose(1, 0, 3, 2, 4)

    qc, kc, vc, gc = to_chunks(q), to_chunks(k), to_chunks(v), to_chunks(log_f)
    incl = jnp.tril(jnp.ones((CHUNK, CHUNK), dtype=bool))

    def step(state, inp):
        q_i, k_i, v_i, g_i = inp
        b = jnp.cumsum(g_i, axis=2)
        o_inter = jnp.einsum('bhtd,bhde->bhte', q_i * jnp.exp(b), state)
        diff = b[:, :, :, None, :] - b[:, :, None, :, :]
        decay = jnp.exp(jnp.where(incl[None, None, :, :, None], diff, -jnp.inf))
        attn = jnp.einsum('bhtd,bhtsd,bhsd->bhts', q_i, decay, k_i)
        o_intra = jnp.einsum('bhts,bhse->bhte', attn, v_i)
        b_last = b[:, :, -1:, :]
        k_dec = k_i * jnp.exp(b_last - b)
        new_state = (jnp.exp(b_last[:, :, 0, :])[..., None] * state
                     + jnp.einsum('bhsd,bhse->bhde', k_dec, v_i))
        return new_state, o_inter + o_intra

    s0 = jnp.zeros((B, H, dk, dv), jnp.float32)
    _, o = lax.scan(step, s0, (qc, kc, vc, gc))
    return o.transpose(1, 0, 3, 2, 4).reshape(B, S, H, dv)


def hybrid_mixer(x, w_in, b_f, lb, norm_g, w_pa, w_pb, w_o):
    B, S, _ = x.shape
    proj = x @ w_in
    q_a, k_a, v_a, f_a, q_b, f_b, i_b, g_b, gate_a, gate_b = jnp.split(proj, IN_SPLITS, axis=-1)

    log_fa = jax.nn.log_sigmoid(f_a.astype(jnp.float32) + b_f.astype(jnp.float32))
    shp_a = (B, S, A_HEADS, A_HEAD_DIM)
    y_a = fox_attention(q_a.reshape(shp_a), k_a.reshape(shp_a), v_a.reshape(shp_a), log_fa)

    lbh = lb.astype(jnp.float32).reshape(B_HEADS, B_DK)
    f = lbh + (1.0 - lbh) * jax.nn.sigmoid(f_b.astype(jnp.float32).reshape(B, S, B_HEADS, B_DK))
    qh = jax.nn.silu(q_b.astype(jnp.float32)).reshape(B, S, B_HEADS, B_DK)
    vh = i_b.astype(jnp.float32).reshape(B, S, B_HEADS, B_DV)
    o_b = hgrn2_chunkwise(qh, 1.0 - f, vh, jnp.log(f))
    o_b = o_b * lax.rsqrt(jnp.mean(jnp.square(o_b), axis=-1, keepdims=True) + RMS_EPS)
    o_b = o_b * norm_g.astype(jnp.float32)
    y_b = (o_b.reshape(B, S, B_WIDTH) * jax.nn.sigmoid(g_b.astype(jnp.float32))).astype(x.dtype)

    p_a = y_a @ w_pa
    p_b = y_b @ w_pb
    merged = jax.nn.sigmoid(gate_a) * p_a + jax.nn.sigmoid(gate_b) * p_b
    return merged @ w_o


def swiglu_ffn(x, w_ff_in, w_ff_out):
    h = x @ w_ff_in
    u, g = jnp.split(h, 2, axis=-1)
    return (jax.nn.silu(g) * u) @ w_ff_out


def setup_inputs(seed: int = 0) -> dict:
    key = jax.random.key(seed)
    ks = jax.random.split(key, 16)
    f32 = jnp.float32
    x = jax.random.normal(ks[0], (BATCH, SEQ, D_MODEL), f32)
    col_scale = np.ones((IN_TOTAL,), np.float32)
    col_scale[2 * A_WIDTH:3 * A_WIDTH] = BETA
    v_b_start = 3 * A_WIDTH + A_HEADS + 2 * B_WIDTH
    col_scale[v_b_start:v_b_start + B_WIDTH] = BETA
    w_in = jax.random.normal(ks[1], (DEPTH, D_MODEL, IN_TOTAL), f32) * (D_MODEL ** -0.5) * jnp.asarray(col_scale)
    b_fgate = jnp.linspace(1.0, 5.0, A_HEADS, dtype=f32)[None, :] + 0.1 * jax.random.normal(ks[2], (DEPTH, A_HEADS), f32)
    hgrn_lb_logits = 0.1 * jax.random.normal(ks[3], (DEPTH, B_WIDTH), f32)
    hgrn_norm_g = 1.0 + 0.02 * jax.random.normal(ks[4], (DEPTH, B_DV), f32)
    w_branch_a = jax.random.normal(ks[5], (DEPTH, A_WIDTH, D_MODEL), f32) * (A_WIDTH ** -0.5) * BETA
    w_branch_b = jax.random.normal(ks[6], (DEPTH, B_WIDTH, D_MODEL), f32) * (B_WIDTH ** -0.5) * BETA
    w_out = jax.random.normal(ks[7], (DEPTH, D_MODEL, D_MODEL), f32) * (D_MODEL ** -0.5) * BETA
    ln1_g = 1.0 + 0.02 * jax.random.normal(ks[8], (DEPTH, D_MODEL), f32)
    ln1_b = 0.02 * jax.random.normal(ks[9], (DEPTH, D_MODEL), f32)
    w_ff_in = jax.random.normal(ks[10], (DEPTH, D_MODEL, 2 * FFN_HIDDEN), f32) * (D_MODEL ** -0.5)
    w_ff_out = jax.random.normal(ks[11], (DEPTH, FFN_HIDDEN, D_MODEL), f32) * (FFN_HIDDEN ** -0.5) * BETA
    ln2_g = 1.0 + 0.02 * jax.random.normal(ks[12], (DEPTH, D_MODEL), f32)
    ln2_b = 0.02 * jax.random.normal(ks[13], (DEPTH, D_MODEL), f32)
    return {"x": x, "w_in": w_in, "b_fgate": b_fgate, "hgrn_lb_logits": hgrn_lb_logits,
            "hgrn_norm_g": hgrn_norm_g, "w_branch_a": w_branch_a, "w_branch_b": w_branch_b,
            "w_out": w_out, "ln1_g": ln1_g, "ln1_b": ln1_b, "w_ff_in": w_ff_in,
            "w_ff_out": w_ff_out, "ln2_g": ln2_g, "ln2_b": ln2_b}


def reference(x, w_in, b_fgate, hgrn_lb_logits, hgrn_norm_g, w_branch_a, w_branch_b,
              w_out, ln1_g, ln1_b, w_ff_in, w_ff_out, ln2_g, ln2_b):
    sm = jax.nn.softmax(hgrn_lb_logits.astype(jnp.float32), axis=0)
    lower_bounds = jnp.cumsum(sm, axis=0) - sm[0:1]
    for l in range(DEPTH):
        mix = hybrid_mixer(x, w_in[l], b_fgate[l], lower_bounds[l], hgrn_norm_g[l],
                           w_branch_a[l], w_branch_b[l], w_out[l])
        x = layer_norm(ALPHA * x + mix, ln1_g[l], ln1_b[l])
        ffn = swiglu_ffn(x, w_ff_in[l], w_ff_out[l])
        x = layer_norm(ALPHA * x + ffn, ln2_g[l], ln2_b[l])
    return x
```

```cpp
#include <hip/hip_runtime.h>
#include <cstdio>
#include <cstdint>
namespace pg8 {
#define PG8_LAS __attribute__((address_space(3)))
typedef unsigned short bf16_t;
typedef short bf16x8 __attribute__((ext_vector_type(8)));
typedef float f32x4 __attribute__((ext_vector_type(4)));
typedef unsigned u32x4 __attribute__((ext_vector_type(4)));
constexpr int BM = 256, BK = 64, HALF = 128, HTB = HALF * BK * 2  , STAGE_BYTES = 8 * HTB, NXCD = 8, WGM = 8;

__host__ __device__ __forceinline__ int lds_byte(int r, int c) { const int st = (r >> 4) * 2 + (c >> 5), rr = r & 15, cc = c & 31, ob = rr * 64 + cc * 2; return st * 1024 + (ob ^ (((ob >> 9) & 1) << 5)); }
__host__ __device__ __forceinline__ void stage_rc(int b, int& R, int& C) { const int st = b / 1024, sb = b % 1024, swz = sb ^ (((sb >> 9) & 1) << 5); R = (st >> 1) * 16 + swz / 64; C = (st & 1) * 32 + (swz % 64) / 2; }
__host__ __device__ __forceinline__ int perm32(int rho) { const int n = rho >> 4, i = rho & 15; return 8 * (i >> 2) + 4 * n + (i & 3); }

struct Unit { int pm, pn; };
struct Gemm { const bf16_t* A; const bf16_t* Bt; int M, N, K; };

struct StaticOrder {
    int nM, nN, nwg, G, c;
    __host__ __device__ void init(int M, int N, int G_, int c_) { nM = M / BM; nN = N / BM; nwg = nM * nN; G = G_; c = c_; }
    __host__ __device__ bool next(int i, Unit& u) const {
        const long L = (long)i * G + c; if (L >= nwg) return false;
        int wgid = (int)L; { const int q = nwg / NXCD, r = nwg % NXCD, xcd = wgid % NXCD, off = wgid / NXCD; wgid = (xcd < r ? xcd * (q + 1) : r * (q + 1) + (xcd - r) * q) + off; }
        const int nig = WGM * nN, gid = wgid / nig, fm = gid * WGM, gsz = (nM - fm) < WGM ? (nM - fm) : WGM;
        u.pm = fm + ((wgid % nig) % gsz); u.pn = (wgid % nig) / gsz; return true;
    }
    __device__ __forceinline__ void a_ready(const Unit&) const {}
    __device__ __forceinline__ void done(const Unit&) const {}
};

typedef float f32x2c_t __attribute__((ext_vector_type(2))); typedef __bf16 bf16x2c_t __attribute__((ext_vector_type(2)));
__device__ __forceinline__ unsigned cvt_pk_bf16(float lo, float hi) { f32x2c_t v = {lo, hi}; bf16x2c_t b = __builtin_convertvector(v, bf16x2c_t); return __builtin_bit_cast(unsigned, b); }
typedef float f32x2 __attribute__((ext_vector_type(2)));
__device__ __forceinline__ f32x2 gelu_pk(f32x2 v) {
    const f32x2 av = __builtin_elementwise_abs(v), d = av * 0.2316418882f + 1.0f;
    f32x2 t; t.x = __builtin_amdgcn_rcpf(d.x); t.y = __builtin_amdgcn_rcpf(d.y);
    f32x2 q = t * 0.5307027145f + (-0.7265760135f); q = q * t + 0.7107068705f; q = q * t + (-0.142248368f); q = q * t + 0.127414796f; q = q * t;
    const f32x2 s = (v * v) * (-0.72134752044f);
    f32x2 e; e.x = __builtin_amdgcn_exp2f(s.x); e.y = __builtin_amdgcn_exp2f(s.y);
    const f32x2 m = v * (q * e), r = v - m;
    f32x2 o; o.x = v.x < 0.f ? m.x : r.x; o.y = v.y < 0.f ? m.y : r.y; return o;
}

template <int ACT  > struct EpiBf16 {
    static constexpr bool PERM = true, AFTER_DRAIN = false; static_assert(ACT == 0 || ACT == 1, "EpiBf16: ACT is 0 (none) or 1 (gelu_pk)");
    bf16_t* O; int ldc; const float* bias; int split_cols; size_t split_stride; float scale0;
    __device__ __forceinline__ void operator()(const f32x4 (&acc)[2][2][4][2], const Unit& u, int wr, int wc, int fr, int fq) const {
        const int row0 = u.pm * BM + wr * 64 + fr; int colt = u.pn * BM; bf16_t* base = O;
        float sc = 1.f; if (split_cols) { const int t = colt / split_cols; base += (size_t)t * split_stride; colt -= t * split_cols; if (t == 0) sc = scale0; }
        const int col0 = colt + wc * 32 + 8 * fq, bcol0 = u.pn * BM + wc * 32 + 8 * fq;
        f32x4 bv[2][2];
#pragma unroll
        for (int bj = 0; bj < 2; ++bj)
#pragma unroll
            for (int n = 0; n < 2; ++n) bv[bj][n] = bias ? *(const f32x4*)(bias + bcol0 + bj * HALF + 4 * n) : (f32x4){0.f, 0.f, 0.f, 0.f};
#pragma unroll
        for (int ai = 0; ai < 2; ++ai)
#pragma unroll
            for (int m = 0; m < 4; ++m) { bf16_t* rowp = base + (size_t)(row0 + ai * HALF + m * 16) * ldc + col0;
#pragma unroll
                for (int bj = 0; bj < 2; ++bj) { f32x4 v0 = acc[ai][bj][m][0] + bv[bj][0], v1 = acc[ai][bj][m][1] + bv[bj][1];
                    if (ACT == 1) { f32x2 a = gelu_pk((f32x2){v0[0], v0[1]}), b = gelu_pk((f32x2){v0[2], v0[3]}), c = gelu_pk((f32x2){v1[0], v1[1]}), d = gelu_pk((f32x2){v1[2], v1[3]});
                        v0 = (f32x4){a.x, a.y, b.x, b.y}; v1 = (f32x4){c.x, c.y, d.x, d.y}; }
                    v0 = v0 * sc; v1 = v1 * sc; u32x4 w; w.x = cvt_pk_bf16(v0[0], v0[1]); w.y = cvt_pk_bf16(v0[2], v0[3]); w.z = cvt_pk_bf16(v1[0], v1[1]); w.w = cvt_pk_bf16(v1[2], v1[3]);
                    *(u32x4*)(rowp + bj * HALF) = w; } }
    }
};

struct PanelStats {
    unsigned* xbuf;
    unsigned* cnt;
    unsigned* tmo;
    int ntn; float eps;
    unsigned code;
    __device__ __forceinline__ bool run(const f32x4 (&v)[2][2][4][2], const Unit& u, int wr, int wc, int fr, int fq, PG8_LAS unsigned char* lds, int wid, int lane) const {
        typedef float f32x2v __attribute__((ext_vector_type(2)));
        PG8_LAS f32x2v* P = (PG8_LAS f32x2v*)lds;
        PG8_LAS f32x2v* S = (PG8_LAS f32x2v*)(lds + 8192);
        PG8_LAS unsigned* flag = (PG8_LAS unsigned*)(lds + 8192 + 2048);
#pragma unroll
        for (int ai = 0; ai < 2; ++ai)
#pragma unroll
            for (int m = 0; m < 4; ++m) {
                float s = 0.f;
#pragma unroll
                for (int bj = 0; bj < 2; ++bj)
#pragma unroll
                    for (int n = 0; n < 2; ++n) { const f32x4 x = v[ai][bj][m][n]; s += (x[0] + x[1]) + (x[2] + x[3]); }
                s += __shfl_xor(s, 16); s += __shfl_xor(s, 32);
                const float mw = s * (1.0f / 64.0f); float q = 0.f;
#pragma unroll
                for (int bj = 0; bj < 2; ++bj)
#pragma unroll
                    for (int n = 0; n < 2; ++n) { const f32x4 d = v[ai][bj][m][n] - mw; q += (d[0] * d[0] + d[1] * d[1]) + (d[2] * d[2] + d[3] * d[3]); }
                q += __shfl_xor(q, 16); q += __shfl_xor(q, 32);
                if (fq == 0) P[(ai * HALF + wr * 64 + m * 16 + fr) * 4 + wc] = (f32x2v){mw, q};
            }
        asm volatile("s_waitcnt lgkmcnt(0)" ::: "memory"); __builtin_amdgcn_s_barrier(); asm volatile("" ::: "memory");
#if defined(BROKEN_EXCHANGE_NO_WAIT)
#warning BROKEN CONTROL BUILD: the row-statistics exchange does not wait; results are wrong by design
        if (blockIdx.x >= 64) { const long long t0_ = clock64(); while (clock64() - t0_ < 60000) __builtin_amdgcn_s_sleep(8); }
#endif
        const int row = wid * 32 + (lane & 31);
        if (lane < 32) {
            const f32x2v a = P[row * 4 + 0], b = P[row * 4 + 1], c = P[row * 4 + 2], d = P[row * 4 + 3];
            const float mt = (a.x + b.x + c.x + d.x) * 0.25f;
            const float da = a.x - mt, db = b.x - mt, dc = c.x - mt, dd = d.x - mt;
            const float m2 = (a.y + b.y) + (c.y + d.y) + 64.0f * ((da * da + db * db) + (dc * dc + dd * dd));
            unsigned long long* slot = (unsigned long long*)xbuf + ((size_t)(u.pm * BM + row) * 4 + u.pn);
            __hip_atomic_store(slot, ((unsigned long long)__float_as_uint(m2) << 32) | __float_as_uint(mt), __ATOMIC_RELAXED, __HIP_MEMORY_SCOPE_AGENT);
        }
        asm volatile("s_waitcnt vmcnt(0)" ::: "memory");
        if (lane == 0) __hip_atomic_fetch_add(cnt + 64 * u.pm, 1u, __ATOMIC_RELAXED, __HIP_MEMORY_SCOPE_AGENT);
        if (wid == 0) {
            bool dead = false; const unsigned long long t0 = __builtin_amdgcn_s_memrealtime(); const unsigned want = 8u * (unsigned)ntn;
            for (;;) {
#if defined(BROKEN_EXCHANGE_NO_WAIT)
                break;
#endif
                if ((unsigned)__builtin_amdgcn_readfirstlane(__hip_atomic_load(cnt + 64 * u.pm, __ATOMIC_RELAXED, __HIP_MEMORY_SCOPE_AGENT)) >= want) break;
                if (__builtin_amdgcn_s_memrealtime() - t0 > 2000000ull) {
                    if (lane == 0) { unsigned expect = 0u; __hip_atomic_compare_exchange_strong(tmo + 1, &expect, code | (unsigned)(u.pm & 0xff), __ATOMIC_RELAXED, __ATOMIC_RELAXED, __HIP_MEMORY_SCOPE_AGENT);
                                     __hip_atomic_store(tmo, 1u, __ATOMIC_RELAXED, __HIP_MEMORY_SCOPE_AGENT); }
                    dead = true; break; }
                __builtin_amdgcn_s_sleep(2);
            }
            __builtin_amdgcn_fence(__ATOMIC_ACQUIRE, "agent");
            if (lane == 0) flag[0] = dead ? 1u : 0u;
        }
        asm volatile("s_waitcnt vmcnt(0) lgkmcnt(0)" ::: "memory"); __builtin_amdgcn_s_barrier(); asm volatile("" ::: "memory");
        const bool bad = flag[0] != 0u;
        if (lane < 32) {
            const unsigned long long* slot = (const unsigned long long*)xbuf + (size_t)(u.pm * BM + row) * 4; float mt[4], m2[4]; float ms = 0.f;
#pragma unroll
            for (int t = 0; t < 4; ++t) { if (t < ntn) { const unsigned long long w = __hip_atomic_load(slot + t, __ATOMIC_RELAXED, __HIP_MEMORY_SCOPE_AGENT); mt[t] = __uint_as_float((unsigned)w); m2[t] = __uint_as_float((unsigned)(w >> 32)); } else { mt[t] = 0.f; m2[t] = 0.f; } ms += mt[t]; }
            const float mean = ms / (float)ntn; float q = 0.f;
#pragma unroll
            for (int t = 0; t < 4; ++t) if (t < ntn) { const float dm = mt[t] - mean; q += m2[t] + 256.0f * dm * dm; }
            S[row] = (f32x2v){mean, 1.0f / sqrtf(q / (256.0f * (float)ntn) + eps)};
        }
        asm volatile("s_waitcnt lgkmcnt(0)" ::: "memory"); __builtin_amdgcn_s_barrier(); asm volatile("" ::: "memory");
        return bad;
    }
};
struct EpiLnRes {
    static constexpr bool PERM = false, AFTER_DRAIN = true;
    const float* base; float* out; int ldc; const float* bias; PanelStats st; unsigned poison;
    __device__ __forceinline__ void fused(f32x4 (&acc)[2][2][4][2], const Unit& u, int wr, int wc, int fr, int fq, PG8_LAS unsigned char* lds, int wid, int lane) const {
        typedef float f32x2v __attribute__((ext_vector_type(2)));
        const PG8_LAS f32x2v* S = (const PG8_LAS f32x2v*)(lds + 8192);
        const int col0 = u.pn * BM + wc * 32 + 4 * fq;
#pragma unroll
        for (int bj = 0; bj < 2; ++bj)
#pragma unroll
            for (int n = 0; n < 2; ++n) { const f32x4 bv = bias ? *(const f32x4*)(bias + col0 + bj * HALF + n * 16) : (f32x4){0.f, 0.f, 0.f, 0.f};
#pragma unroll
                for (int ai = 0; ai < 2; ++ai)
#pragma unroll
                    for (int m = 0; m < 4; ++m) acc[ai][bj][m][n] += bv; }
        f32x4 pre[4][2][2];
#pragma unroll
        for (int m = 0; m < 4; ++m) { const size_t off = (size_t)(u.pm * BM + wr * 64 + m * 16 + fr) * ldc + col0;
#pragma unroll
            for (int bj = 0; bj < 2; ++bj)
#pragma unroll
                for (int n = 0; n < 2; ++n) pre[m][bj][n] = *(const f32x4*)(base + off + bj * HALF + n * 16); }
        const bool bad = st.run(acc, u, wr, wc, fr, fq, lds, wid, lane) || poison != 0u;
        const float qnan = __builtin_nanf("");
#pragma unroll
        for (int ai = 0; ai < 2; ++ai)
#pragma unroll
            for (int m = 0; m < 4; ++m) { const int r = ai * HALF + wr * 64 + m * 16 + fr; const f32x2v sr = S[r]; const size_t off = (size_t)(u.pm * BM + r) * ldc + col0;
#pragma unroll
                for (int bj = 0; bj < 2; ++bj)
#pragma unroll
                    for (int n = 0; n < 2; ++n) { const f32x4 bs = ai == 0 ? pre[m][bj][n] : *(const f32x4*)(base + off + bj * HALF + n * 16); f32x4 o = bs + (acc[ai][bj][m][n] - sr.x) * sr.y;
                        if (bad) o = (f32x4){qnan, qnan, qnan, qnan}; *(f32x4*)(out + off + bj * HALF + n * 16) = o; }
                if (m & 1) asm volatile("" ::: "memory"); }
    }
};
struct EpiLnResLn {
    static constexpr bool PERM = false, AFTER_DRAIN = true;
    const float* base; float* out; bf16_t* xn; int ldc; const float* bias; PanelStats st1, st2; unsigned poison;
    __device__ __forceinline__ void fused(f32x4 (&acc)[2][2][4][2], const Unit& u, int wr, int wc, int fr, int fq, PG8_LAS unsigned char* lds, int wid, int lane) const {
        typedef float f32x2v __attribute__((ext_vector_type(2))); typedef unsigned u32x2v __attribute__((ext_vector_type(2)));
        const PG8_LAS f32x2v* S = (const PG8_LAS f32x2v*)(lds + 8192);
        const int col0 = u.pn * BM + wc * 32 + 4 * fq;
#pragma unroll
        for (int bj = 0; bj < 2; ++bj)
#pragma unroll
            for (int n = 0; n < 2; ++n) { const f32x4 bv = bias ? *(const f32x4*)(bias + col0 + bj * HALF + n * 16) : (f32x4){0.f, 0.f, 0.f, 0.f};
#pragma unroll
                for (int ai = 0; ai < 2; ++ai)
#pragma unroll
                    for (int m = 0; m < 4; ++m) acc[ai][bj][m][n] += bv; }
        bool bad = st1.run(acc, u, wr, wc, fr, fq, lds, wid, lane) || poison != 0u;
        const float qnan = __builtin_nanf("");
#pragma unroll
        for (int ai = 0; ai < 2; ++ai)
#pragma unroll
            for (int m = 0; m < 4; ++m) { const int r = ai * HALF + wr * 64 + m * 16 + fr; const f32x2v sr = S[r]; const size_t off = (size_t)(u.pm * BM + r) * ldc + col0;
#pragma unroll
                for (int bj = 0; bj < 2; ++bj)
#pragma unroll
                    for (int n = 0; n < 2; ++n) { const f32x4 bs = *(const f32x4*)(base + off + bj * HALF + n * 16); acc[ai][bj][m][n] = bs + (acc[ai][bj][m][n] - sr.x) * sr.y; }
                asm volatile("" : "+v"(acc[ai][0][m][0]), "+v"(acc[ai][0][m][1]), "+v"(acc[ai][1][m][0]), "+v"(acc[ai][1][m][1]));
                if (m & 1) asm volatile("" ::: "memory"); }
        const bool bad1 = bad;
        bad = st2.run(acc, u, wr, wc, fr, fq, lds, wid, lane) || bad;
#pragma unroll
        for (int ai = 0; ai < 2; ++ai)
#pragma unroll
            for (int m = 0; m < 4; ++m) { const int r = ai * HALF + wr * 64 + m * 16 + fr; const f32x2v sr = S[r]; const size_t off = (size_t)(u.pm * BM + r) * ldc + col0;
#pragma unroll
                for (int bj = 0; bj < 2; ++bj)
#pragma unroll
                    for (int n = 0; n < 2; ++n) { const f32x4 x1 = acc[ai][bj][m][n]; *(f32x4*)(out + off + bj * HALF + n * 16) = bad1 ? (f32x4){qnan, qnan, qnan, qnan} : x1;
                        const f32x4 o = (x1 - sr.x) * sr.y; u32x2v w; w.x = cvt_pk_bf16(o[0], o[1]); w.y = cvt_pk_bf16(o[2], o[3]);
                        if (bad) { w.x = 0x7fc07fc0u; w.y = 0x7fc07fc0u; } *(u32x2v*)(xn + off + bj * HALF + n * 16) = w; }
                asm volatile("" ::: "memory"); }
    }
};

template <class Epi, class Sched, bool ALIGN_EPI = false, bool SP2 = false>
__device__ __forceinline__ void gemm_phase(PG8_LAS unsigned char* lds, const Gemm g, const Sched& S, const Epi& E) {
    int tid_ = threadIdx.x; asm volatile("" : "+v"(tid_));
    const int tid = tid_, wid = __builtin_amdgcn_readfirstlane(tid >> 6), lane = tid & 63, wr = wid >> 2, wc = wid & 3, fr = lane & 15, fq = lane >> 4;
    const int K = g.K, nt = K / BK;
    unsigned voffA[2], voffB[2];
#pragma unroll
    for (int i = 0; i < 2; ++i) { int R, C; stage_rc(tid * 16 + i * 8192, R, C); const int Rb = Epi::PERM ? ((R & ~31) + perm32(R & 31)) : R;
        voffA[i] = (unsigned)(R * K + C) * 2u; voffB[i] = (unsigned)(Rb * K + C) * 2u; }
    const size_t kstep = (size_t)(BK * 2);
    const size_t hstep = (size_t)HALF * K * 2;
    const size_t tstep = 2 * hstep;
    const unsigned ldsw = (unsigned)wid * 1024u;
    const int aoff = lds_byte(wr * 64 + fr, fq * 8), boff = lds_byte(wc * 32 + fr, fq * 8);
#define PG8_SA(b, h) (((b) * 2 + (h)) * HTB)
#define PG8_SB(b, h) ((4 + (b) * 2 + (h)) * HTB)
#define PG8_STAGE(bufoff, gbase, voff) do { _Pragma("unroll") for (int _i = 0; _i < 2; ++_i) \
        __builtin_amdgcn_global_load_lds((const unsigned*)((const char*)(gbase) + (voff)[_i]), (PG8_LAS unsigned*)(lds + (bufoff) + ldsw + _i * 8192), 16, 0, 0); } while (0)
#define PG8_LDA(dst, b, h) do { _Pragma("unroll") for (int m = 0; m < 4; ++m) _Pragma("unroll") for (int k = 0; k < 2; ++k) dst[m][k] = *(const PG8_LAS bf16x8*)(lds + PG8_SA(b, h) + aoff + m * 2048 + k * 1024); } while (0)
#define PG8_LDB(dst, b, h) do { _Pragma("unroll") for (int n = 0; n < 2; ++n) _Pragma("unroll") for (int k = 0; k < 2; ++k) dst[n][k] = *(const PG8_LAS bf16x8*)(lds + PG8_SB(b, h) + boff + n * 2048 + k * 1024); } while (0)
#define PG8_MMA(ai, bj, At, Bt) do { __builtin_amdgcn_s_setprio(1); _Pragma("unroll") for (int m = 0; m < 4; ++m) _Pragma("unroll") for (int n = 0; n < 2; ++n) _Pragma("unroll") for (int k = 0; k < 2; ++k) \
        acc[ai][bj][m][n] = __builtin_amdgcn_mfma_f32_16x16x32_bf16(Bt[n][k], At[m][k], acc[ai][bj][m][n], 0, 0, 0); __builtin_amdgcn_s_setprio(0); } while (0)
#define PG8_WAIT_V(n) asm volatile("s_waitcnt vmcnt(" #n ")" ::: "memory")
#define PG8_WAIT_L(n) asm volatile("s_waitcnt lgkmcnt(" #n ")" ::: "memory")
#define PG8_BAR __builtin_amdgcn_s_barrier()
#define PG8_SCHED __builtin_amdgcn_sched_barrier(0)
    Unit cur, nxt; int ui = 0;
    if (!S.next(0, cur)) return;
    f32x4 acc[2][2][4][2];
#pragma unroll
    for (int a = 0; a < 2; ++a)
#pragma unroll
        for (int b = 0; b < 2; ++b)
#pragma unroll
            for (int m = 0; m < 4; ++m)
#pragma unroll
                for (int n = 0; n < 2; ++n) acc[a][b][m][n] = (f32x4){0.f, 0.f, 0.f, 0.f};
    bf16x8 At[4][2], B0[2][2], B1[2][2];
    const char* cA = (const char*)g.A + (size_t)cur.pm * tstep; const char* cB = (const char*)g.Bt + (size_t)cur.pn * tstep;
    S.a_ready(cur);
    if constexpr (SP2) {
        PG8_STAGE(PG8_SB(0, 0), cB, voffB); PG8_STAGE(PG8_SB(0, 1), cB + hstep, voffB); PG8_STAGE(PG8_SA(0, 0), cA, voffA); PG8_STAGE(PG8_SA(0, 1), cA + hstep, voffA);
        if (wr == 1) PG8_BAR;
        PG8_WAIT_V(2); PG8_BAR;
        PG8_STAGE(PG8_SB(1, 0), cB + kstep, voffB); PG8_STAGE(PG8_SA(1, 0), cA + kstep, voffA); PG8_STAGE(PG8_SB(1, 1), cB + hstep + kstep, voffB);
        PG8_WAIT_V(6); PG8_BAR;
    } else {
        PG8_STAGE(PG8_SB(0, 0), cB, voffB); PG8_STAGE(PG8_SA(0, 0), cA, voffA); PG8_STAGE(PG8_SB(0, 1), cB + hstep, voffB); PG8_STAGE(PG8_SA(0, 1), cA + hstep, voffA);
        if (wr == 1) PG8_BAR;
        PG8_WAIT_V(4); PG8_BAR;
        PG8_STAGE(PG8_SB(1, 0), cB + kstep, voffB); PG8_STAGE(PG8_SA(1, 0), cA + kstep, voffA); PG8_STAGE(PG8_SB(1, 1), cB + hstep + kstep, voffB);
        PG8_WAIT_V(6); PG8_BAR;
    }
    for (;;) {
        const bool has_next = S.next(ui + 1, nxt);
        const char* nA = has_next ? (const char*)g.A + (size_t)nxt.pm * tstep : cA; const char* nB = has_next ? (const char*)g.Bt + (size_t)nxt.pn * tstep : cB;
        for (int t = 0; t < nt; t += 2) {
            const bool last = (t == nt - 2);
            const char* a1 = cA + (size_t)(t + 1) * kstep;
            const char* a2 = last ? nA : cA + (size_t)(t + 2) * kstep; const char* b2 = last ? nB : cB + (size_t)(t + 2) * kstep;
            const char* a3 = a2 + kstep; const char* b3 = b2 + kstep;
            if (last && has_next) S.a_ready(nxt);
            if constexpr (SP2) {
            PG8_LDB(B0, 0, 0); PG8_LDB(B1, 0, 1); PG8_SCHED; PG8_LDA(At, 0, 0); PG8_STAGE(PG8_SA(1, 1), a1 + hstep, voffA);
            PG8_WAIT_V(8); PG8_WAIT_L(0); PG8_BAR; PG8_MMA(0, 0, At, B0); PG8_MMA(0, 1, At, B1); PG8_BAR; PG8_SCHED;
            PG8_LDA(At, 0, 1); PG8_STAGE(PG8_SB(0, 0), b2, voffB); PG8_STAGE(PG8_SB(0, 1), b2 + hstep, voffB); PG8_STAGE(PG8_SA(0, 0), a2, voffA);
            PG8_WAIT_V(8); PG8_WAIT_L(0); PG8_BAR; PG8_MMA(1, 0, At, B0); PG8_MMA(1, 1, At, B1); PG8_BAR; PG8_SCHED;
            PG8_LDB(B0, 1, 0); PG8_LDB(B1, 1, 1); PG8_SCHED; PG8_LDA(At, 1, 0); PG8_STAGE(PG8_SA(0, 1), a2 + hstep, voffA);
            PG8_WAIT_V(8); PG8_WAIT_L(0); PG8_BAR; PG8_MMA(0, 0, At, B0); PG8_MMA(0, 1, At, B1); PG8_BAR; PG8_SCHED;
            PG8_LDA(At, 1, 1); PG8_STAGE(PG8_SB(1, 0), b3, voffB); PG8_STAGE(PG8_SB(1, 1), b3 + hstep, voffB); PG8_STAGE(PG8_SA(1, 0), a3, voffA);
            PG8_WAIT_V(8); PG8_WAIT_L(0); PG8_BAR; PG8_MMA(1, 0, At, B0); PG8_MMA(1, 1, At, B1); PG8_BAR; PG8_SCHED;
            } else {
            PG8_LDB(B0, 0, 0); PG8_SCHED; PG8_LDA(At, 0, 0); PG8_STAGE(PG8_SA(1, 1), a1 + hstep, voffA);
            PG8_WAIT_L(8); PG8_BAR; PG8_WAIT_L(0); PG8_MMA(0, 0, At, B0); PG8_BAR; PG8_SCHED;
            PG8_LDB(B1, 0, 1); PG8_STAGE(PG8_SB(0, 0), b2, voffB);
            PG8_BAR; PG8_WAIT_L(0); PG8_MMA(0, 1, At, B1); PG8_BAR;
            PG8_LDA(At, 0, 1); PG8_STAGE(PG8_SA(0, 0), a2, voffA);
            PG8_BAR; PG8_WAIT_L(0); PG8_MMA(1, 0, At, B0); PG8_BAR; PG8_SCHED;
            PG8_STAGE(PG8_SB(0, 1), b2 + hstep, voffB);
            PG8_WAIT_V(6); PG8_BAR; PG8_MMA(1, 1, At, B1); PG8_BAR;
            PG8_LDB(B0, 1, 0); PG8_SCHED; PG8_LDA(At, 1, 0); PG8_STAGE(PG8_SA(0, 1), a2 + hstep, voffA);
            PG8_WAIT_L(8); PG8_BAR; PG8_WAIT_L(0); PG8_MMA(0, 0, At, B0); PG8_BAR; PG8_SCHED;
            PG8_LDB(B1, 1, 1); PG8_STAGE(PG8_SB(1, 0), b3, voffB);
            PG8_BAR; PG8_WAIT_L(0); PG8_MMA(0, 1, At, B1); PG8_BAR;
            PG8_LDA(At, 1, 1); PG8_STAGE(PG8_SA(1, 0), a3, voffA);
            PG8_BAR; PG8_WAIT_L(0); PG8_MMA(1, 0, At, B0); PG8_BAR; PG8_SCHED;
            PG8_STAGE(PG8_SB(1, 1), b3 + hstep, voffB);
            PG8_WAIT_V(6); PG8_BAR; PG8_MMA(1, 1, At, B1); PG8_BAR;
            }
        }
        if constexpr (ALIGN_EPI) { if (wr == 0) PG8_BAR; }
        if constexpr (!Epi::AFTER_DRAIN) { E(acc, cur, wr, wc, fr, fq); S.done(cur); }
        if (!has_next) break;
#pragma unroll
        for (int a = 0; a < 2; ++a)
#pragma unroll
            for (int b = 0; b < 2; ++b)
#pragma unroll
                for (int m = 0; m < 4; ++m)
#pragma unroll
                    for (int n = 0; n < 2; ++n) acc[a][b][m][n] = (f32x4){0.f, 0.f, 0.f, 0.f};
        cur = nxt; cA = nA; cB = nB; ++ui;
        if constexpr (ALIGN_EPI) { if (wr == 1) PG8_BAR; }
    }
    PG8_WAIT_V(0);
    if constexpr (!ALIGN_EPI) { if (wr == 0) PG8_BAR; }
    PG8_BAR;
    if constexpr (Epi::AFTER_DRAIN) { E.fused(acc, cur, wr, wc, fr, fq, lds, wid, lane); S.done(cur); }
#undef PG8_SA
#undef PG8_SB
#undef PG8_STAGE
#undef PG8_LDA
#undef PG8_LDB
#undef PG8_MMA
#undef PG8_WAIT_V
#undef PG8_WAIT_L
#undef PG8_BAR
#undef PG8_SCHED
}
}
namespace pg8 {
__device__ __forceinline__ float fsig(float v) { return __builtin_amdgcn_rcpf(1.0f + __builtin_amdgcn_exp2f(-1.4426950408889634f * v)); }
__device__ __forceinline__ float bf_lo(unsigned w) { return __uint_as_float(w << 16); }
__device__ __forceinline__ float bf_hi(unsigned w) { return __uint_as_float(w & 0xffff0000u); }

struct EpiInProj {
    static constexpr bool PERM = true, AFTER_DRAIN = false;
    bf16_t* QAB; bf16_t* KA; bf16_t* VA; float* G; bf16_t* IB; bf16_t* GB; const float* lbl; int layer; float qscale;
    __device__ __forceinline__ void operator()(const f32x4 (&acc)[2][2][4][2], const Unit& u, int wr, int wc, int fr, int fq) const {
        const int type = u.pn >> 1;
        const int ct = (u.pn & 1) * 256 + wc * 32 + 8 * fq;
        const int row0 = u.pm * BM + wr * 64 + fr;
        if (type == 4) {
            float lb[2][8];
#pragma unroll
            for (int bj = 0; bj < 2; ++bj)
#pragma unroll
                for (int j = 0; j < 8; ++j) {
                    float v = 0.f;
                    if (layer != 0) { const float l0 = lbl[ct + bj * HALF + j], l1 = lbl[512 + ct + bj * HALF + j]; v = 1.0f / (1.0f + __expf(l0 - l1)); }
                    lb[bj][j] = v;
                }
#pragma unroll
            for (int ai = 0; ai < 2; ++ai)
#pragma unroll
                for (int m = 0; m < 4; ++m) { float* rowp = G + (size_t)(row0 + ai * HALF + m * 16) * 512 + ct;
#pragma unroll
                    for (int bj = 0; bj < 2; ++bj) { f32x4 o0, o1;
#pragma unroll
                        for (int j = 0; j < 4; ++j) {
                            const float f0 = lb[bj][j] + (1.0f - lb[bj][j]) * fsig(acc[ai][bj][m][0][j]);
                            const float f1 = lb[bj][4 + j] + (1.0f - lb[bj][4 + j]) * fsig(acc[ai][bj][m][1][j]);
                            o0[j] = __builtin_amdgcn_logf(f0) * 0.6931471805599453f; o1[j] = __builtin_amdgcn_logf(f1) * 0.6931471805599453f; }
                        *(f32x4*)(rowp + bj * HALF) = o0; *(f32x4*)(rowp + bj * HALF + 4) = o1; } }
        } else {
            bf16_t* base; int ldc = 512, act = 0; float sc = 1.f;
            if (type == 0) { base = QAB; ldc = 1024; sc = qscale; }
            else if (type == 1) base = KA;
            else if (type == 2) base = VA;
            else if (type == 3) { base = QAB + 512; ldc = 1024; act = 1; }
            else if (type == 5) base = IB;
            else { base = GB; act = 2; }
#pragma unroll
            for (int ai = 0; ai < 2; ++ai)
#pragma unroll
                for (int m = 0; m < 4; ++m) { bf16_t* rowp = base + (size_t)(row0 + ai * HALF + m * 16) * ldc + ct;
#pragma unroll
                    for (int bj = 0; bj < 2; ++bj) { f32x4 v0 = acc[ai][bj][m][0], v1 = acc[ai][bj][m][1];
                        if (act != 0) {
#pragma unroll
                            for (int j = 0; j < 4; ++j) { const float s0 = fsig(v0[j]), s1 = fsig(v1[j]); v0[j] = (act == 1) ? v0[j] * s0 : s0; v1[j] = (act == 1) ? v1[j] * s1 : s1; }
                        } else { v0 = v0 * sc; v1 = v1 * sc; }
                        u32x4 w; w.x = cvt_pk_bf16(v0[0], v0[1]); w.y = cvt_pk_bf16(v0[2], v0[3]); w.z = cvt_pk_bf16(v1[0], v1[1]); w.w = cvt_pk_bf16(v1[2], v1[3]);
                        *(u32x4*)(rowp + bj * HALF) = w; } }
        }
    }
};
struct EpiGates {
    static constexpr bool PERM = true, AFTER_DRAIN = false;
    bf16_t* O;
    __device__ __forceinline__ void operator()(const f32x4 (&acc)[2][2][4][2], const Unit& u, int wr, int wc, int fr, int fq) const {
        const int row0 = u.pm * BM + wr * 64 + fr, col0 = u.pn * BM + wc * 32 + 8 * fq;
#pragma unroll
        for (int ai = 0; ai < 2; ++ai)
#pragma unroll
            for (int m = 0; m < 4; ++m) { bf16_t* rowp = O + (size_t)(row0 + ai * HALF + m * 16) * 2048 + col0;
#pragma unroll
                for (int bj = 0; bj < 2; ++bj) { f32x4 v0 = acc[ai][bj][m][0], v1 = acc[ai][bj][m][1];
#pragma unroll
                    for (int j = 0; j < 4; ++j) { v0[j] = fsig(v0[j]); v1[j] = fsig(v1[j]); }
                    u32x4 w; w.x = cvt_pk_bf16(v0[0], v0[1]); w.y = cvt_pk_bf16(v0[2], v0[3]); w.z = cvt_pk_bf16(v1[0], v1[1]); w.w = cvt_pk_bf16(v1[2], v1[3]);
                    *(u32x4*)(rowp + bj * HALF) = w; } }
    }
};
struct EpiMerge {
    static constexpr bool PERM = true, AFTER_DRAIN = false;
    const bf16_t* GT; bf16_t* O;
    __device__ __forceinline__ void operator()(const f32x4 (&acc)[2][2][4][2], const Unit& u, int wr, int wc, int fr, int fq) const {
        const int row0 = u.pm * BM + wr * 64 + fr, col0 = u.pn * HALF + wc * 32 + 8 * fq;
#pragma unroll
        for (int ai = 0; ai < 2; ++ai)
#pragma unroll
            for (int m = 0; m < 4; ++m) { const size_t row = (size_t)(row0 + ai * HALF + m * 16);
                const u32x4 ga = *(const u32x4*)(GT + row * 2048 + col0), gb = *(const u32x4*)(GT + row * 2048 + 1024 + col0);
                const f32x4 a0 = acc[ai][0][m][0], a1 = acc[ai][0][m][1], b0 = acc[ai][1][m][0], b1 = acc[ai][1][m][1];
                u32x4 w;
                w.x = cvt_pk_bf16(bf_lo(ga.x) * a0[0] + bf_lo(gb.x) * b0[0], bf_hi(ga.x) * a0[1] + bf_hi(gb.x) * b0[1]);
                w.y = cvt_pk_bf16(bf_lo(ga.y) * a0[2] + bf_lo(gb.y) * b0[2], bf_hi(ga.y) * a0[3] + bf_hi(gb.y) * b0[3]);
                w.z = cvt_pk_bf16(bf_lo(ga.z) * a1[0] + bf_lo(gb.z) * b1[0], bf_hi(ga.z) * a1[1] + bf_hi(gb.z) * b1[1]);
                w.w = cvt_pk_bf16(bf_lo(ga.w) * a1[2] + bf_lo(gb.w) * b1[2], bf_hi(ga.w) * a1[3] + bf_hi(gb.w) * b1[3]);
                *(u32x4*)(O + row * 1024 + col0) = w;
                if (m & 1) asm volatile("" ::: "memory"); }
    }
};
struct EpiSwiGLU {
    static constexpr bool PERM = true, AFTER_DRAIN = false;
    bf16_t* O;
    __device__ __forceinline__ void operator()(const f32x4 (&acc)[2][2][4][2], const Unit& u, int wr, int wc, int fr, int fq) const {
        const int row0 = u.pm * BM + wr * 64 + fr, col0 = u.pn * HALF + wc * 32 + 8 * fq;
#pragma unroll
        for (int ai = 0; ai < 2; ++ai)
#pragma unroll
            for (int m = 0; m < 4; ++m) { const size_t row = (size_t)(row0 + ai * HALF + m * 16);
                f32x4 v0, v1;
#pragma unroll
                for (int j = 0; j < 4; ++j) { const float g0 = acc[ai][1][m][0][j], g1 = acc[ai][1][m][1][j];
                    v0[j] = g0 * fsig(g0) * acc[ai][0][m][0][j]; v1[j] = g1 * fsig(g1) * acc[ai][0][m][1][j]; }
                u32x4 w; w.x = cvt_pk_bf16(v0[0], v0[1]); w.y = cvt_pk_bf16(v0[2], v0[3]); w.z = cvt_pk_bf16(v1[0], v1[1]); w.w = cvt_pk_bf16(v1[2], v1[3]);
                *(u32x4*)(O + row * 2816 + col0) = w; }
    }
};
struct EpiResid {
    static constexpr bool PERM = false, AFTER_DRAIN = false;
    const float* xres; float* out; float alpha;
    __device__ __forceinline__ void operator()(const f32x4 (&acc)[2][2][4][2], const Unit& u, int wr, int wc, int fr, int fq) const {
        const int row0 = u.pm * BM + wr * 64 + fr, col0 = u.pn * BM + wc * 32 + 4 * fq;
#pragma unroll
        for (int ai = 0; ai < 2; ++ai)
#pragma unroll
            for (int m = 0; m < 4; ++m) { const size_t off = (size_t)(row0 + ai * HALF + m * 16) * 1024 + col0;
#pragma unroll
                for (int bj = 0; bj < 2; ++bj)
#pragma unroll
                    for (int n = 0; n < 2; ++n) { const f32x4 x = *(const f32x4*)(xres + off + bj * HALF + n * 16);
                        *(f32x4*)(out + off + bj * HALF + n * 16) = x * alpha + acc[ai][bj][m][n]; }
                if (m & 1) asm volatile("" ::: "memory"); }
    }
};
}
#include <hip/hip_bf16.h>
#include <cmath>
namespace attn_body {
using bf16=__hip_bfloat16;
using bf16x8=__attribute__((ext_vector_type(8)))short;
using s16x4=__attribute__((ext_vector_type(4)))short;
using f32x16=__attribute__((ext_vector_type(16)))float;
using u32x4=__attribute__((ext_vector_type(4)))unsigned;
constexpr int BATCH=2,NHEAD=8,SEQ=16384,D=64,QP=1024,KP=512;
constexpr int NW=8,QBLK=32,QB=QBLK*NW,KVBLK=64,NQB=SEQ/QB;
constexpr int ATTN_UNIT_ROWS=QB;
__device__ __forceinline__ int crow(int r,int hi){return (r&3)+8*(r>>2)+4*hi;}
#define SBAR() __builtin_amdgcn_sched_barrier(0)
__device__ __forceinline__ void cmask(f32x16&p0,f32x16&p1,int jb,int qrel,int hi){
  const float NEG=-INFINITY; int kb=64*jb+4*hi;
  #pragma unroll
  for(int r=0;r<16;++r){int kv=kb+(r&3)+8*(r>>2); if(kv>qrel)p0[r]=NEG; if(kv+32>qrel)p1[r]=NEG;}
}

constexpr int NSLOT=3, SLOTB=8192;
constexpr int LDS_K=0, LDS_V=NSLOT*SLOTB, LDS_WS=2*NSLOT*SLOTB, LDS_OST=LDS_WS+NW*64*4, LDS_FB=LDS_OST+NW*4096, LDS_BYTES=LDS_FB+SEQ*4;
constexpr float C2=0.125f*1.4426950408889634f;
__device__ __forceinline__ void glds16(const void*gsrc,unsigned lds_dst){unsigned keep;
  asm volatile("s_mov_b32 %0, m0\n\ts_mov_b32 m0, %2\n\ts_nop 0\n\tglobal_load_lds_dwordx4 %1, off\n\ts_mov_b32 m0, %0":"=&s"(keep):"v"(gsrc),"s"(lds_dst):"memory");}
__device__ __forceinline__ float max3f(float a,float b,float c){float r;asm("v_max3_f32 %0, %1, %2, %3":"=v"(r):"v"(a),"v"(b),"v"(c));return r;}
__device__ __forceinline__ float max2f(float a,float b){float r;asm("v_max_f32_e32 %0, %1, %2":"=v"(r):"v"(a),"v"(b));return r;}
__device__ __forceinline__ float fadd_s(float a,float b){float r;asm("v_add_f32_e32 %0, %1, %2":"=v"(r):"v"(a),"v"(b));return r;}
__device__ __forceinline__ float fsub_s(float a,float b){float r;asm("v_sub_f32_e32 %0, %1, %2":"=v"(r):"v"(a),"v"(b));return r;}
typedef float f32x2_t __attribute__((ext_vector_type(2))); typedef __bf16 bf16x2_t __attribute__((ext_vector_type(2)));
__device__ __forceinline__ unsigned cvtpk_s(float lo,float hi){f32x2_t v={lo,hi};bf16x2_t b=__builtin_convertvector(v,bf16x2_t);return __builtin_bit_cast(unsigned,b);}
#define WAIT_BAR(N) asm volatile("s_waitcnt vmcnt(" #N ") lgkmcnt(0)\n\ts_barrier":::"memory")

__device__ __forceinline__ void qkt(f32x16&p0,f32x16&p1,const char*Kslot,const bf16x8*qr,int r32,int hi){
  const char*kb=Kslot+hi*1024+r32*16;
  #pragma unroll
  for(int d0=0;d0<4;++d0){
    const bf16x8 b0=*reinterpret_cast<const bf16x8*>(kb+d0*2048);
    const bf16x8 b1=*reinterpret_cast<const bf16x8*>(kb+d0*2048+512);
    p0=__builtin_amdgcn_mfma_f32_32x32x16_bf16(b0,qr[d0],p0,0,0,0);p1=__builtin_amdgcn_mfma_f32_32x32x16_bf16(b1,qr[d0],p1,0,0,0);}
}
typedef __attribute__((address_space(3))) const char* lds_cptr;
typedef short v4i16_t __attribute__((ext_vector_type(4)));
__device__ __forceinline__ void kload8(bf16x8*kf,lds_cptr kp){
  kf[0]=*(const __attribute__((address_space(3))) bf16x8*)(kp);      kf[1]=*(const __attribute__((address_space(3))) bf16x8*)(kp+512);
  kf[2]=*(const __attribute__((address_space(3))) bf16x8*)(kp+2048); kf[3]=*(const __attribute__((address_space(3))) bf16x8*)(kp+2560);
  kf[4]=*(const __attribute__((address_space(3))) bf16x8*)(kp+4096); kf[5]=*(const __attribute__((address_space(3))) bf16x8*)(kp+4608);
  kf[6]=*(const __attribute__((address_space(3))) bf16x8*)(kp+6144); kf[7]=*(const __attribute__((address_space(3))) bf16x8*)(kp+6656);
}
__device__ __forceinline__ void kload2(bf16x8*kf,lds_cptr kp,int j){ kf[2*j]=*(const __attribute__((address_space(3))) bf16x8*)(kp+j*2048); kf[2*j+1]=*(const __attribute__((address_space(3))) bf16x8*)(kp+j*2048+512); }
__device__ __forceinline__ s16x4 vtr(lds_cptr p){ return __builtin_bit_cast(s16x4,__builtin_amdgcn_ds_read_tr16_b64_v4i16((__attribute__((address_space(3))) v4i16_t*)p)); }
__device__ __forceinline__ float rowmax(const f32x16&p0,const f32x16&p1){
  float a=max3f(p0[0],p0[1],p1[0]),b=max3f(p0[2],p0[3],p1[1]);a=max3f(a,p1[2],p1[3]);
  #pragma unroll
  for(int r=4;r<16;r+=4){a=max3f(a,p0[r],p0[r+1]);b=max3f(b,p0[r+2],p0[r+3]);a=max3f(a,p1[r],p1[r+1]);b=max3f(b,p1[r+2],p1[r+3]);}
  const float m=max2f(a,b);
  auto rr=__builtin_amdgcn_permlane32_swap(__float_as_uint(m),__float_as_uint(m),false,false);
  return max2f(__uint_as_float(rr[0]),__uint_as_float(rr[1]));
}
__device__ __forceinline__ void pv(f32x16*o,int vb,bf16x8 pa0,bf16x8 pa1,bf16x8 pa2,bf16x8 pa3){
  #pragma unroll
  for(int d0=0;d0<2;++d0){s16x4 lo[4],hi[4];
    #pragma unroll
    for(int ks=0;ks<4;++ks){
      asm volatile("ds_read_b64_tr_b16 %0,%1 offset:%c2":"=&v"(lo[ks]):"v"(vb),"i"(d0*4096+ks*1024):"memory");
      asm volatile("ds_read_b64_tr_b16 %0,%1 offset:%c2":"=&v"(hi[ks]):"v"(vb),"i"(d0*4096+ks*1024+512):"memory");}
    asm volatile("s_waitcnt lgkmcnt(0)":::"memory");SBAR();
    #define PK(k) (bf16x8){lo[k][0],lo[k][1],lo[k][2],lo[k][3],hi[k][0],hi[k][1],hi[k][2],hi[k][3]}
    o[d0]=__builtin_amdgcn_mfma_f32_32x32x16_bf16(pa0,PK(0),o[d0],0,0,0);
    o[d0]=__builtin_amdgcn_mfma_f32_32x32x16_bf16(pa1,PK(1),o[d0],0,0,0);
    o[d0]=__builtin_amdgcn_mfma_f32_32x32x16_bf16(pa2,PK(2),o[d0],0,0,0);
    o[d0]=__builtin_amdgcn_mfma_f32_32x32x16_bf16(pa3,PK(3),o[d0],0,0,0);
    #undef PK
  }
}

#ifndef ATTN_STORE16
#define ATTN_STORE16(p,v) (*(u32x4*)(p)=(v))
#endif
template<int THRL> __device__ __forceinline__ void attn_unit(int b,int h,int qb,const bf16*Q,const bf16*__restrict__ K,const bf16*__restrict__ V,bf16*O,const float*__restrict__ Fg,char*shm){
  int tid_=threadIdx.x; asm volatile("":"+v"(tid_));
  const int tid=tid_,lane=tid&63,r32=lane&31,hi=lane>>5; const int wid=__builtin_amdgcn_readfirstlane(tid>>6);
  const long rowbase=(long)b*SEQ; const int q0=qb*QB;
  const bf16*Qw=Q+(rowbase+q0+wid*QBLK)*QP+h*D;
  const bf16*Kh=K+rowbase*KP+h*D,*Vh=V+rowbase*KP+h*D;
  __attribute__((address_space(3))) char* const shm3w=(__attribute__((address_space(3))) char*)shm;
  const unsigned lds0=(unsigned)(uintptr_t)shm;
  float*wsf=(float*)(shm+LDS_WS)+wid*64;
  const bf16*ksrc=Kh+(long)lane*KP+wid*8;
  const bf16*vsrc=Vh+(long)(16*(wid&3)+(lane>>2))*KP+(wid>>2)*32+(lane&3)*8;
  const unsigned kdst=lds0+LDS_K+wid*1024, vdst=lds0+LDS_V+wid*1024;
  #define DMA_K(t,slot) glds16(ksrc+(long)(t)*KVBLK*KP,(unsigned)__builtin_amdgcn_readfirstlane(kdst+(slot)))
  #define DMA_V(t,slot) glds16(vsrc+(long)(t)*KVBLK*KP,(unsigned)__builtin_amdgcn_readfirstlane(vdst+(slot)))
  const int vb0=(int)(lds0+LDS_V)+((lane>>4)&1)*32+(lane&3)*8+(4*hi+((lane&15)>>2))*64;
  const char*Kbase=shm+LDS_K; bf16x8 kf[8];
  const lds_cptr shm3=(lds_cptr)shm; const lds_cptr kp0=shm3+LDS_K+hi*1024+r32*16; const lds_cptr vp0=shm3+LDS_V+((lane>>4)&1)*32+(lane&3)*8+(4*hi+((lane&15)>>2))*64;
  const int NT=(q0+QB)/KVBLK;
  { typedef __attribute__((address_space(3))) float* lds_fptr; const lds_fptr fbl=(lds_fptr)(shm3w+LDS_FB); const float fref=Fg[q0];
    for(int i=tid;i<q0+QB;i+=NW*64) fbl[i]=(fref-Fg[i])*1.4426950408889634f; }
  DMA_K(0,0);DMA_V(0,0);DMA_K(1,SLOTB);
  bf16x8 qr[4];
  #pragma unroll
  for(int d0=0;d0<4;++d0)qr[d0]=*reinterpret_cast<const bf16x8*>(&Qw[(long)r32*QP+d0*16+hi*8]);
  float mhat=0.f,l_reg=0.f;f32x16 o[2];o[0]=f32x16{};o[1]=f32x16{};
  const lds_cptr fb0=(lds_cptr)shm3w+LDS_FB+hi*16;
  typedef float f32x4v __attribute__((ext_vector_type(4)));
  #define BLD(P0,P1,t) do{ const lds_cptr fp_=fb0+(t)*256; _Pragma("unroll") for(int j_=0;j_<4;++j_){ \
      const f32x4v a_=*(const __attribute__((address_space(3))) f32x4v*)(fp_+j_*32), b_=*(const __attribute__((address_space(3))) f32x4v*)(fp_+128+j_*32); \
      P0[4*j_]=a_[0];P0[4*j_+1]=a_[1];P0[4*j_+2]=a_[2];P0[4*j_+3]=a_[3]; P1[4*j_]=b_[0];P1[4*j_+1]=b_[1];P1[4*j_+2]=b_[2];P1[4*j_+3]=b_[3]; } }while(0)
  const int qrel=wid*QBLK+r32;
  #define CMASK(P0,P1,t) do{int jb_=(t)-(NT-4); if(jb_>=0)cmask(P0,P1,jb_,qrel,hi);}while(0)
  bool resc=false;
  #define START(P0,P1) do{ const float rm=rowmax(P0,P1); resc=false; mhat=rm; \
    _Pragma("unroll") for(int r=0;r<16;++r)P0[r]=__builtin_amdgcn_exp2f(P0[r]-mhat); }while(0)
  #define RESC() do{ if(resc){ asm volatile("s_waitcnt lgkmcnt(0)":::"memory"); \
      _Pragma("unroll") for(int d_=0;d_<2;++d_) _Pragma("unroll") for(int r=0;r<16;++r)o[d_][r]*=wsf[crow(r,hi)]; } }while(0)
  f32x16 pA0,pA1,pB0,pB1;
  int sl_prev=0,sl_cur=0,sl_next=SLOTB;
  #define ROT() do{sl_prev=sl_cur;sl_cur=sl_next;sl_next=(sl_next==(NSLOT-1)*SLOTB)?0:sl_next+SLOTB;}while(0)
  DMA_K(2,2*SLOTB);
  WAIT_BAR(3);
  BLD(pA0,pA1,0);
  qkt(pA0,pA1,Kbase,qr,r32,hi);asm volatile("s_nop 15\n\ts_nop 7":"+v"(pA0),"+v"(pA1));CMASK(pA0,pA1,0);
  START(pA0,pA1);
  _Pragma("unroll") for(int r=0;r<16;++r)pA1[r]=__builtin_amdgcn_exp2f(pA1[r]-mhat);
  WAIT_BAR(0);
  DMA_K(3,0);DMA_V(1,SLOTB);
  ROT();
  kload8(kf,kp0+sl_cur);
  BLD(pB0,pB1,1);
  WAIT_BAR(2);
  s16x4 vlo[8],vhi[8]; u32x4 pw0,pw1,pw2,pw3;
  #define PKW(P,B) cvtpk_s(P[B],P[B+1])
  #define PAF(k) __builtin_bit_cast(bf16x8,pw##k)
  #define VFR(i) (bf16x8){vlo[i][0],vlo[i][1],vlo[i][2],vlo[i][3],vhi[i][0],vhi[i][1],vhi[i][2],vhi[i][3]}
  #define PIN(x) asm volatile("":"+v"(x))
  #define MX3(a,b,c) __builtin_fmaxf(__builtin_fmaxf((a),(b)),(c))
  #define GAPA(MF,A0,A1,A2,A3,W0,W1,PW) do{ MF; sacc+=A0; sacc+=A1; sacc+=A2; sacc+=A3; PIN(sacc); W0; W1; PIN(PW); SBAR(); }while(0)
  #define EX(v) __builtin_amdgcn_exp2f(v)
  #define GAPB(MF,X,B) do{ MF; X[B]=EX(X[B]-mhat); X[B+1]=EX(X[B+1]-mhat); X[B+2]=EX(X[B+2]-mhat); X[B+3]=EX(X[B+3]-mhat); PIN(X); SBAR(); }while(0)
  #define VRD(i) do{ vlo[i]=vtr(vp_+(((i)>>2)*4096+((i)&3)*1024)); vhi[i]=vtr(vp_+(((i)>>2)*4096+((i)&3)*1024+512)); }while(0)
  #define KRD(G,j) do{ if(G){ kload2(kf,kp0+sl_next,j); SBAR(); } }while(0)
  #define STEP(C0,C1,P0,P1,t,GK,GV,GL) do{ SBAR(); \
    const lds_cptr vp_=vp0+sl_prev; \
    VRD(0); SBAR(); float sacc=(P0[0]+P0[1]); \
    GAPA(C0=__builtin_amdgcn_mfma_f32_32x32x16_bf16(kf[0],qr[0],C0,0,0,0), P0[2],P0[3],P0[4],P0[5],     pw0[0]=PKW(P0,0), pw0[1]=PKW(P0,2), pw0); \
    VRD(4); SBAR(); GAPA(C1=__builtin_amdgcn_mfma_f32_32x32x16_bf16(kf[1],qr[0],C1,0,0,0), P0[6],P0[7],P0[8],P0[9],     pw0[2]=PKW(P0,4), pw0[3]=PKW(P0,6), pw0); \
    VRD(1); SBAR(); GAPA(C0=__builtin_amdgcn_mfma_f32_32x32x16_bf16(kf[2],qr[1],C0,0,0,0),   P0[10],P0[11],P0[12],P0[13], pw1[0]=PKW(P0,8), pw1[1]=PKW(P0,10), pw1); \
    VRD(5); SBAR(); GAPA(C1=__builtin_amdgcn_mfma_f32_32x32x16_bf16(kf[3],qr[1],C1,0,0,0),   P0[14],P0[15],P1[0],P1[1],   pw1[2]=PKW(P0,12),pw1[3]=PKW(P0,14), pw1); \
    VRD(2); SBAR(); GAPA(C0=__builtin_amdgcn_mfma_f32_32x32x16_bf16(kf[4],qr[2],C0,0,0,0),   P1[2],P1[3],P1[4],P1[5],     pw2[0]=PKW(P1,0), pw2[1]=PKW(P1,2), pw2); \
    VRD(6); SBAR(); GAPA(C1=__builtin_amdgcn_mfma_f32_32x32x16_bf16(kf[5],qr[2],C1,0,0,0),   P1[6],P1[7],P1[8],P1[9],     pw2[2]=PKW(P1,4), pw2[3]=PKW(P1,6), pw2); \
    VRD(3); SBAR(); GAPA(C0=__builtin_amdgcn_mfma_f32_32x32x16_bf16(kf[6],qr[3],C0,0,0,0),   P1[10],P1[11],P1[12],P1[13], pw3[0]=PKW(P1,8), pw3[1]=PKW(P1,10), pw3); \
    VRD(7); SBAR(); GAPA(C1=__builtin_amdgcn_mfma_f32_32x32x16_bf16(kf[7],qr[3],C1,0,0,0),   P1[14],P1[15],0.f,0.f,       pw3[2]=PKW(P1,12),pw3[3]=PKW(P1,14), pw3); \
    l_reg+=sacc; \
    if(GK){DMA_K((t)+3,sl_cur);} if(GV){DMA_V((t)+1,sl_next);} \
    CMASK(C0,C1,t); \
    { float a=MX3(C0[0],C0[1],C1[0]),b=MX3(C0[2],C0[3],C1[1]); a=MX3(a,C1[2],C1[3]); \
      _Pragma("unroll") for(int r=4;r<16;r+=4){a=MX3(a,C0[r],C0[r+1]);b=MX3(b,C0[r+2],C0[r+3]);a=MX3(a,C1[r],C1[r+1]);b=MX3(b,C1[r+2],C1[r+3]);} \
      float rm=__builtin_fmaxf(a,b); { auto rr=__builtin_amdgcn_permlane32_swap(__float_as_uint(rm),__float_as_uint(rm),false,false); rm=__builtin_fmaxf(__uint_as_float(rr[0]),__uint_as_float(rr[1])); } \
      rm-=mhat; resc=false; \
      if(__builtin_expect(__any(rm>(float)THRL),0)){ const float dl=__builtin_fmaxf(rm,0.f); mhat+=dl; \
        const float f=__builtin_amdgcn_exp2f(-dl); l_reg*=f; if(hi==0)wsf[r32]=f; resc=true; } } \
    SBAR(); if(GL){ BLD(P0,P1,(t)+1); } \
    SBAR(); \
    GAPB(o[0]=__builtin_amdgcn_mfma_f32_32x32x16_bf16(PAF(0),VFR(0),o[0],0,0,0), C0,0); \
    GAPB(o[1]=__builtin_amdgcn_mfma_f32_32x32x16_bf16(PAF(0),VFR(4),o[1],0,0,0), C0,4); \
    KRD(GL,0); GAPB(o[0]=__builtin_amdgcn_mfma_f32_32x32x16_bf16(PAF(1),VFR(1),o[0],0,0,0), C0,8); \
    KRD(GL,1); GAPB(o[1]=__builtin_amdgcn_mfma_f32_32x32x16_bf16(PAF(1),VFR(5),o[1],0,0,0), C0,12); \
    KRD(GL,2); GAPB(o[0]=__builtin_amdgcn_mfma_f32_32x32x16_bf16(PAF(2),VFR(2),o[0],0,0,0), C1,0); \
    KRD(GL,3); GAPB(o[1]=__builtin_amdgcn_mfma_f32_32x32x16_bf16(PAF(2),VFR(6),o[1],0,0,0), C1,4); \
    GAPB(o[0]=__builtin_amdgcn_mfma_f32_32x32x16_bf16(PAF(3),VFR(3),o[0],0,0,0), C1,8); \
    GAPB(o[1]=__builtin_amdgcn_mfma_f32_32x32x16_bf16(PAF(3),VFR(7),o[1],0,0,0), C1,12); \
    }while(0)
  int t=1;
  #undef CMASK
  #define CMASK(P0,P1,t) do{}while(0)
  for(;t+5<NT;t+=2){
    STEP(pB0,pB1,pA0,pA1,t,true,true,true);     WAIT_BAR(2); RESC(); ROT();
    STEP(pA0,pA1,pB0,pB1,t+1,true,true,true);   WAIT_BAR(2); RESC(); ROT();
  }
  #undef CMASK
  #define CMASK(P0,P1,t) do{int jb_=(t)-(NT-4); if(jb_>=0)cmask(P0,P1,jb_,qrel,hi);}while(0)
  #define ENDW(tt) do{ if((tt)+3<NT){WAIT_BAR(2);} else if((tt)+2<NT){WAIT_BAR(1);} else {WAIT_BAR(0);} }while(0)
  for(;t+1<NT;t+=2){
    STEP(pB0,pB1,pA0,pA1,t,(t+3<NT),(t+1<NT),(t+1<NT));       ENDW(t);   RESC(); ROT();
    STEP(pA0,pA1,pB0,pB1,t+1,(t+4<NT),(t+2<NT),(t+2<NT));     ENDW(t+1); RESC(); ROT();
  }
  STEP(pB0,pB1,pA0,pA1,NT-1,false,false,false); RESC();
  { float sacc=pB0[0]+pB0[1]; _Pragma("unroll") for(int r=2;r<16;++r)sacc+=pB0[r]; _Pragma("unroll") for(int r=0;r<16;++r)sacc+=pB1[r]; l_reg+=sacc;
    pw0=(u32x4){PKW(pB0,0),PKW(pB0,2),PKW(pB0,4),PKW(pB0,6)};pw1=(u32x4){PKW(pB0,8),PKW(pB0,10),PKW(pB0,12),PKW(pB0,14)};pw2=(u32x4){PKW(pB1,0),PKW(pB1,2),PKW(pB1,4),PKW(pB1,6)};pw3=(u32x4){PKW(pB1,8),PKW(pB1,10),PKW(pB1,12),PKW(pB1,14)};
    SBAR(); pv(o,vb0+sl_cur,PAF(0),PAF(1),PAF(2),PAF(3)); }
  #undef PKW
  #undef PAF
  #undef VFR
  #undef PIN
  #undef MX3
  #undef GAPA
  #undef GAPB
  #undef EX
  #undef VRD
  #undef KRD
  #undef STEP
  #undef ENDW
  {auto rr=__builtin_amdgcn_permlane32_swap(__float_as_uint(l_reg),__float_as_uint(l_reg),false,false);l_reg=__uint_as_float(rr[0])+__uint_as_float(rr[1]);}
  if(hi==0)wsf[32+r32]=l_reg;asm volatile("s_waitcnt lgkmcnt(0)":::"memory");
  float rli[16];
  #pragma unroll
  for(int r=0;r<16;++r)rli[r]=__builtin_amdgcn_rcpf(wsf[32+crow(r,hi)]);
  bf16*Ow=O+(rowbase+q0+wid*QBLK)*QP+h*D;
  { bf16*stg=(bf16*)(shm+LDS_OST)+wid*2048;
    #pragma unroll
    for(int r=0;r<16;++r){const int orow=crow(r,hi);
      #pragma unroll
      for(int d0=0;d0<2;++d0)stg[orow*64+d0*32+r32]=__float2bfloat16(o[d0][r]*rli[r]);}
    asm volatile("s_waitcnt lgkmcnt(0)":::"memory");
    #pragma unroll
    for(int i=0;i<4;++i){const int row=i*8+(lane>>3),ch=lane&7; const u32x4 v=*(const u32x4*)(stg+row*64+ch*8); ATTN_STORE16(Ow+(long)row*QP+ch*8,v);} }
  asm volatile("s_waitcnt lgkmcnt(0)\n\ts_barrier":::"memory");
  #undef DMA_K
  #undef DMA_V
  #undef CMASK
  #undef START
  #undef RESC
  #undef BLD
  #undef ROT
}
constexpr int ATTN_LDS_BYTES=LDS_BYTES;
struct AttnTensors { const bf16* Q; const bf16* K; const bf16* V; bf16* O; const float* F; };
struct AttnUnit { int bh; int qb; };
struct StaticOrder {
  int vcu,G;
  __device__ __forceinline__ explicit StaticOrder(int grid,int block):vcu((grid%8==0)?(block%8)*(grid/8)+block/8:block),G(grid){}
  __device__ __forceinline__ bool next(int i,AttnUnit&u)const{ const int L=i*G+vcu; if(L>=1024)return false; const int rd=L>>8,v=L&255,s=v&15; u.bh=v>>4; u.qb=(rd==0)?s:(rd==1)?31-s:(rd==2)?32+s:63-s; return true; }
  __device__ __forceinline__ void a_ready(const AttnUnit&)const{}
  __device__ __forceinline__ void done(const AttnUnit&)const{}
};
template<class Sched,int THRL=8> __device__ __forceinline__ void attn_phase(char*lds,const AttnTensors&T,const Sched&S){
  AttnUnit u;
  for(int i=0;S.next(i,u);++i){ S.a_ready(u); attn_unit<THRL>(u.bh/NHEAD,u.bh%NHEAD,u.qb,T.Q,T.K,T.V,T.O,T.F+(long)u.bh*SEQ,lds); S.done(u); }
}
#undef SBAR
#undef WAIT_BAR
}
#include <hip/hip_cooperative_groups.h>
namespace cg = cooperative_groups;
#define LAS __attribute__((address_space(3)))
typedef unsigned short bf16;
typedef unsigned v4u __attribute__((ext_vector_type(4)));
typedef float f32x4 __attribute__((ext_vector_type(4)));
typedef short bf16x8 __attribute__((ext_vector_type(8)));
typedef LAS unsigned char* lp;

constexpr int NWAVES = 8, NTHR = 512;
constexpr int BATCH = 2, SEQ = 16384, D = 1024, M = BATCH * SEQ, DEPTH = 2;
constexpr int NIN = 5640, NP1 = 3584, NG = 2048, FFH = 2816, NF1 = 5632;
constexpr float ALPHA = 1.4142135623730951f;
constexpr float LN_EPS = 1e-5f, RMS_EPS = 1e-6f;
constexpr size_t MiB = 1u << 20;
constexpr size_t WL_IN = 0, WL_G = 7 * MiB, WL_M = 11 * MiB, WL_O = 15 * MiB, WL_F1 = 17 * MiB, WL_F2 = 28 * MiB, WL_STRIDE = 34 * MiB;
constexpr size_t WS_W = 0, WS_XN = 68 * MiB, WS_QAB = 132 * MiB, WS_KA = 196 * MiB, WS_VA = 228 * MiB, WS_G = 260 * MiB, WS_IB = 324 * MiB, WS_GB = 356 * MiB,
                 WS_ST = 388 * MiB, WS_DEC = 452 * MiB, WS_LF = 453 * MiB, WS_F = 454 * MiB, WS_END = 455 * MiB;
constexpr size_t WS_GATES = WS_G  , WS_MERGED = WS_KA  , WS_H = WS_QAB  ;
constexpr int LDS_TOTAL = 155648;
static_assert(attn_body::LDS_BYTES <= LDS_TOTAL && pg8::STAGE_BYTES <= LDS_TOTAL, "LDS map");

__device__ __forceinline__ float wave_sum(float v) {
#pragma unroll
    for (int o = 1; o < 64; o <<= 1) v += __shfl_xor(v, o);
    return v;
}
__device__ __forceinline__ unsigned pk2(float lo, float hi) { return pg8::cvt_pk_bf16(lo, hi); }
__device__ __forceinline__ float bf2f(unsigned short h) { return __uint_as_float((unsigned)h << 16); }

__device__ __forceinline__ void transpose_item(const float* Wsrc, int pitch, bf16* WTdst, int Kdst, LAS float* scr, int lane, bool zero) {
    if (!zero) {
#pragma unroll 8
        for (int i = 0; i < 32; ++i) { const int kk = 2 * i + (lane >> 5); scr[kk * 33 + (lane & 31)] = Wsrc[(size_t)kk * pitch + (lane & 31)]; }
    }
    asm volatile("s_waitcnt lgkmcnt(0)" ::: "memory");
    const int c = lane & 7;
#pragma unroll
    for (int j = 0; j < 4; ++j) { const int n = (lane >> 3) + 8 * j; const LAS float* s = scr + (8 * c) * 33 + n;
        v4u o;
        if (zero) { o = (v4u){0u, 0u, 0u, 0u}; }
        else { o.x = pk2(s[0 * 33], s[1 * 33]); o.y = pk2(s[2 * 33], s[3 * 33]); o.z = pk2(s[4 * 33], s[5 * 33]); o.w = pk2(s[6 * 33], s[7 * 33]); }
        *(v4u*)(WTdst + (size_t)n * Kdst + 8 * c) = o; }
    asm volatile("s_waitcnt lgkmcnt(0)" ::: "memory");
}

struct Ptrs {
    const float *x, *w_in, *b_fgate, *lb_logits, *norm_g, *w_pa, *w_pb, *w_o, *ln1_g, *ln1_b, *w_ff_in, *w_ff_out, *ln2_g, *ln2_b;
    float* out; unsigned char* ws;
};

__device__ __forceinline__ void weight_items(const Ptrs& P, LAS float* scr, int gw, int NGW, int lane) {
    constexpr int I_IN = 16 * (NP1 / 32), I_G = 16 * (NG / 32), I_M = 16 * (2048 / 32), I_O = 16 * 32, I_F1 = 16 * (NF1 / 32), I_F2 = (FFH / 64) * 32;
    constexpr int PER_LAYER = I_IN + I_G + I_M + I_O + I_F1 + I_F2;
    for (int it = gw; it < DEPTH * PER_LAYER; it += NGW) {
        const int l = it / PER_LAYER; int r = it % PER_LAYER;
        bf16* WB = (bf16*)(P.ws + WS_W + (size_t)l * WL_STRIDE);
        if (r < I_IN) { const int nblk = NP1 / 32, kb = r / nblk, nb = r % nblk, k0 = 64 * kb, n0 = 32 * nb; const int sc = n0 < 1536 ? n0 : n0 + 8;
            transpose_item(P.w_in + (size_t)l * D * NIN + (size_t)k0 * NIN + sc, NIN, (bf16*)((unsigned char*)WB + WL_IN) + (size_t)n0 * 1024 + k0, 1024, scr, lane, false); continue; } r -= I_IN;
        if (r < I_G) { const int nblk = NG / 32, kb = r / nblk, nb = r % nblk, k0 = 64 * kb, n0 = 32 * nb;
            transpose_item(P.w_in + (size_t)l * D * NIN + (size_t)k0 * NIN + 3592 + n0, NIN, (bf16*)((unsigned char*)WB + WL_G) + (size_t)n0 * 1024 + k0, 1024, scr, lane, false); continue; } r -= I_G;
        if (r < I_M) { const int nblk = 64, kb = r / nblk, nb = r % nblk, k0 = 64 * kb, n0 = 32 * nb; const int tile = n0 >> 8, half = (n0 >> 7) & 1, col = 128 * tile + (n0 & 127);
            const bool lowk = kb < 8; const bool zero = lowk ? (half != 0) : (half != 1);
            const float* src = lowk ? P.w_pa + (size_t)l * 512 * 1024 + (size_t)k0 * 1024 + col : P.w_pb + (size_t)l * 512 * 1024 + (size_t)(k0 - 512) * 1024 + col;
            transpose_item(src, 1024, (bf16*)((unsigned char*)WB + WL_M) + (size_t)n0 * 1024 + k0, 1024, scr, lane, zero); continue; } r -= I_M;
        if (r < I_O) { const int nblk = 32, kb = r / nblk, nb = r % nblk, k0 = 64 * kb, n0 = 32 * nb;
            transpose_item(P.w_o + (size_t)l * 1024 * 1024 + (size_t)k0 * 1024 + n0, 1024, (bf16*)((unsigned char*)WB + WL_O) + (size_t)n0 * 1024 + k0, 1024, scr, lane, false); continue; } r -= I_O;
        if (r < I_F1) { const int nblk = NF1 / 32, kb = r / nblk, nb = r % nblk, k0 = 64 * kb, n0 = 32 * nb; const int tile = n0 >> 8, half = (n0 >> 7) & 1, col = half * FFH + 128 * tile + (n0 & 127);
            transpose_item(P.w_ff_in + (size_t)l * D * NF1 + (size_t)k0 * NF1 + col, NF1, (bf16*)((unsigned char*)WB + WL_F1) + (size_t)n0 * 1024 + k0, 1024, scr, lane, false); continue; } r -= I_F1;
        { const int nblk = 32, kb = r / nblk, nb = r % nblk, k0 = 64 * kb, n0 = 32 * nb;
            transpose_item(P.w_ff_out + (size_t)l * FFH * 1024 + (size_t)k0 * 1024 + n0, 1024, (bf16*)((unsigned char*)WB + WL_F2) + (size_t)n0 * FFH + k0, FFH, scr, lane, false); }
    }
}

__device__ __forceinline__ void stage_wfa(const float* w_in_l, LAS float* wfa, int tid) {
    for (int idx = tid; idx < 8192; idx += NTHR) { const int k = idx >> 3, col = idx & 7; const int j = k >> 8, ln = (k >> 2) & 63, i = k & 3, half = col >> 2, c = col & 3;
        wfa[((((j * 4 + i) * 2 + half) * 64) + ln) * 4 + c] = w_in_l[(size_t)k * NIN + 1536 + col]; }
}
template <bool DO_LN, bool W32, bool WBF, bool DO_FA>
__device__ __forceinline__ void row_pass(const float* src, float* dst32, bf16* dstbf, const float* gam, const float* bet, float* lf, const LAS float* wfa, const float* bfg, int gw, int NGW, int lane) {
    for (int m = gw; m < M; m += NGW) {
        const f32x4* xr = (const f32x4*)(src + (size_t)m * D) + lane;
        f32x4 v[4];
#pragma unroll
        for (int j = 0; j < 4; ++j) v[j] = xr[64 * j];
        if (DO_LN) {
            float s = 0.f;
#pragma unroll
            for (int j = 0; j < 4; ++j) s += (v[j].x + v[j].y) + (v[j].z + v[j].w);
            const float mean = wave_sum(s) * (1.f / D); float s2 = 0.f;
#pragma unroll
            for (int j = 0; j < 4; ++j) { v[j] = v[j] - mean; s2 += (v[j].x * v[j].x + v[j].y * v[j].y) + (v[j].z * v[j].z + v[j].w * v[j].w); }
            const float rstd = 1.f / sqrtf(wave_sum(s2) * (1.f / D) + LN_EPS);
#pragma unroll
            for (int j = 0; j < 4; ++j) { const f32x4 gv = ((const f32x4*)gam)[64 * j + lane], bv = ((const f32x4*)bet)[64 * j + lane]; v[j] = v[j] * rstd * gv + bv; }
        }
        if (W32) { f32x4* o = (f32x4*)(dst32 + (size_t)m * D) + lane;
#pragma unroll
            for (int j = 0; j < 4; ++j) {
#ifdef DBG_SANITIZE
                if (!WBF) { for (int i = 0; i < 4; ++i) if (!(fabsf(v[j][i]) < 1e30f)) v[j][i] = 0.f; }
#endif
                o[64 * j] = v[j]; } }
        if (WBF) { unsigned long long* o8 = (unsigned long long*)(dstbf + (size_t)m * D) + lane;
#pragma unroll
            for (int j = 0; j < 4; ++j) o8[64 * j] = (unsigned long long)pk2(v[j].x, v[j].y) | ((unsigned long long)pk2(v[j].z, v[j].w) << 32); }
        if (DO_FA) {
            float a[8];
#pragma unroll
            for (int c = 0; c < 8; ++c) a[c] = 0.f;
#pragma unroll
            for (int j = 0; j < 4; ++j)
#pragma unroll
                for (int i = 0; i < 4; ++i) { const float xv = v[j][i];
                    const f32x4 w0 = *(const LAS f32x4*)(wfa + ((((j * 4 + i) * 2 + 0) * 64) + lane) * 4), w1 = *(const LAS f32x4*)(wfa + ((((j * 4 + i) * 2 + 1) * 64) + lane) * 4);
                    a[0] += xv * w0.x; a[1] += xv * w0.y; a[2] += xv * w0.z; a[3] += xv * w0.w; a[4] += xv * w1.x; a[5] += xv * w1.y; a[6] += xv * w1.z; a[7] += xv * w1.w; }
#pragma unroll
            for (int c = 0; c < 8; ++c) a[c] = wave_sum(a[c]);
            float z = a[0];
#pragma unroll
            for (int c = 1; c < 8; ++c) z = (lane == c) ? a[c] : z;
            if (lane < 8) { z += bfg[lane]; const float ls = fminf(z, 0.f) - __logf(1.0f + __expf(-fabsf(z))); lf[(size_t)m * 8 + lane] = ls; }
        }
    }
}

__device__ __forceinline__ void fcumsum_unit(int bh, const float* LF, float* F, lp lds, int tid) {
    const int b = bh >> 3, h = bh & 7, lane = tid & 63, wave = tid >> 6;
    const float* src = LF + ((size_t)b * SEQ + (size_t)tid * 32) * 8 + h;
    float cs[32]; float run = 0.f;
#pragma unroll
    for (int i = 0; i < 32; ++i) { run += src[i * 8]; cs[i] = run; }
    float inc = run;
#pragma unroll
    for (int o = 1; o < 64; o <<= 1) { const float n = __shfl_up(inc, o); if (lane >= o) inc += n; }
    LAS float* WS = (LAS float*)lds;
    if (lane == 63) WS[wave] = inc;
    __syncthreads();
    float woff = 0.f;
    for (int w = 0; w < wave; ++w) woff += WS[w];
    const float excl = woff + inc - run;
    float* dst = F + (size_t)bh * SEQ + (size_t)tid * 32;
#pragma unroll
    for (int i = 0; i < 32; i += 4) *(f32x4*)(dst + i) = (f32x4){excl + cs[i], excl + cs[i + 1], excl + cs[i + 2], excl + cs[i + 3]};
    __syncthreads();
}

namespace hg {
constexpr int P128 = 136, P64 = 72;
constexpr int O_QP = 0, O_QPP = O_QP + 64 * P128 * 2, O_KP = O_QPP + 64 * P128 * 2, O_VT = O_KP + 64 * P128 * 2, O_ST = O_VT + 128 * P64 * 2, O_PM = O_ST + 128 * P128 * 2,
              O_PT = O_PM + 64 * P64 * 2, O_RS = O_PT + 2048, O_END = O_RS + 512;
constexpr int O_KDT = O_QP;
static_assert(O_END <= 131072 && 128 * P64 * 2 <= 2 * 64 * P128 * 2, "hgrn LDS map");

__device__ __forceinline__ void load_cumsum(const float* Gu, int d, int part, lp lds, float (&g)[16], float (&b)[16], float& bmid, float& blast) {
#pragma unroll
    for (int i = 0; i < 16; ++i) g[i] = Gu[(size_t)(part * 16 + i) * 512 + d];
    float run = 0.f;
#pragma unroll
    for (int i = 0; i < 16; ++i) { run += g[i]; b[i] = run; }
    LAS float* PT = (LAS float*)(lds + O_PT);
    PT[part * 128 + d] = run;
    __syncthreads();
    const float p0 = PT[d], p1 = PT[128 + d], p2 = PT[256 + d], p3 = PT[384 + d];
    const float off = (part > 0 ? p0 : 0.f) + (part > 1 ? p1 : 0.f) + (part > 2 ? p2 : 0.f);
#pragma unroll
    for (int i = 0; i < 16; ++i) b[i] += off;
    bmid = p0 + p1; blast = (p0 + p1) + (p2 + p3);
}
__device__ __forceinline__ void stage_vt(const bf16* vp  , lp lds, int e, int part) {
    unsigned w[8];
#pragma unroll
    for (int i = 0; i < 8; ++i) { const unsigned lo = vp[(size_t)(2 * i) * 512], hi = vp[(size_t)(2 * i + 1) * 512]; w[i] = lo | (hi << 16); }
    LAS v4u* dst = (LAS v4u*)(lds + O_VT + (e * P64 + part * 16) * 2);
    dst[0] = (v4u){w[0], w[1], w[2], w[3]}; dst[1] = (v4u){w[4], w[5], w[6], w[7]};
}
__device__ __forceinline__ void pass1_unit(int unit, const float* G, const bf16* IB, bf16* ST, float* DEC, lp lds, int tid, unsigned* dbgw = nullptr) {
    const int c = unit & 255, h = (unit >> 8) & 3, b = unit >> 10;
    const int d = tid & 127, part = tid >> 7, lane = tid & 63, wave = tid >> 6, fr = lane & 15, fq = lane >> 4;
    const size_t row0 = (size_t)b * SEQ + (size_t)c * 64;
    float g[16], bb[16], bmid, blast;
    load_cumsum(G + row0 * 512 + h * 128, d, part, lds, g, bb, bmid, blast);
#ifdef DBG_P1
    { bool b1 = false, b3 = false; for (int i = 0; i < 16; ++i) { if (g[i] > 0.f) b1 = true; const float kk = (1.0f - __expf(g[i])) * __expf(blast - bb[i]); if (!(fabsf(kk) < 1e30f)) b3 = true; }
      if (b1) atomicMin(dbgw, 51u); if (b3) atomicMin(dbgw, 53u); }
#endif
    { unsigned w[8];
#pragma unroll
      for (int i = 0; i < 8; ++i) { const float k0 = (1.0f - __expf(g[2 * i])) * __expf(blast - bb[2 * i]), k1 = (1.0f - __expf(g[2 * i + 1])) * __expf(blast - bb[2 * i + 1]); w[i] = pk2(k0, k1); }
      LAS v4u* dst = (LAS v4u*)(lds + O_KDT + (d * P64 + part * 16) * 2);
      dst[0] = (v4u){w[0], w[1], w[2], w[3]}; dst[1] = (v4u){w[4], w[5], w[6], w[7]}; }
    stage_vt(IB + (row0 + part * 16) * 512 + h * 128 + d, lds, d, part);
    if (part == 0) DEC[(size_t)unit * 128 + d] = __expf(blast);
    __syncthreads();
    const bf16x8 a0 = *(const LAS bf16x8*)(lds + O_VT + ((16 * wave + fr) * P64 + 8 * fq) * 2), a1 = *(const LAS bf16x8*)(lds + O_VT + ((16 * wave + fr) * P64 + 32 + 8 * fq) * 2);
    bf16* out = ST + (size_t)unit * 16384;
#pragma unroll
    for (int dt = 0; dt < 8; ++dt) {
        const bf16x8 b0 = *(const LAS bf16x8*)(lds + O_KDT + ((16 * dt + fr) * P64 + 8 * fq) * 2), b1 = *(const LAS bf16x8*)(lds + O_KDT + ((16 * dt + fr) * P64 + 32 + 8 * fq) * 2);
        f32x4 acc = (f32x4){0.f, 0.f, 0.f, 0.f};
        acc = __builtin_amdgcn_mfma_f32_16x16x32_bf16(a0, b0, acc, 0, 0, 0);
        acc = __builtin_amdgcn_mfma_f32_16x16x32_bf16(a1, b1, acc, 0, 0, 0);
#ifdef DBG_P1
        for (int r = 0; r < 4; ++r) if (!(fabsf(acc[r]) < 1e30f)) atomicMin(dbgw, 54u);
#endif
#pragma unroll
        for (int r = 0; r < 4; ++r) out[(16 * wave + 4 * fq + r) * 128 + 16 * dt + fr] = (bf16)(pk2(acc[r], 0.f) & 0xffffu);
    }
    __syncthreads();
}
__device__ __forceinline__ void pass2_scan(bf16* ST, const float* DEC, int gtid, int gthreads) {
    for (int id = gtid; id < 8 * 16384; id += gthreads) {
        const int bh = id >> 14, ed = id & 16383, d = ed & 127;
        bf16* p = ST + (size_t)bh * 256 * 16384 + ed; const float* dp = DEC + (size_t)bh * 256 * 128 + d;
        float state = 0.f;
        for (int c = 0; c < 256; c += 16) {
            unsigned short u[16]; float dc[16];
#pragma unroll
            for (int i = 0; i < 16; ++i) { u[i] = p[(size_t)(c + i) * 16384]; dc[i] = dp[(size_t)(c + i) * 128]; }
#pragma unroll
            for (int i = 0; i < 16; ++i) { p[(size_t)(c + i) * 16384] = (bf16)(pk2(state, 0.f) & 0xffffu); state = dc[i] * state + bf2f(u[i]); }
        }
    }
}
__device__ __forceinline__ void pass3_unit(int unit, const float* G, const bf16* IB, const bf16* GB, const bf16* ST, bf16* QAB, const float* normg, lp lds, int tid) {
    const int c = unit & 255, h = (unit >> 8) & 3, b = unit >> 10;
    const int d = tid & 127, part = tid >> 7, lane = tid & 63, wave = tid >> 6, fr = lane & 15, fq = lane >> 4;
    const size_t row0 = (size_t)b * SEQ + (size_t)c * 64;
    { const bf16* sp = ST + (size_t)unit * 16384;
#pragma unroll
      for (int ps = 0; ps < 4; ++ps) { const int idx = ps * NTHR + tid, e = idx >> 4, d8 = (idx & 15) * 8; const v4u w = *(const v4u*)(sp + e * 128 + d8); *(LAS v4u*)(lds + O_ST + (e * P128 + d8) * 2) = w; } }
    float g[16], bb[16], bmid, blast;
    load_cumsum(G + row0 * 512 + h * 128, d, part, lds, g, bb, bmid, blast);
    { const bf16* qp = QAB + (row0 + part * 16) * 1024 + 512 + h * 128 + d; const float emid = __expf(bmid);
      LAS bf16* Qp = (LAS bf16*)(lds + O_QP), *Qpp = (LAS bf16*)(lds + O_QPP), *Kp = (LAS bf16*)(lds + O_KP);
#pragma unroll
      for (int i = 0; i < 16; ++i) { const float q = bf2f(qp[(size_t)i * 1024]); const float q1 = q * __expf(bb[i] - bmid), q2 = q1 * emid, k1 = (1.0f - __expf(g[i])) * __expf(bmid - bb[i]);
          const int t = part * 16 + i; const unsigned w = pk2(q1, q2), w2 = pk2(k1, 0.f);
          Qp[t * P128 + d] = (bf16)(w & 0xffffu); Qpp[t * P128 + d] = (bf16)(w >> 16); Kp[t * P128 + d] = (bf16)(w2 & 0xffffu); } }
    stage_vt(IB + (row0 + part * 16) * 512 + h * 128 + d, lds, d, part);
    __syncthreads();
    { const int ti = wave >> 1; LAS bf16* Pm = (LAS bf16*)(lds + O_PM);
#pragma unroll
      for (int sj2 = 0; sj2 < 2; ++sj2) { const int sj = 2 * (wave & 1) + sj2; f32x4 acc = (f32x4){0.f, 0.f, 0.f, 0.f};
#pragma unroll
          for (int ks = 0; ks < 4; ++ks) { const bf16x8 a = *(const LAS bf16x8*)(lds + O_QP + ((16 * ti + fr) * P128 + 32 * ks + 8 * fq) * 2), bq = *(const LAS bf16x8*)(lds + O_KP + ((16 * sj + fr) * P128 + 32 * ks + 8 * fq) * 2);
              acc = __builtin_amdgcn_mfma_f32_16x16x32_bf16(a, bq, acc, 0, 0, 0); }
#pragma unroll
          for (int r = 0; r < 4; ++r) { const int t = 16 * ti + 4 * fq + r, s = 16 * sj + fr; const float v = (s <= t) ? acc[r] : 0.f; Pm[t * P64 + s] = (bf16)(pk2(v, 0.f) & 0xffffu); } } }
    __syncthreads();
    const int rb = wave & 3, ch = wave >> 2;
    f32x4 o[4];
#pragma unroll
    for (int j = 0; j < 4; ++j) o[j] = (f32x4){0.f, 0.f, 0.f, 0.f};
    { bf16x8 ap[2], aq[4];
#pragma unroll
      for (int ks = 0; ks < 2; ++ks) ap[ks] = *(const LAS bf16x8*)(lds + O_PM + ((16 * rb + fr) * P64 + 32 * ks + 8 * fq) * 2);
#pragma unroll
      for (int ks = 0; ks < 4; ++ks) aq[ks] = *(const LAS bf16x8*)(lds + O_QPP + ((16 * rb + fr) * P128 + 32 * ks + 8 * fq) * 2);
#pragma unroll
      for (int j = 0; j < 4; ++j) { const int e0 = 64 * ch + 16 * j;
#pragma unroll
          for (int ks = 0; ks < 2; ++ks) { const bf16x8 bv = *(const LAS bf16x8*)(lds + O_VT + ((e0 + fr) * P64 + 32 * ks + 8 * fq) * 2); o[j] = __builtin_amdgcn_mfma_f32_16x16x32_bf16(ap[ks], bv, o[j], 0, 0, 0); }
#pragma unroll
          for (int ks = 0; ks < 4; ++ks) { const bf16x8 bs = *(const LAS bf16x8*)(lds + O_ST + ((e0 + fr) * P128 + 32 * ks + 8 * fq) * 2); o[j] = __builtin_amdgcn_mfma_f32_16x16x32_bf16(aq[ks], bs, o[j], 0, 0, 0); } } }
    LAS float* RS = (LAS float*)(lds + O_RS);
#pragma unroll
    for (int r = 0; r < 4; ++r) { float s = 0.f;
#pragma unroll
        for (int j = 0; j < 4; ++j) s += o[j][r] * o[j][r];
        s += __shfl_xor(s, 1); s += __shfl_xor(s, 2); s += __shfl_xor(s, 4); s += __shfl_xor(s, 8);
        if (fr == 0) RS[ch * 64 + 16 * rb + 4 * fq + r] = s; }
    __syncthreads();
#pragma unroll
    for (int r = 0; r < 4; ++r) { const int t = 16 * rb + 4 * fq + r; const float rstd = 1.0f / sqrtf((RS[t] + RS[64 + t]) * (1.0f / 128.0f) + RMS_EPS);
        const bf16* gbp = GB + (row0 + t) * 512 + h * 128 + 64 * ch + fr; bf16* yp = QAB + (row0 + t) * 1024 + 512 + h * 128 + 64 * ch + fr;
#pragma unroll
        for (int j = 0; j < 4; ++j) { const float y = o[j][r] * rstd * normg[64 * ch + 16 * j + fr] * bf2f(gbp[16 * j]); yp[16 * j] = (bf16)(pk2(y, 0.f) & 0xffffu); } }
    __syncthreads();
}
}

#ifdef DBG_NAN
__device__ __forceinline__ void dbg_scan(const void* p, size_t nbytes, bool is_bf, int stage, unsigned* word) {
    const size_t n16 = nbytes / 16; const v4u* q = (const v4u*)p; bool bad = false;
    int t_ = threadIdx.x; asm volatile("" : "+v"(t_));
    int b_ = blockIdx.x; asm volatile("" : "+s"(b_)); int g_ = gridDim.x; asm volatile("" : "+s"(g_));
    for (unsigned i = (unsigned)(b_ * NTHR + t_); i < (unsigned)n16; i += (unsigned)(g_ * NTHR)) { const v4u w = q[i];
        for (int k = 0; k < 4; ++k) { const unsigned x = w[k];
            if (is_bf) { if ((x & 0x7f80u) == 0x7f80u || (x & 0x7f800000u) == 0x7f800000u) bad = true; }
            else { if ((x & 0x7f800000u) == 0x7f800000u) bad = true; } } }
    if (bad) atomicMin(word, (unsigned)stage);
}
#define DBG(stage, ptr, bytes, isbf) do { if (l == DBG_LAYER) dbg_scan((ptr), (bytes), (isbf), (stage), (unsigned*)(args.ws + WS_END)); } while (0)
#else
#define DBG(stage, ptr, bytes, isbf) do {} while (0)
#endif
#define GSYNC() do { asm volatile("s_waitcnt vmcnt(0) lgkmcnt(0)" ::: "memory"); grid.sync(); __builtin_amdgcn_fence(__ATOMIC_ACQUIRE, "agent"); asm volatile("s_waitcnt vmcnt(0)" ::: "memory"); __syncthreads(); } while (0)
struct Args { const float* in[14]; float* out; unsigned char* ws; };
#define FRESH_PTR(T, var, expr) T var = (T)(expr); asm volatile("" : "+s"(var))
#define IDS() int tid_ = threadIdx.x; asm volatile("" : "+v"(tid_)); const int tid = tid_, lane = tid & 63, wave = __builtin_amdgcn_readfirstlane(tid >> 6); const int G = gridDim.x, bx = blockIdx.x, vcu = (G % 8 == 0) ? (bx % 8) * (G / 8) + bx / 8 : bx; \
              const int gw = vcu * NWAVES + wave, NGW = G * NWAVES; (void)tid; (void)lane; (void)wave; (void)gw; (void)NGW; (void)vcu; (void)bx
__global__ void __launch_bounds__(NTHR, 2) mega_fwd(Args args) {
    extern __shared__ __attribute__((aligned(16))) unsigned char lds_raw[];
    cg::grid_group grid = cg::this_grid();
    const lp lds = (lp)lds_raw;

#ifdef DBG_NAN
    if (blockIdx.x == 0 && threadIdx.x == 0) *(unsigned*)(args.ws + WS_END) = 990u;
    GSYNC();
#endif
    { IDS();
      Ptrs P;
      P.x = args.in[0]; P.w_in = args.in[1]; P.b_fgate = args.in[2]; P.lb_logits = args.in[3]; P.norm_g = args.in[4]; P.w_pa = args.in[5]; P.w_pb = args.in[6]; P.w_o = args.in[7];
      P.ln1_g = args.in[8]; P.ln1_b = args.in[9]; P.w_ff_in = args.in[10]; P.w_ff_out = args.in[11]; P.ln2_g = args.in[12]; P.ln2_b = args.in[13]; P.out = args.out; P.ws = args.ws;
      weight_items(P, (LAS float*)(lds + wave * 16384), gw, NGW, lane);
      __syncthreads();
      stage_wfa(P.w_in, (LAS float*)lds, tid);
      __syncthreads();
      row_pass<false, false, true, true>(P.x, nullptr, (bf16*)(P.ws + WS_XN), nullptr, nullptr, (float*)(P.ws + WS_LF), (const LAS float*)lds, P.b_fgate, gw, NGW, lane); }
    GSYNC();
    { const int l = 0; DBG(10, args.ws + WS_XN, (size_t)64 * MiB, true); DBG(10, args.ws + WS_LF, (size_t)1 * MiB, false); }

#pragma unroll 1
    for (int l = 0; l < DEPTH; ++l) {
        { IDS(); FRESH_PTR(unsigned char*, ws, args.ws); FRESH_PTR(const float*, lbl, args.in[3]);
          pg8::Gemm g{(const bf16*)(ws + WS_XN), (const bf16*)(ws + WS_W + (size_t)l * WL_STRIDE + WL_IN), M, NP1, D}; pg8::StaticOrder S; S.init(M, NP1, G, bx);
          pg8::EpiInProj E{(bf16*)(ws + WS_QAB), (bf16*)(ws + WS_KA), (bf16*)(ws + WS_VA), (float*)(ws + WS_G), (bf16*)(ws + WS_IB), (bf16*)(ws + WS_GB), lbl, l, attn_body::C2};
          pg8::gemm_phase<pg8::EpiInProj, pg8::StaticOrder, true, true>(lds, g, S, E); }
        GSYNC();
        DBG(20, args.ws + WS_QAB, (size_t)64 * MiB, true); DBG(30, args.ws + WS_KA, (size_t)64 * MiB, true); DBG(40, args.ws + WS_G, (size_t)64 * MiB, false); DBG(50, args.ws + WS_IB, (size_t)64 * MiB, true);
        { IDS(); FRESH_PTR(unsigned char*, ws, args.ws);
          for (int u = vcu; u < 2048; u += G) hg::pass1_unit(u, (const float*)(ws + WS_G), (const bf16*)(ws + WS_IB), (bf16*)(ws + WS_ST), (float*)(ws + WS_DEC), lds, tid, (unsigned*)(ws + WS_END));
          for (int u = vcu; u < 16; u += G) fcumsum_unit(u, (const float*)(ws + WS_LF), (float*)(ws + WS_F), lds, tid); }
        GSYNC();
        DBG(60, args.ws + WS_ST, (size_t)64 * MiB, true); DBG(61, args.ws + WS_DEC, (size_t)1 * MiB, false); DBG(70, args.ws + WS_F, (size_t)1 * MiB, false);
        { IDS(); FRESH_PTR(unsigned char*, ws, args.ws);
          hg::pass2_scan((bf16*)(ws + WS_ST), (const float*)(ws + WS_DEC), vcu * NTHR + tid, G * NTHR); }
        GSYNC();
        DBG(80, args.ws + WS_ST, (size_t)64 * MiB, true);
        { const int G = gridDim.x, bx = blockIdx.x; FRESH_PTR(unsigned char*, ws, args.ws);
          const attn_body::AttnTensors AT{(const attn_body::bf16*)(ws + WS_QAB), (const attn_body::bf16*)(ws + WS_KA), (const attn_body::bf16*)(ws + WS_VA), (attn_body::bf16*)(ws + WS_QAB), (const float*)(ws + WS_F)};
          const attn_body::StaticOrder S(G, bx);
          attn_body::attn_phase<attn_body::StaticOrder>((char*)lds_raw, AT, S); }
        __syncthreads();
        { IDS(); FRESH_PTR(unsigned char*, ws, args.ws); FRESH_PTR(const float*, ng, args.in[4]);
          for (int u = vcu; u < 2048; u += G) hg::pass3_unit(u, (const float*)(ws + WS_G), (const bf16*)(ws + WS_IB), (const bf16*)(ws + WS_GB), (const bf16*)(ws + WS_ST), (bf16*)(ws + WS_QAB), ng + l * 128, lds, tid); }
        GSYNC();
        DBG(90, args.ws + WS_QAB, (size_t)64 * MiB, true);
        { IDS(); FRESH_PTR(unsigned char*, ws, args.ws);
          pg8::Gemm g{(const bf16*)(ws + WS_XN), (const bf16*)(ws + WS_W + (size_t)l * WL_STRIDE + WL_G), M, NG, D}; pg8::StaticOrder S; S.init(M, NG, G, bx);
          pg8::EpiGates E{(bf16*)(ws + WS_GATES)};
          pg8::gemm_phase<pg8::EpiGates, pg8::StaticOrder, true, true>(lds, g, S, E); }
        GSYNC();
        DBG(100, args.ws + WS_GATES, (size_t)128 * MiB, true);
        { IDS(); FRESH_PTR(unsigned char*, ws, args.ws);
          pg8::Gemm g{(const bf16*)(ws + WS_QAB), (const bf16*)(ws + WS_W + (size_t)l * WL_STRIDE + WL_M), M, 2048, D}; pg8::StaticOrder S; S.init(M, 2048, G, bx);
          pg8::EpiMerge E{(const bf16*)(ws + WS_GATES), (bf16*)(ws + WS_MERGED)};
          pg8::gemm_phase<pg8::EpiMerge, pg8::StaticOrder, true, true>(lds, g, S, E); }
        GSYNC();
        DBG(110, args.ws + WS_MERGED, (size_t)64 * MiB, true);
        { IDS(); FRESH_PTR(unsigned char*, ws, args.ws); FRESH_PTR(const float*, xin, args.in[0]); FRESH_PTR(float*, outp, args.out); const float* xres = (l == 0) ? xin : (const float*)outp;
          pg8::Gemm g{(const bf16*)(ws + WS_MERGED), (const bf16*)(ws + WS_W + (size_t)l * WL_STRIDE + WL_O), M, D, D}; pg8::StaticOrder S; S.init(M, D, G, bx);
          pg8::EpiResid E{xres, outp, ALPHA};
          pg8::gemm_phase<pg8::EpiResid, pg8::StaticOrder, true, true>(lds, g, S, E); }
        GSYNC();
        DBG(120, args.out, (size_t)128 * MiB, false);
        { IDS(); FRESH_PTR(unsigned char*, ws, args.ws); FRESH_PTR(float*, outp, args.out); FRESH_PTR(const float*, gm, args.in[8]); FRESH_PTR(const float*, bt, args.in[9]);
          row_pass<true, true, true, false>(outp, outp, (bf16*)(ws + WS_XN), gm + l * D, bt + l * D, nullptr, nullptr, nullptr, gw, NGW, lane); }
        GSYNC();
        DBG(130, args.ws + WS_XN, (size_t)64 * MiB, true);
        { IDS(); FRESH_PTR(unsigned char*, ws, args.ws);
          pg8::Gemm g{(const bf16*)(ws + WS_XN), (const bf16*)(ws + WS_W + (size_t)l * WL_STRIDE + WL_F1), M, NF1, D}; pg8::StaticOrder S; S.init(M, NF1, G, bx);
          pg8::EpiSwiGLU E{(bf16*)(ws + WS_H)};
          pg8::gemm_phase<pg8::EpiSwiGLU, pg8::StaticOrder, true, true>(lds, g, S, E); }
        GSYNC();
        DBG(140, args.ws + WS_H, (size_t)176 * MiB, true);
        { IDS(); FRESH_PTR(unsigned char*, ws, args.ws); FRESH_PTR(float*, outp, args.out);
          pg8::Gemm g{(const bf16*)(ws + WS_H), (const bf16*)(ws + WS_W + (size_t)l * WL_STRIDE + WL_F2), M, D, FFH}; pg8::StaticOrder S; S.init(M, D, G, bx);
          pg8::EpiResid E{outp, outp, ALPHA};
          pg8::gemm_phase<pg8::EpiResid, pg8::StaticOrder, true, true>(lds, g, S, E); }
        GSYNC();
        DBG(150, args.out, (size_t)128 * MiB, false);
        { IDS(); FRESH_PTR(unsigned char*, ws, args.ws); FRESH_PTR(float*, outp, args.out); FRESH_PTR(const float*, gm, args.in[12]); FRESH_PTR(const float*, bt, args.in[13]);
          if (l + 1 < DEPTH) {
              FRESH_PTR(const float*, win, args.in[1]); FRESH_PTR(const float*, bfg, args.in[2]);
              stage_wfa(win + (size_t)(l + 1) * D * NIN, (LAS float*)lds, tid);
              __syncthreads();
              row_pass<true, true, true, true>(outp, outp, (bf16*)(ws + WS_XN), gm + l * D, bt + l * D, (float*)(ws + WS_LF), (const LAS float*)lds, bfg + (l + 1) * 8, gw, NGW, lane);
          } else {
              row_pass<true, true, false, false>(outp, outp, nullptr, gm + l * D, bt + l * D, nullptr, nullptr, nullptr, gw, NGW, lane);
          } }
        if (l + 1 < DEPTH) GSYNC();
    }
#ifdef DBG_NAN
    GSYNC();
    if (blockIdx.x == 0 && threadIdx.x == 0) args.out[0] = 100.0f * (float)*(volatile unsigned*)(args.ws + WS_END);
#endif
}

extern "C" void kernel_launch(void* const* d_in, const int* in_sizes, int n_in, void* d_out, int out_size, void* d_ws, size_t ws_size, hipStream_t stream) {
    static int grid = 0;
    if (grid == 0) {
        if (n_in != 14 || in_sizes[0] != M * D || out_size != M * D || ws_size < WS_END) { fprintf(stderr, "kernel_launch: unexpected shapes (n_in %d, in0 %d, out %d, ws %zu)\n", n_in, n_in > 0 ? in_sizes[0] : -1, out_size, ws_size); grid = -1; return; }
        int dev = 0, cus = 0, per_cu = 0;
        if (hipGetDevice(&dev) != hipSuccess || hipDeviceGetAttribute(&cus, hipDeviceAttributeMultiprocessorCount, dev) != hipSuccess) { grid = -1; return; }
        if (hipFuncSetAttribute((const void*)mega_fwd, hipFuncAttributeMaxDynamicSharedMemorySize, LDS_TOTAL) != hipSuccess) { fprintf(stderr, "kernel_launch: hipFuncSetAttribute failed\n"); grid = -1; return; }
        if (hipOccupancyMaxActiveBlocksPerMultiprocessor(&per_cu, (const void*)mega_fwd, NTHR, LDS_TOTAL) != hipSuccess || per_cu < 1) { fprintf(stderr, "kernel_launch: occupancy query says %d\n", per_cu); per_cu = 1; }
        (void)hipGetLastError();
        grid = cus * per_cu;
    }
    if (grid < 0) return;
    Args a{};
    for (int i = 0; i < 14; ++i) a.in[i] = (const float*)d_in[i];
    a.out = (float*)d_out; a.ws = (unsigned char*)d_ws;
    void* kargs[] = {&a};
    hipError_t e = hipLaunchCooperativeKernel((const void*)mega_fwd, dim3(grid), dim3(NTHR), kargs, LDS_TOTAL, stream);
    if (e != hipSuccess) fprintf(stderr, "kernel_launch: cooperative launch failed: %s (grid %d)\n", hipGetErrorString(e), grid);
}
```

```cpp
#include <hip/hip_runtime.h>
#include <cstdio>
#include <cstdint>
namespace pg8 {
#define PG8_LAS __attribute__((address_space(3)))
typedef unsigned short bf16_t;
typedef short bf16x8 __attribute__((ext_vector_type(8)));
typedef float f32x4 __attribute__((ext_vector_type(4)));
typedef unsigned u32x4 __attribute__((ext_vector_type(4)));
constexpr int BM = 256, BK = 64, HALF = 128, HTB = HALF * BK * 2  , STAGE_BYTES = 8 * HTB, NXCD = 8, WGM = 8;

__host__ __device__ __forceinline__ int lds_byte(int r, int c) { const int st = (r >> 4) * 2 + (c >> 5), rr = r & 15, cc = c & 31, ob = rr * 64 + cc * 2; return st * 1024 + (ob ^ (((ob >> 9) & 1) << 5)); }
__host__ __device__ __forceinline__ void stage_rc(int b, int& R, int& C) { const int st = b / 1024, sb = b % 1024, swz = sb ^ (((sb >> 9) & 1) << 5); R = (st >> 1) * 16 + swz / 64; C = (st & 1) * 32 + (swz % 64) / 2; }
__host__ __device__ __forceinline__ int perm32(int rho) { const int n = rho >> 4, i = rho & 15; return 8 * (i >> 2) + 4 * n + (i & 3); }

struct Unit { int pm, pn; };
struct Gemm { const bf16_t* A; const bf16_t* Bt; int M, N, K; };

struct StaticOrder {
    int nM, nN, nwg, G, c;
    __host__ __device__ void init(int M, int N, int G_, int c_) { nM = M / BM; nN = N / BM; nwg = nM * nN; G = G_; c = c_; }
    __host__ __device__ bool next(int i, Unit& u) const {
        const long L = (long)i * G + c; if (L >= nwg) return false;
        int wgid = (int)L; { const int q = nwg / NXCD, r = nwg % NXCD, xcd = wgid % NXCD, off = wgid / NXCD; wgid = (xcd < r ? xcd * (q + 1) : r * (q + 1) + (xcd - r) * q) + off; }
        const int nig = WGM * nN, gid = wgid / nig, fm = gid * WGM, gsz = (nM - fm) < WGM ? (nM - fm) : WGM;
        u.pm = fm + ((wgid % nig) % gsz); u.pn = (wgid % nig) / gsz; return true;
    }
    __device__ __forceinline__ void a_ready(const Unit&) const {}
    __device__ __forceinline__ void done(const Unit&) const {}
};

typedef float f32x2c_t __attribute__((ext_vector_type(2))); typedef __bf16 bf16x2c_t __attribute__((ext_vector_type(2)));
__device__ __forceinline__ unsigned cvt_pk_bf16(float lo, float hi) { f32x2c_t v = {lo, hi}; bf16x2c_t b = __builtin_convertvector(v, bf16x2c_t); return __builtin_bit_cast(unsigned, b); }
typedef float f32x2 __attribute__((ext_vector_type(2)));
__device__ __forceinline__ f32x2 gelu_pk(f32x2 v) {
    const f32x2 av = __builtin_elementwise_abs(v), d = av * 0.2316418882f + 1.0f;
    f32x2 t; t.x = __builtin_amdgcn_rcpf(d.x); t.y = __builtin_amdgcn_rcpf(d.y);
    f32x2 q = t * 0.5307027145f + (-0.7265760135f); q = q * t + 0.7107068705f; q = q * t + (-0.142248368f); q = q * t + 0.127414796f; q = q * t;
    const f32x2 s = (v * v) * (-0.72134752044f);
    f32x2 e; e.x = __builtin_amdgcn_exp2f(s.x); e.y = __builtin_amdgcn_exp2f(s.y);
    const f32x2 m = v * (q * e), r = v - m;
    f32x2 o; o.x = v.x < 0.f ? m.x : r.x; o.y = v.y < 0.f ? m.y : r.y; return o;
}

template <int ACT  > struct EpiBf16 {
    static constexpr bool PERM = true, AFTER_DRAIN = false; static_assert(ACT == 0 || ACT == 1, "EpiBf16: ACT is 0 (none) or 1 (gelu_pk)");
    bf16_t* O; int ldc; const float* bias; int split_cols; size_t split_stride; float scale0;
    __device__ __forceinline__ void operator()(const f32x4 (&acc)[2][2][4][2], const Unit& u, int wr, int wc, int fr, int fq) const {
        const int row0 = u.pm * BM + wr * 64 + fr; int colt = u.pn * BM; bf16_t* base = O;
        float sc = 1.f; if (split_cols) { const int t = colt / split_cols; base += (size_t)t * split_stride; colt -= t * split_cols; if (t == 0) sc = scale0; }
        const int col0 = colt + wc * 32 + 8 * fq, bcol0 = u.pn * BM + wc * 32 + 8 * fq;
        f32x4 bv[2][2];
#pragma unroll
        for (int bj = 0; bj < 2; ++bj)
#pragma unroll
            for (int n = 0; n < 2; ++n) bv[bj][n] = bias ? *(const f32x4*)(bias + bcol0 + bj * HALF + 4 * n) : (f32x4){0.f, 0.f, 0.f, 0.f};
#pragma unroll
        for (int ai = 0; ai < 2; ++ai)
#pragma unroll
            for (int m = 0; m < 4; ++m) { bf16_t* rowp = base + (size_t)(row0 + ai * HALF + m * 16) * ldc + col0;
#pragma unroll
                for (int bj = 0; bj < 2; ++bj) { f32x4 v0 = acc[ai][bj][m][0] + bv[bj][0], v1 = acc[ai][bj][m][1] + bv[bj][1];
                    if (ACT == 1) { f32x2 a = gelu_pk((f32x2){v0[0], v0[1]}), b = gelu_pk((f32x2){v0[2], v0[3]}), c = gelu_pk((f32x2){v1[0], v1[1]}), d = gelu_pk((f32x2){v1[2], v1[3]});
                        v0 = (f32x4){a.x, a.y, b.x, b.y}; v1 = (f32x4){c.x, c.y, d.x, d.y}; }
                    v0 = v0 * sc; v1 = v1 * sc; u32x4 w; w.x = cvt_pk_bf16(v0[0], v0[1]); w.y = cvt_pk_bf16(v0[2], v0[3]); w.z = cvt_pk_bf16(v1[0], v1[1]); w.w = cvt_pk_bf16(v1[2], v1[3]);
                    *(u32x4*)(rowp + bj * HALF) = w; } }
    }
};

struct PanelStats {
    unsigned* xbuf;
    unsigned* cnt;
    unsigned* tmo;
    int ntn; float eps;
    unsigned code;
    __device__ __forceinline__ bool run(const f32x4 (&v)[2][2][4][2], const Unit& u, int wr, int wc, int fr, int fq, PG8_LAS unsigned char* lds, int wid, int lane) const {
        typedef float f32x2v __attribute__((ext_vector_type(2)));
        PG8_LAS f32x2v* P = (PG8_LAS f32x2v*)lds;
        PG8_LAS f32x2v* S = (PG8_LAS f32x2v*)(lds + 8192);
        PG8_LAS unsigned* flag = (PG8_LAS unsigned*)(lds + 8192 + 2048);
#pragma unroll
        for (int ai = 0; ai < 2; ++ai)
#pragma unroll
            for (int m = 0; m < 4; ++m) {
                float s = 0.f;
#pragma unroll
                for (int bj = 0; bj < 2; ++bj)
#pragma unroll
                    for (int n = 0; n < 2; ++n) { const f32x4 x = v[ai][bj][m][n]; s += (x[0] + x[1]) + (x[2] + x[3]); }
                s += __shfl_xor(s, 16); s += __shfl_xor(s, 32);
                const float mw = s * (1.0f / 64.0f); float q = 0.f;
#pragma unroll
                for (int bj = 0; bj < 2; ++bj)
#pragma unroll
                    for (int n = 0; n < 2; ++n) { const f32x4 d = v[ai][bj][m][n] - mw; q += (d[0] * d[0] + d[1] * d[1]) + (d[2] * d[2] + d[3] * d[3]); }
                q += __shfl_xor(q, 16); q += __shfl_xor(q, 32);
                if (fq == 0) P[(ai * HALF + wr * 64 + m * 16 + fr) * 4 + wc] = (f32x2v){mw, q};
            }
        asm volatile("s_waitcnt lgkmcnt(0)" ::: "memory"); __builtin_amdgcn_s_barrier(); asm volatile("" ::: "memory");
#if defined(BROKEN_EXCHANGE_NO_WAIT)
#warning BROKEN CONTROL BUILD: the row-statistics exchange does not wait; results are wrong by design
        if (blockIdx.x >= 64) { const long long t0_ = clock64(); while (clock64() - t0_ < 60000) __builtin_amdgcn_s_sleep(8); }
#endif
        const int row = wid * 32 + (lane & 31);
        if (lane < 32) {
            const f32x2v a = P[row * 4 + 0], b = P[row * 4 + 1], c = P[row * 4 + 2], d = P[row * 4 + 3];
            const float mt = (a.x + b.x + c.x + d.x) * 0.25f;
            const float da = a.x - mt, db = b.x - mt, dc = c.x - mt, dd = d.x - mt;
            const float m2 = (a.y + b.y) + (c.y + d.y) + 64.0f * ((da * da + db * db) + (dc * dc + dd * dd));
            unsigned long long* slot = (unsigned long long*)xbuf + ((size_t)(u.pm * BM + row) * 4 + u.pn);
            __hip_atomic_store(slot, ((unsigned long long)__float_as_uint(m2) << 32) | __float_as_uint(mt), __ATOMIC_RELAXED, __HIP_MEMORY_SCOPE_AGENT);
        }
        asm volatile("s_waitcnt vmcnt(0)" ::: "memory");
        if (lane == 0) __hip_atomic_fetch_add(cnt + 64 * u.pm, 1u, __ATOMIC_RELAXED, __HIP_MEMORY_SCOPE_AGENT);
        if (wid == 0) {
            bool dead = false; const unsigned long long t0 = __builtin_amdgcn_s_memrealtime(); const unsigned want = 8u * (unsigned)ntn;
            for (;;) {
#if defined(BROKEN_EXCHANGE_NO_WAIT)
                break;
#endif
                if ((unsigned)__builtin_amdgcn_readfirstlane(__hip_atomic_load(cnt + 64 * u.pm, __ATOMIC_RELAXED, __HIP_MEMORY_SCOPE_AGENT)) >= want) break;
                if (__builtin_amdgcn_s_memrealtime() - t0 > 2000000ull) {
                    if (lane == 0) { unsigned expect = 0u; __hip_atomic_compare_exchange_strong(tmo + 1, &expect, code | (unsigned)(u.pm & 0xff), __ATOMIC_RELAXED, __ATOMIC_RELAXED, __HIP_MEMORY_SCOPE_AGENT);
                                     __hip_atomic_store(tmo, 1u, __ATOMIC_RELAXED, __HIP_MEMORY_SCOPE_AGENT); }
                    dead = true; break; }
                __builtin_amdgcn_s_sleep(2);
            }
            __builtin_amdgcn_fence(__ATOMIC_ACQUIRE, "agent");
            if (lane == 0) flag[0] = dead ? 1u : 0u;
        }
        asm volatile("s_waitcnt vmcnt(0) lgkmcnt(0)" ::: "memory"); __builtin_amdgcn_s_barrier(); asm volatile("" ::: "memory");
        const bool bad = flag[0] != 0u;
        if (lane < 32) {
            const unsigned long long* slot = (const unsigned long long*)xbuf + (size_t)(u.pm * BM + row) * 4; float mt[4], m2[4]; float ms = 0.f;
#pragma unroll
            for (int t = 0; t < 4; ++t) { if (t < ntn) { const unsigned long long w = __hip_atomic_load(slot + t, __ATOMIC_RELAXED, __HIP_MEMORY_SCOPE_AGENT); mt[t] = __uint_as_float((unsigned)w); m2[t] = __uint_as_float((unsigned)(w >> 32)); } else { mt[t] = 0.f; m2[t] = 0.f; } ms += mt[t]; }
            const float mean = ms / (float)ntn; float q = 0.f;
#pragma unroll
            for (int t = 0; t < 4; ++t) if (t < ntn) { const float dm = mt[t] - mean; q += m2[t] + 256.0f * dm * dm; }
            S[row] = (f32x2v){mean, 1.0f / sqrtf(q / (256.0f * (float)ntn) + eps)};
        }
        asm volatile("s_waitcnt lgkmcnt(0)" ::: "memory"); __builtin_amdgcn_s_barrier(); asm volatile("" ::: "memory");
        return bad;
    }
};
struct EpiLnRes {
    static constexpr bool PERM = false, AFTER_DRAIN = true;
    const float* base; float* out; int ldc; const float* bias; PanelStats st; unsigned poison;
    __device__ __forceinline__ void fused(f32x4 (&acc)[2][2][4][2], const Unit& u, int wr, int wc, int fr, int fq, PG8_LAS unsigned char* lds, int wid, int lane) const {
        typedef float f32x2v __attribute__((ext_vector_type(2)));
        const PG8_LAS f32x2v* S = (const PG8_LAS f32x2v*)(lds + 8192);
        const int col0 = u.pn * BM + wc * 32 + 4 * fq;
#pragma unroll
        for (int bj = 0; bj < 2; ++bj)
#pragma unroll
            for (int n = 0; n < 2; ++n) { const f32x4 bv = bias ? *(const f32x4*)(bias + col0 + bj * HALF + n * 16) : (f32x4){0.f, 0.f, 0.f, 0.f};
#pragma unroll
                for (int ai = 0; ai < 2; ++ai)
#pragma unroll
                    for (int m = 0; m < 4; ++m) acc[ai][bj][m][n] += bv; }
        f32x4 pre[4][2][2];
#pragma unroll
        for (int m = 0; m < 4; ++m) { const size_t off = (size_t)(u.pm * BM + wr * 64 + m * 16 + fr) * ldc + col0;
#pragma unroll
            for (int bj = 0; bj < 2; ++bj)
#pragma unroll
                for (int n = 0; n < 2; ++n) pre[m][bj][n] = *(const f32x4*)(base + off + bj * HALF + n * 16); }
        const bool bad = st.run(acc, u, wr, wc, fr, fq, lds, wid, lane) || poison != 0u;
        const float qnan = __builtin_nanf("");
#pragma unroll
        for (int ai = 0; ai < 2; ++ai)
#pragma unroll
            for (int m = 0; m < 4; ++m) { const int r = ai * HALF + wr * 64 + m * 16 + fr; const f32x2v sr = S[r]; const size_t off = (size_t)(u.pm * BM + r) * ldc + col0;
#pragma unroll
                for (int bj = 0; bj < 2; ++bj)
#pragma unroll
                    for (int n = 0; n < 2; ++n) { const f32x4 bs = ai == 0 ? pre[m][bj][n] : *(const f32x4*)(base + off + bj * HALF + n * 16); f32x4 o = bs + (acc[ai][bj][m][n] - sr.x) * sr.y;
                        if (bad) o = (f32x4){qnan, qnan, qnan, qnan}; *(f32x4*)(out + off + bj * HALF + n * 16) = o; }
                if (m & 1) asm volatile("" ::: "memory"); }
    }
};
struct EpiLnResLn {
    static constexpr bool PERM = false, AFTER_DRAIN = true;
    const float* base; float* out; bf16_t* xn; int ldc; const float* bias; PanelStats st1, st2; unsigned poison;
    __device__ __forceinline__ void fused(f32x4 (&acc)[2][2][4][2], const Unit& u, int wr, int wc, int fr, int fq, PG8_LAS unsigned char* lds, int wid, int lane) const {
        typedef float f32x2v __attribute__((ext_vector_type(2))); typedef unsigned u32x2v __attribute__((ext_vector_type(2)));
        const PG8_LAS f32x2v* S = (const PG8_LAS f32x2v*)(lds + 8192);
        const int col0 = u.pn * BM + wc * 32 + 4 * fq;
#pragma unroll
        for (int bj = 0; bj < 2; ++bj)
#pragma unroll
            for (int n = 0; n < 2; ++n) { const f32x4 bv = bias ? *(const f32x4*)(bias + col0 + bj * HALF + n * 16) : (f32x4){0.f, 0.f, 0.f, 0.f};
#pragma unroll
                for (int ai = 0; ai < 2; ++ai)
#pragma unroll
                    for (int m = 0; m < 4; ++m) acc[ai][bj][m][n] += bv; }
        bool bad = st1.run(acc, u, wr, wc, fr, fq, lds, wid, lane) || poison != 0u;
        const float qnan = __builtin_nanf("");
#pragma unroll
        for (int ai = 0; ai < 2; ++ai)
#pragma unroll
            for (int m = 0; m < 4; ++m) { const int r = ai * HALF + wr * 64 + m * 16 + fr; const f32x2v sr = S[r]; const size_t off = (size_t)(u.pm * BM + r) * ldc + col0;
#pragma unroll
                for (int bj = 0; bj < 2; ++bj)
#pragma unroll
                    for (int n = 0; n < 2; ++n) { const f32x4 bs = *(const f32x4*)(base + off + bj * HALF + n * 16); acc[ai][bj][m][n] = bs + (acc[ai][bj][m][n] - sr.x) * sr.y; }
                asm volatile("" : "+v"(acc[ai][0][m][0]), "+v"(acc[ai][0][m][1]), "+v"(acc[ai][1][m][0]), "+v"(acc[ai][1][m][1]));
                if (m & 1) asm volatile("" ::: "memory"); }
        const bool bad1 = bad;
        bad = st2.run(acc, u, wr, wc, fr, fq, lds, wid, lane) || bad;
#pragma unroll
        for (int ai = 0; ai < 2; ++ai)
#pragma unroll
            for (int m = 0; m < 4; ++m) { const int r = ai * HALF + wr * 64 + m * 16 + fr; const f32x2v sr = S[r]; const size_t off = (size_t)(u.pm * BM + r) * ldc + col0;
#pragma unroll
                for (int bj = 0; bj < 2; ++bj)
#pragma unroll
                    for (int n = 0; n < 2; ++n) { const f32x4 x1 = acc[ai][bj][m][n]; *(f32x4*)(out + off + bj * HALF + n * 16) = bad1 ? (f32x4){qnan, qnan, qnan, qnan} : x1;
                        const f32x4 o = (x1 - sr.x) * sr.y; u32x2v w; w.x = cvt_pk_bf16(o[0], o[1]); w.y = cvt_pk_bf16(o[2], o[3]);
                        if (bad) { w.x = 0x7fc07fc0u; w.y = 0x7fc07fc0u; } *(u32x2v*)(xn + off + bj * HALF + n * 16) = w; }
                asm volatile("" ::: "memory"); }
    }
};

template <class Epi, class Sched, bool ALIGN_EPI = false, bool SP2 = false>
__device__ __forceinline__ void gemm_phase(PG8_LAS unsigned char* lds, const Gemm g, const Sched& S, const Epi& E) {
    int tid_ = threadIdx.x; asm volatile("" : "+v"(tid_));
    const int tid = tid_, wid = __builtin_amdgcn_readfirstlane(tid >> 6), lane = tid & 63, wr = wid >> 2, wc = wid & 3, fr = lane & 15, fq = lane >> 4;
    const int K = g.K, nt = K / BK;
    unsigned voffA[2], voffB[2];
#pragma unroll
    for (int i = 0; i < 2; ++i) { int R, C; stage_rc(tid * 16 + i * 8192, R, C); const int Rb = Epi::PERM ? ((R & ~31) + perm32(R & 31)) : R;
        voffA[i] = (unsigned)(R * K + C) * 2u; voffB[i] = (unsigned)(Rb * K + C) * 2u; }
    const size_t kstep = (size_t)(BK * 2);
    const size_t hstep = (size_t)HALF * K * 2;
    const size_t tstep = 2 * hstep;
    const unsigned ldsw = (unsigned)wid * 1024u;
    const int aoff = lds_byte(wr * 64 + fr, fq * 8), boff = lds_byte(wc * 32 + fr, fq * 8);
#define PG8_SA(b, h) (((b) * 2 + (h)) * HTB)
#define PG8_SB(b, h) ((4 + (b) * 2 + (h)) * HTB)
#define PG8_STAGE(bufoff, gbase, voff) do { _Pragma("unroll") for (int _i = 0; _i < 2; ++_i) \
        __builtin_amdgcn_global_load_lds((const unsigned*)((const char*)(gbase) + (voff)[_i]), (PG8_LAS unsigned*)(lds + (bufoff) + ldsw + _i * 8192), 16, 0, 0); } while (0)
#define PG8_LDA(dst, b, h) do { _Pragma("unroll") for (int m = 0; m < 4; ++m) _Pragma("unroll") for (int k = 0; k < 2; ++k) dst[m][k] = *(const PG8_LAS bf16x8*)(lds + PG8_SA(b, h) + aoff + m * 2048 + k * 1024); } while (0)
#define PG8_LDB(dst, b, h) do { _Pragma("unroll") for (int n = 0; n < 2; ++n) _Pragma("unroll") for (int k = 0; k < 2; ++k) dst[n][k] = *(const PG8_LAS bf16x8*)(lds + PG8_SB(b, h) + boff + n * 2048 + k * 1024); } while (0)
#define PG8_MMA(ai, bj, At, Bt) do { __builtin_amdgcn_s_setprio(1); _Pragma("unroll") for (int m = 0; m < 4; ++m) _Pragma("unroll") for (int n = 0; n < 2; ++n) _Pragma("unroll") for (int k = 0; k < 2; ++k) \
        acc[ai][bj][m][n] = __builtin_amdgcn_mfma_f32_16x16x32_bf16(Bt[n][k], At[m][k], acc[ai][bj][m][n], 0, 0, 0); __builtin_amdgcn_s_setprio(0); } while (0)
#define PG8_WAIT_V(n) asm volatile("s_waitcnt vmcnt(" #n ")" ::: "memory")
#define PG8_WAIT_L(n) asm volatile("s_waitcnt lgkmcnt(" #n ")" ::: "memory")
#define PG8_BAR __builtin_amdgcn_s_barrier()
#define PG8_SCHED __builtin_amdgcn_sched_barrier(0)
    Unit cur, nxt; int ui = 0;
    if (!S.next(0, cur)) return;
    f32x4 acc[2][2][4][2];
#pragma unroll
    for (int a = 0; a < 2; ++a)
#pragma unroll
        for (int b = 0; b < 2; ++b)
#pragma unroll
            for (int m = 0; m < 4; ++m)
#pragma unroll
                for (int n = 0; n < 2; ++n) acc[a][b][m][n] = (f32x4){0.f, 0.f, 0.f, 0.f};
    bf16x8 At[4][2], B0[2][2], B1[2][2];
    const char* cA = (const char*)g.A + (size_t)cur.pm * tstep; const char* cB = (const char*)g.Bt + (size_t)cur.pn * tstep;
    S.a_ready(cur);
    if constexpr (SP2) {
        PG8_STAGE(PG8_SB(0, 0), cB, voffB); PG8_STAGE(PG8_SB(0, 1), cB + hstep, voffB); PG8_STAGE(PG8_SA(0, 0), cA, voffA); PG8_STAGE(PG8_SA(0, 1), cA + hstep, voffA);
        if (wr == 1) PG8_BAR;
        PG8_WAIT_V(2); PG8_BAR;
        PG8_STAGE(PG8_SB(1, 0), cB + kstep, voffB); PG8_STAGE(PG8_SA(1, 0), cA + kstep, voffA); PG8_STAGE(PG8_SB(1, 1), cB + hstep + kstep, voffB);
        PG8_WAIT_V(6); PG8_BAR;
    } else {
        PG8_STAGE(PG8_SB(0, 0), cB, voffB); PG8_STAGE(PG8_SA(0, 0), cA, voffA); PG8_STAGE(PG8_SB(0, 1), cB + hstep, voffB); PG8_STAGE(PG8_SA(0, 1), cA + hstep, voffA);
        if (wr == 1) PG8_BAR;
        PG8_WAIT_V(4); PG8_BAR;
        PG8_STAGE(PG8_SB(1, 0), cB + kstep, voffB); PG8_STAGE(PG8_SA(1, 0), cA + kstep, voffA); PG8_STAGE(PG8_SB(1, 1), cB + hstep + kstep, voffB);
        PG8_WAIT_V(6); PG8_BAR;
    }
    for (;;) {
        const bool has_next = S.next(ui + 1, nxt);
        const char* nA = has_next ? (const char*)g.A + (size_t)nxt.pm * tstep : cA; const char* nB = has_next ? (const char*)g.Bt + (size_t)nxt.pn * tstep : cB;
        for (int t = 0; t < nt; t += 2) {
            const bool last = (t == nt - 2);
            const char* a1 = cA + (size_t)(t + 1) * kstep;
            const char* a2 = last ? nA : cA + (size_t)(t + 2) * kstep; const char* b2 = last ? nB : cB + (size_t)(t + 2) * kstep;
            const char* a3 = a2 + kstep; const char* b3 = b2 + kstep;
            if (last && has_next) S.a_ready(nxt);
            if constexpr (SP2) {
            PG8_LDB(B0, 0, 0); PG8_LDB(B1, 0, 1); PG8_SCHED; PG8_LDA(At, 0, 0); PG8_STAGE(PG8_SA(1, 1), a1 + hstep, voffA);
            PG8_WAIT_V(8); PG8_WAIT_L(0); PG8_BAR; PG8_MMA(0, 0, At, B0); PG8_MMA(0, 1, At, B1); PG8_BAR; PG8_SCHED;
            PG8_LDA(At, 0, 1); PG8_STAGE(PG8_SB(0, 0), b2, voffB); PG8_STAGE(PG8_SB(0, 1), b2 + hstep, voffB); PG8_STAGE(PG8_SA(0, 0), a2, voffA);
            PG8_WAIT_V(8); PG8_WAIT_L(0); PG8_BAR; PG8_MMA(1, 0, At, B0); PG8_MMA(1, 1, At, B1); PG8_BAR; PG8_SCHED;
            PG8_LDB(B0, 1, 0); PG8_LDB(B1, 1, 1); PG8_SCHED; PG8_LDA(At, 1, 0); PG8_STAGE(PG8_SA(0, 1), a2 + hstep, voffA);
            PG8_WAIT_V(8); PG8_WAIT_L(0); PG8_BAR; PG8_MMA(0, 0, At, B0); PG8_MMA(0, 1, At, B1); PG8_BAR; PG8_SCHED;
            PG8_LDA(At, 1, 1); PG8_STAGE(PG8_SB(1, 0), b3, voffB); PG8_STAGE(PG8_SB(1, 1), b3 + hstep, voffB); PG8_STAGE(PG8_SA(1, 0), a3, voffA);
            PG8_WAIT_V(8); PG8_WAIT_L(0); PG8_BAR; PG8_MMA(1, 0, At, B0); PG8_MMA(1, 1, At, B1); PG8_BAR; PG8_SCHED;
            } else {
            PG8_LDB(B0, 0, 0); PG8_SCHED; PG8_LDA(At, 0, 0); PG8_STAGE(PG8_SA(1, 1), a1 + hstep, voffA);
            PG8_WAIT_L(8); PG8_BAR; PG8_WAIT_L(0); PG8_MMA(0, 0, At, B0); PG8_BAR; PG8_SCHED;
            PG8_LDB(B1, 0, 1); PG8_STAGE(PG8_SB(0, 0), b2, voffB);
            PG8_BAR; PG8_WAIT_L(0); PG8_MMA(0, 1, At, B1); PG8_BAR;
            PG8_LDA(At, 0, 1); PG8_STAGE(PG8_SA(0, 0), a2, voffA);
            PG8_BAR; PG8_WAIT_L(0); PG8_MMA(1, 0, At, B0); PG8_BAR; PG8_SCHED;
            PG8_STAGE(PG8_SB(0, 1), b2 + hstep, voffB);
            PG8_WAIT_V(6); PG8_BAR; PG8_MMA(1, 1, At, B1); PG8_BAR;
            PG8_LDB(B0, 1, 0); PG8_SCHED; PG8_LDA(At, 1, 0); PG8_STAGE(PG8_SA(0, 1), a2 + hstep, voffA);
            PG8_WAIT_L(8); PG8_BAR; PG8_WAIT_L(0); PG8_MMA(0, 0, At, B0); PG8_BAR; PG8_SCHED;
            PG8_LDB(B1, 1, 1); PG8_STAGE(PG8_SB(1, 0), b3, voffB);
            PG8_BAR; PG8_WAIT_L(0); PG8_MMA(0, 1, At, B1); PG8_BAR;
            PG8_LDA(At, 1, 1); PG8_STAGE(PG8_SA(1, 0), a3, voffA);
            PG8_BAR; PG8_WAIT_L(0); PG8_MMA(1, 0, At, B0); PG8_BAR; PG8_SCHED;
            PG8_STAGE(PG8_SB(1, 1), b3 + hstep, voffB);
            PG8_WAIT_V(6); PG8_BAR; PG8_MMA(1, 1, At, B1); PG8_BAR;
            }
        }
        if constexpr (ALIGN_EPI) { if (wr == 0) PG8_BAR; }
        if constexpr (!Epi::AFTER_DRAIN) { E(acc, cur, wr, wc, fr, fq); S.done(cur); }
        if (!has_next) break;
#pragma unroll
        for (int a = 0; a < 2; ++a)
#pragma unroll
            for (int b = 0; b < 2; ++b)
#pragma unroll
                for (int m = 0; m < 4; ++m)
#pragma unroll
                    for (int n = 0; n < 2; ++n) acc[a][b][m][n] = (f32x4){0.f, 0.f, 0.f, 0.f};
        cur = nxt; cA = nA; cB = nB; ++ui;
        if constexpr (ALIGN_EPI) { if (wr == 1) PG8_BAR; }
    }
    PG8_WAIT_V(0);
    if constexpr (!ALIGN_EPI) { if (wr == 0) PG8_BAR; }
    PG8_BAR;
    if constexpr (Epi::AFTER_DRAIN) { E.fused(acc, cur, wr, wc, fr, fq, lds, wid, lane); S.done(cur); }
#undef PG8_SA
#undef PG8_SB
#undef PG8_STAGE
#undef PG8_LDA
#undef PG8_LDB
#undef PG8_MMA
#undef PG8_WAIT_V
#undef PG8_WAIT_L
#undef PG8_BAR
#undef PG8_SCHED
}
}
namespace pg8 {
__device__ __forceinline__ float fsig(float v) { return __builtin_amdgcn_rcpf(1.0f + __builtin_amdgcn_exp2f(-1.4426950408889634f * v)); }
__device__ __forceinline__ float bf_lo(unsigned w) { return __uint_as_float(w << 16); }
__device__ __forceinline__ float bf_hi(unsigned w) { return __uint_as_float(w & 0xffff0000u); }

struct EpiInProj {
    static constexpr bool PERM = true, AFTER_DRAIN = false;
    bf16_t* QAB; bf16_t* KA; bf16_t* VA; float* G; bf16_t* IB; bf16_t* GB; const float* lbl; int layer; float qscale;
    __device__ __forceinline__ void operator()(const f32x4 (&acc)[2][2][4][2], const Unit& u, int wr, int wc, int fr, int fq) const {
        const int type = u.pn >> 1;
        const int ct = (u.pn & 1) * 256 + wc * 32 + 8 * fq;
        const int row0 = u.pm * BM + wr * 64 + fr;
        if (type == 4) {
            float lb[2][8];
#pragma unroll
            for (int bj = 0; bj < 2; ++bj)
#pragma unroll
                for (int j = 0; j < 8; ++j) {
                    float v = 0.f;
                    if (layer != 0) { const float l0 = lbl[ct + bj * HALF + j], l1 = lbl[512 + ct + bj * HALF + j]; v = 1.0f / (1.0f + __expf(l0 - l1)); }
                    lb[bj][j] = v;
                }
#pragma unroll
            for (int ai = 0; ai < 2; ++ai)
#pragma unroll
                for (int m = 0; m < 4; ++m) { float* rowp = G + (size_t)(row0 + ai * HALF + m * 16) * 512 + ct;
#pragma unroll
                    for (int bj = 0; bj < 2; ++bj) { f32x4 o0, o1;
#pragma unroll
                        for (int j = 0; j < 4; ++j) {
                            const float f0 = lb[bj][j] + (1.0f - lb[bj][j]) * fsig(acc[ai][bj][m][0][j]);
                            const float f1 = lb[bj][4 + j] + (1.0f - lb[bj][4 + j]) * fsig(acc[ai][bj][m][1][j]);
                            o0[j] = __builtin_amdgcn_logf(f0) * 0.6931471805599453f; o1[j] = __builtin_amdgcn_logf(f1) * 0.6931471805599453f; }
                        *(f32x4*)(rowp + bj * HALF) = o0; *(f32x4*)(rowp + bj * HALF + 4) = o1; } }
        } else {
            bf16_t* base; int ldc = 512, act = 0; float sc = 1.f;
            if (type == 0) { base = QAB; ldc = 1024; sc = qscale; }
            else if (type == 1) base = KA;
            else if (type == 2) base = VA;
            else if (type == 3) { base = QAB + 512; ldc = 1024; act = 1; }
            else if (type == 5) base = IB;
            else { base = GB; act = 2; }
#pragma unroll
            for (int ai = 0; ai < 2; ++ai)
#pragma unroll
                for (int m = 0; m < 4; ++m) { bf16_t* rowp = base + (size_t)(row0 + ai * HALF + m * 16) * ldc + ct;
#pragma unroll
                    for (int bj = 0; bj < 2; ++bj) { f32x4 v0 = acc[ai][bj][m][0], v1 = acc[ai][bj][m][1];
                        if (act != 0) {
#pragma unroll
                            for (int j = 0; j < 4; ++j) { const float s0 = fsig(v0[j]), s1 = fsig(v1[j]); v0[j] = (act == 1) ? v0[j] * s0 : s0; v1[j] = (act == 1) ? v1[j] * s1 : s1; }
                        } else { v0 = v0 * sc; v1 = v1 * sc; }
                        u32x4 w; w.x = cvt_pk_bf16(v0[0], v0[1]); w.y = cvt_pk_bf16(v0[2], v0[3]); w.z = cvt_pk_bf16(v1[0], v1[1]); w.w = cvt_pk_bf16(v1[2], v1[3]);
                        *(u32x4*)(rowp + bj * HALF) = w; } }
        }
    }
};
struct EpiGates {
    static constexpr bool PERM = true, AFTER_DRAIN = false;
    bf16_t* O;
    __device__ __forceinline__ void operator()(const f32x4 (&acc)[2][2][4][2], const Unit& u, int wr, int wc, int fr, int fq) const {
        const int row0 = u.pm * BM + wr * 64 + fr, col0 = u.pn * BM + wc * 32 + 8 * fq;
#pragma unroll
        for (int ai = 0; ai < 2; ++ai)
#pragma unroll
            for (int m = 0; m < 4; ++m) { bf16_t* rowp = O + (size_t)(row0 + ai * HALF + m * 16) * 2048 + col0;
#pragma unroll
                for (int bj = 0; bj < 2; ++bj) { f32x4 v0 = acc[ai][bj][m][0], v1 = acc[ai][bj][m][1];
#pragma unroll
                    for (int j = 0; j < 4; ++j) { v0[j] = fsig(v0[j]); v1[j] = fsig(v1[j]); }
                    u32x4 w; w.x = cvt_pk_bf16(v0[0], v0[1]); w.y = cvt_pk_bf16(v0[2], v0[3]); w.z = cvt_pk_bf16(v1[0], v1[1]); w.w = cvt_pk_bf16(v1[2], v1[3]);
                    *(u32x4*)(rowp + bj * HALF) = w; } }
    }
};
struct EpiMerge {
    static constexpr bool PERM = true, AFTER_DRAIN = false;
    const bf16_t* GT; bf16_t* O;
    __device__ __forceinline__ void operator()(const f32x4 (&acc)[2][2][4][2], const Unit& u, int wr, int wc, int fr, int fq) const {
        const int row0 = u.pm * BM + wr * 64 + fr, col0 = u.pn * HALF + wc * 32 + 8 * fq;
#pragma unroll
        for (int ai = 0; ai < 2; ++ai)
#pragma unroll
            for (int m = 0; m < 4; ++m) { const size_t row = (size_t)(row0 + ai * HALF + m * 16);
                const u32x4 ga = *(const u32x4*)(GT + row * 2048 + col0), gb = *(const u32x4*)(GT + row * 2048 + 1024 + col0);
                const f32x4 a0 = acc[ai][0][m][0], a1 = acc[ai][0][m][1], b0 = acc[ai][1][m][0], b1 = acc[ai][1][m][1];
                u32x4 w;
                w.x = cvt_pk_bf16(bf_lo(ga.x) * a0[0] + bf_lo(gb.x) * b0[0], bf_hi(ga.x) * a0[1] + bf_hi(gb.x) * b0[1]);
                w.y = cvt_pk_bf16(bf_lo(ga.y) * a0[2] + bf_lo(gb.y) * b0[2], bf_hi(ga.y) * a0[3] + bf_hi(gb.y) * b0[3]);
                w.z = cvt_pk_bf16(bf_lo(ga.z) * a1[0] + bf_lo(gb.z) * b1[0], bf_hi(ga.z) * a1[1] + bf_hi(gb.z) * b1[1]);
                w.w = cvt_pk_bf16(bf_lo(ga.w) * a1[2] + bf_lo(gb.w) * b1[2], bf_hi(ga.w) * a1[3] + bf_hi(gb.w) * b1[3]);
                *(u32x4*)(O + row * 1024 + col0) = w;
                if (m & 1) asm volatile("" ::: "memory"); }
    }
};
struct EpiSwiGLU {
    static constexpr bool PERM = true, AFTER_DRAIN = false;
    bf16_t* O;
    __device__ __forceinline__ void operator()(const f32x4 (&acc)[2][2][4][2], const Unit& u, int wr, int wc, int fr, int fq) const {
        const int row0 = u.pm * BM + wr * 64 + fr, col0 = u.pn * HALF + wc * 32 + 8 * fq;
#pragma unroll
        for (int ai = 0; ai < 2; ++ai)
#pragma unroll
            for (int m = 0; m < 4; ++m) { const size_t row = (size_t)(row0 + ai * HALF + m * 16);
                f32x4 v0, v1;
#pragma unroll
                for (int j = 0; j < 4; ++j) { const float g0 = acc[ai][1][m][0][j], g1 = acc[ai][1][m][1][j];
                    v0[j] = g0 * fsig(g0) * acc[ai][0][m][0][j]; v1[j] = g1 * fsig(g1) * acc[ai][0][m][1][j]; }
                u32x4 w; w.x = cvt_pk_bf16(v0[0], v0[1]); w.y = cvt_pk_bf16(v0[2], v0[3]); w.z = cvt_pk_bf16(v1[0], v1[1]); w.w = cvt_pk_bf16(v1[2], v1[3]);
                *(u32x4*)(O + row * 2816 + col0) = w; }
    }
};
struct EpiResid {
    static constexpr bool PERM = false, AFTER_DRAIN = false;
    const float* xres; float* out; float alpha;
    __device__ __forceinline__ void operator()(const f32x4 (&acc)[2][2][4][2], const Unit& u, int wr, int wc, int fr, int fq) const {
        const int row0 = u.pm * BM + wr * 64 + fr, col0 = u.pn * BM + wc * 32 + 4 * fq;
#pragma unroll
        for (int ai = 0; ai < 2; ++ai)
#pragma unroll
            for (int m = 0; m < 4; ++m) { const size_t off = (size_t)(row0 + ai * HALF + m * 16) * 1024 + col0;
#pragma unroll
                for (int bj = 0; bj < 2; ++bj)
#pragma unroll
                    for (int n = 0; n < 2; ++n) { const f32x4 x = *(const f32x4*)(xres + off + bj * HALF + n * 16);
                        *(f32x4*)(out + off + bj * HALF + n * 16) = x * alpha + acc[ai][bj][m][n]; }
                if (m & 1) asm volatile("" ::: "memory"); }
    }
};
}
#include <hip/hip_bf16.h>
#include <cmath>
namespace attn_body {
using bf16=__hip_bfloat16;
using bf16x8=__attribute__((ext_vector_type(8)))short;
using s16x4=__attribute__((ext_vector_type(4)))short;
using f32x16=__attribute__((ext_vector_type(16)))float;
using u32x4=__attribute__((ext_vector_type(4)))unsigned;
constexpr int BATCH=2,NHEAD=8,SEQ=16384,D=64,QP=1024,KP=512;
constexpr int NW=8,QBLK=32,QB=QBLK*NW,KVBLK=64,NQB=SEQ/QB;
constexpr int ATTN_UNIT_ROWS=QB;
__device__ __forceinline__ int crow(int r,int hi){return (r&3)+8*(r>>2)+4*hi;}
#define SBAR() __builtin_amdgcn_sched_barrier(0)
__device__ __forceinline__ void cmask(f32x16&p0,f32x16&p1,int jb,int qrel,int hi){
  const float NEG=-INFINITY; int kb=64*jb+4*hi;
  #pragma unroll
  for(int r=0;r<16;++r){int kv=kb+(r&3)+8*(r>>2); if(kv>qrel)p0[r]=NEG; if(kv+32>qrel)p1[r]=NEG;}
}

constexpr int NSLOT=3, SLOTB=8192;
constexpr int LDS_K=0, LDS_V=NSLOT*SLOTB, LDS_WS=2*NSLOT*SLOTB, LDS_OST=LDS_WS+NW*64*4, LDS_FB=LDS_OST+NW*4096, LDS_BYTES=LDS_FB+SEQ*4;
constexpr float C2=0.125f*1.4426950408889634f;
__device__ __forceinline__ void glds16(const void*gsrc,unsigned lds_dst){unsigned keep;
  asm volatile("s_mov_b32 %0, m0\n\ts_mov_b32 m0, %2\n\ts_nop 0\n\tglobal_load_lds_dwordx4 %1, off\n\ts_mov_b32 m0, %0":"=&s"(keep):"v"(gsrc),"s"(lds_dst):"memory");}
__device__ __forceinline__ float max3f(float a,float b,float c){float r;asm("v_max3_f32 %0, %1, %2, %3":"=v"(r):"v"(a),"v"(b),"v"(c));return r;}
__device__ __forceinline__ float max2f(float a,float b){float r;asm("v_max_f32_e32 %0, %1, %2":"=v"(r):"v"(a),"v"(b));return r;}
__device__ __forceinline__ float fadd_s(float a,float b){float r;asm("v_add_f32_e32 %0, %1, %2":"=v"(r):"v"(a),"v"(b));return r;}
__device__ __forceinline__ float fsub_s(float a,float b){float r;asm("v_sub_f32_e32 %0, %1, %2":"=v"(r):"v"(a),"v"(b));return r;}
typedef float f32x2_t __attribute__((ext_vector_type(2))); typedef __bf16 bf16x2_t __attribute__((ext_vector_type(2)));
__device__ __forceinline__ unsigned cvtpk_s(float lo,float hi){f32x2_t v={lo,hi};bf16x2_t b=__builtin_convertvector(v,bf16x2_t);return __builtin_bit_cast(unsigned,b);}
#define WAIT_BAR(N) asm volatile("s_waitcnt vmcnt(" #N ") lgkmcnt(0)\n\ts_barrier":::"memory")

__device__ __forceinline__ void qkt(f32x16&p0,f32x16&p1,const char*Kslot,const bf16x8*qr,int r32,int hi){
  const char*kb=Kslot+hi*1024+r32*16;
  #pragma unroll
  for(int d0=0;d0<4;++d0){
    const bf16x8 b0=*reinterpret_cast<const bf16x8*>(kb+d0*2048);
    const bf16x8 b1=*reinterpret_cast<const bf16x8*>(kb+d0*2048+512);
    p0=__builtin_amdgcn_mfma_f32_32x32x16_bf16(b0,qr[d0],p0,0,0,0);p1=__builtin_amdgcn_mfma_f32_32x32x16_bf16(b1,qr[d0],p1,0,0,0);}
}
typedef __attribute__((address_space(3))) const char* lds_cptr;
typedef short v4i16_t __attribute__((ext_vector_type(4)));
__device__ __forceinline__ void kload8(bf16x8*kf,lds_cptr kp){
  kf[0]=*(const __attribute__((address_space(3))) bf16x8*)(kp);      kf[1]=*(const __attribute__((address_space(3))) bf16x8*)(kp+512);
  kf[2]=*(const __attribute__((address_space(3))) bf16x8*)(kp+2048); kf[3]=*(const __attribute__((address_space(3))) bf16x8*)(kp+2560);
  kf[4]=*(const __attribute__((address_space(3))) bf16x8*)(kp+4096); kf[5]=*(const __attribute__((address_space(3))) bf16x8*)(kp+4608);
  kf[6]=*(const __attribute__((address_space(3))) bf16x8*)(kp+6144); kf[7]=*(const __attribute__((address_space(3))) bf16x8*)(kp+6656);
}
__device__ __forceinline__ void kload2(bf16x8*kf,lds_cptr kp,int j){ kf[2*j]=*(const __attribute__((address_space(3))) bf16x8*)(kp+j*2048); kf[2*j+1]=*(const __attribute__((address_space(3))) bf16x8*)(kp+j*2048+512); }
__device__ __forceinline__ s16x4 vtr(lds_cptr p){ return __builtin_bit_cast(s16x4,__builtin_amdgcn_ds_read_tr16_b64_v4i16((__attribute__((address_space(3))) v4i16_t*)p)); }
__device__ __forceinline__ float rowmax(const f32x16&p0,const f32x16&p1){
  float a=max3f(p0[0],p0[1],p1[0]),b=max3f(p0[2],p0[3],p1[1]);a=max3f(a,p1[2],p1[3]);
  #pragma unroll
  for(int r=4;r<16;r+=4){a=max3f(a,p0[r],p0[r+1]);b=max3f(b,p0[r+2],p0[r+3]);a=max3f(a,p1[r],p1[r+1]);b=max3f(b,p1[r+2],p1[r+3]);}
  const float m=max2f(a,b);
  auto rr=__builtin_amdgcn_permlane32_swap(__float_as_uint(m),__float_as_uint(m),false,false);
  return max2f(__uint_as_float(rr[0]),__uint_as_float(rr[1]));
}
__device__ __forceinline__ void pv(f32x16*o,int vb,bf16x8 pa0,bf16x8 pa1,bf16x8 pa2,bf16x8 pa3){
  #pragma unroll
  for(int d0=0;d0<2;++d0){s16x4 lo[4],hi[4];
    #pragma unroll
    for(int ks=0;ks<4;++ks){
      asm volatile("ds_read_b64_tr_b16 %0,%1 offset:%c2":"=&v"(lo[ks]):"v"(vb),"i"(d0*4096+ks*1024):"memory");
      asm volatile("ds_read_b64_tr_b16 %0,%1 offset:%c2":"=&v"(hi[ks]):"v"(vb),"i"(d0*4096+ks*1024+512):"memory");}
    asm volatile("s_waitcnt lgkmcnt(0)":::"memory");SBAR();
    #define PK(k) (bf16x8){lo[k][0],lo[k][1],lo[k][2],lo[k][3],hi[k][0],hi[k][1],hi[k][2],hi[k][3]}
    o[d0]=__builtin_amdgcn_mfma_f32_32x32x16_bf16(pa0,PK(0),o[d0],0,0,0);
    o[d0]=__builtin_amdgcn_mfma_f32_32x32x16_bf16(pa1,PK(1),o[d0],0,0,0);
    o[d0]=__builtin_amdgcn_mfma_f32_32x32x16_bf16(pa2,PK(2),o[d0],0,0,0);
    o[d0]=__builtin_amdgcn_mfma_f32_32x32x16_bf16(pa3,PK(3),o[d0],0,0,0);
    #undef PK
  }
}

#ifndef ATTN_STORE16
#define ATTN_STORE16(p,v) (*(u32x4*)(p)=(v))
#endif
template<int THRL> __device__ __forceinline__ void attn_unit(int b,int h,int qb,const bf16*Q,const bf16*__restrict__ K,const bf16*__restrict__ V,bf16*O,const float*__restrict__ Fg,char*shm){
  int tid_=threadIdx.x; asm volatile("":"+v"(tid_));
  const int tid=tid_,lane=tid&63,r32=lane&31,hi=lane>>5; const int wid=__builtin_amdgcn_readfirstlane(tid>>6);
  const long rowbase=(long)b*SEQ; const int q0=qb*QB;
  const bf16*Qw=Q+(rowbase+q0+wid*QBLK)*QP+h*D;
  const bf16*Kh=K+rowbase*KP+h*D,*Vh=V+rowbase*KP+h*D;
  __attribute__((address_space(3))) char* const shm3w=(__attribute__((address_space(3))) char*)shm;
  const unsigned lds0=(unsigned)(uintptr_t)shm;
  float*wsf=(float*)(shm+LDS_WS)+wid*64;
  const bf16*ksrc=Kh+(long)lane*KP+wid*8;
  const bf16*vsrc=Vh+(long)(16*(wid&3)+(lane>>2))*KP+(wid>>2)*32+(lane&3)*8;
  const unsigned kdst=lds0+LDS_K+wid*1024, vdst=lds0+LDS_V+wid*1024;
  #define DMA_K(t,slot) glds16(ksrc+(long)(t)*KVBLK*KP,(unsigned)__builtin_amdgcn_readfirstlane(kdst+(slot)))
  #define DMA_V(t,slot) glds16(vsrc+(long)(t)*KVBLK*KP,(unsigned)__builtin_amdgcn_readfirstlane(vdst+(slot)))
  const int vb0=(int)(lds0+LDS_V)+((lane>>4)&1)*32+(lane&3)*8+(4*hi+((lane&15)>>2))*64;
  const char*Kbase=shm+LDS_K; bf16x8 kf[8];
  const lds_cptr shm3=(lds_cptr)shm; const lds_cptr kp0=shm3+LDS_K+hi*1024+r32*16; const lds_cptr vp0=shm3+LDS_V+((lane>>4)&1)*32+(lane&3)*8+(4*hi+((lane&15)>>2))*64;
  const int NT=(q0+QB)/KVBLK;
  { typedef __attribute__((address_space(3))) float* lds_fptr; const lds_fptr fbl=(lds_fptr)(shm3w+LDS_FB); const float fref=Fg[q0];
    for(int i=tid;i<q0+QB;i+=NW*64) fbl[i]=(fref-Fg[i])*1.4426950408889634f; }
  DMA_K(0,0);DMA_V(0,0);DMA_K(1,SLOTB);
  bf16x8 qr[4];
  #pragma unroll
  for(int d0=0;d0<4;++d0)qr[d0]=*reinterpret_cast<const bf16x8*>(&Qw[(long)r32*QP+d0*16+hi*8]);
  float mhat=0.f,l_reg=0.f;f32x16 o[2];o[0]=f32x16{};o[1]=f32x16{};
  const lds_cptr fb0=(lds_cptr)shm3w+LDS_FB+hi*16;
  typedef float f32x4v __attribute__((ext_vector_type(4)));
  #define BLD(P0,P1,t) do{ const lds_cptr fp_=fb0+(t)*256; _Pragma("unroll") for(int j_=0;j_<4;++j_){ \
      const f32x4v a_=*(const __attribute__((address_space(3))) f32x4v*)(fp_+j_*32), b_=*(const __attribute__((address_space(3))) f32x4v*)(fp_+128+j_*32); \
      P0[4*j_]=a_[0];P0[4*j_+1]=a_[1];P0[4*j_+2]=a_[2];P0[4*j_+3]=a_[3]; P1[4*j_]=b_[0];P1[4*j_+1]=b_[1];P1[4*j_+2]=b_[2];P1[4*j_+3]=b_[3]; } }while(0)
  const int qrel=wid*QBLK+r32;
  #define CMASK(P0,P1,t) do{int jb_=(t)-(NT-4); if(jb_>=0)cmask(P0,P1,jb_,qrel,hi);}while(0)
  bool resc=false;
  #define START(P0,P1) do{ const float rm=rowmax(P0,P1); resc=false; mhat=rm; \
    _Pragma("unroll") for(int r=0;r<16;++r)P0[r]=__builtin_amdgcn_exp2f(P0[r]-mhat); }while(0)
  #define RESC() do{ if(resc){ asm volatile("s_waitcnt lgkmcnt(0)":::"memory"); \
      _Pragma("unroll") for(int d_=0;d_<2;++d_) _Pragma("unroll") for(int r=0;r<16;++r)o[d_][r]*=wsf[crow(r,hi)]; } }while(0)
  f32x16 pA0,pA1,pB0,pB1;
  int sl_prev=0,sl_cur=0,sl_next=SLOTB;
  #define ROT() do{sl_prev=sl_cur;sl_cur=sl_next;sl_next=(sl_next==(NSLOT-1)*SLOTB)?0:sl_next+SLOTB;}while(0)
  DMA_K(2,2*SLOTB);
  WAIT_BAR(3);
  BLD(pA0,pA1,0);
  qkt(pA0,pA1,Kbase,qr,r32,hi);asm volatile("s_nop 15\n\ts_nop 7":"+v"(pA0),"+v"(pA1));CMASK(pA0,pA1,0);
  START(pA0,pA1);
  _Pragma("unroll") for(int r=0;r<16;++r)pA1[r]=__builtin_amdgcn_exp2f(pA1[r]-mhat);
  WAIT_BAR(0);
  DMA_K(3,0);DMA_V(1,SLOTB);
  ROT();
  kload8(kf,kp0+sl_cur);
  BLD(pB0,pB1,1);
  WAIT_BAR(2);
  s16x4 vlo[8],vhi[8]; u32x4 pw0,pw1,pw2,pw3;
  #define PKW(P,B) cvtpk_s(P[B],P[B+1])
  #define PAF(k) __builtin_bit_cast(bf16x8,pw##k)
  #define VFR(i) (bf16x8){vlo[i][0],vlo[i][1],vlo[i][2],vlo[i][3],vhi[i][0],vhi[i][1],vhi[i][2],vhi[i][3]}
  #define PIN(x) asm volatile("":"+v"(x))
  #define MX3(a,b,c) __builtin_fmaxf(__builtin_fmaxf((a),(b)),(c))
  #define GAPA(MF,A0,A1,A2,A3,W0,W1,PW) do{ MF; sacc+=A0; sacc+=A1; sacc+=A2; sacc+=A3; PIN(sacc); W0; W1; PIN(PW); SBAR(); }while(0)
  #define EX(v) __builtin_amdgcn_exp2f(v)
  #define GAPB(MF,X,B) do{ MF; X[B]=EX(X[B]-mhat); X[B+1]=EX(X[B+1]-mhat); X[B+2]=EX(X[B+2]-mhat); X[B+3]=EX(X[B+3]-mhat); PIN(X); SBAR(); }while(0)
  #define VRD(i) do{ vlo[i]=vtr(vp_+(((i)>>2)*4096+((i)&3)*1024)); vhi[i]=vtr(vp_+(((i)>>2)*4096+((i)&3)*1024+512)); }while(0)
  #define KRD(G,j) do{ if(G){ kload2(kf,kp0+sl_next,j); SBAR(); } }while(0)
  #define STEP(C0,C1,P0,P1,t,GK,GV,GL) do{ SBAR(); \
    const lds_cptr vp_=vp0+sl_prev; \
    VRD(0); SBAR(); float sacc=(P0[0]+P0[1]); \
    GAPA(C0=__builtin_amdgcn_mfma_f32_32x32x16_bf16(kf[0],qr[0],C0,0,0,0), P0[2],P0[3],P0[4],P0[5],     pw0[0]=PKW(P0,0), pw0[1]=PKW(P0,2), pw0); \
    VRD(4); SBAR(); GAPA(C1=__builtin_amdgcn_mfma_f32_32x32x16_bf16(kf[1],qr[0],C1,0,0,0), P0[6],P0[7],P0[8],P0[9],     pw0[2]=PKW(P0,4), pw0[3]=PKW(P0,6), pw0); \
    VRD(1); SBAR(); GAPA(C0=__builtin_amdgcn_mfma_f32_32x32x16_bf16(kf[2],qr[1],C0,0,0,0),   P0[10],P0[11],P0[12],P0[13], pw1[0]=PKW(P0,8), pw1[1]=PKW(P0,10), pw1); \
    VRD(5); SBAR(); GAPA(C1=__builtin_amdgcn_mfma_f32_32x32x16_bf16(kf[3],qr[1],C1,0,0,0),   P0[14],P0[15],P1[0],P1[1],   pw1[2]=PKW(P0,12),pw1[3]=PKW(P0,14), pw1); \
    VRD(2); SBAR(); GAPA(C0=__builtin_amdgcn_mfma_f32_32x32x16_bf16(kf[4],qr[2],C0,0,0,0),   P1[2],P1[3],P1[4],P1[5],     pw2[0]=PKW(P1,0), pw2[1]=PKW(P1,2), pw2); \
    VRD(6); SBAR(); GAPA(C1=__builtin_amdgcn_mfma_f32_32x32x16_bf16(kf[5],qr[2],C1,0,0,0),   P1[6],P1[7],P1[8],P1[9],     pw2[2]=PKW(P1,4), pw2[3]=PKW(P1,6), pw2); \
    VRD(3); SBAR(); GAPA(C0=__builtin_amdgcn_mfma_f32_32x32x16_bf16(kf[6],qr[3],C0,0,0,0),   P1[10],P1[11],P1[12],P1[13], pw3[0]=PKW(P1,8), pw3[1]=PKW(P1,10), pw3); \
    VRD(7); SBAR(); GAPA(C1=__builtin_amdgcn_mfma_f32_32x32x16_bf16(kf[7],qr[3],C1,0,0,0),   P1[14],P1[15],0.f,0.f,       pw3[2]=PKW(P1,12),pw3[3]=PKW(P1,14), pw3); \
    l_reg+=sacc; \
    if(GK){DMA_K((t)+3,sl_cur);} if(GV){DMA_V((t)+1,sl_next);} \
    CMASK(C0,C1,t); \
    { float a=MX3(C0[0],C0[1],C1[0]),b=MX3(C0[2],C0[3],C1[1]); a=MX3(a,C1[2],C1[3]); \
      _Pragma("unroll") for(int r=4;r<16;r+=4){a=MX3(a,C0[r],C0[r+1]);b=MX3(b,C0[r+2],C0[r+3]);a=MX3(a,C1[r],C1[r+1]);b=MX3(b,C1[r+2],C1[r+3]);} \
      float rm=__builtin_fmaxf(a,b); { auto rr=__builtin_amdgcn_permlane32_swap(__float_as_uint(rm),__float_as_uint(rm),false,false); rm=__builtin_fmaxf(__uint_as_float(rr[0]),__uint_as_float(rr[1])); } \
      rm-=mhat; resc=false; \
      if(__builtin_expect(__any(rm>(float)THRL),0)){ const float dl=__builtin_fmaxf(rm,0.f); mhat+=dl; \
        const float f=__builtin_amdgcn_exp2f(-dl); l_reg*=f; if(hi==0)wsf[r32]=f; resc=true; } } \
    SBAR(); if(GL){ BLD(P0,P1,(t)+1); } \
    SBAR(); \
    GAPB(o[0]=__builtin_amdgcn_mfma_f32_32x32x16_bf16(PAF(0),VFR(0),o[0],0,0,0), C0,0); \
    GAPB(o[1]=__builtin_amdgcn_mfma_f32_32x32x16_bf16(PAF(0),VFR(4),o[1],0,0,0), C0,4); \
    KRD(GL,0); GAPB(o[0]=__builtin_amdgcn_mfma_f32_32x32x16_bf16(PAF(1),VFR(1),o[0],0,0,0), C0,8); \
    KRD(GL,1); GAPB(o[1]=__builtin_amdgcn_mfma_f32_32x32x16_bf16(PAF(1),VFR(5),o[1],0,0,0), C0,12); \
    KRD(GL,2); GAPB(o[0]=__builtin_amdgcn_mfma_f32_32x32x16_bf16(PAF(2),VFR(2),o[0],0,0,0), C1,0); \
    KRD(GL,3); GAPB(o[1]=__builtin_amdgcn_mfma_f32_32x32x16_bf16(PAF(2),VFR(6),o[1],0,0,0), C1,4); \
    GAPB(o[0]=__builtin_amdgcn_mfma_f32_32x32x16_bf16(PAF(3),VFR(3),o[0],0,0,0), C1,8); \
    GAPB(o[1]=__builtin_amdgcn_mfma_f32_32x32x16_bf16(PAF(3),VFR(7),o[1],0,0,0), C1,12); \
    }while(0)
  int t=1;
  #undef CMASK
  #define CMASK(P0,P1,t) do{}while(0)
  for(;t+5<NT;t+=2){
    STEP(pB0,pB1,pA0,pA1,t,true,true,true);     WAIT_BAR(2); RESC(); ROT();
    STEP(pA0,pA1,pB0,pB1,t+1,true,true,true);   WAIT_BAR(2); RESC(); ROT();
  }
  #undef CMASK
  #define CMASK(P0,P1,t) do{int jb_=(t)-(NT-4); if(jb_>=0)cmask(P0,P1,jb_,qrel,hi);}while(0)
  #define ENDW(tt) do{ if((tt)+3<NT){WAIT_BAR(2);} else if((tt)+2<NT){WAIT_BAR(1);} else {WAIT_BAR(0);} }while(0)
  for(;t+1<NT;t+=2){
    STEP(pB0,pB1,pA0,pA1,t,(t+3<NT),(t+1<NT),(t+1<NT));       ENDW(t);   RESC(); ROT();
    STEP(pA0,pA1,pB0,pB1,t+1,(t+4<NT),(t+2<NT),(t+2<NT));     ENDW(t+1); RESC(); ROT();
  }
  STEP(pB0,pB1,pA0,pA1,NT-1,false,false,false); RESC();
  { float sacc=pB0[0]+pB0[1]; _Pragma("unroll") for(int r=2;r<16;++r)sacc+=pB0[r]; _Pragma("unroll") for(int r=0;r<16;++r)sacc+=pB1[r]; l_reg+=sacc;
    pw0=(u32x4){PKW(pB0,0),PKW(pB0,2),PKW(pB0,4),PKW(pB0,6)};pw1=(u32x4){PKW(pB0,8),PKW(pB0,10),PKW(pB0,12),PKW(pB0,14)};pw2=(u32x4){PKW(pB1,0),PKW(pB1,2),PKW(pB1,4),PKW(pB1,6)};pw3=(u32x4){PKW(pB1,8),PKW(pB1,10),PKW(pB1,12),PKW(pB1,14)};
    SBAR(); pv(o,vb0+sl_cur,PAF(0),PAF(1),PAF(2),PAF(3)); }
  #undef PKW
  #undef PAF
  #undef VFR
  #undef PIN
  #undef MX3
  #undef GAPA
  #undef GAPB
  #undef EX
  #undef VRD
  #undef KRD
  #undef STEP
  #undef ENDW
  {auto rr=__builtin_amdgcn_permlane32_swap(__float_as_uint(l_reg),__float_as_uint(l_reg),false,false);l_reg=__uint_as_float(rr[0])+__uint_as_float(rr[1]);}
  if(hi==0)wsf[32+r32]=l_reg;asm volatile("s_waitcnt lgkmcnt(0)":::"memory");
  float rli[16];
  #pragma unroll
  for(int r=0;r<16;++r)rli[r]=__builtin_amdgcn_rcpf(wsf[32+crow(r,hi)]);
  bf16*Ow=O+(rowbase+q0+wid*QBLK)*QP+h*D;
  { bf16*stg=(bf16*)(shm+LDS_OST)+wid*2048;
    #pragma unroll
    for(int r=0;r<16;++r){const int orow=crow(r,hi);
      #pragma unroll
      for(int d0=0;d0<2;++d0)stg[orow*64+d0*32+r32]=__float2bfloat16(o[d0][r]*rli[r]);}
    asm volatile("s_waitcnt lgkmcnt(0)":::"memory");
    #pragma unroll
    for(int i=0;i<4;++i){const int row=i*8+(lane>>3),ch=lane&7; const u32x4 v=*(const u32x4*)(stg+row*64+ch*8); ATTN_STORE16(Ow+(long)row*QP+ch*8,v);} }
  asm volatile("s_waitcnt lgkmcnt(0)\n\ts_barrier":::"memory");
  #undef DMA_K
  #undef DMA_V
  #undef CMASK
  #undef START
  #undef RESC
  #undef BLD
  #undef ROT
}
constexpr int ATTN_LDS_BYTES=LDS_BYTES;
struct AttnTensors { const bf16* Q; const bf16* K; const bf16* V; bf16* O; const float* F; };
struct AttnUnit { int bh; int qb; };
struct StaticOrder {
  int vcu,G;
  __device__ __forceinline__ explicit StaticOrder(int grid,int block):vcu((grid%8==0)?(block%8)*(grid/8)+block/8:block),G(grid){}
  __device__ __forceinline__ bool next(int i,AttnUnit&u)const{ const int L=i*G+vcu; if(L>=1024)return false; const int rd=L>>8,v=L&255,s=v&15; u.bh=v>>4; u.qb=(rd==0)?s:(rd==1)?31-s:(rd==2)?32+s:63-s; return true; }
  __device__ __forceinline__ void a_ready(const AttnUnit&)const{}
  __device__ __forceinline__ void done(const AttnUnit&)const{}
};
template<class Sched,int THRL=8> __device__ __forceinline__ void attn_phase(char*lds,const AttnTensors&T,const Sched&S){
  AttnUnit u;
  for(int i=0;S.next(i,u);++i){ S.a_ready(u); attn_unit<THRL>(u.bh/NHEAD,u.bh%NHEAD,u.qb,T.Q,T.K,T.V,T.O,T.F+(long)u.bh*SEQ,lds); S.done(u); }
}
#undef SBAR
#undef WAIT_BAR
}
#include <hip/hip_cooperative_groups.h>
namespace cg = cooperative_groups;
#define LAS __attribute__((address_space(3)))
typedef unsigned short bf16;
typedef unsigned v4u __attribute__((ext_vector_type(4)));
typedef float f32x4 __attribute__((ext_vector_type(4)));
typedef short bf16x8 __attribute__((ext_vector_type(8)));
typedef LAS unsigned char* lp;

#define XB_TMO      128
#define XB_XCNT(j)  (256  + 64 * (j))
#define XB_XSUB(j)  (1280 + 64 * (j))
#define XB_XGEN(j)  (2304 + 64 * (j))
#define XB_TOP      3328
#define XB_TOPGEN   3392
#define XCD_BAR_WORDS 3456
#define XB_SPIN_CAP (1u << 18)

__device__ __forceinline__ unsigned xb_ld(unsigned* p)              { return __hip_atomic_load(p, __ATOMIC_RELAXED, __HIP_MEMORY_SCOPE_AGENT); }
__device__ __forceinline__ unsigned xb_add(unsigned* p, unsigned v) { return __hip_atomic_fetch_add(p, v, __ATOMIC_RELAXED, __HIP_MEMORY_SCOPE_AGENT); }
__device__ __forceinline__ unsigned xb_xcc_id() { return (unsigned)__builtin_amdgcn_s_getreg((3 << 11) | 20) & 0xFu; }
#define XB_SPIN(cond, bar) do { unsigned _sp = 0; while (cond) { __builtin_amdgcn_s_sleep(1); \
    if ((++_sp & 255u) == 0u) { if (xb_ld(&(bar)[XB_TMO])) break; if (_sp > XB_SPIN_CAP) { atomicAdd(&(bar)[XB_TMO], 1u); break; } } } } while (0)

struct XcdBarrier {
    unsigned* bar; unsigned x;
    volatile LAS unsigned* st;
};

__device__ __forceinline__ XcdBarrier xcd_barrier_post(unsigned* bar, volatile LAS unsigned* st) {
    XcdBarrier b; b.bar = bar; b.x = xb_xcc_id(); b.st = st;
    if (threadIdx.x == 0) (void)xb_add(&bar[XB_XCNT(b.x)], 1u);
    return b;
}
__device__ __forceinline__ void xcd_barrier_complete(unsigned* bar, unsigned x, unsigned& nloc, unsigned& nx) {
    const unsigned G = gridDim.x * gridDim.y * gridDim.z;
    unsigned sum, cnt, mine, sp = 0u;
    for (;;) {
        sum = 0u; cnt = 0u; mine = 0u;
#pragma unroll
        for (unsigned j = 0; j < 16; ++j) { const unsigned c = xb_ld(&bar[XB_XCNT(j)]); sum += c; cnt += (c > 0u) ? 1u : 0u; mine = (j == x) ? c : mine; }
        if (sum == G) break;
        __builtin_amdgcn_s_sleep(1);
        if ((++sp & 255u) == 0u) { if (xb_ld(&bar[XB_TMO])) break; if (sp > XB_SPIN_CAP) { atomicAdd(&bar[XB_TMO], 1u); break; } }
    }
    nloc = mine > 0u ? mine : 1u; nx = cnt > 0u ? cnt : 1u;
}

__device__ __forceinline__ void xcd_barrier(const XcdBarrier& b) {
    asm volatile("s_waitcnt vmcnt(0)" ::: "memory");
    __syncthreads();
    if (threadIdx.x == 0) {
        unsigned* bar = b.bar;
        __builtin_amdgcn_s_waitcnt(0);
        unsigned nloc = b.st[0], nx = b.st[1];
        if (nloc == 0u) { xcd_barrier_complete(bar, b.x, nloc, nx); b.st[0] = nloc; b.st[1] = nx; }
        const unsigned old = xb_add(&bar[XB_XSUB(b.x)], 1u);
        const unsigned gen = old / nloc;
        if (old + 1u == (gen + 1u) * nloc) {
            __builtin_amdgcn_fence(__ATOMIC_RELEASE, "agent");
            asm volatile("s_waitcnt vmcnt(0)" ::: "memory");
            const unsigned og = xb_add(&bar[XB_TOP], 1u);
            const unsigned tg = og / nx;
            if (og + 1u == (tg + 1u) * nx) xb_add(&bar[XB_TOPGEN], 1u);
            else XB_SPIN(xb_ld(&bar[XB_TOPGEN]) == tg, bar);
            __builtin_amdgcn_fence(__ATOMIC_ACQUIRE, "agent");
            xb_add(&bar[XB_XGEN(b.x)], 1u);
            asm volatile("s_waitcnt vmcnt(0)" ::: "memory");
        } else {
            XB_SPIN(xb_ld(&bar[XB_XGEN(b.x)]) == gen, bar);
            __builtin_amdgcn_fence(__ATOMIC_ACQUIRE, "agent");
            asm volatile("s_waitcnt vmcnt(0)" ::: "memory");
        }
    }
    __syncthreads();
}


constexpr int NWAVES = 8, NTHR = 512;
constexpr int BATCH = 2, SEQ = 16384, D = 1024, M = BATCH * SEQ, DEPTH = 2;
constexpr int NIN = 5640, NP1 = 3584, NG = 2048, FFH = 2816, NF1 = 5632;
constexpr float ALPHA = 1.4142135623730951f;
constexpr float LN_EPS = 1e-5f, RMS_EPS = 1e-6f;
constexpr size_t MiB = 1u << 20;
constexpr size_t WL_IN = 0, WL_G = 7 * MiB, WL_M = 11 * MiB, WL_O = 15 * MiB, WL_F1 = 17 * MiB, WL_F2 = 28 * MiB, WL_STRIDE = 34 * MiB;
constexpr size_t WS_W = 0, WS_XN = 68 * MiB, WS_QAB = 132 * MiB, WS_KA = 196 * MiB, WS_VA = 228 * MiB, WS_G = 260 * MiB, WS_IB = 324 * MiB, WS_GB = 356 * MiB,
                 WS_ST = 388 * MiB, WS_DEC = 452 * MiB, WS_LF = 453 * MiB, WS_F = 454 * MiB, WS_CTL = 455 * MiB  , WS_DBG = 455 * MiB + 512 * 1024, WS_END = 456 * MiB;
constexpr size_t WS_GATES = WS_G  , WS_MERGED = WS_KA  , WS_H = WS_QAB  ;
constexpr int LDS_TOTAL = 155648;
static_assert(attn_body::LDS_BYTES <= LDS_TOTAL && pg8::STAGE_BYTES <= LDS_TOTAL, "LDS map");

__device__ __forceinline__ float wave_sum(float v) {
#pragma unroll
    for (int o = 1; o < 64; o <<= 1) v += __shfl_xor(v, o);
    return v;
}
__device__ __forceinline__ unsigned pk2(float lo, float hi) { return pg8::cvt_pk_bf16(lo, hi); }
__device__ __forceinline__ float bf2f(unsigned short h) { return __uint_as_float((unsigned)h << 16); }

__device__ __forceinline__ void transpose_item(const float* Wsrc, int pitch, bf16* WTdst, int Kdst, LAS float* scr, int lane, bool zero) {
    if (!zero) {
#pragma unroll 8
        for (int i = 0; i < 32; ++i) { const int kk = 2 * i + (lane >> 5); scr[kk * 33 + (lane & 31)] = Wsrc[(size_t)kk * pitch + (lane & 31)]; }
    }
    asm volatile("s_waitcnt lgkmcnt(0)" ::: "memory");
    const int c = lane & 7;
#pragma unroll
    for (int j = 0; j < 4; ++j) { const int n = (lane >> 3) + 8 * j; const LAS float* s = scr + (8 * c) * 33 + n;
        v4u o;
        if (zero) { o = (v4u){0u, 0u, 0u, 0u}; }
        else { o.x = pk2(s[0 * 33], s[1 * 33]); o.y = pk2(s[2 * 33], s[3 * 33]); o.z = pk2(s[4 * 33], s[5 * 33]); o.w = pk2(s[6 * 33], s[7 * 33]); }
        *(v4u*)(WTdst + (size_t)n * Kdst + 8 * c) = o; }
    asm volatile("s_waitcnt lgkmcnt(0)" ::: "memory");
}

struct Ptrs {
    const float *x, *w_in, *b_fgate, *lb_logits, *norm_g, *w_pa, *w_pb, *w_o, *ln1_g, *ln1_b, *w_ff_in, *w_ff_out, *ln2_g, *ln2_b;
    float* out; unsigned char* ws;
};

__device__ __forceinline__ void weight_items(const Ptrs& P, LAS float* scr, int gw, int NGW, int lane) {
    constexpr int I_IN = 16 * (NP1 / 32), I_G = 16 * (NG / 32), I_M = 16 * (2048 / 32), I_O = 16 * 32, I_F1 = 16 * (NF1 / 32), I_F2 = (FFH / 64) * 32;
    constexpr int PER_LAYER = I_IN + I_G + I_M + I_O + I_F1 + I_F2;
    for (int it = gw; it < DEPTH * PER_LAYER; it += NGW) {
        const int l = it / PER_LAYER; int r = it % PER_LAYER;
        bf16* WB = (bf16*)(P.ws + WS_W + (size_t)l * WL_STRIDE);
        if (r < I_IN) { const int nblk = NP1 / 32, kb = r / nblk, nb = r % nblk, k0 = 64 * kb, n0 = 32 * nb; const int sc = n0 < 1536 ? n0 : n0 + 8;
            transpose_item(P.w_in + (size_t)l * D * NIN + (size_t)k0 * NIN + sc, NIN, (bf16*)((unsigned char*)WB + WL_IN) + (size_t)n0 * 1024 + k0, 1024, scr, lane, false); continue; } r -= I_IN;
        if (r < I_G) { const int nblk = NG / 32, kb = r / nblk, nb = r % nblk, k0 = 64 * kb, n0 = 32 * nb;
            transpose_item(P.w_in + (size_t)l * D * NIN + (size_t)k0 * NIN + 3592 + n0, NIN, (bf16*)((unsigned char*)WB + WL_G) + (size_t)n0 * 1024 + k0, 1024, scr, lane, false); continue; } r -= I_G;
        if (r < I_M) { const int nblk = 64, kb = r / nblk, nb = r % nblk, k0 = 64 * kb, n0 = 32 * nb; const int tile = n0 >> 8, half = (n0 >> 7) & 1, col = 128 * tile + (n0 & 127);
            const bool lowk = kb < 8; const bool zero = lowk ? (half != 0) : (half != 1);
            const float* src = lowk ? P.w_pa + (size_t)l * 512 * 1024 + (size_t)k0 * 1024 + col : P.w_pb + (size_t)l * 512 * 1024 + (size_t)(k0 - 512) * 1024 + col;
            transpose_item(src, 1024, (bf16*)((unsigned char*)WB + WL_M) + (size_t)n0 * 1024 + k0, 1024, scr, lane, zero); continue; } r -= I_M;
        if (r < I_O) { const int nblk = 32, kb = r / nblk, nb = r % nblk, k0 = 64 * kb, n0 = 32 * nb;
            transpose_item(P.w_o + (size_t)l * 1024 * 1024 + (size_t)k0 * 1024 + n0, 1024, (bf16*)((unsigned char*)WB + WL_O) + (size_t)n0 * 1024 + k0, 1024, scr, lane, false); continue; } r -= I_O;
        if (r < I_F1) { const int nblk = NF1 / 32, kb = r / nblk, nb = r % nblk, k0 = 64 * kb, n0 = 32 * nb; const int tile = n0 >> 8, half = (n0 >> 7) & 1, col = half * FFH + 128 * tile + (n0 & 127);
            transpose_item(P.w_ff_in + (size_t)l * D * NF1 + (size_t)k0 * NF1 + col, NF1, (bf16*)((unsigned char*)WB + WL_F1) + (size_t)n0 * 1024 + k0, 1024, scr, lane, false); continue; } r -= I_F1;
        { const int nblk = 32, kb = r / nblk, nb = r % nblk, k0 = 64 * kb, n0 = 32 * nb;
            transpose_item(P.w_ff_out + (size_t)l * FFH * 1024 + (size_t)k0 * 1024 + n0, 1024, (bf16*)((unsigned char*)WB + WL_F2) + (size_t)n0 * FFH + k0, FFH, scr, lane, false); }
    }
}

__device__ __forceinline__ void stage_wfa(const float* w_in_l, LAS float* wfa, int tid) {
    for (int idx = tid; idx < 8192; idx += NTHR) { const int k = idx >> 3, col = idx & 7; const int j = k >> 8, ln = (k >> 2) & 63, i = k & 3, half = col >> 2, c = col & 3;
        wfa[((((j * 4 + i) * 2 + half) * 64) + ln) * 4 + c] = w_in_l[(size_t)k * NIN + 1536 + col]; }
}
template <bool DO_LN, bool W32, bool WBF, bool DO_FA>
__device__ __forceinline__ void row_pass(const float* src, float* dst32, bf16* dstbf, const float* gam, const float* bet, float* lf, const LAS float* wfa, const float* bfg, int gw, int NGW, int lane) {
    for (int m = gw; m < M; m += NGW) {
        const f32x4* xr = (const f32x4*)(src + (size_t)m * D) + lane;
        f32x4 v[4];
#pragma unroll
        for (int j = 0; j < 4; ++j) v[j] = xr[64 * j];
        if (DO_LN) {
            float s = 0.f;
#pragma unroll
            for (int j = 0; j < 4; ++j) s += (v[j].x + v[j].y) + (v[j].z + v[j].w);
            const float mean = wave_sum(s) * (1.f / D); float s2 = 0.f;
#pragma unroll
            for (int j = 0; j < 4; ++j) { v[j] = v[j] - mean; s2 += (v[j].x * v[j].x + v[j].y * v[j].y) + (v[j].z * v[j].z + v[j].w * v[j].w); }
            const float rstd = 1.f / sqrtf(wave_sum(s2) * (1.f / D) + LN_EPS);
#pragma unroll
            for (int j = 0; j < 4; ++j) { const f32x4 gv = ((const f32x4*)gam)[64 * j + lane], bv = ((const f32x4*)bet)[64 * j + lane]; v[j] = v[j] * rstd * gv + bv; }
        }
        if (W32) { f32x4* o = (f32x4*)(dst32 + (size_t)m * D) + lane;
#pragma unroll
            for (int j = 0; j < 4; ++j) {
#ifdef DBG_SANITIZE
                if (!WBF) { for (int i = 0; i < 4; ++i) if (!(fabsf(v[j][i]) < 1e30f)) v[j][i] = 0.f; }
#endif
                o[64 * j] = v[j]; } }
        if (WBF) { unsigned long long* o8 = (unsigned long long*)(dstbf + (size_t)m * D) + lane;
#pragma unroll
            for (int j = 0; j < 4; ++j) o8[64 * j] = (unsigned long long)pk2(v[j].x, v[j].y) | ((unsigned long long)pk2(v[j].z, v[j].w) << 32); }
        if (DO_FA) {
            float a[8];
#pragma unroll
            for (int c = 0; c < 8; ++c) a[c] = 0.f;
#pragma unroll
            for (int j = 0; j < 4; ++j)
#pragma unroll
                for (int i = 0; i < 4; ++i) { const float xv = v[j][i];
                    const f32x4 w0 = *(const LAS f32x4*)(wfa + ((((j * 4 + i) * 2 + 0) * 64) + lane) * 4), w1 = *(const LAS f32x4*)(wfa + ((((j * 4 + i) * 2 + 1) * 64) + lane) * 4);
                    a[0] += xv * w0.x; a[1] += xv * w0.y; a[2] += xv * w0.z; a[3] += xv * w0.w; a[4] += xv * w1.x; a[5] += xv * w1.y; a[6] += xv * w1.z; a[7] += xv * w1.w; }
#pragma unroll
            for (int c = 0; c < 8; ++c) a[c] = wave_sum(a[c]);
            float z = a[0];
#pragma unroll
            for (int c = 1; c < 8; ++c) z = (lane == c) ? a[c] : z;
            if (lane < 8) { z += bfg[lane]; const float ls = fminf(z, 0.f) - __logf(1.0f + __expf(-fabsf(z))); lf[(size_t)m * 8 + lane] = ls; }
        }
    }
}

__device__ __forceinline__ void fcumsum_unit(int bh, const float* LF, float* F, lp lds, int tid) {
    const int b = bh >> 3, h = bh & 7, lane = tid & 63, wave = tid >> 6;
    const float* src = LF + ((size_t)b * SEQ + (size_t)tid * 32) * 8 + h;
    float cs[32]; float run = 0.f;
#pragma unroll
    for (int i = 0; i < 32; ++i) { run += src[i * 8]; cs[i] = run; }
    float inc = run;
#pragma unroll
    for (int o = 1; o < 64; o <<= 1) { const float n = __shfl_up(inc, o); if (lane >= o) inc += n; }
    LAS float* WS = (LAS float*)lds;
    if (lane == 63) WS[wave] = inc;
    __syncthreads();
    float woff = 0.f;
    for (int w = 0; w < wave; ++w) woff += WS[w];
    const float excl = woff + inc - run;
    float* dst = F + (size_t)bh * SEQ + (size_t)tid * 32;
#pragma unroll
    for (int i = 0; i < 32; i += 4) *(f32x4*)(dst + i) = (f32x4){excl + cs[i], excl + cs[i + 1], excl + cs[i + 2], excl + cs[i + 3]};
    __syncthreads();
}

namespace hg {
constexpr int P128 = 136, P64 = 72;
constexpr int O_QP = 0, O_QPP = O_QP + 64 * P128 * 2, O_KP = O_QPP + 64 * P128 * 2, O_VT = O_KP + 64 * P128 * 2, O_ST = O_VT + 128 * P64 * 2, O_PM = O_ST + 128 * P128 * 2,
              O_PT = O_PM + 64 * P64 * 2, O_RS = O_PT + 2048, O_END = O_RS + 512;
constexpr int O_KDT = O_QP;
static_assert(O_END <= 131072 && 128 * P64 * 2 <= 2 * 64 * P128 * 2, "hgrn LDS map");

__device__ __forceinline__ void load_cumsum(const float* Gu, int d, int part, lp lds, float (&g)[16], float (&b)[16], float& bmid, float& blast) {
#pragma unroll
    for (int i = 0; i < 16; ++i) g[i] = Gu[(size_t)(part * 16 + i) * 512 + d];
    float run = 0.f;
#pragma unroll
    for (int i = 0; i < 16; ++i) { run += g[i]; b[i] = run; }
    LAS float* PT = (LAS float*)(lds + O_PT);
    PT[part * 128 + d] = run;
    __syncthreads();
    const float p0 = PT[d], p1 = PT[128 + d], p2 = PT[256 + d], p3 = PT[384 + d];
    const float off = (part > 0 ? p0 : 0.f) + (part > 1 ? p1 : 0.f) + (part > 2 ? p2 : 0.f);
#pragma unroll
    for (int i = 0; i < 16; ++i) b[i] += off;
    bmid = p0 + p1; blast = (p0 + p1) + (p2 + p3);
}
__device__ __forceinline__ void stage_vt(const bf16* vp  , lp lds, int e, int part) {
    unsigned w[8];
#pragma unroll
    for (int i = 0; i < 8; ++i) { const unsigned lo = vp[(size_t)(2 * i) * 512], hi = vp[(size_t)(2 * i + 1) * 512]; w[i] = lo | (hi << 16); }
    LAS v4u* dst = (LAS v4u*)(lds + O_VT + (e * P64 + part * 16) * 2);
    dst[0] = (v4u){w[0], w[1], w[2], w[3]}; dst[1] = (v4u){w[4], w[5], w[6], w[7]};
}
__device__ __forceinline__ void pass1_unit(int unit, const float* G, const bf16* IB, bf16* ST, float* DEC, lp lds, int tid, unsigned* dbgw = nullptr) {
    const int c = unit & 255, h = (unit >> 8) & 3, b = unit >> 10;
    const int d = tid & 127, part = tid >> 7, lane = tid & 63, wave = tid >> 6, fr = lane & 15, fq = lane >> 4;
    const size_t row0 = (size_t)b * SEQ + (size_t)c * 64;
    float g[16], bb[16], bmid, blast;
    load_cumsum(G + row0 * 512 + h * 128, d, part, lds, g, bb, bmid, blast);
#ifdef DBG_P1
    { bool b1 = false, b3 = false; for (int i = 0; i < 16; ++i) { if (g[i] > 0.f) b1 = true; const float kk = (1.0f - __expf(g[i])) * __expf(blast - bb[i]); if (!(fabsf(kk) < 1e30f)) b3 = true; }
      if (b1) atomicMin(dbgw, 51u); if (b3) atomicMin(dbgw, 53u); }
#endif
    { unsigned w[8];
#pragma unroll
      for (int i = 0; i < 8; ++i) { const float k0 = (1.0f - __expf(g[2 * i])) * __expf(blast - bb[2 * i]), k1 = (1.0f - __expf(g[2 * i + 1])) * __expf(blast - bb[2 * i + 1]); w[i] = pk2(k0, k1); }
      LAS v4u* dst = (LAS v4u*)(lds + O_KDT + (d * P64 + part * 16) * 2);
      dst[0] = (v4u){w[0], w[1], w[2], w[3]}; dst[1] = (v4u){w[4], w[5], w[6], w[7]}; }
    stage_vt(IB + (row0 + part * 16) * 512 + h * 128 + d, lds, d, part);
    if (part == 0) DEC[(size_t)unit * 128 + d] = __expf(blast);
    __syncthreads();
    const bf16x8 a0 = *(const LAS bf16x8*)(lds + O_VT + ((16 * wave + fr) * P64 + 8 * fq) * 2), a1 = *(const LAS bf16x8*)(lds + O_VT + ((16 * wave + fr) * P64 + 32 + 8 * fq) * 2);
    bf16* out = ST + (size_t)unit * 16384;
#pragma unroll
    for (int dt = 0; dt < 8; ++dt) {
        const bf16x8 b0 = *(const LAS bf16x8*)(lds + O_KDT + ((16 * dt + fr) * P64 + 8 * fq) * 2), b1 = *(const LAS bf16x8*)(lds + O_KDT + ((16 * dt + fr) * P64 + 32 + 8 * fq) * 2);
        f32x4 acc = (f32x4){0.f, 0.f, 0.f, 0.f};
        acc = __builtin_amdgcn_mfma_f32_16x16x32_bf16(a0, b0, acc, 0, 0, 0);
        acc = __builtin_amdgcn_mfma_f32_16x16x32_bf16(a1, b1, acc, 0, 0, 0);
#ifdef DBG_P1
        for (int r = 0; r < 4; ++r) if (!(fabsf(acc[r]) < 1e30f)) atomicMin(dbgw, 54u);
#endif
#pragma unroll
        for (int r = 0; r < 4; ++r) out[(16 * wave + 4 * fq + r) * 128 + 16 * dt + fr] = (bf16)(pk2(acc[r], 0.f) & 0xffffu);
    }
    __syncthreads();
}
__device__ __forceinline__ void pass2_scan(bf16* ST, const float* DEC, int gtid, int gthreads) {
    for (int id = gtid; id < 8 * 16384; id += gthreads) {
        const int bh = id >> 14, ed = id & 16383, d = ed & 127;
        bf16* p = ST + (size_t)bh * 256 * 16384 + ed; const float* dp = DEC + (size_t)bh * 256 * 128 + d;
        float state = 0.f;
        for (int c = 0; c < 256; c += 16) {
            unsigned short u[16]; float dc[16];
#pragma unroll
            for (int i = 0; i < 16; ++i) { u[i] = p[(size_t)(c + i) * 16384]; dc[i] = dp[(size_t)(c + i) * 128]; }
#pragma unroll
            for (int i = 0; i < 16; ++i) { p[(size_t)(c + i) * 16384] = (bf16)(pk2(state, 0.f) & 0xffffu); state = dc[i] * state + bf2f(u[i]); }
        }
    }
}
__device__ __forceinline__ void pass3_unit(int unit, const float* G, const bf16* IB, const bf16* GB, const bf16* ST, bf16* QAB, const float* normg, lp lds, int tid) {
    const int c = unit & 255, h = (unit >> 8) & 3, b = unit >> 10;
    const int d = tid & 127, part = tid >> 7, lane = tid & 63, wave = tid >> 6, fr = lane & 15, fq = lane >> 4;
    const size_t row0 = (size_t)b * SEQ + (size_t)c * 64;
    { const bf16* sp = ST + (size_t)unit * 16384;
#pragma unroll
      for (int ps = 0; ps < 4; ++ps) { const int idx = ps * NTHR + tid, e = idx >> 4, d8 = (idx & 15) * 8; const v4u w = *(const v4u*)(sp + e * 128 + d8); *(LAS v4u*)(lds + O_ST + (e * P128 + d8) * 2) = w; } }
    float g[16], bb[16], bmid, blast;
    load_cumsum(G + row0 * 512 + h * 128, d, part, lds, g, bb, bmid, blast);
    { const bf16* qp = QAB + (row0 + part * 16) * 1024 + 512 + h * 128 + d; const float emid = __expf(bmid);
      LAS bf16* Qp = (LAS bf16*)(lds + O_QP), *Qpp = (LAS bf16*)(lds + O_QPP), *Kp = (LAS bf16*)(lds + O_KP);
#pragma unroll
      for (int i = 0; i < 16; ++i) { const float q = bf2f(qp[(size_t)i * 1024]); const float q1 = q * __expf(bb[i] - bmid), q2 = q1 * emid, k1 = (1.0f - __expf(g[i])) * __expf(bmid - bb[i]);
          const int t = part * 16 + i; const unsigned w = pk2(q1, q2), w2 = pk2(k1, 0.f);
          Qp[t * P128 + d] = (bf16)(w & 0xffffu); Qpp[t * P128 + d] = (bf16)(w >> 16); Kp[t * P128 + d] = (bf16)(w2 & 0xffffu); } }
    stage_vt(IB + (row0 + part * 16) * 512 + h * 128 + d, lds, d, part);
    __syncthreads();
    { const int ti = wave >> 1; LAS bf16* Pm = (LAS bf16*)(lds + O_PM);
#pragma unroll
      for (int sj2 = 0; sj2 < 2; ++sj2) { const int sj = 2 * (wave & 1) + sj2; f32x4 acc = (f32x4){0.f, 0.f, 0.f, 0.f};
#pragma unroll
          for (int ks = 0; ks < 4; ++ks) { const bf16x8 a = *(const LAS bf16x8*)(lds + O_QP + ((16 * ti + fr) * P128 + 32 * ks + 8 * fq) * 2), bq = *(const LAS bf16x8*)(lds + O_KP + ((16 * sj + fr) * P128 + 32 * ks + 8 * fq) * 2);
              acc = __builtin_amdgcn_mfma_f32_16x16x32_bf16(a, bq, acc, 0, 0, 0); }
#pragma unroll
          for (int r = 0; r < 4; ++r) { const int t = 16 * ti + 4 * fq + r, s = 16 * sj + fr; const float v = (s <= t) ? acc[r] : 0.f; Pm[t * P64 + s] = (bf16)(pk2(v, 0.f) & 0xffffu); } } }
    __syncthreads();
    const int rb = wave & 3, ch = wave >> 2;
    f32x4 o[4];
#pragma unroll
    for (int j = 0; j < 4; ++j) o[j] = (f32x4){0.f, 0.f, 0.f, 0.f};
    { bf16x8 ap[2], aq[4];
#pragma unroll
      for (int ks = 0; ks < 2; ++ks) ap[ks] = *(const LAS bf16x8*)(lds + O_PM + ((16 * rb + fr) * P64 + 32 * ks + 8 * fq) * 2);
#pragma unroll
      for (int ks = 0; ks < 4; ++ks) aq[ks] = *(const LAS bf16x8*)(lds + O_QPP + ((16 * rb + fr) * P128 + 32 * ks + 8 * fq) * 2);
#pragma unroll
      for (int j = 0; j < 4; ++j) { const int e0 = 64 * ch + 16 * j;
#pragma unroll
          for (int ks = 0; ks < 2; ++ks) { const bf16x8 bv = *(const LAS bf16x8*)(lds + O_VT + ((e0 + fr) * P64 + 32 * ks + 8 * fq) * 2); o[j] = __builtin_amdgcn_mfma_f32_16x16x32_bf16(ap[ks], bv, o[j], 0, 0, 0); }
#pragma unroll
          for (int ks = 0; ks < 4; ++ks) { const bf16x8 bs = *(const LAS bf16x8*)(lds + O_ST + ((e0 + fr) * P128 + 32 * ks + 8 * fq) * 2); o[j] = __builtin_amdgcn_mfma_f32_16x16x32_bf16(aq[ks], bs, o[j], 0, 0, 0); } } }
    LAS float* RS = (LAS float*)(lds + O_RS);
#pragma unroll
    for (int r = 0; r < 4; ++r) { float s = 0.f;
#pragma unroll
        for (int j = 0; j < 4; ++j) s += o[j][r] * o[j][r];
        s += __shfl_xor(s, 1); s += __shfl_xor(s, 2); s += __shfl_xor(s, 4); s += __shfl_xor(s, 8);
        if (fr == 0) RS[ch * 64 + 16 * rb + 4 * fq + r] = s; }
    __syncthreads();
#pragma unroll
    for (int r = 0; r < 4; ++r) { const int t = 16 * rb + 4 * fq + r; const float rstd = 1.0f / sqrtf((RS[t] + RS[64 + t]) * (1.0f / 128.0f) + RMS_EPS);
        const bf16* gbp = GB + (row0 + t) * 512 + h * 128 + 64 * ch + fr; bf16* yp = QAB + (row0 + t) * 1024 + 512 + h * 128 + 64 * ch + fr;
#pragma unroll
        for (int j = 0; j < 4; ++j) { const float y = o[j][r] * rstd * normg[64 * ch + 16 * j + fr] * bf2f(gbp[16 * j]); yp[16 * j] = (bf16)(pk2(y, 0.f) & 0xffffu); } }
    __syncthreads();
}
}

#ifdef DBG_NAN
__device__ __forceinline__ void dbg_scan(const void* p, size_t nbytes, bool is_bf, int stage, unsigned* word) {
    const size_t n16 = nbytes / 16; const v4u* q = (const v4u*)p; bool bad = false;
    int t_ = threadIdx.x; asm volatile("" : "+v"(t_));
    int b_ = blockIdx.x; asm volatile("" : "+s"(b_)); int g_ = gridDim.x; asm volatile("" : "+s"(g_));
    for (unsigned i = (unsigned)(b_ * NTHR + t_); i < (unsigned)n16; i += (unsigned)(g_ * NTHR)) { const v4u w = q[i];
        for (int k = 0; k < 4; ++k) { const unsigned x = w[k];
            if (is_bf) { if ((x & 0x7f80u) == 0x7f80u || (x & 0x7f800000u) == 0x7f800000u) bad = true; }
            else { if ((x & 0x7f800000u) == 0x7f800000u) bad = true; } } }
    if (bad) atomicMin(word, (unsigned)stage);
}
#define DBG(stage, ptr, bytes, isbf) do { if (l == DBG_LAYER) dbg_scan((ptr), (bytes), (isbf), (stage), (unsigned*)(args.ws + WS_DBG)); } while (0)
#else
#define DBG(stage, ptr, bytes, isbf) do {} while (0)
#endif
#define GSYNC() xcd_barrier(xbar)
#ifdef DBG_TS
#define STAMP(k) do { if (blockIdx.x == 0 && threadIdx.x == 0) ((unsigned long long*)(args.ws + WS_DBG + 4096))[(k)] = __builtin_amdgcn_s_memrealtime(); } while (0)
#else
#define STAMP(k) do {} while (0)
#endif
#ifndef REP_P1
#define REP_P1 1
#endif
#ifndef REP_P2
#define REP_P2 1
#endif
#ifndef REP_P8
#define REP_P8 1
#endif
#ifndef REP_P45
#define REP_P45 1
#endif
#ifndef REP_ATT0
#define REP_ATT0 0
#endif
struct Args { const float* in[14]; float* out; unsigned char* ws; };
#define FRESH_PTR(T, var, expr) T var = (T)(expr); asm volatile("" : "+s"(var))
#define IDS() int tid_ = threadIdx.x; asm volatile("" : "+v"(tid_)); const int tid = tid_, lane = tid & 63, wave = __builtin_amdgcn_readfirstlane(tid >> 6); const int G = gridDim.x, bx = blockIdx.x, vcu = (G % 8 == 0) ? (bx % 8) * (G / 8) + bx / 8 : bx; \
              const int gw = vcu * NWAVES + wave, NGW = G * NWAVES; (void)tid; (void)lane; (void)wave; (void)gw; (void)NGW; (void)vcu; (void)bx
__global__ void __launch_bounds__(NTHR, 2) mega_fwd(Args args) {
    extern __shared__ __attribute__((aligned(16))) unsigned char lds_raw[];
    cg::grid_group grid = cg::this_grid();
    const lp lds = (lp)lds_raw;
    volatile LAS unsigned* xbst = (volatile LAS unsigned*)(lds + LDS_TOTAL - 64);
    if (threadIdx.x < 16) xbst[threadIdx.x] = 0u;
    __syncthreads();
    const XcdBarrier xbar = xcd_barrier_post((unsigned*)(args.ws + WS_CTL), xbst);
    grid.sync();
    int tsn = 1; (void)tsn; STAMP(0);

#ifdef DBG_NAN
    if (blockIdx.x == 0 && threadIdx.x == 0) *(unsigned*)(args.ws + WS_DBG) = 990u;
    GSYNC(); STAMP(tsn); ++tsn;
#endif
    { IDS();
      Ptrs P;
      P.x = args.in[0]; P.w_in = args.in[1]; P.b_fgate = args.in[2]; P.lb_logits = args.in[3]; P.norm_g = args.in[4]; P.w_pa = args.in[5]; P.w_pb = args.in[6]; P.w_o = args.in[7];
      P.ln1_g = args.in[8]; P.ln1_b = args.in[9]; P.w_ff_in = args.in[10]; P.w_ff_out = args.in[11]; P.ln2_g = args.in[12]; P.ln2_b = args.in[13]; P.out = args.out; P.ws = args.ws;
      weight_items(P, (LAS float*)(lds + wave * 16384), gw, NGW, lane);
      __syncthreads();
      stage_wfa(P.w_in, (LAS float*)lds, tid);
      __syncthreads();
      row_pass<false, false, true, true>(P.x, nullptr, (bf16*)(P.ws + WS_XN), nullptr, nullptr, (float*)(P.ws + WS_LF), (const LAS float*)lds, P.b_fgate, gw, NGW, lane); }
    GSYNC(); STAMP(tsn); ++tsn;
    { const int l = 0; DBG(10, args.ws + WS_XN, (size_t)64 * MiB, true); DBG(10, args.ws + WS_LF, (size_t)1 * MiB, false); }

#pragma unroll 1
    for (int l = 0; l < DEPTH; ++l) {
        for (int rep_ = 0; rep_ < REP_P1; ++rep_) {
        { IDS(); FRESH_PTR(unsigned char*, ws, args.ws); FRESH_PTR(const float*, lbl, args.in[3]);
          pg8::Gemm g{(const bf16*)(ws + WS_XN), (const bf16*)(ws + WS_W + (size_t)l * WL_STRIDE + WL_IN), M, NP1, D}; pg8::StaticOrder S; S.init(M, NP1, G, bx);
          pg8::EpiInProj E{(bf16*)(ws + WS_QAB), (bf16*)(ws + WS_KA), (bf16*)(ws + WS_VA), (float*)(ws + WS_G), (bf16*)(ws + WS_IB), (bf16*)(ws + WS_GB), lbl, l, attn_body::C2};
          pg8::gemm_phase<pg8::EpiInProj, pg8::StaticOrder, true, true>(lds, g, S, E); }
        }
        GSYNC(); STAMP(tsn); ++tsn;
        DBG(20, args.ws + WS_QAB, (size_t)64 * MiB, true); DBG(30, args.ws + WS_KA, (size_t)64 * MiB, true); DBG(40, args.ws + WS_G, (size_t)64 * MiB, false); DBG(50, args.ws + WS_IB, (size_t)64 * MiB, true);
        for (int rep_ = 0; rep_ < REP_P2; ++rep_) {
        { IDS(); FRESH_PTR(unsigned char*, ws, args.ws);
          for (int u = vcu; u < 2048; u += G) hg::pass1_unit(u, (const float*)(ws + WS_G), (const bf16*)(ws + WS_IB), (bf16*)(ws + WS_ST), (float*)(ws + WS_DEC), lds, tid, (unsigned*)(ws + WS_DBG));
          for (int u = vcu; u < 16; u += G) fcumsum_unit(u, (const float*)(ws + WS_LF), (float*)(ws + WS_F), lds, tid); }
        }
        GSYNC(); STAMP(tsn); ++tsn;
        DBG(60, args.ws + WS_ST, (size_t)64 * MiB, true); DBG(61, args.ws + WS_DEC, (size_t)1 * MiB, false); DBG(70, args.ws + WS_F, (size_t)1 * MiB, false);
        { IDS(); FRESH_PTR(unsigned char*, ws, args.ws);
          hg::pass2_scan((bf16*)(ws + WS_ST), (const float*)(ws + WS_DEC), vcu * NTHR + tid, G * NTHR); }
        GSYNC(); STAMP(tsn); ++tsn;
        DBG(80, args.ws + WS_ST, (size_t)64 * MiB, true);
        if (REP_ATT0 && l == 0) { const int G = gridDim.x, bx = blockIdx.x; FRESH_PTR(unsigned char*, ws, args.ws); FRESH_PTR(float*, outp, args.out);
          const attn_body::AttnTensors AT{(const attn_body::bf16*)(ws + WS_QAB), (const attn_body::bf16*)(ws + WS_KA), (const attn_body::bf16*)(ws + WS_VA), (attn_body::bf16*)outp, (const float*)(ws + WS_F)};
          const attn_body::StaticOrder S(G, bx);
          attn_body::attn_phase<attn_body::StaticOrder>((char*)lds_raw, AT, S); __syncthreads(); }
        { const int G = gridDim.x, bx = blockIdx.x; FRESH_PTR(unsigned char*, ws, args.ws);
          const attn_body::AttnTensors AT{(const attn_body::bf16*)(ws + WS_QAB), (const attn_body::bf16*)(ws + WS_KA), (const attn_body::bf16*)(ws + WS_VA), (attn_body::bf16*)(ws + WS_QAB), (const float*)(ws + WS_F)};
          const attn_body::StaticOrder S(G, bx);
          attn_body::attn_phase<attn_body::StaticOrder>((char*)lds_raw, AT, S); }
        __syncthreads();
        { IDS(); FRESH_PTR(unsigned char*, ws, args.ws); FRESH_PTR(const float*, ng, args.in[4]);
          for (int u = vcu; u < 2048; u += G) hg::pass3_unit(u, (const float*)(ws + WS_G), (const bf16*)(ws + WS_IB), (const bf16*)(ws + WS_GB), (const bf16*)(ws + WS_ST), (bf16*)(ws + WS_QAB), ng + l * 128, lds, tid); }
        GSYNC(); STAMP(tsn); ++tsn;
        DBG(90, args.ws + WS_QAB, (size_t)64 * MiB, true);
        for (int rep_ = 0; rep_ < REP_P45; ++rep_) {
        { IDS(); FRESH_PTR(unsigned char*, ws, args.ws);
          pg8::Gemm g{(const bf16*)(ws + WS_XN), (const bf16*)(ws + WS_W + (size_t)l * WL_STRIDE + WL_G), M, NG, D}; pg8::StaticOrder S; S.init(M, NG, G, bx);
          pg8::EpiGates E{(bf16*)(ws + WS_GATES)};
          pg8::gemm_phase<pg8::EpiGates, pg8::StaticOrder, true, true>(lds, g, S, E); }
        }
        GSYNC(); STAMP(tsn); ++tsn;
        DBG(100, args.ws + WS_GATES, (size_t)128 * MiB, true);
        for (int rep_ = 0; rep_ < REP_P45; ++rep_) {
        { IDS(); FRESH_PTR(unsigned char*, ws, args.ws);
          pg8::Gemm g{(const bf16*)(ws + WS_QAB), (const bf16*)(ws + WS_W + (size_t)l * WL_STRIDE + WL_M), M, 2048, D}; pg8::StaticOrder S; S.init(M, 2048, G, bx);
          pg8::EpiMerge E{(const bf16*)(ws + WS_GATES), (bf16*)(ws + WS_MERGED)};
          pg8::gemm_phase<pg8::EpiMerge, pg8::StaticOrder, true, true>(lds, g, S, E); }
        }
        GSYNC(); STAMP(tsn); ++tsn;
        DBG(110, args.ws + WS_MERGED, (size_t)64 * MiB, true);
        { IDS(); FRESH_PTR(unsigned char*, ws, args.ws); FRESH_PTR(const float*, xin, args.in[0]); FRESH_PTR(float*, outp, args.out); const float* xres = (l == 0) ? xin : (const float*)outp;
          pg8::Gemm g{(const bf16*)(ws + WS_MERGED), (const bf16*)(ws + WS_W + (size_t)l * WL_STRIDE + WL_O), M, D, D}; pg8::StaticOrder S; S.init(M, D, G, bx);
          pg8::EpiResid E{xres, outp, ALPHA};
          pg8::gemm_phase<pg8::EpiResid, pg8::StaticOrder, true, true>(lds, g, S, E); }
        GSYNC(); STAMP(tsn); ++tsn;
        DBG(120, args.out, (size_t)128 * MiB, false);
        { IDS(); FRESH_PTR(unsigned char*, ws, args.ws); FRESH_PTR(float*, outp, args.out); FRESH_PTR(const float*, gm, args.in[8]); FRESH_PTR(const float*, bt, args.in[9]);
          row_pass<true, true, true, false>(outp, outp, (bf16*)(ws + WS_XN), gm + l * D, bt + l * D, nullptr, nullptr, nullptr, gw, NGW, lane); }
        GSYNC(); STAMP(tsn); ++tsn;
        DBG(130, args.ws + WS_XN, (size_t)64 * MiB, true);
        for (int rep_ = 0; rep_ < REP_P8; ++rep_) {
        { IDS(); FRESH_PTR(unsigned char*, ws, args.ws);
          pg8::Gemm g{(const bf16*)(ws + WS_XN), (const bf16*)(ws + WS_W + (size_t)l * WL_STRIDE + WL_F1), M, NF1, D}; pg8::StaticOrder S; S.init(M, NF1, G, bx);
          pg8::EpiSwiGLU E{(bf16*)(ws + WS_H)};
          pg8::gemm_phase<pg8::EpiSwiGLU, pg8::StaticOrder, true, true>(lds, g, S, E); }
        }
        GSYNC(); STAMP(tsn); ++tsn;
        DBG(140, args.ws + WS_H, (size_t)176 * MiB, true);
        { IDS(); FRESH_PTR(unsigned char*, ws, args.ws); FRESH_PTR(float*, outp, args.out);
          pg8::Gemm g{(const bf16*)(ws + WS_H), (const bf16*)(ws + WS_W + (size_t)l * WL_STRIDE + WL_F2), M, D, FFH}; pg8::StaticOrder S; S.init(M, D, G, bx);
          pg8::EpiResid E{outp, outp, ALPHA};
          pg8::gemm_phase<pg8::EpiResid, pg8::StaticOrder, true, true>(lds, g, S, E); }
        GSYNC(); STAMP(tsn); ++tsn;
        DBG(150, args.out, (size_t)128 * MiB, false);
        { IDS(); FRESH_PTR(unsigned char*, ws, args.ws); FRESH_PTR(float*, outp, args.out); FRESH_PTR(const float*, gm, args.in[12]); FRESH_PTR(const float*, bt, args.in[13]);
          if (l + 1 < DEPTH) {
              FRESH_PTR(const float*, win, args.in[1]); FRESH_PTR(const float*, bfg, args.in[2]);
              stage_wfa(win + (size_t)(l + 1) * D * NIN, (LAS float*)lds, tid);
              __syncthreads();
              row_pass<true, true, true, true>(outp, outp, (bf16*)(ws + WS_XN), gm + l * D, bt + l * D, (float*)(ws + WS_LF), (const LAS float*)lds, bfg + (l + 1) * 8, gw, NGW, lane);
          } else {
              row_pass<true, true, false, false>(outp, outp, nullptr, gm + l * D, bt + l * D, nullptr, nullptr, nullptr, gw, NGW, lane);
          } }
        if (l + 1 < DEPTH) GSYNC(); STAMP(tsn); ++tsn;
    }
#ifdef DBG_TS
    GSYNC(); STAMP(tsn);
    { const volatile unsigned long long* T = (const volatile unsigned long long*)(args.ws + WS_DBG + 4096);
      float sum[2] = {0.f, 0.f};
      if (blockIdx.x == 0) {
          for (int k = 0; k < 23; ++k) { const float us = (float)(T[k + 1] - T[k]) * 0.01f; const int j = (k == 0) ? -1 : (k - 1) % 11;
              for (int w = 0; w < 2; ++w) { const unsigned mask = (w == 0) ? DBG_TS_A : DBG_TS_B; const bool in = (j < 0) ? ((mask >> 15) & 1u) : ((mask >> j) & 1u); if (in) sum[w] += us; } }
          for (int i = threadIdx.x; i < (1 << 20); i += NTHR) args.out[1024 + i] = sum[1];
          __syncthreads();
          if (threadIdx.x == 0) args.out[0] = 100.0f * sum[0];
      } }
#endif
#ifdef DBG_NAN
    GSYNC();
    if (blockIdx.x == 0 && threadIdx.x == 0) args.out[0] = 100.0f * (float)*(volatile unsigned*)(args.ws + WS_DBG);
#endif
}

extern "C" void kernel_launch(void* const* d_in, const int* in_sizes, int n_in, void* d_out, int out_size, void* d_ws, size_t ws_size, hipStream_t stream) {
    static int grid = 0;
    if (grid == 0) {
        if (n_in != 14 || in_sizes[0] != M * D || out_size != M * D || ws_size < WS_END) { fprintf(stderr, "kernel_launch: unexpected shapes (n_in %d, in0 %d, out %d, ws %zu)\n", n_in, n_in > 0 ? in_sizes[0] : -1, out_size, ws_size); grid = -1; return; }
        int dev = 0, cus = 0, per_cu = 0;
        if (hipGetDevice(&dev) != hipSuccess || hipDeviceGetAttribute(&cus, hipDeviceAttributeMultiprocessorCount, dev) != hipSuccess) { grid = -1; return; }
        if (hipFuncSetAttribute((const void*)mega_fwd, hipFuncAttributeMaxDynamicSharedMemorySize, LDS_TOTAL) != hipSuccess) { fprintf(stderr, "kernel_launch: hipFuncSetAttribute failed\n"); grid = -1; return; }
        if (hipOccupancyMaxActiveBlocksPerMultiprocessor(&per_cu, (const void*)mega_fwd, NTHR, LDS_TOTAL) != hipSuccess || per_cu < 1) { fprintf(stderr, "kernel_launch: occupancy query says %d\n", per_cu); per_cu = 1; }
        (void)hipGetLastError();
        grid = cus * per_cu;
    }
    if (grid < 0) return;
    if (hipMemsetAsync((char*)d_ws + WS_CTL, 0, 65536, stream) != hipSuccess) { fprintf(stderr, "kernel_launch: hipMemsetAsync failed\n"); return; }
    Args a{};
    for (int i = 0; i < 14; ++i) a.in[i] = (const float*)d_in[i];
    a.out = (float*)d_out; a.ws = (unsigned char*)d_ws;
    void* kargs[] = {&a};
    hipError_t e = hipLaunchCooperativeKernel((const void*)mega_fwd, dim3(grid), dim3(NTHR), kargs, LDS_TOTAL, stream);
    if (e != hipSuccess) fprintf(stderr, "kernel_launch: cooperative launch failed: %s (grid %d)\n", hipGetErrorString(e), grid);
}
```

```cpp
#include <hip/hip_runtime.h>
#include <cstdio>
#include <cstdint>
namespace pg8 {
#define PG8_LAS __attribute__((address_space(3)))
typedef unsigned short bf16_t;
typedef short bf16x8 __attribute__((ext_vector_type(8)));
typedef float f32x4 __attribute__((ext_vector_type(4)));
typedef unsigned u32x4 __attribute__((ext_vector_type(4)));
constexpr int BM = 256, BK = 64, HALF = 128, HTB = HALF * BK * 2  , STAGE_BYTES = 8 * HTB, NXCD = 8, WGM = 8;

__host__ __device__ __forceinline__ int lds_byte(int r, int c) { const int st = (r >> 4) * 2 + (c >> 5), rr = r & 15, cc = c & 31, ob = rr * 64 + cc * 2; return st * 1024 + (ob ^ (((ob >> 9) & 1) << 5)); }
__host__ __device__ __forceinline__ void stage_rc(int b, int& R, int& C) { const int st = b / 1024, sb = b % 1024, swz = sb ^ (((sb >> 9) & 1) << 5); R = (st >> 1) * 16 + swz / 64; C = (st & 1) * 32 + (swz % 64) / 2; }
__host__ __device__ __forceinline__ int perm32(int rho) { const int n = rho >> 4, i = rho & 15; return 8 * (i >> 2) + 4 * n + (i & 3); }

struct Unit { int pm, pn; };
struct Gemm { const bf16_t* A; const bf16_t* Bt; int M, N, K; };

struct StaticOrder {
    int nM, nN, nwg, G, c;
    __host__ __device__ void init(int M, int N, int G_, int c_) { nM = M / BM; nN = N / BM; nwg = nM * nN; G = G_; c = c_; }
    __host__ __device__ bool next(int i, Unit& u) const {
        const long L = (long)i * G + c; if (L >= nwg) return false;
        int wgid = (int)L; { const int q = nwg / NXCD, r = nwg % NXCD, xcd = wgid % NXCD, off = wgid / NXCD; wgid = (xcd < r ? xcd * (q + 1) : r * (q + 1) + (xcd - r) * q) + off; }
        const int nig = WGM * nN, gid = wgid / nig, fm = gid * WGM, gsz = (nM - fm) < WGM ? (nM - fm) : WGM;
        u.pm = fm + ((wgid % nig) % gsz); u.pn = (wgid % nig) / gsz; return true;
    }
    __device__ __forceinline__ void a_ready(const Unit&) const {}
    __device__ __forceinline__ void done(const Unit&) const {}
};

typedef float f32x2c_t __attribute__((ext_vector_type(2))); typedef __bf16 bf16x2c_t __attribute__((ext_vector_type(2)));
__device__ __forceinline__ unsigned cvt_pk_bf16(float lo, float hi) { f32x2c_t v = {lo, hi}; bf16x2c_t b = __builtin_convertvector(v, bf16x2c_t); return __builtin_bit_cast(unsigned, b); }
typedef float f32x2 __attribute__((ext_vector_type(2)));
__device__ __forceinline__ f32x2 gelu_pk(f32x2 v) {
    const f32x2 av = __builtin_elementwise_abs(v), d = av * 0.2316418882f + 1.0f;
    f32x2 t; t.x = __builtin_amdgcn_rcpf(d.x); t.y = __builtin_amdgcn_rcpf(d.y);
    f32x2 q = t * 0.5307027145f + (-0.7265760135f); q = q * t + 0.7107068705f; q = q * t + (-0.142248368f); q = q * t + 0.127414796f; q = q * t;
    const f32x2 s = (v * v) * (-0.72134752044f);
    f32x2 e; e.x = __builtin_amdgcn_exp2f(s.x); e.y = __builtin_amdgcn_exp2f(s.y);
    const f32x2 m = v * (q * e), r = v - m;
    f32x2 o; o.x = v.x < 0.f ? m.x : r.x; o.y = v.y < 0.f ? m.y : r.y; return o;
}

template <int ACT  > struct EpiBf16 {
    static constexpr bool PERM = true, AFTER_DRAIN = false; static_assert(ACT == 0 || ACT == 1, "EpiBf16: ACT is 0 (none) or 1 (gelu_pk)");
    bf16_t* O; int ldc; const float* bias; int split_cols; size_t split_stride; float scale0;
    __device__ __forceinline__ void operator()(const f32x4 (&acc)[2][2][4][2], const Unit& u, int wr, int wc, int fr, int fq) const {
        const int row0 = u.pm * BM + wr * 64 + fr; int colt = u.pn * BM; bf16_t* base = O;
        float sc = 1.f; if (split_cols) { const int t = colt / split_cols; base += (size_t)t * split_stride; colt -= t * split_cols; if (t == 0) sc = scale0; }
        const int col0 = colt + wc * 32 + 8 * fq, bcol0 = u.pn * BM + wc * 32 + 8 * fq;
        f32x4 bv[2][2];
#pragma unroll
        for (int bj = 0; bj < 2; ++bj)
#pragma unroll
            for (int n = 0; n < 2; ++n) bv[bj][n] = bias ? *(const f32x4*)(bias + bcol0 + bj * HALF + 4 * n) : (f32x4){0.f, 0.f, 0.f, 0.f};
#pragma unroll
        for (int ai = 0; ai < 2; ++ai)
#pragma unroll
            for (int m = 0; m < 4; ++m) { bf16_t* rowp = base + (size_t)(row0 + ai * HALF + m * 16) * ldc + col0;
#pragma unroll
                for (int bj = 0; bj < 2; ++bj) { f32x4 v0 = acc[ai][bj][m][0] + bv[bj][0], v1 = acc[ai][bj][m][1] + bv[bj][1];
                    if (ACT == 1) { f32x2 a = gelu_pk((f32x2){v0[0], v0[1]}), b = gelu_pk((f32x2){v0[2], v0[3]}), c = gelu_pk((f32x2){v1[0], v1[1]}), d = gelu_pk((f32x2){v1[2], v1[3]});
                        v0 = (f32x4){a.x, a.y, b.x, b.y}; v1 = (f32x4){c.x, c.y, d.x, d.y}; }
                    v0 = v0 * sc; v1 = v1 * sc; u32x4 w; w.x = cvt_pk_bf16(v0[0], v0[1]); w.y = cvt_pk_bf16(v0[2], v0[3]); w.z = cvt_pk_bf16(v1[0], v1[1]); w.w = cvt_pk_bf16(v1[2], v1[3]);
                    *(u32x4*)(rowp + bj * HALF) = w; } }
    }
};

struct PanelStats {
    unsigned* xbuf;
    unsigned* cnt;
    unsigned* tmo;
    int ntn; float eps;
    unsigned code;
    __device__ __forceinline__ bool run(const f32x4 (&v)[2][2][4][2], const Unit& u, int wr, int wc, int fr, int fq, PG8_LAS unsigned char* lds, int wid, int lane) const {
        typedef float f32x2v __attribute__((ext_vector_type(2)));
        PG8_LAS f32x2v* P = (PG8_LAS f32x2v*)lds;
        PG8_LAS f32x2v* S = (PG8_LAS f32x2v*)(lds + 8192);
        PG8_LAS unsigned* flag = (PG8_LAS unsigned*)(lds + 8192 + 2048);
#pragma unroll
        for (int ai = 0; ai < 2; ++ai)
#pragma unroll
            for (int m = 0; m < 4; ++m) {
                float s = 0.f;
#pragma unroll
                for (int bj = 0; bj < 2; ++bj)
#pragma unroll
                    for (int n = 0; n < 2; ++n) { const f32x4 x = v[ai][bj][m][n]; s += (x[0] + x[1]) + (x[2] + x[3]); }
                s += __shfl_xor(s, 16); s += __shfl_xor(s, 32);
                const float mw = s * (1.0f / 64.0f); float q = 0.f;
#pragma unroll
                for (int bj = 0; bj < 2; ++bj)
#pragma unroll
                    for (int n = 0; n < 2; ++n) { const f32x4 d = v[ai][bj][m][n] - mw; q += (d[0] * d[0] + d[1] * d[1]) + (d[2] * d[2] + d[3] * d[3]); }
                q += __shfl_xor(q, 16); q += __shfl_xor(q, 32);
                if (fq == 0) P[(ai * HALF + wr * 64 + m * 16 + fr) * 4 + wc] = (f32x2v){mw, q};
            }
        asm volatile("s_waitcnt lgkmcnt(0)" ::: "memory"); __builtin_amdgcn_s_barrier(); asm volatile("" ::: "memory");
#if defined(BROKEN_EXCHANGE_NO_WAIT)
#warning BROKEN CONTROL BUILD: the row-statistics exchange does not wait; results are wrong by design
        if (blockIdx.x >= 64) { const long long t0_ = clock64(); while (clock64() - t0_ < 60000) __builtin_amdgcn_s_sleep(8); }
#endif
        const int row = wid * 32 + (lane & 31);
        if (lane < 32) {
            const f32x2v a = P[row * 4 + 0], b = P[row * 4 + 1], c = P[row * 4 + 2], d = P[row * 4 + 3];
            const float mt = (a.x + b.x + c.x + d.x) * 0.25f;
            const float da = a.x - mt, db = b.x - mt, dc = c.x - mt, dd = d.x - mt;
            const float m2 = (a.y + b.y) + (c.y + d.y) + 64.0f * ((da * da + db * db) + (dc * dc + dd * dd));
            unsigned long long* slot = (unsigned long long*)xbuf + ((size_t)(u.pm * BM + row) * 4 + u.pn);
            __hip_atomic_store(slot, ((unsigned long long)__float_as_uint(m2) << 32) | __float_as_uint(mt), __ATOMIC_RELAXED, __HIP_MEMORY_SCOPE_AGENT);
        }
        asm volatile("s_waitcnt vmcnt(0)" ::: "memory");
        if (lane == 0) __hip_atomic_fetch_add(cnt + 64 * u.pm, 1u, __ATOMIC_RELAXED, __HIP_MEMORY_SCOPE_AGENT);
        if (wid == 0) {
            bool dead = false; const unsigned long long t0 = __builtin_amdgcn_s_memrealtime(); const unsigned want = 8u * (unsigned)ntn;
            for (;;) {
#if defined(BROKEN_EXCHANGE_NO_WAIT)
                break;
#endif
                if ((unsigned)__builtin_amdgcn_readfirstlane(__hip_atomic_load(cnt + 64 * u.pm, __ATOMIC_RELAXED, __HIP_MEMORY_SCOPE_AGENT)) >= want) break;
                if (__builtin_amdgcn_s_memrealtime() - t0 > 2000000ull) {
                    if (lane == 0) { unsigned expect = 0u; __hip_atomic_compare_exchange_strong(tmo + 1, &expect, code | (unsigned)(u.pm & 0xff), __ATOMIC_RELAXED, __ATOMIC_RELAXED, __HIP_MEMORY_SCOPE_AGENT);
                                     __hip_atomic_store(tmo, 1u, __ATOMIC_RELAXED, __HIP_MEMORY_SCOPE_AGENT); }
                    dead = true; break; }
                __builtin_amdgcn_s_sleep(2);
            }
            __builtin_amdgcn_fence(__ATOMIC_ACQUIRE, "agent");
            if (lane == 0) flag[0] = dead ? 1u : 0u;
        }
        asm volatile("s_waitcnt vmcnt(0) lgkmcnt(0)" ::: "memory"); __builtin_amdgcn_s_barrier(); asm volatile("" ::: "memory");
        const bool bad = flag[0] != 0u;
        if (lane < 32) {
            const unsigned long long* slot = (const unsigned long long*)xbuf + (size_t)(u.pm * BM + row) * 4; float mt[4], m2[4]; float ms = 0.f;
#pragma unroll
            for (int t = 0; t < 4; ++t) { if (t < ntn) { const unsigned long long w = __hip_atomic_load(slot + t, __ATOMIC_RELAXED, __HIP_MEMORY_SCOPE_AGENT); mt[t] = __uint_as_float((unsigned)w); m2[t] = __uint_as_float((unsigned)(w >> 32)); } else { mt[t] = 0.f; m2[t] = 0.f; } ms += mt[t]; }
            const float mean = ms / (float)ntn; float q = 0.f;
#pragma unroll
            for (int t = 0; t < 4; ++t) if (t < ntn) { const float dm = mt[t] - mean; q += m2[t] + 256.0f * dm * dm; }
            S[row] = (f32x2v){mean, 1.0f / sqrtf(q / (256.0f * (float)ntn) + eps)};
        }
        asm volatile("s_waitcnt lgkmcnt(0)" ::: "memory"); __builtin_amdgcn_s_barrier(); asm volatile("" ::: "memory");
        return bad;
    }
};
struct EpiLnRes {
    static constexpr bool PERM = false, AFTER_DRAIN = true;
    const float* base; float* out; int ldc; const float* bias; PanelStats st; unsigned poison;
    __device__ __forceinline__ void fused(f32x4 (&acc)[2][2][4][2], const Unit& u, int wr, int wc, int fr, int fq, PG8_LAS unsigned char* lds, int wid, int lane) const {
        typedef float f32x2v __attribute__((ext_vector_type(2)));
        const PG8_LAS f32x2v* S = (const PG8_LAS f32x2v*)(lds + 8192);
        const int col0 = u.pn * BM + wc * 32 + 4 * fq;
#pragma unroll
        for (int bj = 0; bj < 2; ++bj)
#pragma unroll
            for (int n = 0; n < 2; ++n) { const f32x4 bv = bias ? *(const f32x4*)(bias + col0 + bj * HALF + n * 16) : (f32x4){0.f, 0.f, 0.f, 0.f};
#pragma unroll
                for (int ai = 0; ai < 2; ++ai)
#pragma unroll
                    for (int m = 0; m < 4; ++m) acc[ai][bj][m][n] += bv; }
        f32x4 pre[4][2][2];
#pragma unroll
        for (int m = 0; m < 4; ++m) { const size_t off = (size_t)(u.pm * BM + wr * 64 + m * 16 + fr) * ldc + col0;
#pragma unroll
            for (int bj = 0; bj < 2; ++bj)
#pragma unroll
                for (int n = 0; n < 2; ++n) pre[m][bj][n] = *(const f32x4*)(base + off + bj * HALF + n * 16); }
        const bool bad = st.run(acc, u, wr, wc, fr, fq, lds, wid, lane) || poison != 0u;
        const float qnan = __builtin_nanf("");
#pragma unroll
        for (int ai = 0; ai < 2; ++ai)
#pragma unroll
            for (int m = 0; m < 4; ++m) { const int r = ai * HALF + wr * 64 + m * 16 + fr; const f32x2v sr = S[r]; const size_t off = (size_t)(u.pm * BM + r) * ldc + col0;
#pragma unroll
                for (int bj = 0; bj < 2; ++bj)
#pragma unroll
                    for (int n = 0; n < 2; ++n) { const f32x4 bs = ai == 0 ? pre[m][bj][n] : *(const f32x4*)(base + off + bj * HALF + n * 16); f32x4 o = bs + (acc[ai][bj][m][n] - sr.x) * sr.y;
                        if (bad) o = (f32x4){qnan, qnan, qnan, qnan}; *(f32x4*)(out + off + bj * HALF + n * 16) = o; }
                if (m & 1) asm volatile("" ::: "memory"); }
    }
};
struct EpiLnResLn {
    static constexpr bool PERM = false, AFTER_DRAIN = true;
    const float* base; float* out; bf16_t* xn; int ldc; const float* bias; PanelStats st1, st2; unsigned poison;
    __device__ __forceinline__ void fused(f32x4 (&acc)[2][2][4][2], const Unit& u, int wr, int wc, int fr, int fq, PG8_LAS unsigned char* lds, int wid, int lane) const {
        typedef float f32x2v __attribute__((ext_vector_type(2))); typedef unsigned u32x2v __attribute__((ext_vector_type(2)));
        const PG8_LAS f32x2v* S = (const PG8_LAS f32x2v*)(lds + 8192);
        const int col0 = u.pn * BM + wc * 32 + 4 * fq;
#pragma unroll
        for (int bj = 0; bj < 2; ++bj)
#pragma unroll
            for (int n = 0; n < 2; ++n) { const f32x4 bv = bias ? *(const f32x4*)(bias + col0 + bj * HALF + n * 16) : (f32x4){0.f, 0.f, 0.f, 0.f};
#pragma unroll
                for (int ai = 0; ai < 2; ++ai)
#pragma unroll
                    for (int m = 0; m < 4; ++m) acc[ai][bj][m][n] += bv; }
        bool bad = st1.run(acc, u, wr, wc, fr, fq, lds, wid, lane) || poison != 0u;
        const float qnan = __builtin_nanf("");
#pragma unroll
        for (int ai = 0; ai < 2; ++ai)
#pragma unroll
            for (int m = 0; m < 4; ++m) { const int r = ai * HALF + wr * 64 + m * 16 + fr; const f32x2v sr = S[r]; const size_t off = (size_t)(u.pm * BM + r) * ldc + col0;
#pragma unroll
                for (int bj = 0; bj < 2; ++bj)
#pragma unroll
                    for (int n = 0; n < 2; ++n) { const f32x4 bs = *(const f32x4*)(base + off + bj * HALF + n * 16); acc[ai][bj][m][n] = bs + (acc[ai][bj][m][n] - sr.x) * sr.y; }
                asm volatile("" : "+v"(acc[ai][0][m][0]), "+v"(acc[ai][0][m][1]), "+v"(acc[ai][1][m][0]), "+v"(acc[ai][1][m][1]));
                if (m & 1) asm volatile("" ::: "memory"); }
        const bool bad1 = bad;
        bad = st2.run(acc, u, wr, wc, fr, fq, lds, wid, lane) || bad;
#pragma unroll
        for (int ai = 0; ai < 2; ++ai)
#pragma unroll
            for (int m = 0; m < 4; ++m) { const int r = ai * HALF + wr * 64 + m * 16 + fr; const f32x2v sr = S[r]; const size_t off = (size_t)(u.pm * BM + r) * ldc + col0;
#pragma unroll
                for (int bj = 0; bj < 2; ++bj)
#pragma unroll
                    for (int n = 0; n < 2; ++n) { const f32x4 x1 = acc[ai][bj][m][n]; *(f32x4*)(out + off + bj * HALF + n * 16) = bad1 ? (f32x4){qnan, qnan, qnan, qnan} : x1;
                        const f32x4 o = (x1 - sr.x) * sr.y; u32x2v w; w.x = cvt_pk_bf16(o[0], o[1]); w.y = cvt_pk_bf16(o[2], o[3]);
                        if (bad) { w.x = 0x7fc07fc0u; w.y = 0x7fc07fc0u; } *(u32x2v*)(xn + off + bj * HALF + n * 16) = w; }
                asm volatile("" ::: "memory"); }
    }
};

template <class Epi, class Sched, bool ALIGN_EPI = false, bool SP2 = false>
__device__ __forceinline__ void gemm_phase(PG8_LAS unsigned char* lds, const Gemm g, const Sched& S, const Epi& E) {
    int tid_ = threadIdx.x; asm volatile("" : "+v"(tid_));
    const int tid = tid_, wid = __builtin_amdgcn_readfirstlane(tid >> 6), lane = tid & 63, wr = wid >> 2, wc = wid & 3, fr = lane & 15, fq = lane >> 4;
    const int K = g.K, nt = K / BK;
    unsigned voffA[2], voffB[2];
#pragma unroll
    for (int i = 0; i < 2; ++i) { int R, C; stage_rc(tid * 16 + i * 8192, R, C); const int Rb = Epi::PERM ? ((R & ~31) + perm32(R & 31)) : R;
        voffA[i] = (unsigned)(R * K + C) * 2u; voffB[i] = (unsigned)(Rb * K + C) * 2u; }
    const size_t kstep = (size_t)(BK * 2);
    const size_t hstep = (size_t)HALF * K * 2;
    const size_t tstep = 2 * hstep;
    const unsigned ldsw = (unsigned)wid * 1024u;
    const int aoff = lds_byte(wr * 64 + fr, fq * 8), boff = lds_byte(wc * 32 + fr, fq * 8);
#define PG8_SA(b, h) (((b) * 2 + (h)) * HTB)
#define PG8_SB(b, h) ((4 + (b) * 2 + (h)) * HTB)
#define PG8_STAGE(bufoff, gbase, voff) do { _Pragma("unroll") for (int _i = 0; _i < 2; ++_i) \
        __builtin_amdgcn_global_load_lds((const unsigned*)((const char*)(gbase) + (voff)[_i]), (PG8_LAS unsigned*)(lds + (bufoff) + ldsw + _i * 8192), 16, 0, 0); } while (0)
#define PG8_LDA(dst, b, h) do { _Pragma("unroll") for (int m = 0; m < 4; ++m) _Pragma("unroll") for (int k = 0; k < 2; ++k) dst[m][k] = *(const PG8_LAS bf16x8*)(lds + PG8_SA(b, h) + aoff + m * 2048 + k * 1024); } while (0)
#define PG8_LDB(dst, b, h) do { _Pragma("unroll") for (int n = 0; n < 2; ++n) _Pragma("unroll") for (int k = 0; k < 2; ++k) dst[n][k] = *(const PG8_LAS bf16x8*)(lds + PG8_SB(b, h) + boff + n * 2048 + k * 1024); } while (0)
#define PG8_MMA(ai, bj, At, Bt) do { __builtin_amdgcn_s_setprio(1); _Pragma("unroll") for (int m = 0; m < 4; ++m) _Pragma("unroll") for (int n = 0; n < 2; ++n) _Pragma("unroll") for (int k = 0; k < 2; ++k) \
        acc[ai][bj][m][n] = __builtin_amdgcn_mfma_f32_16x16x32_bf16(Bt[n][k], At[m][k], acc[ai][bj][m][n], 0, 0, 0); __builtin_amdgcn_s_setprio(0); } while (0)
#define PG8_WAIT_V(n) asm volatile("s_waitcnt vmcnt(" #n ")" ::: "memory")
#define PG8_WAIT_L(n) asm volatile("s_waitcnt lgkmcnt(" #n ")" ::: "memory")
#define PG8_BAR __builtin_amdgcn_s_barrier()
#define PG8_SCHED __builtin_amdgcn_sched_barrier(0)
    Unit cur, nxt; int ui = 0;
    if (!S.next(0, cur)) return;
    f32x4 acc[2][2][4][2];
#pragma unroll
    for (int a = 0; a < 2; ++a)
#pragma unroll
        for (int b = 0; b < 2; ++b)
#pragma unroll
            for (int m = 0; m < 4; ++m)
#pragma unroll
                for (int n = 0; n < 2; ++n) acc[a][b][m][n] = (f32x4){0.f, 0.f, 0.f, 0.f};
    bf16x8 At[4][2], B0[2][2], B1[2][2];
    const char* cA = (const char*)g.A + (size_t)cur.pm * tstep; const char* cB = (const char*)g.Bt + (size_t)cur.pn * tstep;
    S.a_ready(cur);
    if constexpr (SP2) {
        PG8_STAGE(PG8_SB(0, 0), cB, voffB); PG8_STAGE(PG8_SB(0, 1), cB + hstep, voffB); PG8_STAGE(PG8_SA(0, 0), cA, voffA); PG8_STAGE(PG8_SA(0, 1), cA + hstep, voffA);
        if (wr == 1) PG8_BAR;
        PG8_WAIT_V(2); PG8_BAR;
        PG8_STAGE(PG8_SB(1, 0), cB + kstep, voffB); PG8_STAGE(PG8_SA(1, 0), cA + kstep, voffA); PG8_STAGE(PG8_SB(1, 1), cB + hstep + kstep, voffB);
        PG8_WAIT_V(6); PG8_BAR;
    } else {
        PG8_STAGE(PG8_SB(0, 0), cB, voffB); PG8_STAGE(PG8_SA(0, 0), cA, voffA); PG8_STAGE(PG8_SB(0, 1), cB + hstep, voffB); PG8_STAGE(PG8_SA(0, 1), cA + hstep, voffA);
        if (wr == 1) PG8_BAR;
        PG8_WAIT_V(4); PG8_BAR;
        PG8_STAGE(PG8_SB(1, 0), cB + kstep, voffB); PG8_STAGE(PG8_SA(1, 0), cA + kstep, voffA); PG8_STAGE(PG8_SB(1, 1), cB + hstep + kstep, voffB);
        PG8_WAIT_V(6); PG8_BAR;
    }
    for (;;) {
        const bool has_next = S.next(ui + 1, nxt);
        const char* nA = has_next ? (const char*)g.A + (size_t)nxt.pm * tstep : cA; const char* nB = has_next ? (const char*)g.Bt + (size_t)nxt.pn * tstep : cB;
        for (int t = 0; t < nt; t += 2) {
            const bool last = (t == nt - 2);
            const char* a1 = cA + (size_t)(t + 1) * kstep;
            const char* a2 = last ? nA : cA + (size_t)(t + 2) * kstep; const char* b2 = last ? nB : cB + (size_t)(t + 2) * kstep;
            const char* a3 = a2 + kstep; const char* b3 = b2 + kstep;
            if (last && has_next) S.a_ready(nxt);
            if constexpr (SP2) {
            PG8_LDB(B0, 0, 0); PG8_LDB(B1, 0, 1); PG8_SCHED; PG8_LDA(At, 0, 0); PG8_STAGE(PG8_SA(1, 1), a1 + hstep, voffA);
            PG8_WAIT_V(8); PG8_WAIT_L(0); PG8_BAR; PG8_MMA(0, 0, At, B0); PG8_MMA(0, 1, At, B1); PG8_BAR; PG8_SCHED;
            PG8_LDA(At, 0, 1); PG8_STAGE(PG8_SB(0, 0), b2, voffB); PG8_STAGE(PG8_SB(0, 1), b2 + hstep, voffB); PG8_STAGE(PG8_SA(0, 0), a2, voffA);
            PG8_WAIT_V(8); PG8_WAIT_L(0); PG8_BAR; PG8_MMA(1, 0, At, B0); PG8_MMA(1, 1, At, B1); PG8_BAR; PG8_SCHED;
            PG8_LDB(B0, 1, 0); PG8_LDB(B1, 1, 1); PG8_SCHED; PG8_LDA(At, 1, 0); PG8_STAGE(PG8_SA(0, 1), a2 + hstep, voffA);
            PG8_WAIT_V(8); PG8_WAIT_L(0); PG8_BAR; PG8_MMA(0, 0, At, B0); PG8_MMA(0, 1, At, B1); PG8_BAR; PG8_SCHED;
            PG8_LDA(At, 1, 1); PG8_STAGE(PG8_SB(1, 0), b3, voffB); PG8_STAGE(PG8_SB(1, 1), b3 + hstep, voffB); PG8_STAGE(PG8_SA(1, 0), a3, voffA);
            PG8_WAIT_V(8); PG8_WAIT_L(0); PG8_BAR; PG8_MMA(1, 0, At, B0); PG8_MMA(1, 1, At, B1); PG8_BAR; PG8_SCHED;
            } else {
            PG8_LDB(B0, 0, 0); PG8_SCHED; PG8_LDA(At, 0, 0); PG8_STAGE(PG8_SA(1, 1), a1 + hstep, voffA);
            PG8_WAIT_L(8); PG8_BAR; PG8_WAIT_L(0); PG8_MMA(0, 0, At, B0); PG8_BAR; PG8_SCHED;
            PG8_LDB(B1, 0, 1); PG8_STAGE(PG8_SB(0, 0), b2, voffB);
            PG8_BAR; PG8_WAIT_L(0); PG8_MMA(0, 1, At, B1); PG8_BAR;
            PG8_LDA(At, 0, 1); PG8_STAGE(PG8_SA(0, 0), a2, voffA);
            PG8_BAR; PG8_WAIT_L(0); PG8_MMA(1, 0, At, B0); PG8_BAR; PG8_SCHED;
            PG8_STAGE(PG8_SB(0, 1), b2 + hstep, voffB);
            PG8_WAIT_V(6); PG8_BAR; PG8_MMA(1, 1, At, B1); PG8_BAR;
            PG8_LDB(B0, 1, 0); PG8_SCHED; PG8_LDA(At, 1, 0); PG8_STAGE(PG8_SA(0, 1), a2 + hstep, voffA);
            PG8_WAIT_L(8); PG8_BAR; PG8_WAIT_L(0); PG8_MMA(0, 0, At, B0); PG8_BAR; PG8_SCHED;
            PG8_LDB(B1, 1, 1); PG8_STAGE(PG8_SB(1, 0), b3, voffB);
            PG8_BAR; PG8_WAIT_L(0); PG8_MMA(0, 1, At, B1); PG8_BAR;
            PG8_LDA(At, 1, 1); PG8_STAGE(PG8_SA(1, 0), a3, voffA);
            PG8_BAR; PG8_WAIT_L(0); PG8_MMA(1, 0, At, B0); PG8_BAR; PG8_SCHED;
            PG8_STAGE(PG8_SB(1, 1), b3 + hstep, voffB);
            PG8_WAIT_V(6); PG8_BAR; PG8_MMA(1, 1, At, B1); PG8_BAR;
            }
        }
        if constexpr (ALIGN_EPI) { if (wr == 0) PG8_BAR; }
        if constexpr (!Epi::AFTER_DRAIN) { E(acc, cur, wr, wc, fr, fq); S.done(cur); }
        if (!has_next) break;
#pragma unroll
        for (int a = 0; a < 2; ++a)
#pragma unroll
            for (int b = 0; b < 2; ++b)
#pragma unroll
                for (int m = 0; m < 4; ++m)
#pragma unroll
                    for (int n = 0; n < 2; ++n) acc[a][b][m][n] = (f32x4){0.f, 0.f, 0.f, 0.f};
        cur = nxt; cA = nA; cB = nB; ++ui;
        if constexpr (ALIGN_EPI) { if (wr == 1) PG8_BAR; }
    }
    PG8_WAIT_V(0);
    if constexpr (!ALIGN_EPI) { if (wr == 0) PG8_BAR; }
    PG8_BAR;
    if constexpr (Epi::AFTER_DRAIN) { E.fused(acc, cur, wr, wc, fr, fq, lds, wid, lane); S.done(cur); }
#undef PG8_SA
#undef PG8_SB
#undef PG8_STAGE
#undef PG8_LDA
#undef PG8_LDB
#undef PG8_MMA
#undef PG8_WAIT_V
#undef PG8_WAIT_L
#undef PG8_BAR
#undef PG8_SCHED
}
}
namespace pg8 {
__device__ __forceinline__ float fsig(float v) { return __builtin_amdgcn_rcpf(1.0f + __builtin_amdgcn_exp2f(-1.4426950408889634f * v)); }
__device__ __forceinline__ float bf_lo(unsigned w) { return __uint_as_float(w << 16); }
__device__ __forceinline__ float bf_hi(unsigned w) { return __uint_as_float(w & 0xffff0000u); }

struct EpiInProj {
    static constexpr bool PERM = true, AFTER_DRAIN = false;
    bf16_t* QAB; bf16_t* KA; bf16_t* VA; float* G; bf16_t* IB; bf16_t* GB; const float* lbl; int layer; float qscale;
    __device__ __forceinline__ void operator()(const f32x4 (&acc)[2][2][4][2], const Unit& u, int wr, int wc, int fr, int fq) const {
        const int type = u.pn >> 1;
        const int ct = (u.pn & 1) * 256 + wc * 32 + 8 * fq;
        const int row0 = u.pm * BM + wr * 64 + fr;
        if (type == 4) {
            float lb[2][8];
#pragma unroll
            for (int bj = 0; bj < 2; ++bj)
#pragma unroll
                for (int j = 0; j < 8; ++j) {
                    float v = 0.f;
                    if (layer != 0) { const float l0 = lbl[ct + bj * HALF + j], l1 = lbl[512 + ct + bj * HALF + j]; v = 1.0f / (1.0f + __expf(l0 - l1)); }
                    lb[bj][j] = v;
                }
#pragma unroll
            for (int ai = 0; ai < 2; ++ai)
#pragma unroll
                for (int m = 0; m < 4; ++m) { float* rowp = G + (size_t)(row0 + ai * HALF + m * 16) * 512 + ct;
#pragma unroll
                    for (int bj = 0; bj < 2; ++bj) { f32x4 o0, o1;
#pragma unroll
                        for (int j = 0; j < 4; ++j) {
                            const float f0 = lb[bj][j] + (1.0f - lb[bj][j]) * fsig(acc[ai][bj][m][0][j]);
                            const float f1 = lb[bj][4 + j] + (1.0f - lb[bj][4 + j]) * fsig(acc[ai][bj][m][1][j]);
                            o0[j] = __builtin_amdgcn_logf(f0) * 0.6931471805599453f; o1[j] = __builtin_amdgcn_logf(f1) * 0.6931471805599453f; }
                        *(f32x4*)(rowp + bj * HALF) = o0; *(f32x4*)(rowp + bj * HALF + 4) = o1; } }
        } else {
            bf16_t* base; int ldc = 512, act = 0; float sc = 1.f;
            if (type == 0) { base = QAB; ldc = 1024; sc = qscale; }
            else if (type == 1) base = KA;
            else if (type == 2) base = VA;
            else if (type == 3) { base = QAB + 512; ldc = 1024; act = 1; }
            else if (type == 5) base = IB;
            else { base = GB; act = 2; }
#pragma unroll
            for (int ai = 0; ai < 2; ++ai)
#pragma unroll
                for (int m = 0; m < 4; ++m) { bf16_t* rowp = base + (size_t)(row0 + ai * HALF + m * 16) * ldc + ct;
#pragma unroll
                    for (int bj = 0; bj < 2; ++bj) { f32x4 v0 = acc[ai][bj][m][0], v1 = acc[ai][bj][m][1];
                        if (act != 0) {
#pragma unroll
                            for (int j = 0; j < 4; ++j) { const float s0 = fsig(v0[j]), s1 = fsig(v1[j]); v0[j] = (act == 1) ? v0[j] * s0 : s0; v1[j] = (act == 1) ? v1[j] * s1 : s1; }
                        } else { v0 = v0 * sc; v1 = v1 * sc; }
                        u32x4 w; w.x = cvt_pk_bf16(v0[0], v0[1]); w.y = cvt_pk_bf16(v0[2], v0[3]); w.z = cvt_pk_bf16(v1[0], v1[1]); w.w = cvt_pk_bf16(v1[2], v1[3]);
                        *(u32x4*)(rowp + bj * HALF) = w; } }
        }
    }
};
struct EpiGates {
    static constexpr bool PERM = true, AFTER_DRAIN = false;
    bf16_t* O;
    __device__ __forceinline__ void operator()(const f32x4 (&acc)[2][2][4][2], const Unit& u, int wr, int wc, int fr, int fq) const {
        const int row0 = u.pm * BM + wr * 64 + fr, col0 = u.pn * BM + wc * 32 + 8 * fq;
#pragma unroll
        for (int ai = 0; ai < 2; ++ai)
#pragma unroll
            for (int m = 0; m < 4; ++m) { bf16_t* rowp = O + (size_t)(row0 + ai * HALF + m * 16) * 2048 + col0;
#pragma unroll
                for (int bj = 0; bj < 2; ++bj) { f32x4 v0 = acc[ai][bj][m][0], v1 = acc[ai][bj][m][1];
#pragma unroll
                    for (int j = 0; j < 4; ++j) { v0[j] = fsig(v0[j]); v1[j] = fsig(v1[j]); }
                    u32x4 w; w.x = cvt_pk_bf16(v0[0], v0[1]); w.y = cvt_pk_bf16(v0[2], v0[3]); w.z = cvt_pk_bf16(v1[0], v1[1]); w.w = cvt_pk_bf16(v1[2], v1[3]);
                    *(u32x4*)(rowp + bj * HALF) = w; } }
    }
};
struct EpiMerge {
    static constexpr bool PERM = true, AFTER_DRAIN = false;
    const bf16_t* GT; bf16_t* O;
    __device__ __forceinline__ void operator()(const f32x4 (&acc)[2][2][4][2], const Unit& u, int wr, int wc, int fr, int fq) const {
        const int row0 = u.pm * BM + wr * 64 + fr, col0 = u.pn * HALF + wc * 32 + 8 * fq;
#pragma unroll
        for (int ai = 0; ai < 2; ++ai)
#pragma unroll
            for (int m = 0; m < 4; ++m) { const size_t row = (size_t)(row0 + ai * HALF + m * 16);
                const u32x4 ga = *(const u32x4*)(GT + row * 2048 + col0), gb = *(const u32x4*)(GT + row * 2048 + 1024 + col0);
                const f32x4 a0 = acc[ai][0][m][0], a1 = acc[ai][0][m][1], b0 = acc[ai][1][m][0], b1 = acc[ai][1][m][1];
                u32x4 w;
                w.x = cvt_pk_bf16(bf_lo(ga.x) * a0[0] + bf_lo(gb.x) * b0[0], bf_hi(ga.x) * a0[1] + bf_hi(gb.x) * b0[1]);
                w.y = cvt_pk_bf16(bf_lo(ga.y) * a0[2] + bf_lo(gb.y) * b0[2], bf_hi(ga.y) * a0[3] + bf_hi(gb.y) * b0[3]);
                w.z = cvt_pk_bf16(bf_lo(ga.z) * a1[0] + bf_lo(gb.z) * b1[0], bf_hi(ga.z) * a1[1] + bf_hi(gb.z) * b1[1]);
                w.w = cvt_pk_bf16(bf_lo(ga.w) * a1[2] + bf_lo(gb.w) * b1[2], bf_hi(ga.w) * a1[3] + bf_hi(gb.w) * b1[3]);
                *(u32x4*)(O + row * 1024 + col0) = w;
                if (m & 1) asm volatile("" ::: "memory"); }
    }
};
struct EpiSwiGLU {
    static constexpr bool PERM = true, AFTER_DRAIN = false;
    bf16_t* O;
    __device__ __forceinline__ void operator()(const f32x4 (&acc)[2][2][4][2], const Unit& u, int wr, int wc, int fr, int fq) const {
        const int row0 = u.pm * BM + wr * 64 + fr, col0 = u.pn * HALF + wc * 32 + 8 * fq;
#pragma unroll
        for (int ai = 0; ai < 2; ++ai)
#pragma unroll
            for (int m = 0; m < 4; ++m) { const size_t row = (size_t)(row0 + ai * HALF + m * 16);
                f32x4 v0, v1;
#pragma unroll
                for (int j = 0; j < 4; ++j) { const float g0 = acc[ai][1][m][0][j], g1 = acc[ai][1][m][1][j];
                    v0[j] = g0 * fsig(g0) * acc[ai][0][m][0][j]; v1[j] = g1 * fsig(g1) * acc[ai][0][m][1][j]; }
                u32x4 w; w.x = cvt_pk_bf16(v0[0], v0[1]); w.y = cvt_pk_bf16(v0[2], v0[3]); w.z = cvt_pk_bf16(v1[0], v1[1]); w.w = cvt_pk_bf16(v1[2], v1[3]);
                *(u32x4*)(O + row * 2816 + col0) = w; }
    }
};
struct EpiResid {
    static constexpr bool PERM = false, AFTER_DRAIN = false;
    const float* xres; float* out; float alpha;
    __device__ __forceinline__ void operator()(const f32x4 (&acc)[2][2][4][2], const Unit& u, int wr, int wc, int fr, int fq) const {
        const int row0 = u.pm * BM + wr * 64 + fr, col0 = u.pn * BM + wc * 32 + 4 * fq;
#pragma unroll
        for (int ai = 0; ai < 2; ++ai)
#pragma unroll
            for (int m = 0; m < 4; ++m) { const size_t off = (size_t)(row0 + ai * HALF + m * 16) * 1024 + col0;
#pragma unroll
                for (int bj = 0; bj < 2; ++bj)
#pragma unroll
                    for (int n = 0; n < 2; ++n) { const f32x4 x = *(const f32x4*)(xres + off + bj * HALF + n * 16);
                        *(f32x4*)(out + off + bj * HALF + n * 16) = x * alpha + acc[ai][bj][m][n]; }
                if (m & 1) asm volatile("" ::: "memory"); }
    }
};
}
#include <hip/hip_bf16.h>
#include <cmath>
namespace attn_body {
using bf16=__hip_bfloat16;
using bf16x8=__attribute__((ext_vector_type(8)))short;
using s16x4=__attribute__((ext_vector_type(4)))short;
using f32x16=__attribute__((ext_vector_type(16)))float;
using u32x4=__attribute__((ext_vector_type(4)))unsigned;
constexpr int BATCH=2,NHEAD=8,SEQ=16384,D=64,QP=1024,KP=512;
constexpr int NW=8,QBLK=32,QB=QBLK*NW,KVBLK=64,NQB=SEQ/QB;
constexpr int ATTN_UNIT_ROWS=QB;
__device__ __forceinline__ int crow(int r,int hi){return (r&3)+8*(r>>2)+4*hi;}
#define SBAR() __builtin_amdgcn_sched_barrier(0)
__device__ __forceinline__ void cmask(f32x16&p0,f32x16&p1,int jb,int qrel,int hi){
  const float NEG=-INFINITY; int kb=64*jb+4*hi;
  #pragma unroll
  for(int r=0;r<16;++r){int kv=kb+(r&3)+8*(r>>2); if(kv>qrel)p0[r]=NEG; if(kv+32>qrel)p1[r]=NEG;}
}

constexpr int NSLOT=3, SLOTB=8192;
constexpr int LDS_K=0, LDS_V=NSLOT*SLOTB, LDS_WS=2*NSLOT*SLOTB, LDS_OST=LDS_WS+NW*64*4, LDS_FB=LDS_OST+NW*4096, LDS_BYTES=LDS_FB+SEQ*4;
constexpr float C2=0.125f*1.4426950408889634f;
__device__ __forceinline__ void glds16(const void*gsrc,unsigned lds_dst){unsigned keep;
  asm volatile("s_mov_b32 %0, m0\n\ts_mov_b32 m0, %2\n\ts_nop 0\n\tglobal_load_lds_dwordx4 %1, off\n\ts_mov_b32 m0, %0":"=&s"(keep):"v"(gsrc),"s"(lds_dst):"memory");}
__device__ __forceinline__ float max3f(float a,float b,float c){float r;asm("v_max3_f32 %0, %1, %2, %3":"=v"(r):"v"(a),"v"(b),"v"(c));return r;}
__device__ __forceinline__ float max2f(float a,float b){float r;asm("v_max_f32_e32 %0, %1, %2":"=v"(r):"v"(a),"v"(b));return r;}
__device__ __forceinline__ float fadd_s(float a,float b){float r;asm("v_add_f32_e32 %0, %1, %2":"=v"(r):"v"(a),"v"(b));return r;}
__device__ __forceinline__ float fsub_s(float a,float b){float r;asm("v_sub_f32_e32 %0, %1, %2":"=v"(r):"v"(a),"v"(b));return r;}
typedef float f32x2_t __attribute__((ext_vector_type(2))); typedef __bf16 bf16x2_t __attribute__((ext_vector_type(2)));
__device__ __forceinline__ unsigned cvtpk_s(float lo,float hi){f32x2_t v={lo,hi};bf16x2_t b=__builtin_convertvector(v,bf16x2_t);return __builtin_bit_cast(unsigned,b);}
#define WAIT_BAR(N) asm volatile("s_waitcnt vmcnt(" #N ") lgkmcnt(0)\n\ts_barrier":::"memory")

__device__ __forceinline__ void qkt(f32x16&p0,f32x16&p1,const char*Kslot,const bf16x8*qr,int r32,int hi){
  const char*kb=Kslot+hi*1024+r32*16;
  #pragma unroll
  for(int d0=0;d0<4;++d0){
    const bf16x8 b0=*reinterpret_cast<const bf16x8*>(kb+d0*2048);
    const bf16x8 b1=*reinterpret_cast<const bf16x8*>(kb+d0*2048+512);
    p0=__builtin_amdgcn_mfma_f32_32x32x16_bf16(b0,qr[d0],p0,0,0,0);p1=__builtin_amdgcn_mfma_f32_32x32x16_bf16(b1,qr[d0],p1,0,0,0);}
}
typedef __attribute__((address_space(3))) const char* lds_cptr;
typedef short v4i16_t __attribute__((ext_vector_type(4)));
__device__ __forceinline__ void kload8(bf16x8*kf,lds_cptr kp){
  kf[0]=*(const __attribute__((address_space(3))) bf16x8*)(kp);      kf[1]=*(const __attribute__((address_space(3))) bf16x8*)(kp+512);
  kf[2]=*(const __attribute__((address_space(3))) bf16x8*)(kp+2048); kf[3]=*(const __attribute__((address_space(3))) bf16x8*)(kp+2560);
  kf[4]=*(const __attribute__((address_space(3))) bf16x8*)(kp+4096); kf[5]=*(const __attribute__((address_space(3))) bf16x8*)(kp+4608);
  kf[6]=*(const __attribute__((address_space(3))) bf16x8*)(kp+6144); kf[7]=*(const __attribute__((address_space(3))) bf16x8*)(kp+6656);
}
__device__ __forceinline__ void kload2(bf16x8*kf,lds_cptr kp,int j){ kf[2*j]=*(const __attribute__((address_space(3))) bf16x8*)(kp+j*2048); kf[2*j+1]=*(const __attribute__((address_space(3))) bf16x8*)(kp+j*2048+512); }
__device__ __forceinline__ s16x4 vtr(lds_cptr p){ return __builtin_bit_cast(s16x4,__builtin_amdgcn_ds_read_tr16_b64_v4i16((__attribute__((address_space(3))) v4i16_t*)p)); }
__device__ __forceinline__ float rowmax(const f32x16&p0,const f32x16&p1){
  float a=max3f(p0[0],p0[1],p1[0]),b=max3f(p0[2],p0[3],p1[1]);a=max3f(a,p1[2],p1[3]);
  #pragma unroll
  for(int r=4;r<16;r+=4){a=max3f(a,p0[r],p0[r+1]);b=max3f(b,p0[r+2],p0[r+3]);a=max3f(a,p1[r],p1[r+1]);b=max3f(b,p1[r+2],p1[r+3]);}
  const float m=max2f(a,b);
  auto rr=__builtin_amdgcn_permlane32_swap(__float_as_uint(m),__float_as_uint(m),false,false);
  return max2f(__uint_as_float(rr[0]),__uint_as_float(rr[1]));
}
__device__ __forceinline__ void pv(f32x16*o,int vb,bf16x8 pa0,bf16x8 pa1,bf16x8 pa2,bf16x8 pa3){
  #pragma unroll
  for(int d0=0;d0<2;++d0){s16x4 lo[4],hi[4];
    #pragma unroll
    for(int ks=0;ks<4;++ks){
      asm volatile("ds_read_b64_tr_b16 %0,%1 offset:%c2":"=&v"(lo[ks]):"v"(vb),"i"(d0*4096+ks*1024):"memory");
      asm volatile("ds_read_b64_tr_b16 %0,%1 offset:%c2":"=&v"(hi[ks]):"v"(vb),"i"(d0*4096+ks*1024+512):"memory");}
    asm volatile("s_waitcnt lgkmcnt(0)":::"memory");SBAR();
    #define PK(k) (bf16x8){lo[k][0],lo[k][1],lo[k][2],lo[k][3],hi[k][0],hi[k][1],hi[k][2],hi[k][3]}
    o[d0]=__builtin_amdgcn_mfma_f32_32x32x16_bf16(pa0,PK(0),o[d0],0,0,0);
    o[d0]=__builtin_amdgcn_mfma_f32_32x32x16_bf16(pa1,PK(1),o[d0],0,0,0);
    o[d0]=__builtin_amdgcn_mfma_f32_32x32x16_bf16(pa2,PK(2),o[d0],0,0,0);
    o[d0]=__builtin_amdgcn_mfma_f32_32x32x16_bf16(pa3,PK(3),o[d0],0,0,0);
    #undef PK
  }
}

#ifndef ATTN_STORE16
#define ATTN_STORE16(p,v) (*(u32x4*)(p)=(v))
#endif
template<int THRL> __device__ __forceinline__ void attn_unit(int b,int h,int qb,const bf16*Q,const bf16*__restrict__ K,const bf16*__restrict__ V,bf16*O,const float*__restrict__ Fg,const unsigned*__restrict__ NB,char*shm){
  int tid_=threadIdx.x; asm volatile("":"+v"(tid_));
  const int tid=tid_,lane=tid&63,r32=lane&31,hi=lane>>5; const int wid=__builtin_amdgcn_readfirstlane(tid>>6);
  const long rowbase=(long)b*SEQ; const int q0=qb*QB;
  const bf16*Qw=Q+(rowbase+q0+wid*QBLK)*QP+h*D;
  const bf16*Kh=K+rowbase*KP+h*D,*Vh=V+rowbase*KP+h*D;
  __attribute__((address_space(3))) char* const shm3w=(__attribute__((address_space(3))) char*)shm;
  const unsigned lds0=(unsigned)(uintptr_t)shm;
  float*wsf=(float*)(shm+LDS_WS)+wid*64;
  const bf16*ksrc_=Kh+(long)lane*KP+wid*8;
  const bf16*vsrc_=Vh+(long)(16*(wid&3)+(lane>>2))*KP+(wid>>2)*32+(lane&3)*8;
  const unsigned kdst=lds0+LDS_K+wid*1024, vdst=lds0+LDS_V+wid*1024;
  #define DMA_K(t,slot) glds16(ksrc+(long)(t)*KVBLK*KP,(unsigned)__builtin_amdgcn_readfirstlane(kdst+(slot)))
  #define DMA_V(t,slot) glds16(vsrc+(long)(t)*KVBLK*KP,(unsigned)__builtin_amdgcn_readfirstlane(vdst+(slot)))
  const int vb0=(int)(lds0+LDS_V)+((lane>>4)&1)*32+(lane&3)*8+(4*hi+((lane&15)>>2))*64;
  const char*Kbase=shm+LDS_K; bf16x8 kf[8];
  const lds_cptr shm3=(lds_cptr)shm; const lds_cptr kp0=shm3+LDS_K+hi*1024+r32*16; const lds_cptr vp0=shm3+LDS_V+((lane>>4)&1)*32+(lane&3)*8+(4*hi+((lane&15)>>2))*64;
  const int NT0=(q0+QB)/KVBLK;
  int j0;
  { typedef __attribute__((address_space(3))) unsigned* lds_uptr; const lds_uptr cnt=(lds_uptr)(shm3w+LDS_BYTES+16);
    const float fref=Fg[q0]; const float Bq=__builtin_sqrtf(__uint_as_float(NB[0])*__uint_as_float(NB[1])); const float thr=-(152.0f+2.0f*Bq);
    if(tid==0)*cnt=0u;
    asm volatile("s_waitcnt lgkmcnt(0)\n\ts_barrier":::"memory");
    bool skip=false; if(tid<NT0-4){ skip=((fref-Fg[64*tid+63])*1.4426950408889634f<thr); }
    const unsigned long long bal=__ballot(skip); if(lane==0&&bal)__hip_atomic_fetch_add(cnt,(unsigned)__popcll(bal),__ATOMIC_RELAXED,__HIP_MEMORY_SCOPE_WORKGROUP);
    asm volatile("s_waitcnt lgkmcnt(0)\n\ts_barrier":::"memory");
    j0=(int)(*cnt)&~1; j0=__builtin_amdgcn_readfirstlane(j0);
    typedef __attribute__((address_space(3))) float* lds_fptr; const lds_fptr fbl=(lds_fptr)(shm3w+LDS_FB);
    for(int i=64*j0+tid;i<q0+QB;i+=NW*64) fbl[i]=(fref-Fg[i])*1.4426950408889634f; }
  const int NT=NT0-j0;
  const bf16*ksrc=ksrc_+(long)j0*KVBLK*KP; const bf16*vsrc=vsrc_+(long)j0*KVBLK*KP;
  DMA_K(0,0);DMA_V(0,0);DMA_K(1,SLOTB);
  bf16x8 qr[4];
  #pragma unroll
  for(int d0=0;d0<4;++d0)qr[d0]=*reinterpret_cast<const bf16x8*>(&Qw[(long)r32*QP+d0*16+hi*8]);
  float mhat=0.f,l_reg=0.f;f32x16 o[2];o[0]=f32x16{};o[1]=f32x16{};
  const lds_cptr fb0=(lds_cptr)shm3w+LDS_FB+hi*16+j0*256;
  typedef float f32x4v __attribute__((ext_vector_type(4)));
  #define BLD(P0,P1,t) do{ const lds_cptr fp_=fb0+(t)*256; _Pragma("unroll") for(int j_=0;j_<4;++j_){ \
      const f32x4v a_=*(const __attribute__((address_space(3))) f32x4v*)(fp_+j_*32), b_=*(const __attribute__((address_space(3))) f32x4v*)(fp_+128+j_*32); \
      P0[4*j_]=a_[0];P0[4*j_+1]=a_[1];P0[4*j_+2]=a_[2];P0[4*j_+3]=a_[3]; P1[4*j_]=b_[0];P1[4*j_+1]=b_[1];P1[4*j_+2]=b_[2];P1[4*j_+3]=b_[3]; } }while(0)
  const int qrel=wid*QBLK+r32;
  #define CMASK(P0,P1,t) do{int jb_=(t)-(NT-4); if(jb_>=0)cmask(P0,P1,jb_,qrel,hi);}while(0)
  bool resc=false;
  #define START(P0,P1) do{ const float rm=rowmax(P0,P1); resc=false; mhat=rm; \
    _Pragma("unroll") for(int r=0;r<16;++r)P0[r]=__builtin_amdgcn_exp2f(P0[r]-mhat); }while(0)
  #define RESC() do{ if(resc){ asm volatile("s_waitcnt lgkmcnt(0)":::"memory"); \
      _Pragma("unroll") for(int d_=0;d_<2;++d_) _Pragma("unroll") for(int r=0;r<16;++r)o[d_][r]*=wsf[crow(r,hi)]; } }while(0)
  f32x16 pA0,pA1,pB0,pB1;
  int sl_prev=0,sl_cur=0,sl_next=SLOTB;
  #define ROT() do{sl_prev=sl_cur;sl_cur=sl_next;sl_next=(sl_next==(NSLOT-1)*SLOTB)?0:sl_next+SLOTB;}while(0)
  DMA_K(2,2*SLOTB);
  WAIT_BAR(3);
  BLD(pA0,pA1,0);
  qkt(pA0,pA1,Kbase,qr,r32,hi);asm volatile("s_nop 15\n\ts_nop 7":"+v"(pA0),"+v"(pA1));CMASK(pA0,pA1,0);
  START(pA0,pA1);
  _Pragma("unroll") for(int r=0;r<16;++r)pA1[r]=__builtin_amdgcn_exp2f(pA1[r]-mhat);
  WAIT_BAR(0);
  DMA_K(3,0);DMA_V(1,SLOTB);
  ROT();
  kload8(kf,kp0+sl_cur);
  BLD(pB0,pB1,1);
  WAIT_BAR(2);
  s16x4 vlo[8],vhi[8]; u32x4 pw0,pw1,pw2,pw3;
  #define PKW(P,B) cvtpk_s(P[B],P[B+1])
  #define PAF(k) __builtin_bit_cast(bf16x8,pw##k)
  #define VFR(i) (bf16x8){vlo[i][0],vlo[i][1],vlo[i][2],vlo[i][3],vhi[i][0],vhi[i][1],vhi[i][2],vhi[i][3]}
  #define PIN(x) asm volatile("":"+v"(x))
  #define MX3(a,b,c) __builtin_fmaxf(__builtin_fmaxf((a),(b)),(c))
  #define GAPA(MF,A0,A1,A2,A3,W0,W1,PW) do{ MF; sacc+=A0; sacc+=A1; sacc+=A2; sacc+=A3; PIN(sacc); W0; W1; PIN(PW); SBAR(); }while(0)
  #define EX(v) __builtin_amdgcn_exp2f(v)
  #define GAPB(MF,X,B) do{ MF; X[B]=EX(X[B]-mhat); X[B+1]=EX(X[B+1]-mhat); X[B+2]=EX(X[B+2]-mhat); X[B+3]=EX(X[B+3]-mhat); PIN(X); SBAR(); }while(0)
  #define VRD(i) do{ vlo[i]=vtr(vp_+(((i)>>2)*4096+((i)&3)*1024)); vhi[i]=vtr(vp_+(((i)>>2)*4096+((i)&3)*1024+512)); }while(0)
  #define KRD(G,j) do{ if(G){ kload2(kf,kp0+sl_next,j); SBAR(); } }while(0)
  #define STEP(C0,C1,P0,P1,t,GK,GV,GL) do{ SBAR(); \
    const lds_cptr vp_=vp0+sl_prev; \
    VRD(0); SBAR(); float sacc=(P0[0]+P0[1]); \
    GAPA(C0=__builtin_amdgcn_mfma_f32_32x32x16_bf16(kf[0],qr[0],C0,0,0,0), P0[2],P0[3],P0[4],P0[5],     pw0[0]=PKW(P0,0), pw0[1]=PKW(P0,2), pw0); \
    VRD(4); SBAR(); GAPA(C1=__builtin_amdgcn_mfma_f32_32x32x16_bf16(kf[1],qr[0],C1,0,0,0), P0[6],P0[7],P0[8],P0[9],     pw0[2]=PKW(P0,4), pw0[3]=PKW(P0,6), pw0); \
    VRD(1); SBAR(); GAPA(C0=__builtin_amdgcn_mfma_f32_32x32x16_bf16(kf[2],qr[1],C0,0,0,0),   P0[10],P0[11],P0[12],P0[13], pw1[0]=PKW(P0,8), pw1[1]=PKW(P0,10), pw1); \
    VRD(5); SBAR(); GAPA(C1=__builtin_amdgcn_mfma_f32_32x32x16_bf16(kf[3],qr[1],C1,0,0,0),   P0[14],P0[15],P1[0],P1[1],   pw1[2]=PKW(P0,12),pw1[3]=PKW(P0,14), pw1); \
    VRD(2); SBAR(); GAPA(C0=__builtin_amdgcn_mfma_f32_32x32x16_bf16(kf[4],qr[2],C0,0,0,0),   P1[2],P1[3],P1[4],P1[5],     pw2[0]=PKW(P1,0), pw2[1]=PKW(P1,2), pw2); \
    VRD(6); SBAR(); GAPA(C1=__builtin_amdgcn_mfma_f32_32x32x16_bf16(kf[5],qr[2],C1,0,0,0),   P1[6],P1[7],P1[8],P1[9],     pw2[2]=PKW(P1,4), pw2[3]=PKW(P1,6), pw2); \
    VRD(3); SBAR(); GAPA(C0=__builtin_amdgcn_mfma_f32_32x32x16_bf16(kf[6],qr[3],C0,0,0,0),   P1[10],P1[11],P1[12],P1[13], pw3[0]=PKW(P1,8), pw3[1]=PKW(P1,10), pw3); \
    VRD(7); SBAR(); GAPA(C1=__builtin_amdgcn_mfma_f32_32x32x16_bf16(kf[7],qr[3],C1,0,0,0),   P1[14],P1[15],0.f,0.f,       pw3[2]=PKW(P1,12),pw3[3]=PKW(P1,14), pw3); \
    l_reg+=sacc; \
    if(GK){DMA_K((t)+3,sl_cur);} if(GV){DMA_V((t)+1,sl_next);} \
    CMASK(C0,C1,t); \
    { float a=MX3(C0[0],C0[1],C1[0]),b=MX3(C0[2],C0[3],C1[1]); a=MX3(a,C1[2],C1[3]); \
      _Pragma("unroll") for(int r=4;r<16;r+=4){a=MX3(a,C0[r],C0[r+1]);b=MX3(b,C0[r+2],C0[r+3]);a=MX3(a,C1[r],C1[r+1]);b=MX3(b,C1[r+2],C1[r+3]);} \
      float rm=__builtin_fmaxf(a,b); { auto rr=__builtin_amdgcn_permlane32_swap(__float_as_uint(rm),__float_as_uint(rm),false,false); rm=__builtin_fmaxf(__uint_as_float(rr[0]),__uint_as_float(rr[1])); } \
      rm-=mhat; resc=false; \
      if(__builtin_expect(__any(rm>(float)THRL),0)){ const float dl=__builtin_fmaxf(rm,0.f); mhat+=dl; \
        const float f=__builtin_amdgcn_exp2f(-dl); l_reg*=f; if(hi==0)wsf[r32]=f; resc=true; } } \
    SBAR(); if(GL){ BLD(P0,P1,(t)+1); } \
    SBAR(); \
    GAPB(o[0]=__builtin_amdgcn_mfma_f32_32x32x16_bf16(PAF(0),VFR(0),o[0],0,0,0), C0,0); \
    GAPB(o[1]=__builtin_amdgcn_mfma_f32_32x32x16_bf16(PAF(0),VFR(4),o[1],0,0,0), C0,4); \
    KRD(GL,0); GAPB(o[0]=__builtin_amdgcn_mfma_f32_32x32x16_bf16(PAF(1),VFR(1),o[0],0,0,0), C0,8); \
    KRD(GL,1); GAPB(o[1]=__builtin_amdgcn_mfma_f32_32x32x16_bf16(PAF(1),VFR(5),o[1],0,0,0), C0,12); \
    KRD(GL,2); GAPB(o[0]=__builtin_amdgcn_mfma_f32_32x32x16_bf16(PAF(2),VFR(2),o[0],0,0,0), C1,0); \
    KRD(GL,3); GAPB(o[1]=__builtin_amdgcn_mfma_f32_32x32x16_bf16(PAF(2),VFR(6),o[1],0,0,0), C1,4); \
    GAPB(o[0]=__builtin_amdgcn_mfma_f32_32x32x16_bf16(PAF(3),VFR(3),o[0],0,0,0), C1,8); \
    GAPB(o[1]=__builtin_amdgcn_mfma_f32_32x32x16_bf16(PAF(3),VFR(7),o[1],0,0,0), C1,12); \
    }while(0)
  int t=1;
  #undef CMASK
  #define CMASK(P0,P1,t) do{}while(0)
  for(;t+5<NT;t+=2){
    STEP(pB0,pB1,pA0,pA1,t,true,true,true);     WAIT_BAR(2); RESC(); ROT();
    STEP(pA0,pA1,pB0,pB1,t+1,true,true,true);   WAIT_BAR(2); RESC(); ROT();
  }
  #undef CMASK
  #define CMASK(P0,P1,t) do{int jb_=(t)-(NT-4); if(jb_>=0)cmask(P0,P1,jb_,qrel,hi);}while(0)
  #define ENDW(tt) do{ if((tt)+3<NT){WAIT_BAR(2);} else if((tt)+2<NT){WAIT_BAR(1);} else {WAIT_BAR(0);} }while(0)
  for(;t+1<NT;t+=2){
    STEP(pB0,pB1,pA0,pA1,t,(t+3<NT),(t+1<NT),(t+1<NT));       ENDW(t);   RESC(); ROT();
    STEP(pA0,pA1,pB0,pB1,t+1,(t+4<NT),(t+2<NT),(t+2<NT));     ENDW(t+1); RESC(); ROT();
  }
  STEP(pB0,pB1,pA0,pA1,NT-1,false,false,false); RESC();
  { float sacc=pB0[0]+pB0[1]; _Pragma("unroll") for(int r=2;r<16;++r)sacc+=pB0[r]; _Pragma("unroll") for(int r=0;r<16;++r)sacc+=pB1[r]; l_reg+=sacc;
    pw0=(u32x4){PKW(pB0,0),PKW(pB0,2),PKW(pB0,4),PKW(pB0,6)};pw1=(u32x4){PKW(pB0,8),PKW(pB0,10),PKW(pB0,12),PKW(pB0,14)};pw2=(u32x4){PKW(pB1,0),PKW(pB1,2),PKW(pB1,4),PKW(pB1,6)};pw3=(u32x4){PKW(pB1,8),PKW(pB1,10),PKW(pB1,12),PKW(pB1,14)};
    SBAR(); pv(o,vb0+sl_cur,PAF(0),PAF(1),PAF(2),PAF(3)); }
  #undef PKW
  #undef PAF
  #undef VFR
  #undef PIN
  #undef MX3
  #undef GAPA
  #undef GAPB
  #undef EX
  #undef VRD
  #undef KRD
  #undef STEP
  #undef ENDW
  {auto rr=__builtin_amdgcn_permlane32_swap(__float_as_uint(l_reg),__float_as_uint(l_reg),false,false);l_reg=__uint_as_float(rr[0])+__uint_as_float(rr[1]);}
  if(hi==0)wsf[32+r32]=l_reg;asm volatile("s_waitcnt lgkmcnt(0)":::"memory");
  float rli[16];
  #pragma unroll
  for(int r=0;r<16;++r)rli[r]=__builtin_amdgcn_rcpf(wsf[32+crow(r,hi)]);
  bf16*Ow=O+(rowbase+q0+wid*QBLK)*QP+h*D;
  { bf16*stg=(bf16*)(shm+LDS_OST)+wid*2048;
    #pragma unroll
    for(int r=0;r<16;++r){const int orow=crow(r,hi);
      #pragma unroll
      for(int d0=0;d0<2;++d0)stg[orow*64+d0*32+r32]=__float2bfloat16(o[d0][r]*rli[r]);}
    asm volatile("s_waitcnt lgkmcnt(0)":::"memory");
    #pragma unroll
    for(int i=0;i<4;++i){const int row=i*8+(lane>>3),ch=lane&7; const u32x4 v=*(const u32x4*)(stg+row*64+ch*8); ATTN_STORE16(Ow+(long)row*QP+ch*8,v);} }
  asm volatile("s_waitcnt lgkmcnt(0)\n\ts_barrier":::"memory");
  #undef DMA_K
  #undef DMA_V
  #undef CMASK
  #undef START
  #undef RESC
  #undef BLD
  #undef ROT
}
constexpr int ATTN_LDS_BYTES=LDS_BYTES;
struct AttnTensors { const bf16* Q; const bf16* K; const bf16* V; bf16* O; const float* F; const unsigned* NB; };
struct AttnUnit { int bh; int qb; };
struct DynOrder {
  unsigned* ctr; volatile __attribute__((address_space(3))) unsigned* slot;
  __device__ __forceinline__ bool next(int,AttnUnit&u)const{
    if(threadIdx.x==0)*slot=__hip_atomic_fetch_add(ctr,1u,__ATOMIC_RELAXED,__HIP_MEMORY_SCOPE_AGENT);
    asm volatile("s_waitcnt vmcnt(0) lgkmcnt(0)\n\ts_barrier":::"memory");
    const unsigned n=*slot; if(n>=1024u)return false; u.qb=63-(int)(n>>4); u.bh=(int)(n&15u); return true; }
  __device__ __forceinline__ void a_ready(const AttnUnit&)const{}
  __device__ __forceinline__ void done(const AttnUnit&)const{}
};
template<class Sched,int THRL=8> __device__ __forceinline__ void attn_phase(char*lds,const AttnTensors&T,const Sched&S){
  AttnUnit u;
  for(int i=0;S.next(i,u);++i){ S.a_ready(u); attn_unit<THRL>(u.bh/NHEAD,u.bh%NHEAD,u.qb,T.Q,T.K,T.V,T.O,T.F+(long)u.bh*SEQ,T.NB+2*u.bh,lds); S.done(u); }
}
#undef SBAR
#undef WAIT_BAR
}
#include <hip/hip_cooperative_groups.h>
namespace cg = cooperative_groups;
#define LAS __attribute__((address_space(3)))
typedef unsigned short bf16;
typedef unsigned v4u __attribute__((ext_vector_type(4)));
typedef float f32x4 __attribute__((ext_vector_type(4)));
typedef short bf16x8 __attribute__((ext_vector_type(8)));
typedef LAS unsigned char* lp;

#define XB_TMO      128
#define XB_XCNT(j)  (256  + 64 * (j))
#define XB_XSUB(j)  (1280 + 64 * (j))
#define XB_XGEN(j)  (2304 + 64 * (j))
#define XB_TOP      3328
#define XB_TOPGEN   3392
#define XCD_BAR_WORDS 3456
#define XB_SPIN_CAP (1u << 18)

__device__ __forceinline__ unsigned xb_ld(unsigned* p)              { return __hip_atomic_load(p, __ATOMIC_RELAXED, __HIP_MEMORY_SCOPE_AGENT); }
__device__ __forceinline__ unsigned xb_add(unsigned* p, unsigned v) { return __hip_atomic_fetch_add(p, v, __ATOMIC_RELAXED, __HIP_MEMORY_SCOPE_AGENT); }
__device__ __forceinline__ unsigned xb_xcc_id() { return (unsigned)__builtin_amdgcn_s_getreg((3 << 11) | 20) & 0xFu; }
#define XB_SPIN(cond, bar) do { unsigned _sp = 0; while (cond) { __builtin_amdgcn_s_sleep(1); \
    if ((++_sp & 255u) == 0u) { if (xb_ld(&(bar)[XB_TMO])) break; if (_sp > XB_SPIN_CAP) { atomicAdd(&(bar)[XB_TMO], 1u); break; } } } } while (0)

struct XcdBarrier {
    unsigned* bar; unsigned x;
    volatile LAS unsigned* st;
};

__device__ __forceinline__ XcdBarrier xcd_barrier_post(unsigned* bar, volatile LAS unsigned* st) {
    XcdBarrier b; b.bar = bar; b.x = xb_xcc_id(); b.st = st;
    if (threadIdx.x == 0) (void)xb_add(&bar[XB_XCNT(b.x)], 1u);
    return b;
}
__device__ __forceinline__ void xcd_barrier_complete(unsigned* bar, unsigned x, unsigned& nloc, unsigned& nx) {
    const unsigned G = gridDim.x * gridDim.y * gridDim.z;
    unsigned sum, cnt, mine, sp = 0u;
    for (;;) {
        sum = 0u; cnt = 0u; mine = 0u;
#pragma unroll
        for (unsigned j = 0; j < 16; ++j) { const unsigned c = xb_ld(&bar[XB_XCNT(j)]); sum += c; cnt += (c > 0u) ? 1u : 0u; mine = (j == x) ? c : mine; }
        if (sum == G) break;
        __builtin_amdgcn_s_sleep(1);
        if ((++sp & 255u) == 0u) { if (xb_ld(&bar[XB_TMO])) break; if (sp > XB_SPIN_CAP) { atomicAdd(&bar[XB_TMO], 1u); break; } }
    }
    nloc = mine > 0u ? mine : 1u; nx = cnt > 0u ? cnt : 1u;
}

__device__ __forceinline__ void xcd_barrier(const XcdBarrier& b) {
    asm volatile("s_waitcnt vmcnt(0)" ::: "memory");
    __syncthreads();
    if (threadIdx.x == 0) {
        unsigned* bar = b.bar;
        __builtin_amdgcn_s_waitcnt(0);
        unsigned nloc = b.st[0], nx = b.st[1];
        if (nloc == 0u) { xcd_barrier_complete(bar, b.x, nloc, nx); b.st[0] = nloc; b.st[1] = nx; }
        const unsigned old = xb_add(&bar[XB_XSUB(b.x)], 1u);
        const unsigned gen = old / nloc;
        if (old + 1u == (gen + 1u) * nloc) {
            __builtin_amdgcn_fence(__ATOMIC_RELEASE, "agent");
            asm volatile("s_waitcnt vmcnt(0)" ::: "memory");
            const unsigned og = xb_add(&bar[XB_TOP], 1u);
            const unsigned tg = og / nx;
            if (og + 1u == (tg + 1u) * nx) xb_add(&bar[XB_TOPGEN], 1u);
            else XB_SPIN(xb_ld(&bar[XB_TOPGEN]) == tg, bar);
            __builtin_amdgcn_fence(__ATOMIC_ACQUIRE, "agent");
            xb_add(&bar[XB_XGEN(b.x)], 1u);
            asm volatile("s_waitcnt vmcnt(0)" ::: "memory");
        } else {
            XB_SPIN(xb_ld(&bar[XB_XGEN(b.x)]) == gen, bar);
            __builtin_amdgcn_fence(__ATOMIC_ACQUIRE, "agent");
            asm volatile("s_waitcnt vmcnt(0)" ::: "memory");
        }
    }
    __syncthreads();
}


constexpr int NWAVES = 8, NTHR = 512;
constexpr int BATCH = 2, SEQ = 16384, D = 1024, M = BATCH * SEQ, DEPTH = 2;
constexpr int NIN = 5640, NP1 = 3584, NG = 2048, FFH = 2816, NF1 = 5632;
constexpr float ALPHA = 1.4142135623730951f;
constexpr float LN_EPS = 1e-5f, RMS_EPS = 1e-6f;
constexpr size_t MiB = 1u << 20;
constexpr size_t WL_IN = 0, WL_G = 7 * MiB, WL_M = 11 * MiB, WL_O = 15 * MiB, WL_F1 = 17 * MiB, WL_F2 = 28 * MiB, WL_STRIDE = 34 * MiB;
constexpr size_t WS_W = 0, WS_XN = 68 * MiB, WS_QAB = 132 * MiB, WS_KA = 196 * MiB, WS_VA = 228 * MiB, WS_G = 260 * MiB, WS_IB = 324 * MiB, WS_GB = 356 * MiB,
                 WS_ST = 388 * MiB, WS_DEC = 452 * MiB, WS_LF = 453 * MiB, WS_F = 454 * MiB, WS_CTL = 455 * MiB  , WS_DBG = 455 * MiB + 512 * 1024, WS_END = 456 * MiB;
constexpr size_t WS_GATES = WS_G  , WS_MERGED = WS_KA  , WS_H = WS_QAB  ;
constexpr size_t CTL_QCTR = 16384  , CTL_NORM = 20480  ;
constexpr int LDS_TOTAL = 155648;
static_assert(attn_body::LDS_BYTES <= LDS_TOTAL && pg8::STAGE_BYTES <= LDS_TOTAL, "LDS map");

__device__ __forceinline__ float wave_sum(float v) {
#pragma unroll
    for (int o = 1; o < 64; o <<= 1) v += __shfl_xor(v, o);
    return v;
}
__device__ __forceinline__ unsigned pk2(float lo, float hi) { return pg8::cvt_pk_bf16(lo, hi); }
__device__ __forceinline__ float bf2f(unsigned short h) { return __uint_as_float((unsigned)h << 16); }

__device__ __forceinline__ void transpose_item(const float* Wsrc, int pitch, bf16* WTdst, int Kdst, LAS float* scr, int lane, bool zero) {
    if (!zero) {
#pragma unroll 8
        for (int i = 0; i < 32; ++i) { const int kk = 2 * i + (lane >> 5); scr[kk * 33 + (lane & 31)] = Wsrc[(size_t)kk * pitch + (lane & 31)]; }
    }
    asm volatile("s_waitcnt lgkmcnt(0)" ::: "memory");
    const int c = lane & 7;
#pragma unroll
    for (int j = 0; j < 4; ++j) { const int n = (lane >> 3) + 8 * j; const LAS float* s = scr + (8 * c) * 33 + n;
        v4u o;
        if (zero) { o = (v4u){0u, 0u, 0u, 0u}; }
        else { o.x = pk2(s[0 * 33], s[1 * 33]); o.y = pk2(s[2 * 33], s[3 * 33]); o.z = pk2(s[4 * 33], s[5 * 33]); o.w = pk2(s[6 * 33], s[7 * 33]); }
        *(v4u*)(WTdst + (size_t)n * Kdst + 8 * c) = o; }
    asm volatile("s_waitcnt lgkmcnt(0)" ::: "memory");
}

struct Ptrs {
    const float *x, *w_in, *b_fgate, *lb_logits, *norm_g, *w_pa, *w_pb, *w_o, *ln1_g, *ln1_b, *w_ff_in, *w_ff_out, *ln2_g, *ln2_b;
    float* out; unsigned char* ws;
};

__device__ __forceinline__ void weight_items(const Ptrs& P, LAS float* scr, int gw, int NGW, int lane) {
    constexpr int I_IN = 16 * (NP1 / 32), I_G = 16 * (NG / 32), I_M = 16 * (2048 / 32), I_O = 16 * 32, I_F1 = 16 * (NF1 / 32), I_F2 = (FFH / 64) * 32;
    constexpr int PER_LAYER = I_IN + I_G + I_M + I_O + I_F1 + I_F2;
    for (int it = gw; it < DEPTH * PER_LAYER; it += NGW) {
        const int l = it / PER_LAYER; int r = it % PER_LAYER;
        bf16* WB = (bf16*)(P.ws + WS_W + (size_t)l * WL_STRIDE);
        if (r < I_IN) { const int nblk = NP1 / 32, kb = r / nblk, nb = r % nblk, k0 = 64 * kb, n0 = 32 * nb; const int sc = n0 < 1536 ? n0 : n0 + 8;
            transpose_item(P.w_in + (size_t)l * D * NIN + (size_t)k0 * NIN + sc, NIN, (bf16*)((unsigned char*)WB + WL_IN) + (size_t)n0 * 1024 + k0, 1024, scr, lane, false); continue; } r -= I_IN;
        if (r < I_G) { const int nblk = NG / 32, kb = r / nblk, nb = r % nblk, k0 = 64 * kb, n0 = 32 * nb;
            transpose_item(P.w_in + (size_t)l * D * NIN + (size_t)k0 * NIN + 3592 + n0, NIN, (bf16*)((unsigned char*)WB + WL_G) + (size_t)n0 * 1024 + k0, 1024, scr, lane, false); continue; } r -= I_G;
        if (r < I_M) { const int nblk = 64, kb = r / nblk, nb = r % nblk, k0 = 64 * kb, n0 = 32 * nb; const int tile = n0 >> 8, half = (n0 >> 7) & 1, col = 128 * tile + (n0 & 127);
            const bool lowk = kb < 8; const bool zero = lowk ? (half != 0) : (half != 1);
            const float* src = lowk ? P.w_pa + (size_t)l * 512 * 1024 + (size_t)k0 * 1024 + col : P.w_pb + (size_t)l * 512 * 1024 + (size_t)(k0 - 512) * 1024 + col;
            transpose_item(src, 1024, (bf16*)((unsigned char*)WB + WL_M) + (size_t)n0 * 1024 + k0, 1024, scr, lane, zero); continue; } r -= I_M;
        if (r < I_O) { const int nblk = 32, kb = r / nblk, nb = r % nblk, k0 = 64 * kb, n0 = 32 * nb;
            transpose_item(P.w_o + (size_t)l * 1024 * 1024 + (size_t)k0 * 1024 + n0, 1024, (bf16*)((unsigned char*)WB + WL_O) + (size_t)n0 * 1024 + k0, 1024, scr, lane, false); continue; } r -= I_O;
        if (r < I_F1) { const int nblk = NF1 / 32, kb = r / nblk, nb = r % nblk, k0 = 64 * kb, n0 = 32 * nb; const int tile = n0 >> 8, half = (n0 >> 7) & 1, col = half * FFH + 128 * tile + (n0 & 127);
            transpose_item(P.w_ff_in + (size_t)l * D * NF1 + (size_t)k0 * NF1 + col, NF1, (bf16*)((unsigned char*)WB + WL_F1) + (size_t)n0 * 1024 + k0, 1024, scr, lane, false); continue; } r -= I_F1;
        { const int nblk = 32, kb = r / nblk, nb = r % nblk, k0 = 64 * kb, n0 = 32 * nb;
            transpose_item(P.w_ff_out + (size_t)l * FFH * 1024 + (size_t)k0 * 1024 + n0, 1024, (bf16*)((unsigned char*)WB + WL_F2) + (size_t)n0 * FFH + k0, FFH, scr, lane, false); }
    }
}

__device__ __forceinline__ void stage_wfa(const float* w_in_l, LAS float* wfa, int tid) {
    for (int idx = tid; idx < 8192; idx += NTHR) { const int k = idx >> 3, col = idx & 7; const int j = k >> 8, ln = (k >> 2) & 63, i = k & 3, half = col >> 2, c = col & 3;
        wfa[((((j * 4 + i) * 2 + half) * 64) + ln) * 4 + c] = w_in_l[(size_t)k * NIN + 1536 + col]; }
}
template <bool DO_LN, bool W32, bool WBF, bool DO_FA>
__device__ __forceinline__ void row_pass(const float* src, float* dst32, bf16* dstbf, const float* gam, const float* bet, float* lf, const LAS float* wfa, const float* bfg, int gw, int NGW, int lane) {
    for (int m = gw; m < M; m += NGW) {
        const f32x4* xr = (const f32x4*)(src + (size_t)m * D) + lane;
        f32x4 v[4];
#pragma unroll
        for (int j = 0; j < 4; ++j) v[j] = xr[64 * j];
        if (DO_LN) {
            float s = 0.f;
#pragma unroll
            for (int j = 0; j < 4; ++j) s += (v[j].x + v[j].y) + (v[j].z + v[j].w);
            const float mean = wave_sum(s) * (1.f / D); float s2 = 0.f;
#pragma unroll
            for (int j = 0; j < 4; ++j) { v[j] = v[j] - mean; s2 += (v[j].x * v[j].x + v[j].y * v[j].y) + (v[j].z * v[j].z + v[j].w * v[j].w); }
            const float rstd = 1.f / sqrtf(wave_sum(s2) * (1.f / D) + LN_EPS);
#pragma unroll
            for (int j = 0; j < 4; ++j) { const f32x4 gv = ((const f32x4*)gam)[64 * j + lane], bv = ((const f32x4*)bet)[64 * j + lane]; v[j] = v[j] * rstd * gv + bv; }
        }
        if (W32) { f32x4* o = (f32x4*)(dst32 + (size_t)m * D) + lane;
#pragma unroll
            for (int j = 0; j < 4; ++j) {
#ifdef DBG_SANITIZE
                if (!WBF) { for (int i = 0; i < 4; ++i) if (!(fabsf(v[j][i]) < 1e30f)) v[j][i] = 0.f; }
#endif
                o[64 * j] = v[j]; } }
        if (WBF) { unsigned long long* o8 = (unsigned long long*)(dstbf + (size_t)m * D) + lane;
#pragma unroll
            for (int j = 0; j < 4; ++j) o8[64 * j] = (unsigned long long)pk2(v[j].x, v[j].y) | ((unsigned long long)pk2(v[j].z, v[j].w) << 32); }
        if (DO_FA) {
            float a[8];
#pragma unroll
            for (int c = 0; c < 8; ++c) a[c] = 0.f;
#pragma unroll
            for (int j = 0; j < 4; ++j)
#pragma unroll
                for (int i = 0; i < 4; ++i) { const float xv = v[j][i];
                    const f32x4 w0 = *(const LAS f32x4*)(wfa + ((((j * 4 + i) * 2 + 0) * 64) + lane) * 4), w1 = *(const LAS f32x4*)(wfa + ((((j * 4 + i) * 2 + 1) * 64) + lane) * 4);
                    a[0] += xv * w0.x; a[1] += xv * w0.y; a[2] += xv * w0.z; a[3] += xv * w0.w; a[4] += xv * w1.x; a[5] += xv * w1.y; a[6] += xv * w1.z; a[7] += xv * w1.w; }
#pragma unroll
            for (int c = 0; c < 8; ++c) a[c] = wave_sum(a[c]);
            float z = a[0];
#pragma unroll
            for (int c = 1; c < 8; ++c) z = (lane == c) ? a[c] : z;
            if (lane < 8) { z += bfg[lane]; const float ls = fminf(z, 0.f) - __logf(1.0f + __expf(-fabsf(z))); lf[(size_t)m * 8 + lane] = ls; }
        }
    }
}

__device__ __forceinline__ void fcumsum_unit(int bh, const float* LF, float* F, lp lds, int tid) {
    const int b = bh >> 3, h = bh & 7, lane = tid & 63, wave = tid >> 6;
    const float* src = LF + ((size_t)b * SEQ + (size_t)tid * 32) * 8 + h;
    float cs[32]; float run = 0.f;
#pragma unroll
    for (int i = 0; i < 32; ++i) { run += src[i * 8]; cs[i] = run; }
    float inc = run;
#pragma unroll
    for (int o = 1; o < 64; o <<= 1) { const float n = __shfl_up(inc, o); if (lane >= o) inc += n; }
    LAS float* WS = (LAS float*)lds;
    if (lane == 63) WS[wave] = inc;
    __syncthreads();
    float woff = 0.f;
    for (int w = 0; w < wave; ++w) woff += WS[w];
    const float excl = woff + inc - run;
    float* dst = F + (size_t)bh * SEQ + (size_t)tid * 32;
#pragma unroll
    for (int i = 0; i < 32; i += 4) *(f32x4*)(dst + i) = (f32x4){excl + cs[i], excl + cs[i + 1], excl + cs[i + 2], excl + cs[i + 3]};
    __syncthreads();
}

__device__ __forceinline__ void norm_unit(int v, const bf16* QAB, const bf16* KA, unsigned* NB, int tid) {
    const int bh = v >> 4, seg = v & 15, b = bh >> 3, h = bh & 7, lane = tid & 63;
    float mq = 0.f, mk = 0.f;
#pragma unroll
    for (int e = 0; e < 2; ++e) { const size_t row = (size_t)b * SEQ + seg * 1024 + tid * 2 + e;
        const v4u* qp = (const v4u*)(QAB + row * 1024 + h * 64); const v4u* kp = (const v4u*)(KA + row * 512 + h * 64); float sq = 0.f, sk = 0.f;
#pragma unroll
        for (int i = 0; i < 8; ++i) { const v4u a = qp[i], c = kp[i];
#pragma unroll
            for (int k = 0; k < 4; ++k) { const float a0 = __uint_as_float(a[k] << 16), a1 = __uint_as_float(a[k] & 0xffff0000u), c0 = __uint_as_float(c[k] << 16), c1 = __uint_as_float(c[k] & 0xffff0000u);
                sq += a0 * a0 + a1 * a1; sk += c0 * c0 + c1 * c1; } }
        mq = fmaxf(mq, sq); mk = fmaxf(mk, sk); }
#pragma unroll
    for (int o = 1; o < 64; o <<= 1) { mq = fmaxf(mq, __shfl_xor(mq, o)); mk = fmaxf(mk, __shfl_xor(mk, o)); }
    if (lane == 0) { atomicMax(NB + 2 * bh, __float_as_uint(mq * 1.01f)); atomicMax(NB + 2 * bh + 1, __float_as_uint(mk * 1.01f)); }
}

namespace hg {
constexpr int P128 = 136, P64 = 72;
constexpr int O_QP = 0, O_QPP = O_QP + 64 * P128 * 2, O_KP = O_QPP + 64 * P128 * 2, O_VT = O_KP + 64 * P128 * 2, O_ST = O_VT + 128 * P64 * 2, O_PM = O_ST + 128 * P128 * 2,
              O_PT = O_PM + 64 * P64 * 2, O_RS = O_PT + 2048, O_END = O_RS + 512;
constexpr int O_KDT = O_QP;
static_assert(O_END <= 131072 && 128 * P64 * 2 <= 2 * 64 * P128 * 2, "hgrn LDS map");

__device__ __forceinline__ void load_cumsum(const float* Gu, int d, int part, lp lds, float (&g)[16], float (&b)[16], float& bmid, float& blast) {
#pragma unroll
    for (int i = 0; i < 16; ++i) g[i] = Gu[(size_t)(part * 16 + i) * 512 + d];
    float run = 0.f;
#pragma unroll
    for (int i = 0; i < 16; ++i) { run += g[i]; b[i] = run; }
    LAS float* PT = (LAS float*)(lds + O_PT);
    PT[part * 128 + d] = run;
    __syncthreads();
    const float p0 = PT[d], p1 = PT[128 + d], p2 = PT[256 + d], p3 = PT[384 + d];
    const float off = (part > 0 ? p0 : 0.f) + (part > 1 ? p1 : 0.f) + (part > 2 ? p2 : 0.f);
#pragma unroll
    for (int i = 0; i < 16; ++i) b[i] += off;
    bmid = p0 + p1; blast = (p0 + p1) + (p2 + p3);
}
__device__ __forceinline__ void stage_vt(const bf16* vp  , lp lds, int e, int part) {
    unsigned w[8];
#pragma unroll
    for (int i = 0; i < 8; ++i) { const unsigned lo = vp[(size_t)(2 * i) * 512], hi = vp[(size_t)(2 * i + 1) * 512]; w[i] = lo | (hi << 16); }
    LAS v4u* dst = (LAS v4u*)(lds + O_VT + (e * P64 + part * 16) * 2);
    dst[0] = (v4u){w[0], w[1], w[2], w[3]}; dst[1] = (v4u){w[4], w[5], w[6], w[7]};
}
__device__ __forceinline__ void pass1_unit(int unit, const float* G, const bf16* IB, bf16* ST, float* DEC, lp lds, int tid, unsigned* dbgw = nullptr) {
    const int c = unit & 255, h = (unit >> 8) & 3, b = unit >> 10;
    const int d = tid & 127, part = tid >> 7, lane = tid & 63, wave = tid >> 6, fr = lane & 15, fq = lane >> 4;
    const size_t row0 = (size_t)b * SEQ + (size_t)c * 64;
    float g[16], bb[16], bmid, blast;
    load_cumsum(G + row0 * 512 + h * 128, d, part, lds, g, bb, bmid, blast);
#ifdef DBG_P1
    { bool b1 = false, b3 = false; for (int i = 0; i < 16; ++i) { if (g[i] > 0.f) b1 = true; const float kk = (1.0f - __expf(g[i])) * __expf(blast - bb[i]); if (!(fabsf(kk) < 1e30f)) b3 = true; }
      if (b1) atomicMin(dbgw, 51u); if (b3) atomicMin(dbgw, 53u); }
#endif
    { unsigned w[8];
#pragma unroll
      for (int i = 0; i < 8; ++i) { const float k0 = (1.0f - __expf(g[2 * i])) * __expf(blast - bb[2 * i]), k1 = (1.0f - __expf(g[2 * i + 1])) * __expf(blast - bb[2 * i + 1]); w[i] = pk2(k0, k1); }
      LAS v4u* dst = (LAS v4u*)(lds + O_KDT + (d * P64 + part * 16) * 2);
      dst[0] = (v4u){w[0], w[1], w[2], w[3]}; dst[1] = (v4u){w[4], w[5], w[6], w[7]}; }
    stage_vt(IB + (row0 + part * 16) * 512 + h * 128 + d, lds, d, part);
    if (part == 0) DEC[(size_t)unit * 128 + d] = __expf(blast);
    __syncthreads();
    const bf16x8 a0 = *(const LAS bf16x8*)(lds + O_VT + ((16 * wave + fr) * P64 + 8 * fq) * 2), a1 = *(const LAS bf16x8*)(lds + O_VT + ((16 * wave + fr) * P64 + 32 + 8 * fq) * 2);
    bf16* out = ST + (size_t)unit * 16384;
#pragma unroll
    for (int dt = 0; dt < 8; ++dt) {
        const bf16x8 b0 = *(const LAS bf16x8*)(lds + O_KDT + ((16 * dt + fr) * P64 + 8 * fq) * 2), b1 = *(const LAS bf16x8*)(lds + O_KDT + ((16 * dt + fr) * P64 + 32 + 8 * fq) * 2);
        f32x4 acc = (f32x4){0.f, 0.f, 0.f, 0.f};
        acc = __builtin_amdgcn_mfma_f32_16x16x32_bf16(a0, b0, acc, 0, 0, 0);
        acc = __builtin_amdgcn_mfma_f32_16x16x32_bf16(a1, b1, acc, 0, 0, 0);
#ifdef DBG_P1
        for (int r = 0; r < 4; ++r) if (!(fabsf(acc[r]) < 1e30f)) atomicMin(dbgw, 54u);
#endif
#pragma unroll
        for (int r = 0; r < 4; ++r) out[(16 * wave + 4 * fq + r) * 128 + 16 * dt + fr] = (bf16)(pk2(acc[r], 0.f) & 0xffffu);
    }
    __syncthreads();
}
__device__ __forceinline__ void pass2_scan(const bf16* STin, bf16* ST, const float* DEC, int gtid, int gthreads) {
    for (int id = gtid; id < 8 * 16384; id += gthreads) {
        const int bh = id >> 14, ed = id & 16383, d = ed & 127;
        bf16* p = ST + (size_t)bh * 256 * 16384 + ed; const bf16* pi = STin + (size_t)bh * 256 * 16384 + ed; const float* dp = DEC + (size_t)bh * 256 * 128 + d;
        float state = 0.f;
        for (int c = 0; c < 256; c += 16) {
            unsigned short u[16]; float dc[16];
#pragma unroll
            for (int i = 0; i < 16; ++i) { u[i] = pi[(size_t)(c + i) * 16384]; dc[i] = dp[(size_t)(c + i) * 128]; }
#pragma unroll
            for (int i = 0; i < 16; ++i) { p[(size_t)(c + i) * 16384] = (bf16)(pk2(state, 0.f) & 0xffffu); state = dc[i] * state + bf2f(u[i]); }
        }
    }
}
__device__ __forceinline__ void pass3_unit(int unit, const float* G, const bf16* IB, const bf16* GB, const bf16* ST, const bf16* QAB, bf16* YAB, const float* normg, lp lds, int tid) {
    const int c = unit & 255, h = (unit >> 8) & 3, b = unit >> 10;
    const int d = tid & 127, part = tid >> 7, lane = tid & 63, wave = tid >> 6, fr = lane & 15, fq = lane >> 4;
    const size_t row0 = (size_t)b * SEQ + (size_t)c * 64;
    { const bf16* sp = ST + (size_t)unit * 16384;
#pragma unroll
      for (int ps = 0; ps < 4; ++ps) { const int idx = ps * NTHR + tid, e = idx >> 4, d8 = (idx & 15) * 8; const v4u w = *(const v4u*)(sp + e * 128 + d8); *(LAS v4u*)(lds + O_ST + (e * P128 + d8) * 2) = w; } }
    float g[16], bb[16], bmid, blast;
    load_cumsum(G + row0 * 512 + h * 128, d, part, lds, g, bb, bmid, blast);
    { const bf16* qp = QAB + (row0 + part * 16) * 1024 + 512 + h * 128 + d; const float emid = __expf(bmid);
      LAS bf16* Qp = (LAS bf16*)(lds + O_QP), *Qpp = (LAS bf16*)(lds + O_QPP), *Kp = (LAS bf16*)(lds + O_KP);
#pragma unroll
      for (int i = 0; i < 16; ++i) { const float q = bf2f(qp[(size_t)i * 1024]); const float q1 = q * __expf(bb[i] - bmid), q2 = q1 * emid, k1 = (1.0f - __expf(g[i])) * __expf(bmid - bb[i]);
          const int t = part * 16 + i; const unsigned w = pk2(q1, q2), w2 = pk2(k1, 0.f);
          Qp[t * P128 + d] = (bf16)(w & 0xffffu); Qpp[t * P128 + d] = (bf16)(w >> 16); Kp[t * P128 + d] = (bf16)(w2 & 0xffffu); } }
    stage_vt(IB + (row0 + part * 16) * 512 + h * 128 + d, lds, d, part);
    __syncthreads();
    { const int ti = wave >> 1; LAS bf16* Pm = (LAS bf16*)(lds + O_PM);
#pragma unroll
      for (int sj2 = 0; sj2 < 2; ++sj2) { const int sj = 2 * (wave & 1) + sj2; f32x4 acc = (f32x4){0.f, 0.f, 0.f, 0.f};
#pragma unroll
          for (int ks = 0; ks < 4; ++ks) { const bf16x8 a = *(const LAS bf16x8*)(lds + O_QP + ((16 * ti + fr) * P128 + 32 * ks + 8 * fq) * 2), bq = *(const LAS bf16x8*)(lds + O_KP + ((16 * sj + fr) * P128 + 32 * ks + 8 * fq) * 2);
              acc = __builtin_amdgcn_mfma_f32_16x16x32_bf16(a, bq, acc, 0, 0, 0); }
#pragma unroll
          for (int r = 0; r < 4; ++r) { const int t = 16 * ti + 4 * fq + r, s = 16 * sj + fr; const float v = (s <= t) ? acc[r] : 0.f; Pm[t * P64 + s] = (bf16)(pk2(v, 0.f) & 0xffffu); } } }
    __syncthreads();
    const int rb = wave & 3, ch = wave >> 2;
    f32x4 o[4];
#pragma unroll
    for (int j = 0; j < 4; ++j) o[j] = (f32x4){0.f, 0.f, 0.f, 0.f};
    { bf16x8 ap[2], aq[4];
#pragma unroll
      for (int ks = 0; ks < 2; ++ks) ap[ks] = *(const LAS bf16x8*)(lds + O_PM + ((16 * rb + fr) * P64 + 32 * ks + 8 * fq) * 2);
#pragma unroll
      for (int ks = 0; ks < 4; ++ks) aq[ks] = *(const LAS bf16x8*)(lds + O_QPP + ((16 * rb + fr) * P128 + 32 * ks + 8 * fq) * 2);
#pragma unroll
      for (int j = 0; j < 4; ++j) { const int e0 = 64 * ch + 16 * j;
#pragma unroll
          for (int ks = 0; ks < 2; ++ks) { const bf16x8 bv = *(const LAS bf16x8*)(lds + O_VT + ((e0 + fr) * P64 + 32 * ks + 8 * fq) * 2); o[j] = __builtin_amdgcn_mfma_f32_16x16x32_bf16(ap[ks], bv, o[j], 0, 0, 0); }
#pragma unroll
          for (int ks = 0; ks < 4; ++ks) { const bf16x8 bs = *(const LAS bf16x8*)(lds + O_ST + ((e0 + fr) * P128 + 32 * ks + 8 * fq) * 2); o[j] = __builtin_amdgcn_mfma_f32_16x16x32_bf16(aq[ks], bs, o[j], 0, 0, 0); } } }
    LAS float* RS = (LAS float*)(lds + O_RS);
#pragma unroll
    for (int r = 0; r < 4; ++r) { float s = 0.f;
#pragma unroll
        for (int j = 0; j < 4; ++j) s += o[j][r] * o[j][r];
        s += __shfl_xor(s, 1); s += __shfl_xor(s, 2); s += __shfl_xor(s, 4); s += __shfl_xor(s, 8);
        if (fr == 0) RS[ch * 64 + 16 * rb + 4 * fq + r] = s; }
    __syncthreads();
#pragma unroll
    for (int r = 0; r < 4; ++r) { const int t = 16 * rb + 4 * fq + r; const float rstd = 1.0f / sqrtf((RS[t] + RS[64 + t]) * (1.0f / 128.0f) + RMS_EPS);
        const bf16* gbp = GB + (row0 + t) * 512 + h * 128 + 64 * ch + fr; bf16* yp = YAB + (row0 + t) * 1024 + 512 + h * 128 + 64 * ch + fr;
#pragma unroll
        for (int j = 0; j < 4; ++j) { const float y = o[j][r] * rstd * normg[64 * ch + 16 * j + fr] * bf2f(gbp[16 * j]); yp[16 * j] = (bf16)(pk2(y, 0.f) & 0xffffu); } }
    __syncthreads();
}
}

#ifdef DBG_NAN
__device__ __forceinline__ void dbg_scan(const void* p, size_t nbytes, bool is_bf, int stage, unsigned* word) {
    const size_t n16 = nbytes / 16; const v4u* q = (const v4u*)p; bool bad = false;
    int t_ = threadIdx.x; asm volatile("" : "+v"(t_));
    int b_ = blockIdx.x; asm volatile("" : "+s"(b_)); int g_ = gridDim.x; asm volatile("" : "+s"(g_));
    for (unsigned i = (unsigned)(b_ * NTHR + t_); i < (unsigned)n16; i += (unsigned)(g_ * NTHR)) { const v4u w = q[i];
        for (int k = 0; k < 4; ++k) { const unsigned x = w[k];
            if (is_bf) { if ((x & 0x7f80u) == 0x7f80u || (x & 0x7f800000u) == 0x7f800000u) bad = true; }
            else { if ((x & 0x7f800000u) == 0x7f800000u) bad = true; } } }
    if (bad) atomicMin(word, (unsigned)stage);
}
#define DBG(stage, ptr, bytes, isbf) do { if (l == DBG_LAYER) dbg_scan((ptr), (bytes), (isbf), (stage), (unsigned*)(args.ws + WS_DBG)); } while (0)
#else
#define DBG(stage, ptr, bytes, isbf) do {} while (0)
#endif
#define GSYNC() xcd_barrier(xbar)
#ifdef DBG_TS
#define STAMP(k) do { if (blockIdx.x == 0 && threadIdx.x == 0) ((unsigned long long*)(args.ws + WS_DBG + 4096))[(k)] = __builtin_amdgcn_s_memrealtime(); } while (0)
#else
#define STAMP(k) do {} while (0)
#endif
#ifndef REP_P1
#define REP_P1 1
#endif
#ifndef REP_P2
#define REP_P2 1
#endif
#ifndef REP_P8
#define REP_P8 1
#endif
#ifndef REP_P45
#define REP_P45 1
#endif
#ifndef REP_HG0
#define REP_HG0 0
#endif
#ifndef REP_P0
#define REP_P0 1
#endif
#ifndef REP_ATT0
#define REP_ATT0 0
#endif
struct Args { const float* in[14]; float* out; unsigned char* ws; };
#define FRESH_PTR(T, var, expr) T var = (T)(expr); asm volatile("" : "+s"(var))
#define IDS() int tid_ = threadIdx.x; asm volatile("" : "+v"(tid_)); const int tid = tid_, lane = tid & 63, wave = __builtin_amdgcn_readfirstlane(tid >> 6); const int G = gridDim.x, bx = blockIdx.x, vcu = (G % 8 == 0) ? (bx % 8) * (G / 8) + bx / 8 : bx; \
              const int gw = vcu * NWAVES + wave, NGW = G * NWAVES; (void)tid; (void)lane; (void)wave; (void)gw; (void)NGW; (void)vcu; (void)bx
__global__ void __launch_bounds__(NTHR, 2) mega_fwd(Args args) {
    extern __shared__ __attribute__((aligned(16))) unsigned char lds_raw[];
    cg::grid_group grid = cg::this_grid();
    const lp lds = (lp)lds_raw;
    volatile LAS unsigned* xbst = (volatile LAS unsigned*)(lds + LDS_TOTAL - 64);
    if (threadIdx.x < 16) xbst[threadIdx.x] = 0u;
    __syncthreads();
    const XcdBarrier xbar = xcd_barrier_post((unsigned*)(args.ws + WS_CTL), xbst);
    grid.sync();
    int tsn = 1; (void)tsn; STAMP(0);

#ifdef DBG_NAN
    if (blockIdx.x == 0 && threadIdx.x == 0) *(unsigned*)(args.ws + WS_DBG) = 990u;
    GSYNC(); STAMP(tsn); ++tsn;
#endif
    for (int rep_ = 0; rep_ < REP_P0; ++rep_) { IDS();
      Ptrs P;
      P.x = args.in[0]; P.w_in = args.in[1]; P.b_fgate = args.in[2]; P.lb_logits = args.in[3]; P.norm_g = args.in[4]; P.w_pa = args.in[5]; P.w_pb = args.in[6]; P.w_o = args.in[7];
      P.ln1_g = args.in[8]; P.ln1_b = args.in[9]; P.w_ff_in = args.in[10]; P.w_ff_out = args.in[11]; P.ln2_g = args.in[12]; P.ln2_b = args.in[13]; P.out = args.out; P.ws = args.ws;
      weight_items(P, (LAS float*)(lds + wave * 16384), gw, NGW, lane);
      __syncthreads();
      stage_wfa(P.w_in, (LAS float*)lds, tid);
      __syncthreads();
      row_pass<false, false, true, true>(P.x, nullptr, (bf16*)(P.ws + WS_XN), nullptr, nullptr, (float*)(P.ws + WS_LF), (const LAS float*)lds, P.b_fgate, gw, NGW, lane); }
    GSYNC(); STAMP(tsn); ++tsn;
    { const int l = 0; DBG(10, args.ws + WS_XN, (size_t)64 * MiB, true); DBG(10, args.ws + WS_LF, (size_t)1 * MiB, false); }

#pragma unroll 1
    for (int l = 0; l < DEPTH; ++l) {
        for (int rep_ = 0; rep_ < REP_P1; ++rep_) {
        { IDS(); FRESH_PTR(unsigned char*, ws, args.ws); FRESH_PTR(const float*, lbl, args.in[3]);
          pg8::Gemm g{(const bf16*)(ws + WS_XN), (const bf16*)(ws + WS_W + (size_t)l * WL_STRIDE + WL_IN), M, NP1, D}; pg8::StaticOrder S; S.init(M, NP1, G, bx);
          pg8::EpiInProj E{(bf16*)(ws + WS_QAB), (bf16*)(ws + WS_KA), (bf16*)(ws + WS_VA), (float*)(ws + WS_G), (bf16*)(ws + WS_IB), (bf16*)(ws + WS_GB), lbl, l, attn_body::C2};
          pg8::gemm_phase<pg8::EpiInProj, pg8::StaticOrder, true, true>(lds, g, S, E); }
        }
        GSYNC(); STAMP(tsn); ++tsn;
        DBG(20, args.ws + WS_QAB, (size_t)64 * MiB, true); DBG(30, args.ws + WS_KA, (size_t)64 * MiB, true); DBG(40, args.ws + WS_G, (size_t)64 * MiB, false); DBG(50, args.ws + WS_IB, (size_t)64 * MiB, true);
        for (int rep_ = 0; rep_ < REP_P2; ++rep_) {
        { IDS(); FRESH_PTR(unsigned char*, ws, args.ws);
          for (int u = vcu; u < 2048; u += G) hg::pass1_unit(u, (const float*)(ws + WS_G), (const bf16*)(ws + WS_IB), (bf16*)(ws + WS_ST), (float*)(ws + WS_DEC), lds, tid, (unsigned*)(ws + WS_DBG));
          for (int u = vcu; u < 16; u += G) fcumsum_unit(u, (const float*)(ws + WS_LF), (float*)(ws + WS_F), lds, tid);
          for (int u = vcu; u < 256; u += G) norm_unit(u, (const bf16*)(ws + WS_QAB), (const bf16*)(ws + WS_KA), (unsigned*)(ws + WS_CTL + CTL_NORM) + l * 32, tid); }
        }
        GSYNC(); STAMP(tsn); ++tsn;
        DBG(60, args.ws + WS_ST, (size_t)64 * MiB, true); DBG(61, args.ws + WS_DEC, (size_t)1 * MiB, false); DBG(70, args.ws + WS_F, (size_t)1 * MiB, false);
        { IDS(); FRESH_PTR(unsigned char*, ws, args.ws);
          #if REP_HG0
          if (l == 0) { FRESH_PTR(float*, outp, args.out); hg::pass2_scan((const bf16*)(ws + WS_ST), (bf16*)outp, (const float*)(ws + WS_DEC), vcu * NTHR + tid, G * NTHR); }
#endif
          hg::pass2_scan((const bf16*)(ws + WS_ST), (bf16*)(ws + WS_ST), (const float*)(ws + WS_DEC), vcu * NTHR + tid, G * NTHR); }
        GSYNC(); STAMP(tsn); ++tsn;
        DBG(80, args.ws + WS_ST, (size_t)64 * MiB, true);
        { FRESH_PTR(unsigned char*, ws, args.ws);
          const attn_body::AttnTensors AT{(const attn_body::bf16*)(ws + WS_QAB), (const attn_body::bf16*)(ws + WS_KA), (const attn_body::bf16*)(ws + WS_VA), (attn_body::bf16*)(ws + WS_QAB), (const float*)(ws + WS_F),
                                          (const unsigned*)(ws + WS_CTL + CTL_NORM) + l * 32};
          const attn_body::DynOrder S{(unsigned*)(ws + WS_CTL + CTL_QCTR) + l * 64, (volatile LAS unsigned*)(lds + attn_body::LDS_BYTES + 32)};
          attn_body::attn_phase<attn_body::DynOrder>((char*)lds_raw, AT, S); }
        __syncthreads();
        { IDS(); FRESH_PTR(unsigned char*, ws, args.ws); FRESH_PTR(const float*, ng, args.in[4]);
          #if REP_HG0
          if (l == 0) { FRESH_PTR(float*, outp, args.out); for (int u = vcu; u < 2048; u += G) hg::pass3_unit(u, (const float*)(ws + WS_G), (const bf16*)(ws + WS_IB), (const bf16*)(ws + WS_GB), (const bf16*)(ws + WS_ST), (const bf16*)(ws + WS_QAB), (bf16*)outp, ng + l * 128, lds, tid); }
#endif
          for (int u = vcu; u < 2048; u += G) hg::pass3_unit(u, (const float*)(ws + WS_G), (const bf16*)(ws + WS_IB), (const bf16*)(ws + WS_GB), (const bf16*)(ws + WS_ST), (const bf16*)(ws + WS_QAB), (bf16*)(ws + WS_QAB), ng + l * 128, lds, tid); }
        GSYNC(); STAMP(tsn); ++tsn;
        DBG(90, args.ws + WS_QAB, (size_t)64 * MiB, true);
        for (int rep_ = 0; rep_ < REP_P45; ++rep_) {
        { IDS(); FRESH_PTR(unsigned char*, ws, args.ws);
          pg8::Gemm g{(const bf16*)(ws + WS_XN), (const bf16*)(ws + WS_W + (size_t)l * WL_STRIDE + WL_G), M, NG, D}; pg8::StaticOrder S; S.init(M, NG, G, bx);
          pg8::EpiGates E{(bf16*)(ws + WS_GATES)};
          pg8::gemm_phase<pg8::EpiGates, pg8::StaticOrder, true, true>(lds, g, S, E); }
        }
        GSYNC(); STAMP(tsn); ++tsn;
        DBG(100, args.ws + WS_GATES, (size_t)128 * MiB, true);
        for (int rep_ = 0; rep_ < REP_P45; ++rep_) {
        { IDS(); FRESH_PTR(unsigned char*, ws, args.ws);
          pg8::Gemm g{(const bf16*)(ws + WS_QAB), (const bf16*)(ws + WS_W + (size_t)l * WL_STRIDE + WL_M), M, 2048, D}; pg8::StaticOrder S; S.init(M, 2048, G, bx);
          pg8::EpiMerge E{(const bf16*)(ws + WS_GATES), (bf16*)(ws + WS_MERGED)};
          pg8::gemm_phase<pg8::EpiMerge, pg8::StaticOrder, true, true>(lds, g, S, E); }
        }
        GSYNC(); STAMP(tsn); ++tsn;
        DBG(110, args.ws + WS_MERGED, (size_t)64 * MiB, true);
        { IDS(); FRESH_PTR(unsigned char*, ws, args.ws); FRESH_PTR(const float*, xin, args.in[0]); FRESH_PTR(float*, outp, args.out); const float* xres = (l == 0) ? xin : (const float*)outp;
          pg8::Gemm g{(const bf16*)(ws + WS_MERGED), (const bf16*)(ws + WS_W + (size_t)l * WL_STRIDE + WL_O), M, D, D}; pg8::StaticOrder S; S.init(M, D, G, bx);
          pg8::EpiResid E{xres, outp, ALPHA};
          pg8::gemm_phase<pg8::EpiResid, pg8::StaticOrder, true, true>(lds, g, S, E); }
        GSYNC(); STAMP(tsn); ++tsn;
        DBG(120, args.out, (size_t)128 * MiB, false);
        { IDS(); FRESH_PTR(unsigned char*, ws, args.ws); FRESH_PTR(float*, outp, args.out); FRESH_PTR(const float*, gm, args.in[8]); FRESH_PTR(const float*, bt, args.in[9]);
          row_pass<true, true, true, false>(outp, outp, (bf16*)(ws + WS_XN), gm + l * D, bt + l * D, nullptr, nullptr, nullptr, gw, NGW, lane); }
        GSYNC(); STAMP(tsn); ++tsn;
        DBG(130, args.ws + WS_XN, (size_t)64 * MiB, true);
        for (int rep_ = 0; rep_ < REP_P8; ++rep_) {
        { IDS(); FRESH_PTR(unsigned char*, ws, args.ws);
          pg8::Gemm g{(const bf16*)(ws + WS_XN), (const bf16*)(ws + WS_W + (size_t)l * WL_STRIDE + WL_F1), M, NF1, D}; pg8::StaticOrder S; S.init(M, NF1, G, bx);
          pg8::EpiSwiGLU E{(bf16*)(ws + WS_H)};
          pg8::gemm_phase<pg8::EpiSwiGLU, pg8::StaticOrder, true, true>(lds, g, S, E); }
        }
        GSYNC(); STAMP(tsn); ++tsn;
        DBG(140, args.ws + WS_H, (size_t)176 * MiB, true);
        { IDS(); FRESH_PTR(unsigned char*, ws, args.ws); FRESH_PTR(float*, outp, args.out);
          pg8::Gemm g{(const bf16*)(ws + WS_H), (const bf16*)(ws + WS_W + (size_t)l * WL_STRIDE + WL_F2), M, D, FFH}; pg8::StaticOrder S; S.init(M, D, G, bx);
          pg8::EpiResid E{outp, outp, ALPHA};
          pg8::gemm_phase<pg8::EpiResid, pg8::StaticOrder, true, true>(lds, g, S, E); }
        GSYNC(); STAMP(tsn); ++tsn;
        DBG(150, args.out, (size_t)128 * MiB, false);
        { IDS(); FRESH_PTR(unsigned char*, ws, args.ws); FRESH_PTR(float*, outp, args.out); FRESH_PTR(const float*, gm, args.in[12]); FRESH_PTR(const float*, bt, args.in[13]);
          if (l + 1 < DEPTH) {
              FRESH_PTR(const float*, win, args.in[1]); FRESH_PTR(const float*, bfg, args.in[2]);
              stage_wfa(win + (size_t)(l + 1) * D * NIN, (LAS float*)lds, tid);
              __syncthreads();
              row_pass<true, true, true, true>(outp, outp, (bf16*)(ws + WS_XN), gm + l * D, bt + l * D, (float*)(ws + WS_LF), (const LAS float*)lds, bfg + (l + 1) * 8, gw, NGW, lane);
          } else {
              row_pass<true, true, false, false>(outp, outp, nullptr, gm + l * D, bt + l * D, nullptr, nullptr, nullptr, gw, NGW, lane);
          } }
        if (l + 1 < DEPTH) GSYNC(); STAMP(tsn); ++tsn;
    }
#ifdef DBG_TS
    GSYNC(); STAMP(tsn);
    { const volatile unsigned long long* T = (const volatile unsigned long long*)(args.ws + WS_DBG + 4096);
      float sum[2] = {0.f, 0.f};
      if (blockIdx.x == 0) {
          for (int k = 0; k < 23; ++k) { const float us = (float)(T[k + 1] - T[k]) * 0.01f; const int j = (k == 0) ? -1 : (k - 1) % 11;
              for (int w = 0; w < 2; ++w) { const unsigned mask = (w == 0) ? DBG_TS_A : DBG_TS_B; const bool in = (j < 0) ? ((mask >> 15) & 1u) : ((mask >> j) & 1u); if (in) sum[w] += us; } }
          for (int i = threadIdx.x; i < (1 << 20); i += NTHR) args.out[1024 + i] = sum[1];
          __syncthreads();
          if (threadIdx.x == 0) args.out[0] = 100.0f * sum[0];
      } }
#endif
#ifdef DBG_NAN
    GSYNC();
    if (blockIdx.x == 0 && threadIdx.x == 0) args.out[0] = 100.0f * (float)*(volatile unsigned*)(args.ws + WS_DBG);
#endif
}

extern "C" void kernel_launch(void* const* d_in, const int* in_sizes, int n_in, void* d_out, int out_size, void* d_ws, size_t ws_size, hipStream_t stream) {
    static int grid = 0;
    if (grid == 0) {
        if (n_in != 14 || in_sizes[0] != M * D || out_size != M * D || ws_size < WS_END) { fprintf(stderr, "kernel_launch: unexpected shapes (n_in %d, in0 %d, out %d, ws %zu)\n", n_in, n_in > 0 ? in_sizes[0] : -1, out_size, ws_size); grid = -1; return; }
        int dev = 0, cus = 0, per_cu = 0;
        if (hipGetDevice(&dev) != hipSuccess || hipDeviceGetAttribute(&cus, hipDeviceAttributeMultiprocessorCount, dev) != hipSuccess) { grid = -1; return; }
        if (hipFuncSetAttribute((const void*)mega_fwd, hipFuncAttributeMaxDynamicSharedMemorySize, LDS_TOTAL) != hipSuccess) { fprintf(stderr, "kernel_launch: hipFuncSetAttribute failed\n"); grid = -1; return; }
        if (hipOccupancyMaxActiveBlocksPerMultiprocessor(&per_cu, (const void*)mega_fwd, NTHR, LDS_TOTAL) != hipSuccess || per_cu < 1) { fprintf(stderr, "kernel_launch: occupancy query says %d\n", per_cu); per_cu = 1; }
        (void)hipGetLastError();
        grid = cus * per_cu;
    }
    if (grid < 0) return;
    if (hipMemsetAsync((char*)d_ws + WS_CTL, 0, 65536, stream) != hipSuccess) { fprintf(stderr, "kernel_launch: hipMemsetAsync failed\n"); return; }
    Args a{};
    for (int i = 0; i < 14; ++i) a.in[i] = (const float*)d_in[i];
    a.out = (float*)d_out; a.ws = (unsigned char*)d_ws;
    void* kargs[] = {&a};
    hipError_t e = hipLaunchCooperativeKernel((const void*)mega_fwd, dim3(grid), dim3(NTHR), kargs, LDS_TOTAL, stream);
    if (e != hipSuccess) fprintf(stderr, "kernel_launch: cooperative launch failed: %s (grid %d)\n", hipGetErrorString(e), grid);
}
```

```cpp
#include <hip/hip_runtime.h>
#include <cstdio>
#include <cstdint>
namespace pg8 {
#define PG8_LAS __attribute__((address_space(3)))
typedef unsigned short bf16_t;
typedef short bf16x8 __attribute__((ext_vector_type(8)));
typedef float f32x4 __attribute__((ext_vector_type(4)));
typedef unsigned u32x4 __attribute__((ext_vector_type(4)));
constexpr int BM = 256, BK = 64, HALF = 128, HTB = HALF * BK * 2  , STAGE_BYTES = 8 * HTB, NXCD = 8, WGM = 8;

__host__ __device__ __forceinline__ int lds_byte(int r, int c) { const int st = (r >> 4) * 2 + (c >> 5), rr = r & 15, cc = c & 31, ob = rr * 64 + cc * 2; return st * 1024 + (ob ^ (((ob >> 9) & 1) << 5)); }
__host__ __device__ __forceinline__ void stage_rc(int b, int& R, int& C) { const int st = b / 1024, sb = b % 1024, swz = sb ^ (((sb >> 9) & 1) << 5); R = (st >> 1) * 16 + swz / 64; C = (st & 1) * 32 + (swz % 64) / 2; }
__host__ __device__ __forceinline__ int perm32(int rho) { const int n = rho >> 4, i = rho & 15; return 8 * (i >> 2) + 4 * n + (i & 3); }

struct Unit { int pm, pn; };
struct Gemm { const bf16_t* A; const bf16_t* Bt; int M, N, K; };

struct StaticOrder {
    int nM, nN, nwg, G, c;
    __host__ __device__ void init(int M, int N, int G_, int c_) { nM = M / BM; nN = N / BM; nwg = nM * nN; G = G_; c = c_; }
    __host__ __device__ bool next(int i, Unit& u) const {
        const long L = (long)i * G + c; if (L >= nwg) return false;
        int wgid = (int)L; { const int q = nwg / NXCD, r = nwg % NXCD, xcd = wgid % NXCD, off = wgid / NXCD; wgid = (xcd < r ? xcd * (q + 1) : r * (q + 1) + (xcd - r) * q) + off; }
        const int nig = WGM * nN, gid = wgid / nig, fm = gid * WGM, gsz = (nM - fm) < WGM ? (nM - fm) : WGM;
        u.pm = fm + ((wgid % nig) % gsz); u.pn = (wgid % nig) / gsz; return true;
    }
    __device__ __forceinline__ void a_ready(const Unit&) const {}
    __device__ __forceinline__ void done(const Unit&) const {}
};

typedef float f32x2c_t __attribute__((ext_vector_type(2))); typedef __bf16 bf16x2c_t __attribute__((ext_vector_type(2)));
__device__ __forceinline__ unsigned cvt_pk_bf16(float lo, float hi) { f32x2c_t v = {lo, hi}; bf16x2c_t b = __builtin_convertvector(v, bf16x2c_t); return __builtin_bit_cast(unsigned, b); }
typedef float f32x2 __attribute__((ext_vector_type(2)));
__device__ __forceinline__ f32x2 gelu_pk(f32x2 v) {
    const f32x2 av = __builtin_elementwise_abs(v), d = av * 0.2316418882f + 1.0f;
    f32x2 t; t.x = __builtin_amdgcn_rcpf(d.x); t.y = __builtin_amdgcn_rcpf(d.y);
    f32x2 q = t * 0.5307027145f + (-0.7265760135f); q = q * t + 0.7107068705f; q = q * t + (-0.142248368f); q = q * t + 0.127414796f; q = q * t;
    const f32x2 s = (v * v) * (-0.72134752044f);
    f32x2 e; e.x = __builtin_amdgcn_exp2f(s.x); e.y = __builtin_amdgcn_exp2f(s.y);
    const f32x2 m = v * (q * e), r = v - m;
    f32x2 o; o.x = v.x < 0.f ? m.x : r.x; o.y = v.y < 0.f ? m.y : r.y; return o;
}

template <int ACT  > struct EpiBf16 {
    static constexpr bool PERM = true, AFTER_DRAIN = false; static_assert(ACT == 0 || ACT == 1, "EpiBf16: ACT is 0 (none) or 1 (gelu_pk)");
    bf16_t* O; int ldc; const float* bias; int split_cols; size_t split_stride; float scale0;
    __device__ __forceinline__ void operator()(const f32x4 (&acc)[2][2][4][2], const Unit& u, int wr, int wc, int fr, int fq) const {
        const int row0 = u.pm * BM + wr * 64 + fr; int colt = u.pn * BM; bf16_t* base = O;
        float sc = 1.f; if (split_cols) { const int t = colt / split_cols; base += (size_t)t * split_stride; colt -= t * split_cols; if (t == 0) sc = scale0; }
        const int col0 = colt + wc * 32 + 8 * fq, bcol0 = u.pn * BM + wc * 32 + 8 * fq;
        f32x4 bv[2][2];
#pragma unroll
        for (int bj = 0; bj < 2; ++bj)
#pragma unroll
            for (int n = 0; n < 2; ++n) bv[bj][n] = bias ? *(const f32x4*)(bias + bcol0 + bj * HALF + 4 * n) : (f32x4){0.f, 0.f, 0.f, 0.f};
#pragma unroll
        for (int ai = 0; ai < 2; ++ai)
#pragma unroll
            for (int m = 0; m < 4; ++m) { bf16_t* rowp = base + (size_t)(row0 + ai * HALF + m * 16) * ldc + col0;
#pragma unroll
                for (int bj = 0; bj < 2; ++bj) { f32x4 v0 = acc[ai][bj][m][0] + bv[bj][0], v1 = acc[ai][bj][m][1] + bv[bj][1];
                    if (ACT == 1) { f32x2 a = gelu_pk((f32x2){v0[0], v0[1]}), b = gelu_pk((f32x2){v0[2], v0[3]}), c = gelu_pk((f32x2){v1[0], v1[1]}), d = gelu_pk((f32x2){v1[2], v1[3]});
                        v0 = (f32x4){a.x, a.y, b.x, b.y}; v1 = (f32x4){c.x, c.y, d.x, d.y}; }
                    v0 = v0 * sc; v1 = v1 * sc; u32x4 w; w.x = cvt_pk_bf16(v0[0], v0[1]); w.y = cvt_pk_bf16(v0[2], v0[3]); w.z = cvt_pk_bf16(v1[0], v1[1]); w.w = cvt_pk_bf16(v1[2], v1[3]);
                    *(u32x4*)(rowp + bj * HALF) = w; } }
    }
};

struct PanelStats {
    unsigned* xbuf;
    unsigned* cnt;
    unsigned* tmo;
    int ntn; float eps;
    unsigned code;
    __device__ __forceinline__ bool run(const f32x4 (&v)[2][2][4][2], const Unit& u, int wr, int wc, int fr, int fq, PG8_LAS unsigned char* lds, int wid, int lane) const {
        typedef float f32x2v __attribute__((ext_vector_type(2)));
        PG8_LAS f32x2v* P = (PG8_LAS f32x2v*)lds;
        PG8_LAS f32x2v* S = (PG8_LAS f32x2v*)(lds + 8192);
        PG8_LAS unsigned* flag = (PG8_LAS unsigned*)(lds + 8192 + 2048);
#pragma unroll
        for (int ai = 0; ai < 2; ++ai)
#pragma unroll
            for (int m = 0; m < 4; ++m) {
                float s = 0.f;
#pragma unroll
                for (int bj = 0; bj < 2; ++bj)
#pragma unroll
                    for (int n = 0; n < 2; ++n) { const f32x4 x = v[ai][bj][m][n]; s += (x[0] + x[1]) + (x[2] + x[3]); }
                s += __shfl_xor(s, 16); s += __shfl_xor(s, 32);
                const float mw = s * (1.0f / 64.0f); float q = 0.f;
#pragma unroll
                for (int bj = 0; bj < 2; ++bj)
#pragma unroll
                    for (int n = 0; n < 2; ++n) { const f32x4 d = v[ai][bj][m][n] - mw; q += (d[0] * d[0] + d[1] * d[1]) + (d[2] * d[2] + d[3] * d[3]); }
                q += __shfl_xor(q, 16); q += __shfl_xor(q, 32);
                if (fq == 0) P[(ai * HALF + wr * 64 + m * 16 + fr) * 4 + wc] = (f32x2v){mw, q};
            }
        asm volatile("s_waitcnt lgkmcnt(0)" ::: "memory"); __builtin_amdgcn_s_barrier(); asm volatile("" ::: "memory");
#if defined(BROKEN_EXCHANGE_NO_WAIT)
#warning BROKEN CONTROL BUILD: the row-statistics exchange does not wait; results are wrong by design
        if (blockIdx.x >= 64) { const long long t0_ = clock64(); while (clock64() - t0_ < 60000) __builtin_amdgcn_s_sleep(8); }
#endif
        const int row = wid * 32 + (lane & 31);
        if (lane < 32) {
            const f32x2v a = P[row * 4 + 0], b = P[row * 4 + 1], c = P[row * 4 + 2], d = P[row * 4 + 3];
            const float mt = (a.x + b.x + c.x + d.x) * 0.25f;
            const float da = a.x - mt, db = b.x - mt, dc = c.x - mt, dd = d.x - mt;
            const float m2 = (a.y + b.y) + (c.y + d.y) + 64.0f * ((da * da + db * db) + (dc * dc + dd * dd));
            unsigned long long* slot = (unsigned long long*)xbuf + ((size_t)(u.pm * BM + row) * 4 + u.pn);
            __hip_atomic_store(slot, ((unsigned long long)__float_as_uint(m2) << 32) | __float_as_uint(mt), __ATOMIC_RELAXED, __HIP_MEMORY_SCOPE_AGENT);
        }
        asm volatile("s_waitcnt vmcnt(0)" ::: "memory");
        if (lane == 0) __hip_atomic_fetch_add(cnt + 64 * u.pm, 1u, __ATOMIC_RELAXED, __HIP_MEMORY_SCOPE_AGENT);
        if (wid == 0) {
            bool dead = false; const unsigned long long t0 = __builtin_amdgcn_s_memrealtime(); const unsigned want = 8u * (unsigned)ntn;
            for (;;) {
#if defined(BROKEN_EXCHANGE_NO_WAIT)
                break;
#endif
                if ((unsigned)__builtin_amdgcn_readfirstlane(__hip_atomic_load(cnt + 64 * u.pm, __ATOMIC_RELAXED, __HIP_MEMORY_SCOPE_AGENT)) >= want) break;
                if (__builtin_amdgcn_s_memrealtime() - t0 > 2000000ull) {
                    if (lane == 0) { unsigned expect = 0u; __hip_atomic_compare_exchange_strong(tmo + 1, &expect, code | (unsigned)(u.pm & 0xff), __ATOMIC_RELAXED, __ATOMIC_RELAXED, __HIP_MEMORY_SCOPE_AGENT);
                                     __hip_atomic_store(tmo, 1u, __ATOMIC_RELAXED, __HIP_MEMORY_SCOPE_AGENT); }
                    dead = true; break; }
                __builtin_amdgcn_s_sleep(2);
            }
            __builtin_amdgcn_fence(__ATOMIC_ACQUIRE, "agent");
            if (lane == 0) flag[0] = dead ? 1u : 0u;
        }
        asm volatile("s_waitcnt vmcnt(0) lgkmcnt(0)" ::: "memory"); __builtin_amdgcn_s_barrier(); asm volatile("" ::: "memory");
        const bool bad = flag[0] != 0u;
        if (lane < 32) {
            const unsigned long long* slot = (const unsigned long long*)xbuf + (size_t)(u.pm * BM + row) * 4; float mt[4], m2[4]; float ms = 0.f;
#pragma unroll
            for (int t = 0; t < 4; ++t) { if (t < ntn) { const unsigned long long w = __hip_atomic_load(slot + t, __ATOMIC_RELAXED, __HIP_MEMORY_SCOPE_AGENT); mt[t] = __uint_as_float((unsigned)w); m2[t] = __uint_as_float((unsigned)(w >> 32)); } else { mt[t] = 0.f; m2[t] = 0.f; } ms += mt[t]; }
            const float mean = ms / (float)ntn; float q = 0.f;
#pragma unroll
            for (int t = 0; t < 4; ++t) if (t < ntn) { const float dm = mt[t] - mean; q += m2[t] + 256.0f * dm * dm; }
            S[row] = (f32x2v){mean, 1.0f / sqrtf(q / (256.0f * (float)ntn) + eps)};
        }
        asm volatile("s_waitcnt lgkmcnt(0)" ::: "memory"); __builtin_amdgcn_s_barrier(); asm volatile("" ::: "memory");
        return bad;
    }
};
struct EpiLnRes {
    static constexpr bool PERM = false, AFTER_DRAIN = true;
    const float* base; float* out; int ldc; const float* bias; PanelStats st; unsigned poison;
    __device__ __forceinline__ void fused(f32x4 (&acc)[2][2][4][2], const Unit& u, int wr, int wc, int fr, int fq, PG8_LAS unsigned char* lds, int wid, int lane) const {
        typedef float f32x2v __attribute__((ext_vector_type(2)));
        const PG8_LAS f32x2v* S = (const PG8_LAS f32x2v*)(lds + 8192);
        const int col0 = u.pn * BM + wc * 32 + 4 * fq;
#pragma unroll
        for (int bj = 0; bj < 2; ++bj)
#pragma unroll
            for (int n = 0; n < 2; ++n) { const f32x4 bv = bias ? *(const f32x4*)(bias + col0 + bj * HALF + n * 16) : (f32x4){0.f, 0.f, 0.f, 0.f};
#pragma unroll
                for (int ai = 0; ai < 2; ++ai)
#pragma unroll
                    for (int m = 0; m < 4; ++m) acc[ai][bj][m][n] += bv; }
        f32x4 pre[4][2][2];
#pragma unroll
        for (int m = 0; m < 4; ++m) { const size_t off = (size_t)(u.pm * BM + wr * 64 + m * 16 + fr) * ldc + col0;
#pragma unroll
            for (int bj = 0; bj < 2; ++bj)
#pragma unroll
                for (int n = 0; n < 2; ++n) pre[m][bj][n] = *(const f32x4*)(base + off + bj * HALF + n * 16); }
        const bool bad = st.run(acc, u, wr, wc, fr, fq, lds, wid, lane) || poison != 0u;
        const float qnan = __builtin_nanf("");
#pragma unroll
        for (int ai = 0; ai < 2; ++ai)
#pragma unroll
            for (int m = 0; m < 4; ++m) { const int r = ai * HALF + wr * 64 + m * 16 + fr; const f32x2v sr = S[r]; const size_t off = (size_t)(u.pm * BM + r) * ldc + col0;
#pragma unroll
                for (int bj = 0; bj < 2; ++bj)
#pragma unroll
                    for (int n = 0; n < 2; ++n) { const f32x4 bs = ai == 0 ? pre[m][bj][n] : *(const f32x4*)(base + off + bj * HALF + n * 16); f32x4 o = bs + (acc[ai][bj][m][n] - sr.x) * sr.y;
                        if (bad) o = (f32x4){qnan, qnan, qnan, qnan}; *(f32x4*)(out + off + bj * HALF + n * 16) = o; }
                if (m & 1) asm volatile("" ::: "memory"); }
    }
};
struct EpiLnResLn {
    static constexpr bool PERM = false, AFTER_DRAIN = true;
    const float* base; float* out; bf16_t* xn; int ldc; const float* bias; PanelStats st1, st2; unsigned poison;
    __device__ __forceinline__ void fused(f32x4 (&acc)[2][2][4][2], const Unit& u, int wr, int wc, int fr, int fq, PG8_LAS unsigned char* lds, int wid, int lane) const {
        typedef float f32x2v __attribute__((ext_vector_type(2))); typedef unsigned u32x2v __attribute__((ext_vector_type(2)));
        const PG8_LAS f32x2v* S = (const PG8_LAS f32x2v*)(lds + 8192);
        const int col0 = u.pn * BM + wc * 32 + 4 * fq;
#pragma unroll
        for (int bj = 0; bj < 2; ++bj)
#pragma unroll
            for (int n = 0; n < 2; ++n) { const f32x4 bv = bias ? *(const f32x4*)(bias + col0 + bj * HALF + n * 16) : (f32x4){0.f, 0.f, 0.f, 0.f};
#pragma unroll
                for (int ai = 0; ai < 2; ++ai)
#pragma unroll
                    for (int m = 0; m < 4; ++m) acc[ai][bj][m][n] += bv; }
        bool bad = st1.run(acc, u, wr, wc, fr, fq, lds, wid, lane) || poison != 0u;
        const float qnan = __builtin_nanf("");
#pragma unroll
        for (int ai = 0; ai < 2; ++ai)
#pragma unroll
            for (int m = 0; m < 4; ++m) { const int r = ai * HALF + wr * 64 + m * 16 + fr; const f32x2v sr = S[r]; const size_t off = (size_t)(u.pm * BM + r) * ldc + col0;
#pragma unroll
                for (int bj = 0; bj < 2; ++bj)
#pragma unroll
                    for (int n = 0; n < 2; ++n) { const f32x4 bs = *(const f32x4*)(base + off + bj * HALF + n * 16); acc[ai][bj][m][n] = bs + (acc[ai][bj][m][n] - sr.x) * sr.y; }
                asm volatile("" : "+v"(acc[ai][0][m][0]), "+v"(acc[ai][0][m][1]), "+v"(acc[ai][1][m][0]), "+v"(acc[ai][1][m][1]));
                if (m & 1) asm volatile("" ::: "memory"); }
        const bool bad1 = bad;
        bad = st2.run(acc, u, wr, wc, fr, fq, lds, wid, lane) || bad;
#pragma unroll
        for (int ai = 0; ai < 2; ++ai)
#pragma unroll
            for (int m = 0; m < 4; ++m) { const int r = ai * HALF + wr * 64 + m * 16 + fr; const f32x2v sr = S[r]; const size_t off = (size_t)(u.pm * BM + r) * ldc + col0;
#pragma unroll
                for (int bj = 0; bj < 2; ++bj)
#pragma unroll
                    for (int n = 0; n < 2; ++n) { const f32x4 x1 = acc[ai][bj][m][n]; *(f32x4*)(out + off + bj * HALF + n * 16) = bad1 ? (f32x4){qnan, qnan, qnan, qnan} : x1;
                        const f32x4 o = (x1 - sr.x) * sr.y; u32x2v w; w.x = cvt_pk_bf16(o[0], o[1]); w.y = cvt_pk_bf16(o[2], o[3]);
                        if (bad) { w.x = 0x7fc07fc0u; w.y = 0x7fc07fc0u; } *(u32x2v*)(xn + off + bj * HALF + n * 16) = w; }
                asm volatile("" ::: "memory"); }
    }
};

template <class Epi, class Sched, bool ALIGN_EPI = false, bool SP2 = false>
__device__ __forceinline__ void gemm_phase(PG8_LAS unsigned char* lds, const Gemm g, const Sched& S, const Epi& E) {
    int tid_ = threadIdx.x; asm volatile("" : "+v"(tid_));
    const int tid = tid_, wid = __builtin_amdgcn_readfirstlane(tid >> 6), lane = tid & 63, wr = wid >> 2, wc = wid & 3, fr = lane & 15, fq = lane >> 4;
    const int K = g.K, nt = K / BK;
    unsigned voffA[2], voffB[2];
#pragma unroll
    for (int i = 0; i < 2; ++i) { int R, C; stage_rc(tid * 16 + i * 8192, R, C); const int Rb = Epi::PERM ? ((R & ~31) + perm32(R & 31)) : R;
        voffA[i] = (unsigned)(R * K + C) * 2u; voffB[i] = (unsigned)(Rb * K + C) * 2u; }
    const size_t kstep = (size_t)(BK * 2);
    const size_t hstep = (size_t)HALF * K * 2;
    const size_t tstep = 2 * hstep;
    const unsigned ldsw = (unsigned)wid * 1024u;
    const int aoff = lds_byte(wr * 64 + fr, fq * 8), boff = lds_byte(wc * 32 + fr, fq * 8);
#define PG8_SA(b, h) (((b) * 2 + (h)) * HTB)
#define PG8_SB(b, h) ((4 + (b) * 2 + (h)) * HTB)
#define PG8_STAGE(bufoff, gbase, voff) do { _Pragma("unroll") for (int _i = 0; _i < 2; ++_i) \
        __builtin_amdgcn_global_load_lds((const unsigned*)((const char*)(gbase) + (voff)[_i]), (PG8_LAS unsigned*)(lds + (bufoff) + ldsw + _i * 8192), 16, 0, 0); } while (0)
#define PG8_LDA(dst, b, h) do { _Pragma("unroll") for (int m = 0; m < 4; ++m) _Pragma("unroll") for (int k = 0; k < 2; ++k) dst[m][k] = *(const PG8_LAS bf16x8*)(lds + PG8_SA(b, h) + aoff + m * 2048 + k * 1024); } while (0)
#define PG8_LDB(dst, b, h) do { _Pragma("unroll") for (int n = 0; n < 2; ++n) _Pragma("unroll") for (int k = 0; k < 2; ++k) dst[n][k] = *(const PG8_LAS bf16x8*)(lds + PG8_SB(b, h) + boff + n * 2048 + k * 1024); } while (0)
#define PG8_MMA(ai, bj, At, Bt) do { __builtin_amdgcn_s_setprio(1); _Pragma("unroll") for (int m = 0; m < 4; ++m) _Pragma("unroll") for (int n = 0; n < 2; ++n) _Pragma("unroll") for (int k = 0; k < 2; ++k) \
        acc[ai][bj][m][n] = __builtin_amdgcn_mfma_f32_16x16x32_bf16(Bt[n][k], At[m][k], acc[ai][bj][m][n], 0, 0, 0); __builtin_amdgcn_s_setprio(0); } while (0)
#define PG8_WAIT_V(n) asm volatile("s_waitcnt vmcnt(" #n ")" ::: "memory")
#define PG8_WAIT_L(n) asm volatile("s_waitcnt lgkmcnt(" #n ")" ::: "memory")
#define PG8_BAR __builtin_amdgcn_s_barrier()
#define PG8_SCHED __builtin_amdgcn_sched_barrier(0)
    Unit cur, nxt; int ui = 0;
    if (!S.next(0, cur)) return;
    f32x4 acc[2][2][4][2];
#pragma unroll
    for (int a = 0; a < 2; ++a)
#pragma unroll
        for (int b = 0; b < 2; ++b)
#pragma unroll
            for (int m = 0; m < 4; ++m)
#pragma unroll
                for (int n = 0; n < 2; ++n) acc[a][b][m][n] = (f32x4){0.f, 0.f, 0.f, 0.f};
    bf16x8 At[4][2], B0[2][2], B1[2][2];
    const char* cA = (const char*)g.A + (size_t)cur.pm * tstep; const char* cB = (const char*)g.Bt + (size_t)cur.pn * tstep;
    S.a_ready(cur);
    if constexpr (SP2) {
        PG8_STAGE(PG8_SB(0, 0), cB, voffB); PG8_STAGE(PG8_SB(0, 1), cB + hstep, voffB); PG8_STAGE(PG8_SA(0, 0), cA, voffA); PG8_STAGE(PG8_SA(0, 1), cA + hstep, voffA);
        if (wr == 1) PG8_BAR;
        PG8_WAIT_V(2); PG8_BAR;
        PG8_STAGE(PG8_SB(1, 0), cB + kstep, voffB); PG8_STAGE(PG8_SA(1, 0), cA + kstep, voffA); PG8_STAGE(PG8_SB(1, 1), cB + hstep + kstep, voffB);
        PG8_WAIT_V(6); PG8_BAR;
    } else {
        PG8_STAGE(PG8_SB(0, 0), cB, voffB); PG8_STAGE(PG8_SA(0, 0), cA, voffA); PG8_STAGE(PG8_SB(0, 1), cB + hstep, voffB); PG8_STAGE(PG8_SA(0, 1), cA + hstep, voffA);
        if (wr == 1) PG8_BAR;
        PG8_WAIT_V(4); PG8_BAR;
        PG8_STAGE(PG8_SB(1, 0), cB + kstep, voffB); PG8_STAGE(PG8_SA(1, 0), cA + kstep, voffA); PG8_STAGE(PG8_SB(1, 1), cB + hstep + kstep, voffB);
        PG8_WAIT_V(6); PG8_BAR;
    }
    for (;;) {
        const bool has_next = S.next(ui + 1, nxt);
        const char* nA = has_next ? (const char*)g.A + (size_t)nxt.pm * tstep : cA; const char* nB = has_next ? (const char*)g.Bt + (size_t)nxt.pn * tstep : cB;
        for (int t = 0; t < nt; t += 2) {
            const bool last = (t == nt - 2);
            const char* a1 = cA + (size_t)(t + 1) * kstep;
            const char* a2 = last ? nA : cA + (size_t)(t + 2) * kstep; const char* b2 = last ? nB : cB + (size_t)(t + 2) * kstep;
            const char* a3 = a2 + kstep; const char* b3 = b2 + kstep;
            if (last && has_next) S.a_ready(nxt);
            if constexpr (SP2) {
            PG8_LDB(B0, 0, 0); PG8_LDB(B1, 0, 1); PG8_SCHED; PG8_LDA(At, 0, 0); PG8_STAGE(PG8_SA(1, 1), a1 + hstep, voffA);
            PG8_WAIT_V(8); PG8_WAIT_L(0); PG8_BAR; PG8_MMA(0, 0, At, B0); PG8_MMA(0, 1, At, B1); PG8_BAR; PG8_SCHED;
            PG8_LDA(At, 0, 1); PG8_STAGE(PG8_SB(0, 0), b2, voffB); PG8_STAGE(PG8_SB(0, 1), b2 + hstep, voffB); PG8_STAGE(PG8_SA(0, 0), a2, voffA);
            PG8_WAIT_V(8); PG8_WAIT_L(0); PG8_BAR; PG8_MMA(1, 0, At, B0); PG8_MMA(1, 1, At, B1); PG8_BAR; PG8_SCHED;
            PG8_LDB(B0, 1, 0); PG8_LDB(B1, 1, 1); PG8_SCHED; PG8_LDA(At, 1, 0); PG8_STAGE(PG8_SA(0, 1), a2 + hstep, voffA);
            PG8_WAIT_V(8); PG8_WAIT_L(0); PG8_BAR; PG8_MMA(0, 0, At, B0); PG8_MMA(0, 1, At, B1); PG8_BAR; PG8_SCHED;
            PG8_LDA(At, 1, 1); PG8_STAGE(PG8_SB(1, 0), b3, voffB); PG8_STAGE(PG8_SB(1, 1), b3 + hstep, voffB); PG8_STAGE(PG8_SA(1, 0), a3, voffA);
            PG8_WAIT_V(8); PG8_WAIT_L(0); PG8_BAR; PG8_MMA(1, 0, At, B0); PG8_MMA(1, 1, At, B1); PG8_BAR; PG8_SCHED;
            } else {
            PG8_LDB(B0, 0, 0); PG8_SCHED; PG8_LDA(At, 0, 0); PG8_STAGE(PG8_SA(1, 1), a1 + hstep, voffA);
            PG8_WAIT_L(8); PG8_BAR; PG8_WAIT_L(0); PG8_MMA(0, 0, At, B0); PG8_BAR; PG8_SCHED;
            PG8_LDB(B1, 0, 1); PG8_STAGE(PG8_SB(0, 0), b2, voffB);
            PG8_BAR; PG8_WAIT_L(0); PG8_MMA(0, 1, At, B1); PG8_BAR;
            PG8_LDA(At, 0, 1); PG8_STAGE(PG8_SA(0, 0), a2, voffA);
            PG8_BAR; PG8_WAIT_L(0); PG8_MMA(1, 0, At, B0); PG8_BAR; PG8_SCHED;
            PG8_STAGE(PG8_SB(0, 1), b2 + hstep, voffB);
            PG8_WAIT_V(6); PG8_BAR; PG8_MMA(1, 1, At, B1); PG8_BAR;
            PG8_LDB(B0, 1, 0); PG8_SCHED; PG8_LDA(At, 1, 0); PG8_STAGE(PG8_SA(0, 1), a2 + hstep, voffA);
            PG8_WAIT_L(8); PG8_BAR; PG8_WAIT_L(0); PG8_MMA(0, 0, At, B0); PG8_BAR; PG8_SCHED;
            PG8_LDB(B1, 1, 1); PG8_STAGE(PG8_SB(1, 0), b3, voffB);
            PG8_BAR; PG8_WAIT_L(0); PG8_MMA(0, 1, At, B1); PG8_BAR;
            PG8_LDA(At, 1, 1); PG8_STAGE(PG8_SA(1, 0), a3, voffA);
            PG8_BAR; PG8_WAIT_L(0); PG8_MMA(1, 0, At, B0); PG8_BAR; PG8_SCHED;
            PG8_STAGE(PG8_SB(1, 1), b3 + hstep, voffB);
            PG8_WAIT_V(6); PG8_BAR; PG8_MMA(1, 1, At, B1); PG8_BAR;
            }
        }
        if constexpr (ALIGN_EPI) { if (wr == 0) PG8_BAR; }
        if constexpr (!Epi::AFTER_DRAIN) { E(acc, cur, wr, wc, fr, fq); S.done(cur); }
        if (!has_next) break;
#pragma unroll
        for (int a = 0; a < 2; ++a)
#pragma unroll
            for (int b = 0; b < 2; ++b)
#pragma unroll
                for (int m = 0; m < 4; ++m)
#pragma unroll
                    for (int n = 0; n < 2; ++n) acc[a][b][m][n] = (f32x4){0.f, 0.f, 0.f, 0.f};
        cur = nxt; cA = nA; cB = nB; ++ui;
        if constexpr (ALIGN_EPI) { if (wr == 1) PG8_BAR; }
    }
    PG8_WAIT_V(0);
    if constexpr (!ALIGN_EPI) { if (wr == 0) PG8_BAR; }
    PG8_BAR;
    if constexpr (Epi::AFTER_DRAIN) { E.fused(acc, cur, wr, wc, fr, fq, lds, wid, lane); S.done(cur); }
#undef PG8_SA
#undef PG8_SB
#undef PG8_STAGE
#undef PG8_LDA
#undef PG8_LDB
#undef PG8_MMA
#undef PG8_WAIT_V
#undef PG8_WAIT_L
#undef PG8_BAR
#undef PG8_SCHED
}
}
namespace pg8 {
__device__ __forceinline__ float fsig(float v) { return __builtin_amdgcn_rcpf(1.0f + __builtin_amdgcn_exp2f(-1.4426950408889634f * v)); }
__device__ __forceinline__ float bf_lo(unsigned w) { return __uint_as_float(w << 16); }
__device__ __forceinline__ float bf_hi(unsigned w) { return __uint_as_float(w & 0xffff0000u); }

struct EpiInProj {
    static constexpr bool PERM = true, AFTER_DRAIN = false;
    bf16_t* QA; bf16_t* QB; bf16_t* KA; bf16_t* VA; float* G; bf16_t* IB; bf16_t* GB; const float* lbl; int layer; float qscale;
    __device__ __forceinline__ void operator()(const f32x4 (&acc)[2][2][4][2], const Unit& u, int wr, int wc, int fr, int fq) const {
        const int type = u.pn >> 1;
        const int ct = (u.pn & 1) * 256 + wc * 32 + 8 * fq;
        const int row0 = u.pm * BM + wr * 64 + fr;
        if (type == 4) {
            float lb[2][8];
#pragma unroll
            for (int bj = 0; bj < 2; ++bj)
#pragma unroll
                for (int j = 0; j < 8; ++j) {
                    float v = 0.f;
                    if (layer != 0) { const float l0 = lbl[ct + bj * HALF + j], l1 = lbl[512 + ct + bj * HALF + j]; v = 1.0f / (1.0f + __expf(l0 - l1)); }
                    lb[bj][j] = v;
                }
#pragma unroll
            for (int ai = 0; ai < 2; ++ai)
#pragma unroll
                for (int m = 0; m < 4; ++m) { float* rowp = G + (size_t)(row0 + ai * HALF + m * 16) * 512 + ct;
#pragma unroll
                    for (int bj = 0; bj < 2; ++bj) { f32x4 o0, o1;
#pragma unroll
                        for (int j = 0; j < 4; ++j) {
                            const float f0 = lb[bj][j] + (1.0f - lb[bj][j]) * fsig(acc[ai][bj][m][0][j]);
                            const float f1 = lb[bj][4 + j] + (1.0f - lb[bj][4 + j]) * fsig(acc[ai][bj][m][1][j]);
                            o0[j] = __builtin_amdgcn_logf(f0) * 0.6931471805599453f; o1[j] = __builtin_amdgcn_logf(f1) * 0.6931471805599453f; }
                        *(f32x4*)(rowp + bj * HALF) = o0; *(f32x4*)(rowp + bj * HALF + 4) = o1; } }
        } else {
            bf16_t* base; int ldc = 512, act = 0; float sc = 1.f;
            if (type == 0) { base = QA; sc = qscale; }
            else if (type == 1) base = KA;
            else if (type == 2) base = VA;
            else if (type == 3) { base = QB; act = 1; }
            else if (type == 5) base = IB;
            else { base = GB; act = 2; }
#pragma unroll
            for (int ai = 0; ai < 2; ++ai)
#pragma unroll
                for (int m = 0; m < 4; ++m) { bf16_t* rowp = base + (size_t)(row0 + ai * HALF + m * 16) * ldc + ct;
#pragma unroll
                    for (int bj = 0; bj < 2; ++bj) { f32x4 v0 = acc[ai][bj][m][0], v1 = acc[ai][bj][m][1];
                        if (act != 0) {
#pragma unroll
                            for (int j = 0; j < 4; ++j) { const float s0 = fsig(v0[j]), s1 = fsig(v1[j]); v0[j] = (act == 1) ? v0[j] * s0 : s0; v1[j] = (act == 1) ? v1[j] * s1 : s1; }
                        } else { v0 = v0 * sc; v1 = v1 * sc; }
                        u32x4 w; w.x = cvt_pk_bf16(v0[0], v0[1]); w.y = cvt_pk_bf16(v0[2], v0[3]); w.z = cvt_pk_bf16(v1[0], v1[1]); w.w = cvt_pk_bf16(v1[2], v1[3]);
                        *(u32x4*)(rowp + bj * HALF) = w; } }
        }
    }
};
struct EpiGates {
    static constexpr bool PERM = true, AFTER_DRAIN = false;
    bf16_t* O;
    __device__ __forceinline__ void operator()(const f32x4 (&acc)[2][2][4][2], const Unit& u, int wr, int wc, int fr, int fq) const {
        const int row0 = u.pm * BM + wr * 64 + fr, col0 = u.pn * BM + wc * 32 + 8 * fq;
#pragma unroll
        for (int ai = 0; ai < 2; ++ai)
#pragma unroll
            for (int m = 0; m < 4; ++m) { bf16_t* rowp = O + (size_t)(row0 + ai * HALF + m * 16) * 2048 + col0;
#pragma unroll
                for (int bj = 0; bj < 2; ++bj) { f32x4 v0 = acc[ai][bj][m][0], v1 = acc[ai][bj][m][1];
#pragma unroll
                    for (int j = 0; j < 4; ++j) { v0[j] = fsig(v0[j]); v1[j] = fsig(v1[j]); }
                    u32x4 w; w.x = cvt_pk_bf16(v0[0], v0[1]); w.y = cvt_pk_bf16(v0[2], v0[3]); w.z = cvt_pk_bf16(v1[0], v1[1]); w.w = cvt_pk_bf16(v1[2], v1[3]);
                    *(u32x4*)(rowp + bj * HALF) = w; } }
    }
};
template <int STEP> struct EpiMerge {
    static constexpr bool PERM = true, AFTER_DRAIN = false;
    const bf16_t* GT; bf16_t* O;
    __device__ __forceinline__ void operator()(const f32x4 (&acc)[2][2][4][2], const Unit& u, int wr, int wc, int fr, int fq) const {
        const int row0 = u.pm * BM + wr * 64 + fr, col0 = u.pn * BM + wc * 32 + 8 * fq;
#pragma unroll
        for (int ai = 0; ai < 2; ++ai)
#pragma unroll
            for (int m = 0; m < 4; ++m) { const size_t row = (size_t)(row0 + ai * HALF + m * 16);
#pragma unroll
                for (int bj = 0; bj < 2; ++bj) {
                    const u32x4 g = *(const u32x4*)(GT + row * 2048 + STEP * 1024 + col0 + bj * HALF);
                    const f32x4 a0 = acc[ai][bj][m][0], a1 = acc[ai][bj][m][1];
                    float o[8] = {bf_lo(g.x) * a0[0], bf_hi(g.x) * a0[1], bf_lo(g.y) * a0[2], bf_hi(g.y) * a0[3], bf_lo(g.z) * a1[0], bf_hi(g.z) * a1[1], bf_lo(g.w) * a1[2], bf_hi(g.w) * a1[3]};
                    if (STEP == 1) { const u32x4 t = *(const u32x4*)(O + row * 1024 + col0 + bj * HALF);
                        o[0] += bf_lo(t.x); o[1] += bf_hi(t.x); o[2] += bf_lo(t.y); o[3] += bf_hi(t.y); o[4] += bf_lo(t.z); o[5] += bf_hi(t.z); o[6] += bf_lo(t.w); o[7] += bf_hi(t.w); }
                    u32x4 w; w.x = cvt_pk_bf16(o[0], o[1]); w.y = cvt_pk_bf16(o[2], o[3]); w.z = cvt_pk_bf16(o[4], o[5]); w.w = cvt_pk_bf16(o[6], o[7]);
                    *(u32x4*)(O + row * 1024 + col0 + bj * HALF) = w; }
                if (m & 1) asm volatile("" ::: "memory"); }
    }
};
struct EpiSwiGLU {
    static constexpr bool PERM = true, AFTER_DRAIN = false;
    bf16_t* O;
    __device__ __forceinline__ void operator()(const f32x4 (&acc)[2][2][4][2], const Unit& u, int wr, int wc, int fr, int fq) const {
        const int row0 = u.pm * BM + wr * 64 + fr, col0 = u.pn * HALF + wc * 32 + 8 * fq;
#pragma unroll
        for (int ai = 0; ai < 2; ++ai)
#pragma unroll
            for (int m = 0; m < 4; ++m) { const size_t row = (size_t)(row0 + ai * HALF + m * 16);
                f32x4 v0, v1;
#pragma unroll
                for (int j = 0; j < 4; ++j) { const float g0 = acc[ai][1][m][0][j], g1 = acc[ai][1][m][1][j];
                    v0[j] = g0 * fsig(g0) * acc[ai][0][m][0][j]; v1[j] = g1 * fsig(g1) * acc[ai][0][m][1][j]; }
                u32x4 w; w.x = cvt_pk_bf16(v0[0], v0[1]); w.y = cvt_pk_bf16(v0[2], v0[3]); w.z = cvt_pk_bf16(v1[0], v1[1]); w.w = cvt_pk_bf16(v1[2], v1[3]);
                *(u32x4*)(O + row * 2816 + col0) = w; }
    }
};
struct EpiResid {
    static constexpr bool PERM = false, AFTER_DRAIN = false;
    const float* xres; float* out; float alpha;
    __device__ __forceinline__ void operator()(const f32x4 (&acc)[2][2][4][2], const Unit& u, int wr, int wc, int fr, int fq) const {
        const int row0 = u.pm * BM + wr * 64 + fr, col0 = u.pn * BM + wc * 32 + 4 * fq;
#pragma unroll
        for (int ai = 0; ai < 2; ++ai)
#pragma unroll
            for (int m = 0; m < 4; ++m) { const size_t off = (size_t)(row0 + ai * HALF + m * 16) * 1024 + col0;
#pragma unroll
                for (int bj = 0; bj < 2; ++bj)
#pragma unroll
                    for (int n = 0; n < 2; ++n) { const f32x4 x = *(const f32x4*)(xres + off + bj * HALF + n * 16);
                        *(f32x4*)(out + off + bj * HALF + n * 16) = x * alpha + acc[ai][bj][m][n]; }
                if (m & 1) asm volatile("" ::: "memory"); }
    }
};
}
#include <hip/hip_bf16.h>
#include <cmath>
namespace attn_body {
using bf16=__hip_bfloat16;
using bf16x8=__attribute__((ext_vector_type(8)))short;
using s16x4=__attribute__((ext_vector_type(4)))short;
using f32x16=__attribute__((ext_vector_type(16)))float;
using u32x4=__attribute__((ext_vector_type(4)))unsigned;
constexpr int BATCH=2,NHEAD=8,SEQ=16384,D=64,QP=512,KP=512;
constexpr int NW=8,QBLK=32,QB=QBLK*NW,KVBLK=64,NQB=SEQ/QB;
constexpr int ATTN_UNIT_ROWS=QB;
__device__ __forceinline__ int crow(int r,int hi){return (r&3)+8*(r>>2)+4*hi;}
#define SBAR() __builtin_amdgcn_sched_barrier(0)
__device__ __forceinline__ void cmask(f32x16&p0,f32x16&p1,int jb,int qrel,int hi){
  const float NEG=-INFINITY; int kb=64*jb+4*hi;
  #pragma unroll
  for(int r=0;r<16;++r){int kv=kb+(r&3)+8*(r>>2); if(kv>qrel)p0[r]=NEG; if(kv+32>qrel)p1[r]=NEG;}
}

constexpr int NSLOT=3, SLOTB=8192;
constexpr int LDS_K=0, LDS_V=NSLOT*SLOTB, LDS_WS=2*NSLOT*SLOTB, LDS_OST=LDS_WS+NW*64*4, LDS_FB=LDS_OST+NW*4096, LDS_BYTES=LDS_FB+SEQ*4;
constexpr float C2=0.125f*1.4426950408889634f;
__device__ __forceinline__ void glds16(const void*gsrc,unsigned lds_dst){unsigned keep;
  asm volatile("s_mov_b32 %0, m0\n\ts_mov_b32 m0, %2\n\ts_nop 0\n\tglobal_load_lds_dwordx4 %1, off\n\ts_mov_b32 m0, %0":"=&s"(keep):"v"(gsrc),"s"(lds_dst):"memory");}
__device__ __forceinline__ float max3f(float a,float b,float c){float r;asm("v_max3_f32 %0, %1, %2, %3":"=v"(r):"v"(a),"v"(b),"v"(c));return r;}
__device__ __forceinline__ float max2f(float a,float b){float r;asm("v_max_f32_e32 %0, %1, %2":"=v"(r):"v"(a),"v"(b));return r;}
__device__ __forceinline__ float fadd_s(float a,float b){float r;asm("v_add_f32_e32 %0, %1, %2":"=v"(r):"v"(a),"v"(b));return r;}
__device__ __forceinline__ float fsub_s(float a,float b){float r;asm("v_sub_f32_e32 %0, %1, %2":"=v"(r):"v"(a),"v"(b));return r;}
typedef float f32x2_t __attribute__((ext_vector_type(2))); typedef __bf16 bf16x2_t __attribute__((ext_vector_type(2)));
__device__ __forceinline__ unsigned cvtpk_s(float lo,float hi){f32x2_t v={lo,hi};bf16x2_t b=__builtin_convertvector(v,bf16x2_t);return __builtin_bit_cast(unsigned,b);}
#define WAIT_BAR(N) asm volatile("s_waitcnt vmcnt(" #N ") lgkmcnt(0)\n\ts_barrier":::"memory")

__device__ __forceinline__ void qkt(f32x16&p0,f32x16&p1,const char*Kslot,const bf16x8*qr,int r32,int hi){
  const char*kb=Kslot+hi*1024+r32*16;
  #pragma unroll
  for(int d0=0;d0<4;++d0){
    const bf16x8 b0=*reinterpret_cast<const bf16x8*>(kb+d0*2048);
    const bf16x8 b1=*reinterpret_cast<const bf16x8*>(kb+d0*2048+512);
    p0=__builtin_amdgcn_mfma_f32_32x32x16_bf16(b0,qr[d0],p0,0,0,0);p1=__builtin_amdgcn_mfma_f32_32x32x16_bf16(b1,qr[d0],p1,0,0,0);}
}
typedef __attribute__((address_space(3))) const char* lds_cptr;
typedef short v4i16_t __attribute__((ext_vector_type(4)));
__device__ __forceinline__ void kload8(bf16x8*kf,lds_cptr kp){
  kf[0]=*(const __attribute__((address_space(3))) bf16x8*)(kp);      kf[1]=*(const __attribute__((address_space(3))) bf16x8*)(kp+512);
  kf[2]=*(const __attribute__((address_space(3))) bf16x8*)(kp+2048); kf[3]=*(const __attribute__((address_space(3))) bf16x8*)(kp+2560);
  kf[4]=*(const __attribute__((address_space(3))) bf16x8*)(kp+4096); kf[5]=*(const __attribute__((address_space(3))) bf16x8*)(kp+4608);
  kf[6]=*(const __attribute__((address_space(3))) bf16x8*)(kp+6144); kf[7]=*(const __attribute__((address_space(3))) bf16x8*)(kp+6656);
}
__device__ __forceinline__ void kload2(bf16x8*kf,lds_cptr kp,int j){ kf[2*j]=*(const __attribute__((address_space(3))) bf16x8*)(kp+j*2048); kf[2*j+1]=*(const __attribute__((address_space(3))) bf16x8*)(kp+j*2048+512); }
__device__ __forceinline__ s16x4 vtr(lds_cptr p){ return __builtin_bit_cast(s16x4,__builtin_amdgcn_ds_read_tr16_b64_v4i16((__attribute__((address_space(3))) v4i16_t*)p)); }
__device__ __forceinline__ float rowmax(const f32x16&p0,const f32x16&p1){
  float a=max3f(p0[0],p0[1],p1[0]),b=max3f(p0[2],p0[3],p1[1]);a=max3f(a,p1[2],p1[3]);
  #pragma unroll
  for(int r=4;r<16;r+=4){a=max3f(a,p0[r],p0[r+1]);b=max3f(b,p0[r+2],p0[r+3]);a=max3f(a,p1[r],p1[r+1]);b=max3f(b,p1[r+2],p1[r+3]);}
  const float m=max2f(a,b);
  auto rr=__builtin_amdgcn_permlane32_swap(__float_as_uint(m),__float_as_uint(m),false,false);
  return max2f(__uint_as_float(rr[0]),__uint_as_float(rr[1]));
}
__device__ __forceinline__ void pv(f32x16*o,int vb,bf16x8 pa0,bf16x8 pa1,bf16x8 pa2,bf16x8 pa3){
  #pragma unroll
  for(int d0=0;d0<2;++d0){s16x4 lo[4],hi[4];
    #pragma unroll
    for(int ks=0;ks<4;++ks){
      asm volatile("ds_read_b64_tr_b16 %0,%1 offset:%c2":"=&v"(lo[ks]):"v"(vb),"i"(d0*4096+ks*1024):"memory");
      asm volatile("ds_read_b64_tr_b16 %0,%1 offset:%c2":"=&v"(hi[ks]):"v"(vb),"i"(d0*4096+ks*1024+512):"memory");}
    asm volatile("s_waitcnt lgkmcnt(0)":::"memory");SBAR();
    #define PK(k) (bf16x8){lo[k][0],lo[k][1],lo[k][2],lo[k][3],hi[k][0],hi[k][1],hi[k][2],hi[k][3]}
    o[d0]=__builtin_amdgcn_mfma_f32_32x32x16_bf16(pa0,PK(0),o[d0],0,0,0);
    o[d0]=__builtin_amdgcn_mfma_f32_32x32x16_bf16(pa1,PK(1),o[d0],0,0,0);
    o[d0]=__builtin_amdgcn_mfma_f32_32x32x16_bf16(pa2,PK(2),o[d0],0,0,0);
    o[d0]=__builtin_amdgcn_mfma_f32_32x32x16_bf16(pa3,PK(3),o[d0],0,0,0);
    #undef PK
  }
}

#ifndef ATTN_STORE16
#define ATTN_STORE16(p,v) (*(u32x4*)(p)=(v))
#endif
template<int THRL> __device__ __forceinline__ void attn_unit(int b,int h,int qb,const bf16*Q,const bf16*__restrict__ K,const bf16*__restrict__ V,bf16*O,const float*__restrict__ Fg,const unsigned*__restrict__ NB,char*shm){
  int tid_=threadIdx.x; asm volatile("":"+v"(tid_));
  const int tid=tid_,lane=tid&63,r32=lane&31,hi=lane>>5; const int wid=__builtin_amdgcn_readfirstlane(tid>>6);
  const long rowbase=(long)b*SEQ; const int q0=qb*QB;
  const bf16*Qw=Q+(rowbase+q0+wid*QBLK)*QP+h*D;
  const bf16*Kh=K+rowbase*KP+h*D,*Vh=V+rowbase*KP+h*D;
  __attribute__((address_space(3))) char* const shm3w=(__attribute__((address_space(3))) char*)shm;
  const unsigned lds0=(unsigned)(uintptr_t)shm;
  float*wsf=(float*)(shm+LDS_WS)+wid*64;
  const bf16*ksrc_=Kh+(long)lane*KP+wid*8;
  const bf16*vsrc_=Vh+(long)(16*(wid&3)+(lane>>2))*KP+(wid>>2)*32+(lane&3)*8;
  const unsigned kdst=lds0+LDS_K+wid*1024, vdst=lds0+LDS_V+wid*1024;
  #define DMA_K(t,slot) glds16(ksrc+(long)(t)*KVBLK*KP,(unsigned)__builtin_amdgcn_readfirstlane(kdst+(slot)))
  #define DMA_V(t,slot) glds16(vsrc+(long)(t)*KVBLK*KP,(unsigned)__builtin_amdgcn_readfirstlane(vdst+(slot)))
  const int vb0=(int)(lds0+LDS_V)+((lane>>4)&1)*32+(lane&3)*8+(4*hi+((lane&15)>>2))*64;
  const char*Kbase=shm+LDS_K; bf16x8 kf[8];
  const lds_cptr shm3=(lds_cptr)shm; const lds_cptr kp0=shm3+LDS_K+hi*1024+r32*16; const lds_cptr vp0=shm3+LDS_V+((lane>>4)&1)*32+(lane&3)*8+(4*hi+((lane&15)>>2))*64;
  const int NT0=(q0+QB)/KVBLK;
  int j0;
  { typedef __attribute__((address_space(3))) unsigned* lds_uptr; const lds_uptr cnt=(lds_uptr)(shm3w+LDS_BYTES+16);
    const float fref=Fg[q0]; const float Bq=__builtin_sqrtf(__uint_as_float(NB[0])*__uint_as_float(NB[1])); const float thr=-(152.0f+2.0f*Bq);
    if(tid==0)*cnt=0u;
    asm volatile("s_waitcnt lgkmcnt(0)\n\ts_barrier":::"memory");
    bool skip=false; if(tid<NT0-4){ skip=((fref-Fg[64*tid+63])*1.4426950408889634f<thr); }
    const unsigned long long bal=__ballot(skip); if(lane==0&&bal)__hip_atomic_fetch_add(cnt,(unsigned)__popcll(bal),__ATOMIC_RELAXED,__HIP_MEMORY_SCOPE_WORKGROUP);
    asm volatile("s_waitcnt lgkmcnt(0)\n\ts_barrier":::"memory");
    j0=(int)(*cnt)&~1; j0=__builtin_amdgcn_readfirstlane(j0);
    typedef __attribute__((address_space(3))) float* lds_fptr; const lds_fptr fbl=(lds_fptr)(shm3w+LDS_FB);
    for(int i=64*j0+tid;i<q0+QB;i+=NW*64) fbl[i]=(fref-Fg[i])*1.4426950408889634f; }
  const int NT=NT0-j0;
  const bf16*ksrc=ksrc_+(long)j0*KVBLK*KP; const bf16*vsrc=vsrc_+(long)j0*KVBLK*KP;
  DMA_K(0,0);DMA_V(0,0);DMA_K(1,SLOTB);
  bf16x8 qr[4];
  #pragma unroll
  for(int d0=0;d0<4;++d0)qr[d0]=*reinterpret_cast<const bf16x8*>(&Qw[(long)r32*QP+d0*16+hi*8]);
  float mhat=0.f,l_reg=0.f;f32x16 o[2];o[0]=f32x16{};o[1]=f32x16{};
  const lds_cptr fb0=(lds_cptr)shm3w+LDS_FB+hi*16+j0*256;
  typedef float f32x4v __attribute__((ext_vector_type(4)));
  #define BLD(P0,P1,t) do{ const lds_cptr fp_=fb0+(t)*256; _Pragma("unroll") for(int j_=0;j_<4;++j_){ \
      const f32x4v a_=*(const __attribute__((address_space(3))) f32x4v*)(fp_+j_*32), b_=*(const __attribute__((address_space(3))) f32x4v*)(fp_+128+j_*32); \
      P0[4*j_]=a_[0];P0[4*j_+1]=a_[1];P0[4*j_+2]=a_[2];P0[4*j_+3]=a_[3]; P1[4*j_]=b_[0];P1[4*j_+1]=b_[1];P1[4*j_+2]=b_[2];P1[4*j_+3]=b_[3]; } }while(0)
  const int qrel=wid*QBLK+r32;
  #define CMASK(P0,P1,t) do{int jb_=(t)-(NT-4); if(jb_>=0)cmask(P0,P1,jb_,qrel,hi);}while(0)
  bool resc=false;
  #define START(P0,P1) do{ const float rm=rowmax(P0,P1); resc=false; mhat=rm; \
    _Pragma("unroll") for(int r=0;r<16;++r)P0[r]=__builtin_amdgcn_exp2f(P0[r]-mhat); }while(0)
  #define RESC() do{ if(resc){ asm volatile("s_waitcnt lgkmcnt(0)":::"memory"); \
      _Pragma("unroll") for(int d_=0;d_<2;++d_) _Pragma("unroll") for(int r=0;r<16;++r)o[d_][r]*=wsf[crow(r,hi)]; } }while(0)
  f32x16 pA0,pA1,pB0,pB1;
  int sl_prev=0,sl_cur=0,sl_next=SLOTB;
  #define ROT() do{sl_prev=sl_cur;sl_cur=sl_next;sl_next=(sl_next==(NSLOT-1)*SLOTB)?0:sl_next+SLOTB;}while(0)
  DMA_K(2,2*SLOTB);
  WAIT_BAR(3);
  BLD(pA0,pA1,0);
  qkt(pA0,pA1,Kbase,qr,r32,hi);asm volatile("s_nop 15\n\ts_nop 7":"+v"(pA0),"+v"(pA1));CMASK(pA0,pA1,0);
  START(pA0,pA1);
  _Pragma("unroll") for(int r=0;r<16;++r)pA1[r]=__builtin_amdgcn_exp2f(pA1[r]-mhat);
  WAIT_BAR(0);
  DMA_K(3,0);DMA_V(1,SLOTB);
  ROT();
  kload8(kf,kp0+sl_cur);
  BLD(pB0,pB1,1);
  WAIT_BAR(2);
  s16x4 vlo[8],vhi[8]; u32x4 pw0,pw1,pw2,pw3;
  #define PKW(P,B) cvtpk_s(P[B],P[B+1])
  #define PAF(k) __builtin_bit_cast(bf16x8,pw##k)
  #define VFR(i) (bf16x8){vlo[i][0],vlo[i][1],vlo[i][2],vlo[i][3],vhi[i][0],vhi[i][1],vhi[i][2],vhi[i][3]}
  #define PIN(x) asm volatile("":"+v"(x))
  #define MX3(a,b,c) __builtin_fmaxf(__builtin_fmaxf((a),(b)),(c))
  #define GAPA(MF,A0,A1,A2,A3,W0,W1,PW) do{ MF; sacc+=A0; sacc+=A1; sacc+=A2; sacc+=A3; PIN(sacc); W0; W1; PIN(PW); SBAR(); }while(0)
  #define EX(v) __builtin_amdgcn_exp2f(v)
  #define GAPB(MF,X,B) do{ MF; X[B]=EX(X[B]-mhat); X[B+1]=EX(X[B+1]-mhat); X[B+2]=EX(X[B+2]-mhat); X[B+3]=EX(X[B+3]-mhat); PIN(X); SBAR(); }while(0)
  #define VRD(i) do{ vlo[i]=vtr(vp_+(((i)>>2)*4096+((i)&3)*1024)); vhi[i]=vtr(vp_+(((i)>>2)*4096+((i)&3)*1024+512)); }while(0)
  #define KRD(G,j) do{ if(G){ kload2(kf,kp0+sl_next,j); SBAR(); } }while(0)
  #define STEP(C0,C1,P0,P1,t,GK,GV,GL) do{ SBAR(); \
    const lds_cptr vp_=vp0+sl_prev; \
    VRD(0); SBAR(); float sacc=(P0[0]+P0[1]); \
    GAPA(C0=__builtin_amdgcn_mfma_f32_32x32x16_bf16(kf[0],qr[0],C0,0,0,0), P0[2],P0[3],P0[4],P0[5],     pw0[0]=PKW(P0,0), pw0[1]=PKW(P0,2), pw0); \
    VRD(4); SBAR(); GAPA(C1=__builtin_amdgcn_mfma_f32_32x32x16_bf16(kf[1],qr[0],C1,0,0,0), P0[6],P0[7],P0[8],P0[9],     pw0[2]=PKW(P0,4), pw0[3]=PKW(P0,6), pw0); \
    VRD(1); SBAR(); GAPA(C0=__builtin_amdgcn_mfma_f32_32x32x16_bf16(kf[2],qr[1],C0,0,0,0),   P0[10],P0[11],P0[12],P0[13], pw1[0]=PKW(P0,8), pw1[1]=PKW(P0,10), pw1); \
    VRD(5); SBAR(); GAPA(C1=__builtin_amdgcn_mfma_f32_32x32x16_bf16(kf[3],qr[1],C1,0,0,0),   P0[14],P0[15],P1[0],P1[1],   pw1[2]=PKW(P0,12),pw1[3]=PKW(P0,14), pw1); \
    VRD(2); SBAR(); GAPA(C0=__builtin_amdgcn_mfma_f32_32x32x16_bf16(kf[4],qr[2],C0,0,0,0),   P1[2],P1[3],P1[4],P1[5],     pw2[0]=PKW(P1,0), pw2[1]=PKW(P1,2), pw2); \
    VRD(6); SBAR(); GAPA(C1=__builtin_amdgcn_mfma_f32_32x32x16_bf16(kf[5],qr[2],C1,0,0,0),   P1[6],P1[7],P1[8],P1[9],     pw2[2]=PKW(P1,4), pw2[3]=PKW(P1,6), pw2); \
    VRD(3); SBAR(); GAPA(C0=__builtin_amdgcn_mfma_f32_32x32x16_bf16(kf[6],qr[3],C0,0,0,0),   P1[10],P1[11],P1[12],P1[13], pw3[0]=PKW(P1,8), pw3[1]=PKW(P1,10), pw3); \
    VRD(7); SBAR(); GAPA(C1=__builtin_amdgcn_mfma_f32_32x32x16_bf16(kf[7],qr[3],C1,0,0,0),   P1[14],P1[15],0.f,0.f,       pw3[2]=PKW(P1,12),pw3[3]=PKW(P1,14), pw3); \
    l_reg+=sacc; \
    if(GK){DMA_K((t)+3,sl_cur);} if(GV){DMA_V((t)+1,sl_next);} \
    CMASK(C0,C1,t); \
    { float a=MX3(C0[0],C0[1],C1[0]),b=MX3(C0[2],C0[3],C1[1]); a=MX3(a,C1[2],C1[3]); \
      _Pragma("unroll") for(int r=4;r<16;r+=4){a=MX3(a,C0[r],C0[r+1]);b=MX3(b,C0[r+2],C0[r+3]);a=MX3(a,C1[r],C1[r+1]);b=MX3(b,C1[r+2],C1[r+3]);} \
      float rm=__builtin_fmaxf(a,b); { auto rr=__builtin_amdgcn_permlane32_swap(__float_as_uint(rm),__float_as_uint(rm),false,false); rm=__builtin_fmaxf(__uint_as_float(rr[0]),__uint_as_float(rr[1])); } \
      rm-=mhat; resc=false; \
      if(__builtin_expect(__any(rm>(float)THRL),0)){ const float dl=__builtin_fmaxf(rm,0.f); mhat+=dl; \
        const float f=__builtin_amdgcn_exp2f(-dl); l_reg*=f; if(hi==0)wsf[r32]=f; resc=true; } } \
    SBAR(); if(GL){ BLD(P0,P1,(t)+1); } \
    SBAR(); \
    GAPB(o[0]=__builtin_amdgcn_mfma_f32_32x32x16_bf16(PAF(0),VFR(0),o[0],0,0,0), C0,0); \
    GAPB(o[1]=__builtin_amdgcn_mfma_f32_32x32x16_bf16(PAF(0),VFR(4),o[1],0,0,0), C0,4); \
    KRD(GL,0); GAPB(o[0]=__builtin_amdgcn_mfma_f32_32x32x16_bf16(PAF(1),VFR(1),o[0],0,0,0), C0,8); \
    KRD(GL,1); GAPB(o[1]=__builtin_amdgcn_mfma_f32_32x32x16_bf16(PAF(1),VFR(5),o[1],0,0,0), C0,12); \
    KRD(GL,2); GAPB(o[0]=__builtin_amdgcn_mfma_f32_32x32x16_bf16(PAF(2),VFR(2),o[0],0,0,0), C1,0); \
    KRD(GL,3); GAPB(o[1]=__builtin_amdgcn_mfma_f32_32x32x16_bf16(PAF(2),VFR(6),o[1],0,0,0), C1,4); \
    GAPB(o[0]=__builtin_amdgcn_mfma_f32_32x32x16_bf16(PAF(3),VFR(3),o[0],0,0,0), C1,8); \
    GAPB(o[1]=__builtin_amdgcn_mfma_f32_32x32x16_bf16(PAF(3),VFR(7),o[1],0,0,0), C1,12); \
    }while(0)
  int t=1;
  #undef CMASK
  #define CMASK(P0,P1,t) do{}while(0)
  for(;t+5<NT;t+=2){
    STEP(pB0,pB1,pA0,pA1,t,true,true,true);     WAIT_BAR(2); RESC(); ROT();
    STEP(pA0,pA1,pB0,pB1,t+1,true,true,true);   WAIT_BAR(2); RESC(); ROT();
  }
  #undef CMASK
  #define CMASK(P0,P1,t) do{int jb_=(t)-(NT-4); if(jb_>=0)cmask(P0,P1,jb_,qrel,hi);}while(0)
  #define ENDW(tt) do{ if((tt)+3<NT){WAIT_BAR(2);} else if((tt)+2<NT){WAIT_BAR(1);} else {WAIT_BAR(0);} }while(0)
  for(;t+1<NT;t+=2){
    STEP(pB0,pB1,pA0,pA1,t,(t+3<NT),(t+1<NT),(t+1<NT));       ENDW(t);   RESC(); ROT();
    STEP(pA0,pA1,pB0,pB1,t+1,(t+4<NT),(t+2<NT),(t+2<NT));     ENDW(t+1); RESC(); ROT();
  }
  STEP(pB0,pB1,pA0,pA1,NT-1,false,false,false); RESC();
  { float sacc=pB0[0]+pB0[1]; _Pragma("unroll") for(int r=2;r<16;++r)sacc+=pB0[r]; _Pragma("unroll") for(int r=0;r<16;++r)sacc+=pB1[r]; l_reg+=sacc;
    pw0=(u32x4){PKW(pB0,0),PKW(pB0,2),PKW(pB0,4),PKW(pB0,6)};pw1=(u32x4){PKW(pB0,8),PKW(pB0,10),PKW(pB0,12),PKW(pB0,14)};pw2=(u32x4){PKW(pB1,0),PKW(pB1,2),PKW(pB1,4),PKW(pB1,6)};pw3=(u32x4){PKW(pB1,8),PKW(pB1,10),PKW(pB1,12),PKW(pB1,14)};
    SBAR(); pv(o,vb0+sl_cur,PAF(0),PAF(1),PAF(2),PAF(3)); }
  #undef PKW
  #undef PAF
  #undef VFR
  #undef PIN
  #undef MX3
  #undef GAPA
  #undef GAPB
  #undef EX
  #undef VRD
  #undef KRD
  #undef STEP
  #undef ENDW
  {auto rr=__builtin_amdgcn_permlane32_swap(__float_as_uint(l_reg),__float_as_uint(l_reg),false,false);l_reg=__uint_as_float(rr[0])+__uint_as_float(rr[1]);}
  if(hi==0)wsf[32+r32]=l_reg;asm volatile("s_waitcnt lgkmcnt(0)":::"memory");
  float rli[16];
  #pragma unroll
  for(int r=0;r<16;++r)rli[r]=__builtin_amdgcn_rcpf(wsf[32+crow(r,hi)]);
  bf16*Ow=O+(rowbase+q0+wid*QBLK)*QP+h*D;
  { bf16*stg=(bf16*)(shm+LDS_OST)+wid*2048;
    #pragma unroll
    for(int r=0;r<16;++r){const int orow=crow(r,hi);
      #pragma unroll
      for(int d0=0;d0<2;++d0)stg[orow*64+d0*32+r32]=__float2bfloat16(o[d0][r]*rli[r]);}
    asm volatile("s_waitcnt lgkmcnt(0)":::"memory");
    #pragma unroll
    for(int i=0;i<4;++i){const int row=i*8+(lane>>3),ch=lane&7; const u32x4 v=*(const u32x4*)(stg+row*64+ch*8); ATTN_STORE16(Ow+(long)row*QP+ch*8,v);} }
  asm volatile("s_waitcnt lgkmcnt(0)\n\ts_barrier":::"memory");
  #undef DMA_K
  #undef DMA_V
  #undef CMASK
  #undef START
  #undef RESC
  #undef BLD
  #undef ROT
}
constexpr int ATTN_LDS_BYTES=LDS_BYTES;
struct AttnTensors { const bf16* Q; const bf16* K; const bf16* V; bf16* O; const float* F; const unsigned* NB; };
struct AttnUnit { int bh; int qb; };
struct DynOrder {
  unsigned* ctr; volatile __attribute__((address_space(3))) unsigned* slot;
  __device__ __forceinline__ bool next(int,AttnUnit&u)const{
    if(threadIdx.x==0)*slot=__hip_atomic_fetch_add(ctr,1u,__ATOMIC_RELAXED,__HIP_MEMORY_SCOPE_AGENT);
    asm volatile("s_waitcnt vmcnt(0) lgkmcnt(0)\n\ts_barrier":::"memory");
    const unsigned n=*slot; if(n>=1024u)return false; u.qb=63-(int)(n>>4); u.bh=(int)(n&15u); return true; }
  __device__ __forceinline__ void a_ready(const AttnUnit&)const{}
  __device__ __forceinline__ void done(const AttnUnit&)const{}
};
template<class Sched,int THRL=8> __device__ __forceinline__ void attn_phase(char*lds,const AttnTensors&T,const Sched&S){
  AttnUnit u;
  for(int i=0;S.next(i,u);++i){ S.a_ready(u); attn_unit<THRL>(u.bh/NHEAD,u.bh%NHEAD,u.qb,T.Q,T.K,T.V,T.O,T.F+(long)u.bh*SEQ,T.NB+2*u.bh,lds); S.done(u); }
}
#undef SBAR
#undef WAIT_BAR
}
#include <hip/hip_cooperative_groups.h>
namespace cg = cooperative_groups;
#define LAS __attribute__((address_space(3)))
typedef unsigned short bf16;
typedef unsigned v4u __attribute__((ext_vector_type(4)));
typedef float f32x4 __attribute__((ext_vector_type(4)));
typedef short bf16x8 __attribute__((ext_vector_type(8)));
typedef LAS unsigned char* lp;

#define XB_TMO      128
#define XB_XCNT(j)  (256  + 64 * (j))
#define XB_XSUB(j)  (1280 + 64 * (j))
#define XB_XGEN(j)  (2304 + 64 * (j))
#define XB_TOP      3328
#define XB_TOPGEN   3392
#define XCD_BAR_WORDS 3456
#define XB_SPIN_CAP (1u << 18)

__device__ __forceinline__ unsigned xb_ld(unsigned* p)              { return __hip_atomic_load(p, __ATOMIC_RELAXED, __HIP_MEMORY_SCOPE_AGENT); }
__device__ __forceinline__ unsigned xb_add(unsigned* p, unsigned v) { return __hip_atomic_fetch_add(p, v, __ATOMIC_RELAXED, __HIP_MEMORY_SCOPE_AGENT); }
__device__ __forceinline__ unsigned xb_xcc_id() { return (unsigned)__builtin_amdgcn_s_getreg((3 << 11) | 20) & 0xFu; }
#define XB_SPIN(cond, bar) do { unsigned _sp = 0; while (cond) { __builtin_amdgcn_s_sleep(1); \
    if ((++_sp & 255u) == 0u) { if (xb_ld(&(bar)[XB_TMO])) break; if (_sp > XB_SPIN_CAP) { atomicAdd(&(bar)[XB_TMO], 1u); break; } } } } while (0)

struct XcdBarrier {
    unsigned* bar; unsigned x;
    volatile LAS unsigned* st;
};

__device__ __forceinline__ XcdBarrier xcd_barrier_post(unsigned* bar, volatile LAS unsigned* st) {
    XcdBarrier b; b.bar = bar; b.x = xb_xcc_id(); b.st = st;
    if (threadIdx.x == 0) (void)xb_add(&bar[XB_XCNT(b.x)], 1u);
    return b;
}
__device__ __forceinline__ void xcd_barrier_complete(unsigned* bar, unsigned x, unsigned& nloc, unsigned& nx) {
    const unsigned G = gridDim.x * gridDim.y * gridDim.z;
    unsigned sum, cnt, mine, sp = 0u;
    for (;;) {
        sum = 0u; cnt = 0u; mine = 0u;
#pragma unroll
        for (unsigned j = 0; j < 16; ++j) { const unsigned c = xb_ld(&bar[XB_XCNT(j)]); sum += c; cnt += (c > 0u) ? 1u : 0u; mine = (j == x) ? c : mine; }
        if (sum == G) break;
        __builtin_amdgcn_s_sleep(1);
        if ((++sp & 255u) == 0u) { if (xb_ld(&bar[XB_TMO])) break; if (sp > XB_SPIN_CAP) { atomicAdd(&bar[XB_TMO], 1u); break; } }
    }
    nloc = mine > 0u ? mine : 1u; nx = cnt > 0u ? cnt : 1u;
}

__device__ __forceinline__ void xcd_barrier(const XcdBarrier& b) {
    asm volatile("s_waitcnt vmcnt(0)" ::: "memory");
    __syncthreads();
    if (threadIdx.x == 0) {
        unsigned* bar = b.bar;
        __builtin_amdgcn_s_waitcnt(0);
        unsigned nloc = b.st[0], nx = b.st[1];
        if (nloc == 0u) { xcd_barrier_complete(bar, b.x, nloc, nx); b.st[0] = nloc; b.st[1] = nx; }
        const unsigned old = xb_add(&bar[XB_XSUB(b.x)], 1u);
        const unsigned gen = old / nloc;
        if (old + 1u == (gen + 1u) * nloc) {
            __builtin_amdgcn_fence(__ATOMIC_RELEASE, "agent");
            asm volatile("s_waitcnt vmcnt(0)" ::: "memory");
            const unsigned og = xb_add(&bar[XB_TOP], 1u);
            const unsigned tg = og / nx;
            if (og + 1u == (tg + 1u) * nx) xb_add(&bar[XB_TOPGEN], 1u);
            else XB_SPIN(xb_ld(&bar[XB_TOPGEN]) == tg, bar);
            __builtin_amdgcn_fence(__ATOMIC_ACQUIRE, "agent");
            xb_add(&bar[XB_XGEN(b.x)], 1u);
            asm volatile("s_waitcnt vmcnt(0)" ::: "memory");
        } else {
            XB_SPIN(xb_ld(&bar[XB_XGEN(b.x)]) == gen, bar);
            __builtin_amdgcn_fence(__ATOMIC_ACQUIRE, "agent");
            asm volatile("s_waitcnt vmcnt(0)" ::: "memory");
        }
    }
    __syncthreads();
}


constexpr int NWAVES = 8, NTHR = 512;
constexpr int BATCH = 2, SEQ = 16384, D = 1024, M = BATCH * SEQ, DEPTH = 2;
constexpr int NIN = 5640, NP1 = 3584, NG = 2048, FFH = 2816, NF1 = 5632;
constexpr float ALPHA = 1.4142135623730951f;
constexpr float LN_EPS = 1e-5f, RMS_EPS = 1e-6f;
constexpr size_t MiB = 1u << 20;
constexpr size_t WL_IN = 0, WL_G = 7 * MiB, WL_M = 11 * MiB, WL_O = 15 * MiB, WL_F1 = 17 * MiB, WL_F2 = 28 * MiB, WL_STRIDE = 34 * MiB;
constexpr size_t WS_W = 0, WS_XN = 68 * MiB, WS_QA = 132 * MiB, WS_QB = 164 * MiB, WS_KA = 196 * MiB, WS_VA = 228 * MiB, WS_G = 260 * MiB, WS_IB = 324 * MiB, WS_GB = 356 * MiB,
                 WS_ST = 388 * MiB, WS_DEC = 452 * MiB, WS_LF = 453 * MiB, WS_F = 454 * MiB, WS_CTL = 455 * MiB  , WS_DBG = 455 * MiB + 512 * 1024, WS_END = 456 * MiB;
constexpr size_t WS_GATES = WS_G  , WS_MERGED = WS_KA  , WS_H = WS_QA  ;
constexpr size_t CTL_QCTR = 16384  , CTL_PCTR = 18432  , CTL_NORM = 20480  ;
constexpr int LDS_TOTAL = 155648;
static_assert(attn_body::LDS_BYTES <= LDS_TOTAL && pg8::STAGE_BYTES <= LDS_TOTAL, "LDS map");

__device__ __forceinline__ float wave_sum(float v) {
#pragma unroll
    for (int o = 1; o < 64; o <<= 1) v += __shfl_xor(v, o);
    return v;
}
__device__ __forceinline__ unsigned pk2(float lo, float hi) { return pg8::cvt_pk_bf16(lo, hi); }
__device__ __forceinline__ float bf2f(unsigned short h) { return __uint_as_float((unsigned)h << 16); }

__device__ __forceinline__ void transpose_item(const float* Wsrc, int pitch, bf16* WTdst, int Kdst, LAS float* scr, int lane, bool zero) {
    if (!zero) {
#pragma unroll 8
        for (int i = 0; i < 32; ++i) { const int kk = 2 * i + (lane >> 5); scr[kk * 33 + (lane & 31)] = Wsrc[(size_t)kk * pitch + (lane & 31)]; }
    }
    asm volatile("s_waitcnt lgkmcnt(0)" ::: "memory");
    const int c = lane & 7;
#pragma unroll
    for (int j = 0; j < 4; ++j) { const int n = (lane >> 3) + 8 * j; const LAS float* s = scr + (8 * c) * 33 + n;
        v4u o;
        if (zero) { o = (v4u){0u, 0u, 0u, 0u}; }
        else { o.x = pk2(s[0 * 33], s[1 * 33]); o.y = pk2(s[2 * 33], s[3 * 33]); o.z = pk2(s[4 * 33], s[5 * 33]); o.w = pk2(s[6 * 33], s[7 * 33]); }
        *(v4u*)(WTdst + (size_t)n * Kdst + 8 * c) = o; }
    asm volatile("s_waitcnt lgkmcnt(0)" ::: "memory");
}

struct Ptrs {
    const float *x, *w_in, *b_fgate, *lb_logits, *norm_g, *w_pa, *w_pb, *w_o, *ln1_g, *ln1_b, *w_ff_in, *w_ff_out, *ln2_g, *ln2_b;
    float* out; unsigned char* ws;
};

__device__ __forceinline__ void weight_items(const Ptrs& P, LAS float* scr, int gw, int NGW, int lane) {
    constexpr int I_IN = 16 * (NP1 / 32), I_G = 16 * (NG / 32), I_M = 2 * 8 * 32, I_O = 16 * 32, I_F1 = 16 * (NF1 / 32), I_F2 = (FFH / 64) * 32;
    constexpr int PER_LAYER = I_IN + I_G + I_M + I_O + I_F1 + I_F2;
    for (int it = gw; it < DEPTH * PER_LAYER; it += NGW) {
        const int l = it / PER_LAYER; int r = it % PER_LAYER;
        bf16* WB = (bf16*)(P.ws + WS_W + (size_t)l * WL_STRIDE);
        if (r < I_IN) { const int nblk = NP1 / 32, kb = r / nblk, nb = r % nblk, k0 = 64 * kb, n0 = 32 * nb; const int sc = n0 < 1536 ? n0 : n0 + 8;
            transpose_item(P.w_in + (size_t)l * D * NIN + (size_t)k0 * NIN + sc, NIN, (bf16*)((unsigned char*)WB + WL_IN) + (size_t)n0 * 1024 + k0, 1024, scr, lane, false); continue; } r -= I_IN;
        if (r < I_G) { const int nblk = NG / 32, kb = r / nblk, nb = r % nblk, k0 = 64 * kb, n0 = 32 * nb;
            transpose_item(P.w_in + (size_t)l * D * NIN + (size_t)k0 * NIN + 3592 + n0, NIN, (bf16*)((unsigned char*)WB + WL_G) + (size_t)n0 * 1024 + k0, 1024, scr, lane, false); continue; } r -= I_G;
        if (r < I_M) { const int which = r >> 8, rr = r & 255, kb = rr >> 5, nb = rr & 31, k0 = 64 * kb, n0 = 32 * nb;
            const float* src = (which ? P.w_pb : P.w_pa) + (size_t)l * 512 * 1024 + (size_t)k0 * 1024 + n0;
            transpose_item(src, 1024, (bf16*)((unsigned char*)WB + WL_M + (size_t)which * MiB) + (size_t)n0 * 512 + k0, 512, scr, lane, false); continue; } r -= I_M;
        if (r < I_O) { const int nblk = 32, kb = r / nblk, nb = r % nblk, k0 = 64 * kb, n0 = 32 * nb;
            transpose_item(P.w_o + (size_t)l * 1024 * 1024 + (size_t)k0 * 1024 + n0, 1024, (bf16*)((unsigned char*)WB + WL_O) + (size_t)n0 * 1024 + k0, 1024, scr, lane, false); continue; } r -= I_O;
        if (r < I_F1) { const int nblk = NF1 / 32, kb = r / nblk, nb = r % nblk, k0 = 64 * kb, n0 = 32 * nb; const int tile = n0 >> 8, half = (n0 >> 7) & 1, col = half * FFH + 128 * tile + (n0 & 127);
            transpose_item(P.w_ff_in + (size_t)l * D * NF1 + (size_t)k0 * NF1 + col, NF1, (bf16*)((unsigned char*)WB + WL_F1) + (size_t)n0 * 1024 + k0, 1024, scr, lane, false); continue; } r -= I_F1;
        { const int nblk = 32, kb = r / nblk, nb = r % nblk, k0 = 64 * kb, n0 = 32 * nb;
            transpose_item(P.w_ff_out + (size_t)l * FFH * 1024 + (size_t)k0 * 1024 + n0, 1024, (bf16*)((unsigned char*)WB + WL_F2) + (size_t)n0 * FFH + k0, FFH, scr, lane, false); }
    }
}

__device__ __forceinline__ void stage_wfa(const float* w_in_l, LAS float* wfa, int tid) {
    for (int idx = tid; idx < 8192; idx += NTHR) { const int k = idx >> 3, col = idx & 7; const int j = k >> 8, ln = (k >> 2) & 63, i = k & 3, half = col >> 2, c = col & 3;
        wfa[((((j * 4 + i) * 2 + half) * 64) + ln) * 4 + c] = w_in_l[(size_t)k * NIN + 1536 + col]; }
}
template <bool DO_LN, bool W32, bool WBF, bool DO_FA>
__device__ __forceinline__ void row_pass(const float* src, float* dst32, bf16* dstbf, const float* gam, const float* bet, float* lf, const LAS float* wfa, const float* bfg, int gw, int NGW, int lane) {
    for (int m = gw; m < M; m += NGW) {
        const f32x4* xr = (const f32x4*)(src + (size_t)m * D) + lane;
        f32x4 v[4];
#pragma unroll
        for (int j = 0; j < 4; ++j) v[j] = xr[64 * j];
        if (DO_LN) {
            float s = 0.f;
#pragma unroll
            for (int j = 0; j < 4; ++j) s += (v[j].x + v[j].y) + (v[j].z + v[j].w);
            const float mean = wave_sum(s) * (1.f / D); float s2 = 0.f;
#pragma unroll
            for (int j = 0; j < 4; ++j) { v[j] = v[j] - mean; s2 += (v[j].x * v[j].x + v[j].y * v[j].y) + (v[j].z * v[j].z + v[j].w * v[j].w); }
            const float rstd = 1.f / sqrtf(wave_sum(s2) * (1.f / D) + LN_EPS);
#pragma unroll
            for (int j = 0; j < 4; ++j) { const f32x4 gv = ((const f32x4*)gam)[64 * j + lane], bv = ((const f32x4*)bet)[64 * j + lane]; v[j] = v[j] * rstd * gv + bv; }
        }
        if (W32) { f32x4* o = (f32x4*)(dst32 + (size_t)m * D) + lane;
#pragma unroll
            for (int j = 0; j < 4; ++j) {
#ifdef DBG_SANITIZE
                if (!WBF) { for (int i = 0; i < 4; ++i) if (!(fabsf(v[j][i]) < 1e30f)) v[j][i] = 0.f; }
#endif
                o[64 * j] = v[j]; } }
        if (WBF) { unsigned long long* o8 = (unsigned long long*)(dstbf + (size_t)m * D) + lane;
#pragma unroll
            for (int j = 0; j < 4; ++j) o8[64 * j] = (unsigned long long)pk2(v[j].x, v[j].y) | ((unsigned long long)pk2(v[j].z, v[j].w) << 32); }
        if (DO_FA) {
            float a[8];
#pragma unroll
            for (int c = 0; c < 8; ++c) a[c] = 0.f;
#pragma unroll
            for (int j = 0; j < 4; ++j)
#pragma unroll
                for (int i = 0; i < 4; ++i) { const float xv = v[j][i];
                    const f32x4 w0 = *(const LAS f32x4*)(wfa + ((((j * 4 + i) * 2 + 0) * 64) + lane) * 4), w1 = *(const LAS f32x4*)(wfa + ((((j * 4 + i) * 2 + 1) * 64) + lane) * 4);
                    a[0] += xv * w0.x; a[1] += xv * w0.y; a[2] += xv * w0.z; a[3] += xv * w0.w; a[4] += xv * w1.x; a[5] += xv * w1.y; a[6] += xv * w1.z; a[7] += xv * w1.w; }
#pragma unroll
            for (int c = 0; c < 8; ++c) a[c] = wave_sum(a[c]);
            float z = a[0];
#pragma unroll
            for (int c = 1; c < 8; ++c) z = (lane == c) ? a[c] : z;
            if (lane < 8) { z += bfg[lane]; const float ls = fminf(z, 0.f) - __logf(1.0f + __expf(-fabsf(z))); lf[(size_t)m * 8 + lane] = ls; }
        }
    }
}

__device__ __forceinline__ void fcumsum_unit(int bh, const float* LF, float* F, lp lds, int tid) {
    const int b = bh >> 3, h = bh & 7, lane = tid & 63, wave = tid >> 6;
    const float* src = LF + ((size_t)b * SEQ + (size_t)tid * 32) * 8 + h;
    float cs[32]; float run = 0.f;
#pragma unroll
    for (int i = 0; i < 32; ++i) { run += src[i * 8]; cs[i] = run; }
    float inc = run;
#pragma unroll
    for (int o = 1; o < 64; o <<= 1) { const float n = __shfl_up(inc, o); if (lane >= o) inc += n; }
    LAS float* WS = (LAS float*)lds;
    if (lane == 63) WS[wave] = inc;
    __syncthreads();
    float woff = 0.f;
    for (int w = 0; w < wave; ++w) woff += WS[w];
    const float excl = woff + inc - run;
    float* dst = F + (size_t)bh * SEQ + (size_t)tid * 32;
#pragma unroll
    for (int i = 0; i < 32; i += 4) *(f32x4*)(dst + i) = (f32x4){excl + cs[i], excl + cs[i + 1], excl + cs[i + 2], excl + cs[i + 3]};
    __syncthreads();
}

__device__ __forceinline__ void norm_unit(int v, const bf16* QA, const bf16* KA, unsigned* NB, int tid) {
    const int bh = v >> 4, seg = v & 15, b = bh >> 3, h = bh & 7, lane = tid & 63;
    float mq = 0.f, mk = 0.f;
#pragma unroll
    for (int e = 0; e < 2; ++e) { const size_t row = (size_t)b * SEQ + seg * 1024 + tid * 2 + e;
        const v4u* qp = (const v4u*)(QA + row * 512 + h * 64); const v4u* kp = (const v4u*)(KA + row * 512 + h * 64); float sq = 0.f, sk = 0.f;
#pragma unroll
        for (int i = 0; i < 8; ++i) { const v4u a = qp[i], c = kp[i];
#pragma unroll
            for (int k = 0; k < 4; ++k) { const float a0 = __uint_as_float(a[k] << 16), a1 = __uint_as_float(a[k] & 0xffff0000u), c0 = __uint_as_float(c[k] << 16), c1 = __uint_as_float(c[k] & 0xffff0000u);
                sq += a0 * a0 + a1 * a1; sk += c0 * c0 + c1 * c1; } }
        mq = fmaxf(mq, sq); mk = fmaxf(mk, sk); }
#pragma unroll
    for (int o = 1; o < 64; o <<= 1) { mq = fmaxf(mq, __shfl_xor(mq, o)); mk = fmaxf(mk, __shfl_xor(mk, o)); }
    if (lane == 0) { atomicMax(NB + 2 * bh, __float_as_uint(mq * 1.01f)); atomicMax(NB + 2 * bh + 1, __float_as_uint(mk * 1.01f)); }
}

namespace hg {
constexpr int P128 = 136, P64 = 72;
constexpr int O_QP = 0, O_QPP = O_QP + 64 * P128 * 2, O_KP = O_QPP + 64 * P128 * 2, O_VT = O_KP + 64 * P128 * 2, O_ST = O_VT + 128 * P64 * 2, O_PM = O_ST + 128 * P128 * 2,
              O_PT = O_PM + 64 * P64 * 2, O_RS = O_PT + 2048, O_END = O_RS + 512;
constexpr int O_KDT = O_QP;
static_assert(O_END <= 131072 && 128 * P64 * 2 <= 2 * 64 * P128 * 2, "hgrn LDS map");

__device__ __forceinline__ void load_cumsum(const float* Gu, int d, int part, lp lds, float (&g)[16], float (&b)[16], float& bmid, float& blast) {
#pragma unroll
    for (int i = 0; i < 16; ++i) g[i] = Gu[(size_t)(part * 16 + i) * 512 + d];
    float run = 0.f;
#pragma unroll
    for (int i = 0; i < 16; ++i) { run += g[i]; b[i] = run; }
    LAS float* PT = (LAS float*)(lds + O_PT);
    PT[part * 128 + d] = run;
    __syncthreads();
    const float p0 = PT[d], p1 = PT[128 + d], p2 = PT[256 + d], p3 = PT[384 + d];
    const float off = (part > 0 ? p0 : 0.f) + (part > 1 ? p1 : 0.f) + (part > 2 ? p2 : 0.f);
#pragma unroll
    for (int i = 0; i < 16; ++i) b[i] += off;
    bmid = p0 + p1; blast = (p0 + p1) + (p2 + p3);
}
__device__ __forceinline__ void stage_vt(const bf16* vp  , lp lds, int e, int part) {
    unsigned w[8];
#pragma unroll
    for (int i = 0; i < 8; ++i) { const unsigned lo = vp[(size_t)(2 * i) * 512], hi = vp[(size_t)(2 * i + 1) * 512]; w[i] = lo | (hi << 16); }
    LAS v4u* dst = (LAS v4u*)(lds + O_VT + (e * P64 + part * 16) * 2);
    dst[0] = (v4u){w[0], w[1], w[2], w[3]}; dst[1] = (v4u){w[4], w[5], w[6], w[7]};
}
__device__ __forceinline__ void pass1_unit(int unit, const float* G, const bf16* IB, bf16* ST, float* DEC, lp lds, int tid, unsigned* dbgw = nullptr) {
    const int c = unit & 255, h = (unit >> 8) & 3, b = unit >> 10;
    const int d = tid & 127, part = tid >> 7, lane = tid & 63, wave = tid >> 6, fr = lane & 15, fq = lane >> 4;
    const size_t row0 = (size_t)b * SEQ + (size_t)c * 64;
    float g[16], bb[16], bmid, blast;
    load_cumsum(G + row0 * 512 + h * 128, d, part, lds, g, bb, bmid, blast);
#ifdef DBG_P1
    { bool b1 = false, b3 = false; for (int i = 0; i < 16; ++i) { if (g[i] > 0.f) b1 = true; const float kk = (1.0f - __expf(g[i])) * __expf(blast - bb[i]); if (!(fabsf(kk) < 1e30f)) b3 = true; }
      if (b1) atomicMin(dbgw, 51u); if (b3) atomicMin(dbgw, 53u); }
#endif
    { unsigned w[8];
#pragma unroll
      for (int i = 0; i < 8; ++i) { const float k0 = (1.0f - __expf(g[2 * i])) * __expf(blast - bb[2 * i]), k1 = (1.0f - __expf(g[2 * i + 1])) * __expf(blast - bb[2 * i + 1]); w[i] = pk2(k0, k1); }
      LAS v4u* dst = (LAS v4u*)(lds + O_KDT + (d * P64 + part * 16) * 2);
      dst[0] = (v4u){w[0], w[1], w[2], w[3]}; dst[1] = (v4u){w[4], w[5], w[6], w[7]}; }
    stage_vt(IB + (row0 + part * 16) * 512 + h * 128 + d, lds, d, part);
    if (part == 0) DEC[(size_t)unit * 128 + d] = __expf(blast);
    __syncthreads();
    const bf16x8 a0 = *(const LAS bf16x8*)(lds + O_VT + ((16 * wave + fr) * P64 + 8 * fq) * 2), a1 = *(const LAS bf16x8*)(lds + O_VT + ((16 * wave + fr) * P64 + 32 + 8 * fq) * 2);
    bf16* out = ST + (size_t)unit * 16384;
#pragma unroll
    for (int dt = 0; dt < 8; ++dt) {
        const bf16x8 b0 = *(const LAS bf16x8*)(lds + O_KDT + ((16 * dt + fr) * P64 + 8 * fq) * 2), b1 = *(const LAS bf16x8*)(lds + O_KDT + ((16 * dt + fr) * P64 + 32 + 8 * fq) * 2);
        f32x4 acc = (f32x4){0.f, 0.f, 0.f, 0.f};
        acc = __builtin_amdgcn_mfma_f32_16x16x32_bf16(a0, b0, acc, 0, 0, 0);
        acc = __builtin_amdgcn_mfma_f32_16x16x32_bf16(a1, b1, acc, 0, 0, 0);
#ifdef DBG_P1
        for (int r = 0; r < 4; ++r) if (!(fabsf(acc[r]) < 1e30f)) atomicMin(dbgw, 54u);
#endif
#pragma unroll
        for (int r = 0; r < 4; ++r) out[(16 * wave + 4 * fq + r) * 128 + 16 * dt + fr] = (bf16)(pk2(acc[r], 0.f) & 0xffffu);
    }
    __syncthreads();
}
__device__ __forceinline__ void pass2_scan(const bf16* STin, bf16* ST, const float* DEC, int gtid, int gthreads) {
    for (int id = gtid; id < 8 * 16384; id += gthreads) {
        const int bh = id >> 14, ed = id & 16383, d = ed & 127;
        bf16* p = ST + (size_t)bh * 256 * 16384 + ed; const bf16* pi = STin + (size_t)bh * 256 * 16384 + ed; const float* dp = DEC + (size_t)bh * 256 * 128 + d;
        float state = 0.f;
        for (int c = 0; c < 256; c += 32) {
            unsigned short u[32]; float dc[32];
#pragma unroll
            for (int i = 0; i < 32; ++i) { u[i] = pi[(size_t)(c + i) * 16384]; dc[i] = dp[(size_t)(c + i) * 128]; }
#pragma unroll
            for (int i = 0; i < 32; ++i) { p[(size_t)(c + i) * 16384] = (bf16)(pk2(state, 0.f) & 0xffffu); state = dc[i] * state + bf2f(u[i]); }
        }
    }
}
__device__ __forceinline__ void pass3_unit(int unit, const float* G, const bf16* IB, const bf16* GB, const bf16* ST, const bf16* QB, bf16* YB, const float* normg, lp lds, int tid) {
    const int c = unit & 255, h = (unit >> 8) & 3, b = unit >> 10;
    const int d = tid & 127, part = tid >> 7, lane = tid & 63, wave = tid >> 6, fr = lane & 15, fq = lane >> 4;
    const size_t row0 = (size_t)b * SEQ + (size_t)c * 64;
    { const bf16* sp = ST + (size_t)unit * 16384;
#pragma unroll
      for (int ps = 0; ps < 4; ++ps) { const int idx = ps * NTHR + tid, e = idx >> 4, d8 = (idx & 15) * 8; const v4u w = *(const v4u*)(sp + e * 128 + d8); *(LAS v4u*)(lds + O_ST + (e * P128 + d8) * 2) = w; } }
    float g[16], bb[16], bmid, blast;
    load_cumsum(G + row0 * 512 + h * 128, d, part, lds, g, bb, bmid, blast);
    { const bf16* qp = QB + (row0 + part * 16) * 512 + h * 128 + d; const float emid = __expf(bmid);
      LAS bf16* Qp = (LAS bf16*)(lds + O_QP), *Qpp = (LAS bf16*)(lds + O_QPP), *Kp = (LAS bf16*)(lds + O_KP);
#pragma unroll
      for (int i = 0; i < 16; ++i) { const float q = bf2f(qp[(size_t)i * 512]); const float q1 = q * __expf(bb[i] - bmid), q2 = q1 * emid, k1 = (1.0f - __expf(g[i])) * __expf(bmid - bb[i]);
          const int t = part * 16 + i; const unsigned w = pk2(q1, q2), w2 = pk2(k1, 0.f);
          Qp[t * P128 + d] = (bf16)(w & 0xffffu); Qpp[t * P128 + d] = (bf16)(w >> 16); Kp[t * P128 + d] = (bf16)(w2 & 0xffffu); } }
    stage_vt(IB + (row0 + part * 16) * 512 + h * 128 + d, lds, d, part);
    __syncthreads();
    { const int ti = wave >> 1; LAS bf16* Pm = (LAS bf16*)(lds + O_PM);
#pragma unroll
      for (int sj2 = 0; sj2 < 2; ++sj2) { const int sj = 2 * (wave & 1) + sj2; f32x4 acc = (f32x4){0.f, 0.f, 0.f, 0.f};
#pragma unroll
          for (int ks = 0; ks < 4; ++ks) { const bf16x8 a = *(const LAS bf16x8*)(lds + O_QP + ((16 * ti + fr) * P128 + 32 * ks + 8 * fq) * 2), bq = *(const LAS bf16x8*)(lds + O_KP + ((16 * sj + fr) * P128 + 32 * ks + 8 * fq) * 2);
              acc = __builtin_amdgcn_mfma_f32_16x16x32_bf16(a, bq, acc, 0, 0, 0); }
#pragma unroll
          for (int r = 0; r < 4; ++r) { const int t = 16 * ti + 4 * fq + r, s = 16 * sj + fr; const float v = (s <= t) ? acc[r] : 0.f; Pm[t * P64 + s] = (bf16)(pk2(v, 0.f) & 0xffffu); } } }
    __syncthreads();
    const int rb = wave & 3, ch = wave >> 2;
    f32x4 o[4];
#pragma unroll
    for (int j = 0; j < 4; ++j) o[j] = (f32x4){0.f, 0.f, 0.f, 0.f};
    { bf16x8 ap[2], aq[4];
#pragma unroll
      for (int ks = 0; ks < 2; ++ks) ap[ks] = *(const LAS bf16x8*)(lds + O_PM + ((16 * rb + fr) * P64 + 32 * ks + 8 * fq) * 2);
#pragma unroll
      for (int ks = 0; ks < 4; ++ks) aq[ks] = *(const LAS bf16x8*)(lds + O_QPP + ((16 * rb + fr) * P128 + 32 * ks + 8 * fq) * 2);
#pragma unroll
      for (int j = 0; j < 4; ++j) { const int e0 = 64 * ch + 16 * j;
#pragma unroll
          for (int ks = 0; ks < 2; ++ks) { const bf16x8 bv = *(const LAS bf16x8*)(lds + O_VT + ((e0 + fr) * P64 + 32 * ks + 8 * fq) * 2); o[j] = __builtin_amdgcn_mfma_f32_16x16x32_bf16(ap[ks], bv, o[j], 0, 0, 0); }
#pragma unroll
          for (int ks = 0; ks < 4; ++ks) { const bf16x8 bs = *(const LAS bf16x8*)(lds + O_ST + ((e0 + fr) * P128 + 32 * ks + 8 * fq) * 2); o[j] = __builtin_amdgcn_mfma_f32_16x16x32_bf16(aq[ks], bs, o[j], 0, 0, 0); } } }
    LAS float* RS = (LAS float*)(lds + O_RS);
#pragma unroll
    for (int r = 0; r < 4; ++r) { float s = 0.f;
#pragma unroll
        for (int j = 0; j < 4; ++j) s += o[j][r] * o[j][r];
        s += __shfl_xor(s, 1); s += __shfl_xor(s, 2); s += __shfl_xor(s, 4); s += __shfl_xor(s, 8);
        if (fr == 0) RS[ch * 64 + 16 * rb + 4 * fq + r] = s; }
    __syncthreads();
#pragma unroll
    for (int r = 0; r < 4; ++r) { const int t = 16 * rb + 4 * fq + r; const float rstd = 1.0f / sqrtf((RS[t] + RS[64 + t]) * (1.0f / 128.0f) + RMS_EPS);
        const bf16* gbp = GB + (row0 + t) * 512 + h * 128 + 64 * ch + fr; bf16* yp = YB + (row0 + t) * 512 + h * 128 + 64 * ch + fr;
#pragma unroll
        for (int j = 0; j < 4; ++j) { const float y = o[j][r] * rstd * normg[64 * ch + 16 * j + fr] * bf2f(gbp[16 * j]); yp[16 * j] = (bf16)(pk2(y, 0.f) & 0xffffu); } }
    __syncthreads();
}
}

#ifdef DBG_NAN
__device__ __forceinline__ void dbg_scan(const void* p, size_t nbytes, bool is_bf, int stage, unsigned* word) {
    const size_t n16 = nbytes / 16; const v4u* q = (const v4u*)p; bool bad = false;
    int t_ = threadIdx.x; asm volatile("" : "+v"(t_));
    int b_ = blockIdx.x; asm volatile("" : "+s"(b_)); int g_ = gridDim.x; asm volatile("" : "+s"(g_));
    for (unsigned i = (unsigned)(b_ * NTHR + t_); i < (unsigned)n16; i += (unsigned)(g_ * NTHR)) { const v4u w = q[i];
        for (int k = 0; k < 4; ++k) { const unsigned x = w[k];
            if (is_bf) { if ((x & 0x7f80u) == 0x7f80u || (x & 0x7f800000u) == 0x7f800000u) bad = true; }
            else { if ((x & 0x7f800000u) == 0x7f800000u) bad = true; } } }
    if (bad) atomicMin(word, (unsigned)stage);
}
#define DBG(stage, ptr, bytes, isbf) do { if (l == DBG_LAYER) dbg_scan((ptr), (bytes), (isbf), (stage), (unsigned*)(args.ws + WS_DBG)); } while (0)
#else
#define DBG(stage, ptr, bytes, isbf) do {} while (0)
#endif
#define GSYNC() xcd_barrier(xbar)
#ifdef DBG_TS
#define STAMP(k) do { if (blockIdx.x == 0 && threadIdx.x == 0) ((unsigned long long*)(args.ws + WS_DBG + 4096))[(k)] = __builtin_amdgcn_s_memrealtime(); } while (0)
#else
#define STAMP(k) do {} while (0)
#endif
#ifndef REP_P1
#define REP_P1 1
#endif
#ifndef REP_P2
#define REP_P2 1
#endif
#ifndef REP_P8
#define REP_P8 1
#endif
#ifndef REP_P45
#define REP_P45 1
#endif
#ifndef REP_HG0
#define REP_HG0 0
#endif
#ifndef REP_P0
#define REP_P0 1
#endif
#ifndef REP_ATT0
#define REP_ATT0 0
#endif
struct Args { const float* in[14]; float* out; unsigned char* ws; };
#define FRESH_PTR(T, var, expr) T var = (T)(expr); asm volatile("" : "+s"(var))
#define IDS() int tid_ = threadIdx.x; asm volatile("" : "+v"(tid_)); const int tid = tid_, lane = tid & 63, wave = __builtin_amdgcn_readfirstlane(tid >> 6); const int G = gridDim.x, bx = blockIdx.x, vcu = (G % 8 == 0) ? (bx % 8) * (G / 8) + bx / 8 : bx; \
              const int gw = vcu * NWAVES + wave, NGW = G * NWAVES; (void)tid; (void)lane; (void)wave; (void)gw; (void)NGW; (void)vcu; (void)bx
__global__ void __launch_bounds__(NTHR, 2) mega_fwd(Args args) {
    extern __shared__ __attribute__((aligned(16))) unsigned char lds_raw[];
    cg::grid_group grid = cg::this_grid();
    const lp lds = (lp)lds_raw;
    volatile LAS unsigned* xbst = (volatile LAS unsigned*)(lds + LDS_TOTAL - 64);
    if (threadIdx.x < 16) xbst[threadIdx.x] = 0u;
    __syncthreads();
    const XcdBarrier xbar = xcd_barrier_post((unsigned*)(args.ws + WS_CTL), xbst);
    grid.sync();
    int tsn = 1; (void)tsn; STAMP(0);

#ifdef DBG_NAN
    if (blockIdx.x == 0 && threadIdx.x == 0) *(unsigned*)(args.ws + WS_DBG) = 990u;
    GSYNC(); STAMP(tsn); ++tsn;
#endif
    for (int rep_ = 0; rep_ < REP_P0; ++rep_) { IDS();
      Ptrs P;
      P.x = args.in[0]; P.w_in = args.in[1]; P.b_fgate = args.in[2]; P.lb_logits = args.in[3]; P.norm_g = args.in[4]; P.w_pa = args.in[5]; P.w_pb = args.in[6]; P.w_o = args.in[7];
      P.ln1_g = args.in[8]; P.ln1_b = args.in[9]; P.w_ff_in = args.in[10]; P.w_ff_out = args.in[11]; P.ln2_g = args.in[12]; P.ln2_b = args.in[13]; P.out = args.out; P.ws = args.ws;
      weight_items(P, (LAS float*)(lds + wave * 16384), gw, NGW, lane);
      __syncthreads();
      stage_wfa(P.w_in, (LAS float*)lds, tid);
      __syncthreads();
      row_pass<false, false, true, true>(P.x, nullptr, (bf16*)(P.ws + WS_XN), nullptr, nullptr, (float*)(P.ws + WS_LF), (const LAS float*)lds, P.b_fgate, gw, NGW, lane); }
    GSYNC(); STAMP(tsn); ++tsn;
    { const int l = 0; DBG(10, args.ws + WS_XN, (size_t)64 * MiB, true); DBG(10, args.ws + WS_LF, (size_t)1 * MiB, false); }

#pragma unroll 1
    for (int l = 0; l < DEPTH; ++l) {
        for (int rep_ = 0; rep_ < REP_P1; ++rep_) {
        { IDS(); FRESH_PTR(unsigned char*, ws, args.ws); FRESH_PTR(const float*, lbl, args.in[3]);
          pg8::Gemm g{(const bf16*)(ws + WS_XN), (const bf16*)(ws + WS_W + (size_t)l * WL_STRIDE + WL_IN), M, NP1, D}; pg8::StaticOrder S; S.init(M, NP1, G, bx);
          pg8::EpiInProj E{(bf16*)(ws + WS_QA), (bf16*)(ws + WS_QB), (bf16*)(ws + WS_KA), (bf16*)(ws + WS_VA), (float*)(ws + WS_G), (bf16*)(ws + WS_IB), (bf16*)(ws + WS_GB), lbl, l, attn_body::C2};
          pg8::gemm_phase<pg8::EpiInProj, pg8::StaticOrder, true, true>(lds, g, S, E); }
        }
        GSYNC(); STAMP(tsn); ++tsn;
        DBG(20, args.ws + WS_QA, (size_t)64 * MiB, true); DBG(30, args.ws + WS_KA, (size_t)64 * MiB, true); DBG(40, args.ws + WS_G, (size_t)64 * MiB, false); DBG(50, args.ws + WS_IB, (size_t)64 * MiB, true);
        for (int rep_ = 0; rep_ < REP_P2; ++rep_) {
        { IDS(); FRESH_PTR(unsigned char*, ws, args.ws);
          for (int u = vcu; u < 2048; u += G) hg::pass1_unit(u, (const float*)(ws + WS_G), (const bf16*)(ws + WS_IB), (bf16*)(ws + WS_ST), (float*)(ws + WS_DEC), lds, tid, (unsigned*)(ws + WS_DBG));
          for (int u = vcu; u < 16; u += G) fcumsum_unit(u, (const float*)(ws + WS_LF), (float*)(ws + WS_F), lds, tid);
          for (int u = vcu; u < 256; u += G) norm_unit(u, (const bf16*)(ws + WS_QA), (const bf16*)(ws + WS_KA), (unsigned*)(ws + WS_CTL + CTL_NORM) + l * 32, tid); }
        }
        GSYNC(); STAMP(tsn); ++tsn;
        DBG(60, args.ws + WS_ST, (size_t)64 * MiB, true); DBG(61, args.ws + WS_DEC, (size_t)1 * MiB, false); DBG(70, args.ws + WS_F, (size_t)1 * MiB, false);
        { IDS(); FRESH_PTR(unsigned char*, ws, args.ws);
          #if REP_HG0
          if (l == 0) { FRESH_PTR(float*, outp, args.out); hg::pass2_scan((const bf16*)(ws + WS_ST), (bf16*)outp, (const float*)(ws + WS_DEC), vcu * NTHR + tid, G * NTHR); }
#endif
          hg::pass2_scan((const bf16*)(ws + WS_ST), (bf16*)(ws + WS_ST), (const float*)(ws + WS_DEC), vcu * NTHR + tid, G * NTHR); }
        GSYNC(); STAMP(tsn); ++tsn;
        DBG(80, args.ws + WS_ST, (size_t)64 * MiB, true);
        { FRESH_PTR(unsigned char*, ws, args.ws);
          const attn_body::AttnTensors AT{(const attn_body::bf16*)(ws + WS_QA), (const attn_body::bf16*)(ws + WS_KA), (const attn_body::bf16*)(ws + WS_VA), (attn_body::bf16*)(ws + WS_QA), (const float*)(ws + WS_F),
                                          (const unsigned*)(ws + WS_CTL + CTL_NORM) + l * 32};
          const attn_body::DynOrder S{(unsigned*)(ws + WS_CTL + CTL_QCTR) + l * 64, (volatile LAS unsigned*)(lds + attn_body::LDS_BYTES + 32)};
          attn_body::attn_phase<attn_body::DynOrder>((char*)lds_raw, AT, S); }
        { IDS(); FRESH_PTR(unsigned char*, ws, args.ws); FRESH_PTR(const float*, ng, args.in[4]);
          volatile LAS unsigned* slot = (volatile LAS unsigned*)(lds + attn_body::LDS_BYTES + 32); unsigned* ctr = (unsigned*)(ws + WS_CTL + CTL_PCTR) + l * 64;
          __syncthreads();
          for (;;) {
              if (tid == 0) *slot = __hip_atomic_fetch_add(ctr, 1u, __ATOMIC_RELAXED, __HIP_MEMORY_SCOPE_AGENT);
              __syncthreads();
              const unsigned n = *slot; if (n >= 2048u) break;
              hg::pass3_unit((int)n, (const float*)(ws + WS_G), (const bf16*)(ws + WS_IB), (const bf16*)(ws + WS_GB), (const bf16*)(ws + WS_ST), (const bf16*)(ws + WS_QB), (bf16*)(ws + WS_QB), ng + l * 128, lds, tid); } }
        GSYNC(); STAMP(tsn); ++tsn;
        DBG(90, args.ws + WS_QA, (size_t)64 * MiB, true);
        for (int rep_ = 0; rep_ < REP_P45; ++rep_) {
        { IDS(); FRESH_PTR(unsigned char*, ws, args.ws);
          pg8::Gemm g{(const bf16*)(ws + WS_XN), (const bf16*)(ws + WS_W + (size_t)l * WL_STRIDE + WL_G), M, NG, D}; pg8::StaticOrder S; S.init(M, NG, G, bx);
          pg8::EpiGates E{(bf16*)(ws + WS_GATES)};
          pg8::gemm_phase<pg8::EpiGates, pg8::StaticOrder, true, true>(lds, g, S, E); }
        }
        GSYNC(); STAMP(tsn); ++tsn;
        DBG(100, args.ws + WS_GATES, (size_t)128 * MiB, true);
        for (int rep_ = 0; rep_ < REP_P45; ++rep_) {
        { IDS(); FRESH_PTR(unsigned char*, ws, args.ws);
          { pg8::Gemm g{(const bf16*)(ws + WS_QA), (const bf16*)(ws + WS_W + (size_t)l * WL_STRIDE + WL_M), M, D, 512}; pg8::StaticOrder S; S.init(M, D, G, bx);
            pg8::EpiMerge<0> E{(const bf16*)(ws + WS_GATES), (bf16*)(ws + WS_MERGED)};
            pg8::gemm_phase<pg8::EpiMerge<0>, pg8::StaticOrder, true, true>(lds, g, S, E); }
          asm volatile("s_waitcnt vmcnt(0)" ::: "memory"); __syncthreads();
          { pg8::Gemm g{(const bf16*)(ws + WS_QB), (const bf16*)(ws + WS_W + (size_t)l * WL_STRIDE + WL_M + MiB), M, D, 512}; pg8::StaticOrder S; S.init(M, D, G, bx);
            pg8::EpiMerge<1> E{(const bf16*)(ws + WS_GATES), (bf16*)(ws + WS_MERGED)};
            pg8::gemm_phase<pg8::EpiMerge<1>, pg8::StaticOrder, true, true>(lds, g, S, E); } }
        }
        GSYNC(); STAMP(tsn); ++tsn;
        DBG(110, args.ws + WS_MERGED, (size_t)64 * MiB, true);
        { IDS(); FRESH_PTR(unsigned char*, ws, args.ws); FRESH_PTR(const float*, xin, args.in[0]); FRESH_PTR(float*, outp, args.out); const float* xres = (l == 0) ? xin : (const float*)outp;
          pg8::Gemm g{(const bf16*)(ws + WS_MERGED), (const bf16*)(ws + WS_W + (size_t)l * WL_STRIDE + WL_O), M, D, D}; pg8::StaticOrder S; S.init(M, D, G, bx);
          pg8::EpiResid E{xres, outp, ALPHA};
          pg8::gemm_phase<pg8::EpiResid, pg8::StaticOrder, true, true>(lds, g, S, E); }
        GSYNC(); STAMP(tsn); ++tsn;
        DBG(120, args.out, (size_t)128 * MiB, false);
        { IDS(); FRESH_PTR(unsigned char*, ws, args.ws); FRESH_PTR(float*, outp, args.out); FRESH_PTR(const float*, gm, args.in[8]); FRESH_PTR(const float*, bt, args.in[9]);
          row_pass<true, true, true, false>(outp, outp, (bf16*)(ws + WS_XN), gm + l * D, bt + l * D, nullptr, nullptr, nullptr, gw, NGW, lane); }
        GSYNC(); STAMP(tsn); ++tsn;
        DBG(130, args.ws + WS_XN, (size_t)64 * MiB, true);
        for (int rep_ = 0; rep_ < REP_P8; ++rep_) {
        { IDS(); FRESH_PTR(unsigned char*, ws, args.ws);
          pg8::Gemm g{(const bf16*)(ws + WS_XN), (const bf16*)(ws + WS_W + (size_t)l * WL_STRIDE + WL_F1), M, NF1, D}; pg8::StaticOrder S; S.init(M, NF1, G, bx);
          pg8::EpiSwiGLU E{(bf16*)(ws + WS_H)};
          pg8::gemm_phase<pg8::EpiSwiGLU, pg8::StaticOrder, true, true>(lds, g, S, E); }
        }
        GSYNC(); STAMP(tsn); ++tsn;
        DBG(140, args.ws + WS_H, (size_t)176 * MiB, true);
        { IDS(); FRESH_PTR(unsigned char*, ws, args.ws); FRESH_PTR(float*, outp, args.out);
          pg8::Gemm g{(const bf16*)(ws + WS_H), (const bf16*)(ws + WS_W + (size_t)l * WL_STRIDE + WL_F2), M, D, FFH}; pg8::StaticOrder S; S.init(M, D, G, bx);
          pg8::EpiResid E{outp, outp, ALPHA};
          pg8::gemm_phase<pg8::EpiResid, pg8::StaticOrder, true, true>(lds, g, S, E); }
        GSYNC(); STAMP(tsn); ++tsn;
        DBG(150, args.out, (size_t)128 * MiB, false);
        { IDS(); FRESH_PTR(unsigned char*, ws, args.ws); FRESH_PTR(float*, outp, args.out); FRESH_PTR(const float*, gm, args.in[12]); FRESH_PTR(const float*, bt, args.in[13]);
          if (l + 1 < DEPTH) {
              FRESH_PTR(const float*, win, args.in[1]); FRESH_PTR(const float*, bfg, args.in[2]);
              stage_wfa(win + (size_t)(l + 1) * D * NIN, (LAS float*)lds, tid);
              __syncthreads();
              row_pass<true, true, true, true>(outp, outp, (bf16*)(ws + WS_XN), gm + l * D, bt + l * D, (float*)(ws + WS_LF), (const LAS float*)lds, bfg + (l + 1) * 8, gw, NGW, lane);
          } else {
              row_pass<true, true, false, false>(outp, outp, nullptr, gm + l * D, bt + l * D, nullptr, nullptr, nullptr, gw, NGW, lane);
          } }
        if (l + 1 < DEPTH) GSYNC(); STAMP(tsn); ++tsn;
    }
#ifdef DBG_TS
    GSYNC(); STAMP(tsn);
    { const volatile unsigned long long* T = (const volatile unsigned long long*)(args.ws + WS_DBG + 4096);
      float sum[2] = {0.f, 0.f};
      if (blockIdx.x == 0) {
          for (int k = 0; k < 23; ++k) { const float us = (float)(T[k + 1] - T[k]) * 0.01f; const int j = (k == 0) ? -1 : (k - 1) % 11;
              for (int w = 0; w < 2; ++w) { const unsigned mask = (w == 0) ? DBG_TS_A : DBG_TS_B; const bool in = (j < 0) ? ((mask >> 15) & 1u) : ((mask >> j) & 1u); if (in) sum[w] += us; } }
          for (int i = threadIdx.x; i < (1 << 20); i += NTHR) args.out[1024 + i] = sum[1];
          __syncthreads();
          if (threadIdx.x == 0) args.out[0] = 100.0f * sum[0];
      } }
#endif
#ifdef DBG_NAN
    GSYNC();
    if (blockIdx.x == 0 && threadIdx.x == 0) args.out[0] = 100.0f * (float)*(volatile unsigned*)(args.ws + WS_DBG);
#endif
}

extern "C" void kernel_launch(void* const* d_in, const int* in_sizes, int n_in, void* d_out, int out_size, void* d_ws, size_t ws_size, hipStream_t stream) {
    static int grid = 0;
    if (grid == 0) {
        if (n_in != 14 || in_sizes[0] != M * D || out_size != M * D || ws_size < WS_END) { fprintf(stderr, "kernel_launch: unexpected shapes (n_in %d, in0 %d, out %d, ws %zu)\n", n_in, n_in > 0 ? in_sizes[0] : -1, out_size, ws_size); grid = -1; return; }
        int dev = 0, cus = 0, per_cu = 0;
        if (hipGetDevice(&dev) != hipSuccess || hipDeviceGetAttribute(&cus, hipDeviceAttributeMultiprocessorCount, dev) != hipSuccess) { grid = -1; return; }
        if (hipFuncSetAttribute((const void*)mega_fwd, hipFuncAttributeMaxDynamicSharedMemorySize, LDS_TOTAL) != hipSuccess) { fprintf(stderr, "kernel_launch: hipFuncSetAttribute failed\n"); grid = -1; return; }
        if (hipOccupancyMaxActiveBlocksPerMultiprocessor(&per_cu, (const void*)mega_fwd, NTHR, LDS_TOTAL) != hipSuccess || per_cu < 1) { fprintf(stderr, "kernel_launch: occupancy query says %d\n", per_cu); per_cu = 1; }
        (void)hipGetLastError();
        grid = cus * per_cu;
    }
    if (grid < 0) return;
    if (hipMemsetAsync((char*)d_ws + WS_CTL, 0, 65536, stream) != hipSuccess) { fprintf(stderr, "kernel_launch: hipMemsetAsync failed\n"); return; }
    Args a{};
    for (int i = 0; i < 14; ++i) a.in[i] = (const float*)d_in[i];
    a.out = (float*)d_out; a.ws = (unsigned char*)d_ws;
    void* kargs[] = {&a};
    hipError_t e = hipLaunchCooperativeKernel((const void*)mega_fwd, dim3(grid), dim3(NTHR), kargs, LDS_TOTAL, stream);
    if (e != hipSuccess) fprintf(stderr, "kernel_launch: cooperative launch failed: %s (grid %d)\n", hipGetErrorString(e), grid);
}
```

```cpp
#include <hip/hip_runtime.h>
#include <cstdio>
#include <cstdint>
namespace pg8 {
#define PG8_LAS __attribute__((address_space(3)))
typedef unsigned short bf16_t;
typedef short bf16x8 __attribute__((ext_vector_type(8)));
typedef float f32x4 __attribute__((ext_vector_type(4)));
typedef unsigned u32x4 __attribute__((ext_vector_type(4)));
constexpr int BM = 256, BK = 64, HALF = 128, HTB = HALF * BK * 2  , STAGE_BYTES = 8 * HTB, NXCD = 8, WGM = 8;

__host__ __device__ __forceinline__ int lds_byte(int r, int c) { const int st = (r >> 4) * 2 + (c >> 5), rr = r & 15, cc = c & 31, ob = rr * 64 + cc * 2; return st * 1024 + (ob ^ (((ob >> 9) & 1) << 5)); }
__host__ __device__ __forceinline__ void stage_rc(int b, int& R, int& C) { const int st = b / 1024, sb = b % 1024, swz = sb ^ (((sb >> 9) & 1) << 5); R = (st >> 1) * 16 + swz / 64; C = (st & 1) * 32 + (swz % 64) / 2; }
__host__ __device__ __forceinline__ int perm32(int rho) { const int n = rho >> 4, i = rho & 15; return 8 * (i >> 2) + 4 * n + (i & 3); }

struct Unit { int pm, pn; };
struct Gemm { const bf16_t* A; const bf16_t* Bt; int M, N, K; };

struct StaticOrder {
    int nM, nN, nwg, G, c;
    __host__ __device__ void init(int M, int N, int G_, int c_) { nM = M / BM; nN = N / BM; nwg = nM * nN; G = G_; c = c_; }
    __host__ __device__ bool next(int i, Unit& u) const {
        const long L = (long)i * G + c; if (L >= nwg) return false;
        int wgid = (int)L; { const int q = nwg / NXCD, r = nwg % NXCD, xcd = wgid % NXCD, off = wgid / NXCD; wgid = (xcd < r ? xcd * (q + 1) : r * (q + 1) + (xcd - r) * q) + off; }
        const int nig = WGM * nN, gid = wgid / nig, fm = gid * WGM, gsz = (nM - fm) < WGM ? (nM - fm) : WGM;
        u.pm = fm + ((wgid % nig) % gsz); u.pn = (wgid % nig) / gsz; return true;
    }
    __device__ __forceinline__ void a_ready(const Unit&) const {}
    __device__ __forceinline__ void done(const Unit&) const {}
};

typedef float f32x2c_t __attribute__((ext_vector_type(2))); typedef __bf16 bf16x2c_t __attribute__((ext_vector_type(2)));
__device__ __forceinline__ unsigned cvt_pk_bf16(float lo, float hi) { f32x2c_t v = {lo, hi}; bf16x2c_t b = __builtin_convertvector(v, bf16x2c_t); return __builtin_bit_cast(unsigned, b); }
typedef float f32x2 __attribute__((ext_vector_type(2)));
__device__ __forceinline__ f32x2 gelu_pk(f32x2 v) {
    const f32x2 av = __builtin_elementwise_abs(v), d = av * 0.2316418882f + 1.0f;
    f32x2 t; t.x = __builtin_amdgcn_rcpf(d.x); t.y = __builtin_amdgcn_rcpf(d.y);
    f32x2 q = t * 0.5307027145f + (-0.7265760135f); q = q * t + 0.7107068705f; q = q * t + (-0.142248368f); q = q * t + 0.127414796f; q = q * t;
    const f32x2 s = (v * v) * (-0.72134752044f);
    f32x2 e; e.x = __builtin_amdgcn_exp2f(s.x); e.y = __builtin_amdgcn_exp2f(s.y);
    const f32x2 m = v * (q * e), r = v - m;
    f32x2 o; o.x = v.x < 0.f ? m.x : r.x; o.y = v.y < 0.f ? m.y : r.y; return o;
}

template <int ACT  > struct EpiBf16 {
    static constexpr bool PERM = true, AFTER_DRAIN = false; static_assert(ACT == 0 || ACT == 1, "EpiBf16: ACT is 0 (none) or 1 (gelu_pk)");
    bf16_t* O; int ldc; const float* bias; int split_cols; size_t split_stride; float scale0;
    __device__ __forceinline__ void operator()(const f32x4 (&acc)[2][2][4][2], const Unit& u, int wr, int wc, int fr, int fq) const {
        const int row0 = u.pm * BM + wr * 64 + fr; int colt = u.pn * BM; bf16_t* base = O;
        float sc = 1.f; if (split_cols) { const int t = colt / split_cols; base += (size_t)t * split_stride; colt -= t * split_cols; if (t == 0) sc = scale0; }
        const int col0 = colt + wc * 32 + 8 * fq, bcol0 = u.pn * BM + wc * 32 + 8 * fq;
        f32x4 bv[2][2];
#pragma unroll
        for (int bj = 0; bj < 2; ++bj)
#pragma unroll
            for (int n = 0; n < 2; ++n) bv[bj][n] = bias ? *(const f32x4*)(bias + bcol0 + bj * HALF + 4 * n) : (f32x4){0.f, 0.f, 0.f, 0.f};
#pragma unroll
        for (int ai = 0; ai < 2; ++ai)
#pragma unroll
            for (int m = 0; m < 4; ++m) { bf16_t* rowp = base + (size_t)(row0 + ai * HALF + m * 16) * ldc + col0;
#pragma unroll
                for (int bj = 0; bj < 2; ++bj) { f32x4 v0 = acc[ai][bj][m][0] + bv[bj][0], v1 = acc[ai][bj][m][1] + bv[bj][1];
                    if (ACT == 1) { f32x2 a = gelu_pk((f32x2){v0[0], v0[1]}), b = gelu_pk((f32x2){v0[2], v0[3]}), c = gelu_pk((f32x2){v1[0], v1[1]}), d = gelu_pk((f32x2){v1[2], v1[3]});
                        v0 = (f32x4){a.x, a.y, b.x, b.y}; v1 = (f32x4){c.x, c.y, d.x, d.y}; }
                    v0 = v0 * sc; v1 = v1 * sc; u32x4 w; w.x = cvt_pk_bf16(v0[0], v0[1]); w.y = cvt_pk_bf16(v0[2], v0[3]); w.z = cvt_pk_bf16(v1[0], v1[1]); w.w = cvt_pk_bf16(v1[2], v1[3]);
                    *(u32x4*)(rowp + bj * HALF) = w; } }
    }
};

struct PanelStats {
    unsigned* xbuf;
    unsigned* cnt;
    unsigned* tmo;
    int ntn; float eps;
    unsigned code;
    __device__ __forceinline__ bool run(const f32x4 (&v)[2][2][4][2], const Unit& u, int wr, int wc, int fr, int fq, PG8_LAS unsigned char* lds, int wid, int lane) const {
        typedef float f32x2v __attribute__((ext_vector_type(2)));
        PG8_LAS f32x2v* P = (PG8_LAS f32x2v*)lds;
        PG8_LAS f32x2v* S = (PG8_LAS f32x2v*)(lds + 8192);
        PG8_LAS unsigned* flag = (PG8_LAS unsigned*)(lds + 8192 + 2048);
#pragma unroll
        for (int ai = 0; ai < 2; ++ai)
#pragma unroll
            for (int m = 0; m < 4; ++m) {
                float s = 0.f;
#pragma unroll
                for (int bj = 0; bj < 2; ++bj)
#pragma unroll
                    for (int n = 0; n < 2; ++n) { const f32x4 x = v[ai][bj][m][n]; s += (x[0] + x[1]) + (x[2] + x[3]); }
                s += __shfl_xor(s, 16); s += __shfl_xor(s, 32);
                const float mw = s * (1.0f / 64.0f); float q = 0.f;
#pragma unroll
                for (int bj = 0; bj < 2; ++bj)
#pragma unroll
                    for (int n = 0; n < 2; ++n) { const f32x4 d = v[ai][bj][m][n] - mw; q += (d[0] * d[0] + d[1] * d[1]) + (d[2] * d[2] + d[3] * d[3]); }
                q += __shfl_xor(q, 16); q += __shfl_xor(q, 32);
                if (fq == 0) P[(ai * HALF + wr * 64 + m * 16 + fr) * 4 + wc] = (f32x2v){mw, q};
            }
        asm volatile("s_waitcnt lgkmcnt(0)" ::: "memory"); __builtin_amdgcn_s_barrier(); asm volatile("" ::: "memory");
#if defined(BROKEN_EXCHANGE_NO_WAIT)
#warning BROKEN CONTROL BUILD: the row-statistics exchange does not wait; results are wrong by design
        if (blockIdx.x >= 64) { const long long t0_ = clock64(); while (clock64() - t0_ < 60000) __builtin_amdgcn_s_sleep(8); }
#endif
        const int row = wid * 32 + (lane & 31);
        if (lane < 32) {
            const f32x2v a = P[row * 4 + 0], b = P[row * 4 + 1], c = P[row * 4 + 2], d = P[row * 4 + 3];
            const float mt = (a.x + b.x + c.x + d.x) * 0.25f;
            const float da = a.x - mt, db = b.x - mt, dc = c.x - mt, dd = d.x - mt;
            const float m2 = (a.y + b.y) + (c.y + d.y) + 64.0f * ((da * da + db * db) + (dc * dc + dd * dd));
            unsigned long long* slot = (unsigned long long*)xbuf + ((size_t)(u.pm * BM + row) * 4 + u.pn);
            __hip_atomic_store(slot, ((unsigned long long)__float_as_uint(m2) << 32) | __float_as_uint(mt), __ATOMIC_RELAXED, __HIP_MEMORY_SCOPE_AGENT);
        }
        asm volatile("s_waitcnt vmcnt(0)" ::: "memory");
        if (lane == 0) __hip_atomic_fetch_add(cnt + 64 * u.pm, 1u, __ATOMIC_RELAXED, __HIP_MEMORY_SCOPE_AGENT);
        if (wid == 0) {
            bool dead = false; const unsigned long long t0 = __builtin_amdgcn_s_memrealtime(); const unsigned want = 8u * (unsigned)ntn;
            for (;;) {
#if defined(BROKEN_EXCHANGE_NO_WAIT)
                break;
#endif
                if ((unsigned)__builtin_amdgcn_readfirstlane(__hip_atomic_load(cnt + 64 * u.pm, __ATOMIC_RELAXED, __HIP_MEMORY_SCOPE_AGENT)) >= want) break;
                if (__builtin_amdgcn_s_memrealtime() - t0 > 2000000ull) {
                    if (lane == 0) { unsigned expect = 0u; __hip_atomic_compare_exchange_strong(tmo + 1, &expect, code | (unsigned)(u.pm & 0xff), __ATOMIC_RELAXED, __ATOMIC_RELAXED, __HIP_MEMORY_SCOPE_AGENT);
                                     __hip_atomic_store(tmo, 1u, __ATOMIC_RELAXED, __HIP_MEMORY_SCOPE_AGENT); }
                    dead = true; break; }
                __builtin_amdgcn_s_sleep(2);
            }
            __builtin_amdgcn_fence(__ATOMIC_ACQUIRE, "agent");
            if (lane == 0) flag[0] = dead ? 1u : 0u;
        }
        asm volatile("s_waitcnt vmcnt(0) lgkmcnt(0)" ::: "memory"); __builtin_amdgcn_s_barrier(); asm volatile("" ::: "memory");
        const bool bad = flag[0] != 0u;
        if (lane < 32) {
            const unsigned long long* slot = (const unsigned long long*)xbuf + (size_t)(u.pm * BM + row) * 4; float mt[4], m2[4]; float ms = 0.f;
#pragma unroll
            for (int t = 0; t < 4; ++t) { if (t < ntn) { const unsigned long long w = __hip_atomic_load(slot + t, __ATOMIC_RELAXED, __HIP_MEMORY_SCOPE_AGENT); mt[t] = __uint_as_float((unsigned)w); m2[t] = __uint_as_float((unsigned)(w >> 32)); } else { mt[t] = 0.f; m2[t] = 0.f; } ms += mt[t]; }
            const float mean = ms / (float)ntn; float q = 0.f;
#pragma unroll
            for (int t = 0; t < 4; ++t) if (t < ntn) { const float dm = mt[t] - mean; q += m2[t] + 256.0f * dm * dm; }
            S[row] = (f32x2v){mean, 1.0f / sqrtf(q / (256.0f * (float)ntn) + eps)};
        }
        asm volatile("s_waitcnt lgkmcnt(0)" ::: "memory"); __builtin_amdgcn_s_barrier(); asm volatile("" ::: "memory");
        return bad;
    }
};
struct EpiLnRes {
    static constexpr bool PERM = false, AFTER_DRAIN = true;
    const float* base; float* out; int ldc; const float* bias; PanelStats st; unsigned poison;
    __device__ __forceinline__ void fused(f32x4 (&acc)[2][2][4][2], const Unit& u, int wr, int wc, int fr, int fq, PG8_LAS unsigned char* lds, int wid, int lane) const {
        typedef float f32x2v __attribute__((ext_vector_type(2)));
        const PG8_LAS f32x2v* S = (const PG8_LAS f32x2v*)(lds + 8192);
        const int col0 = u.pn * BM + wc * 32 + 4 * fq;
#pragma unroll
        for (int bj = 0; bj < 2; ++bj)
#pragma unroll
            for (int n = 0; n < 2; ++n) { const f32x4 bv = bias ? *(const f32x4*)(bias + col0 + bj * HALF + n * 16) : (f32x4){0.f, 0.f, 0.f, 0.f};
#pragma unroll
                for (int ai = 0; ai < 2; ++ai)
#pragma unroll
                    for (int m = 0; m < 4; ++m) acc[ai][bj][m][n] += bv; }
        f32x4 pre[4][2][2];
#pragma unroll
        for (int m = 0; m < 4; ++m) { const size_t off = (size_t)(u.pm * BM + wr * 64 + m * 16 + fr) * ldc + col0;
#pragma unroll
            for (int bj = 0; bj < 2; ++bj)
#pragma unroll
                for (int n = 0; n < 2; ++n) pre[m][bj][n] = *(const f32x4*)(base + off + bj * HALF + n * 16); }
        const bool bad = st.run(acc, u, wr, wc, fr, fq, lds, wid, lane) || poison != 0u;
        const float qnan = __builtin_nanf("");
#pragma unroll
        for (int ai = 0; ai < 2; ++ai)
#pragma unroll
            for (int m = 0; m < 4; ++m) { const int r = ai * HALF + wr * 64 + m * 16 + fr; const f32x2v sr = S[r]; const size_t off = (size_t)(u.pm * BM + r) * ldc + col0;
#pragma unroll
                for (int bj = 0; bj < 2; ++bj)
#pragma unroll
                    for (int n = 0; n < 2; ++n) { const f32x4 bs = ai == 0 ? pre[m][bj][n] : *(const f32x4*)(base + off + bj * HALF + n * 16); f32x4 o = bs + (acc[ai][bj][m][n] - sr.x) * sr.y;
                        if (bad) o = (f32x4){qnan, qnan, qnan, qnan}; *(f32x4*)(out + off + bj * HALF + n * 16) = o; }
                if (m & 1) asm volatile("" ::: "memory"); }
    }
};
struct EpiLnResLn {
    static constexpr bool PERM = false, AFTER_DRAIN = true;
    const float* base; float* out; bf16_t* xn; int ldc; const float* bias; PanelStats st1, st2; unsigned poison;
    __device__ __forceinline__ void fused(f32x4 (&acc)[2][2][4][2], const Unit& u, int wr, int wc, int fr, int fq, PG8_LAS unsigned char* lds, int wid, int lane) const {
        typedef float f32x2v __attribute__((ext_vector_type(2))); typedef unsigned u32x2v __attribute__((ext_vector_type(2)));
        const PG8_LAS f32x2v* S = (const PG8_LAS f32x2v*)(lds + 8192);
        const int col0 = u.pn * BM + wc * 32 + 4 * fq;
#pragma unroll
        for (int bj = 0; bj < 2; ++bj)
#pragma unroll
            for (int n = 0; n < 2; ++n) { const f32x4 bv = bias ? *(const f32x4*)(bias + col0 + bj * HALF + n * 16) : (f32x4){0.f, 0.f, 0.f, 0.f};
#pragma unroll
                for (int ai = 0; ai < 2; ++ai)
#pragma unroll
                    for (int m = 0; m < 4; ++m) acc[ai][bj][m][n] += bv; }
        bool bad = st1.run(acc, u, wr, wc, fr, fq, lds, wid, lane) || poison != 0u;
        const float qnan = __builtin_nanf("");
#pragma unroll
        for (int ai = 0; ai < 2; ++ai)
#pragma unroll
            for (int m = 0; m < 4; ++m) { const int r = ai * HALF + wr * 64 + m * 16 + fr; const f32x2v sr = S[r]; const size_t off = (size_t)(u.pm * BM + r) * ldc + col0;
#pragma unroll
                for (int bj = 0; bj < 2; ++bj)
#pragma unroll
                    for (int n = 0; n < 2; ++n) { const f32x4 bs = *(const f32x4*)(base + off + bj * HALF + n * 16); acc[ai][bj][m][n] = bs + (acc[ai][bj][m][n] - sr.x) * sr.y; }
                asm volatile("" : "+v"(acc[ai][0][m][0]), "+v"(acc[ai][0][m][1]), "+v"(acc[ai][1][m][0]), "+v"(acc[ai][1][m][1]));
                if (m & 1) asm volatile("" ::: "memory"); }
        const bool bad1 = bad;
        bad = st2.run(acc, u, wr, wc, fr, fq, lds, wid, lane) || bad;
#pragma unroll
        for (int ai = 0; ai < 2; ++ai)
#pragma unroll
            for (int m = 0; m < 4; ++m) { const int r = ai * HALF + wr * 64 + m * 16 + fr; const f32x2v sr = S[r]; const size_t off = (size_t)(u.pm * BM + r) * ldc + col0;
#pragma unroll
                for (int bj = 0; bj < 2; ++bj)
#pragma unroll
                    for (int n = 0; n < 2; ++n) { const f32x4 x1 = acc[ai][bj][m][n]; *(f32x4*)(out + off + bj * HALF + n * 16) = bad1 ? (f32x4){qnan, qnan, qnan, qnan} : x1;
                        const f32x4 o = (x1 - sr.x) * sr.y; u32x2v w; w.x = cvt_pk_bf16(o[0], o[1]); w.y = cvt_pk_bf16(o[2], o[3]);
                        if (bad) { w.x = 0x7fc07fc0u; w.y = 0x7fc07fc0u; } *(u32x2v*)(xn + off + bj * HALF + n * 16) = w; }
                asm volatile("" ::: "memory"); }
    }
};

template <class Epi, class Sched, bool ALIGN_EPI = false, bool SP2 = false>
__device__ __forceinline__ void gemm_phase(PG8_LAS unsigned char* lds, const Gemm g, const Sched& S, const Epi& E) {
    int tid_ = threadIdx.x; asm volatile("" : "+v"(tid_));
    const int tid = tid_, wid = __builtin_amdgcn_readfirstlane(tid >> 6), lane = tid & 63, wr = wid >> 2, wc = wid & 3, fr = lane & 15, fq = lane >> 4;
    const int K = g.K, nt = K / BK;
    unsigned voffA[2], voffB[2];
#pragma unroll
    for (int i = 0; i < 2; ++i) { int R, C; stage_rc(tid * 16 + i * 8192, R, C); const int Rb = Epi::PERM ? ((R & ~31) + perm32(R & 31)) : R;
        voffA[i] = (unsigned)(R * K + C) * 2u; voffB[i] = (unsigned)(Rb * K + C) * 2u; }
    const size_t kstep = (size_t)(BK * 2);
    const size_t hstep = (size_t)HALF * K * 2;
    const size_t tstep = 2 * hstep;
    const unsigned ldsw = (unsigned)wid * 1024u;
    const int aoff = lds_byte(wr * 64 + fr, fq * 8), boff = lds_byte(wc * 32 + fr, fq * 8);
#define PG8_SA(b, h) (((b) * 2 + (h)) * HTB)
#define PG8_SB(b, h) ((4 + (b) * 2 + (h)) * HTB)
#define PG8_STAGE(bufoff, gbase, voff) do { _Pragma("unroll") for (int _i = 0; _i < 2; ++_i) \
        __builtin_amdgcn_global_load_lds((const unsigned*)((const char*)(gbase) + (voff)[_i]), (PG8_LAS unsigned*)(lds + (bufoff) + ldsw + _i * 8192), 16, 0, 0); } while (0)
#define PG8_LDA(dst, b, h) do { _Pragma("unroll") for (int m = 0; m < 4; ++m) _Pragma("unroll") for (int k = 0; k < 2; ++k) dst[m][k] = *(const PG8_LAS bf16x8*)(lds + PG8_SA(b, h) + aoff + m * 2048 + k * 1024); } while (0)
#define PG8_LDB(dst, b, h) do { _Pragma("unroll") for (int n = 0; n < 2; ++n) _Pragma("unroll") for (int k = 0; k < 2; ++k) dst[n][k] = *(const PG8_LAS bf16x8*)(lds + PG8_SB(b, h) + boff + n * 2048 + k * 1024); } while (0)
#define PG8_MMA(ai, bj, At, Bt) do { __builtin_amdgcn_s_setprio(1); _Pragma("unroll") for (int m = 0; m < 4; ++m) _Pragma("unroll") for (int n = 0; n < 2; ++n) _Pragma("unroll") for (int k = 0; k < 2; ++k) \
        acc[ai][bj][m][n] = __builtin_amdgcn_mfma_f32_16x16x32_bf16(Bt[n][k], At[m][k], acc[ai][bj][m][n], 0, 0, 0); __builtin_amdgcn_s_setprio(0); } while (0)
#define PG8_WAIT_V(n) asm volatile("s_waitcnt vmcnt(" #n ")" ::: "memory")
#define PG8_WAIT_L(n) asm volatile("s_waitcnt lgkmcnt(" #n ")" ::: "memory")
#define PG8_BAR __builtin_amdgcn_s_barrier()
#define PG8_SCHED __builtin_amdgcn_sched_barrier(0)
    Unit cur, nxt; int ui = 0;
    if (!S.next(0, cur)) return;
    f32x4 acc[2][2][4][2];
#pragma unroll
    for (int a = 0; a < 2; ++a)
#pragma unroll
        for (int b = 0; b < 2; ++b)
#pragma unroll
            for (int m = 0; m < 4; ++m)
#pragma unroll
                for (int n = 0; n < 2; ++n) acc[a][b][m][n] = (f32x4){0.f, 0.f, 0.f, 0.f};
    bf16x8 At[4][2], B0[2][2], B1[2][2];
    const char* cA = (const char*)g.A + (size_t)cur.pm * tstep; const char* cB = (const char*)g.Bt + (size_t)cur.pn * tstep;
    S.a_ready(cur);
    if constexpr (SP2) {
        PG8_STAGE(PG8_SB(0, 0), cB, voffB); PG8_STAGE(PG8_SB(0, 1), cB + hstep, voffB); PG8_STAGE(PG8_SA(0, 0), cA, voffA); PG8_STAGE(PG8_SA(0, 1), cA + hstep, voffA);
        if (wr == 1) PG8_BAR;
        PG8_WAIT_V(2); PG8_BAR;
        PG8_STAGE(PG8_SB(1, 0), cB + kstep, voffB); PG8_STAGE(PG8_SA(1, 0), cA + kstep, voffA); PG8_STAGE(PG8_SB(1, 1), cB + hstep + kstep, voffB);
        PG8_WAIT_V(6); PG8_BAR;
    } else {
        PG8_STAGE(PG8_SB(0, 0), cB, voffB); PG8_STAGE(PG8_SA(0, 0), cA, voffA); PG8_STAGE(PG8_SB(0, 1), cB + hstep, voffB); PG8_STAGE(PG8_SA(0, 1), cA + hstep, voffA);
        if (wr == 1) PG8_BAR;
        PG8_WAIT_V(4); PG8_BAR;
        PG8_STAGE(PG8_SB(1, 0), cB + kstep, voffB); PG8_STAGE(PG8_SA(1, 0), cA + kstep, voffA); PG8_STAGE(PG8_SB(1, 1), cB + hstep + kstep, voffB);
        PG8_WAIT_V(6); PG8_BAR;
    }
    for (;;) {
        const bool has_next = S.next(ui + 1, nxt);
        const char* nA = has_next ? (const char*)g.A + (size_t)nxt.pm * tstep : cA; const char* nB = has_next ? (const char*)g.Bt + (size_t)nxt.pn * tstep : cB;
        for (int t = 0; t < nt; t += 2) {
            const bool last = (t == nt - 2);
            const char* a1 = cA + (size_t)(t + 1) * kstep;
            const char* a2 = last ? nA : cA + (size_t)(t + 2) * kstep; const char* b2 = last ? nB : cB + (size_t)(t + 2) * kstep;
            const char* a3 = a2 + kstep; const char* b3 = b2 + kstep;
            if (last && has_next) S.a_ready(nxt);
            if constexpr (SP2) {
            PG8_LDB(B0, 0, 0); PG8_LDB(B1, 0, 1); PG8_SCHED; PG8_LDA(At, 0, 0); PG8_STAGE(PG8_SA(1, 1), a1 + hstep, voffA);
            PG8_WAIT_V(8); PG8_WAIT_L(0); PG8_BAR; PG8_MMA(0, 0, At, B0); PG8_MMA(0, 1, At, B1); PG8_BAR; PG8_SCHED;
            PG8_LDA(At, 0, 1); PG8_STAGE(PG8_SB(0, 0), b2, voffB); PG8_STAGE(PG8_SB(0, 1), b2 + hstep, voffB); PG8_STAGE(PG8_SA(0, 0), a2, voffA);
            PG8_WAIT_V(8); PG8_WAIT_L(0); PG8_BAR; PG8_MMA(1, 0, At, B0); PG8_MMA(1, 1, At, B1); PG8_BAR; PG8_SCHED;
            PG8_LDB(B0, 1, 0); PG8_LDB(B1, 1, 1); PG8_SCHED; PG8_LDA(At, 1, 0); PG8_STAGE(PG8_SA(0, 1), a2 + hstep, voffA);
            PG8_WAIT_V(8); PG8_WAIT_L(0); PG8_BAR; PG8_MMA(0, 0, At, B0); PG8_MMA(0, 1, At, B1); PG8_BAR; PG8_SCHED;
            PG8_LDA(At, 1, 1); PG8_STAGE(PG8_SB(1, 0), b3, voffB); PG8_STAGE(PG8_SB(1, 1), b3 + hstep, voffB); PG8_STAGE(PG8_SA(1, 0), a3, voffA);
            PG8_WAIT_V(8); PG8_WAIT_L(0); PG8_BAR; PG8_MMA(1, 0, At, B0); PG8_MMA(1, 1, At, B1); PG8_BAR; PG8_SCHED;
            } else {
            PG8_LDB(B0, 0, 0); PG8_SCHED; PG8_LDA(At, 0, 0); PG8_STAGE(PG8_SA(1, 1), a1 + hstep, voffA);
            PG8_WAIT_L(8); PG8_BAR; PG8_WAIT_L(0); PG8_MMA(0, 0, At, B0); PG8_BAR; PG8_SCHED;
            PG8_LDB(B1, 0, 1); PG8_STAGE(PG8_SB(0, 0), b2, voffB);
            PG8_BAR; PG8_WAIT_L(0); PG8_MMA(0, 1, At, B1); PG8_BAR;
            PG8_LDA(At, 0, 1); PG8_STAGE(PG8_SA(0, 0), a2, voffA);
            PG8_BAR; PG8_WAIT_L(0); PG8_MMA(1, 0, At, B0); PG8_BAR; PG8_SCHED;
            PG8_STAGE(PG8_SB(0, 1), b2 + hstep, voffB);
            PG8_WAIT_V(6); PG8_BAR; PG8_MMA(1, 1, At, B1); PG8_BAR;
            PG8_LDB(B0, 1, 0); PG8_SCHED; PG8_LDA(At, 1, 0); PG8_STAGE(PG8_SA(0, 1), a2 + hstep, voffA);
            PG8_WAIT_L(8); PG8_BAR; PG8_WAIT_L(0); PG8_MMA(0, 0, At, B0); PG8_BAR; PG8_SCHED;
            PG8_LDB(B1, 1, 1); PG8_STAGE(PG8_SB(1, 0), b3, voffB);
            PG8_BAR; PG8_WAIT_L(0); PG8_MMA(0, 1, At, B1); PG8_BAR;
            PG8_LDA(At, 1, 1); PG8_STAGE(PG8_SA(1, 0), a3, voffA);
            PG8_BAR; PG8_WAIT_L(0); PG8_MMA(1, 0, At, B0); PG8_BAR; PG8_SCHED;
            PG8_STAGE(PG8_SB(1, 1), b3 + hstep, voffB);
            PG8_WAIT_V(6); PG8_BAR; PG8_MMA(1, 1, At, B1); PG8_BAR;
            }
        }
        if constexpr (ALIGN_EPI) { if (wr == 0) PG8_BAR; }
        if constexpr (!Epi::AFTER_DRAIN) { E(acc, cur, wr, wc, fr, fq); S.done(cur); }
        if (!has_next) break;
#pragma unroll
        for (int a = 0; a < 2; ++a)
#pragma unroll
            for (int b = 0; b < 2; ++b)
#pragma unroll
                for (int m = 0; m < 4; ++m)
#pragma unroll
                    for (int n = 0; n < 2; ++n) acc[a][b][m][n] = (f32x4){0.f, 0.f, 0.f, 0.f};
        cur = nxt; cA = nA; cB = nB; ++ui;
        if constexpr (ALIGN_EPI) { if (wr == 1) PG8_BAR; }
    }
    PG8_WAIT_V(0);
    if constexpr (!ALIGN_EPI) { if (wr == 0) PG8_BAR; }
    PG8_BAR;
    if constexpr (Epi::AFTER_DRAIN) { E.fused(acc, cur, wr, wc, fr, fq, lds, wid, lane); S.done(cur); }
#undef PG8_SA
#undef PG8_SB
#undef PG8_STAGE
#undef PG8_LDA
#undef PG8_LDB
#undef PG8_MMA
#undef PG8_WAIT_V
#undef PG8_WAIT_L
#undef PG8_BAR
#undef PG8_SCHED
}
}
namespace pg8 {
__device__ __forceinline__ float fsig(float v) { return __builtin_amdgcn_rcpf(1.0f + __builtin_amdgcn_exp2f(-1.4426950408889634f * v)); }
__device__ __forceinline__ float bf_lo(unsigned w) { return __uint_as_float(w << 16); }
__device__ __forceinline__ float bf_hi(unsigned w) { return __uint_as_float(w & 0xffff0000u); }

struct EpiInProj {
    static constexpr bool PERM = true, AFTER_DRAIN = false;
    bf16_t* QA; bf16_t* QB; bf16_t* KA; bf16_t* VA; float* G; bf16_t* IB; bf16_t* GB; const float* lbl; int layer; float qscale;
    __device__ __forceinline__ void operator()(const f32x4 (&acc)[2][2][4][2], const Unit& u, int wr, int wc, int fr, int fq) const {
        const int type = u.pn >> 1;
        const int ct = (u.pn & 1) * 256 + wc * 32 + 8 * fq;
        const int row0 = u.pm * BM + wr * 64 + fr;
        if (type == 4) {
            float lb[2][8];
#pragma unroll
            for (int bj = 0; bj < 2; ++bj)
#pragma unroll
                for (int j = 0; j < 8; ++j) {
                    float v = 0.f;
                    if (layer != 0) { const float l0 = lbl[ct + bj * HALF + j], l1 = lbl[512 + ct + bj * HALF + j]; v = 1.0f / (1.0f + __expf(l0 - l1)); }
                    lb[bj][j] = v;
                }
#pragma unroll
            for (int ai = 0; ai < 2; ++ai)
#pragma unroll
                for (int m = 0; m < 4; ++m) { float* rowp = G + (size_t)(row0 + ai * HALF + m * 16) * 512 + ct;
#pragma unroll
                    for (int bj = 0; bj < 2; ++bj) { f32x4 o0, o1;
#pragma unroll
                        for (int j = 0; j < 4; ++j) {
                            const float f0 = lb[bj][j] + (1.0f - lb[bj][j]) * fsig(acc[ai][bj][m][0][j]);
                            const float f1 = lb[bj][4 + j] + (1.0f - lb[bj][4 + j]) * fsig(acc[ai][bj][m][1][j]);
                            o0[j] = __builtin_amdgcn_logf(f0) * 0.6931471805599453f; o1[j] = __builtin_amdgcn_logf(f1) * 0.6931471805599453f; }
                        *(f32x4*)(rowp + bj * HALF) = o0; *(f32x4*)(rowp + bj * HALF + 4) = o1; } }
        } else {
            bf16_t* base; int ldc = 512, act = 0; float sc = 1.f;
            if (type == 0) { base = QA; sc = qscale; }
            else if (type == 1) base = KA;
            else if (type == 2) base = VA;
            else if (type == 3) { base = QB; act = 1; }
            else if (type == 5) base = IB;
            else { base = GB; act = 2; }
#pragma unroll
            for (int ai = 0; ai < 2; ++ai)
#pragma unroll
                for (int m = 0; m < 4; ++m) { bf16_t* rowp = base + (size_t)(row0 + ai * HALF + m * 16) * ldc + ct;
#pragma unroll
                    for (int bj = 0; bj < 2; ++bj) { f32x4 v0 = acc[ai][bj][m][0], v1 = acc[ai][bj][m][1];
                        if (act != 0) {
#pragma unroll
                            for (int j = 0; j < 4; ++j) { const float s0 = fsig(v0[j]), s1 = fsig(v1[j]); v0[j] = (act == 1) ? v0[j] * s0 : s0; v1[j] = (act == 1) ? v1[j] * s1 : s1; }
                        } else { v0 = v0 * sc; v1 = v1 * sc; }
                        u32x4 w; w.x = cvt_pk_bf16(v0[0], v0[1]); w.y = cvt_pk_bf16(v0[2], v0[3]); w.z = cvt_pk_bf16(v1[0], v1[1]); w.w = cvt_pk_bf16(v1[2], v1[3]);
                        *(u32x4*)(rowp + bj * HALF) = w; } }
        }
    }
};
struct EpiGates {
    static constexpr bool PERM = true, AFTER_DRAIN = false;
    bf16_t* O;
    __device__ __forceinline__ void operator()(const f32x4 (&acc)[2][2][4][2], const Unit& u, int wr, int wc, int fr, int fq) const {
        const int row0 = u.pm * BM + wr * 64 + fr, col0 = u.pn * BM + wc * 32 + 8 * fq;
#pragma unroll
        for (int ai = 0; ai < 2; ++ai)
#pragma unroll
            for (int m = 0; m < 4; ++m) { bf16_t* rowp = O + (size_t)(row0 + ai * HALF + m * 16) * 2048 + col0;
#pragma unroll
                for (int bj = 0; bj < 2; ++bj) { f32x4 v0 = acc[ai][bj][m][0], v1 = acc[ai][bj][m][1];
#pragma unroll
                    for (int j = 0; j < 4; ++j) { v0[j] = fsig(v0[j]); v1[j] = fsig(v1[j]); }
                    u32x4 w; w.x = cvt_pk_bf16(v0[0], v0[1]); w.y = cvt_pk_bf16(v0[2], v0[3]); w.z = cvt_pk_bf16(v1[0], v1[1]); w.w = cvt_pk_bf16(v1[2], v1[3]);
                    *(u32x4*)(rowp + bj * HALF) = w; } }
    }
};
template <int STEP> struct EpiMerge {
    static constexpr bool PERM = true, AFTER_DRAIN = false;
    const bf16_t* GT; bf16_t* O;
    __device__ __forceinline__ void operator()(const f32x4 (&acc)[2][2][4][2], const Unit& u, int wr, int wc, int fr, int fq) const {
        const int row0 = u.pm * BM + wr * 64 + fr, col0 = u.pn * BM + wc * 32 + 8 * fq;
#pragma unroll
        for (int ai = 0; ai < 2; ++ai)
#pragma unroll
            for (int m = 0; m < 4; ++m) { const size_t row = (size_t)(row0 + ai * HALF + m * 16);
#pragma unroll
                for (int bj = 0; bj < 2; ++bj) {
                    const u32x4 g = *(const u32x4*)(GT + row * 2048 + STEP * 1024 + col0 + bj * HALF);
                    const f32x4 a0 = acc[ai][bj][m][0], a1 = acc[ai][bj][m][1];
                    float o[8] = {bf_lo(g.x) * a0[0], bf_hi(g.x) * a0[1], bf_lo(g.y) * a0[2], bf_hi(g.y) * a0[3], bf_lo(g.z) * a1[0], bf_hi(g.z) * a1[1], bf_lo(g.w) * a1[2], bf_hi(g.w) * a1[3]};
                    if (STEP == 1) { const u32x4 t = *(const u32x4*)(O + row * 1024 + col0 + bj * HALF);
                        o[0] += bf_lo(t.x); o[1] += bf_hi(t.x); o[2] += bf_lo(t.y); o[3] += bf_hi(t.y); o[4] += bf_lo(t.z); o[5] += bf_hi(t.z); o[6] += bf_lo(t.w); o[7] += bf_hi(t.w); }
                    u32x4 w; w.x = cvt_pk_bf16(o[0], o[1]); w.y = cvt_pk_bf16(o[2], o[3]); w.z = cvt_pk_bf16(o[4], o[5]); w.w = cvt_pk_bf16(o[6], o[7]);
                    *(u32x4*)(O + row * 1024 + col0 + bj * HALF) = w; }
                if (m & 1) asm volatile("" ::: "memory"); }
    }
};
struct EpiSwiGLU {
    static constexpr bool PERM = true, AFTER_DRAIN = false;
    bf16_t* O;
    __device__ __forceinline__ void operator()(const f32x4 (&acc)[2][2][4][2], const Unit& u, int wr, int wc, int fr, int fq) const {
        const int row0 = u.pm * BM + wr * 64 + fr, col0 = u.pn * HALF + wc * 32 + 8 * fq;
#pragma unroll
        for (int ai = 0; ai < 2; ++ai)
#pragma unroll
            for (int m = 0; m < 4; ++m) { const size_t row = (size_t)(row0 + ai * HALF + m * 16);
                f32x4 v0, v1;
#pragma unroll
                for (int j = 0; j < 4; ++j) { const float g0 = acc[ai][1][m][0][j], g1 = acc[ai][1][m][1][j];
                    v0[j] = g0 * fsig(g0) * acc[ai][0][m][0][j]; v1[j] = g1 * fsig(g1) * acc[ai][0][m][1][j]; }
                u32x4 w; w.x = cvt_pk_bf16(v0[0], v0[1]); w.y = cvt_pk_bf16(v0[2], v0[3]); w.z = cvt_pk_bf16(v1[0], v1[1]); w.w = cvt_pk_bf16(v1[2], v1[3]);
                *(u32x4*)(O + row * 2816 + col0) = w; }
    }
};
struct EpiResid {
    static constexpr bool PERM = false, AFTER_DRAIN = false;
    const float* xres; float* out; float alpha; const float* st; const float* gam; const float* bet;
    __device__ __forceinline__ void operator()(const f32x4 (&acc)[2][2][4][2], const Unit& u, int wr, int wc, int fr, int fq) const {
        const int row0 = u.pm * BM + wr * 64 + fr, col0 = u.pn * BM + wc * 32 + 4 * fq;
        typedef float f32x2e __attribute__((ext_vector_type(2)));
        f32x4 gv[2][2], bv[2][2];
        if (st) {
#pragma unroll
            for (int bj = 0; bj < 2; ++bj)
#pragma unroll
                for (int n = 0; n < 2; ++n) { gv[bj][n] = *(const f32x4*)(gam + col0 + bj * HALF + n * 16); bv[bj][n] = *(const f32x4*)(bet + col0 + bj * HALF + n * 16); }
        }
#pragma unroll
        for (int ai = 0; ai < 2; ++ai)
#pragma unroll
            for (int m = 0; m < 4; ++m) { const size_t row = (size_t)(row0 + ai * HALF + m * 16); const size_t off = row * 1024 + col0;
                f32x2e sr = {0.f, 1.f}; if (st) sr = *(const f32x2e*)(st + 2 * row);
#pragma unroll
                for (int bj = 0; bj < 2; ++bj)
#pragma unroll
                    for (int n = 0; n < 2; ++n) { f32x4 x = *(const f32x4*)(xres + off + bj * HALF + n * 16);
                        if (st) x = (x - sr.x) * sr.y * gv[bj][n] + bv[bj][n];
                        *(f32x4*)(out + off + bj * HALF + n * 16) = x * alpha + acc[ai][bj][m][n]; }
                if (m & 1) asm volatile("" ::: "memory"); }
    }
};
}
#include <hip/hip_bf16.h>
#include <cmath>
namespace attn_body {
using bf16=__hip_bfloat16;
using bf16x8=__attribute__((ext_vector_type(8)))short;
using s16x4=__attribute__((ext_vector_type(4)))short;
using f32x16=__attribute__((ext_vector_type(16)))float;
using u32x4=__attribute__((ext_vector_type(4)))unsigned;
constexpr int BATCH=2,NHEAD=8,SEQ=16384,D=64,QP=512,KP=512;
constexpr int NW=8,QBLK=32,QB=QBLK*NW,KVBLK=64,NQB=SEQ/QB;
constexpr int ATTN_UNIT_ROWS=QB;
__device__ __forceinline__ int crow(int r,int hi){return (r&3)+8*(r>>2)+4*hi;}
#define SBAR() __builtin_amdgcn_sched_barrier(0)
__device__ __forceinline__ void cmask(f32x16&p0,f32x16&p1,int jb,int qrel,int hi){
  const float NEG=-INFINITY; int kb=64*jb+4*hi;
  #pragma unroll
  for(int r=0;r<16;++r){int kv=kb+(r&3)+8*(r>>2); if(kv>qrel)p0[r]=NEG; if(kv+32>qrel)p1[r]=NEG;}
}

constexpr int NSLOT=3, SLOTB=8192;
constexpr int LDS_K=0, LDS_V=NSLOT*SLOTB, LDS_WS=2*NSLOT*SLOTB, LDS_OST=LDS_WS+NW*64*4, LDS_FB=LDS_OST+NW*4096, LDS_BYTES=LDS_FB+SEQ*4;
constexpr float C2=0.125f*1.4426950408889634f;
__device__ __forceinline__ void glds16(const void*gsrc,unsigned lds_dst){unsigned keep;
  asm volatile("s_mov_b32 %0, m0\n\ts_mov_b32 m0, %2\n\ts_nop 0\n\tglobal_load_lds_dwordx4 %1, off\n\ts_mov_b32 m0, %0":"=&s"(keep):"v"(gsrc),"s"(lds_dst):"memory");}
__device__ __forceinline__ float max3f(float a,float b,float c){float r;asm("v_max3_f32 %0, %1, %2, %3":"=v"(r):"v"(a),"v"(b),"v"(c));return r;}
__device__ __forceinline__ float max2f(float a,float b){float r;asm("v_max_f32_e32 %0, %1, %2":"=v"(r):"v"(a),"v"(b));return r;}
__device__ __forceinline__ float fadd_s(float a,float b){float r;asm("v_add_f32_e32 %0, %1, %2":"=v"(r):"v"(a),"v"(b));return r;}
__device__ __forceinline__ float fsub_s(float a,float b){float r;asm("v_sub_f32_e32 %0, %1, %2":"=v"(r):"v"(a),"v"(b));return r;}
typedef float f32x2_t __attribute__((ext_vector_type(2))); typedef __bf16 bf16x2_t __attribute__((ext_vector_type(2)));
__device__ __forceinline__ unsigned cvtpk_s(float lo,float hi){f32x2_t v={lo,hi};bf16x2_t b=__builtin_convertvector(v,bf16x2_t);return __builtin_bit_cast(unsigned,b);}
#define WAIT_BAR(N) asm volatile("s_waitcnt vmcnt(" #N ") lgkmcnt(0)\n\ts_barrier":::"memory")

__device__ __forceinline__ void qkt(f32x16&p0,f32x16&p1,const char*Kslot,const bf16x8*qr,int r32,int hi){
  const char*kb=Kslot+hi*1024+r32*16;
  #pragma unroll
  for(int d0=0;d0<4;++d0){
    const bf16x8 b0=*reinterpret_cast<const bf16x8*>(kb+d0*2048);
    const bf16x8 b1=*reinterpret_cast<const bf16x8*>(kb+d0*2048+512);
    p0=__builtin_amdgcn_mfma_f32_32x32x16_bf16(b0,qr[d0],p0,0,0,0);p1=__builtin_amdgcn_mfma_f32_32x32x16_bf16(b1,qr[d0],p1,0,0,0);}
}
typedef __attribute__((address_space(3))) const char* lds_cptr;
typedef short v4i16_t __attribute__((ext_vector_type(4)));
__device__ __forceinline__ void kload8(bf16x8*kf,lds_cptr kp){
  kf[0]=*(const __attribute__((address_space(3))) bf16x8*)(kp);      kf[1]=*(const __attribute__((address_space(3))) bf16x8*)(kp+512);
  kf[2]=*(const __attribute__((address_space(3))) bf16x8*)(kp+2048); kf[3]=*(const __attribute__((address_space(3))) bf16x8*)(kp+2560);
  kf[4]=*(const __attribute__((address_space(3))) bf16x8*)(kp+4096); kf[5]=*(const __attribute__((address_space(3))) bf16x8*)(kp+4608);
  kf[6]=*(const __attribute__((address_space(3))) bf16x8*)(kp+6144); kf[7]=*(const __attribute__((address_space(3))) bf16x8*)(kp+6656);
}
__device__ __forceinline__ void kload2(bf16x8*kf,lds_cptr kp,int j){ kf[2*j]=*(const __attribute__((address_space(3))) bf16x8*)(kp+j*2048); kf[2*j+1]=*(const __attribute__((address_space(3))) bf16x8*)(kp+j*2048+512); }
__device__ __forceinline__ s16x4 vtr(lds_cptr p){ return __builtin_bit_cast(s16x4,__builtin_amdgcn_ds_read_tr16_b64_v4i16((__attribute__((address_space(3))) v4i16_t*)p)); }
__device__ __forceinline__ float rowmax(const f32x16&p0,const f32x16&p1){
  float a=max3f(p0[0],p0[1],p1[0]),b=max3f(p0[2],p0[3],p1[1]);a=max3f(a,p1[2],p1[3]);
  #pragma unroll
  for(int r=4;r<16;r+=4){a=max3f(a,p0[r],p0[r+1]);b=max3f(b,p0[r+2],p0[r+3]);a=max3f(a,p1[r],p1[r+1]);b=max3f(b,p1[r+2],p1[r+3]);}
  const float m=max2f(a,b);
  auto rr=__builtin_amdgcn_permlane32_swap(__float_as_uint(m),__float_as_uint(m),false,false);
  return max2f(__uint_as_float(rr[0]),__uint_as_float(rr[1]));
}
__device__ __forceinline__ void pv(f32x16*o,int vb,bf16x8 pa0,bf16x8 pa1,bf16x8 pa2,bf16x8 pa3){
  #pragma unroll
  for(int d0=0;d0<2;++d0){s16x4 lo[4],hi[4];
    #pragma unroll
    for(int ks=0;ks<4;++ks){
      asm volatile("ds_read_b64_tr_b16 %0,%1 offset:%c2":"=&v"(lo[ks]):"v"(vb),"i"(d0*4096+ks*1024):"memory");
      asm volatile("ds_read_b64_tr_b16 %0,%1 offset:%c2":"=&v"(hi[ks]):"v"(vb),"i"(d0*4096+ks*1024+512):"memory");}
    asm volatile("s_waitcnt lgkmcnt(0)":::"memory");SBAR();
    #define PK(k) (bf16x8){lo[k][0],lo[k][1],lo[k][2],lo[k][3],hi[k][0],hi[k][1],hi[k][2],hi[k][3]}
    o[d0]=__builtin_amdgcn_mfma_f32_32x32x16_bf16(pa0,PK(0),o[d0],0,0,0);
    o[d0]=__builtin_amdgcn_mfma_f32_32x32x16_bf16(pa1,PK(1),o[d0],0,0,0);
    o[d0]=__builtin_amdgcn_mfma_f32_32x32x16_bf16(pa2,PK(2),o[d0],0,0,0);
    o[d0]=__builtin_amdgcn_mfma_f32_32x32x16_bf16(pa3,PK(3),o[d0],0,0,0);
    #undef PK
  }
}

#ifndef ATTN_STORE16
#define ATTN_STORE16(p,v) (*(u32x4*)(p)=(v))
#endif
template<int THRL> __device__ __forceinline__ void attn_unit(int b,int h,int qb,const bf16*Q,const bf16*__restrict__ K,const bf16*__restrict__ V,bf16*O,const float*__restrict__ Fg,const unsigned*__restrict__ NB,char*shm){
  int tid_=threadIdx.x; asm volatile("":"+v"(tid_));
  const int tid=tid_,lane=tid&63,r32=lane&31,hi=lane>>5; const int wid=__builtin_amdgcn_readfirstlane(tid>>6);
  const long rowbase=(long)b*SEQ; const int q0=qb*QB;
  const bf16*Qw=Q+(rowbase+q0+wid*QBLK)*QP+h*D;
  const bf16*Kh=K+rowbase*KP+h*D,*Vh=V+rowbase*KP+h*D;
  __attribute__((address_space(3))) char* const shm3w=(__attribute__((address_space(3))) char*)shm;
  const unsigned lds0=(unsigned)(uintptr_t)shm;
  float*wsf=(float*)(shm+LDS_WS)+wid*64;
  const bf16*ksrc_=Kh+(long)lane*KP+wid*8;
  const bf16*vsrc_=Vh+(long)(16*(wid&3)+(lane>>2))*KP+(wid>>2)*32+(lane&3)*8;
  const unsigned kdst=lds0+LDS_K+wid*1024, vdst=lds0+LDS_V+wid*1024;
  #define DMA_K(t,slot) glds16(ksrc+(long)(t)*KVBLK*KP,(unsigned)__builtin_amdgcn_readfirstlane(kdst+(slot)))
  #define DMA_V(t,slot) glds16(vsrc+(long)(t)*KVBLK*KP,(unsigned)__builtin_amdgcn_readfirstlane(vdst+(slot)))
  const int vb0=(int)(lds0+LDS_V)+((lane>>4)&1)*32+(lane&3)*8+(4*hi+((lane&15)>>2))*64;
  const char*Kbase=shm+LDS_K; bf16x8 kf[8];
  const lds_cptr shm3=(lds_cptr)shm; const lds_cptr kp0=shm3+LDS_K+hi*1024+r32*16; const lds_cptr vp0=shm3+LDS_V+((lane>>4)&1)*32+(lane&3)*8+(4*hi+((lane&15)>>2))*64;
  const int NT0=(q0+QB)/KVBLK;
  int j0;
  { typedef __attribute__((address_space(3))) unsigned* lds_uptr; const lds_uptr cnt=(lds_uptr)(shm3w+LDS_BYTES+16);
    const float fref=Fg[q0]; const float Bq=__builtin_sqrtf(__uint_as_float(NB[0])*__uint_as_float(NB[1])); const float thr=-(152.0f+2.0f*Bq);
    if(tid==0)*cnt=0u;
    asm volatile("s_waitcnt lgkmcnt(0)\n\ts_barrier":::"memory");
    bool skip=false; if(tid<NT0-4){ skip=((fref-Fg[64*tid+63])*1.4426950408889634f<thr); }
    const unsigned long long bal=__ballot(skip); if(lane==0&&bal)__hip_atomic_fetch_add(cnt,(unsigned)__popcll(bal),__ATOMIC_RELAXED,__HIP_MEMORY_SCOPE_WORKGROUP);
    asm volatile("s_waitcnt lgkmcnt(0)\n\ts_barrier":::"memory");
    j0=(int)(*cnt)&~1; j0=__builtin_amdgcn_readfirstlane(j0);
    typedef __attribute__((address_space(3))) float* lds_fptr; const lds_fptr fbl=(lds_fptr)(shm3w+LDS_FB);
    for(int i=64*j0+tid;i<q0+QB;i+=NW*64) fbl[i]=(fref-Fg[i])*1.4426950408889634f; }
  const int NT=NT0-j0;
  const bf16*ksrc=ksrc_+(long)j0*KVBLK*KP; const bf16*vsrc=vsrc_+(long)j0*KVBLK*KP;
  DMA_K(0,0);DMA_V(0,0);DMA_K(1,SLOTB);
  bf16x8 qr[4];
  #pragma unroll
  for(int d0=0;d0<4;++d0)qr[d0]=*reinterpret_cast<const bf16x8*>(&Qw[(long)r32*QP+d0*16+hi*8]);
  float mhat=0.f,l_reg=0.f;f32x16 o[2];o[0]=f32x16{};o[1]=f32x16{};
  const lds_cptr fb0=(lds_cptr)shm3w+LDS_FB+hi*16+j0*256;
  typedef float f32x4v __attribute__((ext_vector_type(4)));
  #define BLD(P0,P1,t) do{ const lds_cptr fp_=fb0+(t)*256; _Pragma("unroll") for(int j_=0;j_<4;++j_){ \
      const f32x4v a_=*(const __attribute__((address_space(3))) f32x4v*)(fp_+j_*32), b_=*(const __attribute__((address_space(3))) f32x4v*)(fp_+128+j_*32); \
      P0[4*j_]=a_[0];P0[4*j_+1]=a_[1];P0[4*j_+2]=a_[2];P0[4*j_+3]=a_[3]; P1[4*j_]=b_[0];P1[4*j_+1]=b_[1];P1[4*j_+2]=b_[2];P1[4*j_+3]=b_[3]; } }while(0)
  const int qrel=wid*QBLK+r32;
  #define CMASK(P0,P1,t) do{int jb_=(t)-(NT-4); if(jb_>=0)cmask(P0,P1,jb_,qrel,hi);}while(0)
  bool resc=false;
  #define START(P0,P1) do{ const float rm=rowmax(P0,P1); resc=false; mhat=rm; \
    _Pragma("unroll") for(int r=0;r<16;++r)P0[r]=__builtin_amdgcn_exp2f(P0[r]-mhat); }while(0)
  #define RESC() do{ if(resc){ asm volatile("s_waitcnt lgkmcnt(0)":::"memory"); \
      _Pragma("unroll") for(int d_=0;d_<2;++d_) _Pragma("unroll") for(int r=0;r<16;++r)o[d_][r]*=wsf[crow(r,hi)]; } }while(0)
  f32x16 pA0,pA1,pB0,pB1;
  int sl_prev=0,sl_cur=0,sl_next=SLOTB;
  #define ROT() do{sl_prev=sl_cur;sl_cur=sl_next;sl_next=(sl_next==(NSLOT-1)*SLOTB)?0:sl_next+SLOTB;}while(0)
  DMA_K(2,2*SLOTB);
  WAIT_BAR(3);
  BLD(pA0,pA1,0);
  qkt(pA0,pA1,Kbase,qr,r32,hi);asm volatile("s_nop 15\n\ts_nop 7":"+v"(pA0),"+v"(pA1));CMASK(pA0,pA1,0);
  START(pA0,pA1);
  _Pragma("unroll") for(int r=0;r<16;++r)pA1[r]=__builtin_amdgcn_exp2f(pA1[r]-mhat);
  WAIT_BAR(0);
  DMA_K(3,0);DMA_V(1,SLOTB);
  ROT();
  kload8(kf,kp0+sl_cur);
  BLD(pB0,pB1,1);
  WAIT_BAR(2);
  s16x4 vlo[8],vhi[8]; u32x4 pw0,pw1,pw2,pw3;
  #define PKW(P,B) cvtpk_s(P[B],P[B+1])
  #define PAF(k) __builtin_bit_cast(bf16x8,pw##k)
  #define VFR(i) (bf16x8){vlo[i][0],vlo[i][1],vlo[i][2],vlo[i][3],vhi[i][0],vhi[i][1],vhi[i][2],vhi[i][3]}
  #define PIN(x) asm volatile("":"+v"(x))
  #define MX3(a,b,c) __builtin_fmaxf(__builtin_fmaxf((a),(b)),(c))
  #define GAPA(MF,A0,A1,A2,A3,W0,W1,PW) do{ MF; sacc+=A0; sacc+=A1; sacc+=A2; sacc+=A3; PIN(sacc); W0; W1; PIN(PW); SBAR(); }while(0)
  #define EX(v) __builtin_amdgcn_exp2f(v)
  #define GAPB(MF,X,B) do{ MF; X[B]=EX(X[B]-mhat); X[B+1]=EX(X[B+1]-mhat); X[B+2]=EX(X[B+2]-mhat); X[B+3]=EX(X[B+3]-mhat); PIN(X); SBAR(); }while(0)
  #define VRD(i) do{ vlo[i]=vtr(vp_+(((i)>>2)*4096+((i)&3)*1024)); vhi[i]=vtr(vp_+(((i)>>2)*4096+((i)&3)*1024+512)); }while(0)
  #define KRD(G,j) do{ if(G){ kload2(kf,kp0+sl_next,j); SBAR(); } }while(0)
  #define STEP(C0,C1,P0,P1,t,GK,GV,GL) do{ SBAR(); \
    const lds_cptr vp_=vp0+sl_prev; \
    VRD(0); SBAR(); float sacc=(P0[0]+P0[1]); \
    GAPA(C0=__builtin_amdgcn_mfma_f32_32x32x16_bf16(kf[0],qr[0],C0,0,0,0), P0[2],P0[3],P0[4],P0[5],     pw0[0]=PKW(P0,0), pw0[1]=PKW(P0,2), pw0); \
    VRD(4); SBAR(); GAPA(C1=__builtin_amdgcn_mfma_f32_32x32x16_bf16(kf[1],qr[0],C1,0,0,0), P0[6],P0[7],P0[8],P0[9],     pw0[2]=PKW(P0,4), pw0[3]=PKW(P0,6), pw0); \
    VRD(1); SBAR(); GAPA(C0=__builtin_amdgcn_mfma_f32_32x32x16_bf16(kf[2],qr[1],C0,0,0,0),   P0[10],P0[11],P0[12],P0[13], pw1[0]=PKW(P0,8), pw1[1]=PKW(P0,10), pw1); \
    VRD(5); SBAR(); GAPA(C1=__builtin_amdgcn_mfma_f32_32x32x16_bf16(kf[3],qr[1],C1,0,0,0),   P0[14],P0[15],P1[0],P1[1],   pw1[2]=PKW(P0,12),pw1[3]=PKW(P0,14), pw1); \
    VRD(2); SBAR(); GAPA(C0=__builtin_amdgcn_mfma_f32_32x32x16_bf16(kf[4],qr[2],C0,0,0,0),   P1[2],P1[3],P1[4],P1[5],     pw2[0]=PKW(P1,0), pw2[1]=PKW(P1,2), pw2); \
    VRD(6); SBAR(); GAPA(C1=__builtin_amdgcn_mfma_f32_32x32x16_bf16(kf[5],qr[2],C1,0,0,0),   P1[6],P1[7],P1[8],P1[9],     pw2[2]=PKW(P1,4), pw2[3]=PKW(P1,6), pw2); \
    VRD(3); SBAR(); GAPA(C0=__builtin_amdgcn_mfma_f32_32x32x16_bf16(kf[6],qr[3],C0,0,0,0),   P1[10],P1[11],P1[12],P1[13], pw3[0]=PKW(P1,8), pw3[1]=PKW(P1,10), pw3); \
    VRD(7); SBAR(); GAPA(C1=__builtin_amdgcn_mfma_f32_32x32x16_bf16(kf[7],qr[3],C1,0,0,0),   P1[14],P1[15],0.f,0.f,       pw3[2]=PKW(P1,12),pw3[3]=PKW(P1,14), pw3); \
    l_reg+=sacc; \
    if(GK){DMA_K((t)+3,sl_cur);} if(GV){DMA_V((t)+1,sl_next);} \
    CMASK(C0,C1,t); \
    { float a=MX3(C0[0],C0[1],C1[0]),b=MX3(C0[2],C0[3],C1[1]); a=MX3(a,C1[2],C1[3]); \
      _Pragma("unroll") for(int r=4;r<16;r+=4){a=MX3(a,C0[r],C0[r+1]);b=MX3(b,C0[r+2],C0[r+3]);a=MX3(a,C1[r],C1[r+1]);b=MX3(b,C1[r+2],C1[r+3]);} \
      float rm=__builtin_fmaxf(a,b); { auto rr=__builtin_amdgcn_permlane32_swap(__float_as_uint(rm),__float_as_uint(rm),false,false); rm=__builtin_fmaxf(__uint_as_float(rr[0]),__uint_as_float(rr[1])); } \
      rm-=mhat; resc=false; \
      if(__builtin_expect(__any(rm>(float)THRL),0)){ const float dl=__builtin_fmaxf(rm,0.f); mhat+=dl; \
        const float f=__builtin_amdgcn_exp2f(-dl); l_reg*=f; if(hi==0)wsf[r32]=f; resc=true; } } \
    SBAR(); if(GL){ BLD(P0,P1,(t)+1); } \
    SBAR(); \
    GAPB(o[0]=__builtin_amdgcn_mfma_f32_32x32x16_bf16(PAF(0),VFR(0),o[0],0,0,0), C0,0); \
    GAPB(o[1]=__builtin_amdgcn_mfma_f32_32x32x16_bf16(PAF(0),VFR(4),o[1],0,0,0), C0,4); \
    KRD(GL,0); GAPB(o[0]=__builtin_amdgcn_mfma_f32_32x32x16_bf16(PAF(1),VFR(1),o[0],0,0,0), C0,8); \
    KRD(GL,1); GAPB(o[1]=__builtin_amdgcn_mfma_f32_32x32x16_bf16(PAF(1),VFR(5),o[1],0,0,0), C0,12); \
    KRD(GL,2); GAPB(o[0]=__builtin_amdgcn_mfma_f32_32x32x16_bf16(PAF(2),VFR(2),o[0],0,0,0), C1,0); \
    KRD(GL,3); GAPB(o[1]=__builtin_amdgcn_mfma_f32_32x32x16_bf16(PAF(2),VFR(6),o[1],0,0,0), C1,4); \
    GAPB(o[0]=__builtin_amdgcn_mfma_f32_32x32x16_bf16(PAF(3),VFR(3),o[0],0,0,0), C1,8); \
    GAPB(o[1]=__builtin_amdgcn_mfma_f32_32x32x16_bf16(PAF(3),VFR(7),o[1],0,0,0), C1,12); \
    }while(0)
  int t=1;
  #undef CMASK
  #define CMASK(P0,P1,t) do{}while(0)
  for(;t+5<NT;t+=2){
    STEP(pB0,pB1,pA0,pA1,t,true,true,true);     WAIT_BAR(2); RESC(); ROT();
    STEP(pA0,pA1,pB0,pB1,t+1,true,true,true);   WAIT_BAR(2); RESC(); ROT();
  }
  #undef CMASK
  #define CMASK(P0,P1,t) do{int jb_=(t)-(NT-4); if(jb_>=0)cmask(P0,P1,jb_,qrel,hi);}while(0)
  #define ENDW(tt) do{ if((tt)+3<NT){WAIT_BAR(2);} else if((tt)+2<NT){WAIT_BAR(1);} else {WAIT_BAR(0);} }while(0)
  for(;t+1<NT;t+=2){
    STEP(pB0,pB1,pA0,pA1,t,(t+3<NT),(t+1<NT),(t+1<NT));       ENDW(t);   RESC(); ROT();
    STEP(pA0,pA1,pB0,pB1,t+1,(t+4<NT),(t+2<NT),(t+2<NT));     ENDW(t+1); RESC(); ROT();
  }
  STEP(pB0,pB1,pA0,pA1,NT-1,false,false,false); RESC();
  { float sacc=pB0[0]+pB0[1]; _Pragma("unroll") for(int r=2;r<16;++r)sacc+=pB0[r]; _Pragma("unroll") for(int r=0;r<16;++r)sacc+=pB1[r]; l_reg+=sacc;
    pw0=(u32x4){PKW(pB0,0),PKW(pB0,2),PKW(pB0,4),PKW(pB0,6)};pw1=(u32x4){PKW(pB0,8),PKW(pB0,10),PKW(pB0,12),PKW(pB0,14)};pw2=(u32x4){PKW(pB1,0),PKW(pB1,2),PKW(pB1,4),PKW(pB1,6)};pw3=(u32x4){PKW(pB1,8),PKW(pB1,10),PKW(pB1,12),PKW(pB1,14)};
    SBAR(); pv(o,vb0+sl_cur,PAF(0),PAF(1),PAF(2),PAF(3)); }
  #undef PKW
  #undef PAF
  #undef VFR
  #undef PIN
  #undef MX3
  #undef GAPA
  #undef GAPB
  #undef EX
  #undef VRD
  #undef KRD
  #undef STEP
  #undef ENDW
  {auto rr=__builtin_amdgcn_permlane32_swap(__float_as_uint(l_reg),__float_as_uint(l_reg),false,false);l_reg=__uint_as_float(rr[0])+__uint_as_float(rr[1]);}
  if(hi==0)wsf[32+r32]=l_reg;asm volatile("s_waitcnt lgkmcnt(0)":::"memory");
  float rli[16];
  #pragma unroll
  for(int r=0;r<16;++r)rli[r]=__builtin_amdgcn_rcpf(wsf[32+crow(r,hi)]);
  bf16*Ow=O+(rowbase+q0+wid*QBLK)*QP+h*D;
  { bf16*stg=(bf16*)(shm+LDS_OST)+wid*2048;
    #pragma unroll
    for(int r=0;r<16;++r){const int orow=crow(r,hi);
      #pragma unroll
      for(int d0=0;d0<2;++d0)stg[orow*64+d0*32+r32]=__float2bfloat16(o[d0][r]*rli[r]);}
    asm volatile("s_waitcnt lgkmcnt(0)":::"memory");
    #pragma unroll
    for(int i=0;i<4;++i){const int row=i*8+(lane>>3),ch=lane&7; const u32x4 v=*(const u32x4*)(stg+row*64+ch*8); ATTN_STORE16(Ow+(long)row*QP+ch*8,v);} }
  asm volatile("s_waitcnt lgkmcnt(0)\n\ts_barrier":::"memory");
  #undef DMA_K
  #undef DMA_V
  #undef CMASK
  #undef START
  #undef RESC
  #undef BLD
  #undef ROT
}
constexpr int ATTN_LDS_BYTES=LDS_BYTES;
struct AttnTensors { const bf16* Q; const bf16* K; const bf16* V; bf16* O; const float* F; const unsigned* NB; };
struct AttnUnit { int bh; int qb; };
struct DynOrder {
  unsigned* ctr; volatile __attribute__((address_space(3))) unsigned* slot;
  __device__ __forceinline__ bool next(int,AttnUnit&u)const{
    if(threadIdx.x==0)*slot=__hip_atomic_fetch_add(ctr,1u,__ATOMIC_RELAXED,__HIP_MEMORY_SCOPE_AGENT);
    asm volatile("s_waitcnt vmcnt(0) lgkmcnt(0)\n\ts_barrier":::"memory");
    const unsigned n=*slot; if(n>=1024u)return false; u.qb=63-(int)(n>>4); u.bh=(int)(n&15u); return true; }
  __device__ __forceinline__ void a_ready(const AttnUnit&)const{}
  __device__ __forceinline__ void done(const AttnUnit&)const{}
};
template<class Sched,int THRL=8> __device__ __forceinline__ void attn_phase(char*lds,const AttnTensors&T,const Sched&S){
  AttnUnit u;
  for(int i=0;S.next(i,u);++i){ S.a_ready(u); attn_unit<THRL>(u.bh/NHEAD,u.bh%NHEAD,u.qb,T.Q,T.K,T.V,T.O,T.F+(long)u.bh*SEQ,T.NB+2*u.bh,lds); S.done(u); }
}
#undef SBAR
#undef WAIT_BAR
}
#include <hip/hip_cooperative_groups.h>
namespace cg = cooperative_groups;
#define LAS __attribute__((address_space(3)))
typedef unsigned short bf16;
typedef unsigned v4u __attribute__((ext_vector_type(4)));
typedef float f32x4 __attribute__((ext_vector_type(4)));
typedef short bf16x8 __attribute__((ext_vector_type(8)));
typedef LAS unsigned char* lp;

#define XB_TMO      128
#define XB_XCNT(j)  (256  + 64 * (j))
#define XB_XSUB(j)  (1280 + 64 * (j))
#define XB_XGEN(j)  (2304 + 64 * (j))
#define XB_TOP      3328
#define XB_TOPGEN   3392
#define XCD_BAR_WORDS 3456
#define XB_SPIN_CAP (1u << 18)

__device__ __forceinline__ unsigned xb_ld(unsigned* p)              { return __hip_atomic_load(p, __ATOMIC_RELAXED, __HIP_MEMORY_SCOPE_AGENT); }
__device__ __forceinline__ unsigned xb_add(unsigned* p, unsigned v) { return __hip_atomic_fetch_add(p, v, __ATOMIC_RELAXED, __HIP_MEMORY_SCOPE_AGENT); }
__device__ __forceinline__ unsigned xb_xcc_id() { return (unsigned)__builtin_amdgcn_s_getreg((3 << 11) | 20) & 0xFu; }
#define XB_SPIN(cond, bar) do { unsigned _sp = 0; while (cond) { __builtin_amdgcn_s_sleep(1); \
    if ((++_sp & 255u) == 0u) { if (xb_ld(&(bar)[XB_TMO])) break; if (_sp > XB_SPIN_CAP) { atomicAdd(&(bar)[XB_TMO], 1u); break; } } } } while (0)

struct XcdBarrier {
    unsigned* bar; unsigned x;
    volatile LAS unsigned* st;
};

__device__ __forceinline__ XcdBarrier xcd_barrier_post(unsigned* bar, volatile LAS unsigned* st) {
    XcdBarrier b; b.bar = bar; b.x = xb_xcc_id(); b.st = st;
    if (threadIdx.x == 0) (void)xb_add(&bar[XB_XCNT(b.x)], 1u);
    return b;
}
__device__ __forceinline__ void xcd_barrier_complete(unsigned* bar, unsigned x, unsigned& nloc, unsigned& nx) {
    const unsigned G = gridDim.x * gridDim.y * gridDim.z;
    unsigned sum, cnt, mine, sp = 0u;
    for (;;) {
        sum = 0u; cnt = 0u; mine = 0u;
#pragma unroll
        for (unsigned j = 0; j < 16; ++j) { const unsigned c = xb_ld(&bar[XB_XCNT(j)]); sum += c; cnt += (c > 0u) ? 1u : 0u; mine = (j == x) ? c : mine; }
        if (sum == G) break;
        __builtin_amdgcn_s_sleep(1);
        if ((++sp & 255u) == 0u) { if (xb_ld(&bar[XB_TMO])) break; if (sp > XB_SPIN_CAP) { atomicAdd(&bar[XB_TMO], 1u); break; } }
    }
    nloc = mine > 0u ? mine : 1u; nx = cnt > 0u ? cnt : 1u;
}

__device__ __forceinline__ void xcd_barrier(const XcdBarrier& b) {
    asm volatile("s_waitcnt vmcnt(0)" ::: "memory");
    __syncthreads();
    if (threadIdx.x == 0) {
        unsigned* bar = b.bar;
        __builtin_amdgcn_s_waitcnt(0);
        unsigned nloc = b.st[0], nx = b.st[1];
        if (nloc == 0u) { xcd_barrier_complete(bar, b.x, nloc, nx); b.st[0] = nloc; b.st[1] = nx; }
        const unsigned old = xb_add(&bar[XB_XSUB(b.x)], 1u);
        const unsigned gen = old / nloc;
        if (old + 1u == (gen + 1u) * nloc) {
            __builtin_amdgcn_fence(__ATOMIC_RELEASE, "agent");
            asm volatile("s_waitcnt vmcnt(0)" ::: "memory");
            const unsigned og = xb_add(&bar[XB_TOP], 1u);
            const unsigned tg = og / nx;
            if (og + 1u == (tg + 1u) * nx) xb_add(&bar[XB_TOPGEN], 1u);
            else XB_SPIN(xb_ld(&bar[XB_TOPGEN]) == tg, bar);
            __builtin_amdgcn_fence(__ATOMIC_ACQUIRE, "agent");
            xb_add(&bar[XB_XGEN(b.x)], 1u);
            asm volatile("s_waitcnt vmcnt(0)" ::: "memory");
        } else {
            XB_SPIN(xb_ld(&bar[XB_XGEN(b.x)]) == gen, bar);
            __builtin_amdgcn_fence(__ATOMIC_ACQUIRE, "agent");
            asm volatile("s_waitcnt vmcnt(0)" ::: "memory");
        }
    }
    __syncthreads();
}


constexpr int NWAVES = 8, NTHR = 512;
constexpr int BATCH = 2, SEQ = 16384, D = 1024, M = BATCH * SEQ, DEPTH = 2;
constexpr int NIN = 5640, NP1 = 3584, NG = 2048, FFH = 2816, NF1 = 5632;
constexpr float ALPHA = 1.4142135623730951f;
constexpr float LN_EPS = 1e-5f, RMS_EPS = 1e-6f;
constexpr size_t MiB = 1u << 20;
constexpr size_t WL_IN = 0, WL_G = 7 * MiB, WL_M = 11 * MiB, WL_O = 15 * MiB, WL_F1 = 17 * MiB, WL_F2 = 28 * MiB, WL_STRIDE = 34 * MiB;
constexpr size_t WS_W = 0, WS_XN = 68 * MiB, WS_QA = 132 * MiB, WS_QB = 164 * MiB, WS_KA = 196 * MiB, WS_VA = 228 * MiB, WS_G = 260 * MiB, WS_IB = 324 * MiB, WS_GB = 356 * MiB,
                 WS_ST = 388 * MiB, WS_DEC = 452 * MiB, WS_LF = 453 * MiB, WS_F = 454 * MiB, WS_CTL = 455 * MiB  , WS_DBG = 455 * MiB + 512 * 1024, WS_END = 456 * MiB;
constexpr size_t WS_GATES = WS_G  , WS_MERGED = WS_KA  , WS_H = WS_QA  ;
constexpr size_t CTL_QCTR = 16384  , CTL_PCTR = 18432  , CTL_STATS = 131072  , CTL_NORM = 20480  ;
constexpr int LDS_TOTAL = 155648;
static_assert(attn_body::LDS_BYTES <= LDS_TOTAL && pg8::STAGE_BYTES <= LDS_TOTAL, "LDS map");

__device__ __forceinline__ float wave_sum(float v) {
#pragma unroll
    for (int o = 1; o < 64; o <<= 1) v += __shfl_xor(v, o);
    return v;
}
__device__ __forceinline__ unsigned pk2(float lo, float hi) { return pg8::cvt_pk_bf16(lo, hi); }
__device__ __forceinline__ float bf2f(unsigned short h) { return __uint_as_float((unsigned)h << 16); }

__device__ __forceinline__ void transpose_item(const float* Wsrc, int pitch, bf16* WTdst, int Kdst, LAS float* scr, int lane, bool zero) {
    if (!zero) {
#pragma unroll 8
        for (int i = 0; i < 32; ++i) { const int kk = 2 * i + (lane >> 5); scr[kk * 33 + (lane & 31)] = Wsrc[(size_t)kk * pitch + (lane & 31)]; }
    }
    asm volatile("s_waitcnt lgkmcnt(0)" ::: "memory");
    const int c = lane & 7;
#pragma unroll
    for (int j = 0; j < 4; ++j) { const int n = (lane >> 3) + 8 * j; const LAS float* s = scr + (8 * c) * 33 + n;
        v4u o;
        if (zero) { o = (v4u){0u, 0u, 0u, 0u}; }
        else { o.x = pk2(s[0 * 33], s[1 * 33]); o.y = pk2(s[2 * 33], s[3 * 33]); o.z = pk2(s[4 * 33], s[5 * 33]); o.w = pk2(s[6 * 33], s[7 * 33]); }
        *(v4u*)(WTdst + (size_t)n * Kdst + 8 * c) = o; }
    asm volatile("s_waitcnt lgkmcnt(0)" ::: "memory");
}

struct Ptrs {
    const float *x, *w_in, *b_fgate, *lb_logits, *norm_g, *w_pa, *w_pb, *w_o, *ln1_g, *ln1_b, *w_ff_in, *w_ff_out, *ln2_g, *ln2_b;
    float* out; unsigned char* ws;
};

__device__ __forceinline__ void weight_items(const Ptrs& P, LAS float* scr, int gw, int NGW, int lane) {
    constexpr int I_IN = 16 * (NP1 / 32), I_G = 16 * (NG / 32), I_M = 2 * 8 * 32, I_O = 16 * 32, I_F1 = 16 * (NF1 / 32), I_F2 = (FFH / 64) * 32;
    constexpr int PER_LAYER = I_IN + I_G + I_M + I_O + I_F1 + I_F2;
    for (int it = gw; it < DEPTH * PER_LAYER; it += NGW) {
        const int l = it / PER_LAYER; int r = it % PER_LAYER;
        bf16* WB = (bf16*)(P.ws + WS_W + (size_t)l * WL_STRIDE);
        if (r < I_IN) { const int nblk = NP1 / 32, kb = r / nblk, nb = r % nblk, k0 = 64 * kb, n0 = 32 * nb; const int sc = n0 < 1536 ? n0 : n0 + 8;
            transpose_item(P.w_in + (size_t)l * D * NIN + (size_t)k0 * NIN + sc, NIN, (bf16*)((unsigned char*)WB + WL_IN) + (size_t)n0 * 1024 + k0, 1024, scr, lane, false); continue; } r -= I_IN;
        if (r < I_G) { const int nblk = NG / 32, kb = r / nblk, nb = r % nblk, k0 = 64 * kb, n0 = 32 * nb;
            transpose_item(P.w_in + (size_t)l * D * NIN + (size_t)k0 * NIN + 3592 + n0, NIN, (bf16*)((unsigned char*)WB + WL_G) + (size_t)n0 * 1024 + k0, 1024, scr, lane, false); continue; } r -= I_G;
        if (r < I_M) { const int which = r >> 8, rr = r & 255, kb = rr >> 5, nb = rr & 31, k0 = 64 * kb, n0 = 32 * nb;
            const float* src = (which ? P.w_pb : P.w_pa) + (size_t)l * 512 * 1024 + (size_t)k0 * 1024 + n0;
            transpose_item(src, 1024, (bf16*)((unsigned char*)WB + WL_M + (size_t)which * MiB) + (size_t)n0 * 512 + k0, 512, scr, lane, false); continue; } r -= I_M;
        if (r < I_O) { const int nblk = 32, kb = r / nblk, nb = r % nblk, k0 = 64 * kb, n0 = 32 * nb;
            transpose_item(P.w_o + (size_t)l * 1024 * 1024 + (size_t)k0 * 1024 + n0, 1024, (bf16*)((unsigned char*)WB + WL_O) + (size_t)n0 * 1024 + k0, 1024, scr, lane, false); continue; } r -= I_O;
        if (r < I_F1) { const int nblk = NF1 / 32, kb = r / nblk, nb = r % nblk, k0 = 64 * kb, n0 = 32 * nb; const int tile = n0 >> 8, half = (n0 >> 7) & 1, col = half * FFH + 128 * tile + (n0 & 127);
            transpose_item(P.w_ff_in + (size_t)l * D * NF1 + (size_t)k0 * NF1 + col, NF1, (bf16*)((unsigned char*)WB + WL_F1) + (size_t)n0 * 1024 + k0, 1024, scr, lane, false); continue; } r -= I_F1;
        { const int nblk = 32, kb = r / nblk, nb = r % nblk, k0 = 64 * kb, n0 = 32 * nb;
            transpose_item(P.w_ff_out + (size_t)l * FFH * 1024 + (size_t)k0 * 1024 + n0, 1024, (bf16*)((unsigned char*)WB + WL_F2) + (size_t)n0 * FFH + k0, FFH, scr, lane, false); }
    }
}

__device__ __forceinline__ void stage_wfa(const float* w_in_l, LAS float* wfa, int tid) {
    for (int idx = tid; idx < 8192; idx += NTHR) { const int k = idx >> 3, col = idx & 7; const int j = k >> 8, ln = (k >> 2) & 63, i = k & 3, half = col >> 2, c = col & 3;
        wfa[((((j * 4 + i) * 2 + half) * 64) + ln) * 4 + c] = w_in_l[(size_t)k * NIN + 1536 + col]; }
}
template <bool DO_LN, bool W32, bool WBF, bool DO_FA>
__device__ __forceinline__ void row_pass(const float* src, float* dst32, bf16* dstbf, const float* gam, const float* bet, float* lf, const LAS float* wfa, const float* bfg, int gw, int NGW, int lane, float* stats = nullptr) {
    constexpr int R = 4;
    f32x4 gv[4], bv[4];
    if (DO_LN) {
#pragma unroll
        for (int j = 0; j < 4; ++j) { gv[j] = ((const f32x4*)gam)[64 * j + lane]; bv[j] = ((const f32x4*)bet)[64 * j + lane]; }
    }
    for (int m0 = gw; m0 < M; m0 += R * NGW) {
        f32x4 v[R][4]; int mr[R]; bool ok[R];
#pragma unroll
        for (int r = 0; r < R; ++r) { const int m = m0 + r * NGW; ok[r] = m < M; mr[r] = ok[r] ? m : m0; const f32x4* xr = (const f32x4*)(src + (size_t)mr[r] * D) + lane;
#pragma unroll
            for (int j = 0; j < 4; ++j) v[r][j] = xr[64 * j]; }
        if (DO_LN) {
            float s[R], s2[R], mean[R], rstd[R];
#pragma unroll
            for (int r = 0; r < R; ++r) { s[r] = 0.f;
#pragma unroll
                for (int j = 0; j < 4; ++j) s[r] += (v[r][j].x + v[r][j].y) + (v[r][j].z + v[r][j].w); }
#pragma unroll
            for (int o = 1; o < 64; o <<= 1)
#pragma unroll
                for (int r = 0; r < R; ++r) s[r] += __shfl_xor(s[r], o);
#pragma unroll
            for (int r = 0; r < R; ++r) { mean[r] = s[r] * (1.f / D); s2[r] = 0.f;
#pragma unroll
                for (int j = 0; j < 4; ++j) { v[r][j] = v[r][j] - mean[r]; s2[r] += (v[r][j].x * v[r][j].x + v[r][j].y * v[r][j].y) + (v[r][j].z * v[r][j].z + v[r][j].w * v[r][j].w); } }
#pragma unroll
            for (int o = 1; o < 64; o <<= 1)
#pragma unroll
                for (int r = 0; r < R; ++r) s2[r] += __shfl_xor(s2[r], o);
#pragma unroll
            for (int r = 0; r < R; ++r) { rstd[r] = 1.f / sqrtf(s2[r] * (1.f / D) + LN_EPS);
                if (stats && lane == 0 && ok[r]) { stats[2 * (size_t)mr[r]] = mean[r]; stats[2 * (size_t)mr[r] + 1] = rstd[r]; }
#pragma unroll
                for (int j = 0; j < 4; ++j) v[r][j] = v[r][j] * rstd[r] * gv[j] + bv[j]; }
        }
#pragma unroll
        for (int r = 0; r < R; ++r) { if (!ok[r]) continue; const int m = mr[r];
            if (W32) { f32x4* o = (f32x4*)(dst32 + (size_t)m * D) + lane;
#pragma unroll
                for (int j = 0; j < 4; ++j) o[64 * j] = v[r][j]; }
            if (WBF) { unsigned long long* o8 = (unsigned long long*)(dstbf + (size_t)m * D) + lane;
#pragma unroll
                for (int j = 0; j < 4; ++j) o8[64 * j] = (unsigned long long)pk2(v[r][j].x, v[r][j].y) | ((unsigned long long)pk2(v[r][j].z, v[r][j].w) << 32); } }
        if (DO_FA) {
            float a[R][8];
#pragma unroll
            for (int r = 0; r < R; ++r)
#pragma unroll
                for (int c = 0; c < 8; ++c) a[r][c] = 0.f;
#pragma unroll
            for (int j = 0; j < 4; ++j)
#pragma unroll
                for (int i = 0; i < 4; ++i) {
                    const f32x4 w0 = *(const LAS f32x4*)(wfa + ((((j * 4 + i) * 2 + 0) * 64) + lane) * 4), w1 = *(const LAS f32x4*)(wfa + ((((j * 4 + i) * 2 + 1) * 64) + lane) * 4);
#pragma unroll
                    for (int r = 0; r < R; ++r) { const float xv = v[r][j][i];
                        a[r][0] += xv * w0.x; a[r][1] += xv * w0.y; a[r][2] += xv * w0.z; a[r][3] += xv * w0.w; a[r][4] += xv * w1.x; a[r][5] += xv * w1.y; a[r][6] += xv * w1.z; a[r][7] += xv * w1.w; } }
#pragma unroll
            for (int o = 1; o < 64; o <<= 1)
#pragma unroll
                for (int r = 0; r < R; ++r)
#pragma unroll
                    for (int c = 0; c < 8; ++c) a[r][c] += __shfl_xor(a[r][c], o);
#pragma unroll
            for (int r = 0; r < R; ++r) { float z = a[r][0];
#pragma unroll
                for (int c = 1; c < 8; ++c) z = (lane == c) ? a[r][c] : z;
                if (lane < 8 && ok[r]) { z += bfg[lane]; const float ls = fminf(z, 0.f) - __logf(1.0f + __expf(-fabsf(z))); lf[(size_t)mr[r] * 8 + lane] = ls; } }
        }
    }
}

__device__ __forceinline__ void fcumsum_unit(int bh, const float* LF, float* F, lp lds, int tid) {
    const int b = bh >> 3, h = bh & 7, lane = tid & 63, wave = tid >> 6;
    const float* src = LF + ((size_t)b * SEQ + (size_t)tid * 32) * 8 + h;
    float cs[32]; float run = 0.f;
#pragma unroll
    for (int i = 0; i < 32; ++i) { run += src[i * 8]; cs[i] = run; }
    float inc = run;
#pragma unroll
    for (int o = 1; o < 64; o <<= 1) { const float n = __shfl_up(inc, o); if (lane >= o) inc += n; }
    LAS float* WS = (LAS float*)lds;
    if (lane == 63) WS[wave] = inc;
    __syncthreads();
    float woff = 0.f;
    for (int w = 0; w < wave; ++w) woff += WS[w];
    const float excl = woff + inc - run;
    float* dst = F + (size_t)bh * SEQ + (size_t)tid * 32;
#pragma unroll
    for (int i = 0; i < 32; i += 4) *(f32x4*)(dst + i) = (f32x4){excl + cs[i], excl + cs[i + 1], excl + cs[i + 2], excl + cs[i + 3]};
    __syncthreads();
}

__device__ __forceinline__ void norm_unit(int v, const bf16* QA, const bf16* KA, unsigned* NB, int tid) {
    const int bh = v >> 4, seg = v & 15, b = bh >> 3, h = bh & 7, lane = tid & 63;
    float mq = 0.f, mk = 0.f;
#pragma unroll
    for (int e = 0; e < 2; ++e) { const size_t row = (size_t)b * SEQ + seg * 1024 + tid * 2 + e;
        const v4u* qp = (const v4u*)(QA + row * 512 + h * 64); const v4u* kp = (const v4u*)(KA + row * 512 + h * 64); float sq = 0.f, sk = 0.f;
#pragma unroll
        for (int i = 0; i < 8; ++i) { const v4u a = qp[i], c = kp[i];
#pragma unroll
            for (int k = 0; k < 4; ++k) { const float a0 = __uint_as_float(a[k] << 16), a1 = __uint_as_float(a[k] & 0xffff0000u), c0 = __uint_as_float(c[k] << 16), c1 = __uint_as_float(c[k] & 0xffff0000u);
                sq += a0 * a0 + a1 * a1; sk += c0 * c0 + c1 * c1; } }
        mq = fmaxf(mq, sq); mk = fmaxf(mk, sk); }
#pragma unroll
    for (int o = 1; o < 64; o <<= 1) { mq = fmaxf(mq, __shfl_xor(mq, o)); mk = fmaxf(mk, __shfl_xor(mk, o)); }
    if (lane == 0) { atomicMax(NB + 2 * bh, __float_as_uint(mq * 1.01f)); atomicMax(NB + 2 * bh + 1, __float_as_uint(mk * 1.01f)); }
}

namespace hg {
constexpr int P128 = 136, P64 = 72;
constexpr int O_QP = 0, O_QPP = O_QP + 64 * P128 * 2, O_KP = O_QPP + 64 * P128 * 2, O_VT = O_KP + 64 * P128 * 2, O_ST = O_VT + 128 * P64 * 2, O_PM = O_ST + 128 * P128 * 2,
              O_PT = O_PM + 64 * P64 * 2, O_RS = O_PT + 2048, O_END = O_RS + 512;
constexpr int O_KDT = O_QP;
static_assert(O_END <= 131072 && 128 * P64 * 2 <= 2 * 64 * P128 * 2, "hgrn LDS map");

__device__ __forceinline__ void load_cumsum(const float* Gu, int d, int part, lp lds, float (&g)[16], float (&b)[16], float& bmid, float& blast) {
#pragma unroll
    for (int i = 0; i < 16; ++i) g[i] = Gu[(size_t)(part * 16 + i) * 512 + d];
    float run = 0.f;
#pragma unroll
    for (int i = 0; i < 16; ++i) { run += g[i]; b[i] = run; }
    LAS float* PT = (LAS float*)(lds + O_PT);
    PT[part * 128 + d] = run;
    __syncthreads();
    const float p0 = PT[d], p1 = PT[128 + d], p2 = PT[256 + d], p3 = PT[384 + d];
    const float off = (part > 0 ? p0 : 0.f) + (part > 1 ? p1 : 0.f) + (part > 2 ? p2 : 0.f);
#pragma unroll
    for (int i = 0; i < 16; ++i) b[i] += off;
    bmid = p0 + p1; blast = (p0 + p1) + (p2 + p3);
}
__device__ __forceinline__ void stage_vt(const bf16* vp  , lp lds, int e, int part) {
    unsigned w[8];
#pragma unroll
    for (int i = 0; i < 8; ++i) { const unsigned lo = vp[(size_t)(2 * i) * 512], hi = vp[(size_t)(2 * i + 1) * 512]; w[i] = lo | (hi << 16); }
    LAS v4u* dst = (LAS v4u*)(lds + O_VT + (e * P64 + part * 16) * 2);
    dst[0] = (v4u){w[0], w[1], w[2], w[3]}; dst[1] = (v4u){w[4], w[5], w[6], w[7]};
}
__device__ __forceinline__ void pass1_unit(int unit, const float* G, const bf16* IB, bf16* ST, float* DEC, lp lds, int tid, unsigned* dbgw = nullptr) {
    const int c = unit & 255, h = (unit >> 8) & 3, b = unit >> 10;
    const int d = tid & 127, part = tid >> 7, lane = tid & 63, wave = tid >> 6, fr = lane & 15, fq = lane >> 4;
    const size_t row0 = (size_t)b * SEQ + (size_t)c * 64;
    float g[16], bb[16], bmid, blast;
    load_cumsum(G + row0 * 512 + h * 128, d, part, lds, g, bb, bmid, blast);
#ifdef DBG_P1
    { bool b1 = false, b3 = false; for (int i = 0; i < 16; ++i) { if (g[i] > 0.f) b1 = true; const float kk = (1.0f - __expf(g[i])) * __expf(blast - bb[i]); if (!(fabsf(kk) < 1e30f)) b3 = true; }
      if (b1) atomicMin(dbgw, 51u); if (b3) atomicMin(dbgw, 53u); }
#endif
    { unsigned w[8];
#pragma unroll
      for (int i = 0; i < 8; ++i) { const float k0 = (1.0f - __expf(g[2 * i])) * __expf(blast - bb[2 * i]), k1 = (1.0f - __expf(g[2 * i + 1])) * __expf(blast - bb[2 * i + 1]); w[i] = pk2(k0, k1); }
      LAS v4u* dst = (LAS v4u*)(lds + O_KDT + (d * P64 + part * 16) * 2);
      dst[0] = (v4u){w[0], w[1], w[2], w[3]}; dst[1] = (v4u){w[4], w[5], w[6], w[7]}; }
    stage_vt(IB + (row0 + part * 16) * 512 + h * 128 + d, lds, d, part);
    if (part == 0) DEC[(size_t)unit * 128 + d] = __expf(blast);
    __syncthreads();
    const bf16x8 a0 = *(const LAS bf16x8*)(lds + O_VT + ((16 * wave + fr) * P64 + 8 * fq) * 2), a1 = *(const LAS bf16x8*)(lds + O_VT + ((16 * wave + fr) * P64 + 32 + 8 * fq) * 2);
    bf16* out = ST + (size_t)unit * 16384;
#pragma unroll
    for (int dt = 0; dt < 8; ++dt) {
        const bf16x8 b0 = *(const LAS bf16x8*)(lds + O_KDT + ((16 * dt + fr) * P64 + 8 * fq) * 2), b1 = *(const LAS bf16x8*)(lds + O_KDT + ((16 * dt + fr) * P64 + 32 + 8 * fq) * 2);
        f32x4 acc = (f32x4){0.f, 0.f, 0.f, 0.f};
        acc = __builtin_amdgcn_mfma_f32_16x16x32_bf16(a0, b0, acc, 0, 0, 0);
        acc = __builtin_amdgcn_mfma_f32_16x16x32_bf16(a1, b1, acc, 0, 0, 0);
#ifdef DBG_P1
        for (int r = 0; r < 4; ++r) if (!(fabsf(acc[r]) < 1e30f)) atomicMin(dbgw, 54u);
#endif
#pragma unroll
        for (int r = 0; r < 4; ++r) out[(16 * wave + 4 * fq + r) * 128 + 16 * dt + fr] = (bf16)(pk2(acc[r], 0.f) & 0xffffu);
    }
    __syncthreads();
}
__device__ __forceinline__ void pass2_scan(const bf16* STin, bf16* ST, const float* DEC, int gtid, int gthreads) {
    for (int id = gtid; id < 8 * 16384; id += gthreads) {
        const int bh = id >> 14, ed = id & 16383, d = ed & 127;
        bf16* p = ST + (size_t)bh * 256 * 16384 + ed; const bf16* pi = STin + (size_t)bh * 256 * 16384 + ed; const float* dp = DEC + (size_t)bh * 256 * 128 + d;
        float state = 0.f;
        for (int c = 0; c < 256; c += 32) {
            unsigned short u[32]; float dc[32];
#pragma unroll
            for (int i = 0; i < 32; ++i) { u[i] = pi[(size_t)(c + i) * 16384]; dc[i] = dp[(size_t)(c + i) * 128]; }
#pragma unroll
            for (int i = 0; i < 32; ++i) { p[(size_t)(c + i) * 16384] = (bf16)(pk2(state, 0.f) & 0xffffu); state = dc[i] * state + bf2f(u[i]); }
        }
    }
}
__device__ __forceinline__ void pass3_unit(int unit, const float* G, const bf16* IB, const bf16* GB, const bf16* ST, const bf16* QB, bf16* YB, const float* normg, lp lds, int tid) {
    const int c = unit & 255, h = (unit >> 8) & 3, b = unit >> 10;
    const int d = tid & 127, part = tid >> 7, lane = tid & 63, wave = tid >> 6, fr = lane & 15, fq = lane >> 4;
    const size_t row0 = (size_t)b * SEQ + (size_t)c * 64;
    { const bf16* sp = ST + (size_t)unit * 16384;
#pragma unroll
      for (int ps = 0; ps < 4; ++ps) { const int idx = ps * NTHR + tid, e = idx >> 4, d8 = (idx & 15) * 8; const v4u w = *(const v4u*)(sp + e * 128 + d8); *(LAS v4u*)(lds + O_ST + (e * P128 + d8) * 2) = w; } }
    float g[16], bb[16], bmid, blast;
    load_cumsum(G + row0 * 512 + h * 128, d, part, lds, g, bb, bmid, blast);
    { const bf16* qp = QB + (row0 + part * 16) * 512 + h * 128 + d; const float emid = __expf(bmid);
      LAS bf16* Qp = (LAS bf16*)(lds + O_QP), *Qpp = (LAS bf16*)(lds + O_QPP), *Kp = (LAS bf16*)(lds + O_KP);
#pragma unroll
      for (int i = 0; i < 16; ++i) { const float q = bf2f(qp[(size_t)i * 512]); const float q1 = q * __expf(bb[i] - bmid), q2 = q1 * emid, k1 = (1.0f - __expf(g[i])) * __expf(bmid - bb[i]);
          const int t = part * 16 + i; const unsigned w = pk2(q1, q2), w2 = pk2(k1, 0.f);
          Qp[t * P128 + d] = (bf16)(w & 0xffffu); Qpp[t * P128 + d] = (bf16)(w >> 16); Kp[t * P128 + d] = (bf16)(w2 & 0xffffu); } }
    stage_vt(IB + (row0 + part * 16) * 512 + h * 128 + d, lds, d, part);
    __syncthreads();
    { const int ti = wave >> 1; LAS bf16* Pm = (LAS bf16*)(lds + O_PM);
#pragma unroll
      for (int sj2 = 0; sj2 < 2; ++sj2) { const int sj = 2 * (wave & 1) + sj2; f32x4 acc = (f32x4){0.f, 0.f, 0.f, 0.f};
#pragma unroll
          for (int ks = 0; ks < 4; ++ks) { const bf16x8 a = *(const LAS bf16x8*)(lds + O_QP + ((16 * ti + fr) * P128 + 32 * ks + 8 * fq) * 2), bq = *(const LAS bf16x8*)(lds + O_KP + ((16 * sj + fr) * P128 + 32 * ks + 8 * fq) * 2);
              acc = __builtin_amdgcn_mfma_f32_16x16x32_bf16(a, bq, acc, 0, 0, 0); }
#pragma unroll
          for (int r = 0; r < 4; ++r) { const int t = 16 * ti + 4 * fq + r, s = 16 * sj + fr; const float v = (s <= t) ? acc[r] : 0.f; Pm[t * P64 + s] = (bf16)(pk2(v, 0.f) & 0xffffu); } } }
    __syncthreads();
    const int rb = wave & 3, ch = wave >> 2;
    f32x4 o[4];
#pragma unroll
    for (int j = 0; j < 4; ++j) o[j] = (f32x4){0.f, 0.f, 0.f, 0.f};
    { bf16x8 ap[2], aq[4];
#pragma unroll
      for (int ks = 0; ks < 2; ++ks) ap[ks] = *(const LAS bf16x8*)(lds + O_PM + ((16 * rb + fr) * P64 + 32 * ks + 8 * fq) * 2);
#pragma unroll
      for (int ks = 0; ks < 4; ++ks) aq[ks] = *(const LAS bf16x8*)(lds + O_QPP + ((16 * rb + fr) * P128 + 32 * ks + 8 * fq) * 2);
#pragma unroll
      for (int j = 0; j < 4; ++j) { const int e0 = 64 * ch + 16 * j;
#pragma unroll
          for (int ks = 0; ks < 2; ++ks) { const bf16x8 bv = *(const LAS bf16x8*)(lds + O_VT + ((e0 + fr) * P64 + 32 * ks + 8 * fq) * 2); o[j] = __builtin_amdgcn_mfma_f32_16x16x32_bf16(ap[ks], bv, o[j], 0, 0, 0); }
#pragma unroll
          for (int ks = 0; ks < 4; ++ks) { const bf16x8 bs = *(const LAS bf16x8*)(lds + O_ST + ((e0 + fr) * P128 + 32 * ks + 8 * fq) * 2); o[j] = __builtin_amdgcn_mfma_f32_16x16x32_bf16(aq[ks], bs, o[j], 0, 0, 0); } } }
    LAS float* RS = (LAS float*)(lds + O_RS);
#pragma unroll
    for (int r = 0; r < 4; ++r) { float s = 0.f;
#pragma unroll
        for (int j = 0; j < 4; ++j) s += o[j][r] * o[j][r];
        s += __shfl_xor(s, 1); s += __shfl_xor(s, 2); s += __shfl_xor(s, 4); s += __shfl_xor(s, 8);
        if (fr == 0) RS[ch * 64 + 16 * rb + 4 * fq + r] = s; }
    __syncthreads();
#pragma unroll
    for (int r = 0; r < 4; ++r) { const int t = 16 * rb + 4 * fq + r; const float rstd = 1.0f / sqrtf((RS[t] + RS[64 + t]) * (1.0f / 128.0f) + RMS_EPS);
        const bf16* gbp = GB + (row0 + t) * 512 + h * 128 + 64 * ch + fr; bf16* yp = YB + (row0 + t) * 512 + h * 128 + 64 * ch + fr;
#pragma unroll
        for (int j = 0; j < 4; ++j) { const float y = o[j][r] * rstd * normg[64 * ch + 16 * j + fr] * bf2f(gbp[16 * j]); yp[16 * j] = (bf16)(pk2(y, 0.f) & 0xffffu); } }
    __syncthreads();
}
}

#ifdef DBG_NAN
__device__ __forceinline__ void dbg_scan(const void* p, size_t nbytes, bool is_bf, int stage, unsigned* word) {
    const size_t n16 = nbytes / 16; const v4u* q = (const v4u*)p; bool bad = false;
    int t_ = threadIdx.x; asm volatile("" : "+v"(t_));
    int b_ = blockIdx.x; asm volatile("" : "+s"(b_)); int g_ = gridDim.x; asm volatile("" : "+s"(g_));
    for (unsigned i = (unsigned)(b_ * NTHR + t_); i < (unsigned)n16; i += (unsigned)(g_ * NTHR)) { const v4u w = q[i];
        for (int k = 0; k < 4; ++k) { const unsigned x = w[k];
            if (is_bf) { if ((x & 0x7f80u) == 0x7f80u || (x & 0x7f800000u) == 0x7f800000u) bad = true; }
            else { if ((x & 0x7f800000u) == 0x7f800000u) bad = true; } } }
    if (bad) atomicMin(word, (unsigned)stage);
}
#define DBG(stage, ptr, bytes, isbf) do { if (l == DBG_LAYER) dbg_scan((ptr), (bytes), (isbf), (stage), (unsigned*)(args.ws + WS_DBG)); } while (0)
#else
#define DBG(stage, ptr, bytes, isbf) do {} while (0)
#endif
#define GSYNC() xcd_barrier(xbar)
#ifdef DBG_TS
#define STAMP(k) do { if (blockIdx.x == 0 && threadIdx.x == 0) ((unsigned long long*)(args.ws + WS_DBG + 4096))[(k)] = __builtin_amdgcn_s_memrealtime(); } while (0)
#else
#define STAMP(k) do {} while (0)
#endif
#ifndef REP_P1
#define REP_P1 1
#endif
#ifndef REP_P2
#define REP_P2 1
#endif
#ifndef REP_P8
#define REP_P8 1
#endif
#ifndef REP_P45
#define REP_P45 1
#endif
#ifndef REP_HG0
#define REP_HG0 0
#endif
#ifndef REP_P0
#define REP_P0 1
#endif
#ifndef REP_LN1
#define REP_LN1 0
#endif
#ifndef REP_ATT0
#define REP_ATT0 0
#endif
struct Args { const float* in[14]; float* out; unsigned char* ws; };
#define FRESH_PTR(T, var, expr) T var = (T)(expr); asm volatile("" : "+s"(var))
#define IDS() int tid_ = threadIdx.x; asm volatile("" : "+v"(tid_)); const int tid = tid_, lane = tid & 63, wave = __builtin_amdgcn_readfirstlane(tid >> 6); const int G = gridDim.x, bx = blockIdx.x, vcu = (G % 8 == 0) ? (bx % 8) * (G / 8) + bx / 8 : bx; \
              const int gw = vcu * NWAVES + wave, NGW = G * NWAVES; (void)tid; (void)lane; (void)wave; (void)gw; (void)NGW; (void)vcu; (void)bx
__global__ void __launch_bounds__(NTHR, 2) mega_fwd(Args args) {
    extern __shared__ __attribute__((aligned(16))) unsigned char lds_raw[];
    cg::grid_group grid = cg::this_grid();
    const lp lds = (lp)lds_raw;
    volatile LAS unsigned* xbst = (volatile LAS unsigned*)(lds + LDS_TOTAL - 64);
    if (threadIdx.x < 16) xbst[threadIdx.x] = 0u;
    __syncthreads();
    const XcdBarrier xbar = xcd_barrier_post((unsigned*)(args.ws + WS_CTL), xbst);
    grid.sync();
    int tsn = 1; (void)tsn; STAMP(0);

#ifdef DBG_NAN
    if (blockIdx.x == 0 && threadIdx.x == 0) *(unsigned*)(args.ws + WS_DBG) = 990u;
    GSYNC(); STAMP(tsn); ++tsn;
#endif
    for (int rep_ = 0; rep_ < REP_P0; ++rep_) { IDS();
      Ptrs P;
      P.x = args.in[0]; P.w_in = args.in[1]; P.b_fgate = args.in[2]; P.lb_logits = args.in[3]; P.norm_g = args.in[4]; P.w_pa = args.in[5]; P.w_pb = args.in[6]; P.w_o = args.in[7];
      P.ln1_g = args.in[8]; P.ln1_b = args.in[9]; P.w_ff_in = args.in[10]; P.w_ff_out = args.in[11]; P.ln2_g = args.in[12]; P.ln2_b = args.in[13]; P.out = args.out; P.ws = args.ws;
      weight_items(P, (LAS float*)(lds + wave * 16384), gw, NGW, lane);
      __syncthreads();
      stage_wfa(P.w_in, (LAS float*)lds, tid);
      __syncthreads();
      row_pass<false, false, true, true>(P.x, nullptr, (bf16*)(P.ws + WS_XN), nullptr, nullptr, (float*)(P.ws + WS_LF), (const LAS float*)lds, P.b_fgate, gw, NGW, lane); }
    GSYNC(); STAMP(tsn); ++tsn;
    { const int l = 0; DBG(10, args.ws + WS_XN, (size_t)64 * MiB, true); DBG(10, args.ws + WS_LF, (size_t)1 * MiB, false); }

#pragma unroll 1
    for (int l = 0; l < DEPTH; ++l) {
        for (int rep_ = 0; rep_ < REP_P1; ++rep_) {
        { IDS(); FRESH_PTR(unsigned char*, ws, args.ws); FRESH_PTR(const float*, lbl, args.in[3]);
          pg8::Gemm g{(const bf16*)(ws + WS_XN), (const bf16*)(ws + WS_W + (size_t)l * WL_STRIDE + WL_IN), M, NP1, D}; pg8::StaticOrder S; S.init(M, NP1, G, bx);
          pg8::EpiInProj E{(bf16*)(ws + WS_QA), (bf16*)(ws + WS_QB), (bf16*)(ws + WS_KA), (bf16*)(ws + WS_VA), (float*)(ws + WS_G), (bf16*)(ws + WS_IB), (bf16*)(ws + WS_GB), lbl, l, attn_body::C2};
          pg8::gemm_phase<pg8::EpiInProj, pg8::StaticOrder, true, true>(lds, g, S, E); }
        }
        GSYNC(); STAMP(tsn); ++tsn;
        DBG(20, args.ws + WS_QA, (size_t)64 * MiB, true); DBG(30, args.ws + WS_KA, (size_t)64 * MiB, true); DBG(40, args.ws + WS_G, (size_t)64 * MiB, false); DBG(50, args.ws + WS_IB, (size_t)64 * MiB, true);
        for (int rep_ = 0; rep_ < REP_P2; ++rep_) {
        { IDS(); FRESH_PTR(unsigned char*, ws, args.ws);
          for (int u = vcu; u < 2048; u += G) hg::pass1_unit(u, (const float*)(ws + WS_G), (const bf16*)(ws + WS_IB), (bf16*)(ws + WS_ST), (float*)(ws + WS_DEC), lds, tid, (unsigned*)(ws + WS_DBG));
          for (int u = vcu; u < 16; u += G) fcumsum_unit(u, (const float*)(ws + WS_LF), (float*)(ws + WS_F), lds, tid);
          for (int u = vcu; u < 256; u += G) norm_unit(u, (const bf16*)(ws + WS_QA), (const bf16*)(ws + WS_KA), (unsigned*)(ws + WS_CTL + CTL_NORM) + l * 32, tid); }
        }
        GSYNC(); STAMP(tsn); ++tsn;
        DBG(60, args.ws + WS_ST, (size_t)64 * MiB, true); DBG(61, args.ws + WS_DEC, (size_t)1 * MiB, false); DBG(70, args.ws + WS_F, (size_t)1 * MiB, false);
        { IDS(); FRESH_PTR(unsigned char*, ws, args.ws);
          #if REP_HG0
          if (l == 0) { FRESH_PTR(float*, outp, args.out); hg::pass2_scan((const bf16*)(ws + WS_ST), (bf16*)outp, (const float*)(ws + WS_DEC), vcu * NTHR + tid, G * NTHR); }
#endif
          hg::pass2_scan((const bf16*)(ws + WS_ST), (bf16*)(ws + WS_ST), (const float*)(ws + WS_DEC), vcu * NTHR + tid, G * NTHR); }
        GSYNC(); STAMP(tsn); ++tsn;
        DBG(80, args.ws + WS_ST, (size_t)64 * MiB, true);
        { FRESH_PTR(unsigned char*, ws, args.ws);
          const attn_body::AttnTensors AT{(const attn_body::bf16*)(ws + WS_QA), (const attn_body::bf16*)(ws + WS_KA), (const attn_body::bf16*)(ws + WS_VA), (attn_body::bf16*)(ws + WS_QA), (const float*)(ws + WS_F),
                                          (const unsigned*)(ws + WS_CTL + CTL_NORM) + l * 32};
          const attn_body::DynOrder S{(unsigned*)(ws + WS_CTL + CTL_QCTR) + l * 64, (volatile LAS unsigned*)(lds + attn_body::LDS_BYTES + 32)};
          attn_body::attn_phase<attn_body::DynOrder>((char*)lds_raw, AT, S); }
        { IDS(); FRESH_PTR(unsigned char*, ws, args.ws); FRESH_PTR(const float*, ng, args.in[4]);
          volatile LAS unsigned* slot = (volatile LAS unsigned*)(lds + attn_body::LDS_BYTES + 32); unsigned* ctr = (unsigned*)(ws + WS_CTL + CTL_PCTR) + l * 64;
          __syncthreads();
          for (;;) {
              if (tid == 0) *slot = __hip_atomic_fetch_add(ctr, 1u, __ATOMIC_RELAXED, __HIP_MEMORY_SCOPE_AGENT);
              __syncthreads();
              const unsigned n = *slot; if (n >= 2048u) break;
              hg::pass3_unit((int)n, (const float*)(ws + WS_G), (const bf16*)(ws + WS_IB), (const bf16*)(ws + WS_GB), (const bf16*)(ws + WS_ST), (const bf16*)(ws + WS_QB), (bf16*)(ws + WS_QB), ng + l * 128, lds, tid); } }
        GSYNC(); STAMP(tsn); ++tsn;
        DBG(90, args.ws + WS_QA, (size_t)64 * MiB, true);
        for (int rep_ = 0; rep_ < REP_P45; ++rep_) {
        { IDS(); FRESH_PTR(unsigned char*, ws, args.ws);
          pg8::Gemm g{(const bf16*)(ws + WS_XN), (const bf16*)(ws + WS_W + (size_t)l * WL_STRIDE + WL_G), M, NG, D}; pg8::StaticOrder S; S.init(M, NG, G, bx);
          pg8::EpiGates E{(bf16*)(ws + WS_GATES)};
          pg8::gemm_phase<pg8::EpiGates, pg8::StaticOrder, true, true>(lds, g, S, E); }
        }
        GSYNC(); STAMP(tsn); ++tsn;
        DBG(100, args.ws + WS_GATES, (size_t)128 * MiB, true);
        for (int rep_ = 0; rep_ < REP_P45; ++rep_) {
        { IDS(); FRESH_PTR(unsigned char*, ws, args.ws);
          { pg8::Gemm g{(const bf16*)(ws + WS_QA), (const bf16*)(ws + WS_W + (size_t)l * WL_STRIDE + WL_M), M, D, 512}; pg8::StaticOrder S; S.init(M, D, G, bx);
            pg8::EpiMerge<0> E{(const bf16*)(ws + WS_GATES), (bf16*)(ws + WS_MERGED)};
            pg8::gemm_phase<pg8::EpiMerge<0>, pg8::StaticOrder, true, true>(lds, g, S, E); }
          asm volatile("s_waitcnt vmcnt(0)" ::: "memory"); __syncthreads();
          { pg8::Gemm g{(const bf16*)(ws + WS_QB), (const bf16*)(ws + WS_W + (size_t)l * WL_STRIDE + WL_M + MiB), M, D, 512}; pg8::StaticOrder S; S.init(M, D, G, bx);
            pg8::EpiMerge<1> E{(const bf16*)(ws + WS_GATES), (bf16*)(ws + WS_MERGED)};
            pg8::gemm_phase<pg8::EpiMerge<1>, pg8::StaticOrder, true, true>(lds, g, S, E); } }
        }
        GSYNC(); STAMP(tsn); ++tsn;
        DBG(110, args.ws + WS_MERGED, (size_t)64 * MiB, true);
        { IDS(); FRESH_PTR(unsigned char*, ws, args.ws); FRESH_PTR(const float*, xin, args.in[0]); FRESH_PTR(float*, outp, args.out); const float* xres = (l == 0) ? xin : (const float*)outp;
          pg8::Gemm g{(const bf16*)(ws + WS_MERGED), (const bf16*)(ws + WS_W + (size_t)l * WL_STRIDE + WL_O), M, D, D}; pg8::StaticOrder S; S.init(M, D, G, bx);
          FRESH_PTR(const float*, g2, args.in[12]); FRESH_PTR(const float*, b2, args.in[13]);
          pg8::EpiResid E{xres, outp, ALPHA, (l == 0) ? (const float*)nullptr : (const float*)(ws + WS_CTL + CTL_STATS + 262144), g2 + (l - 1) * D, b2 + (l - 1) * D};
          pg8::gemm_phase<pg8::EpiResid, pg8::StaticOrder, true, true>(lds, g, S, E); }
        GSYNC(); STAMP(tsn); ++tsn;
        DBG(120, args.out, (size_t)128 * MiB, false);
        { IDS(); FRESH_PTR(unsigned char*, ws, args.ws); FRESH_PTR(float*, outp, args.out); FRESH_PTR(const float*, gm, args.in[8]); FRESH_PTR(const float*, bt, args.in[9]);
#if REP_LN1
          row_pass<true, true, true, false>(outp, (float*)(ws + WS_GATES), (bf16*)(ws + WS_ST), gm + l * D, bt + l * D, nullptr, nullptr, nullptr, gw, NGW, lane);
#endif
          row_pass<true, false, true, false>(outp, nullptr, (bf16*)(ws + WS_XN), gm + l * D, bt + l * D, nullptr, nullptr, nullptr, gw, NGW, lane, (float*)(ws + WS_CTL + CTL_STATS + (size_t)l * 524288)); }
        GSYNC(); STAMP(tsn); ++tsn;
        DBG(130, args.ws + WS_XN, (size_t)64 * MiB, true);
        for (int rep_ = 0; rep_ < REP_P8; ++rep_) {
        { IDS(); FRESH_PTR(unsigned char*, ws, args.ws);
          pg8::Gemm g{(const bf16*)(ws + WS_XN), (const bf16*)(ws + WS_W + (size_t)l * WL_STRIDE + WL_F1), M, NF1, D}; pg8::StaticOrder S; S.init(M, NF1, G, bx);
          pg8::EpiSwiGLU E{(bf16*)(ws + WS_H)};
          pg8::gemm_phase<pg8::EpiSwiGLU, pg8::StaticOrder, true, true>(lds, g, S, E); }
        }
        GSYNC(); STAMP(tsn); ++tsn;
        DBG(140, args.ws + WS_H, (size_t)176 * MiB, true);
        { IDS(); FRESH_PTR(unsigned char*, ws, args.ws); FRESH_PTR(float*, outp, args.out);
          pg8::Gemm g{(const bf16*)(ws + WS_H), (const bf16*)(ws + WS_W + (size_t)l * WL_STRIDE + WL_F2), M, D, FFH}; pg8::StaticOrder S; S.init(M, D, G, bx);
          FRESH_PTR(const float*, g1, args.in[8]); FRESH_PTR(const float*, b1, args.in[9]);
          pg8::EpiResid E{outp, outp, ALPHA, (const float*)(ws + WS_CTL + CTL_STATS + (size_t)l * 524288), g1 + l * D, b1 + l * D};
          pg8::gemm_phase<pg8::EpiResid, pg8::StaticOrder, true, true>(lds, g, S, E); }
        GSYNC(); STAMP(tsn); ++tsn;
        DBG(150, args.out, (size_t)128 * MiB, false);
        { IDS(); FRESH_PTR(unsigned char*, ws, args.ws); FRESH_PTR(float*, outp, args.out); FRESH_PTR(const float*, gm, args.in[12]); FRESH_PTR(const float*, bt, args.in[13]);
          if (l + 1 < DEPTH) {
              FRESH_PTR(const float*, win, args.in[1]); FRESH_PTR(const float*, bfg, args.in[2]);
              stage_wfa(win + (size_t)(l + 1) * D * NIN, (LAS float*)lds, tid);
              __syncthreads();
              row_pass<true, false, true, true>(outp, nullptr, (bf16*)(ws + WS_XN), gm + l * D, bt + l * D, (float*)(ws + WS_LF), (const LAS float*)lds, bfg + (l + 1) * 8, gw, NGW, lane, (float*)(ws + WS_CTL + CTL_STATS + 262144));
          } else {
              row_pass<true, true, false, false>(outp, outp, nullptr, gm + l * D, bt + l * D, nullptr, nullptr, nullptr, gw, NGW, lane);
          } }
        if (l + 1 < DEPTH) GSYNC(); STAMP(tsn); ++tsn;
    }
#ifdef DBG_TS
    GSYNC(); STAMP(tsn);
    { const volatile unsigned long long* T = (const volatile unsigned long long*)(args.ws + WS_DBG + 4096);
      float sum[2] = {0.f, 0.f};
      if (blockIdx.x == 0) {
          for (int k = 0; k < 23; ++k) { const float us = (float)(T[k + 1] - T[k]) * 0.01f; const int j = (k == 0) ? -1 : (k - 1) % 11;
              for (int w = 0; w < 2; ++w) { const unsigned mask = (w == 0) ? DBG_TS_A : DBG_TS_B; const bool in = (j < 0) ? ((mask >> 15) & 1u) : ((mask >> j) & 1u); if (in) sum[w] += us; } }
          for (int i = threadIdx.x; i < (1 << 20); i += NTHR) args.out[1024 + i] = sum[1];
          __syncthreads();
          if (threadIdx.x == 0) args.out[0] = 100.0f * sum[0];
      } }
#endif
#ifdef DBG_NAN
    GSYNC();
    if (blockIdx.x == 0 && threadIdx.x == 0) args.out[0] = 100.0f * (float)*(volatile unsigned*)(args.ws + WS_DBG);
#endif
}

extern "C" void kernel_launch(void* const* d_in, const int* in_sizes, int n_in, void* d_out, int out_size, void* d_ws, size_t ws_size, hipStream_t stream) {
    static int grid = 0;
    if (grid == 0) {
        if (n_in != 14 || in_sizes[0] != M * D || out_size != M * D || ws_size < WS_END) { fprintf(stderr, "kernel_launch: unexpected shapes (n_in %d, in0 %d, out %d, ws %zu)\n", n_in, n_in > 0 ? in_sizes[0] : -1, out_size, ws_size); grid = -1; return; }
        int dev = 0, cus = 0, per_cu = 0;
        if (hipGetDevice(&dev) != hipSuccess || hipDeviceGetAttribute(&cus, hipDeviceAttributeMultiprocessorCount, dev) != hipSuccess) { grid = -1; return; }
        if (hipFuncSetAttribute((const void*)mega_fwd, hipFuncAttributeMaxDynamicSharedMemorySize, LDS_TOTAL) != hipSuccess) { fprintf(stderr, "kernel_launch: hipFuncSetAttribute failed\n"); grid = -1; return; }
        if (hipOccupancyMaxActiveBlocksPerMultiprocessor(&per_cu, (const void*)mega_fwd, NTHR, LDS_TOTAL) != hipSuccess || per_cu < 1) { fprintf(stderr, "kernel_launch: occupancy query says %d\n", per_cu); per_cu = 1; }
        (void)hipGetLastError();
        grid = cus * per_cu;
    }
    if (grid < 0) return;
    if (hipMemsetAsync((char*)d_ws + WS_CTL, 0, 65536, stream) != hipSuccess) { fprintf(stderr, "kernel_launch: hipMemsetAsync failed\n"); return; }
    Args a{};
    for (int i = 0; i < 14; ++i) a.in[i] = (const float*)d_in[i];
    a.out = (float*)d_out; a.ws = (unsigned char*)d_ws;
    void* kargs[] = {&a};
    hipError_t e = hipLaunchCooperativeKernel((const void*)mega_fwd, dim3(grid), dim3(NTHR), kargs, LDS_TOTAL, stream);
    if (e != hipSuccess) fprintf(stderr, "kernel_launch: cooperative launch failed: %s (grid %d)\n", hipGetErrorString(e), grid);
}
```

```cpp
#include <hip/hip_runtime.h>
#include <cstdio>
#include <cstdint>
namespace pg8 {
#define PG8_LAS __attribute__((address_space(3)))
typedef unsigned short bf16_t;
typedef short bf16x8 __attribute__((ext_vector_type(8)));
typedef float f32x4 __attribute__((ext_vector_type(4)));
typedef unsigned u32x4 __attribute__((ext_vector_type(4)));
constexpr int BM = 256, BK = 64, HALF = 128, HTB = HALF * BK * 2  , STAGE_BYTES = 8 * HTB, NXCD = 8, WGM = 8;

__host__ __device__ __forceinline__ int lds_byte(int r, int c) { const int st = (r >> 4) * 2 + (c >> 5), rr = r & 15, cc = c & 31, ob = rr * 64 + cc * 2; return st * 1024 + (ob ^ (((ob >> 9) & 1) << 5)); }
__host__ __device__ __forceinline__ void stage_rc(int b, int& R, int& C) { const int st = b / 1024, sb = b % 1024, swz = sb ^ (((sb >> 9) & 1) << 5); R = (st >> 1) * 16 + swz / 64; C = (st & 1) * 32 + (swz % 64) / 2; }
__host__ __device__ __forceinline__ int perm32(int rho) { const int n = rho >> 4, i = rho & 15; return 8 * (i >> 2) + 4 * n + (i & 3); }

struct Unit { int pm, pn; };
struct Gemm { const bf16_t* A; const bf16_t* Bt; int M, N, K; };

struct StaticOrder {
    int nM, nN, nwg, G, c;
    __host__ __device__ void init(int M, int N, int G_, int c_) { nM = M / BM; nN = N / BM; nwg = nM * nN; G = G_; c = c_; }
    __host__ __device__ bool next(int i, Unit& u) const {
        const long L = (long)i * G + c; if (L >= nwg) return false;
        int wgid = (int)L; { const int q = nwg / NXCD, r = nwg % NXCD, xcd = wgid % NXCD, off = wgid / NXCD; wgid = (xcd < r ? xcd * (q + 1) : r * (q + 1) + (xcd - r) * q) + off; }
        const int nig = WGM * nN, gid = wgid / nig, fm = gid * WGM, gsz = (nM - fm) < WGM ? (nM - fm) : WGM;
        u.pm = fm + ((wgid % nig) % gsz); u.pn = (wgid % nig) / gsz; return true;
    }
    __device__ __forceinline__ void a_ready(const Unit&) const {}
    __device__ __forceinline__ void done(const Unit&) const {}
};

typedef float f32x2c_t __attribute__((ext_vector_type(2))); typedef __bf16 bf16x2c_t __attribute__((ext_vector_type(2)));
__device__ __forceinline__ unsigned cvt_pk_bf16(float lo, float hi) { f32x2c_t v = {lo, hi}; bf16x2c_t b = __builtin_convertvector(v, bf16x2c_t); return __builtin_bit_cast(unsigned, b); }
typedef float f32x2 __attribute__((ext_vector_type(2)));
__device__ __forceinline__ f32x2 gelu_pk(f32x2 v) {
    const f32x2 av = __builtin_elementwise_abs(v), d = av * 0.2316418882f + 1.0f;
    f32x2 t; t.x = __builtin_amdgcn_rcpf(d.x); t.y = __builtin_amdgcn_rcpf(d.y);
    f32x2 q = t * 0.5307027145f + (-0.7265760135f); q = q * t + 0.7107068705f; q = q * t + (-0.142248368f); q = q * t + 0.127414796f; q = q * t;
    const f32x2 s = (v * v) * (-0.72134752044f);
    f32x2 e; e.x = __builtin_amdgcn_exp2f(s.x); e.y = __builtin_amdgcn_exp2f(s.y);
    const f32x2 m = v * (q * e), r = v - m;
    f32x2 o; o.x = v.x < 0.f ? m.x : r.x; o.y = v.y < 0.f ? m.y : r.y; return o;
}

template <int ACT  > struct EpiBf16 {
    static constexpr bool PERM = true, AFTER_DRAIN = false; static_assert(ACT == 0 || ACT == 1, "EpiBf16: ACT is 0 (none) or 1 (gelu_pk)");
    bf16_t* O; int ldc; const float* bias; int split_cols; size_t split_stride; float scale0;
    __device__ __forceinline__ void operator()(const f32x4 (&acc)[2][2][4][2], const Unit& u, int wr, int wc, int fr, int fq) const {
        const int row0 = u.pm * BM + wr * 64 + fr; int colt = u.pn * BM; bf16_t* base = O;
        float sc = 1.f; if (split_cols) { const int t = colt / split_cols; base += (size_t)t * split_stride; colt -= t * split_cols; if (t == 0) sc = scale0; }
        const int col0 = colt + wc * 32 + 8 * fq, bcol0 = u.pn * BM + wc * 32 + 8 * fq;
        f32x4 bv[2][2];
#pragma unroll
        for (int bj = 0; bj < 2; ++bj)
#pragma unroll
            for (int n = 0; n < 2; ++n) bv[bj][n] = bias ? *(const f32x4*)(bias + bcol0 + bj * HALF + 4 * n) : (f32x4){0.f, 0.f, 0.f, 0.f};
#pragma unroll
        for (int ai = 0; ai < 2; ++ai)
#pragma unroll
            for (int m = 0; m < 4; ++m) { bf16_t* rowp = base + (size_t)(row0 + ai * HALF + m * 16) * ldc + col0;
#pragma unroll
                for (int bj = 0; bj < 2; ++bj) { f32x4 v0 = acc[ai][bj][m][0] + bv[bj][0], v1 = acc[ai][bj][m][1] + bv[bj][1];
                    if (ACT == 1) { f32x2 a = gelu_pk((f32x2){v0[0], v0[1]}), b = gelu_pk((f32x2){v0[2], v0[3]}), c = gelu_pk((f32x2){v1[0], v1[1]}), d = gelu_pk((f32x2){v1[2], v1[3]});
                        v0 = (f32x4){a.x, a.y, b.x, b.y}; v1 = (f32x4){c.x, c.y, d.x, d.y}; }
                    v0 = v0 * sc; v1 = v1 * sc; u32x4 w; w.x = cvt_pk_bf16(v0[0], v0[1]); w.y = cvt_pk_bf16(v0[2], v0[3]); w.z = cvt_pk_bf16(v1[0], v1[1]); w.w = cvt_pk_bf16(v1[2], v1[3]);
                    *(u32x4*)(rowp + bj * HALF) = w; } }
    }
};

struct PanelStats {
    unsigned* xbuf;
    unsigned* cnt;
    unsigned* tmo;
    int ntn; float eps;
    unsigned code;
    __device__ __forceinline__ bool run(const f32x4 (&v)[2][2][4][2], const Unit& u, int wr, int wc, int fr, int fq, PG8_LAS unsigned char* lds, int wid, int lane) const {
        typedef float f32x2v __attribute__((ext_vector_type(2)));
        PG8_LAS f32x2v* P = (PG8_LAS f32x2v*)lds;
        PG8_LAS f32x2v* S = (PG8_LAS f32x2v*)(lds + 8192);
        PG8_LAS unsigned* flag = (PG8_LAS unsigned*)(lds + 8192 + 2048);
#pragma unroll
        for (int ai = 0; ai < 2; ++ai)
#pragma unroll
            for (int m = 0; m < 4; ++m) {
                float s = 0.f;
#pragma unroll
                for (int bj = 0; bj < 2; ++bj)
#pragma unroll
                    for (int n = 0; n < 2; ++n) { const f32x4 x = v[ai][bj][m][n]; s += (x[0] + x[1]) + (x[2] + x[3]); }
                s += __shfl_xor(s, 16); s += __shfl_xor(s, 32);
                const float mw = s * (1.0f / 64.0f); float q = 0.f;
#pragma unroll
                for (int bj = 0; bj < 2; ++bj)
#pragma unroll
                    for (int n = 0; n < 2; ++n) { const f32x4 d = v[ai][bj][m][n] - mw; q += (d[0] * d[0] + d[1] * d[1]) + (d[2] * d[2] + d[3] * d[3]); }
                q += __shfl_xor(q, 16); q += __shfl_xor(q, 32);
                if (fq == 0) P[(ai * HALF + wr * 64 + m * 16 + fr) * 4 + wc] = (f32x2v){mw, q};
            }
        asm volatile("s_waitcnt lgkmcnt(0)" ::: "memory"); __builtin_amdgcn_s_barrier(); asm volatile("" ::: "memory");
#if defined(BROKEN_EXCHANGE_NO_WAIT)
#warning BROKEN CONTROL BUILD: the row-statistics exchange does not wait; results are wrong by design
        if (blockIdx.x >= 64) { const long long t0_ = clock64(); while (clock64() - t0_ < 60000) __builtin_amdgcn_s_sleep(8); }
#endif
        const int row = wid * 32 + (lane & 31);
        if (lane < 32) {
            const f32x2v a = P[row * 4 + 0], b = P[row * 4 + 1], c = P[row * 4 + 2], d = P[row * 4 + 3];
            const float mt = (a.x + b.x + c.x + d.x) * 0.25f;
            const float da = a.x - mt, db = b.x - mt, dc = c.x - mt, dd = d.x - mt;
            const float m2 = (a.y + b.y) + (c.y + d.y) + 64.0f * ((da * da + db * db) + (dc * dc + dd * dd));
            unsigned long long* slot = (unsigned long long*)xbuf + ((size_t)(u.pm * BM + row) * 4 + u.pn);
            __hip_atomic_store(slot, ((unsigned long long)__float_as_uint(m2) << 32) | __float_as_uint(mt), __ATOMIC_RELAXED, __HIP_MEMORY_SCOPE_AGENT);
        }
        asm volatile("s_waitcnt vmcnt(0)" ::: "memory");
        if (lane == 0) __hip_atomic_fetch_add(cnt + 64 * u.pm, 1u, __ATOMIC_RELAXED, __HIP_MEMORY_SCOPE_AGENT);
        if (wid == 0) {
            bool dead = false; const unsigned long long t0 = __builtin_amdgcn_s_memrealtime(); const unsigned want = 8u * (unsigned)ntn;
            for (;;) {
#if defined(BROKEN_EXCHANGE_NO_WAIT)
                break;
#endif
                if ((unsigned)__builtin_amdgcn_readfirstlane(__hip_atomic_load(cnt + 64 * u.pm, __ATOMIC_RELAXED, __HIP_MEMORY_SCOPE_AGENT)) >= want) break;
                if (__builtin_amdgcn_s_memrealtime() - t0 > 2000000ull) {
                    if (lane == 0) { unsigned expect = 0u; __hip_atomic_compare_exchange_strong(tmo + 1, &expect, code | (unsigned)(u.pm & 0xff), __ATOMIC_RELAXED, __ATOMIC_RELAXED, __HIP_MEMORY_SCOPE_AGENT);
                                     __hip_atomic_store(tmo, 1u, __ATOMIC_RELAXED, __HIP_MEMORY_SCOPE_AGENT); }
                    dead = true; break; }
                __builtin_amdgcn_s_sleep(2);
            }
            __builtin_amdgcn_fence(__ATOMIC_ACQUIRE, "agent");
            if (lane == 0) flag[0] = dead ? 1u : 0u;
        }
        asm volatile("s_waitcnt vmcnt(0) lgkmcnt(0)" ::: "memory"); __builtin_amdgcn_s_barrier(); asm volatile("" ::: "memory");
        const bool bad = flag[0] != 0u;
        if (lane < 32) {
            const unsigned long long* slot = (const unsigned long long*)xbuf + (size_t)(u.pm * BM + row) * 4; float mt[4], m2[4]; float ms = 0.f;
#pragma unroll
            for (int t = 0; t < 4; ++t) { if (t < ntn) { const unsigned long long w = __hip_atomic_load(slot + t, __ATOMIC_RELAXED, __HIP_MEMORY_SCOPE_AGENT); mt[t] = __uint_as_float((unsigned)w); m2[t] = __uint_as_float((unsigned)(w >> 32)); } else { mt[t] = 0.f; m2[t] = 0.f; } ms += mt[t]; }
            const float mean = ms / (float)ntn; float q = 0.f;
#pragma unroll
            for (int t = 0; t < 4; ++t) if (t < ntn) { const float dm = mt[t] - mean; q += m2[t] + 256.0f * dm * dm; }
            S[row] = (f32x2v){mean, 1.0f / sqrtf(q / (256.0f * (float)ntn) + eps)};
        }
        asm volatile("s_waitcnt lgkmcnt(0)" ::: "memory"); __builtin_amdgcn_s_barrier(); asm volatile("" ::: "memory");
        return bad;
    }
};
struct EpiLnRes {
    static constexpr bool PERM = false, AFTER_DRAIN = true;
    const float* base; float* out; int ldc; const float* bias; PanelStats st; unsigned poison;
    __device__ __forceinline__ void fused(f32x4 (&acc)[2][2][4][2], const Unit& u, int wr, int wc, int fr, int fq, PG8_LAS unsigned char* lds, int wid, int lane) const {
        typedef float f32x2v __attribute__((ext_vector_type(2)));
        const PG8_LAS f32x2v* S = (const PG8_LAS f32x2v*)(lds + 8192);
        const int col0 = u.pn * BM + wc * 32 + 4 * fq;
#pragma unroll
        for (int bj = 0; bj < 2; ++bj)
#pragma unroll
            for (int n = 0; n < 2; ++n) { const f32x4 bv = bias ? *(const f32x4*)(bias + col0 + bj * HALF + n * 16) : (f32x4){0.f, 0.f, 0.f, 0.f};
#pragma unroll
                for (int ai = 0; ai < 2; ++ai)
#pragma unroll
                    for (int m = 0; m < 4; ++m) acc[ai][bj][m][n] += bv; }
        f32x4 pre[4][2][2];
#pragma unroll
        for (int m = 0; m < 4; ++m) { const size_t off = (size_t)(u.pm * BM + wr * 64 + m * 16 + fr) * ldc + col0;
#pragma unroll
            for (int bj = 0; bj < 2; ++bj)
#pragma unroll
                for (int n = 0; n < 2; ++n) pre[m][bj][n] = *(const f32x4*)(base + off + bj * HALF + n * 16); }
        const bool bad = st.run(acc, u, wr, wc, fr, fq, lds, wid, lane) || poison != 0u;
        const float qnan = __builtin_nanf("");
#pragma unroll
        for (int ai = 0; ai < 2; ++ai)
#pragma unroll
            for (int m = 0; m < 4; ++m) { const int r = ai * HALF + wr * 64 + m * 16 + fr; const f32x2v sr = S[r]; const size_t off = (size_t)(u.pm * BM + r) * ldc + col0;
#pragma unroll
                for (int bj = 0; bj < 2; ++bj)
#pragma unroll
                    for (int n = 0; n < 2; ++n) { const f32x4 bs = ai == 0 ? pre[m][bj][n] : *(const f32x4*)(base + off + bj * HALF + n * 16); f32x4 o = bs + (acc[ai][bj][m][n] - sr.x) * sr.y;
                        if (bad) o = (f32x4){qnan, qnan, qnan, qnan}; *(f32x4*)(out + off + bj * HALF + n * 16) = o; }
                if (m & 1) asm volatile("" ::: "memory"); }
    }
};
struct EpiLnResLn {
    static constexpr bool PERM = false, AFTER_DRAIN = true;
    const float* base; float* out; bf16_t* xn; int ldc; const float* bias; PanelStats st1, st2; unsigned poison;
    __device__ __forceinline__ void fused(f32x4 (&acc)[2][2][4][2], const Unit& u, int wr, int wc, int fr, int fq, PG8_LAS unsigned char* lds, int wid, int lane) const {
        typedef float f32x2v __attribute__((ext_vector_type(2))); typedef unsigned u32x2v __attribute__((ext_vector_type(2)));
        const PG8_LAS f32x2v* S = (const PG8_LAS f32x2v*)(lds + 8192);
        const int col0 = u.pn * BM + wc * 32 + 4 * fq;
#pragma unroll
        for (int bj = 0; bj < 2; ++bj)
#pragma unroll
            for (int n = 0; n < 2; ++n) { const f32x4 bv = bias ? *(const f32x4*)(bias + col0 + bj * HALF + n * 16) : (f32x4){0.f, 0.f, 0.f, 0.f};
#pragma unroll
                for (int ai = 0; ai < 2; ++ai)
#pragma unroll
                    for (int m = 0; m < 4; ++m) acc[ai][bj][m][n] += bv; }
        bool bad = st1.run(acc, u, wr, wc, fr, fq, lds, wid, lane) || poison != 0u;
        const float qnan = __builtin_nanf("");
#pragma unroll
        for (int ai = 0; ai < 2; ++ai)
#pragma unroll
            for (int m = 0; m < 4; ++m) { const int r = ai * HALF + wr * 64 + m * 16 + fr; const f32x2v sr = S[r]; const size_t off = (size_t)(u.pm * BM + r) * ldc + col0;
#pragma unroll
                for (int bj = 0; bj < 2; ++bj)
#pragma unroll
                    for (int n = 0; n < 2; ++n) { const f32x4 bs = *(const f32x4*)(base + off + bj * HALF + n * 16); acc[ai][bj][m][n] = bs + (acc[ai][bj][m][n] - sr.x) * sr.y; }
                asm volatile("" : "+v"(acc[ai][0][m][0]), "+v"(acc[ai][0][m][1]), "+v"(acc[ai][1][m][0]), "+v"(acc[ai][1][m][1]));
                if (m & 1) asm volatile("" ::: "memory"); }
        const bool bad1 = bad;
        bad = st2.run(acc, u, wr, wc, fr, fq, lds, wid, lane) || bad;
#pragma unroll
        for (int ai = 0; ai < 2; ++ai)
#pragma unroll
            for (int m = 0; m < 4; ++m) { const int r = ai * HALF + wr * 64 + m * 16 + fr; const f32x2v sr = S[r]; const size_t off = (size_t)(u.pm * BM + r) * ldc + col0;
#pragma unroll
                for (int bj = 0; bj < 2; ++bj)
#pragma unroll
                    for (int n = 0; n < 2; ++n) { const f32x4 x1 = acc[ai][bj][m][n]; *(f32x4*)(out + off + bj * HALF + n * 16) = bad1 ? (f32x4){qnan, qnan, qnan, qnan} : x1;
                        const f32x4 o = (x1 - sr.x) * sr.y; u32x2v w; w.x = cvt_pk_bf16(o[0], o[1]); w.y = cvt_pk_bf16(o[2], o[3]);
                        if (bad) { w.x = 0x7fc07fc0u; w.y = 0x7fc07fc0u; } *(u32x2v*)(xn + off + bj * HALF + n * 16) = w; }
                asm volatile("" ::: "memory"); }
    }
};

template <class Epi, class Sched, bool ALIGN_EPI = false, bool SP2 = false>
__device__ __forceinline__ void gemm_phase(PG8_LAS unsigned char* lds, const Gemm g, const Sched& S, const Epi& E) {
    int tid_ = threadIdx.x; asm volatile("" : "+v"(tid_));
    const int tid = tid_, wid = __builtin_amdgcn_readfirstlane(tid >> 6), lane = tid & 63, wr = wid >> 2, wc = wid & 3, fr = lane & 15, fq = lane >> 4;
    const int K = g.K, nt = K / BK;
    unsigned voffA[2], voffB[2];
#pragma unroll
    for (int i = 0; i < 2; ++i) { int R, C; stage_rc(tid * 16 + i * 8192, R, C); const int Rb = Epi::PERM ? ((R & ~31) + perm32(R & 31)) : R;
        voffA[i] = (unsigned)(R * K + C) * 2u; voffB[i] = (unsigned)(Rb * K + C) * 2u; }
    const size_t kstep = (size_t)(BK * 2);
    const size_t hstep = (size_t)HALF * K * 2;
    const size_t tstep = 2 * hstep;
    const unsigned ldsw = (unsigned)wid * 1024u;
    const int aoff = lds_byte(wr * 64 + fr, fq * 8), boff = lds_byte(wc * 32 + fr, fq * 8);
#define PG8_SA(b, h) (((b) * 2 + (h)) * HTB)
#define PG8_SB(b, h) ((4 + (b) * 2 + (h)) * HTB)
#define PG8_STAGE(bufoff, gbase, voff) do { _Pragma("unroll") for (int _i = 0; _i < 2; ++_i) \
        __builtin_amdgcn_global_load_lds((const unsigned*)((const char*)(gbase) + (voff)[_i]), (PG8_LAS unsigned*)(lds + (bufoff) + ldsw + _i * 8192), 16, 0, 0); } while (0)
#define PG8_LDA(dst, b, h) do { _Pragma("unroll") for (int m = 0; m < 4; ++m) _Pragma("unroll") for (int k = 0; k < 2; ++k) dst[m][k] = *(const PG8_LAS bf16x8*)(lds + PG8_SA(b, h) + aoff + m * 2048 + k * 1024); } while (0)
#define PG8_LDB(dst, b, h) do { _Pragma("unroll") for (int n = 0; n < 2; ++n) _Pragma("unroll") for (int k = 0; k < 2; ++k) dst[n][k] = *(const PG8_LAS bf16x8*)(lds + PG8_SB(b, h) + boff + n * 2048 + k * 1024); } while (0)
#define PG8_MMA(ai, bj, At, Bt) do { __builtin_amdgcn_s_setprio(1); _Pragma("unroll") for (int m = 0; m < 4; ++m) _Pragma("unroll") for (int n = 0; n < 2; ++n) _Pragma("unroll") for (int k = 0; k < 2; ++k) \
        acc[ai][bj][m][n] = __builtin_amdgcn_mfma_f32_16x16x32_bf16(Bt[n][k], At[m][k], acc[ai][bj][m][n], 0, 0, 0); __builtin_amdgcn_s_setprio(0); } while (0)
#define PG8_WAIT_V(n) asm volatile("s_waitcnt vmcnt(" #n ")" ::: "memory")
#define PG8_WAIT_L(n) asm volatile("s_waitcnt lgkmcnt(" #n ")" ::: "memory")
#define PG8_BAR __builtin_amdgcn_s_barrier()
#define PG8_SCHED __builtin_amdgcn_sched_barrier(0)
    Unit cur, nxt; int ui = 0;
    if (!S.next(0, cur)) return;
    f32x4 acc[2][2][4][2];
#pragma unroll
    for (int a = 0; a < 2; ++a)
#pragma unroll
        for (int b = 0; b < 2; ++b)
#pragma unroll
            for (int m = 0; m < 4; ++m)
#pragma unroll
                for (int n = 0; n < 2; ++n) acc[a][b][m][n] = (f32x4){0.f, 0.f, 0.f, 0.f};
    bf16x8 At[4][2], B0[2][2], B1[2][2];
    const char* cA = (const char*)g.A + (size_t)cur.pm * tstep; const char* cB = (const char*)g.Bt + (size_t)cur.pn * tstep;
    S.a_ready(cur);
    if constexpr (SP2) {
        PG8_STAGE(PG8_SB(0, 0), cB, voffB); PG8_STAGE(PG8_SB(0, 1), cB + hstep, voffB); PG8_STAGE(PG8_SA(0, 0), cA, voffA); PG8_STAGE(PG8_SA(0, 1), cA + hstep, voffA);
        if (wr == 1) PG8_BAR;
        PG8_WAIT_V(2); PG8_BAR;
        PG8_STAGE(PG8_SB(1, 0), cB + kstep, voffB); PG8_STAGE(PG8_SA(1, 0), cA + kstep, voffA); PG8_STAGE(PG8_SB(1, 1), cB + hstep + kstep, voffB);
        PG8_WAIT_V(6); PG8_BAR;
    } else {
        PG8_STAGE(PG8_SB(0, 0), cB, voffB); PG8_STAGE(PG8_SA(0, 0), cA, voffA); PG8_STAGE(PG8_SB(0, 1), cB + hstep, voffB); PG8_STAGE(PG8_SA(0, 1), cA + hstep, voffA);
        if (wr == 1) PG8_BAR;
        PG8_WAIT_V(4); PG8_BAR;
        PG8_STAGE(PG8_SB(1, 0), cB + kstep, voffB); PG8_STAGE(PG8_SA(1, 0), cA + kstep, voffA); PG8_STAGE(PG8_SB(1, 1), cB + hstep + kstep, voffB);
        PG8_WAIT_V(6); PG8_BAR;
    }
    for (;;) {
        const bool has_next = S.next(ui + 1, nxt);
        const char* nA = has_next ? (const char*)g.A + (size_t)nxt.pm * tstep : cA; const char* nB = has_next ? (const char*)g.Bt + (size_t)nxt.pn * tstep : cB;
        for (int t = 0; t < nt; t += 2) {
            const bool last = (t == nt - 2);
            const char* a1 = cA + (size_t)(t + 1) * kstep;
            const char* a2 = last ? nA : cA + (size_t)(t + 2) * kstep; const char* b2 = last ? nB : cB + (size_t)(t + 2) * kstep;
            const char* a3 = a2 + kstep; const char* b3 = b2 + kstep;
            if (last && has_next) S.a_ready(nxt);
            if constexpr (SP2) {
            PG8_LDB(B0, 0, 0); PG8_LDB(B1, 0, 1); PG8_SCHED; PG8_LDA(At, 0, 0); PG8_STAGE(PG8_SA(1, 1), a1 + hstep, voffA);
            PG8_WAIT_V(8); PG8_WAIT_L(0); PG8_BAR; PG8_MMA(0, 0, At, B0); PG8_MMA(0, 1, At, B1); PG8_BAR; PG8_SCHED;
            PG8_LDA(At, 0, 1); PG8_STAGE(PG8_SB(0, 0), b2, voffB); PG8_STAGE(PG8_SB(0, 1), b2 + hstep, voffB); PG8_STAGE(PG8_SA(0, 0), a2, voffA);
            PG8_WAIT_V(8); PG8_WAIT_L(0); PG8_BAR; PG8_MMA(1, 0, At, B0); PG8_MMA(1, 1, At, B1); PG8_BAR; PG8_SCHED;
            PG8_LDB(B0, 1, 0); PG8_LDB(B1, 1, 1); PG8_SCHED; PG8_LDA(At, 1, 0); PG8_STAGE(PG8_SA(0, 1), a2 + hstep, voffA);
            PG8_WAIT_V(8); PG8_WAIT_L(0); PG8_BAR; PG8_MMA(0, 0, At, B0); PG8_MMA(0, 1, At, B1); PG8_BAR; PG8_SCHED;
            PG8_LDA(At, 1, 1); PG8_STAGE(PG8_SB(1, 0), b3, voffB); PG8_STAGE(PG8_SB(1, 1), b3 + hstep, voffB); PG8_STAGE(PG8_SA(1, 0), a3, voffA);
            PG8_WAIT_V(8); PG8_WAIT_L(0); PG8_BAR; PG8_MMA(1, 0, At, B0); PG8_MMA(1, 1, At, B1); PG8_BAR; PG8_SCHED;
            } else {
            PG8_LDB(B0, 0, 0); PG8_SCHED; PG8_LDA(At, 0, 0); PG8_STAGE(PG8_SA(1, 1), a1 + hstep, voffA);
            PG8_WAIT_L(8); PG8_BAR; PG8_WAIT_L(0); PG8_MMA(0, 0, At, B0); PG8_BAR; PG8_SCHED;
            PG8_LDB(B1, 0, 1); PG8_STAGE(PG8_SB(0, 0), b2, voffB);
            PG8_BAR; PG8_WAIT_L(0); PG8_MMA(0, 1, At, B1); PG8_BAR;
            PG8_LDA(At, 0, 1); PG8_STAGE(PG8_SA(0, 0), a2, voffA);
            PG8_BAR; PG8_WAIT_L(0); PG8_MMA(1, 0, At, B0); PG8_BAR; PG8_SCHED;
            PG8_STAGE(PG8_SB(0, 1), b2 + hstep, voffB);
            PG8_WAIT_V(6); PG8_BAR; PG8_MMA(1, 1, At, B1); PG8_BAR;
            PG8_LDB(B0, 1, 0); PG8_SCHED; PG8_LDA(At, 1, 0); PG8_STAGE(PG8_SA(0, 1), a2 + hstep, voffA);
            PG8_WAIT_L(8); PG8_BAR; PG8_WAIT_L(0); PG8_MMA(0, 0, At, B0); PG8_BAR; PG8_SCHED;
            PG8_LDB(B1, 1, 1); PG8_STAGE(PG8_SB(1, 0), b3, voffB);
            PG8_BAR; PG8_WAIT_L(0); PG8_MMA(0, 1, At, B1); PG8_BAR;
            PG8_LDA(At, 1, 1); PG8_STAGE(PG8_SA(1, 0), a3, voffA);
            PG8_BAR; PG8_WAIT_L(0); PG8_MMA(1, 0, At, B0); PG8_BAR; PG8_SCHED;
            PG8_STAGE(PG8_SB(1, 1), b3 + hstep, voffB);
            PG8_WAIT_V(6); PG8_BAR; PG8_MMA(1, 1, At, B1); PG8_BAR;
            }
        }
        if constexpr (ALIGN_EPI) { if (wr == 0) PG8_BAR; }
        if constexpr (!Epi::AFTER_DRAIN) { E(acc, cur, wr, wc, fr, fq); S.done(cur); }
        if (!has_next) break;
#pragma unroll
        for (int a = 0; a < 2; ++a)
#pragma unroll
            for (int b = 0; b < 2; ++b)
#pragma unroll
                for (int m = 0; m < 4; ++m)
#pragma unroll
                    for (int n = 0; n < 2; ++n) acc[a][b][m][n] = (f32x4){0.f, 0.f, 0.f, 0.f};
        cur = nxt; cA = nA; cB = nB; ++ui;
        if constexpr (ALIGN_EPI) { if (wr == 1) PG8_BAR; }
    }
    PG8_WAIT_V(0);
    if constexpr (!ALIGN_EPI) { if (wr == 0) PG8_BAR; }
    PG8_BAR;
    if constexpr (Epi::AFTER_DRAIN) { E.fused(acc, cur, wr, wc, fr, fq, lds, wid, lane); S.done(cur); }
#undef PG8_SA
#undef PG8_SB
#undef PG8_STAGE
#undef PG8_LDA
#undef PG8_LDB
#undef PG8_MMA
#undef PG8_WAIT_V
#undef PG8_WAIT_L
#undef PG8_BAR
#undef PG8_SCHED
}
}
namespace pg8 {
__device__ __forceinline__ float fsig(float v) { return __builtin_amdgcn_rcpf(1.0f + __builtin_amdgcn_exp2f(-1.4426950408889634f * v)); }
__device__ __forceinline__ float bf_lo(unsigned w) { return __uint_as_float(w << 16); }
__device__ __forceinline__ float bf_hi(unsigned w) { return __uint_as_float(w & 0xffff0000u); }

struct EpiInProj {
    static constexpr bool PERM = true, AFTER_DRAIN = false;
    bf16_t* QA; bf16_t* QB; bf16_t* KA; bf16_t* VA; float* G; bf16_t* IB; bf16_t* GB; const float* lbl; int layer; float qscale;
    __device__ __forceinline__ void operator()(const f32x4 (&acc)[2][2][4][2], const Unit& u, int wr, int wc, int fr, int fq) const {
        const int type = u.pn >> 1;
        const int ct = (u.pn & 1) * 256 + wc * 32 + 8 * fq;
        const int row0 = u.pm * BM + wr * 64 + fr;
        if (type == 4) {
            float lb[2][8];
#pragma unroll
            for (int bj = 0; bj < 2; ++bj)
#pragma unroll
                for (int j = 0; j < 8; ++j) {
                    float v = 0.f;
                    if (layer != 0) { const float l0 = lbl[ct + bj * HALF + j], l1 = lbl[512 + ct + bj * HALF + j]; v = 1.0f / (1.0f + __expf(l0 - l1)); }
                    lb[bj][j] = v;
                }
#pragma unroll
            for (int ai = 0; ai < 2; ++ai)
#pragma unroll
                for (int m = 0; m < 4; ++m) { float* rowp = G + (size_t)(row0 + ai * HALF + m * 16) * 512 + ct;
#pragma unroll
                    for (int bj = 0; bj < 2; ++bj) { f32x4 o0, o1;
#pragma unroll
                        for (int j = 0; j < 4; ++j) {
                            const float f0 = lb[bj][j] + (1.0f - lb[bj][j]) * fsig(acc[ai][bj][m][0][j]);
                            const float f1 = lb[bj][4 + j] + (1.0f - lb[bj][4 + j]) * fsig(acc[ai][bj][m][1][j]);
                            o0[j] = __builtin_amdgcn_logf(f0) * 0.6931471805599453f; o1[j] = __builtin_amdgcn_logf(f1) * 0.6931471805599453f; }
                        *(f32x4*)(rowp + bj * HALF) = o0; *(f32x4*)(rowp + bj * HALF + 4) = o1; } }
        } else {
            bf16_t* base; int ldc = 512, act = 0; float sc = 1.f;
            if (type == 0) { base = QA; sc = qscale; }
            else if (type == 1) base = KA;
            else if (type == 2) base = VA;
            else if (type == 3) { base = QB; act = 1; }
            else if (type == 5) base = IB;
            else { base = GB; act = 2; }
#pragma unroll
            for (int ai = 0; ai < 2; ++ai)
#pragma unroll
                for (int m = 0; m < 4; ++m) { bf16_t* rowp = base + (size_t)(row0 + ai * HALF + m * 16) * ldc + ct;
#pragma unroll
                    for (int bj = 0; bj < 2; ++bj) { f32x4 v0 = acc[ai][bj][m][0], v1 = acc[ai][bj][m][1];
                        if (act != 0) {
#pragma unroll
                            for (int j = 0; j < 4; ++j) { const float s0 = fsig(v0[j]), s1 = fsig(v1[j]); v0[j] = (act == 1) ? v0[j] * s0 : s0; v1[j] = (act == 1) ? v1[j] * s1 : s1; }
                        } else { v0 = v0 * sc; v1 = v1 * sc; }
                        u32x4 w; w.x = cvt_pk_bf16(v0[0], v0[1]); w.y = cvt_pk_bf16(v0[2], v0[3]); w.z = cvt_pk_bf16(v1[0], v1[1]); w.w = cvt_pk_bf16(v1[2], v1[3]);
                        *(u32x4*)(rowp + bj * HALF) = w; } }
        }
    }
};
struct EpiGates {
    static constexpr bool PERM = true, AFTER_DRAIN = false;
    bf16_t* O;
    __device__ __forceinline__ void operator()(const f32x4 (&acc)[2][2][4][2], const Unit& u, int wr, int wc, int fr, int fq) const {
        const int row0 = u.pm * BM + wr * 64 + fr, col0 = u.pn * BM + wc * 32 + 8 * fq;
#pragma unroll
        for (int ai = 0; ai < 2; ++ai)
#pragma unroll
            for (int m = 0; m < 4; ++m) { bf16_t* rowp = O + (size_t)(row0 + ai * HALF + m * 16) * 2048 + col0;
#pragma unroll
                for (int bj = 0; bj < 2; ++bj) { f32x4 v0 = acc[ai][bj][m][0], v1 = acc[ai][bj][m][1];
#pragma unroll
                    for (int j = 0; j < 4; ++j) { v0[j] = fsig(v0[j]); v1[j] = fsig(v1[j]); }
                    u32x4 w; w.x = cvt_pk_bf16(v0[0], v0[1]); w.y = cvt_pk_bf16(v0[2], v0[3]); w.z = cvt_pk_bf16(v1[0], v1[1]); w.w = cvt_pk_bf16(v1[2], v1[3]);
                    *(u32x4*)(rowp + bj * HALF) = w; } }
    }
};
template <int STEP> struct EpiMerge {
    static constexpr bool PERM = true, AFTER_DRAIN = false;
    const bf16_t* GT; bf16_t* O;
    __device__ __forceinline__ void operator()(const f32x4 (&acc)[2][2][4][2], const Unit& u, int wr, int wc, int fr, int fq) const {
        const int row0 = u.pm * BM + wr * 64 + fr, col0 = u.pn * BM + wc * 32 + 8 * fq;
#pragma unroll
        for (int ai = 0; ai < 2; ++ai) {
            u32x4 gq[4][2], tq[4][2];
#pragma unroll
            for (int m = 0; m < 4; ++m) { const size_t row = (size_t)(row0 + ai * HALF + m * 16);
#pragma unroll
                for (int bj = 0; bj < 2; ++bj) { gq[m][bj] = *(const u32x4*)(GT + row * 2048 + STEP * 1024 + col0 + bj * HALF);
                    if (STEP == 1) tq[m][bj] = *(const u32x4*)(O + row * 1024 + col0 + bj * HALF); } }
            asm volatile("" ::: "memory");
#pragma unroll
            for (int m = 0; m < 4; ++m) { const size_t row = (size_t)(row0 + ai * HALF + m * 16);
#pragma unroll
                for (int bj = 0; bj < 2; ++bj) { const u32x4 g = gq[m][bj];
                    const f32x4 a0 = acc[ai][bj][m][0], a1 = acc[ai][bj][m][1];
                    float o[8] = {bf_lo(g.x) * a0[0], bf_hi(g.x) * a0[1], bf_lo(g.y) * a0[2], bf_hi(g.y) * a0[3], bf_lo(g.z) * a1[0], bf_hi(g.z) * a1[1], bf_lo(g.w) * a1[2], bf_hi(g.w) * a1[3]};
                    if (STEP == 1) { const u32x4 t = tq[m][bj];
                        o[0] += bf_lo(t.x); o[1] += bf_hi(t.x); o[2] += bf_lo(t.y); o[3] += bf_hi(t.y); o[4] += bf_lo(t.z); o[5] += bf_hi(t.z); o[6] += bf_lo(t.w); o[7] += bf_hi(t.w); }
                    u32x4 w; w.x = cvt_pk_bf16(o[0], o[1]); w.y = cvt_pk_bf16(o[2], o[3]); w.z = cvt_pk_bf16(o[4], o[5]); w.w = cvt_pk_bf16(o[6], o[7]);
                    *(u32x4*)(O + row * 1024 + col0 + bj * HALF) = w; } }
            asm volatile("" ::: "memory");
        }
    }
};
struct EpiSwiGLU {
    static constexpr bool PERM = true, AFTER_DRAIN = false;
    bf16_t* O;
    __device__ __forceinline__ void operator()(const f32x4 (&acc)[2][2][4][2], const Unit& u, int wr, int wc, int fr, int fq) const {
        const int row0 = u.pm * BM + wr * 64 + fr, col0 = u.pn * HALF + wc * 32 + 8 * fq;
#pragma unroll
        for (int ai = 0; ai < 2; ++ai)
#pragma unroll
            for (int m = 0; m < 4; ++m) { const size_t row = (size_t)(row0 + ai * HALF + m * 16);
                f32x4 v0, v1;
#pragma unroll
                for (int j = 0; j < 4; ++j) { const float g0 = acc[ai][1][m][0][j], g1 = acc[ai][1][m][1][j];
                    v0[j] = g0 * fsig(g0) * acc[ai][0][m][0][j]; v1[j] = g1 * fsig(g1) * acc[ai][0][m][1][j]; }
                u32x4 w; w.x = cvt_pk_bf16(v0[0], v0[1]); w.y = cvt_pk_bf16(v0[2], v0[3]); w.z = cvt_pk_bf16(v1[0], v1[1]); w.w = cvt_pk_bf16(v1[2], v1[3]);
                *(u32x4*)(O + row * 2816 + col0) = w; }
    }
};
struct EpiResid {
    static constexpr bool PERM = false, AFTER_DRAIN = false;
    const float* xres; float* out; float alpha; const float* st; const float* gam; const float* bet;
    __device__ __forceinline__ void operator()(const f32x4 (&acc)[2][2][4][2], const Unit& u, int wr, int wc, int fr, int fq) const {
        const int row0 = u.pm * BM + wr * 64 + fr, col0 = u.pn * BM + wc * 32 + 4 * fq;
        typedef float f32x2e __attribute__((ext_vector_type(2)));
        f32x4 gv[2][2], bv[2][2];
        if (st) {
#pragma unroll
            for (int bj = 0; bj < 2; ++bj)
#pragma unroll
                for (int n = 0; n < 2; ++n) { gv[bj][n] = *(const f32x4*)(gam + col0 + bj * HALF + n * 16); bv[bj][n] = *(const f32x4*)(bet + col0 + bj * HALF + n * 16); }
        }
#pragma unroll
        for (int ai = 0; ai < 2; ++ai)
#pragma unroll
            for (int m = 0; m < 4; ++m) { const size_t row = (size_t)(row0 + ai * HALF + m * 16); const size_t off = row * 1024 + col0;
                f32x2e sr = {0.f, 1.f}; if (st) sr = *(const f32x2e*)(st + 2 * row);
#pragma unroll
                for (int bj = 0; bj < 2; ++bj)
#pragma unroll
                    for (int n = 0; n < 2; ++n) { f32x4 x = *(const f32x4*)(xres + off + bj * HALF + n * 16);
                        if (st) x = (x - sr.x) * sr.y * gv[bj][n] + bv[bj][n];
                        *(f32x4*)(out + off + bj * HALF + n * 16) = x * alpha + acc[ai][bj][m][n]; }
                if (m & 1) asm volatile("" ::: "memory"); }
    }
};
}
#include <hip/hip_bf16.h>
#include <cmath>
namespace attn_body {
using bf16=__hip_bfloat16;
using bf16x8=__attribute__((ext_vector_type(8)))short;
using s16x4=__attribute__((ext_vector_type(4)))short;
using f32x16=__attribute__((ext_vector_type(16)))float;
using u32x4=__attribute__((ext_vector_type(4)))unsigned;
constexpr int BATCH=2,NHEAD=8,SEQ=16384,D=64,QP=512,KP=512;
constexpr int NW=8,QBLK=32,QB=QBLK*NW,KVBLK=64,NQB=SEQ/QB;
constexpr int ATTN_UNIT_ROWS=QB;
__device__ __forceinline__ int crow(int r,int hi){return (r&3)+8*(r>>2)+4*hi;}
#define SBAR() __builtin_amdgcn_sched_barrier(0)
__device__ __forceinline__ void cmask(f32x16&p0,f32x16&p1,int jb,int qrel,int hi){
  const float NEG=-INFINITY; int kb=64*jb+4*hi;
  #pragma unroll
  for(int r=0;r<16;++r){int kv=kb+(r&3)+8*(r>>2); if(kv>qrel)p0[r]=NEG; if(kv+32>qrel)p1[r]=NEG;}
}

constexpr int NSLOT=3, SLOTB=8192;
constexpr int LDS_K=0, LDS_V=NSLOT*SLOTB, LDS_WS=2*NSLOT*SLOTB, LDS_OST=LDS_WS+NW*64*4, LDS_FB=LDS_OST+NW*4096, LDS_BYTES=LDS_FB+SEQ*4;
constexpr float C2=0.125f*1.4426950408889634f;
__device__ __forceinline__ void glds16(const void*gsrc,unsigned lds_dst){unsigned keep;
  asm volatile("s_mov_b32 %0, m0\n\ts_mov_b32 m0, %2\n\ts_nop 0\n\tglobal_load_lds_dwordx4 %1, off\n\ts_mov_b32 m0, %0":"=&s"(keep):"v"(gsrc),"s"(lds_dst):"memory");}
__device__ __forceinline__ float max3f(float a,float b,float c){float r;asm("v_max3_f32 %0, %1, %2, %3":"=v"(r):"v"(a),"v"(b),"v"(c));return r;}
__device__ __forceinline__ float max2f(float a,float b){float r;asm("v_max_f32_e32 %0, %1, %2":"=v"(r):"v"(a),"v"(b));return r;}
__device__ __forceinline__ float fadd_s(float a,float b){float r;asm("v_add_f32_e32 %0, %1, %2":"=v"(r):"v"(a),"v"(b));return r;}
__device__ __forceinline__ float fsub_s(float a,float b){float r;asm("v_sub_f32_e32 %0, %1, %2":"=v"(r):"v"(a),"v"(b));return r;}
typedef float f32x2_t __attribute__((ext_vector_type(2))); typedef __bf16 bf16x2_t __attribute__((ext_vector_type(2)));
__device__ __forceinline__ unsigned cvtpk_s(float lo,float hi){f32x2_t v={lo,hi};bf16x2_t b=__builtin_convertvector(v,bf16x2_t);return __builtin_bit_cast(unsigned,b);}
#define WAIT_BAR(N) asm volatile("s_waitcnt vmcnt(" #N ") lgkmcnt(0)\n\ts_barrier":::"memory")

__device__ __forceinline__ void qkt(f32x16&p0,f32x16&p1,const char*Kslot,const bf16x8*qr,int r32,int hi){
  const char*kb=Kslot+hi*1024+r32*16;
  #pragma unroll
  for(int d0=0;d0<4;++d0){
    const bf16x8 b0=*reinterpret_cast<const bf16x8*>(kb+d0*2048);
    const bf16x8 b1=*reinterpret_cast<const bf16x8*>(kb+d0*2048+512);
    p0=__builtin_amdgcn_mfma_f32_32x32x16_bf16(b0,qr[d0],p0,0,0,0);p1=__builtin_amdgcn_mfma_f32_32x32x16_bf16(b1,qr[d0],p1,0,0,0);}
}
typedef __attribute__((address_space(3))) const char* lds_cptr;
typedef short v4i16_t __attribute__((ext_vector_type(4)));
__device__ __forceinline__ void kload8(bf16x8*kf,lds_cptr kp){
  kf[0]=*(const __attribute__((address_space(3))) bf16x8*)(kp);      kf[1]=*(const __attribute__((address_space(3))) bf16x8*)(kp+512);
  kf[2]=*(const __attribute__((address_space(3))) bf16x8*)(kp+2048); kf[3]=*(const __attribute__((address_space(3))) bf16x8*)(kp+2560);
  kf[4]=*(const __attribute__((address_space(3))) bf16x8*)(kp+4096); kf[5]=*(const __attribute__((address_space(3))) bf16x8*)(kp+4608);
  kf[6]=*(const __attribute__((address_space(3))) bf16x8*)(kp+6144); kf[7]=*(const __attribute__((address_space(3))) bf16x8*)(kp+6656);
}
__device__ __forceinline__ void kload2(bf16x8*kf,lds_cptr kp,int j){ kf[2*j]=*(const __attribute__((address_space(3))) bf16x8*)(kp+j*2048); kf[2*j+1]=*(const __attribute__((address_space(3))) bf16x8*)(kp+j*2048+512); }
__device__ __forceinline__ s16x4 vtr(lds_cptr p){ return __builtin_bit_cast(s16x4,__builtin_amdgcn_ds_read_tr16_b64_v4i16((__attribute__((address_space(3))) v4i16_t*)p)); }
__device__ __forceinline__ float rowmax(const f32x16&p0,const f32x16&p1){
  float a=max3f(p0[0],p0[1],p1[0]),b=max3f(p0[2],p0[3],p1[1]);a=max3f(a,p1[2],p1[3]);
  #pragma unroll
  for(int r=4;r<16;r+=4){a=max3f(a,p0[r],p0[r+1]);b=max3f(b,p0[r+2],p0[r+3]);a=max3f(a,p1[r],p1[r+1]);b=max3f(b,p1[r+2],p1[r+3]);}
  const float m=max2f(a,b);
  auto rr=__builtin_amdgcn_permlane32_swap(__float_as_uint(m),__float_as_uint(m),false,false);
  return max2f(__uint_as_float(rr[0]),__uint_as_float(rr[1]));
}
__device__ __forceinline__ void pv(f32x16*o,int vb,bf16x8 pa0,bf16x8 pa1,bf16x8 pa2,bf16x8 pa3){
  #pragma unroll
  for(int d0=0;d0<2;++d0){s16x4 lo[4],hi[4];
    #pragma unroll
    for(int ks=0;ks<4;++ks){
      asm volatile("ds_read_b64_tr_b16 %0,%1 offset:%c2":"=&v"(lo[ks]):"v"(vb),"i"(d0*4096+ks*1024):"memory");
      asm volatile("ds_read_b64_tr_b16 %0,%1 offset:%c2":"=&v"(hi[ks]):"v"(vb),"i"(d0*4096+ks*1024+512):"memory");}
    asm volatile("s_waitcnt lgkmcnt(0)":::"memory");SBAR();
    #define PK(k) (bf16x8){lo[k][0],lo[k][1],lo[k][2],lo[k][3],hi[k][0],hi[k][1],hi[k][2],hi[k][3]}
    o[d0]=__builtin_amdgcn_mfma_f32_32x32x16_bf16(pa0,PK(0),o[d0],0,0,0);
    o[d0]=__builtin_amdgcn_mfma_f32_32x32x16_bf16(pa1,PK(1),o[d0],0,0,0);
    o[d0]=__builtin_amdgcn_mfma_f32_32x32x16_bf16(pa2,PK(2),o[d0],0,0,0);
    o[d0]=__builtin_amdgcn_mfma_f32_32x32x16_bf16(pa3,PK(3),o[d0],0,0,0);
    #undef PK
  }
}

#ifndef ATTN_STORE16
#define ATTN_STORE16(p,v) (*(u32x4*)(p)=(v))
#endif
template<int THRL> __device__ __forceinline__ void attn_unit(int b,int h,int qb,const bf16*Q,const bf16*__restrict__ K,const bf16*__restrict__ V,bf16*O,const float*__restrict__ Fg,const unsigned*__restrict__ NB,char*shm){
  int tid_=threadIdx.x; asm volatile("":"+v"(tid_));
  const int tid=tid_,lane=tid&63,r32=lane&31,hi=lane>>5; const int wid=__builtin_amdgcn_readfirstlane(tid>>6);
  const long rowbase=(long)b*SEQ; const int q0=qb*QB;
  const bf16*Qw=Q+(rowbase+q0+wid*QBLK)*QP+h*D;
  const bf16*Kh=K+rowbase*KP+h*D,*Vh=V+rowbase*KP+h*D;
  __attribute__((address_space(3))) char* const shm3w=(__attribute__((address_space(3))) char*)shm;
  const unsigned lds0=(unsigned)(uintptr_t)shm;
  float*wsf=(float*)(shm+LDS_WS)+wid*64;
  const bf16*ksrc_=Kh+(long)lane*KP+wid*8;
  const bf16*vsrc_=Vh+(long)(16*(wid&3)+(lane>>2))*KP+(wid>>2)*32+(lane&3)*8;
  const unsigned kdst=lds0+LDS_K+wid*1024, vdst=lds0+LDS_V+wid*1024;
  #define DMA_K(t,slot) glds16(ksrc+(long)(t)*KVBLK*KP,(unsigned)__builtin_amdgcn_readfirstlane(kdst+(slot)))
  #define DMA_V(t,slot) glds16(vsrc+(long)(t)*KVBLK*KP,(unsigned)__builtin_amdgcn_readfirstlane(vdst+(slot)))
  const int vb0=(int)(lds0+LDS_V)+((lane>>4)&1)*32+(lane&3)*8+(4*hi+((lane&15)>>2))*64;
  const char*Kbase=shm+LDS_K; bf16x8 kf[8];
  const lds_cptr shm3=(lds_cptr)shm; const lds_cptr kp0=shm3+LDS_K+hi*1024+r32*16; const lds_cptr vp0=shm3+LDS_V+((lane>>4)&1)*32+(lane&3)*8+(4*hi+((lane&15)>>2))*64;
  const int NT0=(q0+QB)/KVBLK;
  int j0;
  { typedef __attribute__((address_space(3))) unsigned* lds_uptr; const lds_uptr cnt=(lds_uptr)(shm3w+LDS_BYTES+16);
    const float fref=Fg[q0]; const float Bq=__builtin_sqrtf(__uint_as_float(NB[0])*__uint_as_float(NB[1])); const float thr=-(152.0f+2.0f*Bq);
    if(tid==0)*cnt=0u;
    asm volatile("s_waitcnt lgkmcnt(0)\n\ts_barrier":::"memory");
    bool skip=false; if(tid<NT0-4){ skip=((fref-Fg[64*tid+63])*1.4426950408889634f<thr); }
    const unsigned long long bal=__ballot(skip); if(lane==0&&bal)__hip_atomic_fetch_add(cnt,(unsigned)__popcll(bal),__ATOMIC_RELAXED,__HIP_MEMORY_SCOPE_WORKGROUP);
    asm volatile("s_waitcnt lgkmcnt(0)\n\ts_barrier":::"memory");
    j0=(int)(*cnt)&~1; j0=__builtin_amdgcn_readfirstlane(j0);
    typedef __attribute__((address_space(3))) float* lds_fptr; const lds_fptr fbl=(lds_fptr)(shm3w+LDS_FB);
    for(int i=64*j0+tid;i<q0+QB;i+=NW*64) fbl[i]=(fref-Fg[i])*1.4426950408889634f; }
  const int NT=NT0-j0;
  const bf16*ksrc=ksrc_+(long)j0*KVBLK*KP; const bf16*vsrc=vsrc_+(long)j0*KVBLK*KP;
  DMA_K(0,0);DMA_V(0,0);DMA_K(1,SLOTB);
  bf16x8 qr[4];
  #pragma unroll
  for(int d0=0;d0<4;++d0)qr[d0]=*reinterpret_cast<const bf16x8*>(&Qw[(long)r32*QP+d0*16+hi*8]);
  float mhat=0.f,l_reg=0.f;f32x16 o[2];o[0]=f32x16{};o[1]=f32x16{};
  const lds_cptr fb0=(lds_cptr)shm3w+LDS_FB+hi*16+j0*256;
  typedef float f32x4v __attribute__((ext_vector_type(4)));
  #define BLD(P0,P1,t) do{ const lds_cptr fp_=fb0+(t)*256; _Pragma("unroll") for(int j_=0;j_<4;++j_){ \
      const f32x4v a_=*(const __attribute__((address_space(3))) f32x4v*)(fp_+j_*32), b_=*(const __attribute__((address_space(3))) f32x4v*)(fp_+128+j_*32); \
      P0[4*j_]=a_[0];P0[4*j_+1]=a_[1];P0[4*j_+2]=a_[2];P0[4*j_+3]=a_[3]; P1[4*j_]=b_[0];P1[4*j_+1]=b_[1];P1[4*j_+2]=b_[2];P1[4*j_+3]=b_[3]; } }while(0)
  const int qrel=wid*QBLK+r32;
  #define CMASK(P0,P1,t) do{int jb_=(t)-(NT-4); if(jb_>=0)cmask(P0,P1,jb_,qrel,hi);}while(0)
  bool resc=false;
  #define START(P0,P1) do{ const float rm=rowmax(P0,P1); resc=false; mhat=rm; \
    _Pragma("unroll") for(int r=0;r<16;++r)P0[r]=__builtin_amdgcn_exp2f(P0[r]-mhat); }while(0)
  #define RESC() do{ if(resc){ asm volatile("s_waitcnt lgkmcnt(0)":::"memory"); \
      _Pragma("unroll") for(int d_=0;d_<2;++d_) _Pragma("unroll") for(int r=0;r<16;++r)o[d_][r]*=wsf[crow(r,hi)]; } }while(0)
  f32x16 pA0,pA1,pB0,pB1;
  int sl_prev=0,sl_cur=0,sl_next=SLOTB;
  #define ROT() do{sl_prev=sl_cur;sl_cur=sl_next;sl_next=(sl_next==(NSLOT-1)*SLOTB)?0:sl_next+SLOTB;}while(0)
  DMA_K(2,2*SLOTB);
  WAIT_BAR(3);
  BLD(pA0,pA1,0);
  qkt(pA0,pA1,Kbase,qr,r32,hi);asm volatile("s_nop 15\n\ts_nop 7":"+v"(pA0),"+v"(pA1));CMASK(pA0,pA1,0);
  START(pA0,pA1);
  _Pragma("unroll") for(int r=0;r<16;++r)pA1[r]=__builtin_amdgcn_exp2f(pA1[r]-mhat);
  WAIT_BAR(0);
  DMA_K(3,0);DMA_V(1,SLOTB);
  ROT();
  kload8(kf,kp0+sl_cur);
  BLD(pB0,pB1,1);
  WAIT_BAR(2);
  s16x4 vlo[8],vhi[8]; u32x4 pw0,pw1,pw2,pw3;
  #define PKW(P,B) cvtpk_s(P[B],P[B+1])
  #define PAF(k) __builtin_bit_cast(bf16x8,pw##k)
  #define VFR(i) (bf16x8){vlo[i][0],vlo[i][1],vlo[i][2],vlo[i][3],vhi[i][0],vhi[i][1],vhi[i][2],vhi[i][3]}
  #define PIN(x) asm volatile("":"+v"(x))
  #define MX3(a,b,c) __builtin_fmaxf(__builtin_fmaxf((a),(b)),(c))
  #define GAPA(MF,A0,A1,A2,A3,W0,W1,PW) do{ MF; sacc+=A0; sacc+=A1; sacc+=A2; sacc+=A3; PIN(sacc); W0; W1; PIN(PW); SBAR(); }while(0)
  #define EX(v) __builtin_amdgcn_exp2f(v)
  #define GAPB(MF,X,B) do{ MF; X[B]=EX(X[B]-mhat); X[B+1]=EX(X[B+1]-mhat); X[B+2]=EX(X[B+2]-mhat); X[B+3]=EX(X[B+3]-mhat); PIN(X); SBAR(); }while(0)
  #define VRD(i) do{ vlo[i]=vtr(vp_+(((i)>>2)*4096+((i)&3)*1024)); vhi[i]=vtr(vp_+(((i)>>2)*4096+((i)&3)*1024+512)); }while(0)
  #define KRD(G,j) do{ if(G){ kload2(kf,kp0+sl_next,j); SBAR(); } }while(0)
  #define STEP(C0,C1,P0,P1,t,GK,GV,GL) do{ SBAR(); \
    const lds_cptr vp_=vp0+sl_prev; \
    VRD(0); SBAR(); float sacc=(P0[0]+P0[1]); \
    GAPA(C0=__builtin_amdgcn_mfma_f32_32x32x16_bf16(kf[0],qr[0],C0,0,0,0), P0[2],P0[3],P0[4],P0[5],     pw0[0]=PKW(P0,0), pw0[1]=PKW(P0,2), pw0); \
    VRD(4); SBAR(); GAPA(C1=__builtin_amdgcn_mfma_f32_32x32x16_bf16(kf[1],qr[0],C1,0,0,0), P0[6],P0[7],P0[8],P0[9],     pw0[2]=PKW(P0,4), pw0[3]=PKW(P0,6), pw0); \
    VRD(1); SBAR(); GAPA(C0=__builtin_amdgcn_mfma_f32_32x32x16_bf16(kf[2],qr[1],C0,0,0,0),   P0[10],P0[11],P0[12],P0[13], pw1[0]=PKW(P0,8), pw1[1]=PKW(P0,10), pw1); \
    VRD(5); SBAR(); GAPA(C1=__builtin_amdgcn_mfma_f32_32x32x16_bf16(kf[3],qr[1],C1,0,0,0),   P0[14],P0[15],P1[0],P1[1],   pw1[2]=PKW(P0,12),pw1[3]=PKW(P0,14), pw1); \
    VRD(2); SBAR(); GAPA(C0=__builtin_amdgcn_mfma_f32_32x32x16_bf16(kf[4],qr[2],C0,0,0,0),   P1[2],P1[3],P1[4],P1[5],     pw2[0]=PKW(P1,0), pw2[1]=PKW(P1,2), pw2); \
    VRD(6); SBAR(); GAPA(C1=__builtin_amdgcn_mfma_f32_32x32x16_bf16(kf[5],qr[2],C1,0,0,0),   P1[6],P1[7],P1[8],P1[9],     pw2[2]=PKW(P1,4), pw2[3]=PKW(P1,6), pw2); \
    VRD(3); SBAR(); GAPA(C0=__builtin_amdgcn_mfma_f32_32x32x16_bf16(kf[6],qr[3],C0,0,0,0),   P1[10],P1[11],P1[12],P1[13], pw3[0]=PKW(P1,8), pw3[1]=PKW(P1,10), pw3); \
    VRD(7); SBAR(); GAPA(C1=__builtin_amdgcn_mfma_f32_32x32x16_bf16(kf[7],qr[3],C1,0,0,0),   P1[14],P1[15],0.f,0.f,       pw3[2]=PKW(P1,12),pw3[3]=PKW(P1,14), pw3); \
    l_reg+=sacc; \
    if(GK){DMA_K((t)+3,sl_cur);} if(GV){DMA_V((t)+1,sl_next);} \
    CMASK(C0,C1,t); \
    { float a=MX3(C0[0],C0[1],C1[0]),b=MX3(C0[2],C0[3],C1[1]); a=MX3(a,C1[2],C1[3]); \
      _Pragma("unroll") for(int r=4;r<16;r+=4){a=MX3(a,C0[r],C0[r+1]);b=MX3(b,C0[r+2],C0[r+3]);a=MX3(a,C1[r],C1[r+1]);b=MX3(b,C1[r+2],C1[r+3]);} \
      float rm=__builtin_fmaxf(a,b); { auto rr=__builtin_amdgcn_permlane32_swap(__float_as_uint(rm),__float_as_uint(rm),false,false); rm=__builtin_fmaxf(__uint_as_float(rr[0]),__uint_as_float(rr[1])); } \
      rm-=mhat; resc=false; \
      if(__builtin_expect(__any(rm>(float)THRL),0)){ const float dl=__builtin_fmaxf(rm,0.f); mhat+=dl; \
        const float f=__builtin_amdgcn_exp2f(-dl); l_reg*=f; if(hi==0)wsf[r32]=f; resc=true; } } \
    SBAR(); if(GL){ BLD(P0,P1,(t)+1); } \
    SBAR(); \
    GAPB(o[0]=__builtin_amdgcn_mfma_f32_32x32x16_bf16(PAF(0),VFR(0),o[0],0,0,0), C0,0); \
    GAPB(o[1]=__builtin_amdgcn_mfma_f32_32x32x16_bf16(PAF(0),VFR(4),o[1],0,0,0), C0,4); \
    KRD(GL,0); GAPB(o[0]=__builtin_amdgcn_mfma_f32_32x32x16_bf16(PAF(1),VFR(1),o[0],0,0,0), C0,8); \
    KRD(GL,1); GAPB(o[1]=__builtin_amdgcn_mfma_f32_32x32x16_bf16(PAF(1),VFR(5),o[1],0,0,0), C0,12); \
    KRD(GL,2); GAPB(o[0]=__builtin_amdgcn_mfma_f32_32x32x16_bf16(PAF(2),VFR(2),o[0],0,0,0), C1,0); \
    KRD(GL,3); GAPB(o[1]=__builtin_amdgcn_mfma_f32_32x32x16_bf16(PAF(2),VFR(6),o[1],0,0,0), C1,4); \
    GAPB(o[0]=__builtin_amdgcn_mfma_f32_32x32x16_bf16(PAF(3),VFR(3),o[0],0,0,0), C1,8); \
    GAPB(o[1]=__builtin_amdgcn_mfma_f32_32x32x16_bf16(PAF(3),VFR(7),o[1],0,0,0), C1,12); \
    }while(0)
  int t=1;
  #undef CMASK
  #define CMASK(P0,P1,t) do{}while(0)
  for(;t+5<NT;t+=2){
    STEP(pB0,pB1,pA0,pA1,t,true,true,true);     WAIT_BAR(2); RESC(); ROT();
    STEP(pA0,pA1,pB0,pB1,t+1,true,true,true);   WAIT_BAR(2); RESC(); ROT();
  }
  #undef CMASK
  #define CMASK(P0,P1,t) do{int jb_=(t)-(NT-4); if(jb_>=0)cmask(P0,P1,jb_,qrel,hi);}while(0)
  #define ENDW(tt) do{ if((tt)+3<NT){WAIT_BAR(2);} else if((tt)+2<NT){WAIT_BAR(1);} else {WAIT_BAR(0);} }while(0)
  for(;t+1<NT;t+=2){
    STEP(pB0,pB1,pA0,pA1,t,(t+3<NT),(t+1<NT),(t+1<NT));       ENDW(t);   RESC(); ROT();
    STEP(pA0,pA1,pB0,pB1,t+1,(t+4<NT),(t+2<NT),(t+2<NT));     ENDW(t+1); RESC(); ROT();
  }
  STEP(pB0,pB1,pA0,pA1,NT-1,false,false,false); RESC();
  { float sacc=pB0[0]+pB0[1]; _Pragma("unroll") for(int r=2;r<16;++r)sacc+=pB0[r]; _Pragma("unroll") for(int r=0;r<16;++r)sacc+=pB1[r]; l_reg+=sacc;
    pw0=(u32x4){PKW(pB0,0),PKW(pB0,2),PKW(pB0,4),PKW(pB0,6)};pw1=(u32x4){PKW(pB0,8),PKW(pB0,10),PKW(pB0,12),PKW(pB0,14)};pw2=(u32x4){PKW(pB1,0),PKW(pB1,2),PKW(pB1,4),PKW(pB1,6)};pw3=(u32x4){PKW(pB1,8),PKW(pB1,10),PKW(pB1,12),PKW(pB1,14)};
    SBAR(); pv(o,vb0+sl_cur,PAF(0),PAF(1),PAF(2),PAF(3)); }
  #undef PKW
  #undef PAF
  #undef VFR
  #undef PIN
  #undef MX3
  #undef GAPA
  #undef GAPB
  #undef EX
  #undef VRD
  #undef KRD
  #undef STEP
  #undef ENDW
  {auto rr=__builtin_amdgcn_permlane32_swap(__float_as_uint(l_reg),__float_as_uint(l_reg),false,false);l_reg=__uint_as_float(rr[0])+__uint_as_float(rr[1]);}
  if(hi==0)wsf[32+r32]=l_reg;asm volatile("s_waitcnt lgkmcnt(0)":::"memory");
  float rli[16];
  #pragma unroll
  for(int r=0;r<16;++r)rli[r]=__builtin_amdgcn_rcpf(wsf[32+crow(r,hi)]);
  bf16*Ow=O+(rowbase+q0+wid*QBLK)*QP+h*D;
  { bf16*stg=(bf16*)(shm+LDS_OST)+wid*2048;
    #pragma unroll
    for(int r=0;r<16;++r){const int orow=crow(r,hi);
      #pragma unroll
      for(int d0=0;d0<2;++d0)stg[orow*64+d0*32+r32]=__float2bfloat16(o[d0][r]*rli[r]);}
    asm volatile("s_waitcnt lgkmcnt(0)":::"memory");
    #pragma unroll
    for(int i=0;i<4;++i){const int row=i*8+(lane>>3),ch=lane&7; const u32x4 v=*(const u32x4*)(stg+row*64+ch*8); ATTN_STORE16(Ow+(long)row*QP+ch*8,v);} }
  asm volatile("s_waitcnt lgkmcnt(0)\n\ts_barrier":::"memory");
  #undef DMA_K
  #undef DMA_V
  #undef CMASK
  #undef START
  #undef RESC
  #undef BLD
  #undef ROT
}
constexpr int ATTN_LDS_BYTES=LDS_BYTES;
struct AttnTensors { const bf16* Q; const bf16* K; const bf16* V; bf16* O; const float* F; const unsigned* NB; };
struct AttnUnit { int bh; int qb; };
struct DynOrder {
  unsigned* ctr; volatile __attribute__((address_space(3))) unsigned* slot;
  __device__ __forceinline__ bool next(int,AttnUnit&u)const{
    if(threadIdx.x==0)*slot=__hip_atomic_fetch_add(ctr,1u,__ATOMIC_RELAXED,__HIP_MEMORY_SCOPE_AGENT);
    asm volatile("s_waitcnt vmcnt(0) lgkmcnt(0)\n\ts_barrier":::"memory");
    const unsigned n=*slot; if(n>=1024u)return false; u.qb=63-(int)(n>>4); u.bh=(int)(n&15u); return true; }
  __device__ __forceinline__ void a_ready(const AttnUnit&)const{}
  __device__ __forceinline__ void done(const AttnUnit&)const{}
};
template<class Sched,int THRL=8> __device__ __forceinline__ void attn_phase(char*lds,const AttnTensors&T,const Sched&S){
  AttnUnit u;
  for(int i=0;S.next(i,u);++i){ S.a_ready(u); attn_unit<THRL>(u.bh/NHEAD,u.bh%NHEAD,u.qb,T.Q,T.K,T.V,T.O,T.F+(long)u.bh*SEQ,T.NB+2*u.bh,lds); S.done(u); }
}
#undef SBAR
#undef WAIT_BAR
}
#include <hip/hip_cooperative_groups.h>
namespace cg = cooperative_groups;
#define LAS __attribute__((address_space(3)))
typedef unsigned short bf16;
typedef unsigned v4u __attribute__((ext_vector_type(4)));
typedef float f32x4 __attribute__((ext_vector_type(4)));
typedef short bf16x8 __attribute__((ext_vector_type(8)));
typedef LAS unsigned char* lp;

#define XB_TMO      128
#define XB_XCNT(j)  (256  + 64 * (j))
#define XB_XSUB(j)  (1280 + 64 * (j))
#define XB_XGEN(j)  (2304 + 64 * (j))
#define XB_TOP      3328
#define XB_TOPGEN   3392
#define XCD_BAR_WORDS 3456
#define XB_SPIN_CAP (1u << 18)

__device__ __forceinline__ unsigned xb_ld(unsigned* p)              { return __hip_atomic_load(p, __ATOMIC_RELAXED, __HIP_MEMORY_SCOPE_AGENT); }
__device__ __forceinline__ unsigned xb_add(unsigned* p, unsigned v) { return __hip_atomic_fetch_add(p, v, __ATOMIC_RELAXED, __HIP_MEMORY_SCOPE_AGENT); }
__device__ __forceinline__ unsigned xb_xcc_id() { return (unsigned)__builtin_amdgcn_s_getreg((3 << 11) | 20) & 0xFu; }
#define XB_SPIN(cond, bar) do { unsigned _sp = 0; while (cond) { __builtin_amdgcn_s_sleep(1); \
    if ((++_sp & 255u) == 0u) { if (xb_ld(&(bar)[XB_TMO])) break; if (_sp > XB_SPIN_CAP) { atomicAdd(&(bar)[XB_TMO], 1u); break; } } } } while (0)

struct XcdBarrier {
    unsigned* bar; unsigned x;
    volatile LAS unsigned* st;
};

__device__ __forceinline__ XcdBarrier xcd_barrier_post(unsigned* bar, volatile LAS unsigned* st) {
    XcdBarrier b; b.bar = bar; b.x = xb_xcc_id(); b.st = st;
    if (threadIdx.x == 0) (void)xb_add(&bar[XB_XCNT(b.x)], 1u);
    return b;
}
__device__ __forceinline__ void xcd_barrier_complete(unsigned* bar, unsigned x, unsigned& nloc, unsigned& nx) {
    const unsigned G = gridDim.x * gridDim.y * gridDim.z;
    unsigned sum, cnt, mine, sp = 0u;
    for (;;) {
        sum = 0u; cnt = 0u; mine = 0u;
#pragma unroll
        for (unsigned j = 0; j < 16; ++j) { const unsigned c = xb_ld(&bar[XB_XCNT(j)]); sum += c; cnt += (c > 0u) ? 1u : 0u; mine = (j == x) ? c : mine; }
        if (sum == G) break;
        __builtin_amdgcn_s_sleep(1);
        if ((++sp & 255u) == 0u) { if (xb_ld(&bar[XB_TMO])) break; if (sp > XB_SPIN_CAP) { atomicAdd(&bar[XB_TMO], 1u); break; } }
    }
    nloc = mine > 0u ? mine : 1u; nx = cnt > 0u ? cnt : 1u;
}

__device__ __forceinline__ void xcd_barrier(const XcdBarrier& b) {
    asm volatile("s_waitcnt vmcnt(0)" ::: "memory");
    __syncthreads();
    if (threadIdx.x == 0) {
        unsigned* bar = b.bar;
        __builtin_amdgcn_s_waitcnt(0);
        unsigned nloc = b.st[0], nx = b.st[1];
        if (nloc == 0u) { xcd_barrier_complete(bar, b.x, nloc, nx); b.st[0] = nloc; b.st[1] = nx; }
        const unsigned old = xb_add(&bar[XB_XSUB(b.x)], 1u);
        const unsigned gen = old / nloc;
        if (old + 1u == (gen + 1u) * nloc) {
            __builtin_amdgcn_fence(__ATOMIC_RELEASE, "agent");
            asm volatile("s_waitcnt vmcnt(0)" ::: "memory");
            const unsigned og = xb_add(&bar[XB_TOP], 1u);
            const unsigned tg = og / nx;
            if (og + 1u == (tg + 1u) * nx) xb_add(&bar[XB_TOPGEN], 1u);
            else XB_SPIN(xb_ld(&bar[XB_TOPGEN]) == tg, bar);
            __builtin_amdgcn_fence(__ATOMIC_ACQUIRE, "agent");
            xb_add(&bar[XB_XGEN(b.x)], 1u);
            asm volatile("s_waitcnt vmcnt(0)" ::: "memory");
        } else {
            XB_SPIN(xb_ld(&bar[XB_XGEN(b.x)]) == gen, bar);
            __builtin_amdgcn_fence(__ATOMIC_ACQUIRE, "agent");
            asm volatile("s_waitcnt vmcnt(0)" ::: "memory");
        }
    }
    __syncthreads();
}


constexpr int NWAVES = 8, NTHR = 512;
constexpr int BATCH = 2, SEQ = 16384, D = 1024, M = BATCH * SEQ, DEPTH = 2;
constexpr int NIN = 5640, NP1 = 3584, NG = 2048, FFH = 2816, NF1 = 5632;
constexpr float ALPHA = 1.4142135623730951f;
constexpr float LN_EPS = 1e-5f, RMS_EPS = 1e-6f;
constexpr size_t MiB = 1u << 20;
constexpr size_t WL_IN = 0, WL_G = 7 * MiB, WL_M = 11 * MiB, WL_O = 15 * MiB, WL_F1 = 17 * MiB, WL_F2 = 28 * MiB, WL_STRIDE = 34 * MiB;
constexpr size_t WS_W = 0, WS_XN = 68 * MiB, WS_QA = 132 * MiB, WS_QB = 164 * MiB, WS_KA = 196 * MiB, WS_VA = 228 * MiB, WS_G = 260 * MiB, WS_IB = 324 * MiB, WS_GB = 356 * MiB,
                 WS_ST = 388 * MiB, WS_DEC = 452 * MiB, WS_LF = 453 * MiB, WS_F = 454 * MiB, WS_CTL = 455 * MiB  , WS_DBG = 455 * MiB + 512 * 1024, WS_END = 456 * MiB;
constexpr size_t WS_GATES = WS_G  , WS_MERGED = WS_KA  , WS_H = WS_QA  ;
constexpr size_t CTL_QCTR = 16384  , CTL_PCTR = 18432  , CTL_STATS = 131072  , CTL_NORM = 20480  ;
constexpr int LDS_TOTAL = 155648;
static_assert(attn_body::LDS_BYTES <= LDS_TOTAL && pg8::STAGE_BYTES <= LDS_TOTAL, "LDS map");

__device__ __forceinline__ float wave_sum(float v) {
#pragma unroll
    for (int o = 1; o < 64; o <<= 1) v += __shfl_xor(v, o);
    return v;
}
__device__ __forceinline__ unsigned pk2(float lo, float hi) { return pg8::cvt_pk_bf16(lo, hi); }
__device__ __forceinline__ float bf2f(unsigned short h) { return __uint_as_float((unsigned)h << 16); }

__device__ __forceinline__ void transpose_item(const float* Wsrc, int pitch, bf16* WTdst, int Kdst, LAS float* scr, int lane, bool zero) {
    if (!zero) {
#pragma unroll
        for (int i = 0; i < 32; ++i) { const int kk = 2 * i + (lane >> 5); scr[kk * 33 + (lane & 31)] = Wsrc[(size_t)kk * pitch + (lane & 31)]; }
    }
    asm volatile("s_waitcnt lgkmcnt(0)" ::: "memory");
    const int c = lane & 7;
#pragma unroll
    for (int j = 0; j < 4; ++j) { const int n = (lane >> 3) + 8 * j; const LAS float* s = scr + (8 * c) * 33 + n;
        v4u o;
        if (zero) { o = (v4u){0u, 0u, 0u, 0u}; }
        else { o.x = pk2(s[0 * 33], s[1 * 33]); o.y = pk2(s[2 * 33], s[3 * 33]); o.z = pk2(s[4 * 33], s[5 * 33]); o.w = pk2(s[6 * 33], s[7 * 33]); }
        *(v4u*)(WTdst + (size_t)n * Kdst + 8 * c) = o; }
    asm volatile("s_waitcnt lgkmcnt(0)" ::: "memory");
}

struct Ptrs {
    const float *x, *w_in, *b_fgate, *lb_logits, *norm_g, *w_pa, *w_pb, *w_o, *ln1_g, *ln1_b, *w_ff_in, *w_ff_out, *ln2_g, *ln2_b;
    float* out; unsigned char* ws;
};

__device__ __forceinline__ void weight_items(const Ptrs& P, LAS float* scr, int gw, int NGW, int lane) {
    constexpr int I_IN = 16 * (NP1 / 32), I_G = 16 * (NG / 32), I_M = 2 * 8 * 32, I_O = 16 * 32, I_F1 = 16 * (NF1 / 32), I_F2 = (FFH / 64) * 32;
    constexpr int PER_LAYER = I_IN + I_G + I_M + I_O + I_F1 + I_F2;
    for (int it = gw; it < DEPTH * PER_LAYER; it += NGW) {
        const int l = it / PER_LAYER; int r = it % PER_LAYER;
        bf16* WB = (bf16*)(P.ws + WS_W + (size_t)l * WL_STRIDE);
        if (r < I_IN) { const int nblk = NP1 / 32, kb = r / nblk, nb = r % nblk, k0 = 64 * kb, n0 = 32 * nb; const int sc = n0 < 1536 ? n0 : n0 + 8;
            transpose_item(P.w_in + (size_t)l * D * NIN + (size_t)k0 * NIN + sc, NIN, (bf16*)((unsigned char*)WB + WL_IN) + (size_t)n0 * 1024 + k0, 1024, scr, lane, false); continue; } r -= I_IN;
        if (r < I_G) { const int nblk = NG / 32, kb = r / nblk, nb = r % nblk, k0 = 64 * kb, n0 = 32 * nb;
            transpose_item(P.w_in + (size_t)l * D * NIN + (size_t)k0 * NIN + 3592 + n0, NIN, (bf16*)((unsigned char*)WB + WL_G) + (size_t)n0 * 1024 + k0, 1024, scr, lane, false); continue; } r -= I_G;
        if (r < I_M) { const int which = r >> 8, rr = r & 255, kb = rr >> 5, nb = rr & 31, k0 = 64 * kb, n0 = 32 * nb;
            const float* src = (which ? P.w_pb : P.w_pa) + (size_t)l * 512 * 1024 + (size_t)k0 * 1024 + n0;
            transpose_item(src, 1024, (bf16*)((unsigned char*)WB + WL_M + (size_t)which * MiB) + (size_t)n0 * 512 + k0, 512, scr, lane, false); continue; } r -= I_M;
        if (r < I_O) { const int nblk = 32, kb = r / nblk, nb = r % nblk, k0 = 64 * kb, n0 = 32 * nb;
            transpose_item(P.w_o + (size_t)l * 1024 * 1024 + (size_t)k0 * 1024 + n0, 1024, (bf16*)((unsigned char*)WB + WL_O) + (size_t)n0 * 1024 + k0, 1024, scr, lane, false); continue; } r -= I_O;
        if (r < I_F1) { const int nblk = NF1 / 32, kb = r / nblk, nb = r % nblk, k0 = 64 * kb, n0 = 32 * nb; const int tile = n0 >> 8, half = (n0 >> 7) & 1, col = half * FFH + 128 * tile + (n0 & 127);
            transpose_item(P.w_ff_in + (size_t)l * D * NF1 + (size_t)k0 * NF1 + col, NF1, (bf16*)((unsigned char*)WB + WL_F1) + (size_t)n0 * 1024 + k0, 1024, scr, lane, false); continue; } r -= I_F1;
        { const int nblk = 32, kb = r / nblk, nb = r % nblk, k0 = 64 * kb, n0 = 32 * nb;
            transpose_item(P.w_ff_out + (size_t)l * FFH * 1024 + (size_t)k0 * 1024 + n0, 1024, (bf16*)((unsigned char*)WB + WL_F2) + (size_t)n0 * FFH + k0, FFH, scr, lane, false); }
    }
}

__device__ __forceinline__ void stage_wfa(const float* w_in_l, LAS float* wfa, int tid) {
    for (int idx = tid; idx < 8192; idx += NTHR) { const int k = idx >> 3, col = idx & 7; const int j = k >> 8, ln = (k >> 2) & 63, i = k & 3, half = col >> 2, c = col & 3;
        wfa[((((j * 4 + i) * 2 + half) * 64) + ln) * 4 + c] = w_in_l[(size_t)k * NIN + 1536 + col]; }
}
template <bool DO_LN, bool W32, bool WBF, bool DO_FA>
__device__ __forceinline__ void row_pass(const float* src, float* dst32, bf16* dstbf, const float* gam, const float* bet, float* lf, const LAS float* wfa, const float* bfg, int gw, int NGW, int lane, float* stats = nullptr) {
    constexpr int R = 4;
    f32x4 gv[4], bv[4];
    if (DO_LN) {
#pragma unroll
        for (int j = 0; j < 4; ++j) { gv[j] = ((const f32x4*)gam)[64 * j + lane]; bv[j] = ((const f32x4*)bet)[64 * j + lane]; }
    }
    for (int m0 = gw; m0 < M; m0 += R * NGW) {
        f32x4 v[R][4]; int mr[R]; bool ok[R];
#pragma unroll
        for (int r = 0; r < R; ++r) { const int m = m0 + r * NGW; ok[r] = m < M; mr[r] = ok[r] ? m : m0; const f32x4* xr = (const f32x4*)(src + (size_t)mr[r] * D) + lane;
#pragma unroll
            for (int j = 0; j < 4; ++j) v[r][j] = xr[64 * j]; }
        if (DO_LN) {
            float s[R], s2[R], mean[R], rstd[R];
#pragma unroll
            for (int r = 0; r < R; ++r) { s[r] = 0.f;
#pragma unroll
                for (int j = 0; j < 4; ++j) s[r] += (v[r][j].x + v[r][j].y) + (v[r][j].z + v[r][j].w); }
#pragma unroll
            for (int o = 1; o < 64; o <<= 1)
#pragma unroll
                for (int r = 0; r < R; ++r) s[r] += __shfl_xor(s[r], o);
#pragma unroll
            for (int r = 0; r < R; ++r) { mean[r] = s[r] * (1.f / D); s2[r] = 0.f;
#pragma unroll
                for (int j = 0; j < 4; ++j) { v[r][j] = v[r][j] - mean[r]; s2[r] += (v[r][j].x * v[r][j].x + v[r][j].y * v[r][j].y) + (v[r][j].z * v[r][j].z + v[r][j].w * v[r][j].w); } }
#pragma unroll
            for (int o = 1; o < 64; o <<= 1)
#pragma unroll
                for (int r = 0; r < R; ++r) s2[r] += __shfl_xor(s2[r], o);
#pragma unroll
            for (int r = 0; r < R; ++r) { rstd[r] = 1.f / sqrtf(s2[r] * (1.f / D) + LN_EPS);
                if (stats && lane == 0 && ok[r]) { stats[2 * (size_t)mr[r]] = mean[r]; stats[2 * (size_t)mr[r] + 1] = rstd[r]; }
#pragma unroll
                for (int j = 0; j < 4; ++j) v[r][j] = v[r][j] * rstd[r] * gv[j] + bv[j]; }
        }
#pragma unroll
        for (int r = 0; r < R; ++r) { if (!ok[r]) continue; const int m = mr[r];
            if (W32) { f32x4* o = (f32x4*)(dst32 + (size_t)m * D) + lane;
#pragma unroll
                for (int j = 0; j < 4; ++j) o[64 * j] = v[r][j]; }
            if (WBF) { unsigned long long* o8 = (unsigned long long*)(dstbf + (size_t)m * D) + lane;
#pragma unroll
                for (int j = 0; j < 4; ++j) o8[64 * j] = (unsigned long long)pk2(v[r][j].x, v[r][j].y) | ((unsigned long long)pk2(v[r][j].z, v[r][j].w) << 32); } }
        if (DO_FA) {
            float a[R][8];
#pragma unroll
            for (int r = 0; r < R; ++r)
#pragma unroll
                for (int c = 0; c < 8; ++c) a[r][c] = 0.f;
#pragma unroll
            for (int j = 0; j < 4; ++j)
#pragma unroll
                for (int i = 0; i < 4; ++i) {
                    const f32x4 w0 = *(const LAS f32x4*)(wfa + ((((j * 4 + i) * 2 + 0) * 64) + lane) * 4), w1 = *(const LAS f32x4*)(wfa + ((((j * 4 + i) * 2 + 1) * 64) + lane) * 4);
#pragma unroll
                    for (int r = 0; r < R; ++r) { const float xv = v[r][j][i];
                        a[r][0] += xv * w0.x; a[r][1] += xv * w0.y; a[r][2] += xv * w0.z; a[r][3] += xv * w0.w; a[r][4] += xv * w1.x; a[r][5] += xv * w1.y; a[r][6] += xv * w1.z; a[r][7] += xv * w1.w; } }
#pragma unroll
            for (int o = 1; o < 64; o <<= 1)
#pragma unroll
                for (int r = 0; r < R; ++r)
#pragma unroll
                    for (int c = 0; c < 8; ++c) a[r][c] += __shfl_xor(a[r][c], o);
#pragma unroll
            for (int r = 0; r < R; ++r) { float z = a[r][0];
#pragma unroll
                for (int c = 1; c < 8; ++c) z = (lane == c) ? a[r][c] : z;
                if (lane < 8 && ok[r]) { z += bfg[lane]; const float ls = fminf(z, 0.f) - __logf(1.0f + __expf(-fabsf(z))); lf[(size_t)mr[r] * 8 + lane] = ls; } }
        }
    }
}

__device__ __forceinline__ void fcumsum_unit(int bh, const float* LF, float* F, lp lds, int tid) {
    const int b = bh >> 3, h = bh & 7, lane = tid & 63, wave = tid >> 6;
    const float* src = LF + ((size_t)b * SEQ + (size_t)tid * 32) * 8 + h;
    float cs[32]; float run = 0.f;
#pragma unroll
    for (int i = 0; i < 32; ++i) { run += src[i * 8]; cs[i] = run; }
    float inc = run;
#pragma unroll
    for (int o = 1; o < 64; o <<= 1) { const float n = __shfl_up(inc, o); if (lane >= o) inc += n; }
    LAS float* WS = (LAS float*)lds;
    if (lane == 63) WS[wave] = inc;
    __syncthreads();
    float woff = 0.f;
    for (int w = 0; w < wave; ++w) woff += WS[w];
    const float excl = woff + inc - run;
    float* dst = F + (size_t)bh * SEQ + (size_t)tid * 32;
#pragma unroll
    for (int i = 0; i < 32; i += 4) *(f32x4*)(dst + i) = (f32x4){excl + cs[i], excl + cs[i + 1], excl + cs[i + 2], excl + cs[i + 3]};
    __syncthreads();
}

__device__ __forceinline__ void norm_unit(int v, const bf16* QA, const bf16* KA, unsigned* NB, int tid) {
    const int bh = v >> 4, seg = v & 15, b = bh >> 3, h = bh & 7, lane = tid & 63;
    float mq = 0.f, mk = 0.f;
#pragma unroll
    for (int e = 0; e < 2; ++e) { const size_t row = (size_t)b * SEQ + seg * 1024 + tid * 2 + e;
        const v4u* qp = (const v4u*)(QA + row * 512 + h * 64); const v4u* kp = (const v4u*)(KA + row * 512 + h * 64); float sq = 0.f, sk = 0.f;
#pragma unroll
        for (int i = 0; i < 8; ++i) { const v4u a = qp[i], c = kp[i];
#pragma unroll
            for (int k = 0; k < 4; ++k) { const float a0 = __uint_as_float(a[k] << 16), a1 = __uint_as_float(a[k] & 0xffff0000u), c0 = __uint_as_float(c[k] << 16), c1 = __uint_as_float(c[k] & 0xffff0000u);
                sq += a0 * a0 + a1 * a1; sk += c0 * c0 + c1 * c1; } }
        mq = fmaxf(mq, sq); mk = fmaxf(mk, sk); }
#pragma unroll
    for (int o = 1; o < 64; o <<= 1) { mq = fmaxf(mq, __shfl_xor(mq, o)); mk = fmaxf(mk, __shfl_xor(mk, o)); }
    if (lane == 0) { atomicMax(NB + 2 * bh, __float_as_uint(mq * 1.01f)); atomicMax(NB + 2 * bh + 1, __float_as_uint(mk * 1.01f)); }
}

namespace hg {
constexpr int P128 = 136, P64 = 72;
constexpr int O_QP = 0, O_QPP = O_QP + 64 * P128 * 2, O_KP = O_QPP + 64 * P128 * 2, O_VT = O_KP + 64 * P128 * 2, O_ST = O_VT + 128 * P64 * 2, O_PM = O_ST + 128 * P128 * 2,
              O_PT = O_PM + 64 * P64 * 2, O_RS = O_PT + 2048, O_END = O_RS + 512;
constexpr int O_KDT = O_QP;
static_assert(O_END <= 131072 && 128 * P64 * 2 <= 2 * 64 * P128 * 2, "hgrn LDS map");

__device__ __forceinline__ void load_cumsum(const float* Gu, int d, int part, lp lds, float (&g)[16], float (&b)[16], float& bmid, float& blast) {
#pragma unroll
    for (int i = 0; i < 16; ++i) g[i] = Gu[(size_t)(part * 16 + i) * 512 + d];
    float run = 0.f;
#pragma unroll
    for (int i = 0; i < 16; ++i) { run += g[i]; b[i] = run; }
    LAS float* PT = (LAS float*)(lds + O_PT);
    PT[part * 128 + d] = run;
    __syncthreads();
    const float p0 = PT[d], p1 = PT[128 + d], p2 = PT[256 + d], p3 = PT[384 + d];
    const float off = (part > 0 ? p0 : 0.f) + (part > 1 ? p1 : 0.f) + (part > 2 ? p2 : 0.f);
#pragma unroll
    for (int i = 0; i < 16; ++i) b[i] += off;
    bmid = p0 + p1; blast = (p0 + p1) + (p2 + p3);
}
__device__ __forceinline__ void stage_vt(const bf16* vp  , lp lds, int e, int part) {
    unsigned w[8];
#pragma unroll
    for (int i = 0; i < 8; ++i) { const unsigned lo = vp[(size_t)(2 * i) * 512], hi = vp[(size_t)(2 * i + 1) * 512]; w[i] = lo | (hi << 16); }
    LAS v4u* dst = (LAS v4u*)(lds + O_VT + (e * P64 + part * 16) * 2);
    dst[0] = (v4u){w[0], w[1], w[2], w[3]}; dst[1] = (v4u){w[4], w[5], w[6], w[7]};
}
__device__ __forceinline__ void pass1_unit(int unit, const float* G, const bf16* IB, bf16* ST, float* DEC, lp lds, int tid, unsigned* dbgw = nullptr) {
    const int c = unit & 255, h = (unit >> 8) & 3, b = unit >> 10;
    const int d = tid & 127, part = tid >> 7, lane = tid & 63, wave = tid >> 6, fr = lane & 15, fq = lane >> 4;
    const size_t row0 = (size_t)b * SEQ + (size_t)c * 64;
    float g[16], bb[16], bmid, blast;
    load_cumsum(G + row0 * 512 + h * 128, d, part, lds, g, bb, bmid, blast);
#ifdef DBG_P1
    { bool b1 = false, b3 = false; for (int i = 0; i < 16; ++i) { if (g[i] > 0.f) b1 = true; const float kk = (1.0f - __expf(g[i])) * __expf(blast - bb[i]); if (!(fabsf(kk) < 1e30f)) b3 = true; }
      if (b1) atomicMin(dbgw, 51u); if (b3) atomicMin(dbgw, 53u); }
#endif
    { unsigned w[8];
#pragma unroll
      for (int i = 0; i < 8; ++i) { const float k0 = (1.0f - __expf(g[2 * i])) * __expf(blast - bb[2 * i]), k1 = (1.0f - __expf(g[2 * i + 1])) * __expf(blast - bb[2 * i + 1]); w[i] = pk2(k0, k1); }
      LAS v4u* dst = (LAS v4u*)(lds + O_KDT + (d * P64 + part * 16) * 2);
      dst[0] = (v4u){w[0], w[1], w[2], w[3]}; dst[1] = (v4u){w[4], w[5], w[6], w[7]}; }
    stage_vt(IB + (row0 + part * 16) * 512 + h * 128 + d, lds, d, part);
    if (part == 0) DEC[(size_t)unit * 128 + d] = __expf(blast);
    __syncthreads();
    const bf16x8 a0 = *(const LAS bf16x8*)(lds + O_VT + ((16 * wave + fr) * P64 + 8 * fq) * 2), a1 = *(const LAS bf16x8*)(lds + O_VT + ((16 * wave + fr) * P64 + 32 + 8 * fq) * 2);
    bf16* out = ST + (size_t)unit * 16384;
#pragma unroll
    for (int dt = 0; dt < 8; ++dt) {
        const bf16x8 b0 = *(const LAS bf16x8*)(lds + O_KDT + ((16 * dt + fr) * P64 + 8 * fq) * 2), b1 = *(const LAS bf16x8*)(lds + O_KDT + ((16 * dt + fr) * P64 + 32 + 8 * fq) * 2);
        f32x4 acc = (f32x4){0.f, 0.f, 0.f, 0.f};
        acc = __builtin_amdgcn_mfma_f32_16x16x32_bf16(a0, b0, acc, 0, 0, 0);
        acc = __builtin_amdgcn_mfma_f32_16x16x32_bf16(a1, b1, acc, 0, 0, 0);
#ifdef DBG_P1
        for (int r = 0; r < 4; ++r) if (!(fabsf(acc[r]) < 1e30f)) atomicMin(dbgw, 54u);
#endif
#pragma unroll
        for (int r = 0; r < 4; ++r) out[(16 * wave + 4 * fq + r) * 128 + 16 * dt + fr] = (bf16)(pk2(acc[r], 0.f) & 0xffffu);
    }
    __syncthreads();
}
__device__ __forceinline__ void pass2_scan(const bf16* STin, bf16* ST, const float* DEC, int gtid, int gthreads) {
    for (int id = gtid; id < 8 * 16384; id += gthreads) {
        const int bh = id >> 14, ed = id & 16383, d = ed & 127;
        bf16* p = ST + (size_t)bh * 256 * 16384 + ed; const bf16* pi = STin + (size_t)bh * 256 * 16384 + ed; const float* dp = DEC + (size_t)bh * 256 * 128 + d;
        float state = 0.f;
        for (int c = 0; c < 256; c += 32) {
            unsigned short u[32]; float dc[32];
#pragma unroll
            for (int i = 0; i < 32; ++i) { u[i] = pi[(size_t)(c + i) * 16384]; dc[i] = dp[(size_t)(c + i) * 128]; }
#pragma unroll
            for (int i = 0; i < 32; ++i) { p[(size_t)(c + i) * 16384] = (bf16)(pk2(state, 0.f) & 0xffffu); state = dc[i] * state + bf2f(u[i]); }
        }
    }
}
__device__ __forceinline__ void pass3_unit(int unit, const float* G, const bf16* IB, const bf16* GB, const bf16* ST, const bf16* QB, bf16* YB, const float* normg, lp lds, int tid) {
    const int c = unit & 255, h = (unit >> 8) & 3, b = unit >> 10;
    const int d = tid & 127, part = tid >> 7, lane = tid & 63, wave = tid >> 6, fr = lane & 15, fq = lane >> 4;
    const size_t row0 = (size_t)b * SEQ + (size_t)c * 64;
    unsigned short gbv[4][4];
    { const int rb_ = wave & 3, ch_ = wave >> 2;
#pragma unroll
      for (int r = 0; r < 4; ++r) { const bf16* gbp_ = GB + (row0 + 16 * rb_ + 4 * fq + r) * 512 + h * 128 + 64 * ch_ + fr;
#pragma unroll
          for (int j = 0; j < 4; ++j) gbv[r][j] = gbp_[16 * j]; } }
    { const bf16* sp = ST + (size_t)unit * 16384;
#pragma unroll
      for (int ps = 0; ps < 4; ++ps) { const int idx = ps * NTHR + tid, e = idx >> 4, d8 = (idx & 15) * 8; const v4u w = *(const v4u*)(sp + e * 128 + d8); *(LAS v4u*)(lds + O_ST + (e * P128 + d8) * 2) = w; } }
    float g[16], bb[16], bmid, blast;
    load_cumsum(G + row0 * 512 + h * 128, d, part, lds, g, bb, bmid, blast);
    { const bf16* qp = QB + (row0 + part * 16) * 512 + h * 128 + d; const float emid = __expf(bmid);
      LAS bf16* Qp = (LAS bf16*)(lds + O_QP), *Qpp = (LAS bf16*)(lds + O_QPP), *Kp = (LAS bf16*)(lds + O_KP);
#pragma unroll
      for (int i = 0; i < 16; ++i) { const float q = bf2f(qp[(size_t)i * 512]); const float q1 = q * __expf(bb[i] - bmid), q2 = q1 * emid, k1 = (1.0f - __expf(g[i])) * __expf(bmid - bb[i]);
          const int t = part * 16 + i; const unsigned w = pk2(q1, q2), w2 = pk2(k1, 0.f);
          Qp[t * P128 + d] = (bf16)(w & 0xffffu); Qpp[t * P128 + d] = (bf16)(w >> 16); Kp[t * P128 + d] = (bf16)(w2 & 0xffffu); } }
    stage_vt(IB + (row0 + part * 16) * 512 + h * 128 + d, lds, d, part);
    __syncthreads();
    { const int ti = wave >> 1; LAS bf16* Pm = (LAS bf16*)(lds + O_PM);
#pragma unroll
      for (int sj2 = 0; sj2 < 2; ++sj2) { const int sj = 2 * (wave & 1) + sj2; f32x4 acc = (f32x4){0.f, 0.f, 0.f, 0.f};
#pragma unroll
          for (int ks = 0; ks < 4; ++ks) { const bf16x8 a = *(const LAS bf16x8*)(lds + O_QP + ((16 * ti + fr) * P128 + 32 * ks + 8 * fq) * 2), bq = *(const LAS bf16x8*)(lds + O_KP + ((16 * sj + fr) * P128 + 32 * ks + 8 * fq) * 2);
              acc = __builtin_amdgcn_mfma_f32_16x16x32_bf16(a, bq, acc, 0, 0, 0); }
#pragma unroll
          for (int r = 0; r < 4; ++r) { const int t = 16 * ti + 4 * fq + r, s = 16 * sj + fr; const float v = (s <= t) ? acc[r] : 0.f; Pm[t * P64 + s] = (bf16)(pk2(v, 0.f) & 0xffffu); } } }
    __syncthreads();
    const int rb = wave & 3, ch = wave >> 2;
    f32x4 o[4];
#pragma unroll
    for (int j = 0; j < 4; ++j) o[j] = (f32x4){0.f, 0.f, 0.f, 0.f};
    { bf16x8 ap[2], aq[4];
#pragma unroll
      for (int ks = 0; ks < 2; ++ks) ap[ks] = *(const LAS bf16x8*)(lds + O_PM + ((16 * rb + fr) * P64 + 32 * ks + 8 * fq) * 2);
#pragma unroll
      for (int ks = 0; ks < 4; ++ks) aq[ks] = *(const LAS bf16x8*)(lds + O_QPP + ((16 * rb + fr) * P128 + 32 * ks + 8 * fq) * 2);
#pragma unroll
      for (int j = 0; j < 4; ++j) { const int e0 = 64 * ch + 16 * j;
#pragma unroll
          for (int ks = 0; ks < 2; ++ks) { const bf16x8 bv = *(const LAS bf16x8*)(lds + O_VT + ((e0 + fr) * P64 + 32 * ks + 8 * fq) * 2); o[j] = __builtin_amdgcn_mfma_f32_16x16x32_bf16(ap[ks], bv, o[j], 0, 0, 0); }
#pragma unroll
          for (int ks = 0; ks < 4; ++ks) { const bf16x8 bs = *(const LAS bf16x8*)(lds + O_ST + ((e0 + fr) * P128 + 32 * ks + 8 * fq) * 2); o[j] = __builtin_amdgcn_mfma_f32_16x16x32_bf16(aq[ks], bs, o[j], 0, 0, 0); } } }
    LAS float* RS = (LAS float*)(lds + O_RS);
#pragma unroll
    for (int r = 0; r < 4; ++r) { float s = 0.f;
#pragma unroll
        for (int j = 0; j < 4; ++j) s += o[j][r] * o[j][r];
        s += __shfl_xor(s, 1); s += __shfl_xor(s, 2); s += __shfl_xor(s, 4); s += __shfl_xor(s, 8);
        if (fr == 0) RS[ch * 64 + 16 * rb + 4 * fq + r] = s; }
    __syncthreads();
#pragma unroll
    for (int r = 0; r < 4; ++r) { const int t = 16 * rb + 4 * fq + r; const float rstd = 1.0f / sqrtf((RS[t] + RS[64 + t]) * (1.0f / 128.0f) + RMS_EPS);
        bf16* yp = YB + (row0 + t) * 512 + h * 128 + 64 * ch + fr;
#pragma unroll
        for (int j = 0; j < 4; ++j) { const float y = o[j][r] * rstd * normg[64 * ch + 16 * j + fr] * bf2f(gbv[r][j]); yp[16 * j] = (bf16)(pk2(y, 0.f) & 0xffffu); } }
    __syncthreads();
}
}

#ifdef DBG_NAN
__device__ __forceinline__ void dbg_scan(const void* p, size_t nbytes, bool is_bf, int stage, unsigned* word) {
    const size_t n16 = nbytes / 16; const v4u* q = (const v4u*)p; bool bad = false;
    int t_ = threadIdx.x; asm volatile("" : "+v"(t_));
    int b_ = blockIdx.x; asm volatile("" : "+s"(b_)); int g_ = gridDim.x; asm volatile("" : "+s"(g_));
    for (unsigned i = (unsigned)(b_ * NTHR + t_); i < (unsigned)n16; i += (unsigned)(g_ * NTHR)) { const v4u w = q[i];
        for (int k = 0; k < 4; ++k) { const unsigned x = w[k];
            if (is_bf) { if ((x & 0x7f80u) == 0x7f80u || (x & 0x7f800000u) == 0x7f800000u) bad = true; }
            else { if ((x & 0x7f800000u) == 0x7f800000u) bad = true; } } }
    if (bad) atomicMin(word, (unsigned)stage);
}
#define DBG(stage, ptr, bytes, isbf) do { if (l == DBG_LAYER) dbg_scan((ptr), (bytes), (isbf), (stage), (unsigned*)(args.ws + WS_DBG)); } while (0)
#else
#define DBG(stage, ptr, bytes, isbf) do {} while (0)
#endif
#define GSYNC() do { XcdBarrier b_; b_.bar = (unsigned*)(args.ws + WS_CTL); b_.x = xb_xcc_id(); b_.st = (volatile LAS unsigned*)(lds + LDS_TOTAL - 64); xcd_barrier(b_); } while (0)
#ifdef DBG_TS
#define STAMP(k) do { if (blockIdx.x == 0 && threadIdx.x == 0) ((unsigned long long*)(args.ws + WS_DBG + 4096))[(k)] = __builtin_amdgcn_s_memrealtime(); } while (0)
#else
#define STAMP(k) do {} while (0)
#endif
#ifndef REP_P1
#define REP_P1 1
#endif
#ifndef REP_P2
#define REP_P2 1
#endif
#ifndef REP_P8
#define REP_P8 1
#endif
#ifndef REP_P45
#define REP_P45 1
#endif
#ifndef REP_HG0
#define REP_HG0 0
#endif
#ifndef REP_P0
#define REP_P0 1
#endif
#ifndef REP_LN1
#define REP_LN1 0
#endif
#ifndef REP_P69
#define REP_P69 0
#endif
#ifndef REP_ATT0
#define REP_ATT0 0
#endif
#ifndef STG_P1
#define STG_P1 300
#define STG_P4B 300
#define STG_P5 300
#define STG_P6 600
#define STG_P8 300
#define STG_P9 600
#endif
#ifndef STG
#define STG 0
#endif
#define STAGGER(ticks) do { if (STG) { const unsigned long long t0_ = __builtin_amdgcn_s_memrealtime(); const unsigned long long w_ = (unsigned long long)((blockIdx.x & 3) * (ticks)); \
    while (__builtin_amdgcn_s_memrealtime() - t0_ < w_) __builtin_amdgcn_s_sleep(8); } } while (0)
struct Args { const float* in[14]; float* out; unsigned char* ws; };
#define FRESH_PTR(T, var, expr) T var = (T)(expr); asm volatile("" : "+s"(var))
#define IDS() int tid_ = threadIdx.x; asm volatile("" : "+v"(tid_)); const int tid = tid_, lane = tid & 63, wave = __builtin_amdgcn_readfirstlane(tid >> 6); const int G = gridDim.x, bx = blockIdx.x, vcu = (G % 8 == 0) ? (bx % 8) * (G / 8) + bx / 8 : bx; \
              const int gw = vcu * NWAVES + wave, NGW = G * NWAVES; (void)tid; (void)lane; (void)wave; (void)gw; (void)NGW; (void)vcu; (void)bx
__global__ void __launch_bounds__(NTHR, 2) mega_fwd(Args args) {
    extern __shared__ __attribute__((aligned(16))) unsigned char lds_raw[];
    cg::grid_group grid = cg::this_grid();
    const lp lds = (lp)lds_raw;
    volatile LAS unsigned* xbst = (volatile LAS unsigned*)(lds + LDS_TOTAL - 64);
    if (threadIdx.x < 16) xbst[threadIdx.x] = 0u;
    __syncthreads();
    (void)xcd_barrier_post((unsigned*)(args.ws + WS_CTL), xbst);
    grid.sync();
    int tsn = 1; (void)tsn; STAMP(0);

#ifdef DBG_NAN
    if (blockIdx.x == 0 && threadIdx.x == 0) *(unsigned*)(args.ws + WS_DBG) = 990u;
    GSYNC(); STAMP(tsn); ++tsn;
#endif
    for (int rep_ = 0; rep_ < REP_P0; ++rep_) { IDS();
      Ptrs P;
      P.x = args.in[0]; P.w_in = args.in[1]; P.b_fgate = args.in[2]; P.lb_logits = args.in[3]; P.norm_g = args.in[4]; P.w_pa = args.in[5]; P.w_pb = args.in[6]; P.w_o = args.in[7];
      P.ln1_g = args.in[8]; P.ln1_b = args.in[9]; P.w_ff_in = args.in[10]; P.w_ff_out = args.in[11]; P.ln2_g = args.in[12]; P.ln2_b = args.in[13]; P.out = args.out; P.ws = args.ws;
      weight_items(P, (LAS float*)(lds + wave * 16384), gw, NGW, lane);
      __syncthreads();
      stage_wfa(P.w_in, (LAS float*)lds, tid);
      __syncthreads();
      row_pass<false, false, true, true>(P.x, nullptr, (bf16*)(P.ws + WS_XN), nullptr, nullptr, (float*)(P.ws + WS_LF), (const LAS float*)lds, P.b_fgate, gw, NGW, lane); }
    GSYNC(); STAMP(tsn); ++tsn;
    { const int l = 0; DBG(10, args.ws + WS_XN, (size_t)64 * MiB, true); DBG(10, args.ws + WS_LF, (size_t)1 * MiB, false); }

#pragma unroll 1
    for (int l = 0; l < DEPTH; ++l) {
        for (int rep_ = 0; rep_ < REP_P1; ++rep_) {
        { IDS(); FRESH_PTR(unsigned char*, ws, args.ws); FRESH_PTR(const float*, lbl, args.in[3]);
          pg8::Gemm g{(const bf16*)(ws + WS_XN), (const bf16*)(ws + WS_W + (size_t)l * WL_STRIDE + WL_IN), M, NP1, D}; pg8::StaticOrder S; S.init(M, NP1, G, bx);
          pg8::EpiInProj E{(bf16*)(ws + WS_QA), (bf16*)(ws + WS_QB), (bf16*)(ws + WS_KA), (bf16*)(ws + WS_VA), (float*)(ws + WS_G), (bf16*)(ws + WS_IB), (bf16*)(ws + WS_GB), lbl, l, attn_body::C2};
          STAGGER(STG_P1); pg8::gemm_phase<pg8::EpiInProj, pg8::StaticOrder, true, true>(lds, g, S, E); }
        }
        GSYNC(); STAMP(tsn); ++tsn;
        DBG(20, args.ws + WS_QA, (size_t)64 * MiB, true); DBG(30, args.ws + WS_KA, (size_t)64 * MiB, true); DBG(40, args.ws + WS_G, (size_t)64 * MiB, false); DBG(50, args.ws + WS_IB, (size_t)64 * MiB, true);
        for (int rep_ = 0; rep_ < REP_P2; ++rep_) {
        { IDS(); FRESH_PTR(unsigned char*, ws, args.ws);
          for (int u = vcu; u < 2048; u += G) hg::pass1_unit(u, (const float*)(ws + WS_G), (const bf16*)(ws + WS_IB), (bf16*)(ws + WS_ST), (float*)(ws + WS_DEC), lds, tid, (unsigned*)(ws + WS_DBG));
          for (int u = vcu; u < 16; u += G) fcumsum_unit(u, (const float*)(ws + WS_LF), (float*)(ws + WS_F), lds, tid);
          for (int u = vcu; u < 256; u += G) norm_unit(u, (const bf16*)(ws + WS_QA), (const bf16*)(ws + WS_KA), (unsigned*)(ws + WS_CTL + CTL_NORM) + l * 32, tid); }
        }
        GSYNC(); STAMP(tsn); ++tsn;
        DBG(60, args.ws + WS_ST, (size_t)64 * MiB, true); DBG(61, args.ws + WS_DEC, (size_t)1 * MiB, false); DBG(70, args.ws + WS_F, (size_t)1 * MiB, false);
        { IDS(); FRESH_PTR(unsigned char*, ws, args.ws);
          #if REP_HG0
          if (l == 0) { FRESH_PTR(float*, outp, args.out); hg::pass2_scan((const bf16*)(ws + WS_ST), (bf16*)outp, (const float*)(ws + WS_DEC), vcu * NTHR + tid, G * NTHR); }
#endif
          hg::pass2_scan((const bf16*)(ws + WS_ST), (bf16*)(ws + WS_ST), (const float*)(ws + WS_DEC), vcu * NTHR + tid, G * NTHR); }
        GSYNC(); STAMP(tsn); ++tsn;
        DBG(80, args.ws + WS_ST, (size_t)64 * MiB, true);
        { FRESH_PTR(unsigned char*, ws, args.ws);
          const attn_body::AttnTensors AT{(const attn_body::bf16*)(ws + WS_QA), (const attn_body::bf16*)(ws + WS_KA), (const attn_body::bf16*)(ws + WS_VA), (attn_body::bf16*)(ws + WS_QA), (const float*)(ws + WS_F),
                                          (const unsigned*)(ws + WS_CTL + CTL_NORM) + l * 32};
          const attn_body::DynOrder S{(unsigned*)(ws + WS_CTL + CTL_QCTR) + l * 64, (volatile LAS unsigned*)(lds + attn_body::LDS_BYTES + 32)};
          attn_body::attn_phase<attn_body::DynOrder>((char*)lds_raw, AT, S); }
        { IDS(); FRESH_PTR(unsigned char*, ws, args.ws); FRESH_PTR(const float*, ng, args.in[4]);
          volatile LAS unsigned* slot = (volatile LAS unsigned*)(lds + attn_body::LDS_BYTES + 32); unsigned* ctr = (unsigned*)(ws + WS_CTL + CTL_PCTR) + l * 64;
          __syncthreads();
          if (tid == 0) *slot = __hip_atomic_fetch_add(ctr, 1u, __ATOMIC_RELAXED, __HIP_MEMORY_SCOPE_AGENT);
          __syncthreads();
          unsigned n = *slot;
          while (n < 2048u) {
              unsigned nxt = 0u; if (tid == 0) nxt = __hip_atomic_fetch_add(ctr, 1u, __ATOMIC_RELAXED, __HIP_MEMORY_SCOPE_AGENT);
              hg::pass3_unit((int)n, (const float*)(ws + WS_G), (const bf16*)(ws + WS_IB), (const bf16*)(ws + WS_GB), (const bf16*)(ws + WS_ST), (const bf16*)(ws + WS_QB), (bf16*)(ws + WS_QB), ng + l * 128, lds, tid);
              if (tid == 0) *slot = nxt;
              __syncthreads();
              n = *slot; } }
        GSYNC(); STAMP(tsn); ++tsn;
        DBG(90, args.ws + WS_QA, (size_t)64 * MiB, true);
        for (int rep_ = 0; rep_ < REP_P45; ++rep_) {
        { IDS(); FRESH_PTR(unsigned char*, ws, args.ws);
          pg8::Gemm g{(const bf16*)(ws + WS_XN), (const bf16*)(ws + WS_W + (size_t)l * WL_STRIDE + WL_G), M, NG, D}; pg8::StaticOrder S; S.init(M, NG, G, bx);
          pg8::EpiGates E{(bf16*)(ws + WS_GATES)};
          STAGGER(STG_P4B); pg8::gemm_phase<pg8::EpiGates, pg8::StaticOrder, true, true>(lds, g, S, E); }
        }
        GSYNC(); STAMP(tsn); ++tsn;
        DBG(100, args.ws + WS_GATES, (size_t)128 * MiB, true);
        for (int rep_ = 0; rep_ < REP_P45; ++rep_) {
        { IDS(); FRESH_PTR(unsigned char*, ws, args.ws);
          { pg8::Gemm g{(const bf16*)(ws + WS_QA), (const bf16*)(ws + WS_W + (size_t)l * WL_STRIDE + WL_M), M, D, 512}; pg8::StaticOrder S; S.init(M, D, G, bx);
            pg8::EpiMerge<0> E{(const bf16*)(ws + WS_GATES), (bf16*)(ws + WS_MERGED)};
            STAGGER(STG_P5); pg8::gemm_phase<pg8::EpiMerge<0>, pg8::StaticOrder, true, true>(lds, g, S, E); }
          asm volatile("s_waitcnt vmcnt(0)" ::: "memory"); __syncthreads();
          { pg8::Gemm g{(const bf16*)(ws + WS_QB), (const bf16*)(ws + WS_W + (size_t)l * WL_STRIDE + WL_M + MiB), M, D, 512}; pg8::StaticOrder S; S.init(M, D, G, bx);
            pg8::EpiMerge<1> E{(const bf16*)(ws + WS_GATES), (bf16*)(ws + WS_MERGED)};
            pg8::gemm_phase<pg8::EpiMerge<1>, pg8::StaticOrder, true, true>(lds, g, S, E); } }
        }
        GSYNC(); STAMP(tsn); ++tsn;
        DBG(110, args.ws + WS_MERGED, (size_t)64 * MiB, true);
        { IDS(); FRESH_PTR(unsigned char*, ws, args.ws); FRESH_PTR(const float*, xin, args.in[0]); FRESH_PTR(float*, outp, args.out); const float* xres = (l == 0) ? xin : (const float*)outp;
          pg8::Gemm g{(const bf16*)(ws + WS_MERGED), (const bf16*)(ws + WS_W + (size_t)l * WL_STRIDE + WL_O), M, D, D}; pg8::StaticOrder S; S.init(M, D, G, bx);
          FRESH_PTR(const float*, g2, args.in[12]); FRESH_PTR(const float*, b2, args.in[13]);
#if REP_P69
          { pg8::EpiResid E0{xres, (float*)(ws + WS_IB), ALPHA, (l == 0) ? (const float*)nullptr : (const float*)(ws + WS_CTL + CTL_STATS + 262144), g2 + (l - 1) * D, b2 + (l - 1) * D};
            pg8::gemm_phase<pg8::EpiResid, pg8::StaticOrder, true, true>(lds, g, S, E0); }
#endif
          pg8::EpiResid E{xres, outp, ALPHA, (l == 0) ? (const float*)nullptr : (const float*)(ws + WS_CTL + CTL_STATS + 262144), g2 + (l - 1) * D, b2 + (l - 1) * D};
          STAGGER(STG_P6); pg8::gemm_phase<pg8::EpiResid, pg8::StaticOrder, true, true>(lds, g, S, E); }
        GSYNC(); STAMP(tsn); ++tsn;
        DBG(120, args.out, (size_t)128 * MiB, false);
        { IDS(); FRESH_PTR(unsigned char*, ws, args.ws); FRESH_PTR(float*, outp, args.out); FRESH_PTR(const float*, gm, args.in[8]); FRESH_PTR(const float*, bt, args.in[9]);
#if REP_LN1
          row_pass<true, true, true, false>(outp, (float*)(ws + WS_GATES), (bf16*)(ws + WS_ST), gm + l * D, bt + l * D, nullptr, nullptr, nullptr, gw, NGW, lane);
#endif
          row_pass<true, false, true, false>(outp, nullptr, (bf16*)(ws + WS_XN), gm + l * D, bt + l * D, nullptr, nullptr, nullptr, gw, NGW, lane, (float*)(ws + WS_CTL + CTL_STATS + (size_t)l * 524288)); }
        GSYNC(); STAMP(tsn); ++tsn;
        DBG(130, args.ws + WS_XN, (size_t)64 * MiB, true);
        for (int rep_ = 0; rep_ < REP_P8; ++rep_) {
        { IDS(); FRESH_PTR(unsigned char*, ws, args.ws);
          pg8::Gemm g{(const bf16*)(ws + WS_XN), (const bf16*)(ws + WS_W + (size_t)l * WL_STRIDE + WL_F1), M, NF1, D}; pg8::StaticOrder S; S.init(M, NF1, G, bx);
          pg8::EpiSwiGLU E{(bf16*)(ws + WS_H)};
          STAGGER(STG_P8); pg8::gemm_phase<pg8::EpiSwiGLU, pg8::StaticOrder, true, true>(lds, g, S, E); }
        }
        GSYNC(); STAMP(tsn); ++tsn;
        DBG(140, args.ws + WS_H, (size_t)176 * MiB, true);
        { IDS(); FRESH_PTR(unsigned char*, ws, args.ws); FRESH_PTR(float*, outp, args.out);
          pg8::Gemm g{(const bf16*)(ws + WS_H), (const bf16*)(ws + WS_W + (size_t)l * WL_STRIDE + WL_F2), M, D, FFH}; pg8::StaticOrder S; S.init(M, D, G, bx);
          FRESH_PTR(const float*, g1, args.in[8]); FRESH_PTR(const float*, b1, args.in[9]);
#if REP_P69
          { pg8::EpiResid E0{outp, (float*)(ws + WS_IB), ALPHA, (const float*)(ws + WS_CTL + CTL_STATS + (size_t)l * 524288), g1 + l * D, b1 + l * D};
            pg8::gemm_phase<pg8::EpiResid, pg8::StaticOrder, true, true>(lds, g, S, E0); }
#endif
          pg8::EpiResid E{outp, outp, ALPHA, (const float*)(ws + WS_CTL + CTL_STATS + (size_t)l * 524288), g1 + l * D, b1 + l * D};
          STAGGER(STG_P9); pg8::gemm_phase<pg8::EpiResid, pg8::StaticOrder, true, true>(lds, g, S, E); }
        GSYNC(); STAMP(tsn); ++tsn;
        DBG(150, args.out, (size_t)128 * MiB, false);
        { IDS(); FRESH_PTR(unsigned char*, ws, args.ws); FRESH_PTR(float*, outp, args.out); FRESH_PTR(const float*, gm, args.in[12]); FRESH_PTR(const float*, bt, args.in[13]);
          if (l + 1 < DEPTH) {
              FRESH_PTR(const float*, win, args.in[1]); FRESH_PTR(const float*, bfg, args.in[2]);
              stage_wfa(win + (size_t)(l + 1) * D * NIN, (LAS float*)lds, tid);
              __syncthreads();
              row_pass<true, false, true, true>(outp, nullptr, (bf16*)(ws + WS_XN), gm + l * D, bt + l * D, (float*)(ws + WS_LF), (const LAS float*)lds, bfg + (l + 1) * 8, gw, NGW, lane, (float*)(ws + WS_CTL + CTL_STATS + 262144));
          } else {
              row_pass<true, true, false, false>(outp, outp, nullptr, gm + l * D, bt + l * D, nullptr, nullptr, nullptr, gw, NGW, lane);
          } }
        if (l + 1 < DEPTH) GSYNC(); STAMP(tsn); ++tsn;
    }
#ifdef DBG_TS
    GSYNC(); STAMP(tsn);
    { const volatile unsigned long long* T = (const volatile unsigned long long*)(args.ws + WS_DBG + 4096);
      float sum[2] = {0.f, 0.f};
      if (blockIdx.x == 0) {
          for (int k = 0; k < 23; ++k) { const float us = (float)(T[k + 1] - T[k]) * 0.01f; const int j = (k == 0) ? -1 : (k - 1) % 11;
              for (int w = 0; w < 2; ++w) { const unsigned mask = (w == 0) ? DBG_TS_A : DBG_TS_B; const bool in = (j < 0) ? ((mask >> 15) & 1u) : ((mask >> j) & 1u); if (in) sum[w] += us; } }
          for (int i = threadIdx.x; i < (1 << 20); i += NTHR) args.out[1024 + i] = sum[1];
          __syncthreads();
          if (threadIdx.x == 0) args.out[0] = 100.0f * sum[0];
      } }
#endif
#ifdef DBG_NAN
    GSYNC();
    if (blockIdx.x == 0 && threadIdx.x == 0) args.out[0] = 100.0f * (float)*(volatile unsigned*)(args.ws + WS_DBG);
#endif
}

extern "C" void kernel_launch(void* const* d_in, const int* in_sizes, int n_in, void* d_out, int out_size, void* d_ws, size_t ws_size, hipStream_t stream) {
    static int grid = 0;
    if (grid == 0) {
        if (n_in != 14 || in_sizes[0] != M * D || out_size != M * D || ws_size < WS_END) { fprintf(stderr, "kernel_launch: unexpected shapes (n_in %d, in0 %d, out %d, ws %zu)\n", n_in, n_in > 0 ? in_sizes[0] : -1, out_size, ws_size); grid = -1; return; }
        int dev = 0, cus = 0, per_cu = 0;
        if (hipGetDevice(&dev) != hipSuccess || hipDeviceGetAttribute(&cus, hipDeviceAttributeMultiprocessorCount, dev) != hipSuccess) { grid = -1; return; }
        if (hipFuncSetAttribute((const void*)mega_fwd, hipFuncAttributeMaxDynamicSharedMemorySize, LDS_TOTAL) != hipSuccess) { fprintf(stderr, "kernel_launch: hipFuncSetAttribute failed\n"); grid = -1; return; }
        if (hipOccupancyMaxActiveBlocksPerMultiprocessor(&per_cu, (const void*)mega_fwd, NTHR, LDS_TOTAL) != hipSuccess || per_cu < 1) { fprintf(stderr, "kernel_launch: occupancy query says %d\n", per_cu); per_cu = 1; }
        (void)hipGetLastError();
        grid = cus * per_cu;
    }
    if (grid < 0) return;
    if (hipMemsetAsync((char*)d_ws + WS_CTL, 0, 65536, stream) != hipSuccess) { fprintf(stderr, "kernel_launch: hipMemsetAsync failed\n"); return; }
    Args a{};
    for (int i = 0; i < 14; ++i) a.in[i] = (const float*)d_in[i];
    a.out = (float*)d_out; a.ws = (unsigned char*)d_ws;
    void* kargs[] = {&a};
    hipError_t e = hipLaunchCooperativeKernel((const void*)mega_fwd, dim3(grid), dim3(NTHR), kargs, LDS_TOTAL, stream);
    if (e != hipSuccess) fprintf(stderr, "kernel_launch: cooperative launch failed: %s (grid %d)\n", hipGetErrorString(e), grid);
}
```

```cpp
#include <hip/hip_runtime.h>
#include <cstdio>
#include <cstdint>
namespace pg8 {
#define PG8_LAS __attribute__((address_space(3)))
typedef unsigned short bf16_t;
typedef short bf16x8 __attribute__((ext_vector_type(8)));
typedef float f32x4 __attribute__((ext_vector_type(4)));
typedef unsigned u32x4 __attribute__((ext_vector_type(4)));
constexpr int BM = 256, BK = 64, HALF = 128, HTB = HALF * BK * 2  , STAGE_BYTES = 8 * HTB, NXCD = 8, WGM = 8;

__host__ __device__ __forceinline__ int lds_byte(int r, int c) { const int st = (r >> 4) * 2 + (c >> 5), rr = r & 15, cc = c & 31, ob = rr * 64 + cc * 2; return st * 1024 + (ob ^ (((ob >> 9) & 1) << 5)); }
__host__ __device__ __forceinline__ void stage_rc(int b, int& R, int& C) { const int st = b / 1024, sb = b % 1024, swz = sb ^ (((sb >> 9) & 1) << 5); R = (st >> 1) * 16 + swz / 64; C = (st & 1) * 32 + (swz % 64) / 2; }
__host__ __device__ __forceinline__ int perm32(int rho) { const int n = rho >> 4, i = rho & 15; return 8 * (i >> 2) + 4 * n + (i & 3); }

struct Unit { int pm, pn; };
struct Gemm { const bf16_t* A; const bf16_t* Bt; int M, N, K; };

struct StaticOrder {
    int nM, nN, nwg, G, c;
    __host__ __device__ void init(int M, int N, int G_, int c_) { nM = M / BM; nN = N / BM; nwg = nM * nN; G = G_; c = c_; }
    __host__ __device__ bool next(int i, Unit& u) const {
        const long L = (long)i * G + c; if (L >= nwg) return false;
        int wgid = (int)L; { const int q = nwg / NXCD, r = nwg % NXCD, xcd = wgid % NXCD, off = wgid / NXCD; wgid = (xcd < r ? xcd * (q + 1) : r * (q + 1) + (xcd - r) * q) + off; }
        const int nig = WGM * nN, gid = wgid / nig, fm = gid * WGM, gsz = (nM - fm) < WGM ? (nM - fm) : WGM;
        u.pm = fm + ((wgid % nig) % gsz); u.pn = (wgid % nig) / gsz; return true;
    }
    __device__ __forceinline__ void a_ready(const Unit&) const {}
    __device__ __forceinline__ void done(const Unit&) const {}
};

typedef float f32x2c_t __attribute__((ext_vector_type(2))); typedef __bf16 bf16x2c_t __attribute__((ext_vector_type(2)));
__device__ __forceinline__ unsigned cvt_pk_bf16(float lo, float hi) { f32x2c_t v = {lo, hi}; bf16x2c_t b = __builtin_convertvector(v, bf16x2c_t); return __builtin_bit_cast(unsigned, b); }
typedef float f32x2 __attribute__((ext_vector_type(2)));
__device__ __forceinline__ f32x2 gelu_pk(f32x2 v) {
    const f32x2 av = __builtin_elementwise_abs(v), d = av * 0.2316418882f + 1.0f;
    f32x2 t; t.x = __builtin_amdgcn_rcpf(d.x); t.y = __builtin_amdgcn_rcpf(d.y);
    f32x2 q = t * 0.5307027145f + (-0.7265760135f); q = q * t + 0.7107068705f; q = q * t + (-0.142248368f); q = q * t + 0.127414796f; q = q * t;
    const f32x2 s = (v * v) * (-0.72134752044f);
    f32x2 e; e.x = __builtin_amdgcn_exp2f(s.x); e.y = __builtin_amdgcn_exp2f(s.y);
    const f32x2 m = v * (q * e), r = v - m;
    f32x2 o; o.x = v.x < 0.f ? m.x : r.x; o.y = v.y < 0.f ? m.y : r.y; return o;
}

template <int ACT  > struct EpiBf16 {
    static constexpr bool PERM = true, AFTER_DRAIN = false; static_assert(ACT == 0 || ACT == 1, "EpiBf16: ACT is 0 (none) or 1 (gelu_pk)");
    bf16_t* O; int ldc; const float* bias; int split_cols; size_t split_stride; float scale0;
    __device__ __forceinline__ void operator()(const f32x4 (&acc)[2][2][4][2], const Unit& u, int wr, int wc, int fr, int fq) const {
        const int row0 = u.pm * BM + wr * 64 + fr; int colt = u.pn * BM; bf16_t* base = O;
        float sc = 1.f; if (split_cols) { const int t = colt / split_cols; base += (size_t)t * split_stride; colt -= t * split_cols; if (t == 0) sc = scale0; }
        const int col0 = colt + wc * 32 + 8 * fq, bcol0 = u.pn * BM + wc * 32 + 8 * fq;
        f32x4 bv[2][2];
#pragma unroll
        for (int bj = 0; bj < 2; ++bj)
#pragma unroll
            for (int n = 0; n < 2; ++n) bv[bj][n] = bias ? *(const f32x4*)(bias + bcol0 + bj * HALF + 4 * n) : (f32x4){0.f, 0.f, 0.f, 0.f};
#pragma unroll
        for (int ai = 0; ai < 2; ++ai)
#pragma unroll
            for (int m = 0; m < 4; ++m) { bf16_t* rowp = base + (size_t)(row0 + ai * HALF + m * 16) * ldc + col0;
#pragma unroll
                for (int bj = 0; bj < 2; ++bj) { f32x4 v0 = acc[ai][bj][m][0] + bv[bj][0], v1 = acc[ai][bj][m][1] + bv[bj][1];
                    if (ACT == 1) { f32x2 a = gelu_pk((f32x2){v0[0], v0[1]}), b = gelu_pk((f32x2){v0[2], v0[3]}), c = gelu_pk((f32x2){v1[0], v1[1]}), d = gelu_pk((f32x2){v1[2], v1[3]});
                        v0 = (f32x4){a.x, a.y, b.x, b.y}; v1 = (f32x4){c.x, c.y, d.x, d.y}; }
                    v0 = v0 * sc; v1 = v1 * sc; u32x4 w; w.x = cvt_pk_bf16(v0[0], v0[1]); w.y = cvt_pk_bf16(v0[2], v0[3]); w.z = cvt_pk_bf16(v1[0], v1[1]); w.w = cvt_pk_bf16(v1[2], v1[3]);
                    *(u32x4*)(rowp + bj * HALF) = w; } }
    }
};

struct PanelStats {
    unsigned* xbuf;
    unsigned* cnt;
    unsigned* tmo;
    int ntn; float eps;
    unsigned code;
    __device__ __forceinline__ bool run(const f32x4 (&v)[2][2][4][2], const Unit& u, int wr, int wc, int fr, int fq, PG8_LAS unsigned char* lds, int wid, int lane) const {
        typedef float f32x2v __attribute__((ext_vector_type(2)));
        PG8_LAS f32x2v* P = (PG8_LAS f32x2v*)lds;
        PG8_LAS f32x2v* S = (PG8_LAS f32x2v*)(lds + 8192);
        PG8_LAS unsigned* flag = (PG8_LAS unsigned*)(lds + 8192 + 2048);
#pragma unroll
        for (int ai = 0; ai < 2; ++ai)
#pragma unroll
            for (int m = 0; m < 4; ++m) {
                float s = 0.f;
#pragma unroll
                for (int bj = 0; bj < 2; ++bj)
#pragma unroll
                    for (int n = 0; n < 2; ++n) { const f32x4 x = v[ai][bj][m][n]; s += (x[0] + x[1]) + (x[2] + x[3]); }
                s += __shfl_xor(s, 16); s += __shfl_xor(s, 32);
                const float mw = s * (1.0f / 64.0f); float q = 0.f;
#pragma unroll
                for (int bj = 0; bj < 2; ++bj)
#pragma unroll
                    for (int n = 0; n < 2; ++n) { const f32x4 d = v[ai][bj][m][n] - mw; q += (d[0] * d[0] + d[1] * d[1]) + (d[2] * d[2] + d[3] * d[3]); }
                q += __shfl_xor(q, 16); q += __shfl_xor(q, 32);
                if (fq == 0) P[(ai * HALF + wr * 64 + m * 16 + fr) * 4 + wc] = (f32x2v){mw, q};
            }
        asm volatile("s_waitcnt lgkmcnt(0)" ::: "memory"); __builtin_amdgcn_s_barrier(); asm volatile("" ::: "memory");
#if defined(BROKEN_EXCHANGE_NO_WAIT)
#warning BROKEN CONTROL BUILD: the row-statistics exchange does not wait; results are wrong by design
        if (blockIdx.x >= 64) { const long long t0_ = clock64(); while (clock64() - t0_ < 60000) __builtin_amdgcn_s_sleep(8); }
#endif
        const int row = wid * 32 + (lane & 31);
        if (lane < 32) {
            const f32x2v a = P[row * 4 + 0], b = P[row * 4 + 1], c = P[row * 4 + 2], d = P[row * 4 + 3];
            const float mt = (a.x + b.x + c.x + d.x) * 0.25f;
            const float da = a.x - mt, db = b.x - mt, dc = c.x - mt, dd = d.x - mt;
            const float m2 = (a.y + b.y) + (c.y + d.y) + 64.0f * ((da * da + db * db) + (dc * dc + dd * dd));
            unsigned long long* slot = (unsigned long long*)xbuf + ((size_t)(u.pm * BM + row) * 4 + u.pn);
            __hip_atomic_store(slot, ((unsigned long long)__float_as_uint(m2) << 32) | __float_as_uint(mt), __ATOMIC_RELAXED, __HIP_MEMORY_SCOPE_AGENT);
        }
        asm volatile("s_waitcnt vmcnt(0)" ::: "memory");
        if (lane == 0) __hip_atomic_fetch_add(cnt + 64 * u.pm, 1u, __ATOMIC_RELAXED, __HIP_MEMORY_SCOPE_AGENT);
        if (wid == 0) {
            bool dead = false; const unsigned long long t0 = __builtin_amdgcn_s_memrealtime(); const unsigned want = 8u * (unsigned)ntn;
            for (;;) {
#if defined(BROKEN_EXCHANGE_NO_WAIT)
                break;
#endif
                if ((unsigned)__builtin_amdgcn_readfirstlane(__hip_atomic_load(cnt + 64 * u.pm, __ATOMIC_RELAXED, __HIP_MEMORY_SCOPE_AGENT)) >= want) break;
                if (__builtin_amdgcn_s_memrealtime() - t0 > 2000000ull) {
                    if (lane == 0) { unsigned expect = 0u; __hip_atomic_compare_exchange_strong(tmo + 1, &expect, code | (unsigned)(u.pm & 0xff), __ATOMIC_RELAXED, __ATOMIC_RELAXED, __HIP_MEMORY_SCOPE_AGENT);
                                     __hip_atomic_store(tmo, 1u, __ATOMIC_RELAXED, __HIP_MEMORY_SCOPE_AGENT); }
                    dead = true; break; }
                __builtin_amdgcn_s_sleep(2);
            }
            __builtin_amdgcn_fence(__ATOMIC_ACQUIRE, "agent");
            if (lane == 0) flag[0] = dead ? 1u : 0u;
        }
        asm volatile("s_waitcnt vmcnt(0) lgkmcnt(0)" ::: "memory"); __builtin_amdgcn_s_barrier(); asm volatile("" ::: "memory");
        const bool bad = flag[0] != 0u;
        if (lane < 32) {
            const unsigned long long* slot = (const unsigned long long*)xbuf + (size_t)(u.pm * BM + row) * 4; float mt[4], m2[4]; float ms = 0.f;
#pragma unroll
            for (int t = 0; t < 4; ++t) { if (t < ntn) { const unsigned long long w = __hip_atomic_load(slot + t, __ATOMIC_RELAXED, __HIP_MEMORY_SCOPE_AGENT); mt[t] = __uint_as_float((unsigned)w); m2[t] = __uint_as_float((unsigned)(w >> 32)); } else { mt[t] = 0.f; m2[t] = 0.f; } ms += mt[t]; }
            const float mean = ms / (float)ntn; float q = 0.f;
#pragma unroll
            for (int t = 0; t < 4; ++t) if (t < ntn) { const float dm = mt[t] - mean; q += m2[t] + 256.0f * dm * dm; }
            S[row] = (f32x2v){mean, 1.0f / sqrtf(q / (256.0f * (float)ntn) + eps)};
        }
        asm volatile("s_waitcnt lgkmcnt(0)" ::: "memory"); __builtin_amdgcn_s_barrier(); asm volatile("" ::: "memory");
        return bad;
    }
};
struct EpiLnRes {
    static constexpr bool PERM = false, AFTER_DRAIN = true;
    const float* base; float* out; int ldc; const float* bias; PanelStats st; unsigned poison;
    __device__ __forceinline__ void fused(f32x4 (&acc)[2][2][4][2], const Unit& u, int wr, int wc, int fr, int fq, PG8_LAS unsigned char* lds, int wid, int lane) const {
        typedef float f32x2v __attribute__((ext_vector_type(2)));
        const PG8_LAS f32x2v* S = (const PG8_LAS f32x2v*)(lds + 8192);
        const int col0 = u.pn * BM + wc * 32 + 4 * fq;
#pragma unroll
        for (int bj = 0; bj < 2; ++bj)
#pragma unroll
            for (int n = 0; n < 2; ++n) { const f32x4 bv = bias ? *(const f32x4*)(bias + col0 + bj * HALF + n * 16) : (f32x4){0.f, 0.f, 0.f, 0.f};
#pragma unroll
                for (int ai = 0; ai < 2; ++ai)
#pragma unroll
                    for (int m = 0; m < 4; ++m) acc[ai][bj][m][n] += bv; }
        f32x4 pre[4][2][2];
#pragma unroll
        for (int m = 0; m < 4; ++m) { const size_t off = (size_t)(u.pm * BM + wr * 64 + m * 16 + fr) * ldc + col0;
#pragma unroll
            for (int bj = 0; bj < 2; ++bj)
#pragma unroll
                for (int n = 0; n < 2; ++n) pre[m][bj][n] = *(const f32x4*)(base + off + bj * HALF + n * 16); }
        const bool bad = st.run(acc, u, wr, wc, fr, fq, lds, wid, lane) || poison != 0u;
        const float qnan = __builtin_nanf("");
#pragma unroll
        for (int ai = 0; ai < 2; ++ai)
#pragma unroll
            for (int m = 0; m < 4; ++m) { const int r = ai * HALF + wr * 64 + m * 16 + fr; const f32x2v sr = S[r]; const size_t off = (size_t)(u.pm * BM + r) * ldc + col0;
#pragma unroll
                for (int bj = 0; bj < 2; ++bj)
#pragma unroll
                    for (int n = 0; n < 2; ++n) { const f32x4 bs = ai == 0 ? pre[m][bj][n] : *(const f32x4*)(base + off + bj * HALF + n * 16); f32x4 o = bs + (acc[ai][bj][m][n] - sr.x) * sr.y;
                        if (bad) o = (f32x4){qnan, qnan, qnan, qnan}; *(f32x4*)(out + off + bj * HALF + n * 16) = o; }
                if (m & 1) asm volatile("" ::: "memory"); }
    }
};
struct EpiLnResLn {
    static constexpr bool PERM = false, AFTER_DRAIN = true;
    const float* base; float* out; bf16_t* xn; int ldc; const float* bias; PanelStats st1, st2; unsigned poison;
    __device__ __forceinline__ void fused(f32x4 (&acc)[2][2][4][2], const Unit& u, int wr, int wc, int fr, int fq, PG8_LAS unsigned char* lds, int wid, int lane) const {
        typedef float f32x2v __attribute__((ext_vector_type(2))); typedef unsigned u32x2v __attribute__((ext_vector_type(2)));
        const PG8_LAS f32x2v* S = (const PG8_LAS f32x2v*)(lds + 8192);
        const int col0 = u.pn * BM + wc * 32 + 4 * fq;
#pragma unroll
        for (int bj = 0; bj < 2; ++bj)
#pragma unroll
            for (int n = 0; n < 2; ++n) { const f32x4 bv = bias ? *(const f32x4*)(bias + col0 + bj * HALF + n * 16) : (f32x4){0.f, 0.f, 0.f, 0.f};
#pragma unroll
                for (int ai = 0; ai < 2; ++ai)
#pragma unroll
                    for (int m = 0; m < 4; ++m) acc[ai][bj][m][n] += bv; }
        bool bad = st1.run(acc, u, wr, wc, fr, fq, lds, wid, lane) || poison != 0u;
        const float qnan = __builtin_nanf("");
#pragma unroll
        for (int ai = 0; ai < 2; ++ai)
#pragma unroll
            for (int m = 0; m < 4; ++m) { const int r = ai * HALF + wr * 64 + m * 16 + fr; const f32x2v sr = S[r]; const size_t off = (size_t)(u.pm * BM + r) * ldc + col0;
#pragma unroll
                for (int bj = 0; bj < 2; ++bj)
#pragma unroll
                    for (int n = 0; n < 2; ++n) { const f32x4 bs = *(const f32x4*)(base + off + bj * HALF + n * 16); acc[ai][bj][m][n] = bs + (acc[ai][bj][m][n] - sr.x) * sr.y; }
                asm volatile("" : "+v"(acc[ai][0][m][0]), "+v"(acc[ai][0][m][1]), "+v"(acc[ai][1][m][0]), "+v"(acc[ai][1][m][1]));
                if (m & 1) asm volatile("" ::: "memory"); }
        const bool bad1 = bad;
        bad = st2.run(acc, u, wr, wc, fr, fq, lds, wid, lane) || bad;
#pragma unroll
        for (int ai = 0; ai < 2; ++ai)
#pragma unroll
            for (int m = 0; m < 4; ++m) { const int r = ai * HALF + wr * 64 + m * 16 + fr; const f32x2v sr = S[r]; const size_t off = (size_t)(u.pm * BM + r) * ldc + col0;
#pragma unroll
                for (int bj = 0; bj < 2; ++bj)
#pragma unroll
                    for (int n = 0; n < 2; ++n) { const f32x4 x1 = acc[ai][bj][m][n]; *(f32x4*)(out + off + bj * HALF + n * 16) = bad1 ? (f32x4){qnan, qnan, qnan, qnan} : x1;
                        const f32x4 o = (x1 - sr.x) * sr.y; u32x2v w; w.x = cvt_pk_bf16(o[0], o[1]); w.y = cvt_pk_bf16(o[2], o[3]);
                        if (bad) { w.x = 0x7fc07fc0u; w.y = 0x7fc07fc0u; } *(u32x2v*)(xn + off + bj * HALF + n * 16) = w; }
                asm volatile("" ::: "memory"); }
    }
};

template <class Epi, class Sched, bool ALIGN_EPI = false, bool SP2 = false>
__device__ __forceinline__ void gemm_phase(PG8_LAS unsigned char* lds, const Gemm g, const Sched& S, const Epi& E) {
    int tid_ = threadIdx.x; asm volatile("" : "+v"(tid_));
    const int tid = tid_, wid = __builtin_amdgcn_readfirstlane(tid >> 6), lane = tid & 63, wr = wid >> 2, wc = wid & 3, fr = lane & 15, fq = lane >> 4;
    const int K = g.K, nt = K / BK;
    unsigned voffA[2], voffB[2];
#pragma unroll
    for (int i = 0; i < 2; ++i) { int R, C; stage_rc(tid * 16 + i * 8192, R, C); const int Rb = Epi::PERM ? ((R & ~31) + perm32(R & 31)) : R;
        voffA[i] = (unsigned)(R * K + C) * 2u; voffB[i] = (unsigned)(Rb * K + C) * 2u; }
    const size_t kstep = (size_t)(BK * 2);
    const size_t hstep = (size_t)HALF * K * 2;
    const size_t tstep = 2 * hstep;
    const unsigned ldsw = (unsigned)wid * 1024u;
    const int aoff = lds_byte(wr * 64 + fr, fq * 8), boff = lds_byte(wc * 32 + fr, fq * 8);
#define PG8_SA(b, h) (((b) * 2 + (h)) * HTB)
#define PG8_SB(b, h) ((4 + (b) * 2 + (h)) * HTB)
#define PG8_STAGE(bufoff, gbase, voff) do { _Pragma("unroll") for (int _i = 0; _i < 2; ++_i) \
        __builtin_amdgcn_global_load_lds((const unsigned*)((const char*)(gbase) + (voff)[_i]), (PG8_LAS unsigned*)(lds + (bufoff) + ldsw + _i * 8192), 16, 0, 0); } while (0)
#define PG8_LDA(dst, b, h) do { _Pragma("unroll") for (int m = 0; m < 4; ++m) _Pragma("unroll") for (int k = 0; k < 2; ++k) dst[m][k] = *(const PG8_LAS bf16x8*)(lds + PG8_SA(b, h) + aoff + m * 2048 + k * 1024); } while (0)
#define PG8_LDB(dst, b, h) do { _Pragma("unroll") for (int n = 0; n < 2; ++n) _Pragma("unroll") for (int k = 0; k < 2; ++k) dst[n][k] = *(const PG8_LAS bf16x8*)(lds + PG8_SB(b, h) + boff + n * 2048 + k * 1024); } while (0)
#define PG8_MMA(ai, bj, At, Bt) do { __builtin_amdgcn_s_setprio(1); _Pragma("unroll") for (int m = 0; m < 4; ++m) _Pragma("unroll") for (int n = 0; n < 2; ++n) _Pragma("unroll") for (int k = 0; k < 2; ++k) \
        acc[ai][bj][m][n] = __builtin_amdgcn_mfma_f32_16x16x32_bf16(Bt[n][k], At[m][k], acc[ai][bj][m][n], 0, 0, 0); __builtin_amdgcn_s_setprio(0); } while (0)
#define PG8_WAIT_V(n) asm volatile("s_waitcnt vmcnt(" #n ")" ::: "memory")
#define PG8_WAIT_L(n) asm volatile("s_waitcnt lgkmcnt(" #n ")" ::: "memory")
#define PG8_BAR __builtin_amdgcn_s_barrier()
#define PG8_SCHED __builtin_amdgcn_sched_barrier(0)
    Unit cur, nxt; int ui = 0;
    if (!S.next(0, cur)) return;
    f32x4 acc[2][2][4][2];
#pragma unroll
    for (int a = 0; a < 2; ++a)
#pragma unroll
        for (int b = 0; b < 2; ++b)
#pragma unroll
            for (int m = 0; m < 4; ++m)
#pragma unroll
                for (int n = 0; n < 2; ++n) acc[a][b][m][n] = (f32x4){0.f, 0.f, 0.f, 0.f};
    bf16x8 At[4][2], B0[2][2], B1[2][2];
    const char* cA = (const char*)g.A + (size_t)cur.pm * tstep; const char* cB = (const char*)g.Bt + (size_t)cur.pn * tstep;
    S.a_ready(cur);
    if constexpr (SP2) {
        PG8_STAGE(PG8_SB(0, 0), cB, voffB); PG8_STAGE(PG8_SB(0, 1), cB + hstep, voffB); PG8_STAGE(PG8_SA(0, 0), cA, voffA); PG8_STAGE(PG8_SA(0, 1), cA + hstep, voffA);
        if (wr == 1) PG8_BAR;
        PG8_WAIT_V(2); PG8_BAR;
        PG8_STAGE(PG8_SB(1, 0), cB + kstep, voffB); PG8_STAGE(PG8_SA(1, 0), cA + kstep, voffA); PG8_STAGE(PG8_SB(1, 1), cB + hstep + kstep, voffB);
        PG8_WAIT_V(6); PG8_BAR;
    } else {
        PG8_STAGE(PG8_SB(0, 0), cB, voffB); PG8_STAGE(PG8_SA(0, 0), cA, voffA); PG8_STAGE(PG8_SB(0, 1), cB + hstep, voffB); PG8_STAGE(PG8_SA(0, 1), cA + hstep, voffA);
        if (wr == 1) PG8_BAR;
        PG8_WAIT_V(4); PG8_BAR;
        PG8_STAGE(PG8_SB(1, 0), cB + kstep, voffB); PG8_STAGE(PG8_SA(1, 0), cA + kstep, voffA); PG8_STAGE(PG8_SB(1, 1), cB + hstep + kstep, voffB);
        PG8_WAIT_V(6); PG8_BAR;
    }
    for (;;) {
        const bool has_next = S.next(ui + 1, nxt);
        const char* nA = has_next ? (const char*)g.A + (size_t)nxt.pm * tstep : cA; const char* nB = has_next ? (const char*)g.Bt + (size_t)nxt.pn * tstep : cB;
        for (int t = 0; t < nt; t += 2) {
            const bool last = (t == nt - 2);
            const char* a1 = cA + (size_t)(t + 1) * kstep;
            const char* a2 = last ? nA : cA + (size_t)(t + 2) * kstep; const char* b2 = last ? nB : cB + (size_t)(t + 2) * kstep;
            const char* a3 = a2 + kstep; const char* b3 = b2 + kstep;
            if (last && has_next) S.a_ready(nxt);
            if constexpr (SP2) {
            PG8_LDB(B0, 0, 0); PG8_LDB(B1, 0, 1); PG8_SCHED; PG8_LDA(At, 0, 0); PG8_STAGE(PG8_SA(1, 1), a1 + hstep, voffA);
            PG8_WAIT_V(8); PG8_WAIT_L(0); PG8_BAR; PG8_MMA(0, 0, At, B0); PG8_MMA(0, 1, At, B1); PG8_BAR; PG8_SCHED;
            PG8_LDA(At, 0, 1); PG8_STAGE(PG8_SB(0, 0), b2, voffB); PG8_STAGE(PG8_SB(0, 1), b2 + hstep, voffB); PG8_STAGE(PG8_SA(0, 0), a2, voffA);
            PG8_WAIT_V(8); PG8_WAIT_L(0); PG8_BAR; PG8_MMA(1, 0, At, B0); PG8_MMA(1, 1, At, B1); PG8_BAR; PG8_SCHED;
            PG8_LDB(B0, 1, 0); PG8_LDB(B1, 1, 1); PG8_SCHED; PG8_LDA(At, 1, 0); PG8_STAGE(PG8_SA(0, 1), a2 + hstep, voffA);
            PG8_WAIT_V(8); PG8_WAIT_L(0); PG8_BAR; PG8_MMA(0, 0, At, B0); PG8_MMA(0, 1, At, B1); PG8_BAR; PG8_SCHED;
            PG8_LDA(At, 1, 1); PG8_STAGE(PG8_SB(1, 0), b3, voffB); PG8_STAGE(PG8_SB(1, 1), b3 + hstep, voffB); PG8_STAGE(PG8_SA(1, 0), a3, voffA);
            PG8_WAIT_V(8); PG8_WAIT_L(0); PG8_BAR; PG8_MMA(1, 0, At, B0); PG8_MMA(1, 1, At, B1); PG8_BAR; PG8_SCHED;
            } else {
            PG8_LDB(B0, 0, 0); PG8_SCHED; PG8_LDA(At, 0, 0); PG8_STAGE(PG8_SA(1, 1), a1 + hstep, voffA);
            PG8_WAIT_L(8); PG8_BAR; PG8_WAIT_L(0); PG8_MMA(0, 0, At, B0); PG8_BAR; PG8_SCHED;
            PG8_LDB(B1, 0, 1); PG8_STAGE(PG8_SB(0, 0), b2, voffB);
            PG8_BAR; PG8_WAIT_L(0); PG8_MMA(0, 1, At, B1); PG8_BAR;
            PG8_LDA(At, 0, 1); PG8_STAGE(PG8_SA(0, 0), a2, voffA);
            PG8_BAR; PG8_WAIT_L(0); PG8_MMA(1, 0, At, B0); PG8_BAR; PG8_SCHED;
            PG8_STAGE(PG8_SB(0, 1), b2 + hstep, voffB);
            PG8_WAIT_V(6); PG8_BAR; PG8_MMA(1, 1, At, B1); PG8_BAR;
            PG8_LDB(B0, 1, 0); PG8_SCHED; PG8_LDA(At, 1, 0); PG8_STAGE(PG8_SA(0, 1), a2 + hstep, voffA);
            PG8_WAIT_L(8); PG8_BAR; PG8_WAIT_L(0); PG8_MMA(0, 0, At, B0); PG8_BAR; PG8_SCHED;
            PG8_LDB(B1, 1, 1); PG8_STAGE(PG8_SB(1, 0), b3, voffB);
            PG8_BAR; PG8_WAIT_L(0); PG8_MMA(0, 1, At, B1); PG8_BAR;
            PG8_LDA(At, 1, 1); PG8_STAGE(PG8_SA(1, 0), a3, voffA);
            PG8_BAR; PG8_WAIT_L(0); PG8_MMA(1, 0, At, B0); PG8_BAR; PG8_SCHED;
            PG8_STAGE(PG8_SB(1, 1), b3 + hstep, voffB);
            PG8_WAIT_V(6); PG8_BAR; PG8_MMA(1, 1, At, B1); PG8_BAR;
            }
        }
        if constexpr (ALIGN_EPI) { if (wr == 0) PG8_BAR; }
        if constexpr (!Epi::AFTER_DRAIN) { E(acc, cur, wr, wc, fr, fq); S.done(cur); }
        if (!has_next) break;
#pragma unroll
        for (int a = 0; a < 2; ++a)
#pragma unroll
            for (int b = 0; b < 2; ++b)
#pragma unroll
                for (int m = 0; m < 4; ++m)
#pragma unroll
                    for (int n = 0; n < 2; ++n) acc[a][b][m][n] = (f32x4){0.f, 0.f, 0.f, 0.f};
        cur = nxt; cA = nA; cB = nB; ++ui;
        if constexpr (ALIGN_EPI) { if (wr == 1) PG8_BAR; }
    }
    PG8_WAIT_V(0);
    if constexpr (!ALIGN_EPI) { if (wr == 0) PG8_BAR; }
    PG8_BAR;
    if constexpr (Epi::AFTER_DRAIN) { E.fused(acc, cur, wr, wc, fr, fq, lds, wid, lane); S.done(cur); }
#undef PG8_SA
#undef PG8_SB
#undef PG8_STAGE
#undef PG8_LDA
#undef PG8_LDB
#undef PG8_MMA
#undef PG8_WAIT_V
#undef PG8_WAIT_L
#undef PG8_BAR
#undef PG8_SCHED
}
}
namespace pg8 {
__device__ __forceinline__ float fsig(float v) { return __builtin_amdgcn_rcpf(1.0f + __builtin_amdgcn_exp2f(-1.4426950408889634f * v)); }
__device__ __forceinline__ float bf_lo(unsigned w) { return __uint_as_float(w << 16); }
__device__ __forceinline__ float bf_hi(unsigned w) { return __uint_as_float(w & 0xffff0000u); }

struct EpiInProj {
    static constexpr bool PERM = true, AFTER_DRAIN = false;
    bf16_t* QA; bf16_t* QB; bf16_t* KA; bf16_t* VA; float* G; bf16_t* IB; bf16_t* GB; const float* lbl; int layer; float qscale;
    __device__ __forceinline__ void operator()(const f32x4 (&acc)[2][2][4][2], const Unit& u, int wr, int wc, int fr, int fq) const {
        const int type = u.pn >> 1;
        const int ct = (u.pn & 1) * 256 + wc * 32 + 8 * fq;
        const int row0 = u.pm * BM + wr * 64 + fr;
        if (type == 4) {
            float lb[2][8];
#pragma unroll
            for (int bj = 0; bj < 2; ++bj)
#pragma unroll
                for (int j = 0; j < 8; ++j) {
                    float v = 0.f;
                    if (layer != 0) { const float l0 = lbl[ct + bj * HALF + j], l1 = lbl[512 + ct + bj * HALF + j]; v = 1.0f / (1.0f + __expf(l0 - l1)); }
                    lb[bj][j] = v;
                }
#pragma unroll
            for (int ai = 0; ai < 2; ++ai)
#pragma unroll
                for (int m = 0; m < 4; ++m) { float* rowp = G + (size_t)(row0 + ai * HALF + m * 16) * 512 + ct;
#pragma unroll
                    for (int bj = 0; bj < 2; ++bj) { f32x4 o0, o1;
#pragma unroll
                        for (int j = 0; j < 4; ++j) {
                            const float f0 = lb[bj][j] + (1.0f - lb[bj][j]) * fsig(acc[ai][bj][m][0][j]);
                            const float f1 = lb[bj][4 + j] + (1.0f - lb[bj][4 + j]) * fsig(acc[ai][bj][m][1][j]);
                            o0[j] = __builtin_amdgcn_logf(f0) * 0.6931471805599453f; o1[j] = __builtin_amdgcn_logf(f1) * 0.6931471805599453f; }
                        *(f32x4*)(rowp + bj * HALF) = o0; *(f32x4*)(rowp + bj * HALF + 4) = o1; } }
        } else {
            bf16_t* base; int ldc = 512, act = 0; float sc = 1.f;
            if (type == 0) { base = QA; sc = qscale; }
            else if (type == 1) base = KA;
            else if (type == 2) base = VA;
            else if (type == 3) { base = QB; act = 1; }
            else if (type == 5) base = IB;
            else { base = GB; act = 2; }
#pragma unroll
            for (int ai = 0; ai < 2; ++ai)
#pragma unroll
                for (int m = 0; m < 4; ++m) { bf16_t* rowp = base + (size_t)(row0 + ai * HALF + m * 16) * ldc + ct;
#pragma unroll
                    for (int bj = 0; bj < 2; ++bj) { f32x4 v0 = acc[ai][bj][m][0], v1 = acc[ai][bj][m][1];
                        if (act != 0) {
#pragma unroll
                            for (int j = 0; j < 4; ++j) { const float s0 = fsig(v0[j]), s1 = fsig(v1[j]); v0[j] = (act == 1) ? v0[j] * s0 : s0; v1[j] = (act == 1) ? v1[j] * s1 : s1; }
                        } else { v0 = v0 * sc; v1 = v1 * sc; }
                        u32x4 w; w.x = cvt_pk_bf16(v0[0], v0[1]); w.y = cvt_pk_bf16(v0[2], v0[3]); w.z = cvt_pk_bf16(v1[0], v1[1]); w.w = cvt_pk_bf16(v1[2], v1[3]);
                        *(u32x4*)(rowp + bj * HALF) = w; } }
        }
    }
};
struct EpiGates {
    static constexpr bool PERM = true, AFTER_DRAIN = false;
    bf16_t* O;
    __device__ __forceinline__ void operator()(const f32x4 (&acc)[2][2][4][2], const Unit& u, int wr, int wc, int fr, int fq) const {
        const int row0 = u.pm * BM + wr * 64 + fr, col0 = u.pn * BM + wc * 32 + 8 * fq;
#pragma unroll
        for (int ai = 0; ai < 2; ++ai)
#pragma unroll
            for (int m = 0; m < 4; ++m) { bf16_t* rowp = O + (size_t)(row0 + ai * HALF + m * 16) * 2048 + col0;
#pragma unroll
                for (int bj = 0; bj < 2; ++bj) { f32x4 v0 = acc[ai][bj][m][0], v1 = acc[ai][bj][m][1];
#pragma unroll
                    for (int j = 0; j < 4; ++j) { v0[j] = fsig(v0[j]); v1[j] = fsig(v1[j]); }
                    u32x4 w; w.x = cvt_pk_bf16(v0[0], v0[1]); w.y = cvt_pk_bf16(v0[2], v0[3]); w.z = cvt_pk_bf16(v1[0], v1[1]); w.w = cvt_pk_bf16(v1[2], v1[3]);
                    *(u32x4*)(rowp + bj * HALF) = w; } }
    }
};
template <int STEP> struct EpiMerge {
    static constexpr bool PERM = true, AFTER_DRAIN = false;
    const bf16_t* GT; bf16_t* O;
    __device__ __forceinline__ void operator()(const f32x4 (&acc)[2][2][4][2], const Unit& u, int wr, int wc, int fr, int fq) const {
        const int row0 = u.pm * BM + wr * 64 + fr, col0 = u.pn * BM + wc * 32 + 8 * fq;
#pragma unroll
        for (int ai = 0; ai < 2; ++ai) {
            u32x4 gq[4][2], tq[4][2];
#pragma unroll
            for (int m = 0; m < 4; ++m) { const size_t row = (size_t)(row0 + ai * HALF + m * 16);
#pragma unroll
                for (int bj = 0; bj < 2; ++bj) { gq[m][bj] = *(const u32x4*)(GT + row * 2048 + STEP * 1024 + col0 + bj * HALF);
                    if (STEP == 1) tq[m][bj] = *(const u32x4*)(O + row * 1024 + col0 + bj * HALF); } }
            asm volatile("" ::: "memory");
#pragma unroll
            for (int m = 0; m < 4; ++m) { const size_t row = (size_t)(row0 + ai * HALF + m * 16);
#pragma unroll
                for (int bj = 0; bj < 2; ++bj) { const u32x4 g = gq[m][bj];
                    const f32x4 a0 = acc[ai][bj][m][0], a1 = acc[ai][bj][m][1];
                    float o[8] = {bf_lo(g.x) * a0[0], bf_hi(g.x) * a0[1], bf_lo(g.y) * a0[2], bf_hi(g.y) * a0[3], bf_lo(g.z) * a1[0], bf_hi(g.z) * a1[1], bf_lo(g.w) * a1[2], bf_hi(g.w) * a1[3]};
                    if (STEP == 1) { const u32x4 t = tq[m][bj];
                        o[0] += bf_lo(t.x); o[1] += bf_hi(t.x); o[2] += bf_lo(t.y); o[3] += bf_hi(t.y); o[4] += bf_lo(t.z); o[5] += bf_hi(t.z); o[6] += bf_lo(t.w); o[7] += bf_hi(t.w); }
                    u32x4 w; w.x = cvt_pk_bf16(o[0], o[1]); w.y = cvt_pk_bf16(o[2], o[3]); w.z = cvt_pk_bf16(o[4], o[5]); w.w = cvt_pk_bf16(o[6], o[7]);
                    *(u32x4*)(O + row * 1024 + col0 + bj * HALF) = w; } }
            asm volatile("" ::: "memory");
        }
    }
};
struct EpiSwiGLU {
    static constexpr bool PERM = true, AFTER_DRAIN = false;
    bf16_t* O;
    __device__ __forceinline__ void operator()(const f32x4 (&acc)[2][2][4][2], const Unit& u, int wr, int wc, int fr, int fq) const {
        const int row0 = u.pm * BM + wr * 64 + fr, col0 = u.pn * HALF + wc * 32 + 8 * fq;
#pragma unroll
        for (int ai = 0; ai < 2; ++ai)
#pragma unroll
            for (int m = 0; m < 4; ++m) { const size_t row = (size_t)(row0 + ai * HALF + m * 16);
                f32x4 v0, v1;
#pragma unroll
                for (int j = 0; j < 4; ++j) { const float g0 = acc[ai][1][m][0][j], g1 = acc[ai][1][m][1][j];
                    v0[j] = g0 * fsig(g0) * acc[ai][0][m][0][j]; v1[j] = g1 * fsig(g1) * acc[ai][0][m][1][j]; }
                u32x4 w; w.x = cvt_pk_bf16(v0[0], v0[1]); w.y = cvt_pk_bf16(v0[2], v0[3]); w.z = cvt_pk_bf16(v1[0], v1[1]); w.w = cvt_pk_bf16(v1[2], v1[3]);
                *(u32x4*)(O + row * 2816 + col0) = w; }
    }
};
struct EpiResid {
    static constexpr bool PERM = false, AFTER_DRAIN = false;
    const float* xres; float* out; float alpha; const float* st; const float* gam; const float* bet;
    __device__ __forceinline__ void operator()(const f32x4 (&acc)[2][2][4][2], const Unit& u, int wr, int wc, int fr, int fq) const {
        const int row0 = u.pm * BM + wr * 64 + fr, col0 = u.pn * BM + wc * 32 + 4 * fq;
        typedef float f32x2e __attribute__((ext_vector_type(2)));
        f32x4 gv[2][2], bv[2][2];
        if (st) {
#pragma unroll
            for (int bj = 0; bj < 2; ++bj)
#pragma unroll
                for (int n = 0; n < 2; ++n) { gv[bj][n] = *(const f32x4*)(gam + col0 + bj * HALF + n * 16); bv[bj][n] = *(const f32x4*)(bet + col0 + bj * HALF + n * 16); }
        }
#pragma unroll
        for (int ai = 0; ai < 2; ++ai)
#pragma unroll
            for (int m = 0; m < 4; ++m) { const size_t row = (size_t)(row0 + ai * HALF + m * 16); const size_t off = row * 1024 + col0;
                f32x2e sr = {0.f, 1.f}; if (st) sr = *(const f32x2e*)(st + 2 * row);
#pragma unroll
                for (int bj = 0; bj < 2; ++bj)
#pragma unroll
                    for (int n = 0; n < 2; ++n) { f32x4 x = *(const f32x4*)(xres + off + bj * HALF + n * 16);
                        if (st) x = (x - sr.x) * sr.y * gv[bj][n] + bv[bj][n];
                        *(f32x4*)(out + off + bj * HALF + n * 16) = x * alpha + acc[ai][bj][m][n]; }
                if (m & 1) asm volatile("" ::: "memory"); }
    }
};
}
#include <hip/hip_bf16.h>
#include <cmath>
namespace attn_body {
using bf16=__hip_bfloat16;
using bf16x8=__attribute__((ext_vector_type(8)))short;
using s16x4=__attribute__((ext_vector_type(4)))short;
using f32x16=__attribute__((ext_vector_type(16)))float;
using u32x4=__attribute__((ext_vector_type(4)))unsigned;
constexpr int BATCH=2,NHEAD=8,SEQ=16384,D=64,QP=512,KP=512;
constexpr int NW=8,QBLK=32,QB=QBLK*NW,KVBLK=64,NQB=SEQ/QB;
constexpr int ATTN_UNIT_ROWS=QB;
__device__ __forceinline__ int crow(int r,int hi){return (r&3)+8*(r>>2)+4*hi;}
#define SBAR() __builtin_amdgcn_sched_barrier(0)
__device__ __forceinline__ void cmask(f32x16&p0,f32x16&p1,int jb,int qrel,int hi){
  const float NEG=-INFINITY; int kb=64*jb+4*hi;
  #pragma unroll
  for(int r=0;r<16;++r){int kv=kb+(r&3)+8*(r>>2); if(kv>qrel)p0[r]=NEG; if(kv+32>qrel)p1[r]=NEG;}
}

constexpr int NSLOT=3, SLOTB=8192;
constexpr int LDS_K=0, LDS_V=NSLOT*SLOTB, LDS_WS=2*NSLOT*SLOTB, LDS_OST=LDS_WS+NW*64*4, LDS_FB=LDS_OST+NW*4096, LDS_BYTES=LDS_FB+SEQ*4;
constexpr float C2=0.125f*1.4426950408889634f;
__device__ __forceinline__ void glds16(const void*gsrc,unsigned lds_dst){unsigned keep;
  asm volatile("s_mov_b32 %0, m0\n\ts_mov_b32 m0, %2\n\ts_nop 0\n\tglobal_load_lds_dwordx4 %1, off\n\ts_mov_b32 m0, %0":"=&s"(keep):"v"(gsrc),"s"(lds_dst):"memory");}
__device__ __forceinline__ float max3f(float a,float b,float c){float r;asm("v_max3_f32 %0, %1, %2, %3":"=v"(r):"v"(a),"v"(b),"v"(c));return r;}
__device__ __forceinline__ float max2f(float a,float b){float r;asm("v_max_f32_e32 %0, %1, %2":"=v"(r):"v"(a),"v"(b));return r;}
__device__ __forceinline__ float fadd_s(float a,float b){float r;asm("v_add_f32_e32 %0, %1, %2":"=v"(r):"v"(a),"v"(b));return r;}
__device__ __forceinline__ float fsub_s(float a,float b){float r;asm("v_sub_f32_e32 %0, %1, %2":"=v"(r):"v"(a),"v"(b));return r;}
typedef float f32x2_t __attribute__((ext_vector_type(2))); typedef __bf16 bf16x2_t __attribute__((ext_vector_type(2)));
__device__ __forceinline__ unsigned cvtpk_s(float lo,float hi){f32x2_t v={lo,hi};bf16x2_t b=__builtin_convertvector(v,bf16x2_t);return __builtin_bit_cast(unsigned,b);}
#define WAIT_BAR(N) asm volatile("s_waitcnt vmcnt(" #N ") lgkmcnt(0)\n\ts_barrier":::"memory")

__device__ __forceinline__ void qkt(f32x16&p0,f32x16&p1,const char*Kslot,const bf16x8*qr,int r32,int hi){
  const char*kb=Kslot+hi*1024+r32*16;
  #pragma unroll
  for(int d0=0;d0<4;++d0){
    const bf16x8 b0=*reinterpret_cast<const bf16x8*>(kb+d0*2048);
    const bf16x8 b1=*reinterpret_cast<const bf16x8*>(kb+d0*2048+512);
    p0=__builtin_amdgcn_mfma_f32_32x32x16_bf16(b0,qr[d0],p0,0,0,0);p1=__builtin_amdgcn_mfma_f32_32x32x16_bf16(b1,qr[d0],p1,0,0,0);}
}
typedef __attribute__((address_space(3))) const char* lds_cptr;
typedef short v4i16_t __attribute__((ext_vector_type(4)));
__device__ __forceinline__ void kload8(bf16x8*kf,lds_cptr kp){
  kf[0]=*(const __attribute__((address_space(3))) bf16x8*)(kp);      kf[1]=*(const __attribute__((address_space(3))) bf16x8*)(kp+512);
  kf[2]=*(const __attribute__((address_space(3))) bf16x8*)(kp+2048); kf[3]=*(const __attribute__((address_space(3))) bf16x8*)(kp+2560);
  kf[4]=*(const __attribute__((address_space(3))) bf16x8*)(kp+4096); kf[5]=*(const __attribute__((address_space(3))) bf16x8*)(kp+4608);
  kf[6]=*(const __attribute__((address_space(3))) bf16x8*)(kp+6144); kf[7]=*(const __attribute__((address_space(3))) bf16x8*)(kp+6656);
}
__device__ __forceinline__ void kload2(bf16x8*kf,lds_cptr kp,int j){ kf[2*j]=*(const __attribute__((address_space(3))) bf16x8*)(kp+j*2048); kf[2*j+1]=*(const __attribute__((address_space(3))) bf16x8*)(kp+j*2048+512); }
__device__ __forceinline__ s16x4 vtr(lds_cptr p){ return __builtin_bit_cast(s16x4,__builtin_amdgcn_ds_read_tr16_b64_v4i16((__attribute__((address_space(3))) v4i16_t*)p)); }
__device__ __forceinline__ float rowmax(const f32x16&p0,const f32x16&p1){
  float a=max3f(p0[0],p0[1],p1[0]),b=max3f(p0[2],p0[3],p1[1]);a=max3f(a,p1[2],p1[3]);
  #pragma unroll
  for(int r=4;r<16;r+=4){a=max3f(a,p0[r],p0[r+1]);b=max3f(b,p0[r+2],p0[r+3]);a=max3f(a,p1[r],p1[r+1]);b=max3f(b,p1[r+2],p1[r+3]);}
  const float m=max2f(a,b);
  auto rr=__builtin_amdgcn_permlane32_swap(__float_as_uint(m),__float_as_uint(m),false,false);
  return max2f(__uint_as_float(rr[0]),__uint_as_float(rr[1]));
}
__device__ __forceinline__ void pv(f32x16*o,int vb,bf16x8 pa0,bf16x8 pa1,bf16x8 pa2,bf16x8 pa3){
  #pragma unroll
  for(int d0=0;d0<2;++d0){s16x4 lo[4],hi[4];
    #pragma unroll
    for(int ks=0;ks<4;++ks){
      asm volatile("ds_read_b64_tr_b16 %0,%1 offset:%c2":"=&v"(lo[ks]):"v"(vb),"i"(d0*4096+ks*1024):"memory");
      asm volatile("ds_read_b64_tr_b16 %0,%1 offset:%c2":"=&v"(hi[ks]):"v"(vb),"i"(d0*4096+ks*1024+512):"memory");}
    asm volatile("s_waitcnt lgkmcnt(0)":::"memory");SBAR();
    #define PK(k) (bf16x8){lo[k][0],lo[k][1],lo[k][2],lo[k][3],hi[k][0],hi[k][1],hi[k][2],hi[k][3]}
    o[d0]=__builtin_amdgcn_mfma_f32_32x32x16_bf16(pa0,PK(0),o[d0],0,0,0);
    o[d0]=__builtin_amdgcn_mfma_f32_32x32x16_bf16(pa1,PK(1),o[d0],0,0,0);
    o[d0]=__builtin_amdgcn_mfma_f32_32x32x16_bf16(pa2,PK(2),o[d0],0,0,0);
    o[d0]=__builtin_amdgcn_mfma_f32_32x32x16_bf16(pa3,PK(3),o[d0],0,0,0);
    #undef PK
  }
}

#ifndef ATTN_STORE16
#define ATTN_STORE16(p,v) (*(u32x4*)(p)=(v))
#endif
template<int THRL> __device__ __forceinline__ void attn_unit(int b,int h,int qb,const bf16*Q,const bf16*__restrict__ K,const bf16*__restrict__ V,bf16*O,const float*__restrict__ Fg,const unsigned*__restrict__ NB,char*shm){
  int tid_=threadIdx.x; asm volatile("":"+v"(tid_));
  const int tid=tid_,lane=tid&63,r32=lane&31,hi=lane>>5; const int wid=__builtin_amdgcn_readfirstlane(tid>>6);
  const long rowbase=(long)b*SEQ; const int q0=qb*QB;
  const bf16*Qw=Q+(rowbase+q0+wid*QBLK)*QP+h*D;
  const bf16*Kh=K+rowbase*KP+h*D,*Vh=V+rowbase*KP+h*D;
  __attribute__((address_space(3))) char* const shm3w=(__attribute__((address_space(3))) char*)shm;
  const unsigned lds0=(unsigned)(uintptr_t)shm;
  float*wsf=(float*)(shm+LDS_WS)+wid*64;
  const bf16*ksrc_=Kh+(long)lane*KP+wid*8;
  const bf16*vsrc_=Vh+(long)(16*(wid&3)+(lane>>2))*KP+(wid>>2)*32+(lane&3)*8;
  const unsigned kdst=lds0+LDS_K+wid*1024, vdst=lds0+LDS_V+wid*1024;
  #define DMA_K(t,slot) glds16(ksrc+(long)(t)*KVBLK*KP,(unsigned)__builtin_amdgcn_readfirstlane(kdst+(slot)))
  #define DMA_V(t,slot) glds16(vsrc+(long)(t)*KVBLK*KP,(unsigned)__builtin_amdgcn_readfirstlane(vdst+(slot)))
  const int vb0=(int)(lds0+LDS_V)+((lane>>4)&1)*32+(lane&3)*8+(4*hi+((lane&15)>>2))*64;
  const char*Kbase=shm+LDS_K; bf16x8 kf[8];
  const lds_cptr shm3=(lds_cptr)shm; const lds_cptr kp0=shm3+LDS_K+hi*1024+r32*16; const lds_cptr vp0=shm3+LDS_V+((lane>>4)&1)*32+(lane&3)*8+(4*hi+((lane&15)>>2))*64;
  const int NT0=(q0+QB)/KVBLK;
  int j0;
  { typedef __attribute__((address_space(3))) unsigned* lds_uptr; const lds_uptr cnt=(lds_uptr)(shm3w+LDS_BYTES+16);
    const float fref=Fg[q0]; const float Bq=__builtin_sqrtf(__uint_as_float(NB[0])*__uint_as_float(NB[1])); const float thr=-(152.0f+2.0f*Bq);
    if(tid==0)*cnt=0u;
    asm volatile("s_waitcnt lgkmcnt(0)\n\ts_barrier":::"memory");
    bool skip=false; if(tid<NT0-4){ skip=((fref-Fg[64*tid+63])*1.4426950408889634f<thr); }
    const unsigned long long bal=__ballot(skip); if(lane==0&&bal)__hip_atomic_fetch_add(cnt,(unsigned)__popcll(bal),__ATOMIC_RELAXED,__HIP_MEMORY_SCOPE_WORKGROUP);
    asm volatile("s_waitcnt lgkmcnt(0)\n\ts_barrier":::"memory");
    j0=(int)(*cnt)&~1; j0=__builtin_amdgcn_readfirstlane(j0);
    typedef __attribute__((address_space(3))) float* lds_fptr; const lds_fptr fbl=(lds_fptr)(shm3w+LDS_FB);
    for(int i=64*j0+tid;i<q0+QB;i+=NW*64) fbl[i]=(fref-Fg[i])*1.4426950408889634f; }
  const int NT=NT0-j0;
  const bf16*ksrc=ksrc_+(long)j0*KVBLK*KP; const bf16*vsrc=vsrc_+(long)j0*KVBLK*KP;
  DMA_K(0,0);DMA_V(0,0);DMA_K(1,SLOTB);
  bf16x8 qr[4];
  #pragma unroll
  for(int d0=0;d0<4;++d0)qr[d0]=*reinterpret_cast<const bf16x8*>(&Qw[(long)r32*QP+d0*16+hi*8]);
  float mhat=0.f,l_reg=0.f;f32x16 o[2];o[0]=f32x16{};o[1]=f32x16{};
  const lds_cptr fb0=(lds_cptr)shm3w+LDS_FB+hi*16+j0*256;
  typedef float f32x4v __attribute__((ext_vector_type(4)));
  #define BLD(P0,P1,t) do{ const lds_cptr fp_=fb0+(t)*256; _Pragma("unroll") for(int j_=0;j_<4;++j_){ \
      const f32x4v a_=*(const __attribute__((address_space(3))) f32x4v*)(fp_+j_*32), b_=*(const __attribute__((address_space(3))) f32x4v*)(fp_+128+j_*32); \
      P0[4*j_]=a_[0];P0[4*j_+1]=a_[1];P0[4*j_+2]=a_[2];P0[4*j_+3]=a_[3]; P1[4*j_]=b_[0];P1[4*j_+1]=b_[1];P1[4*j_+2]=b_[2];P1[4*j_+3]=b_[3]; } }while(0)
  const int qrel=wid*QBLK+r32;
  #define CMASK(P0,P1,t) do{int jb_=(t)-(NT-4); if(jb_>=0)cmask(P0,P1,jb_,qrel,hi);}while(0)
  bool resc=false;
  #define START(P0,P1) do{ const float rm=rowmax(P0,P1); resc=false; mhat=rm; \
    _Pragma("unroll") for(int r=0;r<16;++r)P0[r]=__builtin_amdgcn_exp2f(P0[r]-mhat); }while(0)
  #define RESC() do{ if(resc){ asm volatile("s_waitcnt lgkmcnt(0)":::"memory"); \
      _Pragma("unroll") for(int d_=0;d_<2;++d_) _Pragma("unroll") for(int r=0;r<16;++r)o[d_][r]*=wsf[crow(r,hi)]; } }while(0)
  f32x16 pA0,pA1,pB0,pB1;
  int sl_prev=0,sl_cur=0,sl_next=SLOTB;
  #define ROT() do{sl_prev=sl_cur;sl_cur=sl_next;sl_next=(sl_next==(NSLOT-1)*SLOTB)?0:sl_next+SLOTB;}while(0)
  DMA_K(2,2*SLOTB);
  WAIT_BAR(3);
  BLD(pA0,pA1,0);
  qkt(pA0,pA1,Kbase,qr,r32,hi);asm volatile("s_nop 15\n\ts_nop 7":"+v"(pA0),"+v"(pA1));CMASK(pA0,pA1,0);
  START(pA0,pA1);
  _Pragma("unroll") for(int r=0;r<16;++r)pA1[r]=__builtin_amdgcn_exp2f(pA1[r]-mhat);
  WAIT_BAR(0);
  DMA_K(3,0);DMA_V(1,SLOTB);
  ROT();
  kload8(kf,kp0+sl_cur);
  BLD(pB0,pB1,1);
  WAIT_BAR(2);
  s16x4 vlo[8],vhi[8]; u32x4 pw0,pw1,pw2,pw3;
  #define PKW(P,B) cvtpk_s(P[B],P[B+1])
  #define PAF(k) __builtin_bit_cast(bf16x8,pw##k)
  #define VFR(i) (bf16x8){vlo[i][0],vlo[i][1],vlo[i][2],vlo[i][3],vhi[i][0],vhi[i][1],vhi[i][2],vhi[i][3]}
  #define PIN(x) asm volatile("":"+v"(x))
  #define MX3(a,b,c) __builtin_fmaxf(__builtin_fmaxf((a),(b)),(c))
  #define GAPA(MF,A0,A1,A2,A3,W0,W1,PW) do{ MF; sacc+=A0; sacc+=A1; sacc+=A2; sacc+=A3; PIN(sacc); W0; W1; PIN(PW); SBAR(); }while(0)
  #define EX(v) __builtin_amdgcn_exp2f(v)
  #define GAPB(MF,X,B) do{ MF; X[B]=EX(X[B]-mhat); X[B+1]=EX(X[B+1]-mhat); X[B+2]=EX(X[B+2]-mhat); X[B+3]=EX(X[B+3]-mhat); PIN(X); SBAR(); }while(0)
  #define VRD(i) do{ vlo[i]=vtr(vp_+(((i)>>2)*4096+((i)&3)*1024)); vhi[i]=vtr(vp_+(((i)>>2)*4096+((i)&3)*1024+512)); }while(0)
  #define KRD(G,j) do{ if(G){ kload2(kf,kp0+sl_next,j); SBAR(); } }while(0)
  #define STEP(C0,C1,P0,P1,t,GK,GV,GL) do{ SBAR(); \
    const lds_cptr vp_=vp0+sl_prev; \
    VRD(0); SBAR(); float sacc=(P0[0]+P0[1]); \
    GAPA(C0=__builtin_amdgcn_mfma_f32_32x32x16_bf16(kf[0],qr[0],C0,0,0,0), P0[2],P0[3],P0[4],P0[5],     pw0[0]=PKW(P0,0), pw0[1]=PKW(P0,2), pw0); \
    VRD(4); SBAR(); GAPA(C1=__builtin_amdgcn_mfma_f32_32x32x16_bf16(kf[1],qr[0],C1,0,0,0), P0[6],P0[7],P0[8],P0[9],     pw0[2]=PKW(P0,4), pw0[3]=PKW(P0,6), pw0); \
    VRD(1); SBAR(); GAPA(C0=__builtin_amdgcn_mfma_f32_32x32x16_bf16(kf[2],qr[1],C0,0,0,0),   P0[10],P0[11],P0[12],P0[13], pw1[0]=PKW(P0,8), pw1[1]=PKW(P0,10), pw1); \
    VRD(5); SBAR(); GAPA(C1=__builtin_amdgcn_mfma_f32_32x32x16_bf16(kf[3],qr[1],C1,0,0,0),   P0[14],P0[15],P1[0],P1[1],   pw1[2]=PKW(P0,12),pw1[3]=PKW(P0,14), pw1); \
    VRD(2); SBAR(); GAPA(C0=__builtin_amdgcn_mfma_f32_32x32x16_bf16(kf[4],qr[2],C0,0,0,0),   P1[2],P1[3],P1[4],P1[5],     pw2[0]=PKW(P1,0), pw2[1]=PKW(P1,2), pw2); \
    VRD(6); SBAR(); GAPA(C1=__builtin_amdgcn_mfma_f32_32x32x16_bf16(kf[5],qr[2],C1,0,0,0),   P1[6],P1[7],P1[8],P1[9],     pw2[2]=PKW(P1,4), pw2[3]=PKW(P1,6), pw2); \
    VRD(3); SBAR(); GAPA(C0=__builtin_amdgcn_mfma_f32_32x32x16_bf16(kf[6],qr[3],C0,0,0,0),   P1[10],P1[11],P1[12],P1[13], pw3[0]=PKW(P1,8), pw3[1]=PKW(P1,10), pw3); \
    VRD(7); SBAR(); GAPA(C1=__builtin_amdgcn_mfma_f32_32x32x16_bf16(kf[7],qr[3],C1,0,0,0),   P1[14],P1[15],0.f,0.f,       pw3[2]=PKW(P1,12),pw3[3]=PKW(P1,14), pw3); \
    l_reg+=sacc; \
    if(GK){DMA_K((t)+3,sl_cur);} if(GV){DMA_V((t)+1,sl_next);} \
    CMASK(C0,C1,t); \
    { float a=MX3(C0[0],C0[1],C1[0]),b=MX3(C0[2],C0[3],C1[1]); a=MX3(a,C1[2],C1[3]); \
      _Pragma("unroll") for(int r=4;r<16;r+=4){a=MX3(a,C0[r],C0[r+1]);b=MX3(b,C0[r+2],C0[r+3]);a=MX3(a,C1[r],C1[r+1]);b=MX3(b,C1[r+2],C1[r+3]);} \
      float rm=__builtin_fmaxf(a,b); { auto rr=__builtin_amdgcn_permlane32_swap(__float_as_uint(rm),__float_as_uint(rm),false,false); rm=__builtin_fmaxf(__uint_as_float(rr[0]),__uint_as_float(rr[1])); } \
      rm-=mhat; resc=false; \
      if(__builtin_expect(__any(rm>(float)THRL),0)){ const float dl=__builtin_fmaxf(rm,0.f); mhat+=dl; \
        const float f=__builtin_amdgcn_exp2f(-dl); l_reg*=f; if(hi==0)wsf[r32]=f; resc=true; } } \
    SBAR(); if(GL){ BLD(P0,P1,(t)+1); } \
    SBAR(); \
    GAPB(o[0]=__builtin_amdgcn_mfma_f32_32x32x16_bf16(PAF(0),VFR(0),o[0],0,0,0), C0,0); \
    GAPB(o[1]=__builtin_amdgcn_mfma_f32_32x32x16_bf16(PAF(0),VFR(4),o[1],0,0,0), C0,4); \
    KRD(GL,0); GAPB(o[0]=__builtin_amdgcn_mfma_f32_32x32x16_bf16(PAF(1),VFR(1),o[0],0,0,0), C0,8); \
    KRD(GL,1); GAPB(o[1]=__builtin_amdgcn_mfma_f32_32x32x16_bf16(PAF(1),VFR(5),o[1],0,0,0), C0,12); \
    KRD(GL,2); GAPB(o[0]=__builtin_amdgcn_mfma_f32_32x32x16_bf16(PAF(2),VFR(2),o[0],0,0,0), C1,0); \
    KRD(GL,3); GAPB(o[1]=__builtin_amdgcn_mfma_f32_32x32x16_bf16(PAF(2),VFR(6),o[1],0,0,0), C1,4); \
    GAPB(o[0]=__builtin_amdgcn_mfma_f32_32x32x16_bf16(PAF(3),VFR(3),o[0],0,0,0), C1,8); \
    GAPB(o[1]=__builtin_amdgcn_mfma_f32_32x32x16_bf16(PAF(3),VFR(7),o[1],0,0,0), C1,12); \
    }while(0)
  int t=1;
  #undef CMASK
  #define CMASK(P0,P1,t) do{}while(0)
  for(;t+5<NT;t+=2){
    STEP(pB0,pB1,pA0,pA1,t,true,true,true);     WAIT_BAR(2); RESC(); ROT();
    STEP(pA0,pA1,pB0,pB1,t+1,true,true,true);   WAIT_BAR(2); RESC(); ROT();
  }
  #undef CMASK
  #define CMASK(P0,P1,t) do{int jb_=(t)-(NT-4); if(jb_>=0)cmask(P0,P1,jb_,qrel,hi);}while(0)
  #define ENDW(tt) do{ if((tt)+3<NT){WAIT_BAR(2);} else if((tt)+2<NT){WAIT_BAR(1);} else {WAIT_BAR(0);} }while(0)
  for(;t+1<NT;t+=2){
    STEP(pB0,pB1,pA0,pA1,t,(t+3<NT),(t+1<NT),(t+1<NT));       ENDW(t);   RESC(); ROT();
    STEP(pA0,pA1,pB0,pB1,t+1,(t+4<NT),(t+2<NT),(t+2<NT));     ENDW(t+1); RESC(); ROT();
  }
  STEP(pB0,pB1,pA0,pA1,NT-1,false,false,false); RESC();
  { float sacc=pB0[0]+pB0[1]; _Pragma("unroll") for(int r=2;r<16;++r)sacc+=pB0[r]; _Pragma("unroll") for(int r=0;r<16;++r)sacc+=pB1[r]; l_reg+=sacc;
    pw0=(u32x4){PKW(pB0,0),PKW(pB0,2),PKW(pB0,4),PKW(pB0,6)};pw1=(u32x4){PKW(pB0,8),PKW(pB0,10),PKW(pB0,12),PKW(pB0,14)};pw2=(u32x4){PKW(pB1,0),PKW(pB1,2),PKW(pB1,4),PKW(pB1,6)};pw3=(u32x4){PKW(pB1,8),PKW(pB1,10),PKW(pB1,12),PKW(pB1,14)};
    SBAR(); pv(o,vb0+sl_cur,PAF(0),PAF(1),PAF(2),PAF(3)); }
  #undef PKW
  #undef PAF
  #undef VFR
  #undef PIN
  #undef MX3
  #undef GAPA
  #undef GAPB
  #undef EX
  #undef VRD
  #undef KRD
  #undef STEP
  #undef ENDW
  {auto rr=__builtin_amdgcn_permlane32_swap(__float_as_uint(l_reg),__float_as_uint(l_reg),false,false);l_reg=__uint_as_float(rr[0])+__uint_as_float(rr[1]);}
  if(hi==0)wsf[32+r32]=l_reg;asm volatile("s_waitcnt lgkmcnt(0)":::"memory");
  float rli[16];
  #pragma unroll
  for(int r=0;r<16;++r)rli[r]=__builtin_amdgcn_rcpf(wsf[32+crow(r,hi)]);
  bf16*Ow=O+(rowbase+q0+wid*QBLK)*QP+h*D;
  { bf16*stg=(bf16*)(shm+LDS_OST)+wid*2048;
    #pragma unroll
    for(int r=0;r<16;++r){const int orow=crow(r,hi);
      #pragma unroll
      for(int d0=0;d0<2;++d0)stg[orow*64+d0*32+r32]=__float2bfloat16(o[d0][r]*rli[r]);}
    asm volatile("s_waitcnt lgkmcnt(0)":::"memory");
    #pragma unroll
    for(int i=0;i<4;++i){const int row=i*8+(lane>>3),ch=lane&7; const u32x4 v=*(const u32x4*)(stg+row*64+ch*8); ATTN_STORE16(Ow+(long)row*QP+ch*8,v);} }
  asm volatile("s_waitcnt lgkmcnt(0)\n\ts_barrier":::"memory");
  #undef DMA_K
  #undef DMA_V
  #undef CMASK
  #undef START
  #undef RESC
  #undef BLD
  #undef ROT
}
constexpr int ATTN_LDS_BYTES=LDS_BYTES;
struct AttnTensors { const bf16* Q; const bf16* K; const bf16* V; bf16* O; const float* F; const unsigned* NB; };
struct AttnUnit { int bh; int qb; };
struct DynOrder {
  unsigned* ctr; volatile __attribute__((address_space(3))) unsigned* slot;
  __device__ __forceinline__ bool next(int,AttnUnit&u)const{
    if(threadIdx.x==0)*slot=__hip_atomic_fetch_add(ctr,1u,__ATOMIC_RELAXED,__HIP_MEMORY_SCOPE_AGENT);
    asm volatile("s_waitcnt vmcnt(0) lgkmcnt(0)\n\ts_barrier":::"memory");
    const unsigned n=*slot; if(n>=1024u)return false; u.qb=63-(int)(n>>4); u.bh=(int)(n&15u); return true; }
  __device__ __forceinline__ void a_ready(const AttnUnit&)const{}
  __device__ __forceinline__ void done(const AttnUnit&)const{}
};
template<class Sched,int THRL=8> __device__ __forceinline__ void attn_phase(char*lds,const AttnTensors&T,const Sched&S){
  AttnUnit u;
  for(int i=0;S.next(i,u);++i){ S.a_ready(u); attn_unit<THRL>(u.bh/NHEAD,u.bh%NHEAD,u.qb,T.Q,T.K,T.V,T.O,T.F+(long)u.bh*SEQ,T.NB+2*u.bh,lds); S.done(u); }
}
#undef SBAR
#undef WAIT_BAR
}
#include <hip/hip_cooperative_groups.h>
namespace cg = cooperative_groups;
#define LAS __attribute__((address_space(3)))
typedef unsigned short bf16;
typedef unsigned v4u __attribute__((ext_vector_type(4)));
typedef float f32x4 __attribute__((ext_vector_type(4)));
typedef short bf16x8 __attribute__((ext_vector_type(8)));
typedef LAS unsigned char* lp;

#define XB_TMO      128
#define XB_XCNT(j)  (256  + 64 * (j))
#define XB_XSUB(j)  (1280 + 64 * (j))
#define XB_XGEN(j)  (2304 + 64 * (j))
#define XB_TOP      3328
#define XB_TOPGEN   3392
#define XCD_BAR_WORDS 3456
#define XB_SPIN_CAP (1u << 18)

__device__ __forceinline__ unsigned xb_ld(unsigned* p)              { return __hip_atomic_load(p, __ATOMIC_RELAXED, __HIP_MEMORY_SCOPE_AGENT); }
__device__ __forceinline__ unsigned xb_add(unsigned* p, unsigned v) { return __hip_atomic_fetch_add(p, v, __ATOMIC_RELAXED, __HIP_MEMORY_SCOPE_AGENT); }
__device__ __forceinline__ unsigned xb_xcc_id() { return (unsigned)__builtin_amdgcn_s_getreg((3 << 11) | 20) & 0xFu; }
#define XB_SPIN(cond, bar) do { unsigned _sp = 0; while (cond) { __builtin_amdgcn_s_sleep(1); \
    if ((++_sp & 255u) == 0u) { if (xb_ld(&(bar)[XB_TMO])) break; if (_sp > XB_SPIN_CAP) { atomicAdd(&(bar)[XB_TMO], 1u); break; } } } } while (0)

struct XcdBarrier {
    unsigned* bar; unsigned x;
    volatile LAS unsigned* st;
};

__device__ __forceinline__ XcdBarrier xcd_barrier_post(unsigned* bar, volatile LAS unsigned* st) {
    XcdBarrier b; b.bar = bar; b.x = xb_xcc_id(); b.st = st;
    if (threadIdx.x == 0) (void)xb_add(&bar[XB_XCNT(b.x)], 1u);
    return b;
}
__device__ __forceinline__ void xcd_barrier_complete(unsigned* bar, unsigned x, unsigned& nloc, unsigned& nx) {
    const unsigned G = gridDim.x * gridDim.y * gridDim.z;
    unsigned sum, cnt, mine, sp = 0u;
    for (;;) {
        sum = 0u; cnt = 0u; mine = 0u;
#pragma unroll
        for (unsigned j = 0; j < 16; ++j) { const unsigned c = xb_ld(&bar[XB_XCNT(j)]); sum += c; cnt += (c > 0u) ? 1u : 0u; mine = (j == x) ? c : mine; }
        if (sum == G) break;
        __builtin_amdgcn_s_sleep(1);
        if ((++sp & 255u) == 0u) { if (xb_ld(&bar[XB_TMO])) break; if (sp > XB_SPIN_CAP) { atomicAdd(&bar[XB_TMO], 1u); break; } }
    }
    nloc = mine > 0u ? mine : 1u; nx = cnt > 0u ? cnt : 1u;
}

__device__ __forceinline__ void xcd_barrier(const XcdBarrier& b) {
    asm volatile("s_waitcnt vmcnt(0)" ::: "memory");
    __syncthreads();
    if (threadIdx.x == 0) {
        unsigned* bar = b.bar;
        __builtin_amdgcn_s_waitcnt(0);
        unsigned nloc = b.st[0], nx = b.st[1];
        if (nloc == 0u) { xcd_barrier_complete(bar, b.x, nloc, nx); b.st[0] = nloc; b.st[1] = nx; }
        const unsigned old = xb_add(&bar[XB_XSUB(b.x)], 1u);
        const unsigned gen = old / nloc;
        if (old + 1u == (gen + 1u) * nloc) {
            __builtin_amdgcn_fence(__ATOMIC_RELEASE, "agent");
            asm volatile("s_waitcnt vmcnt(0)" ::: "memory");
            const unsigned og = xb_add(&bar[XB_TOP], 1u);
            const unsigned tg = og / nx;
            if (og + 1u == (tg + 1u) * nx) xb_add(&bar[XB_TOPGEN], 1u);
            else XB_SPIN(xb_ld(&bar[XB_TOPGEN]) == tg, bar);
            __builtin_amdgcn_fence(__ATOMIC_ACQUIRE, "agent");
            xb_add(&bar[XB_XGEN(b.x)], 1u);
            asm volatile("s_waitcnt vmcnt(0)" ::: "memory");
        } else {
            XB_SPIN(xb_ld(&bar[XB_XGEN(b.x)]) == gen, bar);
            __builtin_amdgcn_fence(__ATOMIC_ACQUIRE, "agent");
            asm volatile("s_waitcnt vmcnt(0)" ::: "memory");
        }
    }
    __syncthreads();
}


constexpr int NWAVES = 8, NTHR = 512;
constexpr int BATCH = 2, SEQ = 16384, D = 1024, M = BATCH * SEQ, DEPTH = 2;
constexpr int NIN = 5640, NP1 = 3584, NG = 2048, FFH = 2816, NF1 = 5632;
constexpr float ALPHA = 1.4142135623730951f;
constexpr float LN_EPS = 1e-5f, RMS_EPS = 1e-6f;
constexpr size_t MiB = 1u << 20;
constexpr size_t WL_IN = 0, WL_G = 7 * MiB, WL_M = 11 * MiB, WL_O = 15 * MiB, WL_F1 = 17 * MiB, WL_F2 = 28 * MiB, WL_STRIDE = 34 * MiB;
constexpr size_t WS_W = 0, WS_XN = 68 * MiB, WS_QA = 132 * MiB, WS_QB = 164 * MiB, WS_KA = 196 * MiB, WS_VA = 228 * MiB, WS_G = 260 * MiB, WS_IB = 324 * MiB, WS_GB = 356 * MiB,
                 WS_ST = 388 * MiB, WS_DEC = 452 * MiB, WS_LF = 453 * MiB, WS_F = 454 * MiB, WS_CTL = 455 * MiB  , WS_DBG = 455 * MiB + 512 * 1024, WS_END = 456 * MiB;
constexpr size_t WS_GATES = WS_G  , WS_MERGED = WS_KA  , WS_H = WS_QA  ;
constexpr size_t CTL_QCTR = 16384  , CTL_PCTR = 18432  , CTL_STATS = 131072  , CTL_NORM = 20480  ;
constexpr int LDS_TOTAL = 155648;
static_assert(attn_body::LDS_BYTES <= LDS_TOTAL && pg8::STAGE_BYTES <= LDS_TOTAL, "LDS map");

__device__ __forceinline__ float wave_sum(float v) {
#pragma unroll
    for (int o = 1; o < 64; o <<= 1) v += __shfl_xor(v, o);
    return v;
}
__device__ __forceinline__ unsigned pk2(float lo, float hi) { return pg8::cvt_pk_bf16(lo, hi); }
__device__ __forceinline__ float bf2f(unsigned short h) { return __uint_as_float((unsigned)h << 16); }

__device__ __forceinline__ void transpose_item(const float* Wsrc, int pitch, bf16* WTdst, int Kdst, LAS float* scr, int lane, bool zero) {
    if (!zero) {
#pragma unroll
        for (int i = 0; i < 32; ++i) { const int kk = 2 * i + (lane >> 5); scr[kk * 33 + (lane & 31)] = Wsrc[(size_t)kk * pitch + (lane & 31)]; }
    }
    asm volatile("s_waitcnt lgkmcnt(0)" ::: "memory");
    const int c = lane & 7;
#pragma unroll
    for (int j = 0; j < 4; ++j) { const int n = (lane >> 3) + 8 * j; const LAS float* s = scr + (8 * c) * 33 + n;
        v4u o;
        if (zero) { o = (v4u){0u, 0u, 0u, 0u}; }
        else { o.x = pk2(s[0 * 33], s[1 * 33]); o.y = pk2(s[2 * 33], s[3 * 33]); o.z = pk2(s[4 * 33], s[5 * 33]); o.w = pk2(s[6 * 33], s[7 * 33]); }
        *(v4u*)(WTdst + (size_t)n * Kdst + 8 * c) = o; }
    asm volatile("s_waitcnt lgkmcnt(0)" ::: "memory");
}

struct Ptrs {
    const float *x, *w_in, *b_fgate, *lb_logits, *norm_g, *w_pa, *w_pb, *w_o, *ln1_g, *ln1_b, *w_ff_in, *w_ff_out, *ln2_g, *ln2_b;
    float* out; unsigned char* ws;
};

__device__ __forceinline__ void weight_items(const Ptrs& P, LAS float* scr, int gw, int NGW, int lane) {
    constexpr int I_IN = 16 * (NP1 / 32), I_G = 16 * (NG / 32), I_M = 2 * 8 * 32, I_O = 16 * 32, I_F1 = 16 * (NF1 / 32), I_F2 = (FFH / 64) * 32;
    constexpr int PER_LAYER = I_IN + I_G + I_M + I_O + I_F1 + I_F2;
    for (int it = gw; it < DEPTH * PER_LAYER; it += NGW) {
        const int l = it / PER_LAYER; int r = it % PER_LAYER;
        bf16* WB = (bf16*)(P.ws + WS_W + (size_t)l * WL_STRIDE);
        if (r < I_IN) { const int nblk = NP1 / 32, kb = r / nblk, nb = r % nblk, k0 = 64 * kb, n0 = 32 * nb; const int sc = n0 < 1536 ? n0 : n0 + 8;
            transpose_item(P.w_in + (size_t)l * D * NIN + (size_t)k0 * NIN + sc, NIN, (bf16*)((unsigned char*)WB + WL_IN) + (size_t)n0 * 1024 + k0, 1024, scr, lane, false); continue; } r -= I_IN;
        if (r < I_G) { const int nblk = NG / 32, kb = r / nblk, nb = r % nblk, k0 = 64 * kb, n0 = 32 * nb;
            transpose_item(P.w_in + (size_t)l * D * NIN + (size_t)k0 * NIN + 3592 + n0, NIN, (bf16*)((unsigned char*)WB + WL_G) + (size_t)n0 * 1024 + k0, 1024, scr, lane, false); continue; } r -= I_G;
        if (r < I_M) { const int which = r >> 8, rr = r & 255, kb = rr >> 5, nb = rr & 31, k0 = 64 * kb, n0 = 32 * nb;
            const float* src = (which ? P.w_pb : P.w_pa) + (size_t)l * 512 * 1024 + (size_t)k0 * 1024 + n0;
            transpose_item(src, 1024, (bf16*)((unsigned char*)WB + WL_M + (size_t)which * MiB) + (size_t)n0 * 512 + k0, 512, scr, lane, false); continue; } r -= I_M;
        if (r < I_O) { const int nblk = 32, kb = r / nblk, nb = r % nblk, k0 = 64 * kb, n0 = 32 * nb;
            transpose_item(P.w_o + (size_t)l * 1024 * 1024 + (size_t)k0 * 1024 + n0, 1024, (bf16*)((unsigned char*)WB + WL_O) + (size_t)n0 * 1024 + k0, 1024, scr, lane, false); continue; } r -= I_O;
        if (r < I_F1) { const int nblk = NF1 / 32, kb = r / nblk, nb = r % nblk, k0 = 64 * kb, n0 = 32 * nb; const int tile = n0 >> 8, half = (n0 >> 7) & 1, col = half * FFH + 128 * tile + (n0 & 127);
            transpose_item(P.w_ff_in + (size_t)l * D * NF1 + (size_t)k0 * NF1 + col, NF1, (bf16*)((unsigned char*)WB + WL_F1) + (size_t)n0 * 1024 + k0, 1024, scr, lane, false); continue; } r -= I_F1;
        { const int nblk = 32, kb = r / nblk, nb = r % nblk, k0 = 64 * kb, n0 = 32 * nb;
            transpose_item(P.w_ff_out + (size_t)l * FFH * 1024 + (size_t)k0 * 1024 + n0, 1024, (bf16*)((unsigned char*)WB + WL_F2) + (size_t)n0 * FFH + k0, FFH, scr, lane, false); }
    }
}

__device__ __forceinline__ void stage_wfa(const float* w_in_l, LAS float* wfa, int tid) {
    for (int idx = tid; idx < 8192; idx += NTHR) { const int k = idx >> 3, col = idx & 7; const int j = k >> 8, ln = (k >> 2) & 63, i = k & 3, half = col >> 2, c = col & 3;
        wfa[((((j * 4 + i) * 2 + half) * 64) + ln) * 4 + c] = w_in_l[(size_t)k * NIN + 1536 + col]; }
}
template <bool DO_LN, bool W32, bool WBF, bool DO_FA>
__device__ __forceinline__ void row_pass(const float* src, float* dst32, bf16* dstbf, const float* gam, const float* bet, float* lf, const LAS float* wfa, const float* bfg, int gw, int NGW, int lane, float* stats = nullptr) {
    constexpr int R = 4;
    f32x4 gv[4], bv[4];
    if (DO_LN) {
#pragma unroll
        for (int j = 0; j < 4; ++j) { gv[j] = ((const f32x4*)gam)[64 * j + lane]; bv[j] = ((const f32x4*)bet)[64 * j + lane]; }
    }
    for (int m0 = gw; m0 < M; m0 += R * NGW) {
        f32x4 v[R][4]; int mr[R]; bool ok[R];
#pragma unroll
        for (int r = 0; r < R; ++r) { const int m = m0 + r * NGW; ok[r] = m < M; mr[r] = ok[r] ? m : m0; const f32x4* xr = (const f32x4*)(src + (size_t)mr[r] * D) + lane;
#pragma unroll
            for (int j = 0; j < 4; ++j) v[r][j] = xr[64 * j]; }
        if (DO_LN) {
            float s[R], s2[R], mean[R], rstd[R];
#pragma unroll
            for (int r = 0; r < R; ++r) { s[r] = 0.f;
#pragma unroll
                for (int j = 0; j < 4; ++j) s[r] += (v[r][j].x + v[r][j].y) + (v[r][j].z + v[r][j].w); }
#pragma unroll
            for (int o = 1; o < 64; o <<= 1)
#pragma unroll
                for (int r = 0; r < R; ++r) s[r] += __shfl_xor(s[r], o);
#pragma unroll
            for (int r = 0; r < R; ++r) { mean[r] = s[r] * (1.f / D); s2[r] = 0.f;
#pragma unroll
                for (int j = 0; j < 4; ++j) { v[r][j] = v[r][j] - mean[r]; s2[r] += (v[r][j].x * v[r][j].x + v[r][j].y * v[r][j].y) + (v[r][j].z * v[r][j].z + v[r][j].w * v[r][j].w); } }
#pragma unroll
            for (int o = 1; o < 64; o <<= 1)
#pragma unroll
                for (int r = 0; r < R; ++r) s2[r] += __shfl_xor(s2[r], o);
#pragma unroll
            for (int r = 0; r < R; ++r) { rstd[r] = 1.f / sqrtf(s2[r] * (1.f / D) + LN_EPS);
                if (stats && lane == 0 && ok[r]) { stats[2 * (size_t)mr[r]] = mean[r]; stats[2 * (size_t)mr[r] + 1] = rstd[r]; }
#pragma unroll
                for (int j = 0; j < 4; ++j) v[r][j] = v[r][j] * rstd[r] * gv[j] + bv[j]; }
        }
#pragma unroll
        for (int r = 0; r < R; ++r) { if (!ok[r]) continue; const int m = mr[r];
            if (W32) { f32x4* o = (f32x4*)(dst32 + (size_t)m * D) + lane;
#pragma unroll
                for (int j = 0; j < 4; ++j) o[64 * j] = v[r][j]; }
            if (WBF) { unsigned long long* o8 = (unsigned long long*)(dstbf + (size_t)m * D) + lane;
#pragma unroll
                for (int j = 0; j < 4; ++j) o8[64 * j] = (unsigned long long)pk2(v[r][j].x, v[r][j].y) | ((unsigned long long)pk2(v[r][j].z, v[r][j].w) << 32); } }
        if (DO_FA) {
            float a[R][8];
#pragma unroll
            for (int r = 0; r < R; ++r)
#pragma unroll
                for (int c = 0; c < 8; ++c) a[r][c] = 0.f;
#pragma unroll
            for (int j = 0; j < 4; ++j)
#pragma unroll
                for (int i = 0; i < 4; ++i) {
                    const f32x4 w0 = *(const LAS f32x4*)(wfa + ((((j * 4 + i) * 2 + 0) * 64) + lane) * 4), w1 = *(const LAS f32x4*)(wfa + ((((j * 4 + i) * 2 + 1) * 64) + lane) * 4);
#pragma unroll
                    for (int r = 0; r < R; ++r) { const float xv = v[r][j][i];
                        a[r][0] += xv * w0.x; a[r][1] += xv * w0.y; a[r][2] += xv * w0.z; a[r][3] += xv * w0.w; a[r][4] += xv * w1.x; a[r][5] += xv * w1.y; a[r][6] += xv * w1.z; a[r][7] += xv * w1.w; } }
#pragma unroll
            for (int o = 1; o < 64; o <<= 1)
#pragma unroll
                for (int r = 0; r < R; ++r)
#pragma unroll
                    for (int c = 0; c < 8; ++c) a[r][c] += __shfl_xor(a[r][c], o);
#pragma unroll
            for (int r = 0; r < R; ++r) { float z = a[r][0];
#pragma unroll
                for (int c = 1; c < 8; ++c) z = (lane == c) ? a[r][c] : z;
                if (lane < 8 && ok[r]) { z += bfg[lane]; const float ls = fminf(z, 0.f) - __logf(1.0f + __expf(-fabsf(z))); lf[(size_t)mr[r] * 8 + lane] = ls; } }
        }
    }
}

__device__ __forceinline__ void fcumsum_unit(int bh, const float* LF, float* F, lp lds, int tid) {
    const int b = bh >> 3, h = bh & 7, lane = tid & 63, wave = tid >> 6;
    const float* src = LF + ((size_t)b * SEQ + (size_t)tid * 32) * 8 + h;
    float cs[32]; float run = 0.f;
#pragma unroll
    for (int i = 0; i < 32; ++i) { run += src[i * 8]; cs[i] = run; }
    float inc = run;
#pragma unroll
    for (int o = 1; o < 64; o <<= 1) { const float n = __shfl_up(inc, o); if (lane >= o) inc += n; }
    LAS float* WS = (LAS float*)lds;
    if (lane == 63) WS[wave] = inc;
    __syncthreads();
    float woff = 0.f;
    for (int w = 0; w < wave; ++w) woff += WS[w];
    const float excl = woff + inc - run;
    float* dst = F + (size_t)bh * SEQ + (size_t)tid * 32;
#pragma unroll
    for (int i = 0; i < 32; i += 4) *(f32x4*)(dst + i) = (f32x4){excl + cs[i], excl + cs[i + 1], excl + cs[i + 2], excl + cs[i + 3]};
    __syncthreads();
}

__device__ __forceinline__ void norm_unit(int v, const bf16* QA, const bf16* KA, unsigned* NB, int tid) {
    const int bh = v >> 4, seg = v & 15, b = bh >> 3, h = bh & 7, lane = tid & 63;
    float mq = 0.f, mk = 0.f;
#pragma unroll
    for (int e = 0; e < 2; ++e) { const size_t row = (size_t)b * SEQ + seg * 1024 + tid * 2 + e;
        const v4u* qp = (const v4u*)(QA + row * 512 + h * 64); const v4u* kp = (const v4u*)(KA + row * 512 + h * 64); float sq = 0.f, sk = 0.f;
#pragma unroll
        for (int i = 0; i < 8; ++i) { const v4u a = qp[i], c = kp[i];
#pragma unroll
            for (int k = 0; k < 4; ++k) { const float a0 = __uint_as_float(a[k] << 16), a1 = __uint_as_float(a[k] & 0xffff0000u), c0 = __uint_as_float(c[k] << 16), c1 = __uint_as_float(c[k] & 0xffff0000u);
                sq += a0 * a0 + a1 * a1; sk += c0 * c0 + c1 * c1; } }
        mq = fmaxf(mq, sq); mk = fmaxf(mk, sk); }
#pragma unroll
    for (int o = 1; o < 64; o <<= 1) { mq = fmaxf(mq, __shfl_xor(mq, o)); mk = fmaxf(mk, __shfl_xor(mk, o)); }
    if (lane == 0) { atomicMax(NB + 2 * bh, __float_as_uint(mq * 1.01f)); atomicMax(NB + 2 * bh + 1, __float_as_uint(mk * 1.01f)); }
}

namespace hg {
constexpr int P128 = 136, P64 = 72;
constexpr int O_QP = 0, O_QPP = O_QP + 64 * P128 * 2, O_KP = O_QPP + 64 * P128 * 2, O_VT = O_KP + 64 * P128 * 2, O_ST = O_VT + 128 * P64 * 2, O_PM = O_ST + 128 * P128 * 2,
              O_PT = O_PM + 64 * P64 * 2, O_RS = O_PT + 2048, O_END = O_RS + 512;
constexpr int O_KDT = O_QP;
static_assert(O_END <= 131072 && 128 * P64 * 2 <= 2 * 64 * P128 * 2, "hgrn LDS map");

__device__ __forceinline__ void load_cumsum(const float* Gu, int d, int part, lp lds, float (&g)[16], float (&b)[16], float& bmid, float& blast) {
#pragma unroll
    for (int i = 0; i < 16; ++i) g[i] = Gu[(size_t)(part * 16 + i) * 512 + d];
    float run = 0.f;
#pragma unroll
    for (int i = 0; i < 16; ++i) { run += g[i]; b[i] = run; }
    LAS float* PT = (LAS float*)(lds + O_PT);
    PT[part * 128 + d] = run;
    __syncthreads();
    const float p0 = PT[d], p1 = PT[128 + d], p2 = PT[256 + d], p3 = PT[384 + d];
    const float off = (part > 0 ? p0 : 0.f) + (part > 1 ? p1 : 0.f) + (part > 2 ? p2 : 0.f);
#pragma unroll
    for (int i = 0; i < 16; ++i) b[i] += off;
    bmid = p0 + p1; blast = (p0 + p1) + (p2 + p3);
}
__device__ __forceinline__ void stage_vt(const bf16* vp  , lp lds, int e, int part) {
    unsigned w[8];
#pragma unroll
    for (int i = 0; i < 8; ++i) { const unsigned lo = vp[(size_t)(2 * i) * 512], hi = vp[(size_t)(2 * i + 1) * 512]; w[i] = lo | (hi << 16); }
    LAS v4u* dst = (LAS v4u*)(lds + O_VT + (e * P64 + part * 16) * 2);
    dst[0] = (v4u){w[0], w[1], w[2], w[3]}; dst[1] = (v4u){w[4], w[5], w[6], w[7]};
}
__device__ __forceinline__ void pass1_unit(int unit, const float* G, const bf16* IB, bf16* ST, float* DEC, lp lds, int tid, unsigned* dbgw = nullptr) {
    const int c = unit & 255, h = (unit >> 8) & 3, b = unit >> 10;
    const int d = tid & 127, part = tid >> 7, lane = tid & 63, wave = tid >> 6, fr = lane & 15, fq = lane >> 4;
    const size_t row0 = (size_t)b * SEQ + (size_t)c * 64;
    float g[16], bb[16], bmid, blast;
    load_cumsum(G + row0 * 512 + h * 128, d, part, lds, g, bb, bmid, blast);
#ifdef DBG_P1
    { bool b1 = false, b3 = false; for (int i = 0; i < 16; ++i) { if (g[i] > 0.f) b1 = true; const float kk = (1.0f - __expf(g[i])) * __expf(blast - bb[i]); if (!(fabsf(kk) < 1e30f)) b3 = true; }
      if (b1) atomicMin(dbgw, 51u); if (b3) atomicMin(dbgw, 53u); }
#endif
    { unsigned w[8];
#pragma unroll
      for (int i = 0; i < 8; ++i) { const float k0 = (1.0f - __expf(g[2 * i])) * __expf(blast - bb[2 * i]), k1 = (1.0f - __expf(g[2 * i + 1])) * __expf(blast - bb[2 * i + 1]); w[i] = pk2(k0, k1); }
      LAS v4u* dst = (LAS v4u*)(lds + O_KDT + (d * P64 + part * 16) * 2);
      dst[0] = (v4u){w[0], w[1], w[2], w[3]}; dst[1] = (v4u){w[4], w[5], w[6], w[7]}; }
    stage_vt(IB + (row0 + part * 16) * 512 + h * 128 + d, lds, d, part);
    if (part == 0) DEC[(size_t)unit * 128 + d] = __expf(blast);
    __syncthreads();
    const bf16x8 a0 = *(const LAS bf16x8*)(lds + O_VT + ((16 * wave + fr) * P64 + 8 * fq) * 2), a1 = *(const LAS bf16x8*)(lds + O_VT + ((16 * wave + fr) * P64 + 32 + 8 * fq) * 2);
    bf16* out = ST + (size_t)unit * 16384;
#pragma unroll
    for (int dt = 0; dt < 8; ++dt) {
        const bf16x8 b0 = *(const LAS bf16x8*)(lds + O_KDT + ((16 * dt + fr) * P64 + 8 * fq) * 2), b1 = *(const LAS bf16x8*)(lds + O_KDT + ((16 * dt + fr) * P64 + 32 + 8 * fq) * 2);
        f32x4 acc = (f32x4){0.f, 0.f, 0.f, 0.f};
        acc = __builtin_amdgcn_mfma_f32_16x16x32_bf16(a0, b0, acc, 0, 0, 0);
        acc = __builtin_amdgcn_mfma_f32_16x16x32_bf16(a1, b1, acc, 0, 0, 0);
#ifdef DBG_P1
        for (int r = 0; r < 4; ++r) if (!(fabsf(acc[r]) < 1e30f)) atomicMin(dbgw, 54u);
#endif
#pragma unroll
        for (int r = 0; r < 4; ++r) out[(16 * wave + 4 * fq + r) * 128 + 16 * dt + fr] = (bf16)(pk2(acc[r], 0.f) & 0xffffu);
    }
    __syncthreads();
}
__device__ __forceinline__ void pass2_scan(const bf16* STin, bf16* ST, const float* DEC, int gtid, int gthreads) {
    for (int id = gtid; id < 8 * 16384; id += gthreads) {
        const int bh = id >> 14, ed = id & 16383, d = ed & 127;
        bf16* p = ST + (size_t)bh * 256 * 16384 + ed; const bf16* pi = STin + (size_t)bh * 256 * 16384 + ed; const float* dp = DEC + (size_t)bh * 256 * 128 + d;
        float state = 0.f;
        for (int c = 0; c < 256; c += 32) {
            unsigned short u[32]; float dc[32];
#pragma unroll
            for (int i = 0; i < 32; ++i) { u[i] = pi[(size_t)(c + i) * 16384]; dc[i] = dp[(size_t)(c + i) * 128]; }
#pragma unroll
            for (int i = 0; i < 32; ++i) { p[(size_t)(c + i) * 16384] = (bf16)(pk2(state, 0.f) & 0xffffu); state = dc[i] * state + bf2f(u[i]); }
        }
    }
}
__device__ __forceinline__ void pass3_unit(int unit, const float* G, const bf16* IB, const bf16* GB, const bf16* ST, const bf16* QB, bf16* YB, const float* normg, lp lds, int tid) {
    const int c = unit & 255, h = (unit >> 8) & 3, b = unit >> 10;
    const int d = tid & 127, part = tid >> 7, lane = tid & 63, wave = tid >> 6, fr = lane & 15, fq = lane >> 4;
    const size_t row0 = (size_t)b * SEQ + (size_t)c * 64;
    unsigned short gbv[4][4];
    { const int rb_ = wave & 3, ch_ = wave >> 2;
#pragma unroll
      for (int r = 0; r < 4; ++r) { const bf16* gbp_ = GB + (row0 + 16 * rb_ + 4 * fq + r) * 512 + h * 128 + 64 * ch_ + fr;
#pragma unroll
          for (int j = 0; j < 4; ++j) gbv[r][j] = gbp_[16 * j]; } }
    { const bf16* sp = ST + (size_t)unit * 16384;
#pragma unroll
      for (int ps = 0; ps < 4; ++ps) { const int idx = ps * NTHR + tid, e = idx >> 4, d8 = (idx & 15) * 8; const v4u w = *(const v4u*)(sp + e * 128 + d8); *(LAS v4u*)(lds + O_ST + (e * P128 + d8) * 2) = w; } }
    float g[16], bb[16], bmid, blast;
    load_cumsum(G + row0 * 512 + h * 128, d, part, lds, g, bb, bmid, blast);
    { const bf16* qp = QB + (row0 + part * 16) * 512 + h * 128 + d; const float emid = __expf(bmid);
      LAS bf16* Qp = (LAS bf16*)(lds + O_QP), *Qpp = (LAS bf16*)(lds + O_QPP), *Kp = (LAS bf16*)(lds + O_KP);
#pragma unroll
      for (int i = 0; i < 16; ++i) { const float q = bf2f(qp[(size_t)i * 512]); const float q1 = q * __expf(bb[i] - bmid), q2 = q1 * emid, k1 = (1.0f - __expf(g[i])) * __expf(bmid - bb[i]);
          const int t = part * 16 + i; const unsigned w = pk2(q1, q2), w2 = pk2(k1, 0.f);
          Qp[t * P128 + d] = (bf16)(w & 0xffffu); Qpp[t * P128 + d] = (bf16)(w >> 16); Kp[t * P128 + d] = (bf16)(w2 & 0xffffu); } }
    stage_vt(IB + (row0 + part * 16) * 512 + h * 128 + d, lds, d, part);
    __syncthreads();
    { const int ti = wave >> 1; LAS bf16* Pm = (LAS bf16*)(lds + O_PM);
#pragma unroll
      for (int sj2 = 0; sj2 < 2; ++sj2) { const int sj = 2 * (wave & 1) + sj2; f32x4 acc = (f32x4){0.f, 0.f, 0.f, 0.f};
#pragma unroll
          for (int ks = 0; ks < 4; ++ks) { const bf16x8 a = *(const LAS bf16x8*)(lds + O_QP + ((16 * ti + fr) * P128 + 32 * ks + 8 * fq) * 2), bq = *(const LAS bf16x8*)(lds + O_KP + ((16 * sj + fr) * P128 + 32 * ks + 8 * fq) * 2);
              acc = __builtin_amdgcn_mfma_f32_16x16x32_bf16(a, bq, acc, 0, 0, 0); }
#pragma unroll
          for (int r = 0; r < 4; ++r) { const int t = 16 * ti + 4 * fq + r, s = 16 * sj + fr; const float v = (s <= t) ? acc[r] : 0.f; Pm[t * P64 + s] = (bf16)(pk2(v, 0.f) & 0xffffu); } } }
    __syncthreads();
    const int rb = wave & 3, ch = wave >> 2;
    f32x4 o[4];
#pragma unroll
    for (int j = 0; j < 4; ++j) o[j] = (f32x4){0.f, 0.f, 0.f, 0.f};
    { bf16x8 ap[2], aq[4];
#pragma unroll
      for (int ks = 0; ks < 2; ++ks) ap[ks] = *(const LAS bf16x8*)(lds + O_PM + ((16 * rb + fr) * P64 + 32 * ks + 8 * fq) * 2);
#pragma unroll
      for (int ks = 0; ks < 4; ++ks) aq[ks] = *(const LAS bf16x8*)(lds + O_QPP + ((16 * rb + fr) * P128 + 32 * ks + 8 * fq) * 2);
#pragma unroll
      for (int j = 0; j < 4; ++j) { const int e0 = 64 * ch + 16 * j;
#pragma unroll
          for (int ks = 0; ks < 2; ++ks) { const bf16x8 bv = *(const LAS bf16x8*)(lds + O_VT + ((e0 + fr) * P64 + 32 * ks + 8 * fq) * 2); o[j] = __builtin_amdgcn_mfma_f32_16x16x32_bf16(ap[ks], bv, o[j], 0, 0, 0); }
#pragma unroll
          for (int ks = 0; ks < 4; ++ks) { const bf16x8 bs = *(const LAS bf16x8*)(lds + O_ST + ((e0 + fr) * P128 + 32 * ks + 8 * fq) * 2); o[j] = __builtin_amdgcn_mfma_f32_16x16x32_bf16(aq[ks], bs, o[j], 0, 0, 0); } } }
    LAS float* RS = (LAS float*)(lds + O_RS);
#pragma unroll
    for (int r = 0; r < 4; ++r) { float s = 0.f;
#pragma unroll
        for (int j = 0; j < 4; ++j) s += o[j][r] * o[j][r];
        s += __shfl_xor(s, 1); s += __shfl_xor(s, 2); s += __shfl_xor(s, 4); s += __shfl_xor(s, 8);
        if (fr == 0) RS[ch * 64 + 16 * rb + 4 * fq + r] = s; }
    __syncthreads();
#pragma unroll
    for (int r = 0; r < 4; ++r) { const int t = 16 * rb + 4 * fq + r; const float rstd = 1.0f / sqrtf((RS[t] + RS[64 + t]) * (1.0f / 128.0f) + RMS_EPS);
        bf16* yp = YB + (row0 + t) * 512 + h * 128 + 64 * ch + fr;
#pragma unroll
        for (int j = 0; j < 4; ++j) { const float y = o[j][r] * rstd * normg[64 * ch + 16 * j + fr] * bf2f(gbv[r][j]); yp[16 * j] = (bf16)(pk2(y, 0.f) & 0xffffu); } }
    __syncthreads();
}
struct P3R { float g[16]; unsigned short q[16], v[16]; v4u st[4]; unsigned short gb[4][4]; };
#define P3_LBAR() asm volatile("s_waitcnt lgkmcnt(0)\n\ts_barrier" ::: "memory")
__device__ __forceinline__ void p3_load(int unit, P3R& R, const float* G, const bf16* IB, const bf16* GB, const bf16* ST, const bf16* QB, int tid) {
    const int c = unit & 255, h = (unit >> 8) & 3, b = unit >> 10;
    const int d = tid & 127, part = tid >> 7, lane = tid & 63, wave = tid >> 6, fr = lane & 15, fq = lane >> 4, rb = wave & 3, ch = wave >> 2;
    const size_t row0 = (size_t)b * SEQ + (size_t)c * 64;
    const bf16* sp = ST + (size_t)unit * 16384;
#pragma unroll
    for (int ps = 0; ps < 4; ++ps) { const int idx = ps * NTHR + tid, e = idx >> 4, d8 = (idx & 15) * 8; R.st[ps] = *(const v4u*)(sp + e * 128 + d8); }
    const float* Gu = G + (row0 + part * 16) * 512 + h * 128 + d; const bf16* qp = QB + (row0 + part * 16) * 512 + h * 128 + d; const bf16* vp = IB + (row0 + part * 16) * 512 + h * 128 + d;
#pragma unroll
    for (int i = 0; i < 16; ++i) { R.g[i] = Gu[(size_t)i * 512]; R.q[i] = qp[(size_t)i * 512]; R.v[i] = vp[(size_t)i * 512]; }
#pragma unroll
    for (int r = 0; r < 4; ++r) { const bf16* gbp = GB + (row0 + 16 * rb + 4 * fq + r) * 512 + h * 128 + 64 * ch + fr;
#pragma unroll
        for (int j = 0; j < 4; ++j) R.gb[r][j] = gbp[16 * j]; }
}
__device__ __forceinline__ void pass3_loop(unsigned* ctr, volatile LAS unsigned* slot, const float* G, const bf16* IB, const bf16* GB, const bf16* ST, bf16* QB, const float* normg, lp lds, int tid) {
    const int d = tid & 127, part = tid >> 7, lane = tid & 63, wave = tid >> 6, fr = lane & 15, fq = lane >> 4, rb = wave & 3, ch = wave >> 2;
    if (tid == 0) { slot[0] = __hip_atomic_fetch_add(ctr, 1u, __ATOMIC_RELAXED, __HIP_MEMORY_SCOPE_AGENT); slot[1] = __hip_atomic_fetch_add(ctr, 1u, __ATOMIC_RELAXED, __HIP_MEMORY_SCOPE_AGENT); }
    __syncthreads();
    unsigned n = slot[0], n1 = slot[1];
    __syncthreads();
    P3R R;
    if (n < 2048u) p3_load((int)n, R, G, IB, GB, ST, QB, tid);
    while (n < 2048u) {
        unsigned n2 = 0u; if (tid == 0) n2 = __hip_atomic_fetch_add(ctr, 1u, __ATOMIC_RELAXED, __HIP_MEMORY_SCOPE_AGENT);
        const int unit = (int)n, c = unit & 255, h = (unit >> 8) & 3, b = unit >> 10; const size_t row0 = (size_t)b * SEQ + (size_t)c * 64;
#pragma unroll
        for (int ps = 0; ps < 4; ++ps) { const int idx = ps * NTHR + tid, e = idx >> 4, d8 = (idx & 15) * 8; *(LAS v4u*)(lds + O_ST + (e * P128 + d8) * 2) = R.st[ps]; }
        float bb[16], bmid;
        { float run = 0.f;
#pragma unroll
          for (int i = 0; i < 16; ++i) { run += R.g[i]; bb[i] = run; }
          LAS float* PT = (LAS float*)(lds + O_PT); PT[part * 128 + d] = run;
          P3_LBAR();
          const float p0 = PT[d], p1 = PT[128 + d], p2 = PT[256 + d];
          const float off = (part > 0 ? p0 : 0.f) + (part > 1 ? p1 : 0.f) + (part > 2 ? p2 : 0.f);
#pragma unroll
          for (int i = 0; i < 16; ++i) bb[i] += off;
          bmid = p0 + p1; }
        { const float emid = __expf(bmid); LAS bf16* Qp = (LAS bf16*)(lds + O_QP), *Qpp = (LAS bf16*)(lds + O_QPP), *Kp = (LAS bf16*)(lds + O_KP);
#pragma unroll
          for (int i = 0; i < 16; ++i) { const float q = bf2f(R.q[i]); const float q1 = q * __expf(bb[i] - bmid), q2 = q1 * emid, k1 = (1.0f - __expf(R.g[i])) * __expf(bmid - bb[i]);
              const int t = part * 16 + i; const unsigned w = pk2(q1, q2), w2 = pk2(k1, 0.f);
              Qp[t * P128 + d] = (bf16)(w & 0xffffu); Qpp[t * P128 + d] = (bf16)(w >> 16); Kp[t * P128 + d] = (bf16)(w2 & 0xffffu); } }
        { unsigned w[8];
#pragma unroll
          for (int i = 0; i < 8; ++i) w[i] = (unsigned)R.v[2 * i] | ((unsigned)R.v[2 * i + 1] << 16);
          LAS v4u* dst = (LAS v4u*)(lds + O_VT + (d * P64 + part * 16) * 2); dst[0] = (v4u){w[0], w[1], w[2], w[3]}; dst[1] = (v4u){w[4], w[5], w[6], w[7]}; }
        unsigned short gbv[4][4];
#pragma unroll
        for (int r = 0; r < 4; ++r)
#pragma unroll
            for (int j = 0; j < 4; ++j) gbv[r][j] = R.gb[r][j];
        P3_LBAR();
        if (n1 < 2048u) p3_load((int)n1, R, G, IB, GB, ST, QB, tid);
        { const int ti = wave >> 1; LAS bf16* Pm = (LAS bf16*)(lds + O_PM);
#pragma unroll
          for (int sj2 = 0; sj2 < 2; ++sj2) { const int sj = 2 * (wave & 1) + sj2; f32x4 acc = (f32x4){0.f, 0.f, 0.f, 0.f};
#pragma unroll
              for (int ks = 0; ks < 4; ++ks) { const bf16x8 a = *(const LAS bf16x8*)(lds + O_QP + ((16 * ti + fr) * P128 + 32 * ks + 8 * fq) * 2), bq = *(const LAS bf16x8*)(lds + O_KP + ((16 * sj + fr) * P128 + 32 * ks + 8 * fq) * 2);
                  acc = __builtin_amdgcn_mfma_f32_16x16x32_bf16(a, bq, acc, 0, 0, 0); }
#pragma unroll
              for (int r = 0; r < 4; ++r) { const int t = 16 * ti + 4 * fq + r, s = 16 * sj + fr; const float v = (s <= t) ? acc[r] : 0.f; Pm[t * P64 + s] = (bf16)(pk2(v, 0.f) & 0xffffu); } } }
        P3_LBAR();
        f32x4 o[4];
#pragma unroll
        for (int j = 0; j < 4; ++j) o[j] = (f32x4){0.f, 0.f, 0.f, 0.f};
        { bf16x8 ap[2], aq[4];
#pragma unroll
          for (int ks = 0; ks < 2; ++ks) ap[ks] = *(const LAS bf16x8*)(lds + O_PM + ((16 * rb + fr) * P64 + 32 * ks + 8 * fq) * 2);
#pragma unroll
          for (int ks = 0; ks < 4; ++ks) aq[ks] = *(const LAS bf16x8*)(lds + O_QPP + ((16 * rb + fr) * P128 + 32 * ks + 8 * fq) * 2);
#pragma unroll
          for (int j = 0; j < 4; ++j) { const int e0 = 64 * ch + 16 * j;
#pragma unroll
              for (int ks = 0; ks < 2; ++ks) { const bf16x8 bv = *(const LAS bf16x8*)(lds + O_VT + ((e0 + fr) * P64 + 32 * ks + 8 * fq) * 2); o[j] = __builtin_amdgcn_mfma_f32_16x16x32_bf16(ap[ks], bv, o[j], 0, 0, 0); }
#pragma unroll
              for (int ks = 0; ks < 4; ++ks) { const bf16x8 bs = *(const LAS bf16x8*)(lds + O_ST + ((e0 + fr) * P128 + 32 * ks + 8 * fq) * 2); o[j] = __builtin_amdgcn_mfma_f32_16x16x32_bf16(aq[ks], bs, o[j], 0, 0, 0); } } }
        LAS float* RS = (LAS float*)(lds + O_RS);
#pragma unroll
        for (int r = 0; r < 4; ++r) { float s = 0.f;
#pragma unroll
            for (int j = 0; j < 4; ++j) s += o[j][r] * o[j][r];
            s += __shfl_xor(s, 1); s += __shfl_xor(s, 2); s += __shfl_xor(s, 4); s += __shfl_xor(s, 8);
            if (fr == 0) RS[ch * 64 + 16 * rb + 4 * fq + r] = s; }
        if (tid == 0) slot[0] = n2;
        P3_LBAR();
#pragma unroll
        for (int r = 0; r < 4; ++r) { const int t = 16 * rb + 4 * fq + r; const float rstd = 1.0f / sqrtf((RS[t] + RS[64 + t]) * (1.0f / 128.0f) + RMS_EPS);
            bf16* yp = QB + (row0 + t) * 512 + h * 128 + 64 * ch + fr;
#pragma unroll
            for (int j = 0; j < 4; ++j) { const float y = o[j][r] * rstd * normg[64 * ch + 16 * j + fr] * bf2f(gbv[r][j]); yp[16 * j] = (bf16)(pk2(y, 0.f) & 0xffffu); } }
        const unsigned nn = slot[0];
        P3_LBAR();
        n = n1; n1 = nn;
    }
}
}

#ifdef DBG_NAN
__device__ __forceinline__ void dbg_scan(const void* p, size_t nbytes, bool is_bf, int stage, unsigned* word) {
    const size_t n16 = nbytes / 16; const v4u* q = (const v4u*)p; bool bad = false;
    int t_ = threadIdx.x; asm volatile("" : "+v"(t_));
    int b_ = blockIdx.x; asm volatile("" : "+s"(b_)); int g_ = gridDim.x; asm volatile("" : "+s"(g_));
    for (unsigned i = (unsigned)(b_ * NTHR + t_); i < (unsigned)n16; i += (unsigned)(g_ * NTHR)) { const v4u w = q[i];
        for (int k = 0; k < 4; ++k) { const unsigned x = w[k];
            if (is_bf) { if ((x & 0x7f80u) == 0x7f80u || (x & 0x7f800000u) == 0x7f800000u) bad = true; }
            else { if ((x & 0x7f800000u) == 0x7f800000u) bad = true; } } }
    if (bad) atomicMin(word, (unsigned)stage);
}
#define DBG(stage, ptr, bytes, isbf) do { if (l == DBG_LAYER) dbg_scan((ptr), (bytes), (isbf), (stage), (unsigned*)(args.ws + WS_DBG)); } while (0)
#else
#define DBG(stage, ptr, bytes, isbf) do {} while (0)
#endif
#define GSYNC() do { XcdBarrier b_; b_.bar = (unsigned*)(args.ws + WS_CTL); b_.x = xb_xcc_id(); b_.st = (volatile LAS unsigned*)(lds + LDS_TOTAL - 64); xcd_barrier(b_); } while (0)
#ifdef DBG_TS
#define STAMP(k) do { if (blockIdx.x == 0 && threadIdx.x == 0) ((unsigned long long*)(args.ws + WS_DBG + 4096))[(k)] = __builtin_amdgcn_s_memrealtime(); } while (0)
#else
#define STAMP(k) do {} while (0)
#endif
#ifndef REP_P1
#define REP_P1 1
#endif
#ifndef REP_P2
#define REP_P2 1
#endif
#ifndef REP_P8
#define REP_P8 1
#endif
#ifndef REP_P45
#define REP_P45 1
#endif
#ifndef REP_HG0
#define REP_HG0 0
#endif
#ifndef REP_P0
#define REP_P0 1
#endif
#ifndef REP_LN1
#define REP_LN1 0
#endif
#ifndef REP_P69
#define REP_P69 0
#endif
#ifndef REP_ATT0
#define REP_ATT0 0
#endif
#ifndef STG_P1
#define STG_P1 300
#define STG_P4B 300
#define STG_P5 300
#define STG_P6 600
#define STG_P8 300
#define STG_P9 600
#endif
#ifndef STG
#define STG 0
#endif
#define STAGGER(ticks) do { if (STG) { const unsigned long long t0_ = __builtin_amdgcn_s_memrealtime(); const unsigned long long w_ = (unsigned long long)((blockIdx.x & 3) * (ticks)); \
    while (__builtin_amdgcn_s_memrealtime() - t0_ < w_) __builtin_amdgcn_s_sleep(8); } } while (0)
struct Args { const float* in[14]; float* out; unsigned char* ws; };
#define FRESH_PTR(T, var, expr) T var = (T)(expr); asm volatile("" : "+s"(var))
#define IDS() int tid_ = threadIdx.x; asm volatile("" : "+v"(tid_)); const int tid = tid_, lane = tid & 63, wave = __builtin_amdgcn_readfirstlane(tid >> 6); const int G = gridDim.x, bx = blockIdx.x, vcu = (G % 8 == 0) ? (bx % 8) * (G / 8) + bx / 8 : bx; \
              const int gw = vcu * NWAVES + wave, NGW = G * NWAVES; (void)tid; (void)lane; (void)wave; (void)gw; (void)NGW; (void)vcu; (void)bx
__global__ void __launch_bounds__(NTHR, 2) mega_fwd(Args args) {
    extern __shared__ __attribute__((aligned(16))) unsigned char lds_raw[];
    cg::grid_group grid = cg::this_grid();
    const lp lds = (lp)lds_raw;
    volatile LAS unsigned* xbst = (volatile LAS unsigned*)(lds + LDS_TOTAL - 64);
    if (threadIdx.x < 16) xbst[threadIdx.x] = 0u;
    __syncthreads();
    (void)xcd_barrier_post((unsigned*)(args.ws + WS_CTL), xbst);
    grid.sync();
    int tsn = 1; (void)tsn; STAMP(0);

#ifdef DBG_NAN
    if (blockIdx.x == 0 && threadIdx.x == 0) *(unsigned*)(args.ws + WS_DBG) = 990u;
    GSYNC(); STAMP(tsn); ++tsn;
#endif
    for (int rep_ = 0; rep_ < REP_P0; ++rep_) { IDS();
      Ptrs P;
      P.x = args.in[0]; P.w_in = args.in[1]; P.b_fgate = args.in[2]; P.lb_logits = args.in[3]; P.norm_g = args.in[4]; P.w_pa = args.in[5]; P.w_pb = args.in[6]; P.w_o = args.in[7];
      P.ln1_g = args.in[8]; P.ln1_b = args.in[9]; P.w_ff_in = args.in[10]; P.w_ff_out = args.in[11]; P.ln2_g = args.in[12]; P.ln2_b = args.in[13]; P.out = args.out; P.ws = args.ws;
      weight_items(P, (LAS float*)(lds + wave * 16384), gw, NGW, lane);
      __syncthreads();
      stage_wfa(P.w_in, (LAS float*)lds, tid);
      __syncthreads();
      row_pass<false, false, true, true>(P.x, nullptr, (bf16*)(P.ws + WS_XN), nullptr, nullptr, (float*)(P.ws + WS_LF), (const LAS float*)lds, P.b_fgate, gw, NGW, lane); }
    GSYNC(); STAMP(tsn); ++tsn;
    { const int l = 0; DBG(10, args.ws + WS_XN, (size_t)64 * MiB, true); DBG(10, args.ws + WS_LF, (size_t)1 * MiB, false); }

#pragma unroll 1
    for (int l = 0; l < DEPTH; ++l) {
        for (int rep_ = 0; rep_ < REP_P1; ++rep_) {
        { IDS(); FRESH_PTR(unsigned char*, ws, args.ws); FRESH_PTR(const float*, lbl, args.in[3]);
          pg8::Gemm g{(const bf16*)(ws + WS_XN), (const bf16*)(ws + WS_W + (size_t)l * WL_STRIDE + WL_IN), M, NP1, D}; pg8::StaticOrder S; S.init(M, NP1, G, bx);
          pg8::EpiInProj E{(bf16*)(ws + WS_QA), (bf16*)(ws + WS_QB), (bf16*)(ws + WS_KA), (bf16*)(ws + WS_VA), (float*)(ws + WS_G), (bf16*)(ws + WS_IB), (bf16*)(ws + WS_GB), lbl, l, attn_body::C2};
          STAGGER(STG_P1); pg8::gemm_phase<pg8::EpiInProj, pg8::StaticOrder, true, true>(lds, g, S, E); }
        }
        GSYNC(); STAMP(tsn); ++tsn;
        DBG(20, args.ws + WS_QA, (size_t)64 * MiB, true); DBG(30, args.ws + WS_KA, (size_t)64 * MiB, true); DBG(40, args.ws + WS_G, (size_t)64 * MiB, false); DBG(50, args.ws + WS_IB, (size_t)64 * MiB, true);
        for (int rep_ = 0; rep_ < REP_P2; ++rep_) {
        { IDS(); FRESH_PTR(unsigned char*, ws, args.ws);
          for (int u = vcu; u < 2048; u += G) hg::pass1_unit(u, (const float*)(ws + WS_G), (const bf16*)(ws + WS_IB), (bf16*)(ws + WS_ST), (float*)(ws + WS_DEC), lds, tid, (unsigned*)(ws + WS_DBG));
          for (int u = vcu; u < 16; u += G) fcumsum_unit(u, (const float*)(ws + WS_LF), (float*)(ws + WS_F), lds, tid);
          for (int u = vcu; u < 256; u += G) norm_unit(u, (const bf16*)(ws + WS_QA), (const bf16*)(ws + WS_KA), (unsigned*)(ws + WS_CTL + CTL_NORM) + l * 32, tid); }
        }
        GSYNC(); STAMP(tsn); ++tsn;
        DBG(60, args.ws + WS_ST, (size_t)64 * MiB, true); DBG(61, args.ws + WS_DEC, (size_t)1 * MiB, false); DBG(70, args.ws + WS_F, (size_t)1 * MiB, false);
        { IDS(); FRESH_PTR(unsigned char*, ws, args.ws);
          #if REP_HG0
          if (l == 0) { FRESH_PTR(float*, outp, args.out); hg::pass2_scan((const bf16*)(ws + WS_ST), (bf16*)outp, (const float*)(ws + WS_DEC), vcu * NTHR + tid, G * NTHR); }
#endif
          hg::pass2_scan((const bf16*)(ws + WS_ST), (bf16*)(ws + WS_ST), (const float*)(ws + WS_DEC), vcu * NTHR + tid, G * NTHR); }
        GSYNC(); STAMP(tsn); ++tsn;
        DBG(80, args.ws + WS_ST, (size_t)64 * MiB, true);
        { FRESH_PTR(unsigned char*, ws, args.ws);
          const attn_body::AttnTensors AT{(const attn_body::bf16*)(ws + WS_QA), (const attn_body::bf16*)(ws + WS_KA), (const attn_body::bf16*)(ws + WS_VA), (attn_body::bf16*)(ws + WS_QA), (const float*)(ws + WS_F),
                                          (const unsigned*)(ws + WS_CTL + CTL_NORM) + l * 32};
          const attn_body::DynOrder S{(unsigned*)(ws + WS_CTL + CTL_QCTR) + l * 64, (volatile LAS unsigned*)(lds + attn_body::LDS_BYTES + 32)};
          attn_body::attn_phase<attn_body::DynOrder>((char*)lds_raw, AT, S); }
        { IDS(); FRESH_PTR(unsigned char*, ws, args.ws); FRESH_PTR(const float*, ng, args.in[4]);
          volatile LAS unsigned* slot = (volatile LAS unsigned*)(lds + attn_body::LDS_BYTES + 32); unsigned* ctr = (unsigned*)(ws + WS_CTL + CTL_PCTR) + l * 64;
          __syncthreads();
          hg::pass3_loop(ctr, slot, (const float*)(ws + WS_G), (const bf16*)(ws + WS_IB), (const bf16*)(ws + WS_GB), (const bf16*)(ws + WS_ST), (bf16*)(ws + WS_QB), ng + l * 128, lds, tid); }
        GSYNC(); STAMP(tsn); ++tsn;
        DBG(90, args.ws + WS_QA, (size_t)64 * MiB, true);
        for (int rep_ = 0; rep_ < REP_P45; ++rep_) {
        { IDS(); FRESH_PTR(unsigned char*, ws, args.ws);
          pg8::Gemm g{(const bf16*)(ws + WS_XN), (const bf16*)(ws + WS_W + (size_t)l * WL_STRIDE + WL_G), M, NG, D}; pg8::StaticOrder S; S.init(M, NG, G, bx);
          pg8::EpiGates E{(bf16*)(ws + WS_GATES)};
          STAGGER(STG_P4B); pg8::gemm_phase<pg8::EpiGates, pg8::StaticOrder, true, true>(lds, g, S, E); }
        }
        GSYNC(); STAMP(tsn); ++tsn;
        DBG(100, args.ws + WS_GATES, (size_t)128 * MiB, true);
        for (int rep_ = 0; rep_ < REP_P45; ++rep_) {
        { IDS(); FRESH_PTR(unsigned char*, ws, args.ws);
          { pg8::Gemm g{(const bf16*)(ws + WS_QA), (const bf16*)(ws + WS_W + (size_t)l * WL_STRIDE + WL_M), M, D, 512}; pg8::StaticOrder S; S.init(M, D, G, bx);
            pg8::EpiMerge<0> E{(const bf16*)(ws + WS_GATES), (bf16*)(ws + WS_MERGED)};
            STAGGER(STG_P5); pg8::gemm_phase<pg8::EpiMerge<0>, pg8::StaticOrder, true, true>(lds, g, S, E); }
          asm volatile("s_waitcnt vmcnt(0)" ::: "memory"); __syncthreads();
          { pg8::Gemm g{(const bf16*)(ws + WS_QB), (const bf16*)(ws + WS_W + (size_t)l * WL_STRIDE + WL_M + MiB), M, D, 512}; pg8::StaticOrder S; S.init(M, D, G, bx);
            pg8::EpiMerge<1> E{(const bf16*)(ws + WS_GATES), (bf16*)(ws + WS_MERGED)};
            pg8::gemm_phase<pg8::EpiMerge<1>, pg8::StaticOrder, true, true>(lds, g, S, E); } }
        }
        GSYNC(); STAMP(tsn); ++tsn;
        DBG(110, args.ws + WS_MERGED, (size_t)64 * MiB, true);
        { IDS(); FRESH_PTR(unsigned char*, ws, args.ws); FRESH_PTR(const float*, xin, args.in[0]); FRESH_PTR(float*, outp, args.out); const float* xres = (l == 0) ? xin : (const float*)outp;
          pg8::Gemm g{(const bf16*)(ws + WS_MERGED), (const bf16*)(ws + WS_W + (size_t)l * WL_STRIDE + WL_O), M, D, D}; pg8::StaticOrder S; S.init(M, D, G, bx);
          FRESH_PTR(const float*, g2, args.in[12]); FRESH_PTR(const float*, b2, args.in[13]);
#if REP_P69
          { pg8::EpiResid E0{xres, (float*)(ws + WS_IB), ALPHA, (l == 0) ? (const float*)nullptr : (const float*)(ws + WS_CTL + CTL_STATS + 262144), g2 + (l - 1) * D, b2 + (l - 1) * D};
            pg8::gemm_phase<pg8::EpiResid, pg8::StaticOrder, true, true>(lds, g, S, E0); }
#endif
          pg8::EpiResid E{xres, outp, ALPHA, (l == 0) ? (const float*)nullptr : (const float*)(ws + WS_CTL + CTL_STATS + 262144), g2 + (l - 1) * D, b2 + (l - 1) * D};
          STAGGER(STG_P6); pg8::gemm_phase<pg8::EpiResid, pg8::StaticOrder, true, true>(lds, g, S, E); }
        GSYNC(); STAMP(tsn); ++tsn;
        DBG(120, args.out, (size_t)128 * MiB, false);
        { IDS(); FRESH_PTR(unsigned char*, ws, args.ws); FRESH_PTR(float*, outp, args.out); FRESH_PTR(const float*, gm, args.in[8]); FRESH_PTR(const float*, bt, args.in[9]);
#if REP_LN1
          row_pass<true, true, true, false>(outp, (float*)(ws + WS_GATES), (bf16*)(ws + WS_ST), gm + l * D, bt + l * D, nullptr, nullptr, nullptr, gw, NGW, lane);
#endif
          row_pass<true, false, true, false>(outp, nullptr, (bf16*)(ws + WS_XN), gm + l * D, bt + l * D, nullptr, nullptr, nullptr, gw, NGW, lane, (float*)(ws + WS_CTL + CTL_STATS + (size_t)l * 524288)); }
        GSYNC(); STAMP(tsn); ++tsn;
        DBG(130, args.ws + WS_XN, (size_t)64 * MiB, true);
        for (int rep_ = 0; rep_ < REP_P8; ++rep_) {
        { IDS(); FRESH_PTR(unsigned char*, ws, args.ws);
          pg8::Gemm g{(const bf16*)(ws + WS_XN), (const bf16*)(ws + WS_W + (size_t)l * WL_STRIDE + WL_F1), M, NF1, D}; pg8::StaticOrder S; S.init(M, NF1, G, bx);
          pg8::EpiSwiGLU E{(bf16*)(ws + WS_H)};
          STAGGER(STG_P8); pg8::gemm_phase<pg8::EpiSwiGLU, pg8::StaticOrder, true, true>(lds, g, S, E); }
        }
        GSYNC(); STAMP(tsn); ++tsn;
        DBG(140, args.ws + WS_H, (size_t)176 * MiB, true);
        { IDS(); FRESH_PTR(unsigned char*, ws, args.ws); FRESH_PTR(float*, outp, args.out);
          pg8::Gemm g{(const bf16*)(ws + WS_H), (const bf16*)(ws + WS_W + (size_t)l * WL_STRIDE + WL_F2), M, D, FFH}; pg8::StaticOrder S; S.init(M, D, G, bx);
          FRESH_PTR(const float*, g1, args.in[8]); FRESH_PTR(const float*, b1, args.in[9]);
#if REP_P69
          { pg8::EpiResid E0{outp, (float*)(ws + WS_IB), ALPHA, (const float*)(ws + WS_CTL + CTL_STATS + (size_t)l * 524288), g1 + l * D, b1 + l * D};
            pg8::gemm_phase<pg8::EpiResid, pg8::StaticOrder, true, true>(lds, g, S, E0); }
#endif
          pg8::EpiResid E{outp, outp, ALPHA, (const float*)(ws + WS_CTL + CTL_STATS + (size_t)l * 524288), g1 + l * D, b1 + l * D};
          STAGGER(STG_P9); pg8::gemm_phase<pg8::EpiResid, pg8::StaticOrder, true, true>(lds, g, S, E); }
        GSYNC(); STAMP(tsn); ++tsn;
        DBG(150, args.out, (size_t)128 * MiB, false);
        { IDS(); FRESH_PTR(unsigned char*, ws, args.ws); FRESH_PTR(float*, outp, args.out); FRESH_PTR(const float*, gm, args.in[12]); FRESH_PTR(const float*, bt, args.in[13]);
          if (l + 1 < DEPTH) {
              FRESH_PTR(const float*, win, args.in[1]); FRESH_PTR(const float*, bfg, args.in[2]);
              stage_wfa(win + (size_t)(l + 1) * D * NIN, (LAS float*)lds, tid);
              __syncthreads();
              row_pass<true, false, true, true>(outp, nullptr, (bf16*)(ws + WS_XN), gm + l * D, bt + l * D, (float*)(ws + WS_LF), (const LAS float*)lds, bfg + (l + 1) * 8, gw, NGW, lane, (float*)(ws + WS_CTL + CTL_STATS + 262144));
          } else {
              row_pass<true, true, false, false>(outp, outp, nullptr, gm + l * D, bt + l * D, nullptr, nullptr, nullptr, gw, NGW, lane);
          } }
        if (l + 1 < DEPTH) GSYNC(); STAMP(tsn); ++tsn;
    }
#ifdef DBG_TS
    GSYNC(); STAMP(tsn);
    { const volatile unsigned long long* T = (const volatile unsigned long long*)(args.ws + WS_DBG + 4096);
      float sum[2] = {0.f, 0.f};
      if (blockIdx.x == 0) {
          for (int k = 0; k < 23; ++k) { const float us = (float)(T[k + 1] - T[k]) * 0.01f; const int j = (k == 0) ? -1 : (k - 1) % 11;
              for (int w = 0; w < 2; ++w) { const unsigned mask = (w == 0) ? DBG_TS_A : DBG_TS_B; const bool in = (j < 0) ? ((mask >> 15) & 1u) : ((mask >> j) & 1u); if (in) sum[w] += us; } }
          for (int i = threadIdx.x; i < (1 << 20); i += NTHR) args.out[1024 + i] = sum[1];
          __syncthreads();
          if (threadIdx.x == 0) args.out[0] = 100.0f * sum[0];
      } }
#endif
#ifdef DBG_NAN
    GSYNC();
    if (blockIdx.x == 0 && threadIdx.x == 0) args.out[0] = 100.0f * (float)*(volatile unsigned*)(args.ws + WS_DBG);
#endif
}

extern "C" void kernel_launch(void* const* d_in, const int* in_sizes, int n_in, void* d_out, int out_size, void* d_ws, size_t ws_size, hipStream_t stream) {
    static int grid = 0;
    if (grid == 0) {
        if (n_in != 14 || in_sizes[0] != M * D || out_size != M * D || ws_size < WS_END) { fprintf(stderr, "kernel_launch: unexpected shapes (n_in %d, in0 %d, out %d, ws %zu)\n", n_in, n_in > 0 ? in_sizes[0] : -1, out_size, ws_size); grid = -1; return; }
        int dev = 0, cus = 0, per_cu = 0;
        if (hipGetDevice(&dev) != hipSuccess || hipDeviceGetAttribute(&cus, hipDeviceAttributeMultiprocessorCount, dev) != hipSuccess) { grid = -1; return; }
        if (hipFuncSetAttribute((const void*)mega_fwd, hipFuncAttributeMaxDynamicSharedMemorySize, LDS_TOTAL) != hipSuccess) { fprintf(stderr, "kernel_launch: hipFuncSetAttribute failed\n"); grid = -1; return; }
        if (hipOccupancyMaxActiveBlocksPerMultiprocessor(&per_cu, (const void*)mega_fwd, NTHR, LDS_TOTAL) != hipSuccess || per_cu < 1) { fprintf(stderr, "kernel_launch: occupancy query says %d\n", per_cu); per_cu = 1; }
        (void)hipGetLastError();
        grid = cus * per_cu;
    }
    if (grid < 0) return;
    if (hipMemsetAsync((char*)d_ws + WS_CTL, 0, 65536, stream) != hipSuccess) { fprintf(stderr, "kernel_launch: hipMemsetAsync failed\n"); return; }
    Args a{};
    for (int i = 0; i < 14; ++i) a.in[i] = (const float*)d_in[i];
    a.out = (float*)d_out; a.ws = (unsigned char*)d_ws;
    void* kargs[] = {&a};
    hipError_t e = hipLaunchCooperativeKernel((const void*)mega_fwd, dim3(grid), dim3(NTHR), kargs, LDS_TOTAL, stream);
    if (e != hipSuccess) fprintf(stderr, "kernel_launch: cooperative launch failed: %s (grid %d)\n", hipGetErrorString(e), grid);
}
```

```cpp
#include <hip/hip_runtime.h>
#include <cstdio>
#include <cstdint>
namespace pg8 {
#define PG8_LAS __attribute__((address_space(3)))
typedef unsigned short bf16_t;
typedef short bf16x8 __attribute__((ext_vector_type(8)));
typedef float f32x4 __attribute__((ext_vector_type(4)));
typedef unsigned u32x4 __attribute__((ext_vector_type(4)));
constexpr int BM = 256, BK = 64, HALF = 128, HTB = HALF * BK * 2  , STAGE_BYTES = 8 * HTB, NXCD = 8, WGM = 8;

__host__ __device__ __forceinline__ int lds_byte(int r, int c) { const int st = (r >> 4) * 2 + (c >> 5), rr = r & 15, cc = c & 31, ob = rr * 64 + cc * 2; return st * 1024 + (ob ^ (((ob >> 9) & 1) << 5)); }
__host__ __device__ __forceinline__ void stage_rc(int b, int& R, int& C) { const int st = b / 1024, sb = b % 1024, swz = sb ^ (((sb >> 9) & 1) << 5); R = (st >> 1) * 16 + swz / 64; C = (st & 1) * 32 + (swz % 64) / 2; }
__host__ __device__ __forceinline__ int perm32(int rho) { const int n = rho >> 4, i = rho & 15; return 8 * (i >> 2) + 4 * n + (i & 3); }

struct Unit { int pm, pn; };
struct Gemm { const bf16_t* A; const bf16_t* Bt; int M, N, K; };

struct StaticOrder {
    int nM, nN, nwg, G, c;
    __host__ __device__ void init(int M, int N, int G_, int c_) { nM = M / BM; nN = N / BM; nwg = nM * nN; G = G_; c = c_; }
    __host__ __device__ bool next(int i, Unit& u) const {
        const long L = (long)i * G + c; if (L >= nwg) return false;
        int wgid = (int)L; { const int q = nwg / NXCD, r = nwg % NXCD, xcd = wgid % NXCD, off = wgid / NXCD; wgid = (xcd < r ? xcd * (q + 1) : r * (q + 1) + (xcd - r) * q) + off; }
        const int nig = WGM * nN, gid = wgid / nig, fm = gid * WGM, gsz = (nM - fm) < WGM ? (nM - fm) : WGM;
        u.pm = fm + ((wgid % nig) % gsz); u.pn = (wgid % nig) / gsz; return true;
    }
    __device__ __forceinline__ void a_ready(const Unit&) const {}
    __device__ __forceinline__ void done(const Unit&) const {}
};

typedef float f32x2c_t __attribute__((ext_vector_type(2))); typedef __bf16 bf16x2c_t __attribute__((ext_vector_type(2)));
__device__ __forceinline__ unsigned cvt_pk_bf16(float lo, float hi) { f32x2c_t v = {lo, hi}; bf16x2c_t b = __builtin_convertvector(v, bf16x2c_t); return __builtin_bit_cast(unsigned, b); }
typedef float f32x2 __attribute__((ext_vector_type(2)));
__device__ __forceinline__ f32x2 gelu_pk(f32x2 v) {
    const f32x2 av = __builtin_elementwise_abs(v), d = av * 0.2316418882f + 1.0f;
    f32x2 t; t.x = __builtin_amdgcn_rcpf(d.x); t.y = __builtin_amdgcn_rcpf(d.y);
    f32x2 q = t * 0.5307027145f + (-0.7265760135f); q = q * t + 0.7107068705f; q = q * t + (-0.142248368f); q = q * t + 0.127414796f; q = q * t;
    const f32x2 s = (v * v) * (-0.72134752044f);
    f32x2 e; e.x = __builtin_amdgcn_exp2f(s.x); e.y = __builtin_amdgcn_exp2f(s.y);
    const f32x2 m = v * (q * e), r = v - m;
    f32x2 o; o.x = v.x < 0.f ? m.x : r.x; o.y = v.y < 0.f ? m.y : r.y; return o;
}

template <int ACT  > struct EpiBf16 {
    static constexpr bool PERM = true, AFTER_DRAIN = false; static_assert(ACT == 0 || ACT == 1, "EpiBf16: ACT is 0 (none) or 1 (gelu_pk)");
    bf16_t* O; int ldc; const float* bias; int split_cols; size_t split_stride; float scale0;
    __device__ __forceinline__ void operator()(const f32x4 (&acc)[2][2][4][2], const Unit& u, int wr, int wc, int fr, int fq) const {
        const int row0 = u.pm * BM + wr * 64 + fr; int colt = u.pn * BM; bf16_t* base = O;
        float sc = 1.f; if (split_cols) { const int t = colt / split_cols; base += (size_t)t * split_stride; colt -= t * split_cols; if (t == 0) sc = scale0; }
        const int col0 = colt + wc * 32 + 8 * fq, bcol0 = u.pn * BM + wc * 32 + 8 * fq;
        f32x4 bv[2][2];
#pragma unroll
        for (int bj = 0; bj < 2; ++bj)
#pragma unroll
            for (int n = 0; n < 2; ++n) bv[bj][n] = bias ? *(const f32x4*)(bias + bcol0 + bj * HALF + 4 * n) : (f32x4){0.f, 0.f, 0.f, 0.f};
#pragma unroll
        for (int ai = 0; ai < 2; ++ai)
#pragma unroll
            for (int m = 0; m < 4; ++m) { bf16_t* rowp = base + (size_t)(row0 + ai * HALF + m * 16) * ldc + col0;
#pragma unroll
                for (int bj = 0; bj < 2; ++bj) { f32x4 v0 = acc[ai][bj][m][0] + bv[bj][0], v1 = acc[ai][bj][m][1] + bv[bj][1];
                    if (ACT == 1) { f32x2 a = gelu_pk((f32x2){v0[0], v0[1]}), b = gelu_pk((f32x2){v0[2], v0[3]}), c = gelu_pk((f32x2){v1[0], v1[1]}), d = gelu_pk((f32x2){v1[2], v1[3]});
                        v0 = (f32x4){a.x, a.y, b.x, b.y}; v1 = (f32x4){c.x, c.y, d.x, d.y}; }
                    v0 = v0 * sc; v1 = v1 * sc; u32x4 w; w.x = cvt_pk_bf16(v0[0], v0[1]); w.y = cvt_pk_bf16(v0[2], v0[3]); w.z = cvt_pk_bf16(v1[0], v1[1]); w.w = cvt_pk_bf16(v1[2], v1[3]);
                    *(u32x4*)(rowp + bj * HALF) = w; } }
    }
};

struct PanelStats {
    unsigned* xbuf;
    unsigned* cnt;
    unsigned* tmo;
    int ntn; float eps;
    unsigned code;
    __device__ __forceinline__ bool run(const f32x4 (&v)[2][2][4][2], const Unit& u, int wr, int wc, int fr, int fq, PG8_LAS unsigned char* lds, int wid, int lane) const {
        typedef float f32x2v __attribute__((ext_vector_type(2)));
        PG8_LAS f32x2v* P = (PG8_LAS f32x2v*)lds;
        PG8_LAS f32x2v* S = (PG8_LAS f32x2v*)(lds + 8192);
        PG8_LAS unsigned* flag = (PG8_LAS unsigned*)(lds + 8192 + 2048);
#pragma unroll
        for (int ai = 0; ai < 2; ++ai)
#pragma unroll
            for (int m = 0; m < 4; ++m) {
                float s = 0.f;
#pragma unroll
                for (int bj = 0; bj < 2; ++bj)
#pragma unroll
                    for (int n = 0; n < 2; ++n) { const f32x4 x = v[ai][bj][m][n]; s += (x[0] + x[1]) + (x[2] + x[3]); }
                s += __shfl_xor(s, 16); s += __shfl_xor(s, 32);
                const float mw = s * (1.0f / 64.0f); float q = 0.f;
#pragma unroll
                for (int bj = 0; bj < 2; ++bj)
#pragma unroll
                    for (int n = 0; n < 2; ++n) { const f32x4 d = v[ai][bj][m][n] - mw; q += (d[0] * d[0] + d[1] * d[1]) + (d[2] * d[2] + d[3] * d[3]); }
                q += __shfl_xor(q, 16); q += __shfl_xor(q, 32);
                if (fq == 0) P[(ai * HALF + wr * 64 + m * 16 + fr) * 4 + wc] = (f32x2v){mw, q};
            }
        asm volatile("s_waitcnt lgkmcnt(0)" ::: "memory"); __builtin_amdgcn_s_barrier(); asm volatile("" ::: "memory");
#if defined(BROKEN_EXCHANGE_NO_WAIT)
#warning BROKEN CONTROL BUILD: the row-statistics exchange does not wait; results are wrong by design
        if (blockIdx.x >= 64) { const long long t0_ = clock64(); while (clock64() - t0_ < 60000) __builtin_amdgcn_s_sleep(8); }
#endif
        const int row = wid * 32 + (lane & 31);
        if (lane < 32) {
            const f32x2v a = P[row * 4 + 0], b = P[row * 4 + 1], c = P[row * 4 + 2], d = P[row * 4 + 3];
            const float mt = (a.x + b.x + c.x + d.x) * 0.25f;
            const float da = a.x - mt, db = b.x - mt, dc = c.x - mt, dd = d.x - mt;
            const float m2 = (a.y + b.y) + (c.y + d.y) + 64.0f * ((da * da + db * db) + (dc * dc + dd * dd));
            unsigned long long* slot = (unsigned long long*)xbuf + ((size_t)(u.pm * BM + row) * 4 + u.pn);
            __hip_atomic_store(slot, ((unsigned long long)__float_as_uint(m2) << 32) | __float_as_uint(mt), __ATOMIC_RELAXED, __HIP_MEMORY_SCOPE_AGENT);
        }
        asm volatile("s_waitcnt vmcnt(0)" ::: "memory");
        if (lane == 0) __hip_atomic_fetch_add(cnt + 64 * u.pm, 1u, __ATOMIC_RELAXED, __HIP_MEMORY_SCOPE_AGENT);
        if (wid == 0) {
            bool dead = false; const unsigned long long t0 = __builtin_amdgcn_s_memrealtime(); const unsigned want = 8u * (unsigned)ntn;
            for (;;) {
#if defined(BROKEN_EXCHANGE_NO_WAIT)
                break;
#endif
                if ((unsigned)__builtin_amdgcn_readfirstlane(__hip_atomic_load(cnt + 64 * u.pm, __ATOMIC_RELAXED, __HIP_MEMORY_SCOPE_AGENT)) >= want) break;
                if (__builtin_amdgcn_s_memrealtime() - t0 > 2000000ull) {
                    if (lane == 0) { unsigned expect = 0u; __hip_atomic_compare_exchange_strong(tmo + 1, &expect, code | (unsigned)(u.pm & 0xff), __ATOMIC_RELAXED, __ATOMIC_RELAXED, __HIP_MEMORY_SCOPE_AGENT);
                                     __hip_atomic_store(tmo, 1u, __ATOMIC_RELAXED, __HIP_MEMORY_SCOPE_AGENT); }
                    dead = true; break; }
                __builtin_amdgcn_s_sleep(2);
            }
            __builtin_amdgcn_fence(__ATOMIC_ACQUIRE, "agent");
            if (lane == 0) flag[0] = dead ? 1u : 0u;
        }
        asm volatile("s_waitcnt vmcnt(0) lgkmcnt(0)" ::: "memory"); __builtin_amdgcn_s_barrier(); asm volatile("" ::: "memory");
        const bool bad = flag[0] != 0u;
        if (lane < 32) {
            const unsigned long long* slot = (const unsigned long long*)xbuf + (size_t)(u.pm * BM + row) * 4; float mt[4], m2[4]; float ms = 0.f;
#pragma unroll
            for (int t = 0; t < 4; ++t) { if (t < ntn) { const unsigned long long w = __hip_atomic_load(slot + t, __ATOMIC_RELAXED, __HIP_MEMORY_SCOPE_AGENT); mt[t] = __uint_as_float((unsigned)w); m2[t] = __uint_as_float((unsigned)(w >> 32)); } else { mt[t] = 0.f; m2[t] = 0.f; } ms += mt[t]; }
            const float mean = ms / (float)ntn; float q = 0.f;
#pragma unroll
            for (int t = 0; t < 4; ++t) if (t < ntn) { const float dm = mt[t] - mean; q += m2[t] + 256.0f * dm * dm; }
            S[row] = (f32x2v){mean, 1.0f / sqrtf(q / (256.0f * (float)ntn) + eps)};
        }
        asm volatile("s_waitcnt lgkmcnt(0)" ::: "memory"); __builtin_amdgcn_s_barrier(); asm volatile("" ::: "memory");
        return bad;
    }
};
struct EpiLnRes {
    static constexpr bool PERM = false, AFTER_DRAIN = true;
    const float* base; float* out; int ldc; const float* bias; PanelStats st; unsigned poison;
    __device__ __forceinline__ void fused(f32x4 (&acc)[2][2][4][2], const Unit& u, int wr, int wc, int fr, int fq, PG8_LAS unsigned char* lds, int wid, int lane) const {
        typedef float f32x2v __attribute__((ext_vector_type(2)));
        const PG8_LAS f32x2v* S = (const PG8_LAS f32x2v*)(lds + 8192);
        const int col0 = u.pn * BM + wc * 32 + 4 * fq;
#pragma unroll
        for (int bj = 0; bj < 2; ++bj)
#pragma unroll
            for (int n = 0; n < 2; ++n) { const f32x4 bv = bias ? *(const f32x4*)(bias + col0 + bj * HALF + n * 16) : (f32x4){0.f, 0.f, 0.f, 0.f};
#pragma unroll
                for (int ai = 0; ai < 2; ++ai)
#pragma unroll
                    for (int m = 0; m < 4; ++m) acc[ai][bj][m][n] += bv; }
        f32x4 pre[4][2][2];
#pragma unroll
        for (int m = 0; m < 4; ++m) { const size_t off = (size_t)(u.pm * BM + wr * 64 + m * 16 + fr) * ldc + col0;
#pragma unroll
            for (int bj = 0; bj < 2; ++bj)
#pragma unroll
                for (int n = 0; n < 2; ++n) pre[m][bj][n] = *(const f32x4*)(base + off + bj * HALF + n * 16); }
        const bool bad = st.run(acc, u, wr, wc, fr, fq, lds, wid, lane) || poison != 0u;
        const float qnan = __builtin_nanf("");
#pragma unroll
        for (int ai = 0; ai < 2; ++ai)
#pragma unroll
            for (int m = 0; m < 4; ++m) { const int r = ai * HALF + wr * 64 + m * 16 + fr; const f32x2v sr = S[r]; const size_t off = (size_t)(u.pm * BM + r) * ldc + col0;
#pragma unroll
                for (int bj = 0; bj < 2; ++bj)
#pragma unroll
                    for (int n = 0; n < 2; ++n) { const f32x4 bs = ai == 0 ? pre[m][bj][n] : *(const f32x4*)(base + off + bj * HALF + n * 16); f32x4 o = bs + (acc[ai][bj][m][n] - sr.x) * sr.y;
                        if (bad) o = (f32x4){qnan, qnan, qnan, qnan}; *(f32x4*)(out + off + bj * HALF + n * 16) = o; }
                if (m & 1) asm volatile("" ::: "memory"); }
    }
};
struct EpiLnResLn {
    static constexpr bool PERM = false, AFTER_DRAIN = true;
    const float* base; float* out; bf16_t* xn; int ldc; const float* bias; PanelStats st1, st2; unsigned poison;
    __device__ __forceinline__ void fused(f32x4 (&acc)[2][2][4][2], const Unit& u, int wr, int wc, int fr, int fq, PG8_LAS unsigned char* lds, int wid, int lane) const {
        typedef float f32x2v __attribute__((ext_vector_type(2))); typedef unsigned u32x2v __attribute__((ext_vector_type(2)));
        const PG8_LAS f32x2v* S = (const PG8_LAS f32x2v*)(lds + 8192);
        const int col0 = u.pn * BM + wc * 32 + 4 * fq;
#pragma unroll
        for (int bj = 0; bj < 2; ++bj)
#pragma unroll
            for (int n = 0; n < 2; ++n) { const f32x4 bv = bias ? *(const f32x4*)(bias + col0 + bj * HALF + n * 16) : (f32x4){0.f, 0.f, 0.f, 0.f};
#pragma unroll
                for (int ai = 0; ai < 2; ++ai)
#pragma unroll
                    for (int m = 0; m < 4; ++m) acc[ai][bj][m][n] += bv; }
        bool bad = st1.run(acc, u, wr, wc, fr, fq, lds, wid, lane) || poison != 0u;
        const float qnan = __builtin_nanf("");
#pragma unroll
        for (int ai = 0; ai < 2; ++ai)
#pragma unroll
            for (int m = 0; m < 4; ++m) { const int r = ai * HALF + wr * 64 + m * 16 + fr; const f32x2v sr = S[r]; const size_t off = (size_t)(u.pm * BM + r) * ldc + col0;
#pragma unroll
                for (int bj = 0; bj < 2; ++bj)
#pragma unroll
                    for (int n = 0; n < 2; ++n) { const f32x4 bs = *(const f32x4*)(base + off + bj * HALF + n * 16); acc[ai][bj][m][n] = bs + (acc[ai][bj][m][n] - sr.x) * sr.y; }
                asm volatile("" : "+v"(acc[ai][0][m][0]), "+v"(acc[ai][0][m][1]), "+v"(acc[ai][1][m][0]), "+v"(acc[ai][1][m][1]));
                if (m & 1) asm volatile("" ::: "memory"); }
        const bool bad1 = bad;
        bad = st2.run(acc, u, wr, wc, fr, fq, lds, wid, lane) || bad;
#pragma unroll
        for (int ai = 0; ai < 2; ++ai)
#pragma unroll
            for (int m = 0; m < 4; ++m) { const int r = ai * HALF + wr * 64 + m * 16 + fr; const f32x2v sr = S[r]; const size_t off = (size_t)(u.pm * BM + r) * ldc + col0;
#pragma unroll
                for (int bj = 0; bj < 2; ++bj)
#pragma unroll
                    for (int n = 0; n < 2; ++n) { const f32x4 x1 = acc[ai][bj][m][n]; *(f32x4*)(out + off + bj * HALF + n * 16) = bad1 ? (f32x4){qnan, qnan, qnan, qnan} : x1;
                        const f32x4 o = (x1 - sr.x) * sr.y; u32x2v w; w.x = cvt_pk_bf16(o[0], o[1]); w.y = cvt_pk_bf16(o[2], o[3]);
                        if (bad) { w.x = 0x7fc07fc0u; w.y = 0x7fc07fc0u; } *(u32x2v*)(xn + off + bj * HALF + n * 16) = w; }
                asm volatile("" ::: "memory"); }
    }
};

template <class Epi, class Sched, bool ALIGN_EPI = false, bool SP2 = false>
__device__ __forceinline__ void gemm_phase(PG8_LAS unsigned char* lds, const Gemm g, const Sched& S, const Epi& E) {
    int tid_ = threadIdx.x; asm volatile("" : "+v"(tid_));
    const int tid = tid_, wid = __builtin_amdgcn_readfirstlane(tid >> 6), lane = tid & 63, wr = wid >> 2, wc = wid & 3, fr = lane & 15, fq = lane >> 4;
    const int K = g.K, nt = K / BK;
    unsigned voffA[2], voffB[2];
#pragma unroll
    for (int i = 0; i < 2; ++i) { int R, C; stage_rc(tid * 16 + i * 8192, R, C); const int Rb = Epi::PERM ? ((R & ~31) + perm32(R & 31)) : R;
        voffA[i] = (unsigned)(R * K + C) * 2u; voffB[i] = (unsigned)(Rb * K + C) * 2u; }
    const size_t kstep = (size_t)(BK * 2);
    const size_t hstep = (size_t)HALF * K * 2;
    const size_t tstep = 2 * hstep;
    const unsigned ldsw = (unsigned)wid * 1024u;
    const int aoff = lds_byte(wr * 64 + fr, fq * 8), boff = lds_byte(wc * 32 + fr, fq * 8);
#define PG8_SA(b, h) (((b) * 2 + (h)) * HTB)
#define PG8_SB(b, h) ((4 + (b) * 2 + (h)) * HTB)
#define PG8_STAGE(bufoff, gbase, voff) do { _Pragma("unroll") for (int _i = 0; _i < 2; ++_i) \
        __builtin_amdgcn_global_load_lds((const unsigned*)((const char*)(gbase) + (voff)[_i]), (PG8_LAS unsigned*)(lds + (bufoff) + ldsw + _i * 8192), 16, 0, 0); } while (0)
#define PG8_LDA(dst, b, h) do { _Pragma("unroll") for (int m = 0; m < 4; ++m) _Pragma("unroll") for (int k = 0; k < 2; ++k) dst[m][k] = *(const PG8_LAS bf16x8*)(lds + PG8_SA(b, h) + aoff + m * 2048 + k * 1024); } while (0)
#define PG8_LDB(dst, b, h) do { _Pragma("unroll") for (int n = 0; n < 2; ++n) _Pragma("unroll") for (int k = 0; k < 2; ++k) dst[n][k] = *(const PG8_LAS bf16x8*)(lds + PG8_SB(b, h) + boff + n * 2048 + k * 1024); } while (0)
#define PG8_MMA(ai, bj, At, Bt) do { __builtin_amdgcn_s_setprio(1); _Pragma("unroll") for (int m = 0; m < 4; ++m) _Pragma("unroll") for (int n = 0; n < 2; ++n) _Pragma("unroll") for (int k = 0; k < 2; ++k) \
        acc[ai][bj][m][n] = __builtin_amdgcn_mfma_f32_16x16x32_bf16(Bt[n][k], At[m][k], acc[ai][bj][m][n], 0, 0, 0); __builtin_amdgcn_s_setprio(0); } while (0)
#define PG8_WAIT_V(n) asm volatile("s_waitcnt vmcnt(" #n ")" ::: "memory")
#define PG8_WAIT_L(n) asm volatile("s_waitcnt lgkmcnt(" #n ")" ::: "memory")
#define PG8_BAR __builtin_amdgcn_s_barrier()
#define PG8_SCHED __builtin_amdgcn_sched_barrier(0)
    Unit cur, nxt; int ui = 0;
    if (!S.next(0, cur)) return;
    f32x4 acc[2][2][4][2];
#pragma unroll
    for (int a = 0; a < 2; ++a)
#pragma unroll
        for (int b = 0; b < 2; ++b)
#pragma unroll
            for (int m = 0; m < 4; ++m)
#pragma unroll
                for (int n = 0; n < 2; ++n) acc[a][b][m][n] = (f32x4){0.f, 0.f, 0.f, 0.f};
    bf16x8 At[4][2], B0[2][2], B1[2][2];
    const char* cA = (const char*)g.A + (size_t)cur.pm * tstep; const char* cB = (const char*)g.Bt + (size_t)cur.pn * tstep;
    S.a_ready(cur);
    if constexpr (SP2) {
        PG8_STAGE(PG8_SB(0, 0), cB, voffB); PG8_STAGE(PG8_SB(0, 1), cB + hstep, voffB); PG8_STAGE(PG8_SA(0, 0), cA, voffA); PG8_STAGE(PG8_SA(0, 1), cA + hstep, voffA);
        if (wr == 1) PG8_BAR;
        PG8_WAIT_V(2); PG8_BAR;
        PG8_STAGE(PG8_SB(1, 0), cB + kstep, voffB); PG8_STAGE(PG8_SA(1, 0), cA + kstep, voffA); PG8_STAGE(PG8_SB(1, 1), cB + hstep + kstep, voffB);
        PG8_WAIT_V(6); PG8_BAR;
    } else {
        PG8_STAGE(PG8_SB(0, 0), cB, voffB); PG8_STAGE(PG8_SA(0, 0), cA, voffA); PG8_STAGE(PG8_SB(0, 1), cB + hstep, voffB); PG8_STAGE(PG8_SA(0, 1), cA + hstep, voffA);
        if (wr == 1) PG8_BAR;
        PG8_WAIT_V(4); PG8_BAR;
        PG8_STAGE(PG8_SB(1, 0), cB + kstep, voffB); PG8_STAGE(PG8_SA(1, 0), cA + kstep, voffA); PG8_STAGE(PG8_SB(1, 1), cB + hstep + kstep, voffB);
        PG8_WAIT_V(6); PG8_BAR;
    }
    for (;;) {
        const bool has_next = S.next(ui + 1, nxt);
        const char* nA = has_next ? (const char*)g.A + (size_t)nxt.pm * tstep : cA; const char* nB = has_next ? (const char*)g.Bt + (size_t)nxt.pn * tstep : cB;
        for (int t = 0; t < nt; t += 2) {
            const bool last = (t == nt - 2);
            const char* a1 = cA + (size_t)(t + 1) * kstep;
            const char* a2 = last ? nA : cA + (size_t)(t + 2) * kstep; const char* b2 = last ? nB : cB + (size_t)(t + 2) * kstep;
            const char* a3 = a2 + kstep; const char* b3 = b2 + kstep;
            if (last && has_next) S.a_ready(nxt);
            if constexpr (SP2) {
            PG8_LDB(B0, 0, 0); PG8_LDB(B1, 0, 1); PG8_SCHED; PG8_LDA(At, 0, 0); PG8_STAGE(PG8_SA(1, 1), a1 + hstep, voffA);
            PG8_WAIT_V(8); PG8_WAIT_L(0); PG8_BAR; PG8_MMA(0, 0, At, B0); PG8_MMA(0, 1, At, B1); PG8_BAR; PG8_SCHED;
            PG8_LDA(At, 0, 1); PG8_STAGE(PG8_SB(0, 0), b2, voffB); PG8_STAGE(PG8_SB(0, 1), b2 + hstep, voffB); PG8_STAGE(PG8_SA(0, 0), a2, voffA);
            PG8_WAIT_V(8); PG8_WAIT_L(0); PG8_BAR; PG8_MMA(1, 0, At, B0); PG8_MMA(1, 1, At, B1); PG8_BAR; PG8_SCHED;
            PG8_LDB(B0, 1, 0); PG8_LDB(B1, 1, 1); PG8_SCHED; PG8_LDA(At, 1, 0); PG8_STAGE(PG8_SA(0, 1), a2 + hstep, voffA);
            PG8_WAIT_V(8); PG8_WAIT_L(0); PG8_BAR; PG8_MMA(0, 0, At, B0); PG8_MMA(0, 1, At, B1); PG8_BAR; PG8_SCHED;
            PG8_LDA(At, 1, 1); PG8_STAGE(PG8_SB(1, 0), b3, voffB); PG8_STAGE(PG8_SB(1, 1), b3 + hstep, voffB); PG8_STAGE(PG8_SA(1, 0), a3, voffA);
            PG8_WAIT_V(8); PG8_WAIT_L(0); PG8_BAR; PG8_MMA(1, 0, At, B0); PG8_MMA(1, 1, At, B1); PG8_BAR; PG8_SCHED;
            } else {
            PG8_LDB(B0, 0, 0); PG8_SCHED; PG8_LDA(At, 0, 0); PG8_STAGE(PG8_SA(1, 1), a1 + hstep, voffA);
            PG8_WAIT_L(8); PG8_BAR; PG8_WAIT_L(0); PG8_MMA(0, 0, At, B0); PG8_BAR; PG8_SCHED;
            PG8_LDB(B1, 0, 1); PG8_STAGE(PG8_SB(0, 0), b2, voffB);
            PG8_BAR; PG8_WAIT_L(0); PG8_MMA(0, 1, At, B1); PG8_BAR;
            PG8_LDA(At, 0, 1); PG8_STAGE(PG8_SA(0, 0), a2, voffA);
            PG8_BAR; PG8_WAIT_L(0); PG8_MMA(1, 0, At, B0); PG8_BAR; PG8_SCHED;
            PG8_STAGE(PG8_SB(0, 1), b2 + hstep, voffB);
            PG8_WAIT_V(6); PG8_BAR; PG8_MMA(1, 1, At, B1); PG8_BAR;
            PG8_LDB(B0, 1, 0); PG8_SCHED; PG8_LDA(At, 1, 0); PG8_STAGE(PG8_SA(0, 1), a2 + hstep, voffA);
            PG8_WAIT_L(8); PG8_BAR; PG8_WAIT_L(0); PG8_MMA(0, 0, At, B0); PG8_BAR; PG8_SCHED;
            PG8_LDB(B1, 1, 1); PG8_STAGE(PG8_SB(1, 0), b3, voffB);
            PG8_BAR; PG8_WAIT_L(0); PG8_MMA(0, 1, At, B1); PG8_BAR;
            PG8_LDA(At, 1, 1); PG8_STAGE(PG8_SA(1, 0), a3, voffA);
            PG8_BAR; PG8_WAIT_L(0); PG8_MMA(1, 0, At, B0); PG8_BAR; PG8_SCHED;
            PG8_STAGE(PG8_SB(1, 1), b3 + hstep, voffB);
            PG8_WAIT_V(6); PG8_BAR; PG8_MMA(1, 1, At, B1); PG8_BAR;
            }
        }
        if constexpr (ALIGN_EPI) { if (wr == 0) PG8_BAR; }
        if constexpr (!Epi::AFTER_DRAIN) { E(acc, cur, wr, wc, fr, fq); S.done(cur); }
        if (!has_next) break;
#pragma unroll
        for (int a = 0; a < 2; ++a)
#pragma unroll
            for (int b = 0; b < 2; ++b)
#pragma unroll
                for (int m = 0; m < 4; ++m)
#pragma unroll
                    for (int n = 0; n < 2; ++n) acc[a][b][m][n] = (f32x4){0.f, 0.f, 0.f, 0.f};
        cur = nxt; cA = nA; cB = nB; ++ui;
        if constexpr (ALIGN_EPI) { if (wr == 1) PG8_BAR; }
    }
    PG8_WAIT_V(0);
    if constexpr (!ALIGN_EPI) { if (wr == 0) PG8_BAR; }
    PG8_BAR;
    if constexpr (Epi::AFTER_DRAIN) { E.fused(acc, cur, wr, wc, fr, fq, lds, wid, lane); S.done(cur); }
#undef PG8_SA
#undef PG8_SB
#undef PG8_STAGE
#undef PG8_LDA
#undef PG8_LDB
#undef PG8_MMA
#undef PG8_WAIT_V
#undef PG8_WAIT_L
#undef PG8_BAR
#undef PG8_SCHED
}
}
namespace pg8 {
__device__ __forceinline__ float fsig(float v) { return __builtin_amdgcn_rcpf(1.0f + __builtin_amdgcn_exp2f(-1.4426950408889634f * v)); }
__device__ __forceinline__ float bf_lo(unsigned w) { return __uint_as_float(w << 16); }
__device__ __forceinline__ float bf_hi(unsigned w) { return __uint_as_float(w & 0xffff0000u); }

struct EpiInProj {
    static constexpr bool PERM = true, AFTER_DRAIN = false;
    bf16_t* QA; bf16_t* QB; bf16_t* KA; bf16_t* VA; float* G; bf16_t* IB; bf16_t* GB; const float* lbl; int layer; float qscale;
    __device__ __forceinline__ void operator()(const f32x4 (&acc)[2][2][4][2], const Unit& u, int wr, int wc, int fr, int fq) const {
        const int type = u.pn >> 1;
        const int ct = (u.pn & 1) * 256 + wc * 32 + 8 * fq;
        const int row0 = u.pm * BM + wr * 64 + fr;
        if (type == 4) {
            float lb[2][8];
#pragma unroll
            for (int bj = 0; bj < 2; ++bj)
#pragma unroll
                for (int j = 0; j < 8; ++j) {
                    float v = 0.f;
                    if (layer != 0) { const float l0 = lbl[ct + bj * HALF + j], l1 = lbl[512 + ct + bj * HALF + j]; v = 1.0f / (1.0f + __expf(l0 - l1)); }
                    lb[bj][j] = v;
                }
#pragma unroll
            for (int ai = 0; ai < 2; ++ai)
#pragma unroll
                for (int m = 0; m < 4; ++m) { float* rowp = G + (size_t)(row0 + ai * HALF + m * 16) * 512 + ct;
#pragma unroll
                    for (int bj = 0; bj < 2; ++bj) { f32x4 o0, o1;
#pragma unroll
                        for (int j = 0; j < 4; ++j) {
                            const float f0 = lb[bj][j] + (1.0f - lb[bj][j]) * fsig(acc[ai][bj][m][0][j]);
                            const float f1 = lb[bj][4 + j] + (1.0f - lb[bj][4 + j]) * fsig(acc[ai][bj][m][1][j]);
                            o0[j] = __builtin_amdgcn_logf(f0) * 0.6931471805599453f; o1[j] = __builtin_amdgcn_logf(f1) * 0.6931471805599453f; }
                        *(f32x4*)(rowp + bj * HALF) = o0; *(f32x4*)(rowp + bj * HALF + 4) = o1; } }
        } else {
            bf16_t* base; int ldc = 512, act = 0; float sc = 1.f;
            if (type == 0) { base = QA; sc = qscale; }
            else if (type == 1) base = KA;
            else if (type == 2) base = VA;
            else if (type == 3) { base = QB; act = 1; }
            else if (type == 5) base = IB;
            else { base = GB; act = 2; }
#pragma unroll
            for (int ai = 0; ai < 2; ++ai)
#pragma unroll
                for (int m = 0; m < 4; ++m) { bf16_t* rowp = base + (size_t)(row0 + ai * HALF + m * 16) * ldc + ct;
#pragma unroll
                    for (int bj = 0; bj < 2; ++bj) { f32x4 v0 = acc[ai][bj][m][0], v1 = acc[ai][bj][m][1];
                        if (act != 0) {
#pragma unroll
                            for (int j = 0; j < 4; ++j) { const float s0 = fsig(v0[j]), s1 = fsig(v1[j]); v0[j] = (act == 1) ? v0[j] * s0 : s0; v1[j] = (act == 1) ? v1[j] * s1 : s1; }
                        } else { v0 = v0 * sc; v1 = v1 * sc; }
                        u32x4 w; w.x = cvt_pk_bf16(v0[0], v0[1]); w.y = cvt_pk_bf16(v0[2], v0[3]); w.z = cvt_pk_bf16(v1[0], v1[1]); w.w = cvt_pk_bf16(v1[2], v1[3]);
                        *(u32x4*)(rowp + bj * HALF) = w; } }
        }
    }
};
struct EpiGates {
    static constexpr bool PERM = true, AFTER_DRAIN = false;
    bf16_t* O;
    __device__ __forceinline__ void operator()(const f32x4 (&acc)[2][2][4][2], const Unit& u, int wr, int wc, int fr, int fq) const {
        const int row0 = u.pm * BM + wr * 64 + fr, col0 = u.pn * BM + wc * 32 + 8 * fq;
#pragma unroll
        for (int ai = 0; ai < 2; ++ai)
#pragma unroll
            for (int m = 0; m < 4; ++m) { bf16_t* rowp = O + (size_t)(row0 + ai * HALF + m * 16) * 2048 + col0;
#pragma unroll
                for (int bj = 0; bj < 2; ++bj) { f32x4 v0 = acc[ai][bj][m][0], v1 = acc[ai][bj][m][1];
#pragma unroll
                    for (int j = 0; j < 4; ++j) { v0[j] = fsig(v0[j]); v1[j] = fsig(v1[j]); }
                    u32x4 w; w.x = cvt_pk_bf16(v0[0], v0[1]); w.y = cvt_pk_bf16(v0[2], v0[3]); w.z = cvt_pk_bf16(v1[0], v1[1]); w.w = cvt_pk_bf16(v1[2], v1[3]);
                    *(u32x4*)(rowp + bj * HALF) = w; } }
    }
};
template <int STEP> struct EpiMerge {
    static constexpr bool PERM = true, AFTER_DRAIN = false;
    const bf16_t* GT; bf16_t* O;
    __device__ __forceinline__ void operator()(const f32x4 (&acc)[2][2][4][2], const Unit& u, int wr, int wc, int fr, int fq) const {
        const int row0 = u.pm * BM + wr * 64 + fr, col0 = u.pn * BM + wc * 32 + 8 * fq;
#pragma unroll
        for (int ai = 0; ai < 2; ++ai) {
            u32x4 gq[4][2], tq[4][2];
#pragma unroll
            for (int m = 0; m < 4; ++m) { const size_t row = (size_t)(row0 + ai * HALF + m * 16);
#pragma unroll
                for (int bj = 0; bj < 2; ++bj) { gq[m][bj] = *(const u32x4*)(GT + row * 2048 + STEP * 1024 + col0 + bj * HALF);
                    if (STEP == 1) tq[m][bj] = *(const u32x4*)(O + row * 1024 + col0 + bj * HALF); } }
            asm volatile("" ::: "memory");
#pragma unroll
            for (int m = 0; m < 4; ++m) { const size_t row = (size_t)(row0 + ai * HALF + m * 16);
#pragma unroll
                for (int bj = 0; bj < 2; ++bj) { const u32x4 g = gq[m][bj];
                    const f32x4 a0 = acc[ai][bj][m][0], a1 = acc[ai][bj][m][1];
                    float o[8] = {bf_lo(g.x) * a0[0], bf_hi(g.x) * a0[1], bf_lo(g.y) * a0[2], bf_hi(g.y) * a0[3], bf_lo(g.z) * a1[0], bf_hi(g.z) * a1[1], bf_lo(g.w) * a1[2], bf_hi(g.w) * a1[3]};
                    if (STEP == 1) { const u32x4 t = tq[m][bj];
                        o[0] += bf_lo(t.x); o[1] += bf_hi(t.x); o[2] += bf_lo(t.y); o[3] += bf_hi(t.y); o[4] += bf_lo(t.z); o[5] += bf_hi(t.z); o[6] += bf_lo(t.w); o[7] += bf_hi(t.w); }
                    u32x4 w; w.x = cvt_pk_bf16(o[0], o[1]); w.y = cvt_pk_bf16(o[2], o[3]); w.z = cvt_pk_bf16(o[4], o[5]); w.w = cvt_pk_bf16(o[6], o[7]);
                    *(u32x4*)(O + row * 1024 + col0 + bj * HALF) = w; } }
            asm volatile("" ::: "memory");
        }
    }
};
struct EpiSwiGLU {
    static constexpr bool PERM = true, AFTER_DRAIN = false;
    bf16_t* O;
    __device__ __forceinline__ void operator()(const f32x4 (&acc)[2][2][4][2], const Unit& u, int wr, int wc, int fr, int fq) const {
        const int row0 = u.pm * BM + wr * 64 + fr, col0 = u.pn * HALF + wc * 32 + 8 * fq;
#pragma unroll
        for (int ai = 0; ai < 2; ++ai)
#pragma unroll
            for (int m = 0; m < 4; ++m) { const size_t row = (size_t)(row0 + ai * HALF + m * 16);
                f32x4 v0, v1;
#pragma unroll
                for (int j = 0; j < 4; ++j) { const float g0 = acc[ai][1][m][0][j], g1 = acc[ai][1][m][1][j];
                    v0[j] = g0 * fsig(g0) * acc[ai][0][m][0][j]; v1[j] = g1 * fsig(g1) * acc[ai][0][m][1][j]; }
                u32x4 w; w.x = cvt_pk_bf16(v0[0], v0[1]); w.y = cvt_pk_bf16(v0[2], v0[3]); w.z = cvt_pk_bf16(v1[0], v1[1]); w.w = cvt_pk_bf16(v1[2], v1[3]);
                *(u32x4*)(O + row * 2816 + col0) = w; }
    }
};
struct EpiResid {
    static constexpr bool PERM = false, AFTER_DRAIN = false;
    const float* xres; float* out; float alpha; const float* st; const float* gam; const float* bet;
    __device__ __forceinline__ void operator()(const f32x4 (&acc)[2][2][4][2], const Unit& u, int wr, int wc, int fr, int fq) const {
        const int row0 = u.pm * BM + wr * 64 + fr, col0 = u.pn * BM + wc * 32 + 4 * fq;
        typedef float f32x2e __attribute__((ext_vector_type(2)));
        f32x4 gv[2][2], bv[2][2];
        if (st) {
#pragma unroll
            for (int bj = 0; bj < 2; ++bj)
#pragma unroll
                for (int n = 0; n < 2; ++n) { gv[bj][n] = *(const f32x4*)(gam + col0 + bj * HALF + n * 16); bv[bj][n] = *(const f32x4*)(bet + col0 + bj * HALF + n * 16); }
        }
#pragma unroll
        for (int ai = 0; ai < 2; ++ai)
#pragma unroll
            for (int m = 0; m < 4; ++m) { const size_t row = (size_t)(row0 + ai * HALF + m * 16); const size_t off = row * 1024 + col0;
                f32x2e sr = {0.f, 1.f}; if (st) sr = *(const f32x2e*)(st + 2 * row);
#pragma unroll
                for (int bj = 0; bj < 2; ++bj)
#pragma unroll
                    for (int n = 0; n < 2; ++n) { f32x4 x = *(const f32x4*)(xres + off + bj * HALF + n * 16);
                        if (st) x = (x - sr.x) * sr.y * gv[bj][n] + bv[bj][n];
                        *(f32x4*)(out + off + bj * HALF + n * 16) = x * alpha + acc[ai][bj][m][n]; }
                if (m & 1) asm volatile("" ::: "memory"); }
    }
};
}
#include <hip/hip_bf16.h>
#include <cmath>
namespace attn_body {
using bf16=__hip_bfloat16;
using bf16x8=__attribute__((ext_vector_type(8)))short;
using s16x4=__attribute__((ext_vector_type(4)))short;
using f32x16=__attribute__((ext_vector_type(16)))float;
using u32x4=__attribute__((ext_vector_type(4)))unsigned;
constexpr int BATCH=2,NHEAD=8,SEQ=16384,D=64,QP=512,KP=512;
constexpr int NW=8,QBLK=32,QB=QBLK*NW,KVBLK=64,NQB=SEQ/QB;
constexpr int ATTN_UNIT_ROWS=QB;
__device__ __forceinline__ int crow(int r,int hi){return (r&3)+8*(r>>2)+4*hi;}
#define SBAR() __builtin_amdgcn_sched_barrier(0)
__device__ __forceinline__ void cmask(f32x16&p0,f32x16&p1,int jb,int qrel,int hi){
  const float NEG=-INFINITY; int kb=64*jb+4*hi;
  #pragma unroll
  for(int r=0;r<16;++r){int kv=kb+(r&3)+8*(r>>2); if(kv>qrel)p0[r]=NEG; if(kv+32>qrel)p1[r]=NEG;}
}

constexpr int NSLOT=3, SLOTB=8192;
constexpr int LDS_K=0, LDS_V=NSLOT*SLOTB, LDS_WS=2*NSLOT*SLOTB, LDS_OST=LDS_WS+NW*64*4, LDS_FB=LDS_OST+NW*4096, LDS_BYTES=LDS_FB+SEQ*4;
constexpr float C2=0.125f*1.4426950408889634f;
__device__ __forceinline__ void glds16(const void*gsrc,unsigned lds_dst){unsigned keep;
  asm volatile("s_mov_b32 %0, m0\n\ts_mov_b32 m0, %2\n\ts_nop 0\n\tglobal_load_lds_dwordx4 %1, off\n\ts_mov_b32 m0, %0":"=&s"(keep):"v"(gsrc),"s"(lds_dst):"memory");}
__device__ __forceinline__ float max3f(float a,float b,float c){float r;asm("v_max3_f32 %0, %1, %2, %3":"=v"(r):"v"(a),"v"(b),"v"(c));return r;}
__device__ __forceinline__ float max2f(float a,float b){float r;asm("v_max_f32_e32 %0, %1, %2":"=v"(r):"v"(a),"v"(b));return r;}
__device__ __forceinline__ float fadd_s(float a,float b){float r;asm("v_add_f32_e32 %0, %1, %2":"=v"(r):"v"(a),"v"(b));return r;}
__device__ __forceinline__ float fsub_s(float a,float b){float r;asm("v_sub_f32_e32 %0, %1, %2":"=v"(r):"v"(a),"v"(b));return r;}
typedef float f32x2_t __attribute__((ext_vector_type(2))); typedef __bf16 bf16x2_t __attribute__((ext_vector_type(2)));
__device__ __forceinline__ unsigned cvtpk_s(float lo,float hi){f32x2_t v={lo,hi};bf16x2_t b=__builtin_convertvector(v,bf16x2_t);return __builtin_bit_cast(unsigned,b);}
#define WAIT_BAR(N) asm volatile("s_waitcnt vmcnt(" #N ") lgkmcnt(0)\n\ts_barrier":::"memory")

__device__ __forceinline__ void qkt(f32x16&p0,f32x16&p1,const char*Kslot,const bf16x8*qr,int r32,int hi){
  const char*kb=Kslot+hi*1024+r32*16;
  #pragma unroll
  for(int d0=0;d0<4;++d0){
    const bf16x8 b0=*reinterpret_cast<const bf16x8*>(kb+d0*2048);
    const bf16x8 b1=*reinterpret_cast<const bf16x8*>(kb+d0*2048+512);
    p0=__builtin_amdgcn_mfma_f32_32x32x16_bf16(b0,qr[d0],p0,0,0,0);p1=__builtin_amdgcn_mfma_f32_32x32x16_bf16(b1,qr[d0],p1,0,0,0);}
}
typedef __attribute__((address_space(3))) const char* lds_cptr;
typedef short v4i16_t __attribute__((ext_vector_type(4)));
__device__ __forceinline__ void kload8(bf16x8*kf,lds_cptr kp){
  kf[0]=*(const __attribute__((address_space(3))) bf16x8*)(kp);      kf[1]=*(const __attribute__((address_space(3))) bf16x8*)(kp+512);
  kf[2]=*(const __attribute__((address_space(3))) bf16x8*)(kp+2048); kf[3]=*(const __attribute__((address_space(3))) bf16x8*)(kp+2560);
  kf[4]=*(const __attribute__((address_space(3))) bf16x8*)(kp+4096); kf[5]=*(const __attribute__((address_space(3))) bf16x8*)(kp+4608);
  kf[6]=*(const __attribute__((address_space(3))) bf16x8*)(kp+6144); kf[7]=*(const __attribute__((address_space(3))) bf16x8*)(kp+6656);
}
__device__ __forceinline__ void kload2(bf16x8*kf,lds_cptr kp,int j){ kf[2*j]=*(const __attribute__((address_space(3))) bf16x8*)(kp+j*2048); kf[2*j+1]=*(const __attribute__((address_space(3))) bf16x8*)(kp+j*2048+512); }
__device__ __forceinline__ s16x4 vtr(lds_cptr p){ return __builtin_bit_cast(s16x4,__builtin_amdgcn_ds_read_tr16_b64_v4i16((__attribute__((address_space(3))) v4i16_t*)p)); }
__device__ __forceinline__ float rowmax(const f32x16&p0,const f32x16&p1){
  float a=max3f(p0[0],p0[1],p1[0]),b=max3f(p0[2],p0[3],p1[1]);a=max3f(a,p1[2],p1[3]);
  #pragma unroll
  for(int r=4;r<16;r+=4){a=max3f(a,p0[r],p0[r+1]);b=max3f(b,p0[r+2],p0[r+3]);a=max3f(a,p1[r],p1[r+1]);b=max3f(b,p1[r+2],p1[r+3]);}
  const float m=max2f(a,b);
  auto rr=__builtin_amdgcn_permlane32_swap(__float_as_uint(m),__float_as_uint(m),false,false);
  return max2f(__uint_as_float(rr[0]),__uint_as_float(rr[1]));
}
__device__ __forceinline__ void pv(f32x16*o,int vb,bf16x8 pa0,bf16x8 pa1,bf16x8 pa2,bf16x8 pa3){
  #pragma unroll
  for(int d0=0;d0<2;++d0){s16x4 lo[4],hi[4];
    #pragma unroll
    for(int ks=0;ks<4;++ks){
      asm volatile("ds_read_b64_tr_b16 %0,%1 offset:%c2":"=&v"(lo[ks]):"v"(vb),"i"(d0*4096+ks*1024):"memory");
      asm volatile("ds_read_b64_tr_b16 %0,%1 offset:%c2":"=&v"(hi[ks]):"v"(vb),"i"(d0*4096+ks*1024+512):"memory");}
    asm volatile("s_waitcnt lgkmcnt(0)":::"memory");SBAR();
    #define PK(k) (bf16x8){lo[k][0],lo[k][1],lo[k][2],lo[k][3],hi[k][0],hi[k][1],hi[k][2],hi[k][3]}
    o[d0]=__builtin_amdgcn_mfma_f32_32x32x16_bf16(pa0,PK(0),o[d0],0,0,0);
    o[d0]=__builtin_amdgcn_mfma_f32_32x32x16_bf16(pa1,PK(1),o[d0],0,0,0);
    o[d0]=__builtin_amdgcn_mfma_f32_32x32x16_bf16(pa2,PK(2),o[d0],0,0,0);
    o[d0]=__builtin_amdgcn_mfma_f32_32x32x16_bf16(pa3,PK(3),o[d0],0,0,0);
    #undef PK
  }
}

#ifndef ATTN_STORE16
#define ATTN_STORE16(p,v) (*(u32x4*)(p)=(v))
#endif
template<int THRL> __device__ __forceinline__ void attn_unit(int b,int h,int qb,const bf16*Q,const bf16*__restrict__ K,const bf16*__restrict__ V,bf16*O,const float*__restrict__ Fg,const unsigned*__restrict__ NB,char*shm){
  int tid_=threadIdx.x; asm volatile("":"+v"(tid_));
  const int tid=tid_,lane=tid&63,r32=lane&31,hi=lane>>5; const int wid=__builtin_amdgcn_readfirstlane(tid>>6);
  const long rowbase=(long)b*SEQ; const int q0=qb*QB;
  const bf16*Qw=Q+(rowbase+q0+wid*QBLK)*QP+h*D;
  const bf16*Kh=K+rowbase*KP+h*D,*Vh=V+rowbase*KP+h*D;
  __attribute__((address_space(3))) char* const shm3w=(__attribute__((address_space(3))) char*)shm;
  const unsigned lds0=(unsigned)(uintptr_t)shm;
  float*wsf=(float*)(shm+LDS_WS)+wid*64;
  const bf16*ksrc_=Kh+(long)lane*KP+wid*8;
  const bf16*vsrc_=Vh+(long)(16*(wid&3)+(lane>>2))*KP+(wid>>2)*32+(lane&3)*8;
  const unsigned kdst=lds0+LDS_K+wid*1024, vdst=lds0+LDS_V+wid*1024;
  #define DMA_K(t,slot) glds16(ksrc+(long)(t)*KVBLK*KP,(unsigned)__builtin_amdgcn_readfirstlane(kdst+(slot)))
  #define DMA_V(t,slot) glds16(vsrc+(long)(t)*KVBLK*KP,(unsigned)__builtin_amdgcn_readfirstlane(vdst+(slot)))
  const int vb0=(int)(lds0+LDS_V)+((lane>>4)&1)*32+(lane&3)*8+(4*hi+((lane&15)>>2))*64;
  const char*Kbase=shm+LDS_K; bf16x8 kf[8];
  const lds_cptr shm3=(lds_cptr)shm; const lds_cptr kp0=shm3+LDS_K+hi*1024+r32*16; const lds_cptr vp0=shm3+LDS_V+((lane>>4)&1)*32+(lane&3)*8+(4*hi+((lane&15)>>2))*64;
  const int NT0=(q0+QB)/KVBLK;
  int j0;
  { typedef __attribute__((address_space(3))) unsigned* lds_uptr; const lds_uptr cnt=(lds_uptr)(shm3w+LDS_BYTES+16);
    const float fref=Fg[q0]; const float Bq=__builtin_sqrtf(__uint_as_float(NB[0])*__uint_as_float(NB[1])); const float thr=-(152.0f+2.0f*Bq);
    if(tid==0)*cnt=0u;
    asm volatile("s_waitcnt lgkmcnt(0)\n\ts_barrier":::"memory");
    bool skip=false; if(tid<NT0-4){ skip=((fref-Fg[64*tid+63])*1.4426950408889634f<thr); }
    const unsigned long long bal=__ballot(skip); if(lane==0&&bal)__hip_atomic_fetch_add(cnt,(unsigned)__popcll(bal),__ATOMIC_RELAXED,__HIP_MEMORY_SCOPE_WORKGROUP);
    asm volatile("s_waitcnt lgkmcnt(0)\n\ts_barrier":::"memory");
    j0=(int)(*cnt)&~1; j0=__builtin_amdgcn_readfirstlane(j0);
    typedef __attribute__((address_space(3))) float* lds_fptr; const lds_fptr fbl=(lds_fptr)(shm3w+LDS_FB);
    for(int i=64*j0+tid;i<q0+QB;i+=NW*64) fbl[i]=(fref-Fg[i])*1.4426950408889634f; }
  const int NT=NT0-j0;
  const bf16*ksrc=ksrc_+(long)j0*KVBLK*KP; const bf16*vsrc=vsrc_+(long)j0*KVBLK*KP;
  DMA_K(0,0);DMA_V(0,0);DMA_K(1,SLOTB);
  bf16x8 qr[4];
  #pragma unroll
  for(int d0=0;d0<4;++d0)qr[d0]=*reinterpret_cast<const bf16x8*>(&Qw[(long)r32*QP+d0*16+hi*8]);
  float mhat=0.f,l_reg=0.f;f32x16 o[2];o[0]=f32x16{};o[1]=f32x16{};
  const lds_cptr fb0=(lds_cptr)shm3w+LDS_FB+hi*16+j0*256;
  typedef float f32x4v __attribute__((ext_vector_type(4)));
  #define BLD(P0,P1,t) do{ const lds_cptr fp_=fb0+(t)*256; _Pragma("unroll") for(int j_=0;j_<4;++j_){ \
      const f32x4v a_=*(const __attribute__((address_space(3))) f32x4v*)(fp_+j_*32), b_=*(const __attribute__((address_space(3))) f32x4v*)(fp_+128+j_*32); \
      P0[4*j_]=a_[0];P0[4*j_+1]=a_[1];P0[4*j_+2]=a_[2];P0[4*j_+3]=a_[3]; P1[4*j_]=b_[0];P1[4*j_+1]=b_[1];P1[4*j_+2]=b_[2];P1[4*j_+3]=b_[3]; } }while(0)
  const int qrel=wid*QBLK+r32;
  #define CMASK(P0,P1,t) do{int jb_=(t)-(NT-4); if(jb_>=0)cmask(P0,P1,jb_,qrel,hi);}while(0)
  bool resc=false;
  #define START(P0,P1) do{ const float rm=rowmax(P0,P1); resc=false; mhat=rm; \
    _Pragma("unroll") for(int r=0;r<16;++r)P0[r]=__builtin_amdgcn_exp2f(P0[r]-mhat); }while(0)
  #define RESC() do{ if(resc){ asm volatile("s_waitcnt lgkmcnt(0)":::"memory"); \
      _Pragma("unroll") for(int d_=0;d_<2;++d_) _Pragma("unroll") for(int r=0;r<16;++r)o[d_][r]*=wsf[crow(r,hi)]; } }while(0)
  f32x16 pA0,pA1,pB0,pB1;
  int sl_prev=0,sl_cur=0,sl_next=SLOTB;
  #define ROT() do{sl_prev=sl_cur;sl_cur=sl_next;sl_next=(sl_next==(NSLOT-1)*SLOTB)?0:sl_next+SLOTB;}while(0)
  DMA_K(2,2*SLOTB);
  WAIT_BAR(3);
  BLD(pA0,pA1,0);
  qkt(pA0,pA1,Kbase,qr,r32,hi);asm volatile("s_nop 15\n\ts_nop 7":"+v"(pA0),"+v"(pA1));CMASK(pA0,pA1,0);
  START(pA0,pA1);
  _Pragma("unroll") for(int r=0;r<16;++r)pA1[r]=__builtin_amdgcn_exp2f(pA1[r]-mhat);
  WAIT_BAR(0);
  DMA_K(3,0);DMA_V(1,SLOTB);
  ROT();
  kload8(kf,kp0+sl_cur);
  BLD(pB0,pB1,1);
  WAIT_BAR(2);
  s16x4 vlo[8],vhi[8]; u32x4 pw0,pw1,pw2,pw3;
  #define PKW(P,B) cvtpk_s(P[B],P[B+1])
  #define PAF(k) __builtin_bit_cast(bf16x8,pw##k)
  #define VFR(i) (bf16x8){vlo[i][0],vlo[i][1],vlo[i][2],vlo[i][3],vhi[i][0],vhi[i][1],vhi[i][2],vhi[i][3]}
  #define PIN(x) asm volatile("":"+v"(x))
  #define MX3(a,b,c) __builtin_fmaxf(__builtin_fmaxf((a),(b)),(c))
  #define GAPA(MF,A0,A1,A2,A3,W0,W1,PW) do{ MF; sacc+=A0; sacc+=A1; sacc+=A2; sacc+=A3; PIN(sacc); W0; W1; PIN(PW); SBAR(); }while(0)
  #define EX(v) __builtin_amdgcn_exp2f(v)
  #define GAPB(MF,X,B) do{ MF; X[B]=EX(X[B]-mhat); X[B+1]=EX(X[B+1]-mhat); X[B+2]=EX(X[B+2]-mhat); X[B+3]=EX(X[B+3]-mhat); PIN(X); SBAR(); }while(0)
  #define VRD(i) do{ vlo[i]=vtr(vp_+(((i)>>2)*4096+((i)&3)*1024)); vhi[i]=vtr(vp_+(((i)>>2)*4096+((i)&3)*1024+512)); }while(0)
  #define KRD(G,j) do{ if(G){ kload2(kf,kp0+sl_next,j); SBAR(); } }while(0)
  #define STEP(C0,C1,P0,P1,t,GK,GV,GL) do{ SBAR(); \
    const lds_cptr vp_=vp0+sl_prev; \
    VRD(0); SBAR(); float sacc=(P0[0]+P0[1]); \
    GAPA(C0=__builtin_amdgcn_mfma_f32_32x32x16_bf16(kf[0],qr[0],C0,0,0,0), P0[2],P0[3],P0[4],P0[5],     pw0[0]=PKW(P0,0), pw0[1]=PKW(P0,2), pw0); \
    VRD(4); SBAR(); GAPA(C1=__builtin_amdgcn_mfma_f32_32x32x16_bf16(kf[1],qr[0],C1,0,0,0), P0[6],P0[7],P0[8],P0[9],     pw0[2]=PKW(P0,4), pw0[3]=PKW(P0,6), pw0); \
    VRD(1); SBAR(); GAPA(C0=__builtin_amdgcn_mfma_f32_32x32x16_bf16(kf[2],qr[1],C0,0,0,0),   P0[10],P0[11],P0[12],P0[13], pw1[0]=PKW(P0,8), pw1[1]=PKW(P0,10), pw1); \
    VRD(5); SBAR(); GAPA(C1=__builtin_amdgcn_mfma_f32_32x32x16_bf16(kf[3],qr[1],C1,0,0,0),   P0[14],P0[15],P1[0],P1[1],   pw1[2]=PKW(P0,12),pw1[3]=PKW(P0,14), pw1); \
    VRD(2); SBAR(); GAPA(C0=__builtin_amdgcn_mfma_f32_32x32x16_bf16(kf[4],qr[2],C0,0,0,0),   P1[2],P1[3],P1[4],P1[5],     pw2[0]=PKW(P1,0), pw2[1]=PKW(P1,2), pw2); \
    VRD(6); SBAR(); GAPA(C1=__builtin_amdgcn_mfma_f32_32x32x16_bf16(kf[5],qr[2],C1,0,0,0),   P1[6],P1[7],P1[8],P1[9],     pw2[2]=PKW(P1,4), pw2[3]=PKW(P1,6), pw2); \
    VRD(3); SBAR(); GAPA(C0=__builtin_amdgcn_mfma_f32_32x32x16_bf16(kf[6],qr[3],C0,0,0,0),   P1[10],P1[11],P1[12],P1[13], pw3[0]=PKW(P1,8), pw3[1]=PKW(P1,10), pw3); \
    VRD(7); SBAR(); GAPA(C1=__builtin_amdgcn_mfma_f32_32x32x16_bf16(kf[7],qr[3],C1,0,0,0),   P1[14],P1[15],0.f,0.f,       pw3[2]=PKW(P1,12),pw3[3]=PKW(P1,14), pw3); \
    l_reg+=sacc; \
    if(GK){DMA_K((t)+3,sl_cur);} if(GV){DMA_V((t)+1,sl_next);} \
    CMASK(C0,C1,t); \
    { float a=MX3(C0[0],C0[1],C1[0]),b=MX3(C0[2],C0[3],C1[1]); a=MX3(a,C1[2],C1[3]); \
      _Pragma("unroll") for(int r=4;r<16;r+=4){a=MX3(a,C0[r],C0[r+1]);b=MX3(b,C0[r+2],C0[r+3]);a=MX3(a,C1[r],C1[r+1]);b=MX3(b,C1[r+2],C1[r+3]);} \
      float rm=__builtin_fmaxf(a,b); { auto rr=__builtin_amdgcn_permlane32_swap(__float_as_uint(rm),__float_as_uint(rm),false,false); rm=__builtin_fmaxf(__uint_as_float(rr[0]),__uint_as_float(rr[1])); } \
      rm-=mhat; resc=false; \
      if(__builtin_expect(__any(rm>(float)THRL),0)){ const float dl=__builtin_fmaxf(rm,0.f); mhat+=dl; \
        const float f=__builtin_amdgcn_exp2f(-dl); l_reg*=f; if(hi==0)wsf[r32]=f; resc=true; } } \
    SBAR(); if(GL){ BLD(P0,P1,(t)+1); } \
    SBAR(); \
    GAPB(o[0]=__builtin_amdgcn_mfma_f32_32x32x16_bf16(PAF(0),VFR(0),o[0],0,0,0), C0,0); \
    GAPB(o[1]=__builtin_amdgcn_mfma_f32_32x32x16_bf16(PAF(0),VFR(4),o[1],0,0,0), C0,4); \
    KRD(GL,0); GAPB(o[0]=__builtin_amdgcn_mfma_f32_32x32x16_bf16(PAF(1),VFR(1),o[0],0,0,0), C0,8); \
    KRD(GL,1); GAPB(o[1]=__builtin_amdgcn_mfma_f32_32x32x16_bf16(PAF(1),VFR(5),o[1],0,0,0), C0,12); \
    KRD(GL,2); GAPB(o[0]=__builtin_amdgcn_mfma_f32_32x32x16_bf16(PAF(2),VFR(2),o[0],0,0,0), C1,0); \
    KRD(GL,3); GAPB(o[1]=__builtin_amdgcn_mfma_f32_32x32x16_bf16(PAF(2),VFR(6),o[1],0,0,0), C1,4); \
    GAPB(o[0]=__builtin_amdgcn_mfma_f32_32x32x16_bf16(PAF(3),VFR(3),o[0],0,0,0), C1,8); \
    GAPB(o[1]=__builtin_amdgcn_mfma_f32_32x32x16_bf16(PAF(3),VFR(7),o[1],0,0,0), C1,12); \
    }while(0)
  int t=1;
  #undef CMASK
  #define CMASK(P0,P1,t) do{}while(0)
  for(;t+5<NT;t+=2){
    STEP(pB0,pB1,pA0,pA1,t,true,true,true);     WAIT_BAR(2); RESC(); ROT();
    STEP(pA0,pA1,pB0,pB1,t+1,true,true,true);   WAIT_BAR(2); RESC(); ROT();
  }
  #undef CMASK
  #define CMASK(P0,P1,t) do{int jb_=(t)-(NT-4); if(jb_>=0)cmask(P0,P1,jb_,qrel,hi);}while(0)
  #define ENDW(tt) do{ if((tt)+3<NT){WAIT_BAR(2);} else if((tt)+2<NT){WAIT_BAR(1);} else {WAIT_BAR(0);} }while(0)
  for(;t+1<NT;t+=2){
    STEP(pB0,pB1,pA0,pA1,t,(t+3<NT),(t+1<NT),(t+1<NT));       ENDW(t);   RESC(); ROT();
    STEP(pA0,pA1,pB0,pB1,t+1,(t+4<NT),(t+2<NT),(t+2<NT));     ENDW(t+1); RESC(); ROT();
  }
  STEP(pB0,pB1,pA0,pA1,NT-1,false,false,false); RESC();
  { float sacc=pB0[0]+pB0[1]; _Pragma("unroll") for(int r=2;r<16;++r)sacc+=pB0[r]; _Pragma("unroll") for(int r=0;r<16;++r)sacc+=pB1[r]; l_reg+=sacc;
    pw0=(u32x4){PKW(pB0,0),PKW(pB0,2),PKW(pB0,4),PKW(pB0,6)};pw1=(u32x4){PKW(pB0,8),PKW(pB0,10),PKW(pB0,12),PKW(pB0,14)};pw2=(u32x4){PKW(pB1,0),PKW(pB1,2),PKW(pB1,4),PKW(pB1,6)};pw3=(u32x4){PKW(pB1,8),PKW(pB1,10),PKW(pB1,12),PKW(pB1,14)};
    SBAR(); pv(o,vb0+sl_cur,PAF(0),PAF(1),PAF(2),PAF(3)); }
  #undef PKW
  #undef PAF
  #undef VFR
  #undef PIN
  #undef MX3
  #undef GAPA
  #undef GAPB
  #undef EX
  #undef VRD
  #undef KRD
  #undef STEP
  #undef ENDW
  {auto rr=__builtin_amdgcn_permlane32_swap(__float_as_uint(l_reg),__float_as_uint(l_reg),false,false);l_reg=__uint_as_float(rr[0])+__uint_as_float(rr[1]);}
  if(hi==0)wsf[32+r32]=l_reg;asm volatile("s_waitcnt lgkmcnt(0)":::"memory");
  float rli[16];
  #pragma unroll
  for(int r=0;r<16;++r)rli[r]=__builtin_amdgcn_rcpf(wsf[32+crow(r,hi)]);
  bf16*Ow=O+(rowbase+q0+wid*QBLK)*QP+h*D;
  { bf16*stg=(bf16*)(shm+LDS_OST)+wid*2048;
    #pragma unroll
    for(int r=0;r<16;++r){const int orow=crow(r,hi);
      #pragma unroll
      for(int d0=0;d0<2;++d0)stg[orow*64+d0*32+r32]=__float2bfloat16(o[d0][r]*rli[r]);}
    asm volatile("s_waitcnt lgkmcnt(0)":::"memory");
    #pragma unroll
    for(int i=0;i<4;++i){const int row=i*8+(lane>>3),ch=lane&7; const u32x4 v=*(const u32x4*)(stg+row*64+ch*8); ATTN_STORE16(Ow+(long)row*QP+ch*8,v);} }
  asm volatile("s_waitcnt lgkmcnt(0)\n\ts_barrier":::"memory");
  #undef DMA_K
  #undef DMA_V
  #undef CMASK
  #undef START
  #undef RESC
  #undef BLD
  #undef ROT
}
constexpr int ATTN_LDS_BYTES=LDS_BYTES;
struct AttnTensors { const bf16* Q; const bf16* K; const bf16* V; bf16* O; const float* F; const unsigned* NB; };
struct AttnUnit { int bh; int qb; };
struct DynOrder {
  unsigned* ctr; volatile __attribute__((address_space(3))) unsigned* slot;
  __device__ __forceinline__ bool next(int,AttnUnit&u)const{
    if(threadIdx.x==0)*slot=__hip_atomic_fetch_add(ctr,1u,__ATOMIC_RELAXED,__HIP_MEMORY_SCOPE_AGENT);
    asm volatile("s_waitcnt vmcnt(0) lgkmcnt(0)\n\ts_barrier":::"memory");
    const unsigned n=*slot; if(n>=1024u)return false; u.qb=63-(int)(n>>4); u.bh=(int)(n&15u); return true; }
  __device__ __forceinline__ void a_ready(const AttnUnit&)const{}
  __device__ __forceinline__ void done(const AttnUnit&)const{}
};
template<class Sched,int THRL=8> __device__ __forceinline__ void attn_phase(char*lds,const AttnTensors&T,const Sched&S){
  AttnUnit u;
  for(int i=0;S.next(i,u);++i){ S.a_ready(u); attn_unit<THRL>(u.bh/NHEAD,u.bh%NHEAD,u.qb,T.Q,T.K,T.V,T.O,T.F+(long)u.bh*SEQ,T.NB+2*u.bh,lds); S.done(u); }
}
#undef SBAR
#undef WAIT_BAR
}
#include <hip/hip_cooperative_groups.h>
namespace cg = cooperative_groups;
#define LAS __attribute__((address_space(3)))
typedef unsigned short bf16;
typedef unsigned v4u __attribute__((ext_vector_type(4)));
typedef float f32x4 __attribute__((ext_vector_type(4)));
typedef short bf16x8 __attribute__((ext_vector_type(8)));
typedef LAS unsigned char* lp;

#define XB_TMO      128
#define XB_XCNT(j)  (256  + 64 * (j))
#define XB_XSUB(j)  (1280 + 64 * (j))
#define XB_XGEN(j)  (2304 + 64 * (j))
#define XB_TOP      3328
#define XB_TOPGEN   3392
#define XCD_BAR_WORDS 3456
#define XB_SPIN_CAP (1u << 18)

__device__ __forceinline__ unsigned xb_ld(unsigned* p)              { return __hip_atomic_load(p, __ATOMIC_RELAXED, __HIP_MEMORY_SCOPE_AGENT); }
__device__ __forceinline__ unsigned xb_add(unsigned* p, unsigned v) { return __hip_atomic_fetch_add(p, v, __ATOMIC_RELAXED, __HIP_MEMORY_SCOPE_AGENT); }
__device__ __forceinline__ unsigned xb_xcc_id() { return (unsigned)__builtin_amdgcn_s_getreg((3 << 11) | 20) & 0xFu; }
#define XB_SPIN(cond, bar) do { unsigned _sp = 0; while (cond) { __builtin_amdgcn_s_sleep(1); \
    if ((++_sp & 255u) == 0u) { if (xb_ld(&(bar)[XB_TMO])) break; if (_sp > XB_SPIN_CAP) { atomicAdd(&(bar)[XB_TMO], 1u); break; } } } } while (0)

struct XcdBarrier {
    unsigned* bar; unsigned x;
    volatile LAS unsigned* st;
};

__device__ __forceinline__ XcdBarrier xcd_barrier_post(unsigned* bar, volatile LAS unsigned* st) {
    XcdBarrier b; b.bar = bar; b.x = xb_xcc_id(); b.st = st;
    if (threadIdx.x == 0) (void)xb_add(&bar[XB_XCNT(b.x)], 1u);
    return b;
}
__device__ __forceinline__ void xcd_barrier_complete(unsigned* bar, unsigned x, unsigned& nloc, unsigned& nx) {
    const unsigned G = gridDim.x * gridDim.y * gridDim.z;
    unsigned sum, cnt, mine, sp = 0u;
    for (;;) {
        sum = 0u; cnt = 0u; mine = 0u;
#pragma unroll
        for (unsigned j = 0; j < 16; ++j) { const unsigned c = xb_ld(&bar[XB_XCNT(j)]); sum += c; cnt += (c > 0u) ? 1u : 0u; mine = (j == x) ? c : mine; }
        if (sum == G) break;
        __builtin_amdgcn_s_sleep(1);
        if ((++sp & 255u) == 0u) { if (xb_ld(&bar[XB_TMO])) break; if (sp > XB_SPIN_CAP) { atomicAdd(&bar[XB_TMO], 1u); break; } }
    }
    nloc = mine > 0u ? mine : 1u; nx = cnt > 0u ? cnt : 1u;
}

__device__ __forceinline__ void xcd_barrier(const XcdBarrier& b) {
    asm volatile("s_waitcnt vmcnt(0)" ::: "memory");
    __syncthreads();
    if (threadIdx.x == 0) {
        unsigned* bar = b.bar;
        __builtin_amdgcn_s_waitcnt(0);
        unsigned nloc = b.st[0], nx = b.st[1];
        if (nloc == 0u) { xcd_barrier_complete(bar, b.x, nloc, nx); b.st[0] = nloc; b.st[1] = nx; }
        const unsigned old = xb_add(&bar[XB_XSUB(b.x)], 1u);
        const unsigned gen = old / nloc;
        if (old + 1u == (gen + 1u) * nloc) {
            __builtin_amdgcn_fence(__ATOMIC_RELEASE, "agent");
            asm volatile("s_waitcnt vmcnt(0)" ::: "memory");
            const unsigned og = xb_add(&bar[XB_TOP], 1u);
            const unsigned tg = og / nx;
            if (og + 1u == (tg + 1u) * nx) xb_add(&bar[XB_TOPGEN], 1u);
            else XB_SPIN(xb_ld(&bar[XB_TOPGEN]) == tg, bar);
            __builtin_amdgcn_fence(__ATOMIC_ACQUIRE, "agent");
            xb_add(&bar[XB_XGEN(b.x)], 1u);
            asm volatile("s_waitcnt vmcnt(0)" ::: "memory");
        } else {
            XB_SPIN(xb_ld(&bar[XB_XGEN(b.x)]) == gen, bar);
            __builtin_amdgcn_fence(__ATOMIC_ACQUIRE, "agent");
            asm volatile("s_waitcnt vmcnt(0)" ::: "memory");
        }
    }
    __syncthreads();
}


constexpr int NWAVES = 8, NTHR = 512;
constexpr int BATCH = 2, SEQ = 16384, D = 1024, M = BATCH * SEQ, DEPTH = 2;
constexpr int NIN = 5640, NP1 = 3584, NG = 2048, FFH = 2816, NF1 = 5632;
constexpr float ALPHA = 1.4142135623730951f;
constexpr float LN_EPS = 1e-5f, RMS_EPS = 1e-6f;
constexpr size_t MiB = 1u << 20;
constexpr size_t WL_IN = 0, WL_G = 7 * MiB, WL_M = 11 * MiB, WL_O = 15 * MiB, WL_F1 = 17 * MiB, WL_F2 = 28 * MiB, WL_STRIDE = 34 * MiB;
constexpr size_t WS_W = 0, WS_XN = 68 * MiB, WS_QA = 132 * MiB, WS_QB = 164 * MiB, WS_KA = 196 * MiB, WS_VA = 228 * MiB, WS_G = 260 * MiB, WS_IB = 324 * MiB, WS_GB = 356 * MiB,
                 WS_ST = 388 * MiB, WS_DEC = 452 * MiB, WS_LF = 453 * MiB, WS_F = 454 * MiB, WS_CTL = 455 * MiB  , WS_DBG = 455 * MiB + 512 * 1024, WS_END = 456 * MiB;
constexpr size_t WS_GATES = WS_G  , WS_MERGED = WS_KA  , WS_H = WS_QA  ;
constexpr size_t CTL_QCTR = 16384  , CTL_PCTR = 18432  , CTL_STATS = 131072  , CTL_NORM = 20480  ;
constexpr int LDS_TOTAL = 155648;
static_assert(attn_body::LDS_BYTES <= LDS_TOTAL && pg8::STAGE_BYTES <= LDS_TOTAL, "LDS map");

__device__ __forceinline__ float wave_sum(float v) {
#pragma unroll
    for (int o = 1; o < 64; o <<= 1) v += __shfl_xor(v, o);
    return v;
}
__device__ __forceinline__ unsigned pk2(float lo, float hi) { return pg8::cvt_pk_bf16(lo, hi); }
__device__ __forceinline__ float bf2f(unsigned short h) { return __uint_as_float((unsigned)h << 16); }

__device__ __forceinline__ void transpose_item(const float* Wsrc, int pitch, bf16* WTdst, int Kdst, LAS float* scr, int lane, bool zero) {
    if (!zero) {
#pragma unroll
        for (int i = 0; i < 32; ++i) { const int kk = 2 * i + (lane >> 5); scr[kk * 33 + (lane & 31)] = Wsrc[(size_t)kk * pitch + (lane & 31)]; }
    }
    asm volatile("s_waitcnt lgkmcnt(0)" ::: "memory");
    const int c = lane & 7;
#pragma unroll
    for (int j = 0; j < 4; ++j) { const int n = (lane >> 3) + 8 * j; const LAS float* s = scr + (8 * c) * 33 + n;
        v4u o;
        if (zero) { o = (v4u){0u, 0u, 0u, 0u}; }
        else { o.x = pk2(s[0 * 33], s[1 * 33]); o.y = pk2(s[2 * 33], s[3 * 33]); o.z = pk2(s[4 * 33], s[5 * 33]); o.w = pk2(s[6 * 33], s[7 * 33]); }
        *(v4u*)(WTdst + (size_t)n * Kdst + 8 * c) = o; }
    asm volatile("s_waitcnt lgkmcnt(0)" ::: "memory");
}

struct Ptrs {
    const float *x, *w_in, *b_fgate, *lb_logits, *norm_g, *w_pa, *w_pb, *w_o, *ln1_g, *ln1_b, *w_ff_in, *w_ff_out, *ln2_g, *ln2_b;
    float* out; unsigned char* ws;
};

__device__ __forceinline__ void weight_items(const Ptrs& P, LAS float* scr, int gw, int NGW, int lane) {
    constexpr int I_IN = 16 * (NP1 / 32), I_G = 16 * (NG / 32), I_M = 2 * 8 * 32, I_O = 16 * 32, I_F1 = 16 * (NF1 / 32), I_F2 = (FFH / 64) * 32;
    constexpr int PER_LAYER = I_IN + I_G + I_M + I_O + I_F1 + I_F2;
    for (int it = gw; it < DEPTH * PER_LAYER; it += NGW) {
        const int l = it / PER_LAYER; int r = it % PER_LAYER;
        bf16* WB = (bf16*)(P.ws + WS_W + (size_t)l * WL_STRIDE);
        if (r < I_IN) { const int nblk = NP1 / 32, kb = r / nblk, nb = r % nblk, k0 = 64 * kb, n0 = 32 * nb; const int sc = n0 < 1536 ? n0 : n0 + 8;
            transpose_item(P.w_in + (size_t)l * D * NIN + (size_t)k0 * NIN + sc, NIN, (bf16*)((unsigned char*)WB + WL_IN) + (size_t)n0 * 1024 + k0, 1024, scr, lane, false); continue; } r -= I_IN;
        if (r < I_G) { const int nblk = NG / 32, kb = r / nblk, nb = r % nblk, k0 = 64 * kb, n0 = 32 * nb;
            transpose_item(P.w_in + (size_t)l * D * NIN + (size_t)k0 * NIN + 3592 + n0, NIN, (bf16*)((unsigned char*)WB + WL_G) + (size_t)n0 * 1024 + k0, 1024, scr, lane, false); continue; } r -= I_G;
        if (r < I_M) { const int which = r >> 8, rr = r & 255, kb = rr >> 5, nb = rr & 31, k0 = 64 * kb, n0 = 32 * nb;
            const float* src = (which ? P.w_pb : P.w_pa) + (size_t)l * 512 * 1024 + (size_t)k0 * 1024 + n0;
            transpose_item(src, 1024, (bf16*)((unsigned char*)WB + WL_M + (size_t)which * MiB) + (size_t)n0 * 512 + k0, 512, scr, lane, false); continue; } r -= I_M;
        if (r < I_O) { const int nblk = 32, kb = r / nblk, nb = r % nblk, k0 = 64 * kb, n0 = 32 * nb;
            transpose_item(P.w_o + (size_t)l * 1024 * 1024 + (size_t)k0 * 1024 + n0, 1024, (bf16*)((unsigned char*)WB + WL_O) + (size_t)n0 * 1024 + k0, 1024, scr, lane, false); continue; } r -= I_O;
        if (r < I_F1) { const int nblk = NF1 / 32, kb = r / nblk, nb = r % nblk, k0 = 64 * kb, n0 = 32 * nb; const int tile = n0 >> 8, half = (n0 >> 7) & 1, col = half * FFH + 128 * tile + (n0 & 127);
            transpose_item(P.w_ff_in + (size_t)l * D * NF1 + (size_t)k0 * NF1 + col, NF1, (bf16*)((unsigned char*)WB + WL_F1) + (size_t)n0 * 1024 + k0, 1024, scr, lane, false); continue; } r -= I_F1;
        { const int nblk = 32, kb = r / nblk, nb = r % nblk, k0 = 64 * kb, n0 = 32 * nb;
            transpose_item(P.w_ff_out + (size_t)l * FFH * 1024 + (size_t)k0 * 1024 + n0, 1024, (bf16*)((unsigned char*)WB + WL_F2) + (size_t)n0 * FFH + k0, FFH, scr, lane, false); }
    }
}

__device__ __forceinline__ void stage_wfa(const float* w_in_l, LAS float* wfa, int tid) {
    for (int idx = tid; idx < 8192; idx += NTHR) { const int k = idx >> 3, col = idx & 7; const int j = k >> 8, ln = (k >> 2) & 63, i = k & 3, half = col >> 2, c = col & 3;
        wfa[((((j * 4 + i) * 2 + half) * 64) + ln) * 4 + c] = w_in_l[(size_t)k * NIN + 1536 + col]; }
}
template <bool DO_LN, bool W32, bool WBF, bool DO_FA>
__device__ __forceinline__ void row_pass(const float* src, float* dst32, bf16* dstbf, const float* gam, const float* bet, float* lf, const LAS float* wfa, const float* bfg, int gw, int NGW, int lane, float* stats = nullptr) {
    constexpr int R = 4;
    f32x4 gv[4], bv[4];
    if (DO_LN) {
#pragma unroll
        for (int j = 0; j < 4; ++j) { gv[j] = ((const f32x4*)gam)[64 * j + lane]; bv[j] = ((const f32x4*)bet)[64 * j + lane]; }
    }
    for (int m0 = gw; m0 < M; m0 += R * NGW) {
        f32x4 v[R][4]; int mr[R]; bool ok[R];
#pragma unroll
        for (int r = 0; r < R; ++r) { const int m = m0 + r * NGW; ok[r] = m < M; mr[r] = ok[r] ? m : m0; const f32x4* xr = (const f32x4*)(src + (size_t)mr[r] * D) + lane;
#pragma unroll
            for (int j = 0; j < 4; ++j) v[r][j] = xr[64 * j]; }
        if (DO_LN) {
            float s[R], s2[R], mean[R], rstd[R];
#pragma unroll
            for (int r = 0; r < R; ++r) { s[r] = 0.f;
#pragma unroll
                for (int j = 0; j < 4; ++j) s[r] += (v[r][j].x + v[r][j].y) + (v[r][j].z + v[r][j].w); }
#pragma unroll
            for (int o = 1; o < 64; o <<= 1)
#pragma unroll
                for (int r = 0; r < R; ++r) s[r] += __shfl_xor(s[r], o);
#pragma unroll
            for (int r = 0; r < R; ++r) { mean[r] = s[r] * (1.f / D); s2[r] = 0.f;
#pragma unroll
                for (int j = 0; j < 4; ++j) { v[r][j] = v[r][j] - mean[r]; s2[r] += (v[r][j].x * v[r][j].x + v[r][j].y * v[r][j].y) + (v[r][j].z * v[r][j].z + v[r][j].w * v[r][j].w); } }
#pragma unroll
            for (int o = 1; o < 64; o <<= 1)
#pragma unroll
                for (int r = 0; r < R; ++r) s2[r] += __shfl_xor(s2[r], o);
#pragma unroll
            for (int r = 0; r < R; ++r) { rstd[r] = 1.f / sqrtf(s2[r] * (1.f / D) + LN_EPS);
                if (stats && lane == 0 && ok[r]) { stats[2 * (size_t)mr[r]] = mean[r]; stats[2 * (size_t)mr[r] + 1] = rstd[r]; }
#pragma unroll
                for (int j = 0; j < 4; ++j) v[r][j] = v[r][j] * rstd[r] * gv[j] + bv[j]; }
        }
#pragma unroll
        for (int r = 0; r < R; ++r) { if (!ok[r]) continue; const int m = mr[r];
            if (W32) { f32x4* o = (f32x4*)(dst32 + (size_t)m * D) + lane;
#pragma unroll
                for (int j = 0; j < 4; ++j) o[64 * j] = v[r][j]; }
            if (WBF) { unsigned long long* o8 = (unsigned long long*)(dstbf + (size_t)m * D) + lane;
#pragma unroll
                for (int j = 0; j < 4; ++j) o8[64 * j] = (unsigned long long)pk2(v[r][j].x, v[r][j].y) | ((unsigned long long)pk2(v[r][j].z, v[r][j].w) << 32); } }
        if (DO_FA) {
            float a[R][8];
#pragma unroll
            for (int r = 0; r < R; ++r)
#pragma unroll
                for (int c = 0; c < 8; ++c) a[r][c] = 0.f;
#pragma unroll
            for (int j = 0; j < 4; ++j)
#pragma unroll
                for (int i = 0; i < 4; ++i) {
                    const f32x4 w0 = *(const LAS f32x4*)(wfa + ((((j * 4 + i) * 2 + 0) * 64) + lane) * 4), w1 = *(const LAS f32x4*)(wfa + ((((j * 4 + i) * 2 + 1) * 64) + lane) * 4);
#pragma unroll
                    for (int r = 0; r < R; ++r) { const float xv = v[r][j][i];
                        a[r][0] += xv * w0.x; a[r][1] += xv * w0.y; a[r][2] += xv * w0.z; a[r][3] += xv * w0.w; a[r][4] += xv * w1.x; a[r][5] += xv * w1.y; a[r][6] += xv * w1.z; a[r][7] += xv * w1.w; } }
#pragma unroll
            for (int o = 1; o < 64; o <<= 1)
#pragma unroll
                for (int r = 0; r < R; ++r)
#pragma unroll
                    for (int c = 0; c < 8; ++c) a[r][c] += __shfl_xor(a[r][c], o);
#pragma unroll
            for (int r = 0; r < R; ++r) { float z = a[r][0];
#pragma unroll
                for (int c = 1; c < 8; ++c) z = (lane == c) ? a[r][c] : z;
                if (lane < 8 && ok[r]) { z += bfg[lane]; const float ls = fminf(z, 0.f) - __logf(1.0f + __expf(-fabsf(z))); lf[(size_t)mr[r] * 8 + lane] = ls; } }
        }
    }
}

__device__ __forceinline__ void fcumsum_unit(int bh, const float* LF, float* F, lp lds, int tid) {
    const int b = bh >> 3, h = bh & 7, lane = tid & 63, wave = tid >> 6;
    const float* src = LF + ((size_t)b * SEQ + (size_t)tid * 32) * 8 + h;
    float cs[32]; float run = 0.f;
#pragma unroll
    for (int i = 0; i < 32; ++i) { run += src[i * 8]; cs[i] = run; }
    float inc = run;
#pragma unroll
    for (int o = 1; o < 64; o <<= 1) { const float n = __shfl_up(inc, o); if (lane >= o) inc += n; }
    LAS float* WS = (LAS float*)lds;
    if (lane == 63) WS[wave] = inc;
    __syncthreads();
    float woff = 0.f;
    for (int w = 0; w < wave; ++w) woff += WS[w];
    const float excl = woff + inc - run;
    float* dst = F + (size_t)bh * SEQ + (size_t)tid * 32;
#pragma unroll
    for (int i = 0; i < 32; i += 4) *(f32x4*)(dst + i) = (f32x4){excl + cs[i], excl + cs[i + 1], excl + cs[i + 2], excl + cs[i + 3]};
    __syncthreads();
}

__device__ __forceinline__ void norm_unit(int v, const bf16* QA, const bf16* KA, unsigned* NB, int tid) {
    const int bh = v >> 4, seg = v & 15, b = bh >> 3, h = bh & 7, lane = tid & 63;
    float mq = 0.f, mk = 0.f;
#pragma unroll
    for (int e = 0; e < 2; ++e) { const size_t row = (size_t)b * SEQ + seg * 1024 + tid * 2 + e;
        const v4u* qp = (const v4u*)(QA + row * 512 + h * 64); const v4u* kp = (const v4u*)(KA + row * 512 + h * 64); float sq = 0.f, sk = 0.f;
#pragma unroll
        for (int i = 0; i < 8; ++i) { const v4u a = qp[i], c = kp[i];
#pragma unroll
            for (int k = 0; k < 4; ++k) { const float a0 = __uint_as_float(a[k] << 16), a1 = __uint_as_float(a[k] & 0xffff0000u), c0 = __uint_as_float(c[k] << 16), c1 = __uint_as_float(c[k] & 0xffff0000u);
                sq += a0 * a0 + a1 * a1; sk += c0 * c0 + c1 * c1; } }
        mq = fmaxf(mq, sq); mk = fmaxf(mk, sk); }
#pragma unroll
    for (int o = 1; o < 64; o <<= 1) { mq = fmaxf(mq, __shfl_xor(mq, o)); mk = fmaxf(mk, __shfl_xor(mk, o)); }
    if (lane == 0) { atomicMax(NB + 2 * bh, __float_as_uint(mq * 1.01f)); atomicMax(NB + 2 * bh + 1, __float_as_uint(mk * 1.01f)); }
}

namespace hg {
constexpr int P128 = 136, P64 = 72;
constexpr int O_QP = 0, O_QPP = O_QP + 64 * P128 * 2, O_KP = O_QPP + 64 * P128 * 2, O_VT = O_KP + 64 * P128 * 2, O_ST = O_VT + 128 * P64 * 2, O_PM = O_ST + 128 * P128 * 2,
              O_PT = O_PM + 64 * P64 * 2, O_RS = O_PT + 2048, O_END = O_RS + 512;
constexpr int O_KDT = O_QP;
static_assert(O_END <= 131072 && 128 * P64 * 2 <= 2 * 64 * P128 * 2, "hgrn LDS map");

__device__ __forceinline__ void load_cumsum(const float* Gu, int d, int part, lp lds, float (&g)[16], float (&b)[16], float& bmid, float& blast) {
#pragma unroll
    for (int i = 0; i < 16; ++i) g[i] = Gu[(size_t)(part * 16 + i) * 512 + d];
    float run = 0.f;
#pragma unroll
    for (int i = 0; i < 16; ++i) { run += g[i]; b[i] = run; }
    LAS float* PT = (LAS float*)(lds + O_PT);
    PT[part * 128 + d] = run;
    __syncthreads();
    const float p0 = PT[d], p1 = PT[128 + d], p2 = PT[256 + d], p3 = PT[384 + d];
    const float off = (part > 0 ? p0 : 0.f) + (part > 1 ? p1 : 0.f) + (part > 2 ? p2 : 0.f);
#pragma unroll
    for (int i = 0; i < 16; ++i) b[i] += off;
    bmid = p0 + p1; blast = (p0 + p1) + (p2 + p3);
}
__device__ __forceinline__ void stage_vt(const bf16* vp  , lp lds, int e, int part) {
    unsigned w[8];
#pragma unroll
    for (int i = 0; i < 8; ++i) { const unsigned lo = vp[(size_t)(2 * i) * 512], hi = vp[(size_t)(2 * i + 1) * 512]; w[i] = lo | (hi << 16); }
    LAS v4u* dst = (LAS v4u*)(lds + O_VT + (e * P64 + part * 16) * 2);
    dst[0] = (v4u){w[0], w[1], w[2], w[3]}; dst[1] = (v4u){w[4], w[5], w[6], w[7]};
}
__device__ __forceinline__ void pass1_unit(int unit, const float* G, const bf16* IB, bf16* ST, float* DEC, lp lds, int tid, unsigned* dbgw = nullptr) {
    const int c = unit & 255, h = (unit >> 8) & 3, b = unit >> 10;
    const int d = tid & 127, part = tid >> 7, lane = tid & 63, wave = tid >> 6, fr = lane & 15, fq = lane >> 4;
    const size_t row0 = (size_t)b * SEQ + (size_t)c * 64;
    float g[16], bb[16], bmid, blast;
    load_cumsum(G + row0 * 512 + h * 128, d, part, lds, g, bb, bmid, blast);
#ifdef DBG_P1
    { bool b1 = false, b3 = false; for (int i = 0; i < 16; ++i) { if (g[i] > 0.f) b1 = true; const float kk = (1.0f - __expf(g[i])) * __expf(blast - bb[i]); if (!(fabsf(kk) < 1e30f)) b3 = true; }
      if (b1) atomicMin(dbgw, 51u); if (b3) atomicMin(dbgw, 53u); }
#endif
    { unsigned w[8];
#pragma unroll
      for (int i = 0; i < 8; ++i) { const float k0 = (1.0f - __expf(g[2 * i])) * __expf(blast - bb[2 * i]), k1 = (1.0f - __expf(g[2 * i + 1])) * __expf(blast - bb[2 * i + 1]); w[i] = pk2(k0, k1); }
      LAS v4u* dst = (LAS v4u*)(lds + O_KDT + (d * P64 + part * 16) * 2);
      dst[0] = (v4u){w[0], w[1], w[2], w[3]}; dst[1] = (v4u){w[4], w[5], w[6], w[7]}; }
    stage_vt(IB + (row0 + part * 16) * 512 + h * 128 + d, lds, d, part);
    if (part == 0) DEC[(size_t)unit * 128 + d] = __expf(blast);
    __syncthreads();
    const bf16x8 a0 = *(const LAS bf16x8*)(lds + O_VT + ((16 * wave + fr) * P64 + 8 * fq) * 2), a1 = *(const LAS bf16x8*)(lds + O_VT + ((16 * wave + fr) * P64 + 32 + 8 * fq) * 2);
    bf16* out = ST + (size_t)unit * 16384;
#pragma unroll
    for (int dt = 0; dt < 8; ++dt) {
        const bf16x8 b0 = *(const LAS bf16x8*)(lds + O_KDT + ((16 * dt + fr) * P64 + 8 * fq) * 2), b1 = *(const LAS bf16x8*)(lds + O_KDT + ((16 * dt + fr) * P64 + 32 + 8 * fq) * 2);
        f32x4 acc = (f32x4){0.f, 0.f, 0.f, 0.f};
        acc = __builtin_amdgcn_mfma_f32_16x16x32_bf16(a0, b0, acc, 0, 0, 0);
        acc = __builtin_amdgcn_mfma_f32_16x16x32_bf16(a1, b1, acc, 0, 0, 0);
#ifdef DBG_P1
        for (int r = 0; r < 4; ++r) if (!(fabsf(acc[r]) < 1e30f)) atomicMin(dbgw, 54u);
#endif
#pragma unroll
        for (int r = 0; r < 4; ++r) out[(16 * wave + 4 * fq + r) * 128 + 16 * dt + fr] = (bf16)(pk2(acc[r], 0.f) & 0xffffu);
    }
    __syncthreads();
}
__device__ __forceinline__ void pass1_loop(int first, int stride, const float* G, const bf16* IB, bf16* ST, float* DEC, lp lds, int tid) {
    const int d = tid & 127, part = tid >> 7, lane = tid & 63, wave = tid >> 6, fr = lane & 15, fq = lane >> 4;
    float g[16]; unsigned short vv[16];
#define P1_LOAD(unit_) do { const int c_ = (unit_) & 255, h_ = ((unit_) >> 8) & 3, b_ = (unit_) >> 10; const size_t r0_ = (size_t)b_ * SEQ + (size_t)c_ * 64 + part * 16; \
        const float* gp_ = G + r0_ * 512 + h_ * 128 + d; const bf16* vp_ = IB + r0_ * 512 + h_ * 128 + d; \
        _Pragma("unroll") for (int i = 0; i < 16; ++i) { g[i] = gp_[(size_t)i * 512]; vv[i] = vp_[(size_t)i * 512]; } } while (0)
    if (first < 2048) P1_LOAD(first);
    for (int unit = first; unit < 2048; unit += stride) {
        float bb[16], blast;
        { float run = 0.f;
#pragma unroll
          for (int i = 0; i < 16; ++i) { run += g[i]; bb[i] = run; }
          LAS float* PT = (LAS float*)(lds + O_PT); PT[part * 128 + d] = run;
          asm volatile("s_waitcnt lgkmcnt(0)\n\ts_barrier" ::: "memory");
          const float p0 = PT[d], p1 = PT[128 + d], p2 = PT[256 + d], p3 = PT[384 + d];
          const float off = (part > 0 ? p0 : 0.f) + (part > 1 ? p1 : 0.f) + (part > 2 ? p2 : 0.f);
#pragma unroll
          for (int i = 0; i < 16; ++i) bb[i] += off;
          blast = (p0 + p1) + (p2 + p3); }
        { unsigned w[8];
#pragma unroll
          for (int i = 0; i < 8; ++i) { const float k0 = (1.0f - __expf(g[2 * i])) * __expf(blast - bb[2 * i]), k1 = (1.0f - __expf(g[2 * i + 1])) * __expf(blast - bb[2 * i + 1]); w[i] = pk2(k0, k1); }
          LAS v4u* dst = (LAS v4u*)(lds + O_KDT + (d * P64 + part * 16) * 2); dst[0] = (v4u){w[0], w[1], w[2], w[3]}; dst[1] = (v4u){w[4], w[5], w[6], w[7]}; }
        { unsigned w[8];
#pragma unroll
          for (int i = 0; i < 8; ++i) w[i] = (unsigned)vv[2 * i] | ((unsigned)vv[2 * i + 1] << 16);
          LAS v4u* dst = (LAS v4u*)(lds + O_VT + (d * P64 + part * 16) * 2); dst[0] = (v4u){w[0], w[1], w[2], w[3]}; dst[1] = (v4u){w[4], w[5], w[6], w[7]}; }
        if (part == 0) DEC[(size_t)unit * 128 + d] = __expf(blast);
        asm volatile("s_waitcnt lgkmcnt(0)\n\ts_barrier" ::: "memory");
        if (unit + stride < 2048) P1_LOAD(unit + stride);
        const bf16x8 a0 = *(const LAS bf16x8*)(lds + O_VT + ((16 * wave + fr) * P64 + 8 * fq) * 2), a1 = *(const LAS bf16x8*)(lds + O_VT + ((16 * wave + fr) * P64 + 32 + 8 * fq) * 2);
        bf16* out = ST + (size_t)unit * 16384;
#pragma unroll
        for (int dt = 0; dt < 8; ++dt) {
            const bf16x8 b0 = *(const LAS bf16x8*)(lds + O_KDT + ((16 * dt + fr) * P64 + 8 * fq) * 2), b1 = *(const LAS bf16x8*)(lds + O_KDT + ((16 * dt + fr) * P64 + 32 + 8 * fq) * 2);
            f32x4 acc = (f32x4){0.f, 0.f, 0.f, 0.f};
            acc = __builtin_amdgcn_mfma_f32_16x16x32_bf16(a0, b0, acc, 0, 0, 0);
            acc = __builtin_amdgcn_mfma_f32_16x16x32_bf16(a1, b1, acc, 0, 0, 0);
#pragma unroll
            for (int r = 0; r < 4; ++r) out[(16 * wave + 4 * fq + r) * 128 + 16 * dt + fr] = (bf16)(pk2(acc[r], 0.f) & 0xffffu);
        }
        asm volatile("s_waitcnt lgkmcnt(0)\n\ts_barrier" ::: "memory");
    }
#undef P1_LOAD
}
__device__ __forceinline__ void pass2_scan(const bf16* STin, bf16* ST, const float* DEC, int gtid, int gthreads) {
    for (int id = gtid; id < 8 * 16384; id += gthreads) {
        const int bh = id >> 14, ed = id & 16383, d = ed & 127;
        bf16* p = ST + (size_t)bh * 256 * 16384 + ed; const bf16* pi = STin + (size_t)bh * 256 * 16384 + ed; const float* dp = DEC + (size_t)bh * 256 * 128 + d;
        float state = 0.f;
        for (int c = 0; c < 256; c += 32) {
            unsigned short u[32]; float dc[32];
#pragma unroll
            for (int i = 0; i < 32; ++i) { u[i] = pi[(size_t)(c + i) * 16384]; dc[i] = dp[(size_t)(c + i) * 128]; }
#pragma unroll
            for (int i = 0; i < 32; ++i) { p[(size_t)(c + i) * 16384] = (bf16)(pk2(state, 0.f) & 0xffffu); state = dc[i] * state + bf2f(u[i]); }
        }
    }
}
__device__ __forceinline__ void pass3_unit(int unit, const float* G, const bf16* IB, const bf16* GB, const bf16* ST, const bf16* QB, bf16* YB, const float* normg, lp lds, int tid) {
    const int c = unit & 255, h = (unit >> 8) & 3, b = unit >> 10;
    const int d = tid & 127, part = tid >> 7, lane = tid & 63, wave = tid >> 6, fr = lane & 15, fq = lane >> 4;
    const size_t row0 = (size_t)b * SEQ + (size_t)c * 64;
    unsigned short gbv[4][4];
    { const int rb_ = wave & 3, ch_ = wave >> 2;
#pragma unroll
      for (int r = 0; r < 4; ++r) { const bf16* gbp_ = GB + (row0 + 16 * rb_ + 4 * fq + r) * 512 + h * 128 + 64 * ch_ + fr;
#pragma unroll
          for (int j = 0; j < 4; ++j) gbv[r][j] = gbp_[16 * j]; } }
    { const bf16* sp = ST + (size_t)unit * 16384;
#pragma unroll
      for (int ps = 0; ps < 4; ++ps) { const int idx = ps * NTHR + tid, e = idx >> 4, d8 = (idx & 15) * 8; const v4u w = *(const v4u*)(sp + e * 128 + d8); *(LAS v4u*)(lds + O_ST + (e * P128 + d8) * 2) = w; } }
    float g[16], bb[16], bmid, blast;
    load_cumsum(G + row0 * 512 + h * 128, d, part, lds, g, bb, bmid, blast);
    { const bf16* qp = QB + (row0 + part * 16) * 512 + h * 128 + d; const float emid = __expf(bmid);
      LAS bf16* Qp = (LAS bf16*)(lds + O_QP), *Qpp = (LAS bf16*)(lds + O_QPP), *Kp = (LAS bf16*)(lds + O_KP);
#pragma unroll
      for (int i = 0; i < 16; ++i) { const float q = bf2f(qp[(size_t)i * 512]); const float q1 = q * __expf(bb[i] - bmid), q2 = q1 * emid, k1 = (1.0f - __expf(g[i])) * __expf(bmid - bb[i]);
          const int t = part * 16 + i; const unsigned w = pk2(q1, q2), w2 = pk2(k1, 0.f);
          Qp[t * P128 + d] = (bf16)(w & 0xffffu); Qpp[t * P128 + d] = (bf16)(w >> 16); Kp[t * P128 + d] = (bf16)(w2 & 0xffffu); } }
    stage_vt(IB + (row0 + part * 16) * 512 + h * 128 + d, lds, d, part);
    __syncthreads();
    { const int ti = wave >> 1; LAS bf16* Pm = (LAS bf16*)(lds + O_PM);
#pragma unroll
      for (int sj2 = 0; sj2 < 2; ++sj2) { const int sj = 2 * (wave & 1) + sj2; f32x4 acc = (f32x4){0.f, 0.f, 0.f, 0.f};
#pragma unroll
          for (int ks = 0; ks < 4; ++ks) { const bf16x8 a = *(const LAS bf16x8*)(lds + O_QP + ((16 * ti + fr) * P128 + 32 * ks + 8 * fq) * 2), bq = *(const LAS bf16x8*)(lds + O_KP + ((16 * sj + fr) * P128 + 32 * ks + 8 * fq) * 2);
              acc = __builtin_amdgcn_mfma_f32_16x16x32_bf16(a, bq, acc, 0, 0, 0); }
#pragma unroll
          for (int r = 0; r < 4; ++r) { const int t = 16 * ti + 4 * fq + r, s = 16 * sj + fr; const float v = (s <= t) ? acc[r] : 0.f; Pm[t * P64 + s] = (bf16)(pk2(v, 0.f) & 0xffffu); } } }
    __syncthreads();
    const int rb = wave & 3, ch = wave >> 2;
    f32x4 o[4];
#pragma unroll
    for (int j = 0; j < 4; ++j) o[j] = (f32x4){0.f, 0.f, 0.f, 0.f};
    { bf16x8 ap[2], aq[4];
#pragma unroll
      for (int ks = 0; ks < 2; ++ks) ap[ks] = *(const LAS bf16x8*)(lds + O_PM + ((16 * rb + fr) * P64 + 32 * ks + 8 * fq) * 2);
#pragma unroll
      for (int ks = 0; ks < 4; ++ks) aq[ks] = *(const LAS bf16x8*)(lds + O_QPP + ((16 * rb + fr) * P128 + 32 * ks + 8 * fq) * 2);
#pragma unroll
      for (int j = 0; j < 4; ++j) { const int e0 = 64 * ch + 16 * j;
#pragma unroll
          for (int ks = 0; ks < 2; ++ks) { const bf16x8 bv = *(const LAS bf16x8*)(lds + O_VT + ((e0 + fr) * P64 + 32 * ks + 8 * fq) * 2); o[j] = __builtin_amdgcn_mfma_f32_16x16x32_bf16(ap[ks], bv, o[j], 0, 0, 0); }
#pragma unroll
          for (int ks = 0; ks < 4; ++ks) { const bf16x8 bs = *(const LAS bf16x8*)(lds + O_ST + ((e0 + fr) * P128 + 32 * ks + 8 * fq) * 2); o[j] = __builtin_amdgcn_mfma_f32_16x16x32_bf16(aq[ks], bs, o[j], 0, 0, 0); } } }
    LAS float* RS = (LAS float*)(lds + O_RS);
#pragma unroll
    for (int r = 0; r < 4; ++r) { float s = 0.f;
#pragma unroll
        for (int j = 0; j < 4; ++j) s += o[j][r] * o[j][r];
        s += __shfl_xor(s, 1); s += __shfl_xor(s, 2); s += __shfl_xor(s, 4); s += __shfl_xor(s, 8);
        if (fr == 0) RS[ch * 64 + 16 * rb + 4 * fq + r] = s; }
    __syncthreads();
#pragma unroll
    for (int r = 0; r < 4; ++r) { const int t = 16 * rb + 4 * fq + r; const float rstd = 1.0f / sqrtf((RS[t] + RS[64 + t]) * (1.0f / 128.0f) + RMS_EPS);
        bf16* yp = YB + (row0 + t) * 512 + h * 128 + 64 * ch + fr;
#pragma unroll
        for (int j = 0; j < 4; ++j) { const float y = o[j][r] * rstd * normg[64 * ch + 16 * j + fr] * bf2f(gbv[r][j]); yp[16 * j] = (bf16)(pk2(y, 0.f) & 0xffffu); } }
    __syncthreads();
}
struct P3R { float g[16]; unsigned short q[16], v[16]; v4u st[4]; unsigned short gb[4][4]; };
#define P3_LBAR() asm volatile("s_waitcnt lgkmcnt(0)\n\ts_barrier" ::: "memory")
__device__ __forceinline__ void p3_load(int unit, P3R& R, const float* G, const bf16* IB, const bf16* GB, const bf16* ST, const bf16* QB, int tid) {
    const int c = unit & 255, h = (unit >> 8) & 3, b = unit >> 10;
    const int d = tid & 127, part = tid >> 7, lane = tid & 63, wave = tid >> 6, fr = lane & 15, fq = lane >> 4, rb = wave & 3, ch = wave >> 2;
    const size_t row0 = (size_t)b * SEQ + (size_t)c * 64;
    const bf16* sp = ST + (size_t)unit * 16384;
#pragma unroll
    for (int ps = 0; ps < 4; ++ps) { const int idx = ps * NTHR + tid, e = idx >> 4, d8 = (idx & 15) * 8; R.st[ps] = *(const v4u*)(sp + e * 128 + d8); }
    const float* Gu = G + (row0 + part * 16) * 512 + h * 128 + d; const bf16* qp = QB + (row0 + part * 16) * 512 + h * 128 + d; const bf16* vp = IB + (row0 + part * 16) * 512 + h * 128 + d;
#pragma unroll
    for (int i = 0; i < 16; ++i) { R.g[i] = Gu[(size_t)i * 512]; R.q[i] = qp[(size_t)i * 512]; R.v[i] = vp[(size_t)i * 512]; }
#pragma unroll
    for (int r = 0; r < 4; ++r) { const bf16* gbp = GB + (row0 + 16 * rb + 4 * fq + r) * 512 + h * 128 + 64 * ch + fr;
#pragma unroll
        for (int j = 0; j < 4; ++j) R.gb[r][j] = gbp[16 * j]; }
}
__device__ __forceinline__ void pass3_loop(unsigned* ctr, volatile LAS unsigned* slot, const float* G, const bf16* IB, const bf16* GB, const bf16* ST, bf16* QB, const float* normg, lp lds, int tid) {
    const int d = tid & 127, part = tid >> 7, lane = tid & 63, wave = tid >> 6, fr = lane & 15, fq = lane >> 4, rb = wave & 3, ch = wave >> 2;
    if (tid == 0) { slot[0] = __hip_atomic_fetch_add(ctr, 1u, __ATOMIC_RELAXED, __HIP_MEMORY_SCOPE_AGENT); slot[1] = __hip_atomic_fetch_add(ctr, 1u, __ATOMIC_RELAXED, __HIP_MEMORY_SCOPE_AGENT); }
    __syncthreads();
    unsigned n = slot[0], n1 = slot[1];
    __syncthreads();
    P3R R;
    if (n < 2048u) p3_load((int)n, R, G, IB, GB, ST, QB, tid);
    while (n < 2048u) {
        unsigned n2 = 0u; if (tid == 0) n2 = __hip_atomic_fetch_add(ctr, 1u, __ATOMIC_RELAXED, __HIP_MEMORY_SCOPE_AGENT);
        const int unit = (int)n, c = unit & 255, h = (unit >> 8) & 3, b = unit >> 10; const size_t row0 = (size_t)b * SEQ + (size_t)c * 64;
#pragma unroll
        for (int ps = 0; ps < 4; ++ps) { const int idx = ps * NTHR + tid, e = idx >> 4, d8 = (idx & 15) * 8; *(LAS v4u*)(lds + O_ST + (e * P128 + d8) * 2) = R.st[ps]; }
        float bb[16], bmid;
        { float run = 0.f;
#pragma unroll
          for (int i = 0; i < 16; ++i) { run += R.g[i]; bb[i] = run; }
          LAS float* PT = (LAS float*)(lds + O_PT); PT[part * 128 + d] = run;
          P3_LBAR();
          const float p0 = PT[d], p1 = PT[128 + d], p2 = PT[256 + d];
          const float off = (part > 0 ? p0 : 0.f) + (part > 1 ? p1 : 0.f) + (part > 2 ? p2 : 0.f);
#pragma unroll
          for (int i = 0; i < 16; ++i) bb[i] += off;
          bmid = p0 + p1; }
        { const float emid = __expf(bmid); LAS bf16* Qp = (LAS bf16*)(lds + O_QP), *Qpp = (LAS bf16*)(lds + O_QPP), *Kp = (LAS bf16*)(lds + O_KP);
#pragma unroll
          for (int i = 0; i < 16; ++i) { const float q = bf2f(R.q[i]); const float q1 = q * __expf(bb[i] - bmid), q2 = q1 * emid, k1 = (1.0f - __expf(R.g[i])) * __expf(bmid - bb[i]);
              const int t = part * 16 + i; const unsigned w = pk2(q1, q2), w2 = pk2(k1, 0.f);
              Qp[t * P128 + d] = (bf16)(w & 0xffffu); Qpp[t * P128 + d] = (bf16)(w >> 16); Kp[t * P128 + d] = (bf16)(w2 & 0xffffu); } }
        { unsigned w[8];
#pragma unroll
          for (int i = 0; i < 8; ++i) w[i] = (unsigned)R.v[2 * i] | ((unsigned)R.v[2 * i + 1] << 16);
          LAS v4u* dst = (LAS v4u*)(lds + O_VT + (d * P64 + part * 16) * 2); dst[0] = (v4u){w[0], w[1], w[2], w[3]}; dst[1] = (v4u){w[4], w[5], w[6], w[7]}; }
        unsigned short gbv[4][4];
#pragma unroll
        for (int r = 0; r < 4; ++r)
#pragma unroll
            for (int j = 0; j < 4; ++j) gbv[r][j] = R.gb[r][j];
        P3_LBAR();
        if (n1 < 2048u) p3_load((int)n1, R, G, IB, GB, ST, QB, tid);
        { const int ti = wave >> 1; LAS bf16* Pm = (LAS bf16*)(lds + O_PM);
#pragma unroll
          for (int sj2 = 0; sj2 < 2; ++sj2) { const int sj = 2 * (wave & 1) + sj2; f32x4 acc = (f32x4){0.f, 0.f, 0.f, 0.f};
#pragma unroll
              for (int ks = 0; ks < 4; ++ks) { const bf16x8 a = *(const LAS bf16x8*)(lds + O_QP + ((16 * ti + fr) * P128 + 32 * ks + 8 * fq) * 2), bq = *(const LAS bf16x8*)(lds + O_KP + ((16 * sj + fr) * P128 + 32 * ks + 8 * fq) * 2);
                  acc = __builtin_amdgcn_mfma_f32_16x16x32_bf16(a, bq, acc, 0, 0, 0); }
#pragma unroll
              for (int r = 0; r < 4; ++r) { const int t = 16 * ti + 4 * fq + r, s = 16 * sj + fr; const float v = (s <= t) ? acc[r] : 0.f; Pm[t * P64 + s] = (bf16)(pk2(v, 0.f) & 0xffffu); } } }
        P3_LBAR();
        f32x4 o[4];
#pragma unroll
        for (int j = 0; j < 4; ++j) o[j] = (f32x4){0.f, 0.f, 0.f, 0.f};
        { bf16x8 ap[2], aq[4];
#pragma unroll
          for (int ks = 0; ks < 2; ++ks) ap[ks] = *(const LAS bf16x8*)(lds + O_PM + ((16 * rb + fr) * P64 + 32 * ks + 8 * fq) * 2);
#pragma unroll
          for (int ks = 0; ks < 4; ++ks) aq[ks] = *(const LAS bf16x8*)(lds + O_QPP + ((16 * rb + fr) * P128 + 32 * ks + 8 * fq) * 2);
#pragma unroll
          for (int j = 0; j < 4; ++j) { const int e0 = 64 * ch + 16 * j;
#pragma unroll
              for (int ks = 0; ks < 2; ++ks) { const bf16x8 bv = *(const LAS bf16x8*)(lds + O_VT + ((e0 + fr) * P64 + 32 * ks + 8 * fq) * 2); o[j] = __builtin_amdgcn_mfma_f32_16x16x32_bf16(ap[ks], bv, o[j], 0, 0, 0); }
#pragma unroll
              for (int ks = 0; ks < 4; ++ks) { const bf16x8 bs = *(const LAS bf16x8*)(lds + O_ST + ((e0 + fr) * P128 + 32 * ks + 8 * fq) * 2); o[j] = __builtin_amdgcn_mfma_f32_16x16x32_bf16(aq[ks], bs, o[j], 0, 0, 0); } } }
        LAS float* RS = (LAS float*)(lds + O_RS);
#pragma unroll
        for (int r = 0; r < 4; ++r) { float s = 0.f;
#pragma unroll
            for (int j = 0; j < 4; ++j) s += o[j][r] * o[j][r];
            s += __shfl_xor(s, 1); s += __shfl_xor(s, 2); s += __shfl_xor(s, 4); s += __shfl_xor(s, 8);
            if (fr == 0) RS[ch * 64 + 16 * rb + 4 * fq + r] = s; }
        if (tid == 0) slot[0] = n2;
        P3_LBAR();
#pragma unroll
        for (int r = 0; r < 4; ++r) { const int t = 16 * rb + 4 * fq + r; const float rstd = 1.0f / sqrtf((RS[t] + RS[64 + t]) * (1.0f / 128.0f) + RMS_EPS);
            bf16* yp = QB + (row0 + t) * 512 + h * 128 + 64 * ch + fr;
#pragma unroll
            for (int j = 0; j < 4; ++j) { const float y = o[j][r] * rstd * normg[64 * ch + 16 * j + fr] * bf2f(gbv[r][j]); yp[16 * j] = (bf16)(pk2(y, 0.f) & 0xffffu); } }
        const unsigned nn = slot[0];
        P3_LBAR();
        n = n1; n1 = nn;
    }
}
}

#ifdef DBG_NAN
__device__ __forceinline__ void dbg_scan(const void* p, size_t nbytes, bool is_bf, int stage, unsigned* word) {
    const size_t n16 = nbytes / 16; const v4u* q = (const v4u*)p; bool bad = false;
    int t_ = threadIdx.x; asm volatile("" : "+v"(t_));
    int b_ = blockIdx.x; asm volatile("" : "+s"(b_)); int g_ = gridDim.x; asm volatile("" : "+s"(g_));
    for (unsigned i = (unsigned)(b_ * NTHR + t_); i < (unsigned)n16; i += (unsigned)(g_ * NTHR)) { const v4u w = q[i];
        for (int k = 0; k < 4; ++k) { const unsigned x = w[k];
            if (is_bf) { if ((x & 0x7f80u) == 0x7f80u || (x & 0x7f800000u) == 0x7f800000u) bad = true; }
            else { if ((x & 0x7f800000u) == 0x7f800000u) bad = true; } } }
    if (bad) atomicMin(word, (unsigned)stage);
}
#define DBG(stage, ptr, bytes, isbf) do { if (l == DBG_LAYER) dbg_scan((ptr), (bytes), (isbf), (stage), (unsigned*)(args.ws + WS_DBG)); } while (0)
#else
#define DBG(stage, ptr, bytes, isbf) do {} while (0)
#endif
#define GSYNC() do { XcdBarrier b_; b_.bar = (unsigned*)(args.ws + WS_CTL); b_.x = xb_xcc_id(); b_.st = (volatile LAS unsigned*)(lds + LDS_TOTAL - 64); xcd_barrier(b_); } while (0)
#ifdef DBG_TS
#define STAMP(k) do { if (blockIdx.x == 0 && threadIdx.x == 0) ((unsigned long long*)(args.ws + WS_DBG + 4096))[(k)] = __builtin_amdgcn_s_memrealtime(); } while (0)
#else
#define STAMP(k) do {} while (0)
#endif
#ifndef REP_P1
#define REP_P1 1
#endif
#ifndef REP_P2
#define REP_P2 1
#endif
#ifndef REP_P8
#define REP_P8 1
#endif
#ifndef REP_P45
#define REP_P45 1
#endif
#ifndef REP_HG0
#define REP_HG0 0
#endif
#ifndef REP_P0
#define REP_P0 1
#endif
#ifndef REP_LN1
#define REP_LN1 0
#endif
#ifndef REP_P69
#define REP_P69 0
#endif
#ifndef REP_ATT0
#define REP_ATT0 0
#endif
#ifndef STG_P1
#define STG_P1 300
#define STG_P4B 300
#define STG_P5 300
#define STG_P6 600
#define STG_P8 300
#define STG_P9 600
#endif
#ifndef STG
#define STG 0
#endif
#define STAGGER(ticks) do { if (STG) { const unsigned long long t0_ = __builtin_amdgcn_s_memrealtime(); const unsigned long long w_ = (unsigned long long)((blockIdx.x & 3) * (ticks)); \
    while (__builtin_amdgcn_s_memrealtime() - t0_ < w_) __builtin_amdgcn_s_sleep(8); } } while (0)
struct Args { const float* in[14]; float* out; unsigned char* ws; };
#define FRESH_PTR(T, var, expr) T var = (T)(expr); asm volatile("" : "+s"(var))
#define IDS() int tid_ = threadIdx.x; asm volatile("" : "+v"(tid_)); const int tid = tid_, lane = tid & 63, wave = __builtin_amdgcn_readfirstlane(tid >> 6); const int G = gridDim.x, bx = blockIdx.x, vcu = (G % 8 == 0) ? (bx % 8) * (G / 8) + bx / 8 : bx; \
              const int gw = vcu * NWAVES + wave, NGW = G * NWAVES; (void)tid; (void)lane; (void)wave; (void)gw; (void)NGW; (void)vcu; (void)bx
__global__ void __launch_bounds__(NTHR, 2) mega_fwd(Args args) {
    extern __shared__ __attribute__((aligned(16))) unsigned char lds_raw[];
    cg::grid_group grid = cg::this_grid();
    const lp lds = (lp)lds_raw;
    volatile LAS unsigned* xbst = (volatile LAS unsigned*)(lds + LDS_TOTAL - 64);
    if (threadIdx.x < 16) xbst[threadIdx.x] = 0u;
    __syncthreads();
    (void)xcd_barrier_post((unsigned*)(args.ws + WS_CTL), xbst);
    grid.sync();
    int tsn = 1; (void)tsn; STAMP(0);

#ifdef DBG_NAN
    if (blockIdx.x == 0 && threadIdx.x == 0) *(unsigned*)(args.ws + WS_DBG) = 990u;
    GSYNC(); STAMP(tsn); ++tsn;
#endif
    for (int rep_ = 0; rep_ < REP_P0; ++rep_) { IDS();
      Ptrs P;
      P.x = args.in[0]; P.w_in = args.in[1]; P.b_fgate = args.in[2]; P.lb_logits = args.in[3]; P.norm_g = args.in[4]; P.w_pa = args.in[5]; P.w_pb = args.in[6]; P.w_o = args.in[7];
      P.ln1_g = args.in[8]; P.ln1_b = args.in[9]; P.w_ff_in = args.in[10]; P.w_ff_out = args.in[11]; P.ln2_g = args.in[12]; P.ln2_b = args.in[13]; P.out = args.out; P.ws = args.ws;
      weight_items(P, (LAS float*)(lds + wave * 16384), gw, NGW, lane);
      __syncthreads();
      stage_wfa(P.w_in, (LAS float*)lds, tid);
      __syncthreads();
      row_pass<false, false, true, true>(P.x, nullptr, (bf16*)(P.ws + WS_XN), nullptr, nullptr, (float*)(P.ws + WS_LF), (const LAS float*)lds, P.b_fgate, gw, NGW, lane); }
    GSYNC(); STAMP(tsn); ++tsn;
    { const int l = 0; DBG(10, args.ws + WS_XN, (size_t)64 * MiB, true); DBG(10, args.ws + WS_LF, (size_t)1 * MiB, false); }

#pragma unroll 1
    for (int l = 0; l < DEPTH; ++l) {
        for (int rep_ = 0; rep_ < REP_P1; ++rep_) {
        { IDS(); FRESH_PTR(unsigned char*, ws, args.ws); FRESH_PTR(const float*, lbl, args.in[3]);
          pg8::Gemm g{(const bf16*)(ws + WS_XN), (const bf16*)(ws + WS_W + (size_t)l * WL_STRIDE + WL_IN), M, NP1, D}; pg8::StaticOrder S; S.init(M, NP1, G, bx);
          pg8::EpiInProj E{(bf16*)(ws + WS_QA), (bf16*)(ws + WS_QB), (bf16*)(ws + WS_KA), (bf16*)(ws + WS_VA), (float*)(ws + WS_G), (bf16*)(ws + WS_IB), (bf16*)(ws + WS_GB), lbl, l, attn_body::C2};
          STAGGER(STG_P1); pg8::gemm_phase<pg8::EpiInProj, pg8::StaticOrder, true, true>(lds, g, S, E); }
        }
        GSYNC(); STAMP(tsn); ++tsn;
        DBG(20, args.ws + WS_QA, (size_t)64 * MiB, true); DBG(30, args.ws + WS_KA, (size_t)64 * MiB, true); DBG(40, args.ws + WS_G, (size_t)64 * MiB, false); DBG(50, args.ws + WS_IB, (size_t)64 * MiB, true);
        for (int rep_ = 0; rep_ < REP_P2; ++rep_) {
        { IDS(); FRESH_PTR(unsigned char*, ws, args.ws);
          hg::pass1_loop(vcu, G, (const float*)(ws + WS_G), (const bf16*)(ws + WS_IB), (bf16*)(ws + WS_ST), (float*)(ws + WS_DEC), lds, tid);
          __syncthreads();
          for (int u = vcu; u < 16; u += G) fcumsum_unit(u, (const float*)(ws + WS_LF), (float*)(ws + WS_F), lds, tid);
          for (int u = vcu; u < 256; u += G) norm_unit(u, (const bf16*)(ws + WS_QA), (const bf16*)(ws + WS_KA), (unsigned*)(ws + WS_CTL + CTL_NORM) + l * 32, tid); }
        }
        GSYNC(); STAMP(tsn); ++tsn;
        DBG(60, args.ws + WS_ST, (size_t)64 * MiB, true); DBG(61, args.ws + WS_DEC, (size_t)1 * MiB, false); DBG(70, args.ws + WS_F, (size_t)1 * MiB, false);
        { IDS(); FRESH_PTR(unsigned char*, ws, args.ws);
          #if REP_HG0
          if (l == 0) { FRESH_PTR(float*, outp, args.out); hg::pass2_scan((const bf16*)(ws + WS_ST), (bf16*)outp, (const float*)(ws + WS_DEC), vcu * NTHR + tid, G * NTHR); }
#endif
          hg::pass2_scan((const bf16*)(ws + WS_ST), (bf16*)(ws + WS_ST), (const float*)(ws + WS_DEC), vcu * NTHR + tid, G * NTHR); }
        GSYNC(); STAMP(tsn); ++tsn;
        DBG(80, args.ws + WS_ST, (size_t)64 * MiB, true);
        { FRESH_PTR(unsigned char*, ws, args.ws);
          const attn_body::AttnTensors AT{(const attn_body::bf16*)(ws + WS_QA), (const attn_body::bf16*)(ws + WS_KA), (const attn_body::bf16*)(ws + WS_VA), (attn_body::bf16*)(ws + WS_QA), (const float*)(ws + WS_F),
                                          (const unsigned*)(ws + WS_CTL + CTL_NORM) + l * 32};
          const attn_body::DynOrder S{(unsigned*)(ws + WS_CTL + CTL_QCTR) + l * 64, (volatile LAS unsigned*)(lds + attn_body::LDS_BYTES + 32)};
          attn_body::attn_phase<attn_body::DynOrder>((char*)lds_raw, AT, S); }
        { IDS(); FRESH_PTR(unsigned char*, ws, args.ws); FRESH_PTR(const float*, ng, args.in[4]);
          volatile LAS unsigned* slot = (volatile LAS unsigned*)(lds + attn_body::LDS_BYTES + 32); unsigned* ctr = (unsigned*)(ws + WS_CTL + CTL_PCTR) + l * 64;
          __syncthreads();
          hg::pass3_loop(ctr, slot, (const float*)(ws + WS_G), (const bf16*)(ws + WS_IB), (const bf16*)(ws + WS_GB), (const bf16*)(ws + WS_ST), (bf16*)(ws + WS_QB), ng + l * 128, lds, tid); }
        GSYNC(); STAMP(tsn); ++tsn;
        DBG(90, args.ws + WS_QA, (size_t)64 * MiB, true);
        for (int rep_ = 0; rep_ < REP_P45; ++rep_) {
        { IDS(); FRESH_PTR(unsigned char*, ws, args.ws);
          pg8::Gemm g{(const bf16*)(ws + WS_XN), (const bf16*)(ws + WS_W + (size_t)l * WL_STRIDE + WL_G), M, NG, D}; pg8::StaticOrder S; S.init(M, NG, G, bx);
          pg8::EpiGates E{(bf16*)(ws + WS_GATES)};
          STAGGER(STG_P4B); pg8::gemm_phase<pg8::EpiGates, pg8::StaticOrder, true, true>(lds, g, S, E); }
        }
        GSYNC(); STAMP(tsn); ++tsn;
        DBG(100, args.ws + WS_GATES, (size_t)128 * MiB, true);
        for (int rep_ = 0; rep_ < REP_P45; ++rep_) {
        { IDS(); FRESH_PTR(unsigned char*, ws, args.ws);
          { pg8::Gemm g{(const bf16*)(ws + WS_QA), (const bf16*)(ws + WS_W + (size_t)l * WL_STRIDE + WL_M), M, D, 512}; pg8::StaticOrder S; S.init(M, D, G, bx);
            pg8::EpiMerge<0> E{(const bf16*)(ws + WS_GATES), (bf16*)(ws + WS_MERGED)};
            STAGGER(STG_P5); pg8::gemm_phase<pg8::EpiMerge<0>, pg8::StaticOrder, true, true>(lds, g, S, E); }
          asm volatile("s_waitcnt vmcnt(0)" ::: "memory"); __syncthreads();
          { pg8::Gemm g{(const bf16*)(ws + WS_QB), (const bf16*)(ws + WS_W + (size_t)l * WL_STRIDE + WL_M + MiB), M, D, 512}; pg8::StaticOrder S; S.init(M, D, G, bx);
            pg8::EpiMerge<1> E{(const bf16*)(ws + WS_GATES), (bf16*)(ws + WS_MERGED)};
            pg8::gemm_phase<pg8::EpiMerge<1>, pg8::StaticOrder, true, true>(lds, g, S, E); } }
        }
        GSYNC(); STAMP(tsn); ++tsn;
        DBG(110, args.ws + WS_MERGED, (size_t)64 * MiB, true);
        { IDS(); FRESH_PTR(unsigned char*, ws, args.ws); FRESH_PTR(const float*, xin, args.in[0]); FRESH_PTR(float*, outp, args.out); const float* xres = (l == 0) ? xin : (const float*)outp;
          pg8::Gemm g{(const bf16*)(ws + WS_MERGED), (const bf16*)(ws + WS_W + (size_t)l * WL_STRIDE + WL_O), M, D, D}; pg8::StaticOrder S; S.init(M, D, G, bx);
          FRESH_PTR(const float*, g2, args.in[12]); FRESH_PTR(const float*, b2, args.in[13]);
#if REP_P69
          { pg8::EpiResid E0{xres, (float*)(ws + WS_IB), ALPHA, (l == 0) ? (const float*)nullptr : (const float*)(ws + WS_CTL + CTL_STATS + 262144), g2 + (l - 1) * D, b2 + (l - 1) * D};
            pg8::gemm_phase<pg8::EpiResid, pg8::StaticOrder, true, true>(lds, g, S, E0); }
#endif
          pg8::EpiResid E{xres, outp, ALPHA, (l == 0) ? (const float*)nullptr : (const float*)(ws + WS_CTL + CTL_STATS + 262144), g2 + (l - 1) * D, b2 + (l - 1) * D};
          STAGGER(STG_P6); pg8::gemm_phase<pg8::EpiResid, pg8::StaticOrder, true, true>(lds, g, S, E); }
        GSYNC(); STAMP(tsn); ++tsn;
        DBG(120, args.out, (size_t)128 * MiB, false);
        { IDS(); FRESH_PTR(unsigned char*, ws, args.ws); FRESH_PTR(float*, outp, args.out); FRESH_PTR(const float*, gm, args.in[8]); FRESH_PTR(const float*, bt, args.in[9]);
#if REP_LN1
          row_pass<true, true, true, false>(outp, (float*)(ws + WS_GATES), (bf16*)(ws + WS_ST), gm + l * D, bt + l * D, nullptr, nullptr, nullptr, gw, NGW, lane);
#endif
          row_pass<true, false, true, false>(outp, nullptr, (bf16*)(ws + WS_XN), gm + l * D, bt + l * D, nullptr, nullptr, nullptr, gw, NGW, lane, (float*)(ws + WS_CTL + CTL_STATS + (size_t)l * 524288)); }
        GSYNC(); STAMP(tsn); ++tsn;
        DBG(130, args.ws + WS_XN, (size_t)64 * MiB, true);
        for (int rep_ = 0; rep_ < REP_P8; ++rep_) {
        { IDS(); FRESH_PTR(unsigned char*, ws, args.ws);
          pg8::Gemm g{(const bf16*)(ws + WS_XN), (const bf16*)(ws + WS_W + (size_t)l * WL_STRIDE + WL_F1), M, NF1, D}; pg8::StaticOrder S; S.init(M, NF1, G, bx);
          pg8::EpiSwiGLU E{(bf16*)(ws + WS_H)};
          STAGGER(STG_P8); pg8::gemm_phase<pg8::EpiSwiGLU, pg8::StaticOrder, true, true>(lds, g, S, E); }
        }
        GSYNC(); STAMP(tsn); ++tsn;
        DBG(140, args.ws + WS_H, (size_t)176 * MiB, true);
        { IDS(); FRESH_PTR(unsigned char*, ws, args.ws); FRESH_PTR(float*, outp, args.out);
          pg8::Gemm g{(const bf16*)(ws + WS_H), (const bf16*)(ws + WS_W + (size_t)l * WL_STRIDE + WL_F2), M, D, FFH}; pg8::StaticOrder S; S.init(M, D, G, bx);
          FRESH_PTR(const float*, g1, args.in[8]); FRESH_PTR(const float*, b1, args.in[9]);
#if REP_P69
          { pg8::EpiResid E0{outp, (float*)(ws + WS_IB), ALPHA, (const float*)(ws + WS_CTL + CTL_STATS + (size_t)l * 524288), g1 + l * D, b1 + l * D};
            pg8::gemm_phase<pg8::EpiResid, pg8::StaticOrder, true, true>(lds, g, S, E0); }
#endif
          pg8::EpiResid E{outp, outp, ALPHA, (const float*)(ws + WS_CTL + CTL_STATS + (size_t)l * 524288), g1 + l * D, b1 + l * D};
          STAGGER(STG_P9); pg8::gemm_phase<pg8::EpiResid, pg8::StaticOrder, true, true>(lds, g, S, E); }
        GSYNC(); STAMP(tsn); ++tsn;
        DBG(150, args.out, (size_t)128 * MiB, false);
        { IDS(); FRESH_PTR(unsigned char*, ws, args.ws); FRESH_PTR(float*, outp, args.out); FRESH_PTR(const float*, gm, args.in[12]); FRESH_PTR(const float*, bt, args.in[13]);
          if (l + 1 < DEPTH) {
              FRESH_PTR(const float*, win, args.in[1]); FRESH_PTR(const float*, bfg, args.in[2]);
              stage_wfa(win + (size_t)(l + 1) * D * NIN, (LAS float*)lds, tid);
              __syncthreads();
              row_pass<true, false, true, true>(outp, nullptr, (bf16*)(ws + WS_XN), gm + l * D, bt + l * D, (float*)(ws + WS_LF), (const LAS float*)lds, bfg + (l + 1) * 8, gw, NGW, lane, (float*)(ws + WS_CTL + CTL_STATS + 262144));
          } else {
              row_pass<true, true, false, false>(outp, outp, nullptr, gm + l * D, bt + l * D, nullptr, nullptr, nullptr, gw, NGW, lane);
          } }
        if (l + 1 < DEPTH) GSYNC(); STAMP(tsn); ++tsn;
    }
#ifdef DBG_TS
    GSYNC(); STAMP(tsn);
    { const volatile unsigned long long* T = (const volatile unsigned long long*)(args.ws + WS_DBG + 4096);
      float sum[2] = {0.f, 0.f};
      if (blockIdx.x == 0) {
          for (int k = 0; k < 23; ++k) { const float us = (float)(T[k + 1] - T[k]) * 0.01f; const int j = (k == 0) ? -1 : (k - 1) % 11;
              for (int w = 0; w < 2; ++w) { const unsigned mask = (w == 0) ? DBG_TS_A : DBG_TS_B; const bool in = (j < 0) ? ((mask >> 15) & 1u) : ((mask >> j) & 1u); if (in) sum[w] += us; } }
          for (int i = threadIdx.x; i < (1 << 20); i += NTHR) args.out[1024 + i] = sum[1];
          __syncthreads();
          if (threadIdx.x == 0) args.out[0] = 100.0f * sum[0];
      } }
#endif
#ifdef DBG_NAN
    GSYNC();
    if (blockIdx.x == 0 && threadIdx.x == 0) args.out[0] = 100.0f * (float)*(volatile unsigned*)(args.ws + WS_DBG);
#endif
}

extern "C" void kernel_launch(void* const* d_in, const int* in_sizes, int n_in, void* d_out, int out_size, void* d_ws, size_t ws_size, hipStream_t stream) {
    static int grid = 0;
    if (grid == 0) {
        if (n_in != 14 || in_sizes[0] != M * D || out_size != M * D || ws_size < WS_END) { fprintf(stderr, "kernel_launch: unexpected shapes (n_in %d, in0 %d, out %d, ws %zu)\n", n_in, n_in > 0 ? in_sizes[0] : -1, out_size, ws_size); grid = -1; return; }
        int dev = 0, cus = 0, per_cu = 0;
        if (hipGetDevice(&dev) != hipSuccess || hipDeviceGetAttribute(&cus, hipDeviceAttributeMultiprocessorCount, dev) != hipSuccess) { grid = -1; return; }
        if (hipFuncSetAttribute((const void*)mega_fwd, hipFuncAttributeMaxDynamicSharedMemorySize, LDS_TOTAL) != hipSuccess) { fprintf(stderr, "kernel_launch: hipFuncSetAttribute failed\n"); grid = -1; return; }
        if (hipOccupancyMaxActiveBlocksPerMultiprocessor(&per_cu, (const void*)mega_fwd, NTHR, LDS_TOTAL) != hipSuccess || per_cu < 1) { fprintf(stderr, "kernel_launch: occupancy query says %d\n", per_cu); per_cu = 1; }
        (void)hipGetLastError();
        grid = cus * per_cu;
    }
    if (grid < 0) return;
    if (hipMemsetAsync((char*)d_ws + WS_CTL, 0, 65536, stream) != hipSuccess) { fprintf(stderr, "kernel_launch: hipMemsetAsync failed\n"); return; }
    Args a{};
    for (int i = 0; i < 14; ++i) a.in[i] = (const float*)d_in[i];
    a.out = (float*)d_out; a.ws = (unsigned char*)d_ws;
    void* kargs[] = {&a};
    hipError_t e = hipLaunchCooperativeKernel((const void*)mega_fwd, dim3(grid), dim3(NTHR), kargs, LDS_TOTAL, stream);
    if (e != hipSuccess) fprintf(stderr, "kernel_launch: cooperative launch failed: %s (grid %d)\n", hipGetErrorString(e), grid);
}
```

```cpp
#include <hip/hip_runtime.h>
#include <cstdio>
#include <cstdint>
namespace pg8 {
#define PG8_LAS __attribute__((address_space(3)))
typedef unsigned short bf16_t;
typedef short bf16x8 __attribute__((ext_vector_type(8)));
typedef float f32x4 __attribute__((ext_vector_type(4)));
typedef unsigned u32x4 __attribute__((ext_vector_type(4)));
constexpr int BM = 256, BK = 64, HALF = 128, HTB = HALF * BK * 2  , STAGE_BYTES = 8 * HTB, NXCD = 8, WGM = 8;

__host__ __device__ __forceinline__ int lds_byte(int r, int c) { const int st = (r >> 4) * 2 + (c >> 5), rr = r & 15, cc = c & 31, ob = rr * 64 + cc * 2; return st * 1024 + (ob ^ (((ob >> 9) & 1) << 5)); }
__host__ __device__ __forceinline__ void stage_rc(int b, int& R, int& C) { const int st = b / 1024, sb = b % 1024, swz = sb ^ (((sb >> 9) & 1) << 5); R = (st >> 1) * 16 + swz / 64; C = (st & 1) * 32 + (swz % 64) / 2; }
__host__ __device__ __forceinline__ int perm32(int rho) { const int n = rho >> 4, i = rho & 15; return 8 * (i >> 2) + 4 * n + (i & 3); }

struct Unit { int pm, pn; };
struct Gemm { const bf16_t* A; const bf16_t* Bt; int M, N, K; };

struct StaticOrder {
    int nM, nN, nwg, G, c;
    __host__ __device__ void init(int M, int N, int G_, int c_) { nM = M / BM; nN = N / BM; nwg = nM * nN; G = G_; c = c_; }
    __host__ __device__ bool next(int i, Unit& u) const {
        const long L = (long)i * G + c; if (L >= nwg) return false;
        int wgid = (int)L; { const int q = nwg / NXCD, r = nwg % NXCD, xcd = wgid % NXCD, off = wgid / NXCD; wgid = (xcd < r ? xcd * (q + 1) : r * (q + 1) + (xcd - r) * q) + off; }
        const int nig = WGM * nN, gid = wgid / nig, fm = gid * WGM, gsz = (nM - fm) < WGM ? (nM - fm) : WGM;
        u.pm = fm + ((wgid % nig) % gsz); u.pn = (wgid % nig) / gsz; return true;
    }
    __device__ __forceinline__ void a_ready(const Unit&) const {}
    __device__ __forceinline__ void done(const Unit&) const {}
};

typedef float f32x2c_t __attribute__((ext_vector_type(2))); typedef __bf16 bf16x2c_t __attribute__((ext_vector_type(2)));
__device__ __forceinline__ unsigned cvt_pk_bf16(float lo, float hi) { f32x2c_t v = {lo, hi}; bf16x2c_t b = __builtin_convertvector(v, bf16x2c_t); return __builtin_bit_cast(unsigned, b); }
typedef float f32x2 __attribute__((ext_vector_type(2)));
__device__ __forceinline__ f32x2 gelu_pk(f32x2 v) {
    const f32x2 av = __builtin_elementwise_abs(v), d = av * 0.2316418882f + 1.0f;
    f32x2 t; t.x = __builtin_amdgcn_rcpf(d.x); t.y = __builtin_amdgcn_rcpf(d.y);
    f32x2 q = t * 0.5307027145f + (-0.7265760135f); q = q * t + 0.7107068705f; q = q * t + (-0.142248368f); q = q * t + 0.127414796f; q = q * t;
    const f32x2 s = (v * v) * (-0.72134752044f);
    f32x2 e; e.x = __builtin_amdgcn_exp2f(s.x); e.y = __builtin_amdgcn_exp2f(s.y);
    const f32x2 m = v * (q * e), r = v - m;
    f32x2 o; o.x = v.x < 0.f ? m.x : r.x; o.y = v.y < 0.f ? m.y : r.y; return o;
}

template <int ACT  > struct EpiBf16 {
    static constexpr bool PERM = true, AFTER_DRAIN = false; static_assert(ACT == 0 || ACT == 1, "EpiBf16: ACT is 0 (none) or 1 (gelu_pk)");
    bf16_t* O; int ldc; const float* bias; int split_cols; size_t split_stride; float scale0;
    __device__ __forceinline__ void operator()(const f32x4 (&acc)[2][2][4][2], const Unit& u, int wr, int wc, int fr, int fq) const {
        const int row0 = u.pm * BM + wr * 64 + fr; int colt = u.pn * BM; bf16_t* base = O;
        float sc = 1.f; if (split_cols) { const int t = colt / split_cols; base += (size_t)t * split_stride; colt -= t * split_cols; if (t == 0) sc = scale0; }
        const int col0 = colt + wc * 32 + 8 * fq, bcol0 = u.pn * BM + wc * 32 + 8 * fq;
        f32x4 bv[2][2];
#pragma unroll
        for (int bj = 0; bj < 2; ++bj)
#pragma unroll
            for (int n = 0; n < 2; ++n) bv[bj][n] = bias ? *(const f32x4*)(bias + bcol0 + bj * HALF + 4 * n) : (f32x4){0.f, 0.f, 0.f, 0.f};
#pragma unroll
        for (int ai = 0; ai < 2; ++ai)
#pragma unroll
            for (int m = 0; m < 4; ++m) { bf16_t* rowp = base + (size_t)(row0 + ai * HALF + m * 16) * ldc + col0;
#pragma unroll
                for (int bj = 0; bj < 2; ++bj) { f32x4 v0 = acc[ai][bj][m][0] + bv[bj][0], v1 = acc[ai][bj][m][1] + bv[bj][1];
                    if (ACT == 1) { f32x2 a = gelu_pk((f32x2){v0[0], v0[1]}), b = gelu_pk((f32x2){v0[2], v0[3]}), c = gelu_pk((f32x2){v1[0], v1[1]}), d = gelu_pk((f32x2){v1[2], v1[3]});
                        v0 = (f32x4){a.x, a.y, b.x, b.y}; v1 = (f32x4){c.x, c.y, d.x, d.y}; }
                    v0 = v0 * sc; v1 = v1 * sc; u32x4 w; w.x = cvt_pk_bf16(v0[0], v0[1]); w.y = cvt_pk_bf16(v0[2], v0[3]); w.z = cvt_pk_bf16(v1[0], v1[1]); w.w = cvt_pk_bf16(v1[2], v1[3]);
                    *(u32x4*)(rowp + bj * HALF) = w; } }
    }
};

struct PanelStats {
    unsigned* xbuf;
    unsigned* cnt;
    unsigned* tmo;
    int ntn; float eps;
    unsigned code;
    __device__ __forceinline__ bool run(const f32x4 (&v)[2][2][4][2], const Unit& u, int wr, int wc, int fr, int fq, PG8_LAS unsigned char* lds, int wid, int lane) const {
        typedef float f32x2v __attribute__((ext_vector_type(2)));
        PG8_LAS f32x2v* P = (PG8_LAS f32x2v*)lds;
        PG8_LAS f32x2v* S = (PG8_LAS f32x2v*)(lds + 8192);
        PG8_LAS unsigned* flag = (PG8_LAS unsigned*)(lds + 8192 + 2048);
#pragma unroll
        for (int ai = 0; ai < 2; ++ai)
#pragma unroll
            for (int m = 0; m < 4; ++m) {
                float s = 0.f;
#pragma unroll
                for (int bj = 0; bj < 2; ++bj)
#pragma unroll
                    for (int n = 0; n < 2; ++n) { const f32x4 x = v[ai][bj][m][n]; s += (x[0] + x[1]) + (x[2] + x[3]); }
                s += __shfl_xor(s, 16); s += __shfl_xor(s, 32);
                const float mw = s * (1.0f / 64.0f); float q = 0.f;
#pragma unroll
                for (int bj = 0; bj < 2; ++bj)
#pragma unroll
                    for (int n = 0; n < 2; ++n) { const f32x4 d = v[ai][bj][m][n] - mw; q += (d[0] * d[0] + d[1] * d[1]) + (d[2] * d[2] + d[3] * d[3]); }
                q += __shfl_xor(q, 16); q += __shfl_xor(q, 32);
                if (fq == 0) P[(ai * HALF + wr * 64 + m * 16 + fr) * 4 + wc] = (f32x2v){mw, q};
            }
        asm volatile("s_waitcnt lgkmcnt(0)" ::: "memory"); __builtin_amdgcn_s_barrier(); asm volatile("" ::: "memory");
#if defined(BROKEN_EXCHANGE_NO_WAIT)
#warning BROKEN CONTROL BUILD: the row-statistics exchange does not wait; results are wrong by design
        if (blockIdx.x >= 64) { const long long t0_ = clock64(); while (clock64() - t0_ < 60000) __builtin_amdgcn_s_sleep(8); }
#endif
        const int row = wid * 32 + (lane & 31);
        if (lane < 32) {
            const f32x2v a = P[row * 4 + 0], b = P[row * 4 + 1], c = P[row * 4 + 2], d = P[row * 4 + 3];
            const float mt = (a.x + b.x + c.x + d.x) * 0.25f;
            const float da = a.x - mt, db = b.x - mt, dc = c.x - mt, dd = d.x - mt;
            const float m2 = (a.y + b.y) + (c.y + d.y) + 64.0f * ((da * da + db * db) + (dc * dc + dd * dd));
            unsigned long long* slot = (unsigned long long*)xbuf + ((size_t)(u.pm * BM + row) * 4 + u.pn);
            __hip_atomic_store(slot, ((unsigned long long)__float_as_uint(m2) << 32) | __float_as_uint(mt), __ATOMIC_RELAXED, __HIP_MEMORY_SCOPE_AGENT);
        }
        asm volatile("s_waitcnt vmcnt(0)" ::: "memory");
        if (lane == 0) __hip_atomic_fetch_add(cnt + 64 * u.pm, 1u, __ATOMIC_RELAXED, __HIP_MEMORY_SCOPE_AGENT);
        if (wid == 0) {
            bool dead = false; const unsigned long long t0 = __builtin_amdgcn_s_memrealtime(); const unsigned want = 8u * (unsigned)ntn;
            for (;;) {
#if defined(BROKEN_EXCHANGE_NO_WAIT)
                break;
#endif
                if ((unsigned)__builtin_amdgcn_readfirstlane(__hip_atomic_load(cnt + 64 * u.pm, __ATOMIC_RELAXED, __HIP_MEMORY_SCOPE_AGENT)) >= want) break;
                if (__builtin_amdgcn_s_memrealtime() - t0 > 2000000ull) {
                    if (lane == 0) { unsigned expect = 0u; __hip_atomic_compare_exchange_strong(tmo + 1, &expect, code | (unsigned)(u.pm & 0xff), __ATOMIC_RELAXED, __ATOMIC_RELAXED, __HIP_MEMORY_SCOPE_AGENT);
                                     __hip_atomic_store(tmo, 1u, __ATOMIC_RELAXED, __HIP_MEMORY_SCOPE_AGENT); }
                    dead = true; break; }
                __builtin_amdgcn_s_sleep(2);
            }
            __builtin_amdgcn_fence(__ATOMIC_ACQUIRE, "agent");
            if (lane == 0) flag[0] = dead ? 1u : 0u;
        }
        asm volatile("s_waitcnt vmcnt(0) lgkmcnt(0)" ::: "memory"); __builtin_amdgcn_s_barrier(); asm volatile("" ::: "memory");
        const bool bad = flag[0] != 0u;
        if (lane < 32) {
            const unsigned long long* slot = (const unsigned long long*)xbuf + (size_t)(u.pm * BM + row) * 4; float mt[4], m2[4]; float ms = 0.f;
#pragma unroll
            for (int t = 0; t < 4; ++t) { if (t < ntn) { const unsigned long long w = __hip_atomic_load(slot + t, __ATOMIC_RELAXED, __HIP_MEMORY_SCOPE_AGENT); mt[t] = __uint_as_float((unsigned)w); m2[t] = __uint_as_float((unsigned)(w >> 32)); } else { mt[t] = 0.f; m2[t] = 0.f; } ms += mt[t]; }
            const float mean = ms / (float)ntn; float q = 0.f;
#pragma unroll
            for (int t = 0; t < 4; ++t) if (t < ntn) { const float dm = mt[t] - mean; q += m2[t] + 256.0f * dm * dm; }
            S[row] = (f32x2v){mean, 1.0f / sqrtf(q / (256.0f * (float)ntn) + eps)};
        }
        asm volatile("s_waitcnt lgkmcnt(0)" ::: "memory"); __builtin_amdgcn_s_barrier(); asm volatile("" ::: "memory");
        return bad;
    }
};
struct EpiLnRes {
    static constexpr bool PERM = false, AFTER_DRAIN = true;
    const float* base; float* out; int ldc; const float* bias; PanelStats st; unsigned poison;
    __device__ __forceinline__ void fused(f32x4 (&acc)[2][2][4][2], const Unit& u, int wr, int wc, int fr, int fq, PG8_LAS unsigned char* lds, int wid, int lane) const {
        typedef float f32x2v __attribute__((ext_vector_type(2)));
        const PG8_LAS f32x2v* S = (const PG8_LAS f32x2v*)(lds + 8192);
        const int col0 = u.pn * BM + wc * 32 + 4 * fq;
#pragma unroll
        for (int bj = 0; bj < 2; ++bj)
#pragma unroll
            for (int n = 0; n < 2; ++n) { const f32x4 bv = bias ? *(const f32x4*)(bias + col0 + bj * HALF + n * 16) : (f32x4){0.f, 0.f, 0.f, 0.f};
#pragma unroll
                for (int ai = 0; ai < 2; ++ai)
#pragma unroll
                    for (int m = 0; m < 4; ++m) acc[ai][bj][m][n] += bv; }
        f32x4 pre[4][2][2];
#pragma unroll
        for (int m = 0; m < 4; ++m) { const size_t off = (size_t)(u.pm * BM + wr * 64 + m * 16 + fr) * ldc + col0;
#pragma unroll
            for (int bj = 0; bj < 2; ++bj)
#pragma unroll
                for (int n = 0; n < 2; ++n) pre[m][bj][n] = *(const f32x4*)(base + off + bj * HALF + n * 16); }
        const bool bad = st.run(acc, u, wr, wc, fr, fq, lds, wid, lane) || poison != 0u;
        const float qnan = __builtin_nanf("");
#pragma unroll
        for (int ai = 0; ai < 2; ++ai)
#pragma unroll
            for (int m = 0; m < 4; ++m) { const int r = ai * HALF + wr * 64 + m * 16 + fr; const f32x2v sr = S[r]; const size_t off = (size_t)(u.pm * BM + r) * ldc + col0;
#pragma unroll
                for (int bj = 0; bj < 2; ++bj)
#pragma unroll
                    for (int n = 0; n < 2; ++n) { const f32x4 bs = ai == 0 ? pre[m][bj][n] : *(const f32x4*)(base + off + bj * HALF + n * 16); f32x4 o = bs + (acc[ai][bj][m][n] - sr.x) * sr.y;
                        if (bad) o = (f32x4){qnan, qnan, qnan, qnan}; *(f32x4*)(out + off + bj * HALF + n * 16) = o; }
                if (m & 1) asm volatile("" ::: "memory"); }
    }
};
struct EpiLnResLn {
    static constexpr bool PERM = false, AFTER_DRAIN = true;
    const float* base; float* out; bf16_t* xn; int ldc; const float* bias; PanelStats st1, st2; unsigned poison;
    __device__ __forceinline__ void fused(f32x4 (&acc)[2][2][4][2], const Unit& u, int wr, int wc, int fr, int fq, PG8_LAS unsigned char* lds, int wid, int lane) const {
        typedef float f32x2v __attribute__((ext_vector_type(2))); typedef unsigned u32x2v __attribute__((ext_vector_type(2)));
        const PG8_LAS f32x2v* S = (const PG8_LAS f32x2v*)(lds + 8192);
        const int col0 = u.pn * BM + wc * 32 + 4 * fq;
#pragma unroll
        for (int bj = 0; bj < 2; ++bj)
#pragma unroll
            for (int n = 0; n < 2; ++n) { const f32x4 bv = bias ? *(const f32x4*)(bias + col0 + bj * HALF + n * 16) : (f32x4){0.f, 0.f, 0.f, 0.f};
#pragma unroll
                for (int ai = 0; ai < 2; ++ai)
#pragma unroll
                    for (int m = 0; m < 4; ++m) acc[ai][bj][m][n] += bv; }
        bool bad = st1.run(acc, u, wr, wc, fr, fq, lds, wid, lane) || poison != 0u;
        const float qnan = __builtin_nanf("");
#pragma unroll
        for (int ai = 0; ai < 2; ++ai)
#pragma unroll
            for (int m = 0; m < 4; ++m) { const int r = ai * HALF + wr * 64 + m * 16 + fr; const f32x2v sr = S[r]; const size_t off = (size_t)(u.pm * BM + r) * ldc + col0;
#pragma unroll
                for (int bj = 0; bj < 2; ++bj)
#pragma unroll
                    for (int n = 0; n < 2; ++n) { const f32x4 bs = *(const f32x4*)(base + off + bj * HALF + n * 16); acc[ai][bj][m][n] = bs + (acc[ai][bj][m][n] - sr.x) * sr.y; }
                asm volatile("" : "+v"(acc[ai][0][m][0]), "+v"(acc[ai][0][m][1]), "+v"(acc[ai][1][m][0]), "+v"(acc[ai][1][m][1]));
                if (m & 1) asm volatile("" ::: "memory"); }
        const bool bad1 = bad;
        bad = st2.run(acc, u, wr, wc, fr, fq, lds, wid, lane) || bad;
#pragma unroll
        for (int ai = 0; ai < 2; ++ai)
#pragma unroll
            for (int m = 0; m < 4; ++m) { const int r = ai * HALF + wr * 64 + m * 16 + fr; const f32x2v sr = S[r]; const size_t off = (size_t)(u.pm * BM + r) * ldc + col0;
#pragma unroll
                for (int bj = 0; bj < 2; ++bj)
#pragma unroll
                    for (int n = 0; n < 2; ++n) { const f32x4 x1 = acc[ai][bj][m][n]; *(f32x4*)(out + off + bj * HALF + n * 16) = bad1 ? (f32x4){qnan, qnan, qnan, qnan} : x1;
                        const f32x4 o = (x1 - sr.x) * sr.y; u32x2v w; w.x = cvt_pk_bf16(o[0], o[1]); w.y = cvt_pk_bf16(o[2], o[3]);
                        if (bad) { w.x = 0x7fc07fc0u; w.y = 0x7fc07fc0u; } *(u32x2v*)(xn + off + bj * HALF + n * 16) = w; }
                asm volatile("" ::: "memory"); }
    }
};

template <class Epi, class Sched, bool ALIGN_EPI = false, bool SP2 = false>
__device__ __forceinline__ void gemm_phase(PG8_LAS unsigned char* lds, const Gemm g, const Sched& S, const Epi& E) {
    int tid_ = threadIdx.x; asm volatile("" : "+v"(tid_));
    const int tid = tid_, wid = __builtin_amdgcn_readfirstlane(tid >> 6), lane = tid & 63, wr = wid >> 2, wc = wid & 3, fr = lane & 15, fq = lane >> 4;
    const int K = g.K, nt = K / BK;
    unsigned voffA[2], voffB[2];
#pragma unroll
    for (int i = 0; i < 2; ++i) { int R, C; stage_rc(tid * 16 + i * 8192, R, C); const int Rb = Epi::PERM ? ((R & ~31) + perm32(R & 31)) : R;
        voffA[i] = (unsigned)(R * K + C) * 2u; voffB[i] = (unsigned)(Rb * K + C) * 2u; }
    const size_t kstep = (size_t)(BK * 2);
    const size_t hstep = (size_t)HALF * K * 2;
    const size_t tstep = 2 * hstep;
    const unsigned ldsw = (unsigned)wid * 1024u;
    const int aoff = lds_byte(wr * 64 + fr, fq * 8), boff = lds_byte(wc * 32 + fr, fq * 8);
#define PG8_SA(b, h) (((b) * 2 + (h)) * HTB)
#define PG8_SB(b, h) ((4 + (b) * 2 + (h)) * HTB)
#define PG8_STAGE(bufoff, gbase, voff) do { _Pragma("unroll") for (int _i = 0; _i < 2; ++_i) \
        __builtin_amdgcn_global_load_lds((const unsigned*)((const char*)(gbase) + (voff)[_i]), (PG8_LAS unsigned*)(lds + (bufoff) + ldsw + _i * 8192), 16, 0, 0); } while (0)
#define PG8_LDA(dst, b, h) do { _Pragma("unroll") for (int m = 0; m < 4; ++m) _Pragma("unroll") for (int k = 0; k < 2; ++k) dst[m][k] = *(const PG8_LAS bf16x8*)(lds + PG8_SA(b, h) + aoff + m * 2048 + k * 1024); } while (0)
#define PG8_LDB(dst, b, h) do { _Pragma("unroll") for (int n = 0; n < 2; ++n) _Pragma("unroll") for (int k = 0; k < 2; ++k) dst[n][k] = *(const PG8_LAS bf16x8*)(lds + PG8_SB(b, h) + boff + n * 2048 + k * 1024); } while (0)
#define PG8_MMA(ai, bj, At, Bt) do { __builtin_amdgcn_s_setprio(1); _Pragma("unroll") for (int m = 0; m < 4; ++m) _Pragma("unroll") for (int n = 0; n < 2; ++n) _Pragma("unroll") for (int k = 0; k < 2; ++k) \
        acc[ai][bj][m][n] = __builtin_amdgcn_mfma_f32_16x16x32_bf16(Bt[n][k], At[m][k], acc[ai][bj][m][n], 0, 0, 0); __builtin_amdgcn_s_setprio(0); } while (0)
#define PG8_WAIT_V(n) asm volatile("s_waitcnt vmcnt(" #n ")" ::: "memory")
#define PG8_WAIT_L(n) asm volatile("s_waitcnt lgkmcnt(" #n ")" ::: "memory")
#define PG8_BAR __builtin_amdgcn_s_barrier()
#define PG8_SCHED __builtin_amdgcn_sched_barrier(0)
    Unit cur, nxt; int ui = 0;
    if (!S.next(0, cur)) return;
    f32x4 acc[2][2][4][2];
#pragma unroll
    for (int a = 0; a < 2; ++a)
#pragma unroll
        for (int b = 0; b < 2; ++b)
#pragma unroll
            for (int m = 0; m < 4; ++m)
#pragma unroll
                for (int n = 0; n < 2; ++n) acc[a][b][m][n] = (f32x4){0.f, 0.f, 0.f, 0.f};
    bf16x8 At[4][2], B0[2][2], B1[2][2];
    const char* cA = (const char*)g.A + (size_t)cur.pm * tstep; const char* cB = (const char*)g.Bt + (size_t)cur.pn * tstep;
    S.a_ready(cur);
    if constexpr (SP2) {
        PG8_STAGE(PG8_SB(0, 0), cB, voffB); PG8_STAGE(PG8_SB(0, 1), cB + hstep, voffB); PG8_STAGE(PG8_SA(0, 0), cA, voffA); PG8_STAGE(PG8_SA(0, 1), cA + hstep, voffA);
        if (wr == 1) PG8_BAR;
        PG8_WAIT_V(2); PG8_BAR;
        PG8_STAGE(PG8_SB(1, 0), cB + kstep, voffB); PG8_STAGE(PG8_SA(1, 0), cA + kstep, voffA); PG8_STAGE(PG8_SB(1, 1), cB + hstep + kstep, voffB);
        PG8_WAIT_V(6); PG8_BAR;
    } else {
        PG8_STAGE(PG8_SB(0, 0), cB, voffB); PG8_STAGE(PG8_SA(0, 0), cA, voffA); PG8_STAGE(PG8_SB(0, 1), cB + hstep, voffB); PG8_STAGE(PG8_SA(0, 1), cA + hstep, voffA);
        if (wr == 1) PG8_BAR;
        PG8_WAIT_V(4); PG8_BAR;
        PG8_STAGE(PG8_SB(1, 0), cB + kstep, voffB); PG8_STAGE(PG8_SA(1, 0), cA + kstep, voffA); PG8_STAGE(PG8_SB(1, 1), cB + hstep + kstep, voffB);
        PG8_WAIT_V(6); PG8_BAR;
    }
    for (;;) {
        const bool has_next = S.next(ui + 1, nxt);
        const char* nA = has_next ? (const char*)g.A + (size_t)nxt.pm * tstep : cA; const char* nB = has_next ? (const char*)g.Bt + (size_t)nxt.pn * tstep : cB;
        for (int t = 0; t < nt; t += 2) {
            const bool last = (t == nt - 2);
            const char* a1 = cA + (size_t)(t + 1) * kstep;
            const char* a2 = last ? nA : cA + (size_t)(t + 2) * kstep; const char* b2 = last ? nB : cB + (size_t)(t + 2) * kstep;
            const char* a3 = a2 + kstep; const char* b3 = b2 + kstep;
            if (last && has_next) S.a_ready(nxt);
            if constexpr (SP2) {
            PG8_LDB(B0, 0, 0); PG8_LDB(B1, 0, 1); PG8_SCHED; PG8_LDA(At, 0, 0); PG8_STAGE(PG8_SA(1, 1), a1 + hstep, voffA);
            PG8_WAIT_V(8); PG8_WAIT_L(0); PG8_BAR; PG8_MMA(0, 0, At, B0); PG8_MMA(0, 1, At, B1); PG8_BAR; PG8_SCHED;
            PG8_LDA(At, 0, 1); PG8_STAGE(PG8_SB(0, 0), b2, voffB); PG8_STAGE(PG8_SB(0, 1), b2 + hstep, voffB); PG8_STAGE(PG8_SA(0, 0), a2, voffA);
            PG8_WAIT_V(8); PG8_WAIT_L(0); PG8_BAR; PG8_MMA(1, 0, At, B0); PG8_MMA(1, 1, At, B1); PG8_BAR; PG8_SCHED;
            PG8_LDB(B0, 1, 0); PG8_LDB(B1, 1, 1); PG8_SCHED; PG8_LDA(At, 1, 0); PG8_STAGE(PG8_SA(0, 1), a2 + hstep, voffA);
            PG8_WAIT_V(8); PG8_WAIT_L(0); PG8_BAR; PG8_MMA(0, 0, At, B0); PG8_MMA(0, 1, At, B1); PG8_BAR; PG8_SCHED;
            PG8_LDA(At, 1, 1); PG8_STAGE(PG8_SB(1, 0), b3, voffB); PG8_STAGE(PG8_SB(1, 1), b3 + hstep, voffB); PG8_STAGE(PG8_SA(1, 0), a3, voffA);
            PG8_WAIT_V(8); PG8_WAIT_L(0); PG8_BAR; PG8_MMA(1, 0, At, B0); PG8_MMA(1, 1, At, B1); PG8_BAR; PG8_SCHED;
            } else {
            PG8_LDB(B0, 0, 0); PG8_SCHED; PG8_LDA(At, 0, 0); PG8_STAGE(PG8_SA(1, 1), a1 + hstep, voffA);
            PG8_WAIT_L(8); PG8_BAR; PG8_WAIT_L(0); PG8_MMA(0, 0, At, B0); PG8_BAR; PG8_SCHED;
            PG8_LDB(B1, 0, 1); PG8_STAGE(PG8_SB(0, 0), b2, voffB);
            PG8_BAR; PG8_WAIT_L(0); PG8_MMA(0, 1, At, B1); PG8_BAR;
            PG8_LDA(At, 0, 1); PG8_STAGE(PG8_SA(0, 0), a2, voffA);
            PG8_BAR; PG8_WAIT_L(0); PG8_MMA(1, 0, At, B0); PG8_BAR; PG8_SCHED;
            PG8_STAGE(PG8_SB(0, 1), b2 + hstep, voffB);
            PG8_WAIT_V(6); PG8_BAR; PG8_MMA(1, 1, At, B1); PG8_BAR;
            PG8_LDB(B0, 1, 0); PG8_SCHED; PG8_LDA(At, 1, 0); PG8_STAGE(PG8_SA(0, 1), a2 + hstep, voffA);
            PG8_WAIT_L(8); PG8_BAR; PG8_WAIT_L(0); PG8_MMA(0, 0, At, B0); PG8_BAR; PG8_SCHED;
            PG8_LDB(B1, 1, 1); PG8_STAGE(PG8_SB(1, 0), b3, voffB);
            PG8_BAR; PG8_WAIT_L(0); PG8_MMA(0, 1, At, B1); PG8_BAR;
            PG8_LDA(At, 1, 1); PG8_STAGE(PG8_SA(1, 0), a3, voffA);
            PG8_BAR; PG8_WAIT_L(0); PG8_MMA(1, 0, At, B0); PG8_BAR; PG8_SCHED;
            PG8_STAGE(PG8_SB(1, 1), b3 + hstep, voffB);
            PG8_WAIT_V(6); PG8_BAR; PG8_MMA(1, 1, At, B1); PG8_BAR;
            }
        }
        if constexpr (ALIGN_EPI) { if (wr == 0) PG8_BAR; }
        if constexpr (!Epi::AFTER_DRAIN) { E(acc, cur, wr, wc, fr, fq); S.done(cur); }
        if (!has_next) break;
#pragma unroll
        for (int a = 0; a < 2; ++a)
#pragma unroll
            for (int b = 0; b < 2; ++b)
#pragma unroll
                for (int m = 0; m < 4; ++m)
#pragma unroll
                    for (int n = 0; n < 2; ++n) acc[a][b][m][n] = (f32x4){0.f, 0.f, 0.f, 0.f};
        cur = nxt; cA = nA; cB = nB; ++ui;
        if constexpr (ALIGN_EPI) { if (wr == 1) PG8_BAR; }
    }
    PG8_WAIT_V(0);
    if constexpr (!ALIGN_EPI) { if (wr == 0) PG8_BAR; }
    PG8_BAR;
    if constexpr (Epi::AFTER_DRAIN) { E.fused(acc, cur, wr, wc, fr, fq, lds, wid, lane); S.done(cur); }
#undef PG8_SA
#undef PG8_SB
#undef PG8_STAGE
#undef PG8_LDA
#undef PG8_LDB
#undef PG8_MMA
#undef PG8_WAIT_V
#undef PG8_WAIT_L
#undef PG8_BAR
#undef PG8_SCHED
}
}
namespace pg8 {
__device__ __forceinline__ float fsig(float v) { return __builtin_amdgcn_rcpf(1.0f + __builtin_amdgcn_exp2f(-1.4426950408889634f * v)); }
__device__ __forceinline__ float bf_lo(unsigned w) { return __uint_as_float(w << 16); }
__device__ __forceinline__ float bf_hi(unsigned w) { return __uint_as_float(w & 0xffff0000u); }

struct EpiInProj {
    static constexpr bool PERM = true, AFTER_DRAIN = false;
    bf16_t* QA; bf16_t* QB; bf16_t* KA; bf16_t* VA; float* G; bf16_t* IB; bf16_t* GB; const float* lbl; int layer; float qscale;
    __device__ __forceinline__ void operator()(const f32x4 (&acc)[2][2][4][2], const Unit& u, int wr, int wc, int fr, int fq) const {
        const int type = u.pn >> 1;
        const int ct = (u.pn & 1) * 256 + wc * 32 + 8 * fq;
        const int row0 = u.pm * BM + wr * 64 + fr;
        if (type == 4) {
            float lb[2][8];
#pragma unroll
            for (int bj = 0; bj < 2; ++bj)
#pragma unroll
                for (int j = 0; j < 8; ++j) {
                    float v = 0.f;
                    if (layer != 0) { const float l0 = lbl[ct + bj * HALF + j], l1 = lbl[512 + ct + bj * HALF + j]; v = 1.0f / (1.0f + __expf(l0 - l1)); }
                    lb[bj][j] = v;
                }
#pragma unroll
            for (int ai = 0; ai < 2; ++ai)
#pragma unroll
                for (int m = 0; m < 4; ++m) { float* rowp = G + (size_t)(row0 + ai * HALF + m * 16) * 512 + ct;
#pragma unroll
                    for (int bj = 0; bj < 2; ++bj) { f32x4 o0, o1;
#pragma unroll
                        for (int j = 0; j < 4; ++j) {
                            const float f0 = lb[bj][j] + (1.0f - lb[bj][j]) * fsig(acc[ai][bj][m][0][j]);
                            const float f1 = lb[bj][4 + j] + (1.0f - lb[bj][4 + j]) * fsig(acc[ai][bj][m][1][j]);
                            o0[j] = __builtin_amdgcn_logf(f0) * 0.6931471805599453f; o1[j] = __builtin_amdgcn_logf(f1) * 0.6931471805599453f; }
                        *(f32x4*)(rowp + bj * HALF) = o0; *(f32x4*)(rowp + bj * HALF + 4) = o1; } }
        } else {
            bf16_t* base; int ldc = 512, act = 0; float sc = 1.f;
            if (type == 0) { base = QA; sc = qscale; }
            else if (type == 1) base = KA;
            else if (type == 2) base = VA;
            else if (type == 3) { base = QB; act = 1; }
            else if (type == 5) base = IB;
            else { base = GB; act = 2; }
#pragma unroll
            for (int ai = 0; ai < 2; ++ai)
#pragma unroll
                for (int m = 0; m < 4; ++m) { bf16_t* rowp = base + (size_t)(row0 + ai * HALF + m * 16) * ldc + ct;
#pragma unroll
                    for (int bj = 0; bj < 2; ++bj) { f32x4 v0 = acc[ai][bj][m][0], v1 = acc[ai][bj][m][1];
                        if (act != 0) {
#pragma unroll
                            for (int j = 0; j < 4; ++j) { const float s0 = fsig(v0[j]), s1 = fsig(v1[j]); v0[j] = (act == 1) ? v0[j] * s0 : s0; v1[j] = (act == 1) ? v1[j] * s1 : s1; }
                        } else { v0 = v0 * sc; v1 = v1 * sc; }
                        u32x4 w; w.x = cvt_pk_bf16(v0[0], v0[1]); w.y = cvt_pk_bf16(v0[2], v0[3]); w.z = cvt_pk_bf16(v1[0], v1[1]); w.w = cvt_pk_bf16(v1[2], v1[3]);
                        *(u32x4*)(rowp + bj * HALF) = w; } }
        }
    }
};
struct EpiGates {
    static constexpr bool PERM = true, AFTER_DRAIN = false;
    bf16_t* O;
    __device__ __forceinline__ void operator()(const f32x4 (&acc)[2][2][4][2], const Unit& u, int wr, int wc, int fr, int fq) const {
        const int row0 = u.pm * BM + wr * 64 + fr, col0 = u.pn * BM + wc * 32 + 8 * fq;
#pragma unroll
        for (int ai = 0; ai < 2; ++ai)
#pragma unroll
            for (int m = 0; m < 4; ++m) { bf16_t* rowp = O + (size_t)(row0 + ai * HALF + m * 16) * 2048 + col0;
#pragma unroll
                for (int bj = 0; bj < 2; ++bj) { f32x4 v0 = acc[ai][bj][m][0], v1 = acc[ai][bj][m][1];
#pragma unroll
                    for (int j = 0; j < 4; ++j) { v0[j] = fsig(v0[j]); v1[j] = fsig(v1[j]); }
                    u32x4 w; w.x = cvt_pk_bf16(v0[0], v0[1]); w.y = cvt_pk_bf16(v0[2], v0[3]); w.z = cvt_pk_bf16(v1[0], v1[1]); w.w = cvt_pk_bf16(v1[2], v1[3]);
                    *(u32x4*)(rowp + bj * HALF) = w; } }
    }
};
template <int STEP> struct EpiMerge {
    static constexpr bool PERM = true, AFTER_DRAIN = false;
    const bf16_t* GT; bf16_t* O;
    __device__ __forceinline__ void operator()(const f32x4 (&acc)[2][2][4][2], const Unit& u, int wr, int wc, int fr, int fq) const {
        const int row0 = u.pm * BM + wr * 64 + fr, col0 = u.pn * BM + wc * 32 + 8 * fq;
#pragma unroll
        for (int ai = 0; ai < 2; ++ai) {
            u32x4 gq[4][2], tq[4][2];
#pragma unroll
            for (int m = 0; m < 4; ++m) { const size_t row = (size_t)(row0 + ai * HALF + m * 16);
#pragma unroll
                for (int bj = 0; bj < 2; ++bj) { gq[m][bj] = *(const u32x4*)(GT + row * 2048 + STEP * 1024 + col0 + bj * HALF);
                    if (STEP == 1) tq[m][bj] = *(const u32x4*)(O + row * 1024 + col0 + bj * HALF); } }
            asm volatile("" ::: "memory");
#pragma unroll
            for (int m = 0; m < 4; ++m) { const size_t row = (size_t)(row0 + ai * HALF + m * 16);
#pragma unroll
                for (int bj = 0; bj < 2; ++bj) { const u32x4 g = gq[m][bj];
                    const f32x4 a0 = acc[ai][bj][m][0], a1 = acc[ai][bj][m][1];
                    float o[8] = {bf_lo(g.x) * a0[0], bf_hi(g.x) * a0[1], bf_lo(g.y) * a0[2], bf_hi(g.y) * a0[3], bf_lo(g.z) * a1[0], bf_hi(g.z) * a1[1], bf_lo(g.w) * a1[2], bf_hi(g.w) * a1[3]};
                    if (STEP == 1) { const u32x4 t = tq[m][bj];
                        o[0] += bf_lo(t.x); o[1] += bf_hi(t.x); o[2] += bf_lo(t.y); o[3] += bf_hi(t.y); o[4] += bf_lo(t.z); o[5] += bf_hi(t.z); o[6] += bf_lo(t.w); o[7] += bf_hi(t.w); }
                    u32x4 w; w.x = cvt_pk_bf16(o[0], o[1]); w.y = cvt_pk_bf16(o[2], o[3]); w.z = cvt_pk_bf16(o[4], o[5]); w.w = cvt_pk_bf16(o[6], o[7]);
                    *(u32x4*)(O + row * 1024 + col0 + bj * HALF) = w; } }
            asm volatile("" ::: "memory");
        }
    }
};
struct EpiSwiGLU {
    static constexpr bool PERM = true, AFTER_DRAIN = false;
    bf16_t* O;
    __device__ __forceinline__ void operator()(const f32x4 (&acc)[2][2][4][2], const Unit& u, int wr, int wc, int fr, int fq) const {
        const int row0 = u.pm * BM + wr * 64 + fr, col0 = u.pn * HALF + wc * 32 + 8 * fq;
#pragma unroll
        for (int ai = 0; ai < 2; ++ai)
#pragma unroll
            for (int m = 0; m < 4; ++m) { const size_t row = (size_t)(row0 + ai * HALF + m * 16);
                f32x4 v0, v1;
#pragma unroll
                for (int j = 0; j < 4; ++j) { const float g0 = acc[ai][1][m][0][j], g1 = acc[ai][1][m][1][j];
                    v0[j] = g0 * fsig(g0) * acc[ai][0][m][0][j]; v1[j] = g1 * fsig(g1) * acc[ai][0][m][1][j]; }
                u32x4 w; w.x = cvt_pk_bf16(v0[0], v0[1]); w.y = cvt_pk_bf16(v0[2], v0[3]); w.z = cvt_pk_bf16(v1[0], v1[1]); w.w = cvt_pk_bf16(v1[2], v1[3]);
                *(u32x4*)(O + row * 2816 + col0) = w; }
    }
};
struct EpiResid {
    static constexpr bool PERM = false, AFTER_DRAIN = false;
    const float* xres; float* out; float alpha; const float* st; const float* gam; const float* bet;
    __device__ __forceinline__ void operator()(const f32x4 (&acc)[2][2][4][2], const Unit& u, int wr, int wc, int fr, int fq) const {
        const int row0 = u.pm * BM + wr * 64 + fr, col0 = u.pn * BM + wc * 32 + 4 * fq;
        typedef float f32x2e __attribute__((ext_vector_type(2)));
        f32x4 gv[2][2], bv[2][2];
        if (st) {
#pragma unroll
            for (int bj = 0; bj < 2; ++bj)
#pragma unroll
                for (int n = 0; n < 2; ++n) { gv[bj][n] = *(const f32x4*)(gam + col0 + bj * HALF + n * 16); bv[bj][n] = *(const f32x4*)(bet + col0 + bj * HALF + n * 16); }
        }
#pragma unroll
        for (int ai = 0; ai < 2; ++ai)
#pragma unroll
            for (int m = 0; m < 4; ++m) { const size_t row = (size_t)(row0 + ai * HALF + m * 16); const size_t off = row * 1024 + col0;
                f32x2e sr = {0.f, 1.f}; if (st) sr = *(const f32x2e*)(st + 2 * row);
#pragma unroll
                for (int bj = 0; bj < 2; ++bj)
#pragma unroll
                    for (int n = 0; n < 2; ++n) { f32x4 x = *(const f32x4*)(xres + off + bj * HALF + n * 16);
                        if (st) x = (x - sr.x) * sr.y * gv[bj][n] + bv[bj][n];
                        *(f32x4*)(out + off + bj * HALF + n * 16) = x * alpha + acc[ai][bj][m][n]; }
                if (m & 1) asm volatile("" ::: "memory"); }
    }
};
}
#include <hip/hip_bf16.h>
#include <cmath>
namespace attn_body {
using bf16=__hip_bfloat16;
using bf16x8=__attribute__((ext_vector_type(8)))short;
using s16x4=__attribute__((ext_vector_type(4)))short;
using f32x16=__attribute__((ext_vector_type(16)))float;
using u32x4=__attribute__((ext_vector_type(4)))unsigned;
constexpr int BATCH=2,NHEAD=8,SEQ=16384,D=64,QP=512,KP=512;
constexpr int NW=8,QBLK=32,QB=QBLK*NW,KVBLK=64,NQB=SEQ/QB;
constexpr int ATTN_UNIT_ROWS=QB;
__device__ __forceinline__ int crow(int r,int hi){return (r&3)+8*(r>>2)+4*hi;}
#define SBAR() __builtin_amdgcn_sched_barrier(0)
__device__ __forceinline__ void cmask(f32x16&p0,f32x16&p1,int jb,int qrel,int hi){
  const float NEG=-INFINITY; int kb=64*jb+4*hi;
  #pragma unroll
  for(int r=0;r<16;++r){int kv=kb+(r&3)+8*(r>>2); if(kv>qrel)p0[r]=NEG; if(kv+32>qrel)p1[r]=NEG;}
}

constexpr int NSLOT=3, SLOTB=8192;
constexpr int LDS_K=0, LDS_V=NSLOT*SLOTB, LDS_WS=2*NSLOT*SLOTB, LDS_OST=LDS_WS+NW*64*4, LDS_FB=LDS_OST+NW*4096, LDS_BYTES=LDS_FB+SEQ*4;
constexpr float C2=0.125f*1.4426950408889634f;
__device__ __forceinline__ void glds16(const void*gsrc,unsigned lds_dst){unsigned keep;
  asm volatile("s_mov_b32 %0, m0\n\ts_mov_b32 m0, %2\n\ts_nop 0\n\tglobal_load_lds_dwordx4 %1, off\n\ts_mov_b32 m0, %0":"=&s"(keep):"v"(gsrc),"s"(lds_dst):"memory");}
__device__ __forceinline__ float max3f(float a,float b,float c){float r;asm("v_max3_f32 %0, %1, %2, %3":"=v"(r):"v"(a),"v"(b),"v"(c));return r;}
__device__ __forceinline__ float max2f(float a,float b){float r;asm("v_max_f32_e32 %0, %1, %2":"=v"(r):"v"(a),"v"(b));return r;}
__device__ __forceinline__ float fadd_s(float a,float b){float r;asm("v_add_f32_e32 %0, %1, %2":"=v"(r):"v"(a),"v"(b));return r;}
__device__ __forceinline__ float fsub_s(float a,float b){float r;asm("v_sub_f32_e32 %0, %1, %2":"=v"(r):"v"(a),"v"(b));return r;}
typedef float f32x2_t __attribute__((ext_vector_type(2))); typedef __bf16 bf16x2_t __attribute__((ext_vector_type(2)));
__device__ __forceinline__ unsigned cvtpk_s(float lo,float hi){f32x2_t v={lo,hi};bf16x2_t b=__builtin_convertvector(v,bf16x2_t);return __builtin_bit_cast(unsigned,b);}
#define WAIT_BAR(N) asm volatile("s_waitcnt vmcnt(" #N ") lgkmcnt(0)\n\ts_barrier":::"memory")

__device__ __forceinline__ void qkt(f32x16&p0,f32x16&p1,const char*Kslot,const bf16x8*qr,int r32,int hi){
  const char*kb=Kslot+hi*1024+r32*16;
  #pragma unroll
  for(int d0=0;d0<4;++d0){
    const bf16x8 b0=*reinterpret_cast<const bf16x8*>(kb+d0*2048);
    const bf16x8 b1=*reinterpret_cast<const bf16x8*>(kb+d0*2048+512);
    p0=__builtin_amdgcn_mfma_f32_32x32x16_bf16(b0,qr[d0],p0,0,0,0);p1=__builtin_amdgcn_mfma_f32_32x32x16_bf16(b1,qr[d0],p1,0,0,0);}
}
typedef __attribute__((address_space(3))) const char* lds_cptr;
typedef short v4i16_t __attribute__((ext_vector_type(4)));
__device__ __forceinline__ void kload8(bf16x8*kf,lds_cptr kp){
  kf[0]=*(const __attribute__((address_space(3))) bf16x8*)(kp);      kf[1]=*(const __attribute__((address_space(3))) bf16x8*)(kp+512);
  kf[2]=*(const __attribute__((address_space(3))) bf16x8*)(kp+2048); kf[3]=*(const __attribute__((address_space(3))) bf16x8*)(kp+2560);
  kf[4]=*(const __attribute__((address_space(3))) bf16x8*)(kp+4096); kf[5]=*(const __attribute__((address_space(3))) bf16x8*)(kp+4608);
  kf[6]=*(const __attribute__((address_space(3))) bf16x8*)(kp+6144); kf[7]=*(const __attribute__((address_space(3))) bf16x8*)(kp+6656);
}
__device__ __forceinline__ void kload2(bf16x8*kf,lds_cptr kp,int j){ kf[2*j]=*(const __attribute__((address_space(3))) bf16x8*)(kp+j*2048); kf[2*j+1]=*(const __attribute__((address_space(3))) bf16x8*)(kp+j*2048+512); }
__device__ __forceinline__ s16x4 vtr(lds_cptr p){ return __builtin_bit_cast(s16x4,__builtin_amdgcn_ds_read_tr16_b64_v4i16((__attribute__((address_space(3))) v4i16_t*)p)); }
__device__ __forceinline__ float rowmax(const f32x16&p0,const f32x16&p1){
  float a=max3f(p0[0],p0[1],p1[0]),b=max3f(p0[2],p0[3],p1[1]);a=max3f(a,p1[2],p1[3]);
  #pragma unroll
  for(int r=4;r<16;r+=4){a=max3f(a,p0[r],p0[r+1]);b=max3f(b,p0[r+2],p0[r+3]);a=max3f(a,p1[r],p1[r+1]);b=max3f(b,p1[r+2],p1[r+3]);}
  const float m=max2f(a,b);
  auto rr=__builtin_amdgcn_permlane32_swap(__float_as_uint(m),__float_as_uint(m),false,false);
  return max2f(__uint_as_float(rr[0]),__uint_as_float(rr[1]));
}
__device__ __forceinline__ void pv(f32x16*o,int vb,bf16x8 pa0,bf16x8 pa1,bf16x8 pa2,bf16x8 pa3){
  #pragma unroll
  for(int d0=0;d0<2;++d0){s16x4 lo[4],hi[4];
    #pragma unroll
    for(int ks=0;ks<4;++ks){
      asm volatile("ds_read_b64_tr_b16 %0,%1 offset:%c2":"=&v"(lo[ks]):"v"(vb),"i"(d0*4096+ks*1024):"memory");
      asm volatile("ds_read_b64_tr_b16 %0,%1 offset:%c2":"=&v"(hi[ks]):"v"(vb),"i"(d0*4096+ks*1024+512):"memory");}
    asm volatile("s_waitcnt lgkmcnt(0)":::"memory");SBAR();
    #define PK(k) (bf16x8){lo[k][0],lo[k][1],lo[k][2],lo[k][3],hi[k][0],hi[k][1],hi[k][2],hi[k][3]}
    o[d0]=__builtin_amdgcn_mfma_f32_32x32x16_bf16(pa0,PK(0),o[d0],0,0,0);
    o[d0]=__builtin_amdgcn_mfma_f32_32x32x16_bf16(pa1,PK(1),o[d0],0,0,0);
    o[d0]=__builtin_amdgcn_mfma_f32_32x32x16_bf16(pa2,PK(2),o[d0],0,0,0);
    o[d0]=__builtin_amdgcn_mfma_f32_32x32x16_bf16(pa3,PK(3),o[d0],0,0,0);
    #undef PK
  }
}

#ifndef ATTN_STORE16
#define ATTN_STORE16(p,v) (*(u32x4*)(p)=(v))
#endif
template<int THRL> __device__ __forceinline__ void attn_unit(int b,int h,int qb,const bf16*Q,const bf16*__restrict__ K,const bf16*__restrict__ V,bf16*O,const float*__restrict__ Fg,const unsigned*__restrict__ NB,char*shm){
  int tid_=threadIdx.x; asm volatile("":"+v"(tid_));
  const int tid=tid_,lane=tid&63,r32=lane&31,hi=lane>>5; const int wid=__builtin_amdgcn_readfirstlane(tid>>6);
  const long rowbase=(long)b*SEQ; const int q0=qb*QB;
  const bf16*Qw=Q+(rowbase+q0+wid*QBLK)*QP+h*D;
  const bf16*Kh=K+rowbase*KP+h*D,*Vh=V+rowbase*KP+h*D;
  __attribute__((address_space(3))) char* const shm3w=(__attribute__((address_space(3))) char*)shm;
  const unsigned lds0=(unsigned)(uintptr_t)shm;
  float*wsf=(float*)(shm+LDS_WS)+wid*64;
  const bf16*ksrc_=Kh+(long)lane*KP+wid*8;
  const bf16*vsrc_=Vh+(long)(16*(wid&3)+(lane>>2))*KP+(wid>>2)*32+(lane&3)*8;
  const unsigned kdst=lds0+LDS_K+wid*1024, vdst=lds0+LDS_V+wid*1024;
  #define DMA_K(t,slot) glds16(ksrc+(long)(t)*KVBLK*KP,(unsigned)__builtin_amdgcn_readfirstlane(kdst+(slot)))
  #define DMA_V(t,slot) glds16(vsrc+(long)(t)*KVBLK*KP,(unsigned)__builtin_amdgcn_readfirstlane(vdst+(slot)))
  const int vb0=(int)(lds0+LDS_V)+((lane>>4)&1)*32+(lane&3)*8+(4*hi+((lane&15)>>2))*64;
  const char*Kbase=shm+LDS_K; bf16x8 kf[8];
  const lds_cptr shm3=(lds_cptr)shm; const lds_cptr kp0=shm3+LDS_K+hi*1024+r32*16; const lds_cptr vp0=shm3+LDS_V+((lane>>4)&1)*32+(lane&3)*8+(4*hi+((lane&15)>>2))*64;
  const int NT0=(q0+QB)/KVBLK;
  int j0;
  { typedef __attribute__((address_space(3))) unsigned* lds_uptr; const lds_uptr cnt=(lds_uptr)(shm3w+LDS_BYTES+16);
    const float fref=Fg[q0]; const float Bq=__builtin_sqrtf(__uint_as_float(NB[0])*__uint_as_float(NB[1])); const float thr=-(152.0f+2.0f*Bq);
    if(tid==0)*cnt=0u;
    asm volatile("s_waitcnt lgkmcnt(0)\n\ts_barrier":::"memory");
    bool skip=false; if(tid<NT0-4){ skip=((fref-Fg[64*tid+63])*1.4426950408889634f<thr); }
    const unsigned long long bal=__ballot(skip); if(lane==0&&bal)__hip_atomic_fetch_add(cnt,(unsigned)__popcll(bal),__ATOMIC_RELAXED,__HIP_MEMORY_SCOPE_WORKGROUP);
    asm volatile("s_waitcnt lgkmcnt(0)\n\ts_barrier":::"memory");
    j0=(int)(*cnt)&~1; j0=__builtin_amdgcn_readfirstlane(j0);
    typedef __attribute__((address_space(3))) float* lds_fptr; const lds_fptr fbl=(lds_fptr)(shm3w+LDS_FB);
    for(int i=64*j0+tid;i<q0+QB;i+=NW*64) fbl[i]=(fref-Fg[i])*1.4426950408889634f; }
  const int NT=NT0-j0;
  const bf16*ksrc=ksrc_+(long)j0*KVBLK*KP; const bf16*vsrc=vsrc_+(long)j0*KVBLK*KP;
  DMA_K(0,0);DMA_V(0,0);DMA_K(1,SLOTB);
  bf16x8 qr[4];
  #pragma unroll
  for(int d0=0;d0<4;++d0)qr[d0]=*reinterpret_cast<const bf16x8*>(&Qw[(long)r32*QP+d0*16+hi*8]);
  float mhat=0.f,l_reg=0.f;f32x16 o[2];o[0]=f32x16{};o[1]=f32x16{};
  const lds_cptr fb0=(lds_cptr)shm3w+LDS_FB+hi*16+j0*256;
  typedef float f32x4v __attribute__((ext_vector_type(4)));
  #define BLD(P0,P1,t) do{ const lds_cptr fp_=fb0+(t)*256; _Pragma("unroll") for(int j_=0;j_<4;++j_){ \
      const f32x4v a_=*(const __attribute__((address_space(3))) f32x4v*)(fp_+j_*32), b_=*(const __attribute__((address_space(3))) f32x4v*)(fp_+128+j_*32); \
      P0[4*j_]=a_[0];P0[4*j_+1]=a_[1];P0[4*j_+2]=a_[2];P0[4*j_+3]=a_[3]; P1[4*j_]=b_[0];P1[4*j_+1]=b_[1];P1[4*j_+2]=b_[2];P1[4*j_+3]=b_[3]; } }while(0)
  const int qrel=wid*QBLK+r32;
  #define CMASK(P0,P1,t) do{int jb_=(t)-(NT-4); if(jb_>=0)cmask(P0,P1,jb_,qrel,hi);}while(0)
  bool resc=false;
  #define START(P0,P1) do{ const float rm=rowmax(P0,P1); resc=false; mhat=rm; \
    _Pragma("unroll") for(int r=0;r<16;++r)P0[r]=__builtin_amdgcn_exp2f(P0[r]-mhat); }while(0)
  #define RESC() do{ if(resc){ asm volatile("s_waitcnt lgkmcnt(0)":::"memory"); \
      _Pragma("unroll") for(int d_=0;d_<2;++d_) _Pragma("unroll") for(int r=0;r<16;++r)o[d_][r]*=wsf[crow(r,hi)]; } }while(0)
  f32x16 pA0,pA1,pB0,pB1;
  int sl_prev=0,sl_cur=0,sl_next=SLOTB;
  #define ROT() do{sl_prev=sl_cur;sl_cur=sl_next;sl_next=(sl_next==(NSLOT-1)*SLOTB)?0:sl_next+SLOTB;}while(0)
  DMA_K(2,2*SLOTB);
  WAIT_BAR(3);
  BLD(pA0,pA1,0);
  qkt(pA0,pA1,Kbase,qr,r32,hi);asm volatile("s_nop 15\n\ts_nop 7":"+v"(pA0),"+v"(pA1));CMASK(pA0,pA1,0);
  START(pA0,pA1);
  _Pragma("unroll") for(int r=0;r<16;++r)pA1[r]=__builtin_amdgcn_exp2f(pA1[r]-mhat);
  WAIT_BAR(0);
  DMA_K(3,0);DMA_V(1,SLOTB);
  ROT();
  kload8(kf,kp0+sl_cur);
  BLD(pB0,pB1,1);
  WAIT_BAR(2);
  s16x4 vlo[8],vhi[8]; u32x4 pw0,pw1,pw2,pw3;
  #define PKW(P,B) cvtpk_s(P[B],P[B+1])
  #define PAF(k) __builtin_bit_cast(bf16x8,pw##k)
  #define VFR(i) (bf16x8){vlo[i][0],vlo[i][1],vlo[i][2],vlo[i][3],vhi[i][0],vhi[i][1],vhi[i][2],vhi[i][3]}
  #define PIN(x) asm volatile("":"+v"(x))
  #define MX3(a,b,c) __builtin_fmaxf(__builtin_fmaxf((a),(b)),(c))
  #define GAPA(MF,A0,A1,A2,A3,W0,W1,PW) do{ MF; sacc+=A0; sacc+=A1; sacc+=A2; sacc+=A3; PIN(sacc); W0; W1; PIN(PW); SBAR(); }while(0)
  #define EX(v) __builtin_amdgcn_exp2f(v)
  #define GAPB(MF,X,B) do{ MF; X[B]=EX(X[B]-mhat); X[B+1]=EX(X[B+1]-mhat); X[B+2]=EX(X[B+2]-mhat); X[B+3]=EX(X[B+3]-mhat); PIN(X); SBAR(); }while(0)
  #define VRD(i) do{ vlo[i]=vtr(vp_+(((i)>>2)*4096+((i)&3)*1024)); vhi[i]=vtr(vp_+(((i)>>2)*4096+((i)&3)*1024+512)); }while(0)
  #define KRD(G,j) do{ if(G){ kload2(kf,kp0+sl_next,j); SBAR(); } }while(0)
  #define STEP(C0,C1,P0,P1,t,GK,GV,GL) do{ SBAR(); \
    const lds_cptr vp_=vp0+sl_prev; \
    VRD(0); SBAR(); float sacc=(P0[0]+P0[1]); \
    GAPA(C0=__builtin_amdgcn_mfma_f32_32x32x16_bf16(kf[0],qr[0],C0,0,0,0), P0[2],P0[3],P0[4],P0[5],     pw0[0]=PKW(P0,0), pw0[1]=PKW(P0,2), pw0); \
    VRD(4); SBAR(); GAPA(C1=__builtin_amdgcn_mfma_f32_32x32x16_bf16(kf[1],qr[0],C1,0,0,0), P0[6],P0[7],P0[8],P0[9],     pw0[2]=PKW(P0,4), pw0[3]=PKW(P0,6), pw0); \
    VRD(1); SBAR(); GAPA(C0=__builtin_amdgcn_mfma_f32_32x32x16_bf16(kf[2],qr[1],C0,0,0,0),   P0[10],P0[11],P0[12],P0[13], pw1[0]=PKW(P0,8), pw1[1]=PKW(P0,10), pw1); \
    VRD(5); SBAR(); GAPA(C1=__builtin_amdgcn_mfma_f32_32x32x16_bf16(kf[3],qr[1],C1,0,0,0),   P0[14],P0[15],P1[0],P1[1],   pw1[2]=PKW(P0,12),pw1[3]=PKW(P0,14), pw1); \
    VRD(2); SBAR(); GAPA(C0=__builtin_amdgcn_mfma_f32_32x32x16_bf16(kf[4],qr[2],C0,0,0,0),   P1[2],P1[3],P1[4],P1[5],     pw2[0]=PKW(P1,0), pw2[1]=PKW(P1,2), pw2); \
    VRD(6); SBAR(); GAPA(C1=__builtin_amdgcn_mfma_f32_32x32x16_bf16(kf[5],qr[2],C1,0,0,0),   P1[6],P1[7],P1[8],P1[9],     pw2[2]=PKW(P1,4), pw2[3]=PKW(P1,6), pw2); \
    VRD(3); SBAR(); GAPA(C0=__builtin_amdgcn_mfma_f32_32x32x16_bf16(kf[6],qr[3],C0,0,0,0),   P1[10],P1[11],P1[12],P1[13], pw3[0]=PKW(P1,8), pw3[1]=PKW(P1,10), pw3); \
    VRD(7); SBAR(); GAPA(C1=__builtin_amdgcn_mfma_f32_32x32x16_bf16(kf[7],qr[3],C1,0,0,0),   P1[14],P1[15],0.f,0.f,       pw3[2]=PKW(P1,12),pw3[3]=PKW(P1,14), pw3); \
    l_reg+=sacc; \
    if(GK){DMA_K((t)+3,sl_cur);} if(GV){DMA_V((t)+1,sl_next);} \
    CMASK(C0,C1,t); \
    { float a=MX3(C0[0],C0[1],C1[0]),b=MX3(C0[2],C0[3],C1[1]); a=MX3(a,C1[2],C1[3]); \
      _Pragma("unroll") for(int r=4;r<16;r+=4){a=MX3(a,C0[r],C0[r+1]);b=MX3(b,C0[r+2],C0[r+3]);a=MX3(a,C1[r],C1[r+1]);b=MX3(b,C1[r+2],C1[r+3]);} \
      float rm=__builtin_fmaxf(a,b); { auto rr=__builtin_amdgcn_permlane32_swap(__float_as_uint(rm),__float_as_uint(rm),false,false); rm=__builtin_fmaxf(__uint_as_float(rr[0]),__uint_as_float(rr[1])); } \
      rm-=mhat; resc=false; \
      if(__builtin_expect(__any(rm>(float)THRL),0)){ const float dl=__builtin_fmaxf(rm,0.f); mhat+=dl; \
        const float f=__builtin_amdgcn_exp2f(-dl); l_reg*=f; if(hi==0)wsf[r32]=f; resc=true; } } \
    SBAR(); if(GL){ BLD(P0,P1,(t)+1); } \
    SBAR(); \
    GAPB(o[0]=__builtin_amdgcn_mfma_f32_32x32x16_bf16(PAF(0),VFR(0),o[0],0,0,0), C0,0); \
    GAPB(o[1]=__builtin_amdgcn_mfma_f32_32x32x16_bf16(PAF(0),VFR(4),o[1],0,0,0), C0,4); \
    KRD(GL,0); GAPB(o[0]=__builtin_amdgcn_mfma_f32_32x32x16_bf16(PAF(1),VFR(1),o[0],0,0,0), C0,8); \
    KRD(GL,1); GAPB(o[1]=__builtin_amdgcn_mfma_f32_32x32x16_bf16(PAF(1),VFR(5),o[1],0,0,0), C0,12); \
    KRD(GL,2); GAPB(o[0]=__builtin_amdgcn_mfma_f32_32x32x16_bf16(PAF(2),VFR(2),o[0],0,0,0), C1,0); \
    KRD(GL,3); GAPB(o[1]=__builtin_amdgcn_mfma_f32_32x32x16_bf16(PAF(2),VFR(6),o[1],0,0,0), C1,4); \
    GAPB(o[0]=__builtin_amdgcn_mfma_f32_32x32x16_bf16(PAF(3),VFR(3),o[0],0,0,0), C1,8); \
    GAPB(o[1]=__builtin_amdgcn_mfma_f32_32x32x16_bf16(PAF(3),VFR(7),o[1],0,0,0), C1,12); \
    }while(0)
  int t=1;
  #undef CMASK
  #define CMASK(P0,P1,t) do{}while(0)
  for(;t+5<NT;t+=2){
    STEP(pB0,pB1,pA0,pA1,t,true,true,true);     WAIT_BAR(2); RESC(); ROT();
    STEP(pA0,pA1,pB0,pB1,t+1,true,true,true);   WAIT_BAR(2); RESC(); ROT();
  }
  #undef CMASK
  #define CMASK(P0,P1,t) do{int jb_=(t)-(NT-4); if(jb_>=0)cmask(P0,P1,jb_,qrel,hi);}while(0)
  #define ENDW(tt) do{ if((tt)+3<NT){WAIT_BAR(2);} else if((tt)+2<NT){WAIT_BAR(1);} else {WAIT_BAR(0);} }while(0)
  for(;t+1<NT;t+=2){
    STEP(pB0,pB1,pA0,pA1,t,(t+3<NT),(t+1<NT),(t+1<NT));       ENDW(t);   RESC(); ROT();
    STEP(pA0,pA1,pB0,pB1,t+1,(t+4<NT),(t+2<NT),(t+2<NT));     ENDW(t+1); RESC(); ROT();
  }
  STEP(pB0,pB1,pA0,pA1,NT-1,false,false,false); RESC();
  { float sacc=pB0[0]+pB0[1]; _Pragma("unroll") for(int r=2;r<16;++r)sacc+=pB0[r]; _Pragma("unroll") for(int r=0;r<16;++r)sacc+=pB1[r]; l_reg+=sacc;
    pw0=(u32x4){PKW(pB0,0),PKW(pB0,2),PKW(pB0,4),PKW(pB0,6)};pw1=(u32x4){PKW(pB0,8),PKW(pB0,10),PKW(pB0,12),PKW(pB0,14)};pw2=(u32x4){PKW(pB1,0),PKW(pB1,2),PKW(pB1,4),PKW(pB1,6)};pw3=(u32x4){PKW(pB1,8),PKW(pB1,10),PKW(pB1,12),PKW(pB1,14)};
    SBAR(); pv(o,vb0+sl_cur,PAF(0),PAF(1),PAF(2),PAF(3)); }
  #undef PKW
  #undef PAF
  #undef VFR
  #undef PIN
  #undef MX3
  #undef GAPA
  #undef GAPB
  #undef EX
  #undef VRD
  #undef KRD
  #undef STEP
  #undef ENDW
  {auto rr=__builtin_amdgcn_permlane32_swap(__float_as_uint(l_reg),__float_as_uint(l_reg),false,false);l_reg=__uint_as_float(rr[0])+__uint_as_float(rr[1]);}
  if(hi==0)wsf[32+r32]=l_reg;asm volatile("s_waitcnt lgkmcnt(0)":::"memory");
  float rli[16];
  #pragma unroll
  for(int r=0;r<16;++r)rli[r]=__builtin_amdgcn_rcpf(wsf[32+crow(r,hi)]);
  bf16*Ow=O+(rowbase+q0+wid*QBLK)*QP+h*D;
  { bf16*stg=(bf16*)(shm+LDS_OST)+wid*2048;
    #pragma unroll
    for(int r=0;r<16;++r){const int orow=crow(r,hi);
      #pragma unroll
      for(int d0=0;d0<2;++d0)stg[orow*64+d0*32+r32]=__float2bfloat16(o[d0][r]*rli[r]);}
    asm volatile("s_waitcnt lgkmcnt(0)":::"memory");
    #pragma unroll
    for(int i=0;i<4;++i){const int row=i*8+(lane>>3),ch=lane&7; const u32x4 v=*(const u32x4*)(stg+row*64+ch*8); ATTN_STORE16(Ow+(long)row*QP+ch*8,v);} }
  asm volatile("s_waitcnt lgkmcnt(0)\n\ts_barrier":::"memory");
  #undef DMA_K
  #undef DMA_V
  #undef CMASK
  #undef START
  #undef RESC
  #undef BLD
  #undef ROT
}
constexpr int ATTN_LDS_BYTES=LDS_BYTES;
struct AttnTensors { const bf16* Q; const bf16* K; const bf16* V; bf16* O; const float* F; const unsigned* NB; };
struct AttnUnit { int bh; int qb; };
struct DynOrder {
  unsigned* ctr; volatile __attribute__((address_space(3))) unsigned* slot;
  __device__ __forceinline__ bool next(int,AttnUnit&u)const{
    if(threadIdx.x==0)*slot=__hip_atomic_fetch_add(ctr,1u,__ATOMIC_RELAXED,__HIP_MEMORY_SCOPE_AGENT);
    asm volatile("s_waitcnt vmcnt(0) lgkmcnt(0)\n\ts_barrier":::"memory");
    const unsigned n=*slot; if(n>=1024u)return false; u.qb=63-(int)(n>>4); u.bh=(int)(n&15u); return true; }
  __device__ __forceinline__ void a_ready(const AttnUnit&)const{}
  __device__ __forceinline__ void done(const AttnUnit&)const{}
};
template<class Sched,int THRL=8> __device__ __forceinline__ void attn_phase(char*lds,const AttnTensors&T,const Sched&S){
  AttnUnit u;
  for(int i=0;S.next(i,u);++i){ S.a_ready(u); attn_unit<THRL>(u.bh/NHEAD,u.bh%NHEAD,u.qb,T.Q,T.K,T.V,T.O,T.F+(long)u.bh*SEQ,T.NB+2*u.bh,lds); S.done(u); }
}
#undef SBAR
#undef WAIT_BAR
}
#include <hip/hip_cooperative_groups.h>
namespace cg = cooperative_groups;
#define LAS __attribute__((address_space(3)))
typedef unsigned short bf16;
typedef unsigned v4u __attribute__((ext_vector_type(4)));
typedef float f32x4 __attribute__((ext_vector_type(4)));
typedef short bf16x8 __attribute__((ext_vector_type(8)));
typedef LAS unsigned char* lp;

#define XB_TMO      128
#define XB_XCNT(j)  (256  + 64 * (j))
#define XB_XSUB(j)  (1280 + 64 * (j))
#define XB_XGEN(j)  (2304 + 64 * (j))
#define XB_TOP      3328
#define XB_TOPGEN   3392
#define XCD_BAR_WORDS 3456
#define XB_SPIN_CAP (1u << 18)

__device__ __forceinline__ unsigned xb_ld(unsigned* p)              { return __hip_atomic_load(p, __ATOMIC_RELAXED, __HIP_MEMORY_SCOPE_AGENT); }
__device__ __forceinline__ unsigned xb_add(unsigned* p, unsigned v) { return __hip_atomic_fetch_add(p, v, __ATOMIC_RELAXED, __HIP_MEMORY_SCOPE_AGENT); }
__device__ __forceinline__ unsigned xb_xcc_id() { return (unsigned)__builtin_amdgcn_s_getreg((3 << 11) | 20) & 0xFu; }
#define XB_SPIN(cond, bar) do { unsigned _sp = 0; while (cond) { __builtin_amdgcn_s_sleep(1); \
    if ((++_sp & 255u) == 0u) { if (xb_ld(&(bar)[XB_TMO])) break; if (_sp > XB_SPIN_CAP) { atomicAdd(&(bar)[XB_TMO], 1u); break; } } } } while (0)

struct XcdBarrier {
    unsigned* bar; unsigned x;
    volatile LAS unsigned* st;
};

__device__ __forceinline__ XcdBarrier xcd_barrier_post(unsigned* bar, volatile LAS unsigned* st) {
    XcdBarrier b; b.bar = bar; b.x = xb_xcc_id(); b.st = st;
    if (threadIdx.x == 0) (void)xb_add(&bar[XB_XCNT(b.x)], 1u);
    return b;
}
__device__ __forceinline__ void xcd_barrier_complete(unsigned* bar, unsigned x, unsigned& nloc, unsigned& nx) {
    const unsigned G = gridDim.x * gridDim.y * gridDim.z;
    unsigned sum, cnt, mine, sp = 0u;
    for (;;) {
        sum = 0u; cnt = 0u; mine = 0u;
#pragma unroll
        for (unsigned j = 0; j < 16; ++j) { const unsigned c = xb_ld(&bar[XB_XCNT(j)]); sum += c; cnt += (c > 0u) ? 1u : 0u; mine = (j == x) ? c : mine; }
        if (sum == G) break;
        __builtin_amdgcn_s_sleep(1);
        if ((++sp & 255u) == 0u) { if (xb_ld(&bar[XB_TMO])) break; if (sp > XB_SPIN_CAP) { atomicAdd(&bar[XB_TMO], 1u); break; } }
    }
    nloc = mine > 0u ? mine : 1u; nx = cnt > 0u ? cnt : 1u;
}

__device__ __forceinline__ void xcd_barrier(const XcdBarrier& b) {
    asm volatile("s_waitcnt vmcnt(0)" ::: "memory");
    __syncthreads();
    if (threadIdx.x == 0) {
        unsigned* bar = b.bar;
        __builtin_amdgcn_s_waitcnt(0);
        unsigned nloc = b.st[0], nx = b.st[1];
        if (nloc == 0u) { xcd_barrier_complete(bar, b.x, nloc, nx); b.st[0] = nloc; b.st[1] = nx; }
        const unsigned old = xb_add(&bar[XB_XSUB(b.x)], 1u);
        const unsigned gen = old / nloc;
        if (old + 1u == (gen + 1u) * nloc) {
            __builtin_amdgcn_fence(__ATOMIC_RELEASE, "agent");
            asm volatile("s_waitcnt vmcnt(0)" ::: "memory");
            const unsigned og = xb_add(&bar[XB_TOP], 1u);
            const unsigned tg = og / nx;
            if (og + 1u == (tg + 1u) * nx) xb_add(&bar[XB_TOPGEN], 1u);
            else XB_SPIN(xb_ld(&bar[XB_TOPGEN]) == tg, bar);
            __builtin_amdgcn_fence(__ATOMIC_ACQUIRE, "agent");
            xb_add(&bar[XB_XGEN(b.x)], 1u);
            asm volatile("s_waitcnt vmcnt(0)" ::: "memory");
        } else {
            XB_SPIN(xb_ld(&bar[XB_XGEN(b.x)]) == gen, bar);
            __builtin_amdgcn_fence(__ATOMIC_ACQUIRE, "agent");
            asm volatile("s_waitcnt vmcnt(0)" ::: "memory");
        }
    }
    __syncthreads();
}


constexpr int NWAVES = 8, NTHR = 512;
constexpr int BATCH = 2, SEQ = 16384, D = 1024, M = BATCH * SEQ, DEPTH = 2;
constexpr int NIN = 5640, NP1 = 3584, NG = 2048, FFH = 2816, NF1 = 5632;
constexpr float ALPHA = 1.4142135623730951f;
constexpr float LN_EPS = 1e-5f, RMS_EPS = 1e-6f;
constexpr size_t MiB = 1u << 20;
constexpr size_t WL_IN = 0, WL_G = 7 * MiB, WL_M = 11 * MiB, WL_O = 15 * MiB, WL_F1 = 17 * MiB, WL_F2 = 28 * MiB, WL_STRIDE = 34 * MiB;
constexpr size_t WS_W = 0, WS_XN = 68 * MiB, WS_QA = 132 * MiB, WS_QB = 164 * MiB, WS_KA = 196 * MiB, WS_VA = 228 * MiB, WS_G = 260 * MiB, WS_IB = 324 * MiB, WS_GB = 356 * MiB,
                 WS_ST = 388 * MiB, WS_DEC = 452 * MiB, WS_LF = 453 * MiB, WS_F = 454 * MiB, WS_CTL = 455 * MiB  , WS_DBG = 455 * MiB + 512 * 1024, WS_END = 456 * MiB;
constexpr size_t WS_GATES = WS_G  , WS_MERGED = WS_KA  , WS_H = WS_QA  ;
constexpr size_t CTL_QCTR = 16384  , CTL_PCTR = 18432  , CTL_STATS = 131072  , CTL_NORM = 20480  ;
constexpr int LDS_TOTAL = 155648;
static_assert(attn_body::LDS_BYTES <= LDS_TOTAL && pg8::STAGE_BYTES <= LDS_TOTAL, "LDS map");

__device__ __forceinline__ float wave_sum(float v) {
#pragma unroll
    for (int o = 1; o < 64; o <<= 1) v += __shfl_xor(v, o);
    return v;
}
__device__ __forceinline__ unsigned pk2(float lo, float hi) { return pg8::cvt_pk_bf16(lo, hi); }
__device__ __forceinline__ float bf2f(unsigned short h) { return __uint_as_float((unsigned)h << 16); }

__device__ __forceinline__ void transpose_item(const float* Wsrc, int pitch, bf16* WTdst, int Kdst, LAS float* scr, int lane, bool zero) {
    if (!zero) {
#pragma unroll
        for (int i = 0; i < 32; ++i) { const int kk = 2 * i + (lane >> 5); scr[kk * 33 + (lane & 31)] = Wsrc[(size_t)kk * pitch + (lane & 31)]; }
    }
    asm volatile("s_waitcnt lgkmcnt(0)" ::: "memory");
    const int c = lane & 7;
#pragma unroll
    for (int j = 0; j < 4; ++j) { const int n = (lane >> 3) + 8 * j; const LAS float* s = scr + (8 * c) * 33 + n;
        v4u o;
        if (zero) { o = (v4u){0u, 0u, 0u, 0u}; }
        else { o.x = pk2(s[0 * 33], s[1 * 33]); o.y = pk2(s[2 * 33], s[3 * 33]); o.z = pk2(s[4 * 33], s[5 * 33]); o.w = pk2(s[6 * 33], s[7 * 33]); }
        *(v4u*)(WTdst + (size_t)n * Kdst + 8 * c) = o; }
    asm volatile("s_waitcnt lgkmcnt(0)" ::: "memory");
}

struct Ptrs {
    const float *x, *w_in, *b_fgate, *lb_logits, *norm_g, *w_pa, *w_pb, *w_o, *ln1_g, *ln1_b, *w_ff_in, *w_ff_out, *ln2_g, *ln2_b;
    float* out; unsigned char* ws;
};

__device__ __forceinline__ void weight_items(const Ptrs& P, LAS float* scr, int gw, int NGW, int lane) {
    constexpr int I_IN = 16 * (NP1 / 32), I_G = 16 * (NG / 32), I_M = 2 * 8 * 32, I_O = 16 * 32, I_F1 = 16 * (NF1 / 32), I_F2 = (FFH / 64) * 32;
    constexpr int PER_LAYER = I_IN + I_G + I_M + I_O + I_F1 + I_F2;
    for (int it = gw; it < DEPTH * PER_LAYER; it += NGW) {
        const int l = it / PER_LAYER; int r = it % PER_LAYER;
        bf16* WB = (bf16*)(P.ws + WS_W + (size_t)l * WL_STRIDE);
        if (r < I_IN) { const int nblk = NP1 / 32, kb = r / nblk, nb = r % nblk, k0 = 64 * kb, n0 = 32 * nb; const int sc = n0 < 1536 ? n0 : n0 + 8;
            transpose_item(P.w_in + (size_t)l * D * NIN + (size_t)k0 * NIN + sc, NIN, (bf16*)((unsigned char*)WB + WL_IN) + (size_t)n0 * 1024 + k0, 1024, scr, lane, false); continue; } r -= I_IN;
        if (r < I_G) { const int nblk = NG / 32, kb = r / nblk, nb = r % nblk, k0 = 64 * kb, n0 = 32 * nb;
            transpose_item(P.w_in + (size_t)l * D * NIN + (size_t)k0 * NIN + 3592 + n0, NIN, (bf16*)((unsigned char*)WB + WL_G) + (size_t)n0 * 1024 + k0, 1024, scr, lane, false); continue; } r -= I_G;
        if (r < I_M) { const int which = r >> 8, rr = r & 255, kb = rr >> 5, nb = rr & 31, k0 = 64 * kb, n0 = 32 * nb;
            const float* src = (which ? P.w_pb : P.w_pa) + (size_t)l * 512 * 1024 + (size_t)k0 * 1024 + n0;
            transpose_item(src, 1024, (bf16*)((unsigned char*)WB + WL_M + (size_t)which * MiB) + (size_t)n0 * 512 + k0, 512, scr, lane, false); continue; } r -= I_M;
        if (r < I_O) { const int nblk = 32, kb = r / nblk, nb = r % nblk, k0 = 64 * kb, n0 = 32 * nb;
            transpose_item(P.w_o + (size_t)l * 1024 * 1024 + (size_t)k0 * 1024 + n0, 1024, (bf16*)((unsigned char*)WB + WL_O) + (size_t)n0 * 1024 + k0, 1024, scr, lane, false); continue; } r -= I_O;
        if (r < I_F1) { const int nblk = NF1 / 32, kb = r / nblk, nb = r % nblk, k0 = 64 * kb, n0 = 32 * nb; const int tile = n0 >> 8, half = (n0 >> 7) & 1, col = half * FFH + 128 * tile + (n0 & 127);
            transpose_item(P.w_ff_in + (size_t)l * D * NF1 + (size_t)k0 * NF1 + col, NF1, (bf16*)((unsigned char*)WB + WL_F1) + (size_t)n0 * 1024 + k0, 1024, scr, lane, false); continue; } r -= I_F1;
        { const int nblk = 32, kb = r / nblk, nb = r % nblk, k0 = 64 * kb, n0 = 32 * nb;
            transpose_item(P.w_ff_out + (size_t)l * FFH * 1024 + (size_t)k0 * 1024 + n0, 1024, (bf16*)((unsigned char*)WB + WL_F2) + (size_t)n0 * FFH + k0, FFH, scr, lane, false); }
    }
}

__device__ __forceinline__ void stage_wfa(const float* w_in_l, LAS float* wfa, int tid) {
    for (int idx = tid; idx < 8192; idx += NTHR) { const int k = idx >> 3, col = idx & 7; const int j = k >> 8, ln = (k >> 2) & 63, i = k & 3, half = col >> 2, c = col & 3;
        wfa[((((j * 4 + i) * 2 + half) * 64) + ln) * 4 + c] = w_in_l[(size_t)k * NIN + 1536 + col]; }
}
template <bool DO_LN, bool W32, bool WBF, bool DO_FA>
__device__ __forceinline__ void row_pass(const float* src, float* dst32, bf16* dstbf, const float* gam, const float* bet, float* lf, const LAS float* wfa, const float* bfg, int gw, int NGW, int lane, float* stats = nullptr) {
    constexpr int R = 4;
    f32x4 gv[4], bv[4];
    if (DO_LN) {
#pragma unroll
        for (int j = 0; j < 4; ++j) { gv[j] = ((const f32x4*)gam)[64 * j + lane]; bv[j] = ((const f32x4*)bet)[64 * j + lane]; }
    }
    for (int m0 = gw; m0 < M; m0 += R * NGW) {
        f32x4 v[R][4]; int mr[R]; bool ok[R];
#pragma unroll
        for (int r = 0; r < R; ++r) { const int m = m0 + r * NGW; ok[r] = m < M; mr[r] = ok[r] ? m : m0; const f32x4* xr = (const f32x4*)(src + (size_t)mr[r] * D) + lane;
#pragma unroll
            for (int j = 0; j < 4; ++j) v[r][j] = xr[64 * j]; }
        if (DO_LN) {
            float s[R], s2[R], mean[R], rstd[R];
#pragma unroll
            for (int r = 0; r < R; ++r) { s[r] = 0.f;
#pragma unroll
                for (int j = 0; j < 4; ++j) s[r] += (v[r][j].x + v[r][j].y) + (v[r][j].z + v[r][j].w); }
#pragma unroll
            for (int o = 1; o < 64; o <<= 1)
#pragma unroll
                for (int r = 0; r < R; ++r) s[r] += __shfl_xor(s[r], o);
#pragma unroll
            for (int r = 0; r < R; ++r) { mean[r] = s[r] * (1.f / D); s2[r] = 0.f;
#pragma unroll
                for (int j = 0; j < 4; ++j) { v[r][j] = v[r][j] - mean[r]; s2[r] += (v[r][j].x * v[r][j].x + v[r][j].y * v[r][j].y) + (v[r][j].z * v[r][j].z + v[r][j].w * v[r][j].w); } }
#pragma unroll
            for (int o = 1; o < 64; o <<= 1)
#pragma unroll
                for (int r = 0; r < R; ++r) s2[r] += __shfl_xor(s2[r], o);
#pragma unroll
            for (int r = 0; r < R; ++r) { rstd[r] = 1.f / sqrtf(s2[r] * (1.f / D) + LN_EPS);
                if (stats && lane == 0 && ok[r]) { stats[2 * (size_t)mr[r]] = mean[r]; stats[2 * (size_t)mr[r] + 1] = rstd[r]; }
#pragma unroll
                for (int j = 0; j < 4; ++j) v[r][j] = v[r][j] * rstd[r] * gv[j] + bv[j]; }
        }
#pragma unroll
        for (int r = 0; r < R; ++r) { if (!ok[r]) continue; const int m = mr[r];
            if (W32) { f32x4* o = (f32x4*)(dst32 + (size_t)m * D) + lane;
#pragma unroll
                for (int j = 0; j < 4; ++j) o[64 * j] = v[r][j]; }
            if (WBF) { unsigned long long* o8 = (unsigned long long*)(dstbf + (size_t)m * D) + lane;
#pragma unroll
                for (int j = 0; j < 4; ++j) o8[64 * j] = (unsigned long long)pk2(v[r][j].x, v[r][j].y) | ((unsigned long long)pk2(v[r][j].z, v[r][j].w) << 32); } }
        if (DO_FA) {
            float a[R][8];
#pragma unroll
            for (int r = 0; r < R; ++r)
#pragma unroll
                for (int c = 0; c < 8; ++c) a[r][c] = 0.f;
#pragma unroll
            for (int j = 0; j < 4; ++j)
#pragma unroll
                for (int i = 0; i < 4; ++i) {
                    const f32x4 w0 = *(const LAS f32x4*)(wfa + ((((j * 4 + i) * 2 + 0) * 64) + lane) * 4), w1 = *(const LAS f32x4*)(wfa + ((((j * 4 + i) * 2 + 1) * 64) + lane) * 4);
#pragma unroll
                    for (int r = 0; r < R; ++r) { const float xv = v[r][j][i];
                        a[r][0] += xv * w0.x; a[r][1] += xv * w0.y; a[r][2] += xv * w0.z; a[r][3] += xv * w0.w; a[r][4] += xv * w1.x; a[r][5] += xv * w1.y; a[r][6] += xv * w1.z; a[r][7] += xv * w1.w; } }
#pragma unroll
            for (int o = 1; o < 64; o <<= 1)
#pragma unroll
                for (int r = 0; r < R; ++r)
#pragma unroll
                    for (int c = 0; c < 8; ++c) a[r][c] += __shfl_xor(a[r][c], o);
#pragma unroll
            for (int r = 0; r < R; ++r) { float z = a[r][0];
#pragma unroll
                for (int c = 1; c < 8; ++c) z = (lane == c) ? a[r][c] : z;
                if (lane < 8 && ok[r]) { z += bfg[lane]; const float ls = fminf(z, 0.f) - __logf(1.0f + __expf(-fabsf(z))); lf[(size_t)mr[r] * 8 + lane] = ls; } }
        }
    }
}

__device__ __forceinline__ void fcumsum_unit(int bh, const float* LF, float* F, lp lds, int tid) {
    const int b = bh >> 3, h = bh & 7, lane = tid & 63, wave = tid >> 6;
    const float* src = LF + ((size_t)b * SEQ + (size_t)tid * 32) * 8 + h;
    float cs[32]; float run = 0.f;
#pragma unroll
    for (int i = 0; i < 32; ++i) { run += src[i * 8]; cs[i] = run; }
    float inc = run;
#pragma unroll
    for (int o = 1; o < 64; o <<= 1) { const float n = __shfl_up(inc, o); if (lane >= o) inc += n; }
    LAS float* WS = (LAS float*)lds;
    if (lane == 63) WS[wave] = inc;
    __syncthreads();
    float woff = 0.f;
    for (int w = 0; w < wave; ++w) woff += WS[w];
    const float excl = woff + inc - run;
    float* dst = F + (size_t)bh * SEQ + (size_t)tid * 32;
#pragma unroll
    for (int i = 0; i < 32; i += 4) *(f32x4*)(dst + i) = (f32x4){excl + cs[i], excl + cs[i + 1], excl + cs[i + 2], excl + cs[i + 3]};
    __syncthreads();
}

__device__ __forceinline__ void norm_unit(int v, const bf16* QA, const bf16* KA, unsigned* NB, int tid) {
    const int bh = v >> 4, seg = v & 15, b = bh >> 3, h = bh & 7, lane = tid & 63;
    float mq = 0.f, mk = 0.f;
#pragma unroll
    for (int e = 0; e < 2; ++e) { const size_t row = (size_t)b * SEQ + seg * 1024 + tid * 2 + e;
        const v4u* qp = (const v4u*)(QA + row * 512 + h * 64); const v4u* kp = (const v4u*)(KA + row * 512 + h * 64); float sq = 0.f, sk = 0.f;
#pragma unroll
        for (int i = 0; i < 8; ++i) { const v4u a = qp[i], c = kp[i];
#pragma unroll
            for (int k = 0; k < 4; ++k) { const float a0 = __uint_as_float(a[k] << 16), a1 = __uint_as_float(a[k] & 0xffff0000u), c0 = __uint_as_float(c[k] << 16), c1 = __uint_as_float(c[k] & 0xffff0000u);
                sq += a0 * a0 + a1 * a1; sk += c0 * c0 + c1 * c1; } }
        mq = fmaxf(mq, sq); mk = fmaxf(mk, sk); }
#pragma unroll
    for (int o = 1; o < 64; o <<= 1) { mq = fmaxf(mq, __shfl_xor(mq, o)); mk = fmaxf(mk, __shfl_xor(mk, o)); }
    if (lane == 0) { atomicMax(NB + 2 * bh, __float_as_uint(mq * 1.01f)); atomicMax(NB + 2 * bh + 1, __float_as_uint(mk * 1.01f)); }
}

namespace hg {
constexpr int P128 = 136, P64 = 72;
constexpr int O_QP = 0, O_QPP = O_QP + 64 * P128 * 2, O_KP = O_QPP + 64 * P128 * 2, O_VT = O_KP + 64 * P128 * 2, O_ST = O_VT + 128 * P64 * 2, O_PM = O_ST + 128 * P128 * 2,
              O_PT = O_PM + 64 * P64 * 2, O_RS = O_PT + 2048, O_END = O_RS + 512;
constexpr int O_KDT = O_QP;
static_assert(O_END <= 131072 && 128 * P64 * 2 <= 2 * 64 * P128 * 2, "hgrn LDS map");

__device__ __forceinline__ void pass1_loop(int first, int stride, const float* G, const bf16* IB, bf16* ST, float* DEC, lp lds, int tid) {
    const int d = tid & 127, part = tid >> 7, lane = tid & 63, wave = tid >> 6, fr = lane & 15, fq = lane >> 4;
    float g[16]; unsigned short vv[16];
#define P1_LOAD(unit_) do { const int c_ = (unit_) & 255, h_ = ((unit_) >> 8) & 3, b_ = (unit_) >> 10; const size_t r0_ = (size_t)b_ * SEQ + (size_t)c_ * 64 + part * 16; \
        const float* gp_ = G + r0_ * 512 + h_ * 128 + d; const bf16* vp_ = IB + r0_ * 512 + h_ * 128 + d; \
        _Pragma("unroll") for (int i = 0; i < 16; ++i) { g[i] = gp_[(size_t)i * 512]; vv[i] = vp_[(size_t)i * 512]; } } while (0)
    if (first < 2048) P1_LOAD(first);
    for (int unit = first; unit < 2048; unit += stride) {
        float bb[16], blast;
        { float run = 0.f;
#pragma unroll
          for (int i = 0; i < 16; ++i) { run += g[i]; bb[i] = run; }
          LAS float* PT = (LAS float*)(lds + O_PT); PT[part * 128 + d] = run;
          asm volatile("s_waitcnt lgkmcnt(0)\n\ts_barrier" ::: "memory");
          const float p0 = PT[d], p1 = PT[128 + d], p2 = PT[256 + d], p3 = PT[384 + d];
          const float off = (part > 0 ? p0 : 0.f) + (part > 1 ? p1 : 0.f) + (part > 2 ? p2 : 0.f);
#pragma unroll
          for (int i = 0; i < 16; ++i) bb[i] += off;
          blast = (p0 + p1) + (p2 + p3); }
        { unsigned w[8];
#pragma unroll
          for (int i = 0; i < 8; ++i) { const float k0 = (1.0f - __expf(g[2 * i])) * __expf(blast - bb[2 * i]), k1 = (1.0f - __expf(g[2 * i + 1])) * __expf(blast - bb[2 * i + 1]); w[i] = pk2(k0, k1); }
          LAS v4u* dst = (LAS v4u*)(lds + O_KDT + (d * P64 + part * 16) * 2); dst[0] = (v4u){w[0], w[1], w[2], w[3]}; dst[1] = (v4u){w[4], w[5], w[6], w[7]}; }
        { unsigned w[8];
#pragma unroll
          for (int i = 0; i < 8; ++i) w[i] = (unsigned)vv[2 * i] | ((unsigned)vv[2 * i + 1] << 16);
          LAS v4u* dst = (LAS v4u*)(lds + O_VT + (d * P64 + part * 16) * 2); dst[0] = (v4u){w[0], w[1], w[2], w[3]}; dst[1] = (v4u){w[4], w[5], w[6], w[7]}; }
        if (part == 0) DEC[(size_t)unit * 128 + d] = __expf(blast);
        asm volatile("s_waitcnt lgkmcnt(0)\n\ts_barrier" ::: "memory");
        if (unit + stride < 2048) P1_LOAD(unit + stride);
        const bf16x8 a0 = *(const LAS bf16x8*)(lds + O_VT + ((16 * wave + fr) * P64 + 8 * fq) * 2), a1 = *(const LAS bf16x8*)(lds + O_VT + ((16 * wave + fr) * P64 + 32 + 8 * fq) * 2);
        bf16* out = ST + (size_t)unit * 16384;
#pragma unroll
        for (int dt = 0; dt < 8; ++dt) {
            const bf16x8 b0 = *(const LAS bf16x8*)(lds + O_KDT + ((16 * dt + fr) * P64 + 8 * fq) * 2), b1 = *(const LAS bf16x8*)(lds + O_KDT + ((16 * dt + fr) * P64 + 32 + 8 * fq) * 2);
            f32x4 acc = (f32x4){0.f, 0.f, 0.f, 0.f};
            acc = __builtin_amdgcn_mfma_f32_16x16x32_bf16(a0, b0, acc, 0, 0, 0);
            acc = __builtin_amdgcn_mfma_f32_16x16x32_bf16(a1, b1, acc, 0, 0, 0);
#pragma unroll
            for (int r = 0; r < 4; ++r) out[(16 * wave + 4 * fq + r) * 128 + 16 * dt + fr] = (bf16)(pk2(acc[r], 0.f) & 0xffffu);
        }
        asm volatile("s_waitcnt lgkmcnt(0)\n\ts_barrier" ::: "memory");
    }
#undef P1_LOAD
}
__device__ __forceinline__ void pass2_scan(const bf16* STin, bf16* ST, const float* DEC, int gtid, int gthreads) {
    for (int id = gtid; id < 8 * 16384; id += gthreads) {
        const int bh = id >> 14, ed = id & 16383, d = ed & 127;
        bf16* p = ST + (size_t)bh * 256 * 16384 + ed; const bf16* pi = STin + (size_t)bh * 256 * 16384 + ed; const float* dp = DEC + (size_t)bh * 256 * 128 + d;
        float state = 0.f;
        for (int c = 0; c < 256; c += 32) {
            unsigned short u[32]; float dc[32];
#pragma unroll
            for (int i = 0; i < 32; ++i) { u[i] = pi[(size_t)(c + i) * 16384]; dc[i] = dp[(size_t)(c + i) * 128]; }
#pragma unroll
            for (int i = 0; i < 32; ++i) { p[(size_t)(c + i) * 16384] = (bf16)(pk2(state, 0.f) & 0xffffu); state = dc[i] * state + bf2f(u[i]); }
        }
    }
}
struct P3R { float g[16]; unsigned short q[16], v[16]; v4u st[4]; unsigned short gb[4][4]; };
#define P3_LBAR() asm volatile("s_waitcnt lgkmcnt(0)\n\ts_barrier" ::: "memory")
__device__ __forceinline__ void p3_load(int unit, P3R& R, const float* G, const bf16* IB, const bf16* GB, const bf16* ST, const bf16* QB, int tid) {
    const int c = unit & 255, h = (unit >> 8) & 3, b = unit >> 10;
    const int d = tid & 127, part = tid >> 7, lane = tid & 63, wave = tid >> 6, fr = lane & 15, fq = lane >> 4, rb = wave & 3, ch = wave >> 2;
    const size_t row0 = (size_t)b * SEQ + (size_t)c * 64;
    const bf16* sp = ST + (size_t)unit * 16384;
#pragma unroll
    for (int ps = 0; ps < 4; ++ps) { const int idx = ps * NTHR + tid, e = idx >> 4, d8 = (idx & 15) * 8; R.st[ps] = *(const v4u*)(sp + e * 128 + d8); }
    const float* Gu = G + (row0 + part * 16) * 512 + h * 128 + d; const bf16* qp = QB + (row0 + part * 16) * 512 + h * 128 + d; const bf16* vp = IB + (row0 + part * 16) * 512 + h * 128 + d;
#pragma unroll
    for (int i = 0; i < 16; ++i) { R.g[i] = Gu[(size_t)i * 512]; R.q[i] = qp[(size_t)i * 512]; R.v[i] = vp[(size_t)i * 512]; }
#pragma unroll
    for (int r = 0; r < 4; ++r) { const bf16* gbp = GB + (row0 + 16 * rb + 4 * fq + r) * 512 + h * 128 + 64 * ch + fr;
#pragma unroll
        for (int j = 0; j < 4; ++j) R.gb[r][j] = gbp[16 * j]; }
}
__device__ __forceinline__ void pass3_loop(unsigned* ctr, volatile LAS unsigned* slot, const float* G, const bf16* IB, const bf16* GB, const bf16* ST, bf16* QB, const float* normg, lp lds, int tid) {
    const int d = tid & 127, part = tid >> 7, lane = tid & 63, wave = tid >> 6, fr = lane & 15, fq = lane >> 4, rb = wave & 3, ch = wave >> 2;
    if (tid == 0) { slot[0] = __hip_atomic_fetch_add(ctr, 1u, __ATOMIC_RELAXED, __HIP_MEMORY_SCOPE_AGENT); slot[1] = __hip_atomic_fetch_add(ctr, 1u, __ATOMIC_RELAXED, __HIP_MEMORY_SCOPE_AGENT); }
    __syncthreads();
    unsigned n = slot[0], n1 = slot[1];
    __syncthreads();
    P3R R;
    if (n < 2048u) p3_load((int)n, R, G, IB, GB, ST, QB, tid);
    while (n < 2048u) {
        unsigned n2 = 0u; if (tid == 0) n2 = __hip_atomic_fetch_add(ctr, 1u, __ATOMIC_RELAXED, __HIP_MEMORY_SCOPE_AGENT);
        const int unit = (int)n, c = unit & 255, h = (unit >> 8) & 3, b = unit >> 10; const size_t row0 = (size_t)b * SEQ + (size_t)c * 64;
#pragma unroll
        for (int ps = 0; ps < 4; ++ps) { const int idx = ps * NTHR + tid, e = idx >> 4, d8 = (idx & 15) * 8; *(LAS v4u*)(lds + O_ST + (e * P128 + d8) * 2) = R.st[ps]; }
        float bb[16], bmid;
        { float run = 0.f;
#pragma unroll
          for (int i = 0; i < 16; ++i) { run += R.g[i]; bb[i] = run; }
          LAS float* PT = (LAS float*)(lds + O_PT); PT[part * 128 + d] = run;
          P3_LBAR();
          const float p0 = PT[d], p1 = PT[128 + d], p2 = PT[256 + d];
          const float off = (part > 0 ? p0 : 0.f) + (part > 1 ? p1 : 0.f) + (part > 2 ? p2 : 0.f);
#pragma unroll
          for (int i = 0; i < 16; ++i) bb[i] += off;
          bmid = p0 + p1; }
        { const float emid = __expf(bmid); LAS bf16* Qp = (LAS bf16*)(lds + O_QP), *Qpp = (LAS bf16*)(lds + O_QPP), *Kp = (LAS bf16*)(lds + O_KP);
#pragma unroll
          for (int i = 0; i < 16; ++i) { const float q = bf2f(R.q[i]); const float q1 = q * __expf(bb[i] - bmid), q2 = q1 * emid, k1 = (1.0f - __expf(R.g[i])) * __expf(bmid - bb[i]);
              const int t = part * 16 + i; const unsigned w = pk2(q1, q2), w2 = pk2(k1, 0.f);
              Qp[t * P128 + d] = (bf16)(w & 0xffffu); Qpp[t * P128 + d] = (bf16)(w >> 16); Kp[t * P128 + d] = (bf16)(w2 & 0xffffu); } }
        { unsigned w[8];
#pragma unroll
          for (int i = 0; i < 8; ++i) w[i] = (unsigned)R.v[2 * i] | ((unsigned)R.v[2 * i + 1] << 16);
          LAS v4u* dst = (LAS v4u*)(lds + O_VT + (d * P64 + part * 16) * 2); dst[0] = (v4u){w[0], w[1], w[2], w[3]}; dst[1] = (v4u){w[4], w[5], w[6], w[7]}; }
        unsigned short gbv[4][4];
#pragma unroll
        for (int r = 0; r < 4; ++r)
#pragma unroll
            for (int j = 0; j < 4; ++j) gbv[r][j] = R.gb[r][j];
        P3_LBAR();
        if (n1 < 2048u) p3_load((int)n1, R, G, IB, GB, ST, QB, tid);
        { const int ti = wave >> 1; LAS bf16* Pm = (LAS bf16*)(lds + O_PM);
#pragma unroll
          for (int sj2 = 0; sj2 < 2; ++sj2) { const int sj = 2 * (wave & 1) + sj2; f32x4 acc = (f32x4){0.f, 0.f, 0.f, 0.f};
#pragma unroll
              for (int ks = 0; ks < 4; ++ks) { const bf16x8 a = *(const LAS bf16x8*)(lds + O_QP + ((16 * ti + fr) * P128 + 32 * ks + 8 * fq) * 2), bq = *(const LAS bf16x8*)(lds + O_KP + ((16 * sj + fr) * P128 + 32 * ks + 8 * fq) * 2);
                  acc = __builtin_amdgcn_mfma_f32_16x16x32_bf16(a, bq, acc, 0, 0, 0); }
#pragma unroll
              for (int r = 0; r < 4; ++r) { const int t = 16 * ti + 4 * fq + r, s = 16 * sj + fr; const float v = (s <= t) ? acc[r] : 0.f; Pm[t * P64 + s] = (bf16)(pk2(v, 0.f) & 0xffffu); } } }
        P3_LBAR();
        f32x4 o[4];
#pragma unroll
        for (int j = 0; j < 4; ++j) o[j] = (f32x4){0.f, 0.f, 0.f, 0.f};
        { bf16x8 ap[2], aq[4];
#pragma unroll
          for (int ks = 0; ks < 2; ++ks) ap[ks] = *(const LAS bf16x8*)(lds + O_PM + ((16 * rb + fr) * P64 + 32 * ks + 8 * fq) * 2);
#pragma unroll
          for (int ks = 0; ks < 4; ++ks) aq[ks] = *(const LAS bf16x8*)(lds + O_QPP + ((16 * rb + fr) * P128 + 32 * ks + 8 * fq) * 2);
#pragma unroll
          for (int j = 0; j < 4; ++j) { const int e0 = 64 * ch + 16 * j;
#pragma unroll
              for (int ks = 0; ks < 2; ++ks) { const bf16x8 bv = *(const LAS bf16x8*)(lds + O_VT + ((e0 + fr) * P64 + 32 * ks + 8 * fq) * 2); o[j] = __builtin_amdgcn_mfma_f32_16x16x32_bf16(ap[ks], bv, o[j], 0, 0, 0); }
#pragma unroll
              for (int ks = 0; ks < 4; ++ks) { const bf16x8 bs = *(const LAS bf16x8*)(lds + O_ST + ((e0 + fr) * P128 + 32 * ks + 8 * fq) * 2); o[j] = __builtin_amdgcn_mfma_f32_16x16x32_bf16(aq[ks], bs, o[j], 0, 0, 0); } } }
        LAS float* RS = (LAS float*)(lds + O_RS);
#pragma unroll
        for (int r = 0; r < 4; ++r) { float s = 0.f;
#pragma unroll
            for (int j = 0; j < 4; ++j) s += o[j][r] * o[j][r];
            s += __shfl_xor(s, 1); s += __shfl_xor(s, 2); s += __shfl_xor(s, 4); s += __shfl_xor(s, 8);
            if (fr == 0) RS[ch * 64 + 16 * rb + 4 * fq + r] = s; }
        if (tid == 0) slot[0] = n2;
        P3_LBAR();
#pragma unroll
        for (int r = 0; r < 4; ++r) { const int t = 16 * rb + 4 * fq + r; const float rstd = 1.0f / sqrtf((RS[t] + RS[64 + t]) * (1.0f / 128.0f) + RMS_EPS);
            bf16* yp = QB + (row0 + t) * 512 + h * 128 + 64 * ch + fr;
#pragma unroll
            for (int j = 0; j < 4; ++j) { const float y = o[j][r] * rstd * normg[64 * ch + 16 * j + fr] * bf2f(gbv[r][j]); yp[16 * j] = (bf16)(pk2(y, 0.f) & 0xffffu); } }
        const unsigned nn = slot[0];
        P3_LBAR();
        n = n1; n1 = nn;
    }
}
}

#define GSYNC() do { XcdBarrier b_; b_.bar = (unsigned*)(args.ws + WS_CTL); b_.x = xb_xcc_id(); b_.st = (volatile LAS unsigned*)(lds + LDS_TOTAL - 64); xcd_barrier(b_); } while (0)
struct Args { const float* in[14]; float* out; unsigned char* ws; };
#define FRESH_PTR(T, var, expr) T var = (T)(expr); asm volatile("" : "+s"(var))
#define IDS() int tid_ = threadIdx.x; asm volatile("" : "+v"(tid_)); const int tid = tid_, lane = tid & 63, wave = __builtin_amdgcn_readfirstlane(tid >> 6); const int G = gridDim.x, bx = blockIdx.x, vcu = (G % 8 == 0) ? (bx % 8) * (G / 8) + bx / 8 : bx; \
              const int gw = vcu * NWAVES + wave, NGW = G * NWAVES; (void)tid; (void)lane; (void)wave; (void)gw; (void)NGW; (void)vcu; (void)bx
__global__ void __launch_bounds__(NTHR, 2) mega_fwd(Args args) {
    extern __shared__ __attribute__((aligned(16))) unsigned char lds_raw[];
    cg::grid_group grid = cg::this_grid();
    const lp lds = (lp)lds_raw;
    volatile LAS unsigned* xbst = (volatile LAS unsigned*)(lds + LDS_TOTAL - 64);
    if (threadIdx.x < 16) xbst[threadIdx.x] = 0u;
    __syncthreads();
    (void)xcd_barrier_post((unsigned*)(args.ws + WS_CTL), xbst);
    grid.sync();

    { IDS();
      Ptrs P;
      P.x = args.in[0]; P.w_in = args.in[1]; P.b_fgate = args.in[2]; P.lb_logits = args.in[3]; P.norm_g = args.in[4]; P.w_pa = args.in[5]; P.w_pb = args.in[6]; P.w_o = args.in[7];
      P.ln1_g = args.in[8]; P.ln1_b = args.in[9]; P.w_ff_in = args.in[10]; P.w_ff_out = args.in[11]; P.ln2_g = args.in[12]; P.ln2_b = args.in[13]; P.out = args.out; P.ws = args.ws;
      weight_items(P, (LAS float*)(lds + wave * 16384), gw, NGW, lane);
      __syncthreads();
      stage_wfa(P.w_in, (LAS float*)lds, tid);
      __syncthreads();
      row_pass<false, false, true, true>(P.x, nullptr, (bf16*)(P.ws + WS_XN), nullptr, nullptr, (float*)(P.ws + WS_LF), (const LAS float*)lds, P.b_fgate, gw, NGW, lane); }
    GSYNC();

#pragma unroll 1
    for (int l = 0; l < DEPTH; ++l) {
        {
        { IDS(); FRESH_PTR(unsigned char*, ws, args.ws); FRESH_PTR(const float*, lbl, args.in[3]);
          pg8::Gemm g{(const bf16*)(ws + WS_XN), (const bf16*)(ws + WS_W + (size_t)l * WL_STRIDE + WL_IN), M, NP1, D}; pg8::StaticOrder S; S.init(M, NP1, G, bx);
          pg8::EpiInProj E{(bf16*)(ws + WS_QA), (bf16*)(ws + WS_QB), (bf16*)(ws + WS_KA), (bf16*)(ws + WS_VA), (float*)(ws + WS_G), (bf16*)(ws + WS_IB), (bf16*)(ws + WS_GB), lbl, l, attn_body::C2};
          pg8::gemm_phase<pg8::EpiInProj, pg8::StaticOrder, true, true>(lds, g, S, E); }
        }
        GSYNC();
        {
        { IDS(); FRESH_PTR(unsigned char*, ws, args.ws);
          hg::pass1_loop(vcu, G, (const float*)(ws + WS_G), (const bf16*)(ws + WS_IB), (bf16*)(ws + WS_ST), (float*)(ws + WS_DEC), lds, tid);
          __syncthreads();
          for (int u = vcu; u < 16; u += G) fcumsum_unit(u, (const float*)(ws + WS_LF), (float*)(ws + WS_F), lds, tid);
          for (int u = vcu; u < 256; u += G) norm_unit(u, (const bf16*)(ws + WS_QA), (const bf16*)(ws + WS_KA), (unsigned*)(ws + WS_CTL + CTL_NORM) + l * 32, tid); }
        }
        GSYNC();
        { IDS(); FRESH_PTR(unsigned char*, ws, args.ws);
          hg::pass2_scan((const bf16*)(ws + WS_ST), (bf16*)(ws + WS_ST), (const float*)(ws + WS_DEC), vcu * NTHR + tid, G * NTHR); }
        GSYNC();
        { FRESH_PTR(unsigned char*, ws, args.ws);
          const attn_body::AttnTensors AT{(const attn_body::bf16*)(ws + WS_QA), (const attn_body::bf16*)(ws + WS_KA), (const attn_body::bf16*)(ws + WS_VA), (attn_body::bf16*)(ws + WS_QA), (const float*)(ws + WS_F),
                                          (const unsigned*)(ws + WS_CTL + CTL_NORM) + l * 32};
          const attn_body::DynOrder S{(unsigned*)(ws + WS_CTL + CTL_QCTR) + l * 64, (volatile LAS unsigned*)(lds + attn_body::LDS_BYTES + 32)};
          attn_body::attn_phase<attn_body::DynOrder>((char*)lds_raw, AT, S); }
        { IDS(); FRESH_PTR(unsigned char*, ws, args.ws); FRESH_PTR(const float*, ng, args.in[4]);
          volatile LAS unsigned* slot = (volatile LAS unsigned*)(lds + attn_body::LDS_BYTES + 32); unsigned* ctr = (unsigned*)(ws + WS_CTL + CTL_PCTR) + l * 64;
          __syncthreads();
          hg::pass3_loop(ctr, slot, (const float*)(ws + WS_G), (const bf16*)(ws + WS_IB), (const bf16*)(ws + WS_GB), (const bf16*)(ws + WS_ST), (bf16*)(ws + WS_QB), ng + l * 128, lds, tid); }
        GSYNC();
        {
        { IDS(); FRESH_PTR(unsigned char*, ws, args.ws);
          pg8::Gemm g{(const bf16*)(ws + WS_XN), (const bf16*)(ws + WS_W + (size_t)l * WL_STRIDE + WL_G), M, NG, D}; pg8::StaticOrder S; S.init(M, NG, G, bx);
          pg8::EpiGates E{(bf16*)(ws + WS_GATES)};
          pg8::gemm_phase<pg8::EpiGates, pg8::StaticOrder, true, true>(lds, g, S, E); }
        }
        GSYNC();
        {
        { IDS(); FRESH_PTR(unsigned char*, ws, args.ws);
          { pg8::Gemm g{(const bf16*)(ws + WS_QA), (const bf16*)(ws + WS_W + (size_t)l * WL_STRIDE + WL_M), M, D, 512}; pg8::StaticOrder S; S.init(M, D, G, bx);
            pg8::EpiMerge<0> E{(const bf16*)(ws + WS_GATES), (bf16*)(ws + WS_MERGED)};
            pg8::gemm_phase<pg8::EpiMerge<0>, pg8::StaticOrder, true, true>(lds, g, S, E); }
          asm volatile("s_waitcnt vmcnt(0)" ::: "memory"); __syncthreads();
          { pg8::Gemm g{(const bf16*)(ws + WS_QB), (const bf16*)(ws + WS_W + (size_t)l * WL_STRIDE + WL_M + MiB), M, D, 512}; pg8::StaticOrder S; S.init(M, D, G, bx);
            pg8::EpiMerge<1> E{(const bf16*)(ws + WS_GATES), (bf16*)(ws + WS_MERGED)};
            pg8::gemm_phase<pg8::EpiMerge<1>, pg8::StaticOrder, true, true>(lds, g, S, E); } }
        }
        GSYNC();
        { IDS(); FRESH_PTR(unsigned char*, ws, args.ws); FRESH_PTR(const float*, xin, args.in[0]); FRESH_PTR(float*, outp, args.out); const float* xres = (l == 0) ? xin : (const float*)outp;
          pg8::Gemm g{(const bf16*)(ws + WS_MERGED), (const bf16*)(ws + WS_W + (size_t)l * WL_STRIDE + WL_O), M, D, D}; pg8::StaticOrder S; S.init(M, D, G, bx);
          FRESH_PTR(const float*, g2, args.in[12]); FRESH_PTR(const float*, b2, args.in[13]);
          pg8::EpiResid E{xres, outp, ALPHA, (l == 0) ? (const float*)nullptr : (const float*)(ws + WS_CTL + CTL_STATS + 262144), g2 + (l - 1) * D, b2 + (l - 1) * D};
          pg8::gemm_phase<pg8::EpiResid, pg8::StaticOrder, true, true>(lds, g, S, E); }
        GSYNC();
        { IDS(); FRESH_PTR(unsigned char*, ws, args.ws); FRESH_PTR(float*, outp, args.out); FRESH_PTR(const float*, gm, args.in[8]); FRESH_PTR(const float*, bt, args.in[9]);
          row_pass<true, false, true, false>(outp, nullptr, (bf16*)(ws + WS_XN), gm + l * D, bt + l * D, nullptr, nullptr, nullptr, gw, NGW, lane, (float*)(ws + WS_CTL + CTL_STATS + (size_t)l * 524288)); }
        GSYNC();
        {
        { IDS(); FRESH_PTR(unsigned char*, ws, args.ws);
          pg8::Gemm g{(const bf16*)(ws + WS_XN), (const bf16*)(ws + WS_W + (size_t)l * WL_STRIDE + WL_F1), M, NF1, D}; pg8::StaticOrder S; S.init(M, NF1, G, bx);
          pg8::EpiSwiGLU E{(bf16*)(ws + WS_H)};
          pg8::gemm_phase<pg8::EpiSwiGLU, pg8::StaticOrder, true, true>(lds, g, S, E); }
        }
        GSYNC();
        { IDS(); FRESH_PTR(unsigned char*, ws, args.ws); FRESH_PTR(float*, outp, args.out);
          pg8::Gemm g{(const bf16*)(ws + WS_H), (const bf16*)(ws + WS_W + (size_t)l * WL_STRIDE + WL_F2), M, D, FFH}; pg8::StaticOrder S; S.init(M, D, G, bx);
          FRESH_PTR(const float*, g1, args.in[8]); FRESH_PTR(const float*, b1, args.in[9]);
          pg8::EpiResid E{outp, outp, ALPHA, (const float*)(ws + WS_CTL + CTL_STATS + (size_t)l * 524288), g1 + l * D, b1 + l * D};
          pg8::gemm_phase<pg8::EpiResid, pg8::StaticOrder, true, true>(lds, g, S, E); }
        GSYNC();
        { IDS(); FRESH_PTR(unsigned char*, ws, args.ws); FRESH_PTR(float*, outp, args.out); FRESH_PTR(const float*, gm, args.in[12]); FRESH_PTR(const float*, bt, args.in[13]);
          if (l + 1 < DEPTH) {
              FRESH_PTR(const float*, win, args.in[1]); FRESH_PTR(const float*, bfg, args.in[2]);
              stage_wfa(win + (size_t)(l + 1) * D * NIN, (LAS float*)lds, tid);
              __syncthreads();
              row_pass<true, false, true, true>(outp, nullptr, (bf16*)(ws + WS_XN), gm + l * D, bt + l * D, (float*)(ws + WS_LF), (const LAS float*)lds, bfg + (l + 1) * 8, gw, NGW, lane, (float*)(ws + WS_CTL + CTL_STATS + 262144));
          } else {
              row_pass<true, true, false, false>(outp, outp, nullptr, gm + l * D, bt + l * D, nullptr, nullptr, nullptr, gw, NGW, lane);
          } }
        if (l + 1 < DEPTH) GSYNC();
    }
}

extern "C" void kernel_launch(void* const* d_in, const int* in_sizes, int n_in, void* d_out, int out_size, void* d_ws, size_t ws_size, hipStream_t stream) {
    static int grid = 0;
    if (grid == 0) {
        if (n_in != 14 || in_sizes[0] != M * D || out_size != M * D || ws_size < WS_END) { fprintf(stderr, "kernel_launch: unexpected shapes (n_in %d, in0 %d, out %d, ws %zu)\n", n_in, n_in > 0 ? in_sizes[0] : -1, out_size, ws_size); grid = -1; return; }
        int dev = 0, cus = 0, per_cu = 0;
        if (hipGetDevice(&dev) != hipSuccess || hipDeviceGetAttribute(&cus, hipDeviceAttributeMultiprocessorCount, dev) != hipSuccess) { grid = -1; return; }
        if (hipFuncSetAttribute((const void*)mega_fwd, hipFuncAttributeMaxDynamicSharedMemorySize, LDS_TOTAL) != hipSuccess) { fprintf(stderr, "kernel_launch: hipFuncSetAttribute failed\n"); grid = -1; return; }
        if (hipOccupancyMaxActiveBlocksPerMultiprocessor(&per_cu, (const void*)mega_fwd, NTHR, LDS_TOTAL) != hipSuccess || per_cu < 1) { fprintf(stderr, "kernel_launch: occupancy query says %d\n", per_cu); per_cu = 1; }
        (void)hipGetLastError();
        grid = cus * per_cu;
    }
    if (grid < 0) return;
    if (hipMemsetAsync((char*)d_ws + WS_CTL, 0, 65536, stream) != hipSuccess) { fprintf(stderr, "kernel_launch: hipMemsetAsync failed\n"); return; }
    Args a{};
    for (int i = 0; i < 14; ++i) a.in[i] = (const float*)d_in[i];
    a.out = (float*)d_out; a.ws = (unsigned char*)d_ws;
    void* kargs[] = {&a};
    hipError_t e = hipLaunchCooperativeKernel((const void*)mega_fwd, dim3(grid), dim3(NTHR), kargs, LDS_TOTAL, stream);
    if (e != hipSuccess) fprintf(stderr, "kernel_launch: cooperative launch failed: %s (grid %d)\n", hipGetErrorString(e), grid);
}
```

```cpp
#include <hip/hip_runtime.h>
#include <cstdio>
#include <cstdint>
namespace pg8 {
#define PG8_LAS __attribute__((address_space(3)))
typedef unsigned short bf16_t;
typedef short bf16x8 __attribute__((ext_vector_type(8)));
typedef float f32x4 __attribute__((ext_vector_type(4)));
typedef unsigned u32x4 __attribute__((ext_vector_type(4)));
constexpr int BM = 256, BK = 64, HALF = 128, HTB = HALF * BK * 2  , STAGE_BYTES = 8 * HTB, NXCD = 8, WGM = 8;

__host__ __device__ __forceinline__ int lds_byte(int r, int c) { const int st = (r >> 4) * 2 + (c >> 5), rr = r & 15, cc = c & 31, ob = rr * 64 + cc * 2; return st * 1024 + (ob ^ (((ob >> 9) & 1) << 5)); }
__host__ __device__ __forceinline__ void stage_rc(int b, int& R, int& C) { const int st = b / 1024, sb = b % 1024, swz = sb ^ (((sb >> 9) & 1) << 5); R = (st >> 1) * 16 + swz / 64; C = (st & 1) * 32 + (swz % 64) / 2; }
__host__ __device__ __forceinline__ int perm32(int rho) { const int n = rho >> 4, i = rho & 15; return 8 * (i >> 2) + 4 * n + (i & 3); }

struct Unit { int pm, pn; };
struct Gemm { const bf16_t* A; const bf16_t* Bt; int M, N, K; };

struct StaticOrder {
    int nM, nN, nwg, G, c;
    __host__ __device__ void init(int M, int N, int G_, int c_) { nM = M / BM; nN = N / BM; nwg = nM * nN; G = G_; c = c_; }
    __host__ __device__ bool next(int i, Unit& u) const {
        const long L = (long)i * G + c; if (L >= nwg) return false;
        int wgid = (int)L; { const int q = nwg / NXCD, r = nwg % NXCD, xcd = wgid % NXCD, off = wgid / NXCD; wgid = (xcd < r ? xcd * (q + 1) : r * (q + 1) + (xcd - r) * q) + off; }
        const int nig = WGM * nN, gid = wgid / nig, fm = gid * WGM, gsz = (nM - fm) < WGM ? (nM - fm) : WGM;
        u.pm = fm + ((wgid % nig) % gsz); u.pn = (wgid % nig) / gsz; return true;
    }
    __device__ __forceinline__ void a_ready(const Unit&) const {}
    __device__ __forceinline__ void done(const Unit&) const {}
};

typedef float f32x2c_t __attribute__((ext_vector_type(2))); typedef __bf16 bf16x2c_t __attribute__((ext_vector_type(2)));
__device__ __forceinline__ unsigned cvt_pk_bf16(float lo, float hi) { f32x2c_t v = {lo, hi}; bf16x2c_t b = __builtin_convertvector(v, bf16x2c_t); return __builtin_bit_cast(unsigned, b); }
typedef float f32x2 __attribute__((ext_vector_type(2)));
__device__ __forceinline__ f32x2 gelu_pk(f32x2 v) {
    const f32x2 av = __builtin_elementwise_abs(v), d = av * 0.2316418882f + 1.0f;
    f32x2 t; t.x = __builtin_amdgcn_rcpf(d.x); t.y = __builtin_amdgcn_rcpf(d.y);
    f32x2 q = t * 0.5307027145f + (-0.7265760135f); q = q * t + 0.7107068705f; q = q * t + (-0.142248368f); q = q * t + 0.127414796f; q = q * t;
    const f32x2 s = (v * v) * (-0.72134752044f);
    f32x2 e; e.x = __builtin_amdgcn_exp2f(s.x); e.y = __builtin_amdgcn_exp2f(s.y);
    const f32x2 m = v * (q * e), r = v - m;
    f32x2 o; o.x = v.x < 0.f ? m.x : r.x; o.y = v.y < 0.f ? m.y : r.y; return o;
}

template <int ACT  > struct EpiBf16 {
    static constexpr bool PERM = true, AFTER_DRAIN = false; static_assert(ACT == 0 || ACT == 1, "EpiBf16: ACT is 0 (none) or 1 (gelu_pk)");
    bf16_t* O; int ldc; const float* bias; int split_cols; size_t split_stride; float scale0;
    __device__ __forceinline__ void operator()(const f32x4 (&acc)[2][2][4][2], const Unit& u, int wr, int wc, int fr, int fq) const {
        const int row0 = u.pm * BM + wr * 64 + fr; int colt = u.pn * BM; bf16_t* base = O;
        float sc = 1.f; if (split_cols) { const int t = colt / split_cols; base += (size_t)t * split_stride; colt -= t * split_cols; if (t == 0) sc = scale0; }
        const int col0 = colt + wc * 32 + 8 * fq, bcol0 = u.pn * BM + wc * 32 + 8 * fq;
        f32x4 bv[2][2];
#pragma unroll
        for (int bj = 0; bj < 2; ++bj)
#pragma unroll
            for (int n = 0; n < 2; ++n) bv[bj][n] = bias ? *(const f32x4*)(bias + bcol0 + bj * HALF + 4 * n) : (f32x4){0.f, 0.f, 0.f, 0.f};
#pragma unroll
        for (int ai = 0; ai < 2; ++ai)
#pragma unroll
            for (int m = 0; m < 4; ++m) { bf16_t* rowp = base + (size_t)(row0 + ai * HALF + m * 16) * ldc + col0;
#pragma unroll
                for (int bj = 0; bj < 2; ++bj) { f32x4 v0 = acc[ai][bj][m][0] + bv[bj][0], v1 = acc[ai][bj][m][1] + bv[bj][1];
                    if (ACT == 1) { f32x2 a = gelu_pk((f32x2){v0[0], v0[1]}), b = gelu_pk((f32x2){v0[2], v0[3]}), c = gelu_pk((f32x2){v1[0], v1[1]}), d = gelu_pk((f32x2){v1[2], v1[3]});
                        v0 = (f32x4){a.x, a.y, b.x, b.y}; v1 = (f32x4){c.x, c.y, d.x, d.y}; }
                    v0 = v0 * sc; v1 = v1 * sc; u32x4 w; w.x = cvt_pk_bf16(v0[0], v0[1]); w.y = cvt_pk_bf16(v0[2], v0[3]); w.z = cvt_pk_bf16(v1[0], v1[1]); w.w = cvt_pk_bf16(v1[2], v1[3]);
                    *(u32x4*)(rowp + bj * HALF) = w; } }
    }
};

struct PanelStats {
    unsigned* xbuf;
    unsigned* cnt;
    unsigned* tmo;
    int ntn; float eps;
    unsigned code;
    __device__ __forceinline__ bool run(const f32x4 (&v)[2][2][4][2], const Unit& u, int wr, int wc, int fr, int fq, PG8_LAS unsigned char* lds, int wid, int lane) const {
        typedef float f32x2v __attribute__((ext_vector_type(2)));
        PG8_LAS f32x2v* P = (PG8_LAS f32x2v*)lds;
        PG8_LAS f32x2v* S = (PG8_LAS f32x2v*)(lds + 8192);
        PG8_LAS unsigned* flag = (PG8_LAS unsigned*)(lds + 8192 + 2048);
#pragma unroll
        for (int ai = 0; ai < 2; ++ai)
#pragma unroll
            for (int m = 0; m < 4; ++m) {
                float s = 0.f;
#pragma unroll
                for (int bj = 0; bj < 2; ++bj)
#pragma unroll
                    for (int n = 0; n < 2; ++n) { const f32x4 x = v[ai][bj][m][n]; s += (x[0] + x[1]) + (x[2] + x[3]); }
                s += __shfl_xor(s, 16); s += __shfl_xor(s, 32);
                const float mw = s * (1.0f / 64.0f); float q = 0.f;
#pragma unroll
                for (int bj = 0; bj < 2; ++bj)
#pragma unroll
                    for (int n = 0; n < 2; ++n) { const f32x4 d = v[ai][bj][m][n] - mw; q += (d[0] * d[0] + d[1] * d[1]) + (d[2] * d[2] + d[3] * d[3]); }
                q += __shfl_xor(q, 16); q += __shfl_xor(q, 32);
                if (fq == 0) P[(ai * HALF + wr * 64 + m * 16 + fr) * 4 + wc] = (f32x2v){mw, q};
            }
        asm volatile("s_waitcnt lgkmcnt(0)" ::: "memory"); __builtin_amdgcn_s_barrier(); asm volatile("" ::: "memory");
#if defined(BROKEN_EXCHANGE_NO_WAIT)
#warning BROKEN CONTROL BUILD: the row-statistics exchange does not wait; results are wrong by design
        if (blockIdx.x >= 64) { const long long t0_ = clock64(); while (clock64() - t0_ < 60000) __builtin_amdgcn_s_sleep(8); }
#endif
        const int row = wid * 32 + (lane & 31);
        if (lane < 32) {
            const f32x2v a = P[row * 4 + 0], b = P[row * 4 + 1], c = P[row * 4 + 2], d = P[row * 4 + 3];
            const float mt = (a.x + b.x + c.x + d.x) * 0.25f;
            const float da = a.x - mt, db = b.x - mt, dc = c.x - mt, dd = d.x - mt;
            const float m2 = (a.y + b.y) + (c.y + d.y) + 64.0f * ((da * da + db * db) + (dc * dc + dd * dd));
            unsigned long long* slot = (unsigned long long*)xbuf + ((size_t)(u.pm * BM + row) * 4 + u.pn);
            __hip_atomic_store(slot, ((unsigned long long)__float_as_uint(m2) << 32) | __float_as_uint(mt), __ATOMIC_RELAXED, __HIP_MEMORY_SCOPE_AGENT);
        }
        asm volatile("s_waitcnt vmcnt(0)" ::: "memory");
        if (lane == 0) __hip_atomic_fetch_add(cnt + 64 * u.pm, 1u, __ATOMIC_RELAXED, __HIP_MEMORY_SCOPE_AGENT);
        if (wid == 0) {
            bool dead = false; const unsigned long long t0 = __builtin_amdgcn_s_memrealtime(); const unsigned want = 8u * (unsigned)ntn;
            for (;;) {
#if defined(BROKEN_EXCHANGE_NO_WAIT)
                break;
#endif
                if ((unsigned)__builtin_amdgcn_readfirstlane(__hip_atomic_load(cnt + 64 * u.pm, __ATOMIC_RELAXED, __HIP_MEMORY_SCOPE_AGENT)) >= want) break;
                if (__builtin_amdgcn_s_memrealtime() - t0 > 2000000ull) {
                    if (lane == 0) { unsigned expect = 0u; __hip_atomic_compare_exchange_strong(tmo + 1, &expect, code | (unsigned)(u.pm & 0xff), __ATOMIC_RELAXED, __ATOMIC_RELAXED, __HIP_MEMORY_SCOPE_AGENT);
                                     __hip_atomic_store(tmo, 1u, __ATOMIC_RELAXED, __HIP_MEMORY_SCOPE_AGENT); }
                    dead = true; break; }
                __builtin_amdgcn_s_sleep(2);
            }
            __builtin_amdgcn_fence(__ATOMIC_ACQUIRE, "agent");
            if (lane == 0) flag[0] = dead ? 1u : 0u;
        }
        asm volatile("s_waitcnt vmcnt(0) lgkmcnt(0)" ::: "memory"); __builtin_amdgcn_s_barrier(); asm volatile("" ::: "memory");
        const bool bad = flag[0] != 0u;
        if (lane < 32) {
            const unsigned long long* slot = (const unsigned long long*)xbuf + (size_t)(u.pm * BM + row) * 4; float mt[4], m2[4]; float ms = 0.f;
#pragma unroll
            for (int t = 0; t < 4; ++t) { if (t < ntn) { const unsigned long long w = __hip_atomic_load(slot + t, __ATOMIC_RELAXED, __HIP_MEMORY_SCOPE_AGENT); mt[t] = __uint_as_float((unsigned)w); m2[t] = __uint_as_float((unsigned)(w >> 32)); } else { mt[t] = 0.f; m2[t] = 0.f; } ms += mt[t]; }
            const float mean = ms / (float)ntn; float q = 0.f;
#pragma unroll
            for (int t = 0; t < 4; ++t) if (t < ntn) { const float dm = mt[t] - mean; q += m2[t] + 256.0f * dm * dm; }
            S[row] = (f32x2v){mean, 1.0f / sqrtf(q / (256.0f * (float)ntn) + eps)};
        }
        asm volatile("s_waitcnt lgkmcnt(0)" ::: "memory"); __builtin_amdgcn_s_barrier(); asm volatile("" ::: "memory");
        return bad;
    }
};
struct EpiLnRes {
    static constexpr bool PERM = false, AFTER_DRAIN = true;
    const float* base; float* out; int ldc; const float* bias; PanelStats st; unsigned poison;
    __device__ __forceinline__ void fused(f32x4 (&acc)[2][2][4][2], const Unit& u, int wr, int wc, int fr, int fq, PG8_LAS unsigned char* lds, int wid, int lane) const {
        typedef float f32x2v __attribute__((ext_vector_type(2)));
        const PG8_LAS f32x2v* S = (const PG8_LAS f32x2v*)(lds + 8192);
        const int col0 = u.pn * BM + wc * 32 + 4 * fq;
#pragma unroll
        for (int bj = 0; bj < 2; ++bj)
#pragma unroll
            for (int n = 0; n < 2; ++n) { const f32x4 bv = bias ? *(const f32x4*)(bias + col0 + bj * HALF + n * 16) : (f32x4){0.f, 0.f, 0.f, 0.f};
#pragma unroll
                for (int ai = 0; ai < 2; ++ai)
#pragma unroll
                    for (int m = 0; m < 4; ++m) acc[ai][bj][m][n] += bv; }
        f32x4 pre[4][2][2];
#pragma unroll
        for (int m = 0; m < 4; ++m) { const size_t off = (size_t)(u.pm * BM + wr * 64 + m * 16 + fr) * ldc + col0;
#pragma unroll
            for (int bj = 0; bj < 2; ++bj)
#pragma unroll
                for (int n = 0; n < 2; ++n) pre[m][bj][n] = *(const f32x4*)(base + off + bj * HALF + n * 16); }
        const bool bad = st.run(acc, u, wr, wc, fr, fq, lds, wid, lane) || poison != 0u;
        const float qnan = __builtin_nanf("");
#pragma unroll
        for (int ai = 0; ai < 2; ++ai)
#pragma unroll
            for (int m = 0; m < 4; ++m) { const int r = ai * HALF + wr * 64 + m * 16 + fr; const f32x2v sr = S[r]; const size_t off = (size_t)(u.pm * BM + r) * ldc + col0;
#pragma unroll
                for (int bj = 0; bj < 2; ++bj)
#pragma unroll
                    for (int n = 0; n < 2; ++n) { const f32x4 bs = ai == 0 ? pre[m][bj][n] : *(const f32x4*)(base + off + bj * HALF + n * 16); f32x4 o = bs + (acc[ai][bj][m][n] - sr.x) * sr.y;
                        if (bad) o = (f32x4){qnan, qnan, qnan, qnan}; *(f32x4*)(out + off + bj * HALF + n * 16) = o; }
                if (m & 1) asm volatile("" ::: "memory"); }
    }
};
struct EpiLnResLn {
    static constexpr bool PERM = false, AFTER_DRAIN = true;
    const float* base; float* out; bf16_t* xn; int ldc; const float* bias; PanelStats st1, st2; unsigned poison;
    __device__ __forceinline__ void fused(f32x4 (&acc)[2][2][4][2], const Unit& u, int wr, int wc, int fr, int fq, PG8_LAS unsigned char* lds, int wid, int lane) const {
        typedef float f32x2v __attribute__((ext_vector_type(2))); typedef unsigned u32x2v __attribute__((ext_vector_type(2)));
        const PG8_LAS f32x2v* S = (const PG8_LAS f32x2v*)(lds + 8192);
        const int col0 = u.pn * BM + wc * 32 + 4 * fq;
#pragma unroll
        for (int bj = 0; bj < 2; ++bj)
#pragma unroll
            for (int n = 0; n < 2; ++n) { const f32x4 bv = bias ? *(const f32x4*)(bias + col0 + bj * HALF + n * 16) : (f32x4){0.f, 0.f, 0.f, 0.f};
#pragma unroll
                for (int ai = 0; ai < 2; ++ai)
#pragma unroll
                    for (int m = 0; m < 4; ++m) acc[ai][bj][m][n] += bv; }
        bool bad = st1.run(acc, u, wr, wc, fr, fq, lds, wid, lane) || poison != 0u;
        const float qnan = __builtin_nanf("");
#pragma unroll
        for (int ai = 0; ai < 2; ++ai)
#pragma unroll
            for (int m = 0; m < 4; ++m) { const int r = ai * HALF + wr * 64 + m * 16 + fr; const f32x2v sr = S[r]; const size_t off = (size_t)(u.pm * BM + r) * ldc + col0;
#pragma unroll
                for (int bj = 0; bj < 2; ++bj)
#pragma unroll
                    for (int n = 0; n < 2; ++n) { const f32x4 bs = *(const f32x4*)(base + off + bj * HALF + n * 16); acc[ai][bj][m][n] = bs + (acc[ai][bj][m][n] - sr.x) * sr.y; }
                asm volatile("" : "+v"(acc[ai][0][m][0]), "+v"(acc[ai][0][m][1]), "+v"(acc[ai][1][m][0]), "+v"(acc[ai][1][m][1]));
                if (m & 1) asm volatile("" ::: "memory"); }
        const bool bad1 = bad;
        bad = st2.run(acc, u, wr, wc, fr, fq, lds, wid, lane) || bad;
#pragma unroll
        for (int ai = 0; ai < 2; ++ai)
#pragma unroll
            for (int m = 0; m < 4; ++m) { const int r = ai * HALF + wr * 64 + m * 16 + fr; const f32x2v sr = S[r]; const size_t off = (size_t)(u.pm * BM + r) * ldc + col0;
#pragma unroll
                for (int bj = 0; bj < 2; ++bj)
#pragma unroll
                    for (int n = 0; n < 2; ++n) { const f32x4 x1 = acc[ai][bj][m][n]; *(f32x4*)(out + off + bj * HALF + n * 16) = bad1 ? (f32x4){qnan, qnan, qnan, qnan} : x1;
                        const f32x4 o = (x1 - sr.x) * sr.y; u32x2v w; w.x = cvt_pk_bf16(o[0], o[1]); w.y = cvt_pk_bf16(o[2], o[3]);
                        if (bad) { w.x = 0x7fc07fc0u; w.y = 0x7fc07fc0u; } *(u32x2v*)(xn + off + bj * HALF + n * 16) = w; }
                asm volatile("" ::: "memory"); }
    }
};

template <class Epi, class Sched, bool ALIGN_EPI = false, bool SP2 = false>
__device__ __forceinline__ void gemm_phase(PG8_LAS unsigned char* lds, const Gemm g, const Sched& S, const Epi& E) {
    int tid_ = threadIdx.x; asm volatile("" : "+v"(tid_));
    const int tid = tid_, wid = __builtin_amdgcn_readfirstlane(tid >> 6), lane = tid & 63, wr = wid >> 2, wc = wid & 3, fr = lane & 15, fq = lane >> 4;
    const int K = g.K, nt = K / BK;
    unsigned voffA[2], voffB[2];
#pragma unroll
    for (int i = 0; i < 2; ++i) { int R, C; stage_rc(tid * 16 + i * 8192, R, C); const int Rb = Epi::PERM ? ((R & ~31) + perm32(R & 31)) : R;
        voffA[i] = (unsigned)(R * K + C) * 2u; voffB[i] = (unsigned)(Rb * K + C) * 2u; }
    const size_t kstep = (size_t)(BK * 2);
    const size_t hstep = (size_t)HALF * K * 2;
    const size_t tstep = 2 * hstep;
    const unsigned ldsw = (unsigned)wid * 1024u;
    const int aoff = lds_byte(wr * 64 + fr, fq * 8), boff = lds_byte(wc * 32 + fr, fq * 8);
#define PG8_SA(b, h) (((b) * 2 + (h)) * HTB)
#define PG8_SB(b, h) ((4 + (b) * 2 + (h)) * HTB)
#define PG8_STAGE(bufoff, gbase, voff) do { _Pragma("unroll") for (int _i = 0; _i < 2; ++_i) \
        __builtin_amdgcn_global_load_lds((const unsigned*)((const char*)(gbase) + (voff)[_i]), (PG8_LAS unsigned*)(lds + (bufoff) + ldsw + _i * 8192), 16, 0, 0); } while (0)
#define PG8_LDA(dst, b, h) do { _Pragma("unroll") for (int m = 0; m < 4; ++m) _Pragma("unroll") for (int k = 0; k < 2; ++k) dst[m][k] = *(const PG8_LAS bf16x8*)(lds + PG8_SA(b, h) + aoff + m * 2048 + k * 1024); } while (0)
#define PG8_LDB(dst, b, h) do { _Pragma("unroll") for (int n = 0; n < 2; ++n) _Pragma("unroll") for (int k = 0; k < 2; ++k) dst[n][k] = *(const PG8_LAS bf16x8*)(lds + PG8_SB(b, h) + boff + n * 2048 + k * 1024); } while (0)
#define PG8_MMA(ai, bj, At, Bt) do { __builtin_amdgcn_s_setprio(1); _Pragma("unroll") for (int m = 0; m < 4; ++m) _Pragma("unroll") for (int n = 0; n < 2; ++n) _Pragma("unroll") for (int k = 0; k < 2; ++k) \
        acc[ai][bj][m][n] = __builtin_amdgcn_mfma_f32_16x16x32_bf16(Bt[n][k], At[m][k], acc[ai][bj][m][n], 0, 0, 0); __builtin_amdgcn_s_setprio(0); } while (0)
#define PG8_WAIT_V(n) asm volatile("s_waitcnt vmcnt(" #n ")" ::: "memory")
#define PG8_WAIT_L(n) asm volatile("s_waitcnt lgkmcnt(" #n ")" ::: "memory")
#define PG8_BAR __builtin_amdgcn_s_barrier()
#define PG8_SCHED __builtin_amdgcn_sched_barrier(0)
    Unit cur, nxt; int ui = 0;
    if (!S.next(0, cur)) return;
    f32x4 acc[2][2][4][2];
#pragma unroll
    for (int a = 0; a < 2; ++a)
#pragma unroll
        for (int b = 0; b < 2; ++b)
#pragma unroll
            for (int m = 0; m < 4; ++m)
#pragma unroll
                for (int n = 0; n < 2; ++n) acc[a][b][m][n] = (f32x4){0.f, 0.f, 0.f, 0.f};
    bf16x8 At[4][2], B0[2][2], B1[2][2];
    const char* cA = (const char*)g.A + (size_t)cur.pm * tstep; const char* cB = (const char*)g.Bt + (size_t)cur.pn * tstep;
    S.a_ready(cur);
    if constexpr (SP2) {
        PG8_STAGE(PG8_SB(0, 0), cB, voffB); PG8_STAGE(PG8_SB(0, 1), cB + hstep, voffB); PG8_STAGE(PG8_SA(0, 0), cA, voffA); PG8_STAGE(PG8_SA(0, 1), cA + hstep, voffA);
        if (wr == 1) PG8_BAR;
        PG8_WAIT_V(2); PG8_BAR;
        PG8_STAGE(PG8_SB(1, 0), cB + kstep, voffB); PG8_STAGE(PG8_SA(1, 0), cA + kstep, voffA); PG8_STAGE(PG8_SB(1, 1), cB + hstep + kstep, voffB);
        PG8_WAIT_V(6); PG8_BAR;
    } else {
        PG8_STAGE(PG8_SB(0, 0), cB, voffB); PG8_STAGE(PG8_SA(0, 0), cA, voffA); PG8_STAGE(PG8_SB(0, 1), cB + hstep, voffB); PG8_STAGE(PG8_SA(0, 1), cA + hstep, voffA);
        if (wr == 1) PG8_BAR;
        PG8_WAIT_V(4); PG8_BAR;
        PG8_STAGE(PG8_SB(1, 0), cB + kstep, voffB); PG8_STAGE(PG8_SA(1, 0), cA + kstep, voffA); PG8_STAGE(PG8_SB(1, 1), cB + hstep + kstep, voffB);
        PG8_WAIT_V(6); PG8_BAR;
    }
    for (;;) {
        const bool has_next = S.next(ui + 1, nxt);
        const char* nA = has_next ? (const char*)g.A + (size_t)nxt.pm * tstep : cA; const char* nB = has_next ? (const char*)g.Bt + (size_t)nxt.pn * tstep : cB;
        for (int t = 0; t < nt; t += 2) {
            const bool last = (t == nt - 2);
            const char* a1 = cA + (size_t)(t + 1) * kstep;
            const char* a2 = last ? nA : cA + (size_t)(t + 2) * kstep; const char* b2 = last ? nB : cB + (size_t)(t + 2) * kstep;
            const char* a3 = a2 + kstep; const char* b3 = b2 + kstep;
            if (last && has_next) S.a_ready(nxt);
            if constexpr (SP2) {
            PG8_LDB(B0, 0, 0); PG8_LDB(B1, 0, 1); PG8_SCHED; PG8_LDA(At, 0, 0); PG8_STAGE(PG8_SA(1, 1), a1 + hstep, voffA);
            PG8_WAIT_V(8); PG8_WAIT_L(0); PG8_BAR; PG8_MMA(0, 0, At, B0); PG8_MMA(0, 1, At, B1); PG8_BAR; PG8_SCHED;
            PG8_LDA(At, 0, 1); PG8_STAGE(PG8_SB(0, 0), b2, voffB); PG8_STAGE(PG8_SB(0, 1), b2 + hstep, voffB); PG8_STAGE(PG8_SA(0, 0), a2, voffA);
            PG8_WAIT_V(8); PG8_WAIT_L(0); PG8_BAR; PG8_MMA(1, 0, At, B0); PG8_MMA(1, 1, At, B1); PG8_BAR; PG8_SCHED;
            PG8_LDB(B0, 1, 0); PG8_LDB(B1, 1, 1); PG8_SCHED; PG8_LDA(At, 1, 0); PG8_STAGE(PG8_SA(0, 1), a2 + hstep, voffA);
            PG8_WAIT_V(8); PG8_WAIT_L(0); PG8_BAR; PG8_MMA(0, 0, At, B0); PG8_MMA(0, 1, At, B1); PG8_BAR; PG8_SCHED;
            PG8_LDA(At, 1, 1); PG8_STAGE(PG8_SB(1, 0), b3, voffB); PG8_STAGE(PG8_SB(1, 1), b3 + hstep, voffB); PG8_STAGE(PG8_SA(1, 0), a3, voffA);
            PG8_WAIT_V(8); PG8_WAIT_L(0); PG8_BAR; PG8_MMA(1, 0, At, B0); PG8_MMA(1, 1, At, B1); PG8_BAR; PG8_SCHED;
            } else {
            PG8_LDB(B0, 0, 0); PG8_SCHED; PG8_LDA(At, 0, 0); PG8_STAGE(PG8_SA(1, 1), a1 + hstep, voffA);
            PG8_WAIT_L(8); PG8_BAR; PG8_WAIT_L(0); PG8_MMA(0, 0, At, B0); PG8_BAR; PG8_SCHED;
            PG8_LDB(B1, 0, 1); PG8_STAGE(PG8_SB(0, 0), b2, voffB);
            PG8_BAR; PG8_WAIT_L(0); PG8_MMA(0, 1, At, B1); PG8_BAR;
            PG8_LDA(At, 0, 1); PG8_STAGE(PG8_SA(0, 0), a2, voffA);
            PG8_BAR; PG8_WAIT_L(0); PG8_MMA(1, 0, At, B0); PG8_BAR; PG8_SCHED;
            PG8_STAGE(PG8_SB(0, 1), b2 + hstep, voffB);
            PG8_WAIT_V(6); PG8_BAR; PG8_MMA(1, 1, At, B1); PG8_BAR;
            PG8_LDB(B0, 1, 0); PG8_SCHED; PG8_LDA(At, 1, 0); PG8_STAGE(PG8_SA(0, 1), a2 + hstep, voffA);
            PG8_WAIT_L(8); PG8_BAR; PG8_WAIT_L(0); PG8_MMA(0, 0, At, B0); PG8_BAR; PG8_SCHED;
            PG8_LDB(B1, 1, 1); PG8_STAGE(PG8_SB(1, 0), b3, voffB);
            PG8_BAR; PG8_WAIT_L(0); PG8_MMA(0, 1, At, B1); PG8_BAR;
            PG8_LDA(At, 1, 1); PG8_STAGE(PG8_SA(1, 0), a3, voffA);
            PG8_BAR; PG8_WAIT_L(0); PG8_MMA(1, 0, At, B0); PG8_BAR; PG8_SCHED;
            PG8_STAGE(PG8_SB(1, 1), b3 + hstep, voffB);
            PG8_WAIT_V(6); PG8_BAR; PG8_MMA(1, 1, At, B1); PG8_BAR;
            }
        }
        if constexpr (ALIGN_EPI) { if (wr == 0) PG8_BAR; }
        if constexpr (!Epi::AFTER_DRAIN) { E(acc, cur, wr, wc, fr, fq); S.done(cur); }
        if (!has_next) break;
#pragma unroll
        for (int a = 0; a < 2; ++a)
#pragma unroll
            for (int b = 0; b < 2; ++b)
#pragma unroll
                for (int m = 0; m < 4; ++m)
#pragma unroll
                    for (int n = 0; n < 2; ++n) acc[a][b][m][n] = (f32x4){0.f, 0.f, 0.f, 0.f};
        cur = nxt; cA = nA; cB = nB; ++ui;
        if constexpr (ALIGN_EPI) { if (wr == 1) PG8_BAR; }
    }
    PG8_WAIT_V(0);
    if constexpr (!ALIGN_EPI) { if (wr == 0) PG8_BAR; }
    PG8_BAR;
    if constexpr (Epi::AFTER_DRAIN) { E.fused(acc, cur, wr, wc, fr, fq, lds, wid, lane); S.done(cur); }
#undef PG8_SA
#undef PG8_SB
#undef PG8_STAGE
#undef PG8_LDA
#undef PG8_LDB
#undef PG8_MMA
#undef PG8_WAIT_V
#undef PG8_WAIT_L
#undef PG8_BAR
#undef PG8_SCHED
}
}
namespace pg8 {
__device__ __forceinline__ float fsig(float v) { return __builtin_amdgcn_rcpf(1.0f + __builtin_amdgcn_exp2f(-1.4426950408889634f * v)); }
__device__ __forceinline__ float bf_lo(unsigned w) { return __uint_as_float(w << 16); }
__device__ __forceinline__ float bf_hi(unsigned w) { return __uint_as_float(w & 0xffff0000u); }

struct EpiInProj {
    static constexpr bool PERM = true, AFTER_DRAIN = false;
    bf16_t* QA; bf16_t* QB; bf16_t* KA; bf16_t* VA; float* G; bf16_t* IB; bf16_t* GB; unsigned char* GT8; const float* lbl; int layer; float qscale;
    __device__ __forceinline__ void operator()(const f32x4 (&acc)[2][2][4][2], const Unit& u, int wr, int wc, int fr, int fq) const {
        const int type = u.pn >> 1;
        const int ct = (u.pn & 1) * 256 + wc * 32 + 8 * fq;
        const int row0 = u.pm * BM + wr * 64 + fr;
        if (type >= 7) {
            const int gc = (u.pn - 14) * 256 + wc * 32 + 8 * fq;
#pragma unroll
            for (int ai = 0; ai < 2; ++ai)
#pragma unroll
                for (int m = 0; m < 4; ++m) { unsigned char* rowp = GT8 + (size_t)(row0 + ai * HALF + m * 16) * 2048 + gc;
#pragma unroll
                    for (int bj = 0; bj < 2; ++bj) { const f32x4 v0 = acc[ai][bj][m][0], v1 = acc[ai][bj][m][1]; unsigned lo = 0u, hi = 0u;
#pragma unroll
                        for (int j = 0; j < 4; ++j) { lo |= (unsigned)(fsig(v0[j]) * 255.0f + 0.5f) << (8 * j); hi |= (unsigned)(fsig(v1[j]) * 255.0f + 0.5f) << (8 * j); }
                        typedef unsigned u32x2g __attribute__((ext_vector_type(2)));
                        *(u32x2g*)(rowp + bj * HALF) = (u32x2g){lo, hi}; } }
        } else if (type == 4) {
            float lb[2][8];
#pragma unroll
            for (int bj = 0; bj < 2; ++bj)
#pragma unroll
                for (int j = 0; j < 8; ++j) {
                    float v = 0.f;
                    if (layer != 0) { const float l0 = lbl[ct + bj * HALF + j], l1 = lbl[512 + ct + bj * HALF + j]; v = 1.0f / (1.0f + __expf(l0 - l1)); }
                    lb[bj][j] = v;
                }
#pragma unroll
            for (int ai = 0; ai < 2; ++ai)
#pragma unroll
                for (int m = 0; m < 4; ++m) { float* rowp = G + (size_t)(row0 + ai * HALF + m * 16) * 512 + ct;
#pragma unroll
                    for (int bj = 0; bj < 2; ++bj) { f32x4 o0, o1;
#pragma unroll
                        for (int j = 0; j < 4; ++j) {
                            const float f0 = lb[bj][j] + (1.0f - lb[bj][j]) * fsig(acc[ai][bj][m][0][j]);
                            const float f1 = lb[bj][4 + j] + (1.0f - lb[bj][4 + j]) * fsig(acc[ai][bj][m][1][j]);
                            o0[j] = __builtin_amdgcn_logf(f0) * 0.6931471805599453f; o1[j] = __builtin_amdgcn_logf(f1) * 0.6931471805599453f; }
                        *(f32x4*)(rowp + bj * HALF) = o0; *(f32x4*)(rowp + bj * HALF + 4) = o1; } }
        } else {
            bf16_t* base; int ldc = 512, act = 0; float sc = 1.f;
            if (type == 0) { base = QA; sc = qscale; }
            else if (type == 1) base = KA;
            else if (type == 2) base = VA;
            else if (type == 3) { base = QB; act = 1; }
            else if (type == 5) base = IB;
            else { base = GB; act = 2; }
#pragma unroll
            for (int ai = 0; ai < 2; ++ai)
#pragma unroll
                for (int m = 0; m < 4; ++m) { bf16_t* rowp = base + (size_t)(row0 + ai * HALF + m * 16) * ldc + ct;
#pragma unroll
                    for (int bj = 0; bj < 2; ++bj) { f32x4 v0 = acc[ai][bj][m][0], v1 = acc[ai][bj][m][1];
                        if (act != 0) {
#pragma unroll
                            for (int j = 0; j < 4; ++j) { const float s0 = fsig(v0[j]), s1 = fsig(v1[j]); v0[j] = (act == 1) ? v0[j] * s0 : s0; v1[j] = (act == 1) ? v1[j] * s1 : s1; }
                        } else { v0 = v0 * sc; v1 = v1 * sc; }
                        u32x4 w; w.x = cvt_pk_bf16(v0[0], v0[1]); w.y = cvt_pk_bf16(v0[2], v0[3]); w.z = cvt_pk_bf16(v1[0], v1[1]); w.w = cvt_pk_bf16(v1[2], v1[3]);
                        *(u32x4*)(rowp + bj * HALF) = w; } }
        }
    }
};
struct EpiGates {
    static constexpr bool PERM = true, AFTER_DRAIN = false;
    bf16_t* O;
    __device__ __forceinline__ void operator()(const f32x4 (&acc)[2][2][4][2], const Unit& u, int wr, int wc, int fr, int fq) const {
        const int row0 = u.pm * BM + wr * 64 + fr, col0 = u.pn * BM + wc * 32 + 8 * fq;
#pragma unroll
        for (int ai = 0; ai < 2; ++ai)
#pragma unroll
            for (int m = 0; m < 4; ++m) { bf16_t* rowp = O + (size_t)(row0 + ai * HALF + m * 16) * 2048 + col0;
#pragma unroll
                for (int bj = 0; bj < 2; ++bj) { f32x4 v0 = acc[ai][bj][m][0], v1 = acc[ai][bj][m][1];
#pragma unroll
                    for (int j = 0; j < 4; ++j) { v0[j] = fsig(v0[j]); v1[j] = fsig(v1[j]); }
                    u32x4 w; w.x = cvt_pk_bf16(v0[0], v0[1]); w.y = cvt_pk_bf16(v0[2], v0[3]); w.z = cvt_pk_bf16(v1[0], v1[1]); w.w = cvt_pk_bf16(v1[2], v1[3]);
                    *(u32x4*)(rowp + bj * HALF) = w; } }
    }
};
template <int STEP> struct EpiMerge {
    static constexpr bool PERM = true, AFTER_DRAIN = false;
    const unsigned char* GT; bf16_t* O;
    __device__ __forceinline__ void operator()(const f32x4 (&acc)[2][2][4][2], const Unit& u, int wr, int wc, int fr, int fq) const {
        const int row0 = u.pm * BM + wr * 64 + fr, col0 = u.pn * BM + wc * 32 + 8 * fq;
        typedef unsigned u32x2g __attribute__((ext_vector_type(2)));
#pragma unroll
        for (int ai = 0; ai < 2; ++ai) {
            u32x2g gq[4][2]; u32x4 tq[4][2];
#pragma unroll
            for (int m = 0; m < 4; ++m) { const size_t row = (size_t)(row0 + ai * HALF + m * 16);
#pragma unroll
                for (int bj = 0; bj < 2; ++bj) { gq[m][bj] = *(const u32x2g*)(GT + row * 2048 + STEP * 1024 + col0 + bj * HALF);
                    if (STEP == 1) tq[m][bj] = *(const u32x4*)(O + row * 1024 + col0 + bj * HALF); } }
            asm volatile("" ::: "memory");
#pragma unroll
            for (int m = 0; m < 4; ++m) { const size_t row = (size_t)(row0 + ai * HALF + m * 16);
#pragma unroll
                for (int bj = 0; bj < 2; ++bj) { const u32x2g g = gq[m][bj]; constexpr float K = 1.0f / 255.0f;
                    const f32x4 a0 = acc[ai][bj][m][0], a1 = acc[ai][bj][m][1];
                    float o[8] = {(float)(g.x & 255u) * K * a0[0], (float)((g.x >> 8) & 255u) * K * a0[1], (float)((g.x >> 16) & 255u) * K * a0[2], (float)(g.x >> 24) * K * a0[3],
                                  (float)(g.y & 255u) * K * a1[0], (float)((g.y >> 8) & 255u) * K * a1[1], (float)((g.y >> 16) & 255u) * K * a1[2], (float)(g.y >> 24) * K * a1[3]};
                    if (STEP == 1) { const u32x4 t = tq[m][bj];
                        o[0] += bf_lo(t.x); o[1] += bf_hi(t.x); o[2] += bf_lo(t.y); o[3] += bf_hi(t.y); o[4] += bf_lo(t.z); o[5] += bf_hi(t.z); o[6] += bf_lo(t.w); o[7] += bf_hi(t.w); }
                    u32x4 w; w.x = cvt_pk_bf16(o[0], o[1]); w.y = cvt_pk_bf16(o[2], o[3]); w.z = cvt_pk_bf16(o[4], o[5]); w.w = cvt_pk_bf16(o[6], o[7]);
                    *(u32x4*)(O + row * 1024 + col0 + bj * HALF) = w; } }
            asm volatile("" ::: "memory");
        }
    }
};
struct EpiSwiGLU {
    static constexpr bool PERM = true, AFTER_DRAIN = false;
    bf16_t* O;
    __device__ __forceinline__ void operator()(const f32x4 (&acc)[2][2][4][2], const Unit& u, int wr, int wc, int fr, int fq) const {
        const int row0 = u.pm * BM + wr * 64 + fr, col0 = u.pn * HALF + wc * 32 + 8 * fq;
#pragma unroll
        for (int ai = 0; ai < 2; ++ai)
#pragma unroll
            for (int m = 0; m < 4; ++m) { const size_t row = (size_t)(row0 + ai * HALF + m * 16);
                f32x4 v0, v1;
#pragma unroll
                for (int j = 0; j < 4; ++j) { const float g0 = acc[ai][1][m][0][j], g1 = acc[ai][1][m][1][j];
                    v0[j] = g0 * fsig(g0) * acc[ai][0][m][0][j]; v1[j] = g1 * fsig(g1) * acc[ai][0][m][1][j]; }
                u32x4 w; w.x = cvt_pk_bf16(v0[0], v0[1]); w.y = cvt_pk_bf16(v0[2], v0[3]); w.z = cvt_pk_bf16(v1[0], v1[1]); w.w = cvt_pk_bf16(v1[2], v1[3]);
                *(u32x4*)(O + row * 2816 + col0) = w; }
    }
};
struct EpiResid {
    static constexpr bool PERM = false, AFTER_DRAIN = false;
    const float* xres; float* out; float alpha; const float* st; const float* gam; const float* bet;
    __device__ __forceinline__ void operator()(const f32x4 (&acc)[2][2][4][2], const Unit& u, int wr, int wc, int fr, int fq) const {
        const int row0 = u.pm * BM + wr * 64 + fr, col0 = u.pn * BM + wc * 32 + 4 * fq;
        typedef float f32x2e __attribute__((ext_vector_type(2)));
        f32x4 gv[2][2], bv[2][2];
        if (st) {
#pragma unroll
            for (int bj = 0; bj < 2; ++bj)
#pragma unroll
                for (int n = 0; n < 2; ++n) { gv[bj][n] = *(const f32x4*)(gam + col0 + bj * HALF + n * 16); bv[bj][n] = *(const f32x4*)(bet + col0 + bj * HALF + n * 16); }
        }
#pragma unroll
        for (int ai = 0; ai < 2; ++ai)
#pragma unroll
            for (int m = 0; m < 4; ++m) { const size_t row = (size_t)(row0 + ai * HALF + m * 16); const size_t off = row * 1024 + col0;
                f32x2e sr = {0.f, 1.f}; if (st) sr = *(const f32x2e*)(st + 2 * row);
#pragma unroll
                for (int bj = 0; bj < 2; ++bj)
#pragma unroll
                    for (int n = 0; n < 2; ++n) { f32x4 x = *(const f32x4*)(xres + off + bj * HALF + n * 16);
                        if (st) x = (x - sr.x) * sr.y * gv[bj][n] + bv[bj][n];
                        *(f32x4*)(out + off + bj * HALF + n * 16) = x * alpha + acc[ai][bj][m][n]; }
                if (m & 1) asm volatile("" ::: "memory"); }
    }
};
}
#include <hip/hip_bf16.h>
#include <cmath>
namespace attn_body {
using bf16=__hip_bfloat16;
using bf16x8=__attribute__((ext_vector_type(8)))short;
using s16x4=__attribute__((ext_vector_type(4)))short;
using f32x16=__attribute__((ext_vector_type(16)))float;
using u32x4=__attribute__((ext_vector_type(4)))unsigned;
constexpr int BATCH=2,NHEAD=8,SEQ=16384,D=64,QP=512,KP=512;
constexpr int NW=8,QBLK=32,QB=QBLK*NW,KVBLK=64,NQB=SEQ/QB;
constexpr int ATTN_UNIT_ROWS=QB;
__device__ __forceinline__ int crow(int r,int hi){return (r&3)+8*(r>>2)+4*hi;}
#define SBAR() __builtin_amdgcn_sched_barrier(0)
__device__ __forceinline__ void cmask(f32x16&p0,f32x16&p1,int jb,int qrel,int hi){
  const float NEG=-INFINITY; int kb=64*jb+4*hi;
  #pragma unroll
  for(int r=0;r<16;++r){int kv=kb+(r&3)+8*(r>>2); if(kv>qrel)p0[r]=NEG; if(kv+32>qrel)p1[r]=NEG;}
}

constexpr int NSLOT=3, SLOTB=8192;
constexpr int LDS_K=0, LDS_V=NSLOT*SLOTB, LDS_WS=2*NSLOT*SLOTB, LDS_OST=LDS_WS+NW*64*4, LDS_FB=LDS_OST+NW*4096, LDS_BYTES=LDS_FB+SEQ*4;
constexpr float C2=0.125f*1.4426950408889634f;
__device__ __forceinline__ void glds16(const void*gsrc,unsigned lds_dst){unsigned keep;
  asm volatile("s_mov_b32 %0, m0\n\ts_mov_b32 m0, %2\n\ts_nop 0\n\tglobal_load_lds_dwordx4 %1, off\n\ts_mov_b32 m0, %0":"=&s"(keep):"v"(gsrc),"s"(lds_dst):"memory");}
__device__ __forceinline__ float max3f(float a,float b,float c){float r;asm("v_max3_f32 %0, %1, %2, %3":"=v"(r):"v"(a),"v"(b),"v"(c));return r;}
__device__ __forceinline__ float max2f(float a,float b){float r;asm("v_max_f32_e32 %0, %1, %2":"=v"(r):"v"(a),"v"(b));return r;}
__device__ __forceinline__ float fadd_s(float a,float b){float r;asm("v_add_f32_e32 %0, %1, %2":"=v"(r):"v"(a),"v"(b));return r;}
__device__ __forceinline__ float fsub_s(float a,float b){float r;asm("v_sub_f32_e32 %0, %1, %2":"=v"(r):"v"(a),"v"(b));return r;}
typedef float f32x2_t __attribute__((ext_vector_type(2))); typedef __bf16 bf16x2_t __attribute__((ext_vector_type(2)));
__device__ __forceinline__ unsigned cvtpk_s(float lo,float hi){f32x2_t v={lo,hi};bf16x2_t b=__builtin_convertvector(v,bf16x2_t);return __builtin_bit_cast(unsigned,b);}
#define WAIT_BAR(N) asm volatile("s_waitcnt vmcnt(" #N ") lgkmcnt(0)\n\ts_barrier":::"memory")

__device__ __forceinline__ void qkt(f32x16&p0,f32x16&p1,const char*Kslot,const bf16x8*qr,int r32,int hi){
  const char*kb=Kslot+hi*1024+r32*16;
  #pragma unroll
  for(int d0=0;d0<4;++d0){
    const bf16x8 b0=*reinterpret_cast<const bf16x8*>(kb+d0*2048);
    const bf16x8 b1=*reinterpret_cast<const bf16x8*>(kb+d0*2048+512);
    p0=__builtin_amdgcn_mfma_f32_32x32x16_bf16(b0,qr[d0],p0,0,0,0);p1=__builtin_amdgcn_mfma_f32_32x32x16_bf16(b1,qr[d0],p1,0,0,0);}
}
typedef __attribute__((address_space(3))) const char* lds_cptr;
typedef short v4i16_t __attribute__((ext_vector_type(4)));
__device__ __forceinline__ void kload8(bf16x8*kf,lds_cptr kp){
  kf[0]=*(const __attribute__((address_space(3))) bf16x8*)(kp);      kf[1]=*(const __attribute__((address_space(3))) bf16x8*)(kp+512);
  kf[2]=*(const __attribute__((address_space(3))) bf16x8*)(kp+2048); kf[3]=*(const __attribute__((address_space(3))) bf16x8*)(kp+2560);
  kf[4]=*(const __attribute__((address_space(3))) bf16x8*)(kp+4096); kf[5]=*(const __attribute__((address_space(3))) bf16x8*)(kp+4608);
  kf[6]=*(const __attribute__((address_space(3))) bf16x8*)(kp+6144); kf[7]=*(const __attribute__((address_space(3))) bf16x8*)(kp+6656);
}
__device__ __forceinline__ void kload2(bf16x8*kf,lds_cptr kp,int j){ kf[2*j]=*(const __attribute__((address_space(3))) bf16x8*)(kp+j*2048); kf[2*j+1]=*(const __attribute__((address_space(3))) bf16x8*)(kp+j*2048+512); }
__device__ __forceinline__ s16x4 vtr(lds_cptr p){ return __builtin_bit_cast(s16x4,__builtin_amdgcn_ds_read_tr16_b64_v4i16((__attribute__((address_space(3))) v4i16_t*)p)); }
__device__ __forceinline__ float rowmax(const f32x16&p0,const f32x16&p1){
  float a=max3f(p0[0],p0[1],p1[0]),b=max3f(p0[2],p0[3],p1[1]);a=max3f(a,p1[2],p1[3]);
  #pragma unroll
  for(int r=4;r<16;r+=4){a=max3f(a,p0[r],p0[r+1]);b=max3f(b,p0[r+2],p0[r+3]);a=max3f(a,p1[r],p1[r+1]);b=max3f(b,p1[r+2],p1[r+3]);}
  const float m=max2f(a,b);
  auto rr=__builtin_amdgcn_permlane32_swap(__float_as_uint(m),__float_as_uint(m),false,false);
  return max2f(__uint_as_float(rr[0]),__uint_as_float(rr[1]));
}
__device__ __forceinline__ void pv(f32x16*o,int vb,bf16x8 pa0,bf16x8 pa1,bf16x8 pa2,bf16x8 pa3){
  #pragma unroll
  for(int d0=0;d0<2;++d0){s16x4 lo[4],hi[4];
    #pragma unroll
    for(int ks=0;ks<4;++ks){
      asm volatile("ds_read_b64_tr_b16 %0,%1 offset:%c2":"=&v"(lo[ks]):"v"(vb),"i"(d0*4096+ks*1024):"memory");
      asm volatile("ds_read_b64_tr_b16 %0,%1 offset:%c2":"=&v"(hi[ks]):"v"(vb),"i"(d0*4096+ks*1024+512):"memory");}
    asm volatile("s_waitcnt lgkmcnt(0)":::"memory");SBAR();
    #define PK(k) (bf16x8){lo[k][0],lo[k][1],lo[k][2],lo[k][3],hi[k][0],hi[k][1],hi[k][2],hi[k][3]}
    o[d0]=__builtin_amdgcn_mfma_f32_32x32x16_bf16(pa0,PK(0),o[d0],0,0,0);
    o[d0]=__builtin_amdgcn_mfma_f32_32x32x16_bf16(pa1,PK(1),o[d0],0,0,0);
    o[d0]=__builtin_amdgcn_mfma_f32_32x32x16_bf16(pa2,PK(2),o[d0],0,0,0);
    o[d0]=__builtin_amdgcn_mfma_f32_32x32x16_bf16(pa3,PK(3),o[d0],0,0,0);
    #undef PK
  }
}

#ifndef ATTN_STORE16
#define ATTN_STORE16(p,v) (*(u32x4*)(p)=(v))
#endif
template<int THRL> __device__ __forceinline__ void attn_unit(int b,int h,int qb,const bf16*Q,const bf16*__restrict__ K,const bf16*__restrict__ V,bf16*O,const float*__restrict__ Fg,const unsigned*__restrict__ NB,char*shm){
  int tid_=threadIdx.x; asm volatile("":"+v"(tid_));
  const int tid=tid_,lane=tid&63,r32=lane&31,hi=lane>>5; const int wid=__builtin_amdgcn_readfirstlane(tid>>6);
  const long rowbase=(long)b*SEQ; const int q0=qb*QB;
  const bf16*Qw=Q+(rowbase+q0+wid*QBLK)*QP+h*D;
  const bf16*Kh=K+rowbase*KP+h*D,*Vh=V+rowbase*KP+h*D;
  __attribute__((address_space(3))) char* const shm3w=(__attribute__((address_space(3))) char*)shm;
  const unsigned lds0=(unsigned)(uintptr_t)shm;
  float*wsf=(float*)(shm+LDS_WS)+wid*64;
  const bf16*ksrc_=Kh+(long)lane*KP+wid*8;
  const bf16*vsrc_=Vh+(long)(16*(wid&3)+(lane>>2))*KP+(wid>>2)*32+(lane&3)*8;
  const unsigned kdst=lds0+LDS_K+wid*1024, vdst=lds0+LDS_V+wid*1024;
  #define DMA_K(t,slot) glds16(ksrc+(long)(t)*KVBLK*KP,(unsigned)__builtin_amdgcn_readfirstlane(kdst+(slot)))
  #define DMA_V(t,slot) glds16(vsrc+(long)(t)*KVBLK*KP,(unsigned)__builtin_amdgcn_readfirstlane(vdst+(slot)))
  const int vb0=(int)(lds0+LDS_V)+((lane>>4)&1)*32+(lane&3)*8+(4*hi+((lane&15)>>2))*64;
  const char*Kbase=shm+LDS_K; bf16x8 kf[8];
  const lds_cptr shm3=(lds_cptr)shm; const lds_cptr kp0=shm3+LDS_K+hi*1024+r32*16; const lds_cptr vp0=shm3+LDS_V+((lane>>4)&1)*32+(lane&3)*8+(4*hi+((lane&15)>>2))*64;
  const int NT0=(q0+QB)/KVBLK;
  int j0;
  { typedef __attribute__((address_space(3))) unsigned* lds_uptr; const lds_uptr cnt=(lds_uptr)(shm3w+LDS_BYTES+16);
    const float fref=Fg[q0]; const float Bq=__builtin_sqrtf(__uint_as_float(NB[0])*__uint_as_float(NB[1])); const float thr=-(152.0f+2.0f*Bq);
    if(tid==0)*cnt=0u;
    asm volatile("s_waitcnt lgkmcnt(0)\n\ts_barrier":::"memory");
    bool skip=false; if(tid<NT0-4){ skip=((fref-Fg[64*tid+63])*1.4426950408889634f<thr); }
    const unsigned long long bal=__ballot(skip); if(lane==0&&bal)__hip_atomic_fetch_add(cnt,(unsigned)__popcll(bal),__ATOMIC_RELAXED,__HIP_MEMORY_SCOPE_WORKGROUP);
    asm volatile("s_waitcnt lgkmcnt(0)\n\ts_barrier":::"memory");
    j0=(int)(*cnt)&~1; j0=__builtin_amdgcn_readfirstlane(j0);
    typedef __attribute__((address_space(3))) float* lds_fptr; const lds_fptr fbl=(lds_fptr)(shm3w+LDS_FB);
    for(int i=64*j0+tid;i<q0+QB;i+=NW*64) fbl[i]=(fref-Fg[i])*1.4426950408889634f; }
  const int NT=NT0-j0;
  const bf16*ksrc=ksrc_+(long)j0*KVBLK*KP; const bf16*vsrc=vsrc_+(long)j0*KVBLK*KP;
  DMA_K(0,0);DMA_V(0,0);DMA_K(1,SLOTB);
  bf16x8 qr[4];
  #pragma unroll
  for(int d0=0;d0<4;++d0)qr[d0]=*reinterpret_cast<const bf16x8*>(&Qw[(long)r32*QP+d0*16+hi*8]);
  float mhat=0.f,l_reg=0.f;f32x16 o[2];o[0]=f32x16{};o[1]=f32x16{};
  const lds_cptr fb0=(lds_cptr)shm3w+LDS_FB+hi*16+j0*256;
  typedef float f32x4v __attribute__((ext_vector_type(4)));
  #define BLD(P0,P1,t) do{ const lds_cptr fp_=fb0+(t)*256; _Pragma("unroll") for(int j_=0;j_<4;++j_){ \
      const f32x4v a_=*(const __attribute__((address_space(3))) f32x4v*)(fp_+j_*32), b_=*(const __attribute__((address_space(3))) f32x4v*)(fp_+128+j_*32); \
      P0[4*j_]=a_[0];P0[4*j_+1]=a_[1];P0[4*j_+2]=a_[2];P0[4*j_+3]=a_[3]; P1[4*j_]=b_[0];P1[4*j_+1]=b_[1];P1[4*j_+2]=b_[2];P1[4*j_+3]=b_[3]; } }while(0)
  const int qrel=wid*QBLK+r32;
  #define CMASK(P0,P1,t) do{int jb_=(t)-(NT-4); if(jb_>=0)cmask(P0,P1,jb_,qrel,hi);}while(0)
  bool resc=false;
  #define START(P0,P1) do{ const float rm=rowmax(P0,P1); resc=false; mhat=rm; \
    _Pragma("unroll") for(int r=0;r<16;++r)P0[r]=__builtin_amdgcn_exp2f(P0[r]-mhat); }while(0)
  #define RESC() do{ if(resc){ asm volatile("s_waitcnt lgkmcnt(0)":::"memory"); \
      _Pragma("unroll") for(int d_=0;d_<2;++d_) _Pragma("unroll") for(int r=0;r<16;++r)o[d_][r]*=wsf[crow(r,hi)]; } }while(0)
  f32x16 pA0,pA1,pB0,pB1;
  int sl_prev=0,sl_cur=0,sl_next=SLOTB;
  #define ROT() do{sl_prev=sl_cur;sl_cur=sl_next;sl_next=(sl_next==(NSLOT-1)*SLOTB)?0:sl_next+SLOTB;}while(0)
  DMA_K(2,2*SLOTB);
  WAIT_BAR(3);
  BLD(pA0,pA1,0);
  qkt(pA0,pA1,Kbase,qr,r32,hi);asm volatile("s_nop 15\n\ts_nop 7":"+v"(pA0),"+v"(pA1));CMASK(pA0,pA1,0);
  START(pA0,pA1);
  _Pragma("unroll") for(int r=0;r<16;++r)pA1[r]=__builtin_amdgcn_exp2f(pA1[r]-mhat);
  WAIT_BAR(0);
  DMA_K(3,0);DMA_V(1,SLOTB);
  ROT();
  kload8(kf,kp0+sl_cur);
  BLD(pB0,pB1,1);
  WAIT_BAR(2);
  s16x4 vlo[8],vhi[8]; u32x4 pw0,pw1,pw2,pw3;
  #define PKW(P,B) cvtpk_s(P[B],P[B+1])
  #define PAF(k) __builtin_bit_cast(bf16x8,pw##k)
  #define VFR(i) (bf16x8){vlo[i][0],vlo[i][1],vlo[i][2],vlo[i][3],vhi[i][0],vhi[i][1],vhi[i][2],vhi[i][3]}
  #define PIN(x) asm volatile("":"+v"(x))
  #define MX3(a,b,c) __builtin_fmaxf(__builtin_fmaxf((a),(b)),(c))
  #define GAPA(MF,A0,A1,A2,A3,W0,W1,PW) do{ MF; sacc+=A0; sacc+=A1; sacc+=A2; sacc+=A3; PIN(sacc); W0; W1; PIN(PW); SBAR(); }while(0)
  #define EX(v) __builtin_amdgcn_exp2f(v)
  #define GAPB(MF,X,B) do{ MF; X[B]=EX(X[B]-mhat); X[B+1]=EX(X[B+1]-mhat); X[B+2]=EX(X[B+2]-mhat); X[B+3]=EX(X[B+3]-mhat); PIN(X); SBAR(); }while(0)
  #define VRD(i) do{ vlo[i]=vtr(vp_+(((i)>>2)*4096+((i)&3)*1024)); vhi[i]=vtr(vp_+(((i)>>2)*4096+((i)&3)*1024+512)); }while(0)
  #define KRD(G,j) do{ if(G){ kload2(kf,kp0+sl_next,j); SBAR(); } }while(0)
  #define STEP(C0,C1,P0,P1,t,GK,GV,GL) do{ SBAR(); \
    const lds_cptr vp_=vp0+sl_prev; \
    VRD(0); SBAR(); float sacc=(P0[0]+P0[1]); \
    GAPA(C0=__builtin_amdgcn_mfma_f32_32x32x16_bf16(kf[0],qr[0],C0,0,0,0), P0[2],P0[3],P0[4],P0[5],     pw0[0]=PKW(P0,0), pw0[1]=PKW(P0,2), pw0); \
    VRD(4); SBAR(); GAPA(C1=__builtin_amdgcn_mfma_f32_32x32x16_bf16(kf[1],qr[0],C1,0,0,0), P0[6],P0[7],P0[8],P0[9],     pw0[2]=PKW(P0,4), pw0[3]=PKW(P0,6), pw0); \
    VRD(1); SBAR(); GAPA(C0=__builtin_amdgcn_mfma_f32_32x32x16_bf16(kf[2],qr[1],C0,0,0,0),   P0[10],P0[11],P0[12],P0[13], pw1[0]=PKW(P0,8), pw1[1]=PKW(P0,10), pw1); \
    VRD(5); SBAR(); GAPA(C1=__builtin_amdgcn_mfma_f32_32x32x16_bf16(kf[3],qr[1],C1,0,0,0),   P0[14],P0[15],P1[0],P1[1],   pw1[2]=PKW(P0,12),pw1[3]=PKW(P0,14), pw1); \
    VRD(2); SBAR(); GAPA(C0=__builtin_amdgcn_mfma_f32_32x32x16_bf16(kf[4],qr[2],C0,0,0,0),   P1[2],P1[3],P1[4],P1[5],     pw2[0]=PKW(P1,0), pw2[1]=PKW(P1,2), pw2); \
    VRD(6); SBAR(); GAPA(C1=__builtin_amdgcn_mfma_f32_32x32x16_bf16(kf[5],qr[2],C1,0,0,0),   P1[6],P1[7],P1[8],P1[9],     pw2[2]=PKW(P1,4), pw2[3]=PKW(P1,6), pw2); \
    VRD(3); SBAR(); GAPA(C0=__builtin_amdgcn_mfma_f32_32x32x16_bf16(kf[6],qr[3],C0,0,0,0),   P1[10],P1[11],P1[12],P1[13], pw3[0]=PKW(P1,8), pw3[1]=PKW(P1,10), pw3); \
    VRD(7); SBAR(); GAPA(C1=__builtin_amdgcn_mfma_f32_32x32x16_bf16(kf[7],qr[3],C1,0,0,0),   P1[14],P1[15],0.f,0.f,       pw3[2]=PKW(P1,12),pw3[3]=PKW(P1,14), pw3); \
    l_reg+=sacc; \
    if(GK){DMA_K((t)+3,sl_cur);} if(GV){DMA_V((t)+1,sl_next);} \
    CMASK(C0,C1,t); \
    { float a=MX3(C0[0],C0[1],C1[0]),b=MX3(C0[2],C0[3],C1[1]); a=MX3(a,C1[2],C1[3]); \
      _Pragma("unroll") for(int r=4;r<16;r+=4){a=MX3(a,C0[r],C0[r+1]);b=MX3(b,C0[r+2],C0[r+3]);a=MX3(a,C1[r],C1[r+1]);b=MX3(b,C1[r+2],C1[r+3]);} \
      float rm=__builtin_fmaxf(a,b); { auto rr=__builtin_amdgcn_permlane32_swap(__float_as_uint(rm),__float_as_uint(rm),false,false); rm=__builtin_fmaxf(__uint_as_float(rr[0]),__uint_as_float(rr[1])); } \
      rm-=mhat; resc=false; \
      if(__builtin_expect(__any(rm>(float)THRL),0)){ const float dl=__builtin_fmaxf(rm,0.f); mhat+=dl; \
        const float f=__builtin_amdgcn_exp2f(-dl); l_reg*=f; if(hi==0)wsf[r32]=f; resc=true; } } \
    SBAR(); if(GL){ BLD(P0,P1,(t)+1); } \
    SBAR(); \
    GAPB(o[0]=__builtin_amdgcn_mfma_f32_32x32x16_bf16(PAF(0),VFR(0),o[0],0,0,0), C0,0); \
    GAPB(o[1]=__builtin_amdgcn_mfma_f32_32x32x16_bf16(PAF(0),VFR(4),o[1],0,0,0), C0,4); \
    KRD(GL,0); GAPB(o[0]=__builtin_amdgcn_mfma_f32_32x32x16_bf16(PAF(1),VFR(1),o[0],0,0,0), C0,8); \
    KRD(GL,1); GAPB(o[1]=__builtin_amdgcn_mfma_f32_32x32x16_bf16(PAF(1),VFR(5),o[1],0,0,0), C0,12); \
    KRD(GL,2); GAPB(o[0]=__builtin_amdgcn_mfma_f32_32x32x16_bf16(PAF(2),VFR(2),o[0],0,0,0), C1,0); \
    KRD(GL,3); GAPB(o[1]=__builtin_amdgcn_mfma_f32_32x32x16_bf16(PAF(2),VFR(6),o[1],0,0,0), C1,4); \
    GAPB(o[0]=__builtin_amdgcn_mfma_f32_32x32x16_bf16(PAF(3),VFR(3),o[0],0,0,0), C1,8); \
    GAPB(o[1]=__builtin_amdgcn_mfma_f32_32x32x16_bf16(PAF(3),VFR(7),o[1],0,0,0), C1,12); \
    }while(0)
  int t=1;
  #undef CMASK
  #define CMASK(P0,P1,t) do{}while(0)
  for(;t+5<NT;t+=2){
    STEP(pB0,pB1,pA0,pA1,t,true,true,true);     WAIT_BAR(2); RESC(); ROT();
    STEP(pA0,pA1,pB0,pB1,t+1,true,true,true);   WAIT_BAR(2); RESC(); ROT();
  }
  #undef CMASK
  #define CMASK(P0,P1,t) do{int jb_=(t)-(NT-4); if(jb_>=0)cmask(P0,P1,jb_,qrel,hi);}while(0)
  #define ENDW(tt) do{ if((tt)+3<NT){WAIT_BAR(2);} else if((tt)+2<NT){WAIT_BAR(1);} else {WAIT_BAR(0);} }while(0)
  for(;t+1<NT;t+=2){
    STEP(pB0,pB1,pA0,pA1,t,(t+3<NT),(t+1<NT),(t+1<NT));       ENDW(t);   RESC(); ROT();
    STEP(pA0,pA1,pB0,pB1,t+1,(t+4<NT),(t+2<NT),(t+2<NT));     ENDW(t+1); RESC(); ROT();
  }
  STEP(pB0,pB1,pA0,pA1,NT-1,false,false,false); RESC();
  { float sacc=pB0[0]+pB0[1]; _Pragma("unroll") for(int r=2;r<16;++r)sacc+=pB0[r]; _Pragma("unroll") for(int r=0;r<16;++r)sacc+=pB1[r]; l_reg+=sacc;
    pw0=(u32x4){PKW(pB0,0),PKW(pB0,2),PKW(pB0,4),PKW(pB0,6)};pw1=(u32x4){PKW(pB0,8),PKW(pB0,10),PKW(pB0,12),PKW(pB0,14)};pw2=(u32x4){PKW(pB1,0),PKW(pB1,2),PKW(pB1,4),PKW(pB1,6)};pw3=(u32x4){PKW(pB1,8),PKW(pB1,10),PKW(pB1,12),PKW(pB1,14)};
    SBAR(); pv(o,vb0+sl_cur,PAF(0),PAF(1),PAF(2),PAF(3)); }
  #undef PKW
  #undef PAF
  #undef VFR
  #undef PIN
  #undef MX3
  #undef GAPA
  #undef GAPB
  #undef EX
  #undef VRD
  #undef KRD
  #undef STEP
  #undef ENDW
  {auto rr=__builtin_amdgcn_permlane32_swap(__float_as_uint(l_reg),__float_as_uint(l_reg),false,false);l_reg=__uint_as_float(rr[0])+__uint_as_float(rr[1]);}
  if(hi==0)wsf[32+r32]=l_reg;asm volatile("s_waitcnt lgkmcnt(0)":::"memory");
  float rli[16];
  #pragma unroll
  for(int r=0;r<16;++r)rli[r]=__builtin_amdgcn_rcpf(wsf[32+crow(r,hi)]);
  bf16*Ow=O+(rowbase+q0+wid*QBLK)*QP+h*D;
  { bf16*stg=(bf16*)(shm+LDS_OST)+wid*2048;
    #pragma unroll
    for(int r=0;r<16;++r){const int orow=crow(r,hi);
      #pragma unroll
      for(int d0=0;d0<2;++d0)stg[orow*64+d0*32+r32]=__float2bfloat16(o[d0][r]*rli[r]);}
    asm volatile("s_waitcnt lgkmcnt(0)":::"memory");
    #pragma unroll
    for(int i=0;i<4;++i){const int row=i*8+(lane>>3),ch=lane&7; const u32x4 v=*(const u32x4*)(stg+row*64+ch*8); ATTN_STORE16(Ow+(long)row*QP+ch*8,v);} }
  asm volatile("s_waitcnt lgkmcnt(0)\n\ts_barrier":::"memory");
  #undef DMA_K
  #undef DMA_V
  #undef CMASK
  #undef START
  #undef RESC
  #undef BLD
  #undef ROT
}
constexpr int ATTN_LDS_BYTES=LDS_BYTES;
struct AttnTensors { const bf16* Q; const bf16* K; const bf16* V; bf16* O; const float* F; const unsigned* NB; };
struct AttnUnit { int bh; int qb; };
struct DynOrder {
  unsigned* ctr; volatile __attribute__((address_space(3))) unsigned* slot;
  __device__ __forceinline__ bool next(int,AttnUnit&u)const{
    if(threadIdx.x==0)*slot=__hip_atomic_fetch_add(ctr,1u,__ATOMIC_RELAXED,__HIP_MEMORY_SCOPE_AGENT);
    asm volatile("s_waitcnt vmcnt(0) lgkmcnt(0)\n\ts_barrier":::"memory");
    const unsigned n=*slot; if(n>=1024u)return false; u.qb=63-(int)(n>>4); u.bh=(int)(n&15u); return true; }
  __device__ __forceinline__ void a_ready(const AttnUnit&)const{}
  __device__ __forceinline__ void done(const AttnUnit&)const{}
};
template<class Sched,int THRL=8> __device__ __forceinline__ void attn_phase(char*lds,const AttnTensors&T,const Sched&S){
  AttnUnit u;
  for(int i=0;S.next(i,u);++i){ S.a_ready(u); attn_unit<THRL>(u.bh/NHEAD,u.bh%NHEAD,u.qb,T.Q,T.K,T.V,T.O,T.F+(long)u.bh*SEQ,T.NB+2*u.bh,lds); S.done(u); }
}
#undef SBAR
#undef WAIT_BAR
}
#include <hip/hip_cooperative_groups.h>
namespace cg = cooperative_groups;
#define LAS __attribute__((address_space(3)))
typedef unsigned short bf16;
typedef unsigned v4u __attribute__((ext_vector_type(4)));
typedef float f32x4 __attribute__((ext_vector_type(4)));
typedef short bf16x8 __attribute__((ext_vector_type(8)));
typedef LAS unsigned char* lp;

#define XB_TMO      128
#define XB_XCNT(j)  (256  + 64 * (j))
#define XB_XSUB(j)  (1280 + 64 * (j))
#define XB_XGEN(j)  (2304 + 64 * (j))
#define XB_TOP      3328
#define XB_TOPGEN   3392
#define XCD_BAR_WORDS 3456
#define XB_SPIN_CAP (1u << 18)

__device__ __forceinline__ unsigned xb_ld(unsigned* p)              { return __hip_atomic_load(p, __ATOMIC_RELAXED, __HIP_MEMORY_SCOPE_AGENT); }
__device__ __forceinline__ unsigned xb_add(unsigned* p, unsigned v) { return __hip_atomic_fetch_add(p, v, __ATOMIC_RELAXED, __HIP_MEMORY_SCOPE_AGENT); }
__device__ __forceinline__ unsigned xb_xcc_id() { return (unsigned)__builtin_amdgcn_s_getreg((3 << 11) | 20) & 0xFu; }
#define XB_SPIN(cond, bar) do { unsigned _sp = 0; while (cond) { __builtin_amdgcn_s_sleep(1); \
    if ((++_sp & 255u) == 0u) { if (xb_ld(&(bar)[XB_TMO])) break; if (_sp > XB_SPIN_CAP) { atomicAdd(&(bar)[XB_TMO], 1u); break; } } } } while (0)

struct XcdBarrier {
    unsigned* bar; unsigned x;
    volatile LAS unsigned* st;
};

__device__ __forceinline__ XcdBarrier xcd_barrier_post(unsigned* bar, volatile LAS unsigned* st) {
    XcdBarrier b; b.bar = bar; b.x = xb_xcc_id(); b.st = st;
    if (threadIdx.x == 0) (void)xb_add(&bar[XB_XCNT(b.x)], 1u);
    return b;
}
__device__ __forceinline__ void xcd_barrier_complete(unsigned* bar, unsigned x, unsigned& nloc, unsigned& nx) {
    const unsigned G = gridDim.x * gridDim.y * gridDim.z;
    unsigned sum, cnt, mine, sp = 0u;
    for (;;) {
        sum = 0u; cnt = 0u; mine = 0u;
#pragma unroll
        for (unsigned j = 0; j < 16; ++j) { const unsigned c = xb_ld(&bar[XB_XCNT(j)]); sum += c; cnt += (c > 0u) ? 1u : 0u; mine = (j == x) ? c : mine; }
        if (sum == G) break;
        __builtin_amdgcn_s_sleep(1);
        if ((++sp & 255u) == 0u) { if (xb_ld(&bar[XB_TMO])) break; if (sp > XB_SPIN_CAP) { atomicAdd(&bar[XB_TMO], 1u); break; } }
    }
    nloc = mine > 0u ? mine : 1u; nx = cnt > 0u ? cnt : 1u;
}

__device__ __forceinline__ void xcd_barrier(const XcdBarrier& b) {
    asm volatile("s_waitcnt vmcnt(0)" ::: "memory");
    __syncthreads();
    if (threadIdx.x == 0) {
        unsigned* bar = b.bar;
        __builtin_amdgcn_s_waitcnt(0);
        unsigned nloc = b.st[0], nx = b.st[1];
        if (nloc == 0u) { xcd_barrier_complete(bar, b.x, nloc, nx); b.st[0] = nloc; b.st[1] = nx; }
        const unsigned old = xb_add(&bar[XB_XSUB(b.x)], 1u);
        const unsigned gen = old / nloc;
        if (old + 1u == (gen + 1u) * nloc) {
            __builtin_amdgcn_fence(__ATOMIC_RELEASE, "agent");
            asm volatile("s_waitcnt vmcnt(0)" ::: "memory");
            const unsigned og = xb_add(&bar[XB_TOP], 1u);
            const unsigned tg = og / nx;
            if (og + 1u == (tg + 1u) * nx) xb_add(&bar[XB_TOPGEN], 1u);
            else XB_SPIN(xb_ld(&bar[XB_TOPGEN]) == tg, bar);
            __builtin_amdgcn_fence(__ATOMIC_ACQUIRE, "agent");
            xb_add(&bar[XB_XGEN(b.x)], 1u);
            asm volatile("s_waitcnt vmcnt(0)" ::: "memory");
        } else {
            XB_SPIN(xb_ld(&bar[XB_XGEN(b.x)]) == gen, bar);
            __builtin_amdgcn_fence(__ATOMIC_ACQUIRE, "agent");
            asm volatile("s_waitcnt vmcnt(0)" ::: "memory");
        }
    }
    __syncthreads();
}


constexpr int NWAVES = 8, NTHR = 512;
constexpr int BATCH = 2, SEQ = 16384, D = 1024, M = BATCH * SEQ, DEPTH = 2;
constexpr int NIN = 5640, NP1 = 5632  , NG = 2048, FFH = 2816, NF1 = 5632;
constexpr float ALPHA = 1.4142135623730951f;
constexpr float LN_EPS = 1e-5f, RMS_EPS = 1e-6f;
constexpr size_t MiB = 1u << 20;
constexpr size_t WL_IN = 0, WL_G = 7 * MiB, WL_M = 11 * MiB, WL_O = 15 * MiB, WL_F1 = 17 * MiB, WL_F2 = 28 * MiB, WL_STRIDE = 34 * MiB;
constexpr size_t WS_W = 0, WS_XN = 68 * MiB, WS_QA = 132 * MiB, WS_QB = 164 * MiB, WS_KA = 196 * MiB, WS_VA = 228 * MiB, WS_G = 260 * MiB, WS_IB = 324 * MiB, WS_GB = 356 * MiB,
                 WS_GT8 = 388 * MiB  , WS_DEC = 452 * MiB, WS_LF = 453 * MiB, WS_F = 454 * MiB, WS_CTL = 455 * MiB  , WS_DBG = 455 * MiB + 512 * 1024, WS_END = 456 * MiB;
constexpr size_t WS_ST = WS_XN  , WS_MERGED = WS_KA  , WS_H = WS_QA  ;
constexpr size_t CTL_QCTR = 16384  , CTL_PCTR = 18432  , CTL_STATS = 131072  , CTL_NORM = 20480  ;
constexpr int LDS_TOTAL = 155648;
static_assert(attn_body::LDS_BYTES <= LDS_TOTAL && pg8::STAGE_BYTES <= LDS_TOTAL, "LDS map");

__device__ __forceinline__ float wave_sum(float v) {
#pragma unroll
    for (int o = 1; o < 64; o <<= 1) v += __shfl_xor(v, o);
    return v;
}
__device__ __forceinline__ unsigned pk2(float lo, float hi) { return pg8::cvt_pk_bf16(lo, hi); }
__device__ __forceinline__ float bf2f(unsigned short h) { return __uint_as_float((unsigned)h << 16); }

__device__ __forceinline__ void transpose_item(const float* Wsrc, int pitch, bf16* WTdst, int Kdst, LAS float* scr, int lane, bool zero) {
    if (!zero) {
#pragma unroll
        for (int i = 0; i < 32; ++i) { const int kk = 2 * i + (lane >> 5); scr[kk * 33 + (lane & 31)] = Wsrc[(size_t)kk * pitch + (lane & 31)]; }
    }
    asm volatile("s_waitcnt lgkmcnt(0)" ::: "memory");
    const int c = lane & 7;
#pragma unroll
    for (int j = 0; j < 4; ++j) { const int n = (lane >> 3) + 8 * j; const LAS float* s = scr + (8 * c) * 33 + n;
        v4u o;
        if (zero) { o = (v4u){0u, 0u, 0u, 0u}; }
        else { o.x = pk2(s[0 * 33], s[1 * 33]); o.y = pk2(s[2 * 33], s[3 * 33]); o.z = pk2(s[4 * 33], s[5 * 33]); o.w = pk2(s[6 * 33], s[7 * 33]); }
        *(v4u*)(WTdst + (size_t)n * Kdst + 8 * c) = o; }
    asm volatile("s_waitcnt lgkmcnt(0)" ::: "memory");
}

struct Ptrs {
    const float *x, *w_in, *b_fgate, *lb_logits, *norm_g, *w_pa, *w_pb, *w_o, *ln1_g, *ln1_b, *w_ff_in, *w_ff_out, *ln2_g, *ln2_b;
    float* out; unsigned char* ws;
};

__device__ __forceinline__ void weight_items(const Ptrs& P, LAS float* scr, int gw, int NGW, int lane) {
    constexpr int I_IN = 16 * (3584 / 32), I_G = 16 * (NG / 32), I_M = 2 * 8 * 32, I_O = 16 * 32, I_F1 = 16 * (NF1 / 32), I_F2 = (FFH / 64) * 32;
    constexpr int PER_LAYER = I_IN + I_G + I_M + I_O + I_F1 + I_F2;
    for (int it = gw; it < DEPTH * PER_LAYER; it += NGW) {
        const int l = it / PER_LAYER; int r = it % PER_LAYER;
        bf16* WB = (bf16*)(P.ws + WS_W + (size_t)l * WL_STRIDE);
        if (r < I_IN) { const int nblk = 3584 / 32, kb = r / nblk, nb = r % nblk, k0 = 64 * kb, n0 = 32 * nb; const int sc = n0 < 1536 ? n0 : n0 + 8;
            transpose_item(P.w_in + (size_t)l * D * NIN + (size_t)k0 * NIN + sc, NIN, (bf16*)((unsigned char*)WB + WL_IN) + (size_t)n0 * 1024 + k0, 1024, scr, lane, false); continue; } r -= I_IN;
        if (r < I_G) { const int nblk = NG / 32, kb = r / nblk, nb = r % nblk, k0 = 64 * kb, n0 = 32 * nb;
            transpose_item(P.w_in + (size_t)l * D * NIN + (size_t)k0 * NIN + 3592 + n0, NIN, (bf16*)((unsigned char*)WB + WL_G) + (size_t)n0 * 1024 + k0, 1024, scr, lane, false); continue; } r -= I_G;
        if (r < I_M) { const int which = r >> 8, rr = r & 255, kb = rr >> 5, nb = rr & 31, k0 = 64 * kb, n0 = 32 * nb;
            const float* src = (which ? P.w_pb : P.w_pa) + (size_t)l * 512 * 1024 + (size_t)k0 * 1024 + n0;
            transpose_item(src, 1024, (bf16*)((unsigned char*)WB + WL_M + (size_t)which * MiB) + (size_t)n0 * 512 + k0, 512, scr, lane, false); continue; } r -= I_M;
        if (r < I_O) { const int nblk = 32, kb = r / nblk, nb = r % nblk, k0 = 64 * kb, n0 = 32 * nb;
            transpose_item(P.w_o + (size_t)l * 1024 * 1024 + (size_t)k0 * 1024 + n0, 1024, (bf16*)((unsigned char*)WB + WL_O) + (size_t)n0 * 1024 + k0, 1024, scr, lane, false); continue; } r -= I_O;
        if (r < I_F1) { const int nblk = NF1 / 32, kb = r / nblk, nb = r % nblk, k0 = 64 * kb, n0 = 32 * nb; const int tile = n0 >> 8, half = (n0 >> 7) & 1, col = half * FFH + 128 * tile + (n0 & 127);
            transpose_item(P.w_ff_in + (size_t)l * D * NF1 + (size_t)k0 * NF1 + col, NF1, (bf16*)((unsigned char*)WB + WL_F1) + (size_t)n0 * 1024 + k0, 1024, scr, lane, false); continue; } r -= I_F1;
        { const int nblk = 32, kb = r / nblk, nb = r % nblk, k0 = 64 * kb, n0 = 32 * nb;
            transpose_item(P.w_ff_out + (size_t)l * FFH * 1024 + (size_t)k0 * 1024 + n0, 1024, (bf16*)((unsigned char*)WB + WL_F2) + (size_t)n0 * FFH + k0, FFH, scr, lane, false); }
    }
}

__device__ __forceinline__ void stage_wfa(const float* w_in_l, LAS float* wfa, int tid) {
    for (int idx = tid; idx < 8192; idx += NTHR) { const int k = idx >> 3, col = idx & 7; const int j = k >> 8, ln = (k >> 2) & 63, i = k & 3, half = col >> 2, c = col & 3;
        wfa[((((j * 4 + i) * 2 + half) * 64) + ln) * 4 + c] = w_in_l[(size_t)k * NIN + 1536 + col]; }
}
template <bool DO_LN, bool W32, bool WBF, bool DO_FA>
__device__ __forceinline__ void row_pass(const float* src, float* dst32, bf16* dstbf, const float* gam, const float* bet, float* lf, const LAS float* wfa, const float* bfg, int gw, int NGW, int lane, float* stats = nullptr) {
    constexpr int R = 4;
    f32x4 gv[4], bv[4];
    if (DO_LN) {
#pragma unroll
        for (int j = 0; j < 4; ++j) { gv[j] = ((const f32x4*)gam)[64 * j + lane]; bv[j] = ((const f32x4*)bet)[64 * j + lane]; }
    }
    for (int m0 = gw; m0 < M; m0 += R * NGW) {
        f32x4 v[R][4]; int mr[R]; bool ok[R];
#pragma unroll
        for (int r = 0; r < R; ++r) { const int m = m0 + r * NGW; ok[r] = m < M; mr[r] = ok[r] ? m : m0; const f32x4* xr = (const f32x4*)(src + (size_t)mr[r] * D) + lane;
#pragma unroll
            for (int j = 0; j < 4; ++j) v[r][j] = xr[64 * j]; }
        if (DO_LN) {
            float s[R], s2[R], mean[R], rstd[R];
#pragma unroll
            for (int r = 0; r < R; ++r) { s[r] = 0.f;
#pragma unroll
                for (int j = 0; j < 4; ++j) s[r] += (v[r][j].x + v[r][j].y) + (v[r][j].z + v[r][j].w); }
#pragma unroll
            for (int o = 1; o < 64; o <<= 1)
#pragma unroll
                for (int r = 0; r < R; ++r) s[r] += __shfl_xor(s[r], o);
#pragma unroll
            for (int r = 0; r < R; ++r) { mean[r] = s[r] * (1.f / D); s2[r] = 0.f;
#pragma unroll
                for (int j = 0; j < 4; ++j) { v[r][j] = v[r][j] - mean[r]; s2[r] += (v[r][j].x * v[r][j].x + v[r][j].y * v[r][j].y) + (v[r][j].z * v[r][j].z + v[r][j].w * v[r][j].w); } }
#pragma unroll
            for (int o = 1; o < 64; o <<= 1)
#pragma unroll
                for (int r = 0; r < R; ++r) s2[r] += __shfl_xor(s2[r], o);
#pragma unroll
            for (int r = 0; r < R; ++r) { rstd[r] = 1.f / sqrtf(s2[r] * (1.f / D) + LN_EPS);
                if (stats && lane == 0 && ok[r]) { stats[2 * (size_t)mr[r]] = mean[r]; stats[2 * (size_t)mr[r] + 1] = rstd[r]; }
#pragma unroll
                for (int j = 0; j < 4; ++j) v[r][j] = v[r][j] * rstd[r] * gv[j] + bv[j]; }
        }
#pragma unroll
        for (int r = 0; r < R; ++r) { if (!ok[r]) continue; const int m = mr[r];
            if (W32) { f32x4* o = (f32x4*)(dst32 + (size_t)m * D) + lane;
#pragma unroll
                for (int j = 0; j < 4; ++j) o[64 * j] = v[r][j]; }
            if (WBF) { unsigned long long* o8 = (unsigned long long*)(dstbf + (size_t)m * D) + lane;
#pragma unroll
                for (int j = 0; j < 4; ++j) o8[64 * j] = (unsigned long long)pk2(v[r][j].x, v[r][j].y) | ((unsigned long long)pk2(v[r][j].z, v[r][j].w) << 32); } }
        if (DO_FA) {
            float a[R][8];
#pragma unroll
            for (int r = 0; r < R; ++r)
#pragma unroll
                for (int c = 0; c < 8; ++c) a[r][c] = 0.f;
#pragma unroll
            for (int j = 0; j < 4; ++j)
#pragma unroll
                for (int i = 0; i < 4; ++i) {
                    const f32x4 w0 = *(const LAS f32x4*)(wfa + ((((j * 4 + i) * 2 + 0) * 64) + lane) * 4), w1 = *(const LAS f32x4*)(wfa + ((((j * 4 + i) * 2 + 1) * 64) + lane) * 4);
#pragma unroll
                    for (int r = 0; r < R; ++r) { const float xv = v[r][j][i];
                        a[r][0] += xv * w0.x; a[r][1] += xv * w0.y; a[r][2] += xv * w0.z; a[r][3] += xv * w0.w; a[r][4] += xv * w1.x; a[r][5] += xv * w1.y; a[r][6] += xv * w1.z; a[r][7] += xv * w1.w; } }
#pragma unroll
            for (int o = 1; o < 64; o <<= 1)
#pragma unroll
                for (int r = 0; r < R; ++r)
#pragma unroll
                    for (int c = 0; c < 8; ++c) a[r][c] += __shfl_xor(a[r][c], o);
#pragma unroll
            for (int r = 0; r < R; ++r) { float z = a[r][0];
#pragma unroll
                for (int c = 1; c < 8; ++c) z = (lane == c) ? a[r][c] : z;
                if (lane < 8 && ok[r]) { z += bfg[lane]; const float ls = fminf(z, 0.f) - __logf(1.0f + __expf(-fabsf(z))); lf[(size_t)mr[r] * 8 + lane] = ls; } }
        }
    }
}

__device__ __forceinline__ void fcumsum_unit(int bh, const float* LF, float* F, lp lds, int tid) {
    const int b = bh >> 3, h = bh & 7, lane = tid & 63, wave = tid >> 6;
    const float* src = LF + ((size_t)b * SEQ + (size_t)tid * 32) * 8 + h;
    float cs[32]; float run = 0.f;
#pragma unroll
    for (int i = 0; i < 32; ++i) { run += src[i * 8]; cs[i] = run; }
    float inc = run;
#pragma unroll
    for (int o = 1; o < 64; o <<= 1) { const float n = __shfl_up(inc, o); if (lane >= o) inc += n; }
    LAS float* WS = (LAS float*)lds;
    if (lane == 63) WS[wave] = inc;
    __syncthreads();
    float woff = 0.f;
    for (int w = 0; w < wave; ++w) woff += WS[w];
    const float excl = woff + inc - run;
    float* dst = F + (size_t)bh * SEQ + (size_t)tid * 32;
#pragma unroll
    for (int i = 0; i < 32; i += 4) *(f32x4*)(dst + i) = (f32x4){excl + cs[i], excl + cs[i + 1], excl + cs[i + 2], excl + cs[i + 3]};
    __syncthreads();
}

__device__ __forceinline__ void norm_unit(int v, const bf16* QA, const bf16* KA, unsigned* NB, int tid) {
    const int bh = v >> 4, seg = v & 15, b = bh >> 3, h = bh & 7, lane = tid & 63;
    float mq = 0.f, mk = 0.f;
#pragma unroll
    for (int e = 0; e < 2; ++e) { const size_t row = (size_t)b * SEQ + seg * 1024 + tid * 2 + e;
        const v4u* qp = (const v4u*)(QA + row * 512 + h * 64); const v4u* kp = (const v4u*)(KA + row * 512 + h * 64); float sq = 0.f, sk = 0.f;
#pragma unroll
        for (int i = 0; i < 8; ++i) { const v4u a = qp[i], c = kp[i];
#pragma unroll
            for (int k = 0; k < 4; ++k) { const float a0 = __uint_as_float(a[k] << 16), a1 = __uint_as_float(a[k] & 0xffff0000u), c0 = __uint_as_float(c[k] << 16), c1 = __uint_as_float(c[k] & 0xffff0000u);
                sq += a0 * a0 + a1 * a1; sk += c0 * c0 + c1 * c1; } }
        mq = fmaxf(mq, sq); mk = fmaxf(mk, sk); }
#pragma unroll
    for (int o = 1; o < 64; o <<= 1) { mq = fmaxf(mq, __shfl_xor(mq, o)); mk = fmaxf(mk, __shfl_xor(mk, o)); }
    if (lane == 0) { atomicMax(NB + 2 * bh, __float_as_uint(mq * 1.01f)); atomicMax(NB + 2 * bh + 1, __float_as_uint(mk * 1.01f)); }
}

namespace hg {
constexpr int P128 = 136, P64 = 72;
constexpr int O_QP = 0, O_QPP = O_QP + 64 * P128 * 2, O_KP = O_QPP + 64 * P128 * 2, O_VT = O_KP + 64 * P128 * 2, O_ST = O_VT + 128 * P64 * 2, O_PM = O_ST + 128 * P128 * 2,
              O_PT = O_PM + 64 * P64 * 2, O_RS = O_PT + 2048, O_END = O_RS + 512;
constexpr int O_KDT = O_QP;
static_assert(O_END <= 131072 && 128 * P64 * 2 <= 2 * 64 * P128 * 2, "hgrn LDS map");

__device__ __forceinline__ void pass1_loop(int first, int stride, const float* G, const bf16* IB, bf16* ST, float* DEC, lp lds, int tid) {
    const int d = tid & 127, part = tid >> 7, lane = tid & 63, wave = tid >> 6, fr = lane & 15, fq = lane >> 4;
    float g[16]; unsigned short vv[16];
#define P1_LOAD(unit_) do { const int c_ = (unit_) & 255, h_ = ((unit_) >> 8) & 3, b_ = (unit_) >> 10; const size_t r0_ = (size_t)b_ * SEQ + (size_t)c_ * 64 + part * 16; \
        const float* gp_ = G + r0_ * 512 + h_ * 128 + d; const bf16* vp_ = IB + r0_ * 512 + h_ * 128 + d; \
        _Pragma("unroll") for (int i = 0; i < 16; ++i) { g[i] = gp_[(size_t)i * 512]; vv[i] = vp_[(size_t)i * 512]; } } while (0)
    if (first < 2048) P1_LOAD(first);
    for (int unit = first; unit < 2048; unit += stride) {
        float bb[16], blast;
        { float run = 0.f;
#pragma unroll
          for (int i = 0; i < 16; ++i) { run += g[i]; bb[i] = run; }
          LAS float* PT = (LAS float*)(lds + O_PT); PT[part * 128 + d] = run;
          asm volatile("s_waitcnt lgkmcnt(0)\n\ts_barrier" ::: "memory");
          const float p0 = PT[d], p1 = PT[128 + d], p2 = PT[256 + d], p3 = PT[384 + d];
          const float off = (part > 0 ? p0 : 0.f) + (part > 1 ? p1 : 0.f) + (part > 2 ? p2 : 0.f);
#pragma unroll
          for (int i = 0; i < 16; ++i) bb[i] += off;
          blast = (p0 + p1) + (p2 + p3); }
        { unsigned w[8];
#pragma unroll
          for (int i = 0; i < 8; ++i) { const float k0 = (1.0f - __expf(g[2 * i])) * __expf(blast - bb[2 * i]), k1 = (1.0f - __expf(g[2 * i + 1])) * __expf(blast - bb[2 * i + 1]); w[i] = pk2(k0, k1); }
          LAS v4u* dst = (LAS v4u*)(lds + O_KDT + (d * P64 + part * 16) * 2); dst[0] = (v4u){w[0], w[1], w[2], w[3]}; dst[1] = (v4u){w[4], w[5], w[6], w[7]}; }
        { unsigned w[8];
#pragma unroll
          for (int i = 0; i < 8; ++i) w[i] = (unsigned)vv[2 * i] | ((unsigned)vv[2 * i + 1] << 16);
          LAS v4u* dst = (LAS v4u*)(lds + O_VT + (d * P64 + part * 16) * 2); dst[0] = (v4u){w[0], w[1], w[2], w[3]}; dst[1] = (v4u){w[4], w[5], w[6], w[7]}; }
        if (part == 0) DEC[(size_t)unit * 128 + d] = __expf(blast);
        asm volatile("s_waitcnt lgkmcnt(0)\n\ts_barrier" ::: "memory");
        if (unit + stride < 2048) P1_LOAD(unit + stride);
        const bf16x8 a0 = *(const LAS bf16x8*)(lds + O_VT + ((16 * wave + fr) * P64 + 8 * fq) * 2), a1 = *(const LAS bf16x8*)(lds + O_VT + ((16 * wave + fr) * P64 + 32 + 8 * fq) * 2);
        bf16* out = ST + (size_t)unit * 16384;
#pragma unroll
        for (int dt = 0; dt < 8; ++dt) {
            const bf16x8 b0 = *(const LAS bf16x8*)(lds + O_KDT + ((16 * dt + fr) * P64 + 8 * fq) * 2), b1 = *(const LAS bf16x8*)(lds + O_KDT + ((16 * dt + fr) * P64 + 32 + 8 * fq) * 2);
            f32x4 acc = (f32x4){0.f, 0.f, 0.f, 0.f};
            acc = __builtin_amdgcn_mfma_f32_16x16x32_bf16(a0, b0, acc, 0, 0, 0);
            acc = __builtin_amdgcn_mfma_f32_16x16x32_bf16(a1, b1, acc, 0, 0, 0);
#pragma unroll
            for (int r = 0; r < 4; ++r) out[(16 * wave + 4 * fq + r) * 128 + 16 * dt + fr] = (bf16)(pk2(acc[r], 0.f) & 0xffffu);
        }
        asm volatile("s_waitcnt lgkmcnt(0)\n\ts_barrier" ::: "memory");
    }
#undef P1_LOAD
}
__device__ __forceinline__ void pass2_scan(const bf16* STin, bf16* ST, const float* DEC, int gtid, int gthreads) {
    for (int id = gtid; id < 8 * 16384; id += gthreads) {
        const int bh = id >> 14, ed = id & 16383, d = ed & 127;
        bf16* p = ST + (size_t)bh * 256 * 16384 + ed; const bf16* pi = STin + (size_t)bh * 256 * 16384 + ed; const float* dp = DEC + (size_t)bh * 256 * 128 + d;
        float state = 0.f;
        for (int c = 0; c < 256; c += 32) {
            unsigned short u[32]; float dc[32];
#pragma unroll
            for (int i = 0; i < 32; ++i) { u[i] = pi[(size_t)(c + i) * 16384]; dc[i] = dp[(size_t)(c + i) * 128]; }
#pragma unroll
            for (int i = 0; i < 32; ++i) { p[(size_t)(c + i) * 16384] = (bf16)(pk2(state, 0.f) & 0xffffu); state = dc[i] * state + bf2f(u[i]); }
        }
    }
}
struct P3R { float g[16]; unsigned short q[16], v[16]; v4u st[4]; unsigned short gb[4][4]; };
#define P3_LBAR() asm volatile("s_waitcnt lgkmcnt(0)\n\ts_barrier" ::: "memory")
__device__ __forceinline__ void p3_load(int unit, P3R& R, const float* G, const bf16* IB, const bf16* GB, const bf16* ST, const bf16* QB, int tid) {
    const int c = unit & 255, h = (unit >> 8) & 3, b = unit >> 10;
    const int d = tid & 127, part = tid >> 7, lane = tid & 63, wave = tid >> 6, fr = lane & 15, fq = lane >> 4, rb = wave & 3, ch = wave >> 2;
    const size_t row0 = (size_t)b * SEQ + (size_t)c * 64;
    const bf16* sp = ST + (size_t)unit * 16384;
#pragma unroll
    for (int ps = 0; ps < 4; ++ps) { const int idx = ps * NTHR + tid, e = idx >> 4, d8 = (idx & 15) * 8; R.st[ps] = *(const v4u*)(sp + e * 128 + d8); }
    const float* Gu = G + (row0 + part * 16) * 512 + h * 128 + d; const bf16* qp = QB + (row0 + part * 16) * 512 + h * 128 + d; const bf16* vp = IB + (row0 + part * 16) * 512 + h * 128 + d;
#pragma unroll
    for (int i = 0; i < 16; ++i) { R.g[i] = Gu[(size_t)i * 512]; R.q[i] = qp[(size_t)i * 512]; R.v[i] = vp[(size_t)i * 512]; }
#pragma unroll
    for (int r = 0; r < 4; ++r) { const bf16* gbp = GB + (row0 + 16 * rb + 4 * fq + r) * 512 + h * 128 + 64 * ch + fr;
#pragma unroll
        for (int j = 0; j < 4; ++j) R.gb[r][j] = gbp[16 * j]; }
}
__device__ __forceinline__ void pass3_loop(unsigned* ctr, volatile LAS unsigned* slot, const float* G, const bf16* IB, const bf16* GB, const bf16* ST, bf16* QB, const float* normg, lp lds, int tid) {
    const int d = tid & 127, part = tid >> 7, lane = tid & 63, wave = tid >> 6, fr = lane & 15, fq = lane >> 4, rb = wave & 3, ch = wave >> 2;
    if (tid == 0) { slot[0] = __hip_atomic_fetch_add(ctr, 1u, __ATOMIC_RELAXED, __HIP_MEMORY_SCOPE_AGENT); slot[1] = __hip_atomic_fetch_add(ctr, 1u, __ATOMIC_RELAXED, __HIP_MEMORY_SCOPE_AGENT); }
    __syncthreads();
    unsigned n = slot[0], n1 = slot[1];
    __syncthreads();
    P3R R;
    if (n < 2048u) p3_load((int)n, R, G, IB, GB, ST, QB, tid);
    while (n < 2048u) {
        unsigned n2 = 0u; if (tid == 0) n2 = __hip_atomic_fetch_add(ctr, 1u, __ATOMIC_RELAXED, __HIP_MEMORY_SCOPE_AGENT);
        const int unit = (int)n, c = unit & 255, h = (unit >> 8) & 3, b = unit >> 10; const size_t row0 = (size_t)b * SEQ + (size_t)c * 64;
#pragma unroll
        for (int ps = 0; ps < 4; ++ps) { const int idx = ps * NTHR + tid, e = idx >> 4, d8 = (idx & 15) * 8; *(LAS v4u*)(lds + O_ST + (e * P128 + d8) * 2) = R.st[ps]; }
        float bb[16], bmid;
        { float run = 0.f;
#pragma unroll
          for (int i = 0; i < 16; ++i) { run += R.g[i]; bb[i] = run; }
          LAS float* PT = (LAS float*)(lds + O_PT); PT[part * 128 + d] = run;
          P3_LBAR();
          const float p0 = PT[d], p1 = PT[128 + d], p2 = PT[256 + d];
          const float off = (part > 0 ? p0 : 0.f) + (part > 1 ? p1 : 0.f) + (part > 2 ? p2 : 0.f);
#pragma unroll
          for (int i = 0; i < 16; ++i) bb[i] += off;
          bmid = p0 + p1; }
        { const float emid = __expf(bmid); LAS bf16* Qp = (LAS bf16*)(lds + O_QP), *Qpp = (LAS bf16*)(lds + O_QPP), *Kp = (LAS bf16*)(lds + O_KP);
#pragma unroll
          for (int i = 0; i < 16; ++i) { const float q = bf2f(R.q[i]); const float q1 = q * __expf(bb[i] - bmid), q2 = q1 * emid, k1 = (1.0f - __expf(R.g[i])) * __expf(bmid - bb[i]);
              const int t = part * 16 + i; const unsigned w = pk2(q1, q2), w2 = pk2(k1, 0.f);
              Qp[t * P128 + d] = (bf16)(w & 0xffffu); Qpp[t * P128 + d] = (bf16)(w >> 16); Kp[t * P128 + d] = (bf16)(w2 & 0xffffu); } }
        { unsigned w[8];
#pragma unroll
          for (int i = 0; i < 8; ++i) w[i] = (unsigned)R.v[2 * i] | ((unsigned)R.v[2 * i + 1] << 16);
          LAS v4u* dst = (LAS v4u*)(lds + O_VT + (d * P64 + part * 16) * 2); dst[0] = (v4u){w[0], w[1], w[2], w[3]}; dst[1] = (v4u){w[4], w[5], w[6], w[7]}; }
        unsigned short gbv[4][4];
#pragma unroll
        for (int r = 0; r < 4; ++r)
#pragma unroll
            for (int j = 0; j < 4; ++j) gbv[r][j] = R.gb[r][j];
        P3_LBAR();
        if (n1 < 2048u) p3_load((int)n1, R, G, IB, GB, ST, QB, tid);
        { const int ti = wave >> 1; LAS bf16* Pm = (LAS bf16*)(lds + O_PM);
#pragma unroll
          for (int sj2 = 0; sj2 < 2; ++sj2) { const int sj = 2 * (wave & 1) + sj2; f32x4 acc = (f32x4){0.f, 0.f, 0.f, 0.f};
#pragma unroll
              for (int ks = 0; ks < 4; ++ks) { const bf16x8 a = *(const LAS bf16x8*)(lds + O_QP + ((16 * ti + fr) * P128 + 32 * ks + 8 * fq) * 2), bq = *(const LAS bf16x8*)(lds + O_KP + ((16 * sj + fr) * P128 + 32 * ks + 8 * fq) * 2);
                  acc = __builtin_amdgcn_mfma_f32_16x16x32_bf16(a, bq, acc, 0, 0, 0); }
#pragma unroll
              for (int r = 0; r < 4; ++r) { const int t = 16 * ti + 4 * fq + r, s = 16 * sj + fr; const float v = (s <= t) ? acc[r] : 0.f; Pm[t * P64 + s] = (bf16)(pk2(v, 0.f) & 0xffffu); } } }
        P3_LBAR();
        f32x4 o[4];
#pragma unroll
        for (int j = 0; j < 4; ++j) o[j] = (f32x4){0.f, 0.f, 0.f, 0.f};
        { bf16x8 ap[2], aq[4];
#pragma unroll
          for (int ks = 0; ks < 2; ++ks) ap[ks] = *(const LAS bf16x8*)(lds + O_PM + ((16 * rb + fr) * P64 + 32 * ks + 8 * fq) * 2);
#pragma unroll
          for (int ks = 0; ks < 4; ++ks) aq[ks] = *(const LAS bf16x8*)(lds + O_QPP + ((16 * rb + fr) * P128 + 32 * ks + 8 * fq) * 2);
#pragma unroll
          for (int j = 0; j < 4; ++j) { const int e0 = 64 * ch + 16 * j;
#pragma unroll
              for (int ks = 0; ks < 2; ++ks) { const bf16x8 bv = *(const LAS bf16x8*)(lds + O_VT + ((e0 + fr) * P64 + 32 * ks + 8 * fq) * 2); o[j] = __builtin_amdgcn_mfma_f32_16x16x32_bf16(ap[ks], bv, o[j], 0, 0, 0); }
#pragma unroll
              for (int ks = 0; ks < 4; ++ks) { const bf16x8 bs = *(const LAS bf16x8*)(lds + O_ST + ((e0 + fr) * P128 + 32 * ks + 8 * fq) * 2); o[j] = __builtin_amdgcn_mfma_f32_16x16x32_bf16(aq[ks], bs, o[j], 0, 0, 0); } } }
        LAS float* RS = (LAS float*)(lds + O_RS);
#pragma unroll
        for (int r = 0; r < 4; ++r) { float s = 0.f;
#pragma unroll
            for (int j = 0; j < 4; ++j) s += o[j][r] * o[j][r];
            s += __shfl_xor(s, 1); s += __shfl_xor(s, 2); s += __shfl_xor(s, 4); s += __shfl_xor(s, 8);
            if (fr == 0) RS[ch * 64 + 16 * rb + 4 * fq + r] = s; }
        if (tid == 0) slot[0] = n2;
        P3_LBAR();
#pragma unroll
        for (int r = 0; r < 4; ++r) { const int t = 16 * rb + 4 * fq + r; const float rstd = 1.0f / sqrtf((RS[t] + RS[64 + t]) * (1.0f / 128.0f) + RMS_EPS);
            bf16* yp = QB + (row0 + t) * 512 + h * 128 + 64 * ch + fr;
#pragma unroll
            for (int j = 0; j < 4; ++j) { const float y = o[j][r] * rstd * normg[64 * ch + 16 * j + fr] * bf2f(gbv[r][j]); yp[16 * j] = (bf16)(pk2(y, 0.f) & 0xffffu); } }
        const unsigned nn = slot[0];
        P3_LBAR();
        n = n1; n1 = nn;
    }
}
}

#define GSYNC() do { XcdBarrier b_; b_.bar = (unsigned*)(args.ws + WS_CTL); b_.x = xb_xcc_id(); b_.st = (volatile LAS unsigned*)(lds + LDS_TOTAL - 64); xcd_barrier(b_); } while (0)
struct Args { const float* in[14]; float* out; unsigned char* ws; };
#define FRESH_PTR(T, var, expr) T var = (T)(expr); asm volatile("" : "+s"(var))
#define IDS() int tid_ = threadIdx.x; asm volatile("" : "+v"(tid_)); const int tid = tid_, lane = tid & 63, wave = __builtin_amdgcn_readfirstlane(tid >> 6); const int G = gridDim.x, bx = blockIdx.x, vcu = (G % 8 == 0) ? (bx % 8) * (G / 8) + bx / 8 : bx; \
              const int gw = vcu * NWAVES + wave, NGW = G * NWAVES; (void)tid; (void)lane; (void)wave; (void)gw; (void)NGW; (void)vcu; (void)bx
__global__ void __launch_bounds__(NTHR, 2) mega_fwd(Args args) {
    extern __shared__ __attribute__((aligned(16))) unsigned char lds_raw[];
    cg::grid_group grid = cg::this_grid();
    const lp lds = (lp)lds_raw;
    volatile LAS unsigned* xbst = (volatile LAS unsigned*)(lds + LDS_TOTAL - 64);
    if (threadIdx.x < 16) xbst[threadIdx.x] = 0u;
    __syncthreads();
    (void)xcd_barrier_post((unsigned*)(args.ws + WS_CTL), xbst);
    grid.sync();

    { IDS();
      Ptrs P;
      P.x = args.in[0]; P.w_in = args.in[1]; P.b_fgate = args.in[2]; P.lb_logits = args.in[3]; P.norm_g = args.in[4]; P.w_pa = args.in[5]; P.w_pb = args.in[6]; P.w_o = args.in[7];
      P.ln1_g = args.in[8]; P.ln1_b = args.in[9]; P.w_ff_in = args.in[10]; P.w_ff_out = args.in[11]; P.ln2_g = args.in[12]; P.ln2_b = args.in[13]; P.out = args.out; P.ws = args.ws;
      weight_items(P, (LAS float*)(lds + wave * 16384), gw, NGW, lane);
      __syncthreads();
      stage_wfa(P.w_in, (LAS float*)lds, tid);
      __syncthreads();
      row_pass<false, false, true, true>(P.x, nullptr, (bf16*)(P.ws + WS_XN), nullptr, nullptr, (float*)(P.ws + WS_LF), (const LAS float*)lds, P.b_fgate, gw, NGW, lane); }
    GSYNC();

#pragma unroll 1
    for (int l = 0; l < DEPTH; ++l) {
        {
        { IDS(); FRESH_PTR(unsigned char*, ws, args.ws); FRESH_PTR(const float*, lbl, args.in[3]);
          pg8::Gemm g{(const bf16*)(ws + WS_XN), (const bf16*)(ws + WS_W + (size_t)l * WL_STRIDE + WL_IN), M, NP1, D}; pg8::StaticOrder S; S.init(M, NP1, G, bx);
          pg8::EpiInProj E{(bf16*)(ws + WS_QA), (bf16*)(ws + WS_QB), (bf16*)(ws + WS_KA), (bf16*)(ws + WS_VA), (float*)(ws + WS_G), (bf16*)(ws + WS_IB), (bf16*)(ws + WS_GB), (unsigned char*)(ws + WS_GT8), lbl, l, attn_body::C2};
          pg8::gemm_phase<pg8::EpiInProj, pg8::StaticOrder, true, true>(lds, g, S, E); }
        }
        GSYNC();
        {
        { IDS(); FRESH_PTR(unsigned char*, ws, args.ws);
          hg::pass1_loop(vcu, G, (const float*)(ws + WS_G), (const bf16*)(ws + WS_IB), (bf16*)(ws + WS_ST), (float*)(ws + WS_DEC), lds, tid);
          __syncthreads();
          for (int u = vcu; u < 16; u += G) fcumsum_unit(u, (const float*)(ws + WS_LF), (float*)(ws + WS_F), lds, tid);
          for (int u = vcu; u < 256; u += G) norm_unit(u, (const bf16*)(ws + WS_QA), (const bf16*)(ws + WS_KA), (unsigned*)(ws + WS_CTL + CTL_NORM) + l * 32, tid); }
        }
        GSYNC();
        { IDS(); FRESH_PTR(unsigned char*, ws, args.ws);
          hg::pass2_scan((const bf16*)(ws + WS_ST), (bf16*)(ws + WS_ST), (const float*)(ws + WS_DEC), vcu * NTHR + tid, G * NTHR); }
        GSYNC();
        { FRESH_PTR(unsigned char*, ws, args.ws);
          const attn_body::AttnTensors AT{(const attn_body::bf16*)(ws + WS_QA), (const attn_body::bf16*)(ws + WS_KA), (const attn_body::bf16*)(ws + WS_VA), (attn_body::bf16*)(ws + WS_QA), (const float*)(ws + WS_F),
                                          (const unsigned*)(ws + WS_CTL + CTL_NORM) + l * 32};
          const attn_body::DynOrder S{(unsigned*)(ws + WS_CTL + CTL_QCTR) + l * 64, (volatile LAS unsigned*)(lds + attn_body::LDS_BYTES + 32)};
          attn_body::attn_phase<attn_body::DynOrder>((char*)lds_raw, AT, S); }
        { IDS(); FRESH_PTR(unsigned char*, ws, args.ws); FRESH_PTR(const float*, ng, args.in[4]);
          volatile LAS unsigned* slot = (volatile LAS unsigned*)(lds + attn_body::LDS_BYTES + 32); unsigned* ctr = (unsigned*)(ws + WS_CTL + CTL_PCTR) + l * 64;
          __syncthreads();
          hg::pass3_loop(ctr, slot, (const float*)(ws + WS_G), (const bf16*)(ws + WS_IB), (const bf16*)(ws + WS_GB), (const bf16*)(ws + WS_ST), (bf16*)(ws + WS_QB), ng + l * 128, lds, tid); }
        GSYNC();
        {
        { IDS(); FRESH_PTR(unsigned char*, ws, args.ws);
          { pg8::Gemm g{(const bf16*)(ws + WS_QA), (const bf16*)(ws + WS_W + (size_t)l * WL_STRIDE + WL_M), M, D, 512}; pg8::StaticOrder S; S.init(M, D, G, bx);
            pg8::EpiMerge<0> E{(const unsigned char*)(ws + WS_GT8), (bf16*)(ws + WS_MERGED)};
            pg8::gemm_phase<pg8::EpiMerge<0>, pg8::StaticOrder, true, true>(lds, g, S, E); }
          asm volatile("s_waitcnt vmcnt(0)" ::: "memory"); __syncthreads();
          { pg8::Gemm g{(const bf16*)(ws + WS_QB), (const bf16*)(ws + WS_W + (size_t)l * WL_STRIDE + WL_M + MiB), M, D, 512}; pg8::StaticOrder S; S.init(M, D, G, bx);
            pg8::EpiMerge<1> E{(const unsigned char*)(ws + WS_GT8), (bf16*)(ws + WS_MERGED)};
            pg8::gemm_phase<pg8::EpiMerge<1>, pg8::StaticOrder, true, true>(lds, g, S, E); } }
        }
        GSYNC();
        { IDS(); FRESH_PTR(unsigned char*, ws, args.ws); FRESH_PTR(const float*, xin, args.in[0]); FRESH_PTR(float*, outp, args.out); const float* xres = (l == 0) ? xin : (const float*)outp;
          pg8::Gemm g{(const bf16*)(ws + WS_MERGED), (const bf16*)(ws + WS_W + (size_t)l * WL_STRIDE + WL_O), M, D, D}; pg8::StaticOrder S; S.init(M, D, G, bx);
          FRESH_PTR(const float*, g2, args.in[12]); FRESH_PTR(const float*, b2, args.in[13]);
          pg8::EpiResid E{xres, outp, ALPHA, (l == 0) ? (const float*)nullptr : (const float*)(ws + WS_CTL + CTL_STATS + 262144), g2 + (l - 1) * D, b2 + (l - 1) * D};
          pg8::gemm_phase<pg8::EpiResid, pg8::StaticOrder, true, true>(lds, g, S, E); }
        GSYNC();
        { IDS(); FRESH_PTR(unsigned char*, ws, args.ws); FRESH_PTR(float*, outp, args.out); FRESH_PTR(const float*, gm, args.in[8]); FRESH_PTR(const float*, bt, args.in[9]);
          row_pass<true, false, true, false>(outp, nullptr, (bf16*)(ws + WS_XN), gm + l * D, bt + l * D, nullptr, nullptr, nullptr, gw, NGW, lane, (float*)(ws + WS_CTL + CTL_STATS + (size_t)l * 524288)); }
        GSYNC();
        {
        { IDS(); FRESH_PTR(unsigned char*, ws, args.ws);
          pg8::Gemm g{(const bf16*)(ws + WS_XN), (const bf16*)(ws + WS_W + (size_t)l * WL_STRIDE + WL_F1), M, NF1, D}; pg8::StaticOrder S; S.init(M, NF1, G, bx);
          pg8::EpiSwiGLU E{(bf16*)(ws + WS_H)};
          pg8::gemm_phase<pg8::EpiSwiGLU, pg8::StaticOrder, true, true>(lds, g, S, E); }
        }
        GSYNC();
        { IDS(); FRESH_PTR(unsigned char*, ws, args.ws); FRESH_PTR(float*, outp, args.out);
          pg8::Gemm g{(const bf16*)(ws + WS_H), (const bf16*)(ws + WS_W + (size_t)l * WL_STRIDE + WL_F2), M, D, FFH}; pg8::StaticOrder S; S.init(M, D, G, bx);
          FRESH_PTR(const float*, g1, args.in[8]); FRESH_PTR(const float*, b1, args.in[9]);
          pg8::EpiResid E{outp, outp, ALPHA, (const float*)(ws + WS_CTL + CTL_STATS + (size_t)l * 524288), g1 + l * D, b1 + l * D};
          pg8::gemm_phase<pg8::EpiResid, pg8::StaticOrder, true, true>(lds, g, S, E); }
        GSYNC();
        { IDS(); FRESH_PTR(unsigned char*, ws, args.ws); FRESH_PTR(float*, outp, args.out); FRESH_PTR(const float*, gm, args.in[12]); FRESH_PTR(const float*, bt, args.in[13]);
          if (l + 1 < DEPTH) {
              FRESH_PTR(const float*, win, args.in[1]); FRESH_PTR(const float*, bfg, args.in[2]);
              stage_wfa(win + (size_t)(l + 1) * D * NIN, (LAS float*)lds, tid);
              __syncthreads();
              row_pass<true, false, true, true>(outp, nullptr, (bf16*)(ws + WS_XN), gm + l * D, bt + l * D, (float*)(ws + WS_LF), (const LAS float*)lds, bfg + (l + 1) * 8, gw, NGW, lane, (float*)(ws + WS_CTL + CTL_STATS + 262144));
          } else {
              row_pass<true, true, false, false>(outp, outp, nullptr, gm + l * D, bt + l * D, nullptr, nullptr, nullptr, gw, NGW, lane);
          } }
        if (l + 1 < DEPTH) GSYNC();
    }
}

extern "C" void kernel_launch(void* const* d_in, const int* in_sizes, int n_in, void* d_out, int out_size, void* d_ws, size_t ws_size, hipStream_t stream) {
    static int grid = 0;
    if (grid == 0) {
        if (n_in != 14 || in_sizes[0] != M * D || out_size != M * D || ws_size < WS_END) { fprintf(stderr, "kernel_launch: unexpected shapes (n_in %d, in0 %d, out %d, ws %zu)\n", n_in, n_in > 0 ? in_sizes[0] : -1, out_size, ws_size); grid = -1; return; }
        int dev = 0, cus = 0, per_cu = 0;
        if (hipGetDevice(&dev) != hipSuccess || hipDeviceGetAttribute(&cus, hipDeviceAttributeMultiprocessorCount, dev) != hipSuccess) { grid = -1; return; }
        if (hipFuncSetAttribute((const void*)mega_fwd, hipFuncAttributeMaxDynamicSharedMemorySize, LDS_TOTAL) != hipSuccess) { fprintf(stderr, "kernel_launch: hipFuncSetAttribute failed\n"); grid = -1; return; }
        if (hipOccupancyMaxActiveBlocksPerMultiprocessor(&per_cu, (const void*)mega_fwd, NTHR, LDS_TOTAL) != hipSuccess || per_cu < 1) { fprintf(stderr, "kernel_launch: occupancy query says %d\n", per_cu); per_cu = 1; }
        (void)hipGetLastError();
        grid = cus * per_cu;
    }
    if (grid < 0) return;
    if (hipMemsetAsync((char*)d_ws + WS_CTL, 0, 65536, stream) != hipSuccess) { fprintf(stderr, "kernel_launch: hipMemsetAsync failed\n"); return; }
    Args a{};
    for (int i = 0; i < 14; ++i) a.in[i] = (const float*)d_in[i];
    a.out = (float*)d_out; a.ws = (unsigned char*)d_ws;
    void* kargs[] = {&a};
    hipError_t e = hipLaunchCooperativeKernel((const void*)mega_fwd, dim3(grid), dim3(NTHR), kargs, LDS_TOTAL, stream);
    if (e != hipSuccess) fprintf(stderr, "kernel_launch: cooperative launch failed: %s (grid %d)\n", hipGetErrorString(e), grid);
}
```
